# Optimizing an MI355X kernel written in HIP

```python
import math, functools
import jax, jax.numpy as jnp
from jax import lax
import numpy as np

D_MODEL = 2048
BATCH = 2
SEQ = 4096
DEPTH = 4
DEC_BATCH = 8
DEC_SEQ = 4
PAST_LEN = 16384
PAGE_SIZE = 128

D_FF = 5504
EPS = 1e-6
N_BRANCH = 4
CONV_WIDTH = 3
W_CONV = 512
ATTN_GROUPS = ((128, 1), (512, 4), (2048, 16))
HEADS_PER_GROUP = 4
ATTN_HEAD_DIM = 64
N_ATTN_HEADS = HEADS_PER_GROUP * len(ATTN_GROUPS)
W_ATTN = N_ATTN_HEADS * ATTN_HEAD_DIM
ATTN_OUT = HEADS_PER_GROUP * ATTN_HEAD_DIM
GLA_HEADS = 4
GLA_DK = 64
GLA_DV = 128
GLA_LOW_RANK = 16
GLA_TAU = 16.0
GLA_CHUNK = 64
POOL_WINDOWS = (2, 4, 8, 16)
POOL_GROUP = 128
W_POOL = POOL_GROUP * len(POOL_WINDOWS)
POOL_HIST = max(POOL_WINDOWS) - 1
IN_SIZES = (W_CONV, W_CONV, W_CONV, W_ATTN, W_ATTN, W_ATTN,
            GLA_HEADS * GLA_DK, GLA_HEADS * GLA_DK, GLA_HEADS * GLA_DV, GLA_HEADS * GLA_DV,
            GLA_LOW_RANK, W_POOL, N_BRANCH * D_MODEL)
N_IN = sum(IN_SIZES)

kernel_name = 'hybrid_gated_branch_decoder_step'


def rmsnorm(x, g):
    xf = x.astype(jnp.float32)
    xf = xf * lax.rsqrt(jnp.mean(xf * xf, axis=-1, keepdims=True) + EPS)
    return xf.astype(x.dtype) * g


def swiglu(x, w_gate, w_up, w_down):
    return (jax.nn.silu(x @ w_gate) * (x @ w_up)) @ w_down


def alibi_slopes():
    i = jnp.arange(1, N_ATTN_HEADS + 1, dtype=jnp.float32)
    return jnp.exp2(-8.0 * i / N_ATTN_HEADS)


def short_conv(u, buf, w):
    T = u.shape[1]
    ext = jnp.concatenate([buf.astype(u.dtype), u], axis=1)
    z = ext[:, 0:T] * w[0]
    for i in range(1, CONV_WIDTH):
        z = z + ext[:, i:i + T] * w[i]
    return z, ext[:, T:]


def pool_mix(u, buf, pos0, w_grp, scale):
    B, T, _ = u.shape
    G = len(POOL_WINDOWS)
    ext = jnp.concatenate([buf.astype(u.dtype), u], axis=1)
    cs = jnp.cumsum(ext.astype(jnp.float32), axis=1)
    cs = jnp.pad(cs, ((0, 0), (1, 0), (0, 0))).reshape(B, POOL_HIST + T + 1, G, POOL_GROUP)
    pos = (pos0 + jnp.arange(T)).astype(jnp.float32)
    hi = cs[:, POOL_HIST + 1:]
    means = []
    for g, w in enumerate(POOL_WINDOWS):
        lo = cs[:, POOL_HIST + 1 - w: POOL_HIST + 1 - w + T, g]
        cnt = jnp.minimum(float(w), pos + 1.0)
        means.append((hi[:, :, g] - lo) / cnt[None, :, None])
    d = jnp.stack(means, axis=2) - u.reshape(B, T, G, POOL_GROUP).astype(jnp.float32)
    y = jnp.einsum('btgc,gcd->btgd', d.astype(u.dtype), w_grp).reshape(B, T, W_POOL) * scale
    return y, ext[:, T:]


def dilated_attn_prompt(q, k, v, slopes, window, dil):
    B, S, H, E = q.shape
    nk = window // dil
    M = S // dil
    nb = -(-M // nk)
    Mp = nb * nk

    def sub(a):
        a = a.reshape(B, M, dil, H, E).transpose(0, 2, 1, 3, 4)
        a = jnp.pad(a, ((0, 0), (0, 0), (0, Mp - M), (0, 0), (0, 0)))
        return a.reshape(B, dil, nb, nk, H, E)

    def with_prev(a):
        prev = jnp.pad(a, ((0, 0), (0, 0), (1, 0), (0, 0), (0, 0), (0, 0)))[:, :, :-1]
        return jnp.concatenate([prev, a], axis=3)

    qb = sub(q)
    kb = with_prev(sub(k))
    vb = with_prev(sub(v))
    s = jnp.einsum('brnqhe,brnkhe->brnhqk', qb, kb).astype(jnp.float32) / math.sqrt(E)
    qi = jnp.arange(nk)[:, None]
    ki = jnp.arange(2 * nk)[None, :]
    dist = qi - ki + nk
    key_sub = jnp.arange(nb)[:, None, None] * nk + ki[None] - nk
    valid = (dist >= 0) & (dist <= nk) & (key_sub >= 0)
    s = s - slopes[:, None, None] * (dist * dil).astype(jnp.float32)
    s = jnp.where(valid[:, None], s, -jnp.inf)
    m = jnp.max(s, axis=-1, keepdims=True)
    p = jnp.exp(s - m)
    l = jnp.sum(p, axis=-1, keepdims=True)
    o = jnp.einsum('brnhqk,brnkhe->brnhqe', p, vb.astype(jnp.float32)) / l
    lse = (m + jnp.log(l))[..., 0]

    def unsub(a):
        a = jnp.moveaxis(a, 3, 4)
        a = a.reshape((B, dil, Mp) + a.shape[4:])[:, :, :M]
        return jnp.moveaxis(a, 1, 2).reshape((B, S) + a.shape[3:])

    return unsub(o), unsub(lse)


def dilated_attn_sample(q, k_all, v_all, slopes, window, dil):
    B, T, H, E = q.shape
    L = k_all.shape[1] - T
    nk = window // dil
    steps = jnp.arange(nk + 1)
    idx = L + jnp.arange(T)[:, None] - steps[None, :] * dil
    valid = idx >= 0
    idx = jnp.maximum(idx, 0)
    kk = k_all[:, idx]
    vv = v_all[:, idx]
    s = jnp.einsum('bthe,btkhe->bthk', q, kk).astype(jnp.float32) / math.sqrt(E)
    s = s - slopes[:, None] * (steps * dil).astype(jnp.float32)[None, :]
    s = jnp.where(valid[:, None, :], s, -jnp.inf)
    m = jnp.max(s, axis=-1, keepdims=True)
    p = jnp.exp(s - m)
    l = jnp.sum(p, axis=-1, keepdims=True)
    o = jnp.einsum('bthk,btkhe->bthe', p, vv.astype(jnp.float32)) / l
    lse = (m + jnp.log(l))[..., 0]
    return o, lse


def merge_groups(outs, lses):
    w = jax.nn.softmax(jnp.stack(lses, 0), axis=0)
    o = jnp.sum(w[..., None] * jnp.stack(outs, 0), axis=0)
    return o.reshape(o.shape[:2] + (-1,))


def attend_prompt(q, k, v, slopes):
    outs, lses, bufs = [], [], []
    for g, (window, dil) in enumerate(ATTN_GROUPS):
        hs = slice(g * HEADS_PER_GROUP, (g + 1) * HEADS_PER_GROUP)
        o, lse = dilated_attn_prompt(q[:, :, hs], k[:, :, hs], v[:, :, hs], slopes[hs], window, dil)
        outs.append(o)
        lses.append(lse)
        n_keep = min(window, q.shape[1])
        bufs.append(jnp.stack([k[:, -n_keep:, hs], v[:, -n_keep:, hs]], axis=2))
    return merge_groups(outs, lses).astype(q.dtype), bufs


def attend_sample(q, k, v, slopes, caches):
    outs, lses, bufs = [], [], []
    for g, (window, dil) in enumerate(ATTN_GROUPS):
        hs = slice(g * HEADS_PER_GROUP, (g + 1) * HEADS_PER_GROUP)
        buf = caches[g]
        L = buf.shape[1]
        k_all = jnp.concatenate([buf[:, :, 0].astype(k.dtype), k[:, :, hs]], axis=1)
        v_all = jnp.concatenate([buf[:, :, 1].astype(v.dtype), v[:, :, hs]], axis=1)
        o, lse = dilated_attn_sample(q[:, :, hs], k_all, v_all, slopes[hs], window, dil)
        outs.append(o)
        lses.append(lse)
        bufs.append(jnp.stack([k_all[:, -L:], v_all[:, -L:]], axis=2))
    return merge_groups(outs, lses).astype(q.dtype), bufs


def gla_chunked(q, k, v, log_a, S0):
    B, T, H, K = q.shape
    V = v.shape[-1]
    C = min(GLA_CHUNK, T)
    n = -(-T // C)
    Tp = n * C

    def blocks(a):
        a = jnp.pad(a.astype(jnp.float32), ((0, 0), (0, Tp - T), (0, 0), (0, 0)))
        return a.reshape(B, n, C, H, a.shape[-1]).transpose(1, 0, 3, 2, 4)

    qf, kf, vf = blocks(q), blocks(k), blocks(v)
    b = jnp.cumsum(blocks(log_a), axis=3)
    b_last = b[:, :, :, -1:]
    q_t = qf * jnp.exp(b)
    k_t = kf * jnp.exp(-b)
    k_end = kf * jnp.exp(b_last - b)
    mask = jnp.tril(jnp.ones((C, C), dtype=bool))
    A = jnp.where(mask, jnp.einsum('nbhtk,nbhsk->nbhts', q_t, k_t), 0.0)
    o_intra = jnp.einsum('nbhts,nbhsv->nbhtv', A, vf)
    dS = jnp.einsum('nbhsk,nbhsv->nbhkv', k_end, vf)
    decay = jnp.exp(b_last[:, :, :, 0])

    def step(S, inp):
        dec, d = inp
        return dec[..., None] * S + d, S

    S_fin, S_prev = lax.scan(step, S0.astype(jnp.float32), (decay, dS))
    o = o_intra + jnp.einsum('nbhtk,nbhkv->nbhtv', q_t, S_prev)
    o = o.transpose(1, 0, 3, 2, 4).reshape(B, Tp, H, V)[:, :T]
    return o.astype(q.dtype), S_fin.astype(S0.dtype)


def token_mix(xn, p, conv_buf, pool_buf, gla_state, pos0, attend):
    B, T, _ = xn.shape
    split_at = np.cumsum(IN_SIZES)[:-1].tolist()
    (c_b, c_c, c_h, a_q, a_k, a_v, g_q, g_k, g_v, g_r, g_lr, pool_in, gate_in) = jnp.split(
        xn @ p['w_in'], split_at, axis=-1)
    z, conv_new = short_conv(c_c * c_h, conv_buf, p['conv_w'])
    y_a = c_b * z
    hd = (B, T, N_ATTN_HEADS, ATTN_HEAD_DIM)
    q = rmsnorm(a_q.reshape(hd), p['q_gain'])
    k = rmsnorm(a_k.reshape(hd), p['k_gain'])
    y_b, win_new = attend(q, k, a_v.reshape(hd))
    gq = g_q.reshape(B, T, GLA_HEADS, GLA_DK) * (GLA_DK ** -0.5)
    gk = g_k.reshape(B, T, GLA_HEADS, GLA_DK)
    gv = g_v.reshape(B, T, GLA_HEADS, GLA_DV)
    log_a = jax.nn.log_sigmoid((g_lr @ p['gla_w_a2'] + p['gla_b_a']).astype(jnp.float32)) / GLA_TAU
    o, gla_new = gla_chunked(gq, gk, gv, log_a.reshape(B, T, GLA_HEADS, GLA_DK), gla_state)
    y_c = rmsnorm(o, p['gla_norm']).reshape(B, T, GLA_HEADS * GLA_DV) * jax.nn.silu(g_r)
    y_d, pool_new = pool_mix(pool_in, pool_buf, pos0, p['pool_w'], p['pool_scale'])
    gates = jax.nn.sigmoid(gate_in.reshape(B, T, N_BRANCH, D_MODEL))
    merged = (gates[:, :, 0] * (y_a @ p['up_a']) + gates[:, :, 1] * (y_b @ p['up_b'])
              + gates[:, :, 2] * (y_c @ p['up_c']) + gates[:, :, 3] * (y_d @ p['up_d']))
    return merged @ p['w_out'], (conv_new, win_new, gla_new, pool_new)


def decoder_layer(x, p, conv_buf, pool_buf, gla_state, pos0, attend):
    x = x + 0.5 * swiglu(rmsnorm(x, p['n_ff1']), p['ff1_gate'], p['ff1_up'], p['ff1_down'])
    mix, new_state = token_mix(rmsnorm(x, p['n_mix']), p, conv_buf, pool_buf, gla_state, pos0, attend)
    x = x + mix
    x = x + 0.5 * swiglu(rmsnorm(x, p['n_ff2']), p['ff2_gate'], p['ff2_up'], p['ff2_down'])
    return x, new_state


def setup_inputs(seed: int = 0) -> dict:
    key = jax.random.key(seed)
    keys = iter(jax.random.split(key, 40))

    def nrm(shape, scale=1.0):
        return jax.random.normal(next(keys), shape, jnp.float32) * scale

    def gain(shape):
        return 1.0 + 0.02 * jax.random.normal(next(keys), shape, jnp.float32)

    d = {}
    d['x_prompt'] = nrm((BATCH, SEQ, D_MODEL))
    d['x_sample'] = nrm((DEC_BATCH, DEC_SEQ, D_MODEL))
    d['state_conv'] = nrm((DEPTH, DEC_BATCH, CONV_WIDTH - 1, W_CONV))
    for window, _ in ATTN_GROUPS:
        d['cache_w%d_kv' % window] = nrm((DEPTH, DEC_BATCH, min(window, PAST_LEN), 2, HEADS_PER_GROUP, ATTN_HEAD_DIM))
    d['state_gla'] = nrm((DEPTH, DEC_BATCH, GLA_HEADS, GLA_DK, GLA_DV))
    d['state_pool'] = nrm((DEPTH, DEC_BATCH, POOL_HIST, W_POOL))
    d['norm_ff1'] = gain((DEPTH, D_MODEL))
    d['ff1_gate'] = nrm((DEPTH, D_MODEL, D_FF), D_MODEL ** -0.5)
    d['ff1_up'] = nrm((DEPTH, D_MODEL, D_FF), D_MODEL ** -0.5)
    d['ff1_down'] = nrm((DEPTH, D_FF, D_MODEL), D_FF ** -0.5)
    d['norm_mix'] = gain((DEPTH, D_MODEL))
    d['w_in'] = nrm((DEPTH, D_MODEL, N_IN), D_MODEL ** -0.5)
    d['conv_w'] = nrm((DEPTH, CONV_WIDTH, W_CONV), CONV_WIDTH ** -0.5)
    d['attn_q_gain'] = gain((DEPTH, N_ATTN_HEADS, ATTN_HEAD_DIM))
    d['attn_k_gain'] = gain((DEPTH, N_ATTN_HEADS, ATTN_HEAD_DIM))
    d['gla_w_a2'] = nrm((DEPTH, GLA_LOW_RANK, GLA_HEADS * GLA_DK), GLA_LOW_RANK ** -0.5)
    d['gla_b_a'] = nrm((DEPTH, GLA_HEADS * GLA_DK), 0.1)
    d['gla_norm'] = gain((DEPTH, GLA_DV))
    d['pool_w'] = nrm((DEPTH, len(POOL_WINDOWS), POOL_GROUP, POOL_GROUP), POOL_GROUP ** -0.5)
    d['pool_scale'] = gain((DEPTH, W_POOL))
    d['w_up_conv'] = nrm((DEPTH, W_CONV, D_MODEL), W_CONV ** -0.5)
    d['w_up_attn'] = nrm((DEPTH, ATTN_OUT, D_MODEL), ATTN_OUT ** -0.5)
    d['w_up_gla'] = nrm((DEPTH, GLA_HEADS * GLA_DV, D_MODEL), (GLA_HEADS * GLA_DV) ** -0.5)
    d['w_up_pool'] = nrm((DEPTH, W_POOL, D_MODEL), W_POOL ** -0.5)
    d['w_out'] = nrm((DEPTH, D_MODEL, D_MODEL), D_MODEL ** -0.5)
    d['norm_ff2'] = gain((DEPTH, D_MODEL))
    d['ff2_gate'] = nrm((DEPTH, D_MODEL, D_FF), D_MODEL ** -0.5)
    d['ff2_up'] = nrm((DEPTH, D_MODEL, D_FF), D_MODEL ** -0.5)
    d['ff2_down'] = nrm((DEPTH, D_FF, D_MODEL), D_FF ** -0.5)
    return d


def reference(x_prompt, x_sample, state_conv, cache_w128_kv, cache_w512_kv, cache_w2048_kv, state_gla, state_pool,
              norm_ff1, ff1_gate, ff1_up, ff1_down, norm_mix, w_in, conv_w, attn_q_gain, attn_k_gain,
              gla_w_a2, gla_b_a, gla_norm, pool_w, pool_scale, w_up_conv, w_up_attn, w_up_gla, w_up_pool, w_out,
              norm_ff2, ff2_gate, ff2_up, ff2_down):
    slopes = alibi_slopes()
    win_caches = (cache_w128_kv, cache_w512_kv, cache_w2048_kv)
    bp = x_prompt.shape[0]
    dt = x_prompt.dtype
    yp, ys = x_prompt, x_sample
    conv_p, conv_s, gla_p, gla_s, pool_p, pool_s = [], [], [], [], [], []
    win_p = [[] for _ in ATTN_GROUPS]
    win_s = [[] for _ in ATTN_GROUPS]
    for l in range(DEPTH):
        p = {'n_ff1': norm_ff1[l], 'ff1_gate': ff1_gate[l], 'ff1_up': ff1_up[l], 'ff1_down': ff1_down[l],
             'n_mix': norm_mix[l], 'w_in': w_in[l], 'conv_w': conv_w[l],
             'q_gain': attn_q_gain[l], 'k_gain': attn_k_gain[l],
             'gla_w_a2': gla_w_a2[l], 'gla_b_a': gla_b_a[l], 'gla_norm': gla_norm[l],
             'pool_w': pool_w[l], 'pool_scale': pool_scale[l],
             'up_a': w_up_conv[l], 'up_b': w_up_attn[l], 'up_c': w_up_gla[l], 'up_d': w_up_pool[l],
             'w_out': w_out[l], 'n_ff2': norm_ff2[l], 'ff2_gate': ff2_gate[l], 'ff2_up': ff2_up[l],
             'ff2_down': ff2_down[l]}
        yp, (c_new, w_new, g_new, q_new) = decoder_layer(
            yp, p,
            jnp.zeros((bp, CONV_WIDTH - 1, W_CONV), dt),
            jnp.zeros((bp, POOL_HIST, W_POOL), dt),
            jnp.zeros((bp, GLA_HEADS, GLA_DK, GLA_DV), jnp.float32),
            0, functools.partial(attend_prompt, slopes=slopes))
        conv_p.append(c_new)
        gla_p.append(g_new)
        pool_p.append(q_new)
        for g in range(len(ATTN_GROUPS)):
            win_p[g].append(w_new[g])
        caches_l = tuple(c[l] for c in win_caches)
        ys, (c_new, w_new, g_new, q_new) = decoder_layer(
            ys, p, state_conv[l], state_pool[l], state_gla[l], PAST_LEN,
            functools.partial(attend_sample, slopes=slopes, caches=caches_l))
        conv_s.append(c_new)
        gla_s.append(g_new)
        pool_s.append(q_new)
        for g in range(len(ATTN_GROUPS)):
            win_s[g].append(w_new[g])
    conv_prompt = jnp.stack(conv_p)
    conv_sample = jnp.stack(conv_s)
    w128_prompt = jnp.stack(win_p[0])
    w128_sample = jnp.stack(win_s[0])
    w512_prompt = jnp.stack(win_p[1])
    w512_sample = jnp.stack(win_s[1])
    w2048_prompt = jnp.stack(win_p[2])
    w2048_sample = jnp.stack(win_s[2])
    gla_prompt = jnp.stack(gla_p)
    gla_sample = jnp.stack(gla_s)
    pool_prompt = jnp.stack(pool_p)
    pool_sample = jnp.stack(pool_s)
    return (yp, ys, conv_prompt, conv_sample, w128_prompt, w128_sample, w512_prompt, w512_sample,
            w2048_prompt, w2048_sample, gla_prompt, gla_sample, pool_prompt, pool_sample)
```

```cpp
#include <hip/hip_runtime.h>
#include <cstdio>
#include <cstdint>
#include <cstring>
#ifndef PROBE_DUP
#define PROBE_DUP 0
#endif
namespace pg8 {
#define PG8_LAS __attribute__((address_space(3)))
typedef unsigned short bf16_t;
typedef short bf16x8 __attribute__((ext_vector_type(8)));
typedef float f32x4 __attribute__((ext_vector_type(4)));
typedef unsigned u32x4 __attribute__((ext_vector_type(4)));
constexpr int BM = 256, BK = 64, HALF = 128, HTB = HALF * BK * 2  , STAGE_BYTES = 8 * HTB, NXCD = 8, WGM = 8;

__host__ __device__ __forceinline__ int lds_byte(int r, int c) { const int st = (r >> 4) * 2 + (c >> 5), rr = r & 15, cc = c & 31, ob = rr * 64 + cc * 2; return st * 1024 + (ob ^ (((ob >> 9) & 1) << 5)); }
__host__ __device__ __forceinline__ void stage_rc(int b, int& R, int& C) { const int st = b / 1024, sb = b % 1024, swz = sb ^ (((sb >> 9) & 1) << 5); R = (st >> 1) * 16 + swz / 64; C = (st & 1) * 32 + (swz % 64) / 2; }
__host__ __device__ __forceinline__ int perm32(int rho) { const int n = rho >> 4, i = rho & 15; return 8 * (i >> 2) + 4 * n + (i & 3); }

struct Unit { int pm, pn, ri; };
struct Gemm { const bf16_t* A; const bf16_t* Bt; int M, N, K; };

struct StaticOrder {
    int nM, nN, nwg, G, c, rep;
    __host__ __device__ void init(int M, int N, int G_, int c_, int rep_ = 1) { nM = M / BM; nN = N / BM; nwg = nM * nN; G = G_; c = c_; rep = rep_; }
    __host__ __device__ bool next(int i, Unit& u) const {
        const long L = (long)i * G + c; if (L >= (long)rep * nwg) return false;
        int wgid = (int)(L % nwg);
#if (PROBE_DUP >> 15) & 1
        if (L >= nwg) wgid = 0;
#endif
        { const int q = nwg / NXCD, r = nwg % NXCD, xcd = wgid % NXCD, off = wgid / NXCD; wgid = (xcd < r ? xcd * (q + 1) : r * (q + 1) + (xcd - r) * q) + off; }
        const int nig = WGM * nN, gid = wgid / nig, fm = gid * WGM, gsz = (nM - fm) < WGM ? (nM - fm) : WGM;
        u.pm = fm + ((wgid % nig) % gsz); u.pn = (wgid % nig) / gsz; u.ri = (int)(L / nwg); return true;
    }
    __device__ __forceinline__ void a_ready(const Unit&) const {}
    __device__ __forceinline__ void done(const Unit&) const {}
};

template <class Epi, class Sched, bool ALIGN_EPI = false, bool SP2 = false>
__device__ __forceinline__ void gemm_phase(PG8_LAS unsigned char* lds, const Gemm g, const Sched S, const Epi E, const int tid) {
    const int wid = __builtin_amdgcn_readfirstlane(tid >> 6), lane = tid & 63, wr = wid >> 2, wc = wid & 3, fr = lane & 15, fq = lane >> 4;
    const int K = g.K, nt = K / BK;
    unsigned voffA[2], voffB[2];
#pragma unroll
    for (int i = 0; i < 2; ++i) { int R, C; stage_rc(tid * 16 + i * 8192, R, C); const int Rb = Epi::PERM ? ((R & ~31) + perm32(R & 31)) : R;
        voffA[i] = (unsigned)(R * K + C) * 2u; voffB[i] = (unsigned)(Rb * K + C) * 2u; }
    const size_t kstep = (size_t)(BK * 2);
    const size_t hstep = (size_t)HALF * K * 2;
    const size_t tstep = 2 * hstep;
    const unsigned ldsw = (unsigned)wid * 1024u;
    const int aoff = lds_byte(wr * 64 + fr, fq * 8), boff = lds_byte(wc * 32 + fr, fq * 8);
#define PG8_SA(b, h) (((b) * 2 + (h)) * HTB)
#define PG8_SB(b, h) ((4 + (b) * 2 + (h)) * HTB)
#define PG8_STAGE(bufoff, gbase, voff) do { _Pragma("unroll") for (int _i = 0; _i < 2; ++_i) \
        __builtin_amdgcn_global_load_lds((const unsigned*)((const char*)(gbase) + (voff)[_i]), (PG8_LAS unsigned*)(lds + (bufoff) + ldsw + _i * 8192), 16, 0, 0); } while (0)
#define PG8_LDA(dst, b, h) do { _Pragma("unroll") for (int m = 0; m < 4; ++m) _Pragma("unroll") for (int k = 0; k < 2; ++k) dst[m][k] = *(const PG8_LAS bf16x8*)(lds + PG8_SA(b, h) + aoff + m * 2048 + k * 1024); } while (0)
#define PG8_LDB(dst, b, h) do { _Pragma("unroll") for (int n = 0; n < 2; ++n) _Pragma("unroll") for (int k = 0; k < 2; ++k) dst[n][k] = *(const PG8_LAS bf16x8*)(lds + PG8_SB(b, h) + boff + n * 2048 + k * 1024); } while (0)
#define PG8_MMA(ai, bj, At, Bt) do { __builtin_amdgcn_s_setprio(1); _Pragma("unroll") for (int m = 0; m < 4; ++m) _Pragma("unroll") for (int n = 0; n < 2; ++n) _Pragma("unroll") for (int k = 0; k < 2; ++k) \
        acc[ai][bj][m][n] = __builtin_amdgcn_mfma_f32_16x16x32_bf16(Bt[n][k], At[m][k], acc[ai][bj][m][n], 0, 0, 0); __builtin_amdgcn_s_setprio(0); } while (0)
#define PG8_WAIT_V(n) asm volatile("s_waitcnt vmcnt(" #n ")" ::: "memory")
#define PG8_WAIT_L(n) asm volatile("s_waitcnt lgkmcnt(" #n ")" ::: "memory")
#define PG8_BAR __builtin_amdgcn_s_barrier()
#define PG8_SCHED __builtin_amdgcn_sched_barrier(0)
    Unit cur, nxt; int ui = 0;
    if (!S.next(0, cur)) return;
    f32x4 acc[2][2][4][2];
#pragma unroll
    for (int a = 0; a < 2; ++a)
#pragma unroll
        for (int b = 0; b < 2; ++b)
#pragma unroll
            for (int m = 0; m < 4; ++m)
#pragma unroll
                for (int n = 0; n < 2; ++n) acc[a][b][m][n] = (f32x4){0.f, 0.f, 0.f, 0.f};
    bf16x8 At[4][2], B0[2][2], B1[2][2];
    const char* cA = (const char*)g.A + (size_t)cur.pm * tstep; const char* cB = (const char*)g.Bt + (size_t)cur.pn * tstep;
    S.a_ready(cur);
    if constexpr (SP2) {
        PG8_STAGE(PG8_SB(0, 0), cB, voffB); PG8_STAGE(PG8_SB(0, 1), cB + hstep, voffB); PG8_STAGE(PG8_SA(0, 0), cA, voffA); PG8_STAGE(PG8_SA(0, 1), cA + hstep, voffA);
        if (wr == 1) PG8_BAR;
        PG8_WAIT_V(2); PG8_BAR;
        PG8_STAGE(PG8_SB(1, 0), cB + kstep, voffB); PG8_STAGE(PG8_SA(1, 0), cA + kstep, voffA); PG8_STAGE(PG8_SB(1, 1), cB + hstep + kstep, voffB);
        PG8_WAIT_V(6); PG8_BAR;
    } else {
        PG8_STAGE(PG8_SB(0, 0), cB, voffB); PG8_STAGE(PG8_SA(0, 0), cA, voffA); PG8_STAGE(PG8_SB(0, 1), cB + hstep, voffB); PG8_STAGE(PG8_SA(0, 1), cA + hstep, voffA);
        if (wr == 1) PG8_BAR;
        PG8_WAIT_V(4); PG8_BAR;
        PG8_STAGE(PG8_SB(1, 0), cB + kstep, voffB); PG8_STAGE(PG8_SA(1, 0), cA + kstep, voffA); PG8_STAGE(PG8_SB(1, 1), cB + hstep + kstep, voffB);
        PG8_WAIT_V(6); PG8_BAR;
    }
    for (;;) {
        const bool has_next = S.next(ui + 1, nxt);
        const char* nA = has_next ? (const char*)g.A + (size_t)nxt.pm * tstep : cA; const char* nB = has_next ? (const char*)g.Bt + (size_t)nxt.pn * tstep : cB;
        for (int t = 0; t < nt; t += 2) {
            const bool last = (t == nt - 2);
            const char* a1 = cA + (size_t)(t + 1) * kstep;
            const char* a2 = last ? nA : cA + (size_t)(t + 2) * kstep; const char* b2 = last ? nB : cB + (size_t)(t + 2) * kstep;
            const char* a3 = a2 + kstep; const char* b3 = b2 + kstep;
            if (last && has_next) S.a_ready(nxt);
            if constexpr (Epi::HAS_MID) { if (t == 8 || t == 12 || t == 20) E.mid(acc, cur, t, wr, wc, fr, fq); }
            if constexpr (SP2) {
            PG8_LDB(B0, 0, 0); PG8_LDB(B1, 0, 1); PG8_SCHED; PG8_LDA(At, 0, 0); PG8_STAGE(PG8_SA(1, 1), a1 + hstep, voffA);
            PG8_WAIT_V(8); PG8_WAIT_L(0); PG8_BAR; PG8_MMA(0, 0, At, B0); PG8_MMA(0, 1, At, B1); PG8_BAR; PG8_SCHED;
            PG8_LDA(At, 0, 1); PG8_STAGE(PG8_SB(0, 0), b2, voffB); PG8_STAGE(PG8_SB(0, 1), b2 + hstep, voffB); PG8_STAGE(PG8_SA(0, 0), a2, voffA);
            PG8_WAIT_V(8); PG8_WAIT_L(0); PG8_BAR; PG8_MMA(1, 0, At, B0); PG8_MMA(1, 1, At, B1); PG8_BAR; PG8_SCHED;
            PG8_LDB(B0, 1, 0); PG8_LDB(B1, 1, 1); PG8_SCHED; PG8_LDA(At, 1, 0); PG8_STAGE(PG8_SA(0, 1), a2 + hstep, voffA);
            PG8_WAIT_V(8); PG8_WAIT_L(0); PG8_BAR; PG8_MMA(0, 0, At, B0); PG8_MMA(0, 1, At, B1); PG8_BAR; PG8_SCHED;
            PG8_LDA(At, 1, 1); PG8_STAGE(PG8_SB(1, 0), b3, voffB); PG8_STAGE(PG8_SB(1, 1), b3 + hstep, voffB); PG8_STAGE(PG8_SA(1, 0), a3, voffA);
            PG8_WAIT_V(8); PG8_WAIT_L(0); PG8_BAR; PG8_MMA(1, 0, At, B0); PG8_MMA(1, 1, At, B1); PG8_BAR; PG8_SCHED;
            } else {
            PG8_LDB(B0, 0, 0); PG8_SCHED; PG8_LDA(At, 0, 0); PG8_STAGE(PG8_SA(1, 1), a1 + hstep, voffA);
            PG8_WAIT_L(8); PG8_BAR; PG8_WAIT_L(0); PG8_MMA(0, 0, At, B0); PG8_BAR; PG8_SCHED;
            PG8_LDB(B1, 0, 1); PG8_STAGE(PG8_SB(0, 0), b2, voffB);
            PG8_BAR; PG8_WAIT_L(0); PG8_MMA(0, 1, At, B1); PG8_BAR;
            PG8_LDA(At, 0, 1); PG8_STAGE(PG8_SA(0, 0), a2, voffA);
            PG8_BAR; PG8_WAIT_L(0); PG8_MMA(1, 0, At, B0); PG8_BAR; PG8_SCHED;
            PG8_STAGE(PG8_SB(0, 1), b2 + hstep, voffB);
            PG8_WAIT_V(6); PG8_BAR; PG8_MMA(1, 1, At, B1); PG8_BAR;
            PG8_LDB(B0, 1, 0); PG8_SCHED; PG8_LDA(At, 1, 0); PG8_STAGE(PG8_SA(0, 1), a2 + hstep, voffA);
            PG8_WAIT_L(8); PG8_BAR; PG8_WAIT_L(0); PG8_MMA(0, 0, At, B0); PG8_BAR; PG8_SCHED;
            PG8_LDB(B1, 1, 1); PG8_STAGE(PG8_SB(1, 0), b3, voffB);
            PG8_BAR; PG8_WAIT_L(0); PG8_MMA(0, 1, At, B1); PG8_BAR;
            PG8_LDA(At, 1, 1); PG8_STAGE(PG8_SA(1, 0), a3, voffA);
            PG8_BAR; PG8_WAIT_L(0); PG8_MMA(1, 0, At, B0); PG8_BAR; PG8_SCHED;
            PG8_STAGE(PG8_SB(1, 1), b3 + hstep, voffB);
            PG8_WAIT_V(6); PG8_BAR; PG8_MMA(1, 1, At, B1); PG8_BAR;
            }
        }
        if constexpr (ALIGN_EPI) { if (wr == 0) PG8_BAR; }
        if constexpr (!Epi::AFTER_DRAIN) { E(acc, cur, wr, wc, fr, fq); S.done(cur); }
        if (!has_next) break;
#pragma unroll
        for (int a = 0; a < 2; ++a)
#pragma unroll
            for (int b = 0; b < 2; ++b)
#pragma unroll
                for (int m = 0; m < 4; ++m)
#pragma unroll
                    for (int n = 0; n < 2; ++n) acc[a][b][m][n] = (f32x4){0.f, 0.f, 0.f, 0.f};
        cur = nxt; cA = nA; cB = nB; ++ui;
        if constexpr (ALIGN_EPI) { if (wr == 1) PG8_BAR; }
    }
    PG8_WAIT_V(0);
    if constexpr (!ALIGN_EPI) { if (wr == 0) PG8_BAR; }
    PG8_BAR;
    if constexpr (Epi::AFTER_DRAIN) { E.fused(acc, cur, wr, wc, fr, fq, lds, wid, lane); S.done(cur); }
#undef PG8_SA
#undef PG8_SB
#undef PG8_STAGE
#undef PG8_LDA
#undef PG8_LDB
#undef PG8_MMA
#undef PG8_WAIT_V
#undef PG8_WAIT_L
#undef PG8_BAR
#undef PG8_SCHED
}
}

constexpr int DM = 2048, DFF = 5504, DEPTH = 4;
constexpr int SEQ = 4096, NB_P = 2, MP = NB_P * SEQ;
constexpr int NB_S = 8, TS = 4, MS = NB_S * TS;
constexpr int MR = MP + MS;
constexpr int MPAD = 8448;
constexpr int PAST = 16384;
constexpr int N_IN = 14096, NWIN = 14336;
constexpr int NGU = 2 * DFF;
constexpr float EPS = 1e-6f;
constexpr int NWAVES = 8, NTHR = 512;

constexpr int C_CB = 0, C_CC = 512, C_CH = 1024, C_AQ = 1536, C_AK = 2304, C_AV = 3072, C_GQ = 3840, C_GK = 4096, C_GV = 4352, C_GR = 4864, C_LR = 5376, C_PIN = 5392, C_GATE = 5904;
constexpr int T_CONV = 0, T_CB = 4, T_Q = 6, T_K = 9, T_V = 12, T_GQ = 15, T_GK = 16, T_GV = 17, T_GR = 19, T_Z = 21, T_PIN = 22, T_GATE = 24;

constexpr int OFF_YP = 0;
constexpr int OFF_YS = OFF_YP + MP * DM;
constexpr int OFF_CONV_P = OFF_YS + MS * DM;
constexpr int OFF_CONV_S = OFF_CONV_P + DEPTH * NB_P * 2 * 512;
constexpr int OFF_W128_P = OFF_CONV_S + DEPTH * NB_S * 2 * 512;
constexpr int OFF_W128_S = OFF_W128_P + DEPTH * NB_P * 128 * 512;
constexpr int OFF_W512_P = OFF_W128_S + DEPTH * NB_S * 128 * 512;
constexpr int OFF_W512_S = OFF_W512_P + DEPTH * NB_P * 512 * 512;
constexpr int OFF_W2048_P = OFF_W512_S + DEPTH * NB_S * 512 * 512;
constexpr int OFF_W2048_S = OFF_W2048_P + DEPTH * NB_P * 2048 * 512;
constexpr int OFF_GLA_P = OFF_W2048_S + DEPTH * NB_S * 2048 * 512;
constexpr int OFF_GLA_S = OFF_GLA_P + DEPTH * NB_P * 4 * 64 * 128;
constexpr int OFF_POOL_P = OFF_GLA_S + DEPTH * NB_S * 4 * 64 * 128;
constexpr int OFF_POOL_S = OFF_POOL_P + DEPTH * NB_P * 15 * 512;
constexpr int OUT_TOTAL = OFF_POOL_S + DEPTH * NB_S * 15 * 512;
static_assert(OUT_TOTAL == 73551872, "output size");

constexpr size_t MiB = 1u << 20;
constexpr size_t WS_CTL = 0, CTL_ZERO_BYTES = 1 * MiB;
constexpr size_t SZ_ROW2K_F32 = (size_t)MPAD * DM * 4, SZ_ROW2K_BF = (size_t)MPAD * DM * 2;
constexpr size_t WS_X = WS_CTL + CTL_ZERO_BYTES;
constexpr size_t WS_XN = WS_X + SZ_ROW2K_F32;
constexpr size_t WS_H = WS_XN + SZ_ROW2K_BF;
constexpr size_t WS_CB = WS_H + (size_t)MPAD * DFF * 2;
constexpr size_t WS_U = WS_CB + (size_t)MPAD * 512 * 2;
constexpr size_t WS_Q = WS_U + (size_t)MPAD * 512 * 2;
constexpr size_t WS_K = WS_Q + (size_t)MPAD * 768 * 2;
constexpr size_t WS_V = WS_K + (size_t)MPAD * 768 * 2;
constexpr size_t WS_GQ = WS_V + (size_t)MPAD * 768 * 2;
constexpr size_t WS_GK = WS_GQ + (size_t)MPAD * 256 * 2;
constexpr size_t WS_GV = WS_GK + (size_t)MPAD * 256 * 2;
constexpr size_t WS_GR = WS_GV + (size_t)MPAD * 512 * 2;
constexpr size_t WS_LA = WS_GR + (size_t)MPAD * 512 * 2;
constexpr size_t WS_PIN = WS_LA + (size_t)MPAD * 256 * 4;
constexpr size_t WS_GATE = WS_PIN + (size_t)MPAD * 512 * 2;
constexpr int YK = 1792, YO_A = 0, YO_B = 512, YO_C = 768, YO_D = 1280;
constexpr size_t WS_YCAT = WS_GATE + (size_t)MPAD * 8192 * 2;
constexpr size_t WS_AO = WS_YCAT + (size_t)MPAD * YK * 2;
constexpr size_t WS_LSE = WS_AO + (size_t)MPAD * 768 * 4;
constexpr size_t WS_DS = WS_LSE + (size_t)MPAD * 12 * 4;
constexpr size_t WS_DEC = WS_DS + (size_t)8 * 64 * 64 * 128 * 4;
constexpr size_t WS_SP = WS_DEC + (size_t)8 * 64 * 64 * 4;
constexpr size_t WS_PM = WS_SP + (size_t)8 * 64 * 64 * 128 * 2;
constexpr size_t WS_MRG = WS_PM + (size_t)(MPAD - MP) * DM * 4;
constexpr size_t WS_W = WS_MRG + SZ_ROW2K_BF;
constexpr size_t WE_GU1 = 0;
constexpr size_t WE_D1 = WE_GU1 + (size_t)NGU * DM;
constexpr size_t WE_IN = WE_D1 + (size_t)DM * DFF;
constexpr size_t WE_UPCAT = WE_IN + (size_t)NWIN * DM;
constexpr size_t WE_OUT = WE_UPCAT + (size_t)DM * YK;
constexpr size_t WE_GU2 = WE_OUT + (size_t)DM * DM;
constexpr size_t WE_D2 = WE_GU2 + (size_t)NGU * DM;
constexpr size_t WE_LAYER = WE_D2 + (size_t)DM * DFF;
static_assert(WE_LAYER == 104857600, "layer weights");
constexpr size_t WS_END = WS_W + (size_t)DEPTH * WE_LAYER * 2;
static_assert(WS_X % 256 == 0 && WS_W % 256 == 0 && WS_LSE % 256 == 0 && WS_DS % 256 == 0, "alignment");

constexpr int CW_BAR = 4096;
constexpr size_t CTL_SS = 65536;
constexpr float SS_FIX = 16777216.0f;
static_assert(CTL_SS + 12 * (size_t)MPAD * 8 <= CTL_ZERO_BYTES, "SS fits the zeroed control region");

constexpr int RING_OFF = 0, RING_BYTES = 131072;
constexpr int LDSCTL_OFF = RING_BYTES, MISC_OFF = LDSCTL_OFF + 320;
constexpr int LDS_BYTES = 147456;

#define GAS __attribute__((address_space(1)))
#define LAS __attribute__((address_space(3)))
typedef unsigned short bf16;
typedef unsigned u32x4 __attribute__((ext_vector_type(4)));
typedef unsigned u32x2 __attribute__((ext_vector_type(2)));
typedef float f32x4 __attribute__((ext_vector_type(4)));
typedef float f32x2 __attribute__((ext_vector_type(2)));
typedef short bf16x8 __attribute__((ext_vector_type(8)));
typedef short s16x4 __attribute__((ext_vector_type(4)));
#define LDS_WAIT() asm volatile("s_waitcnt lgkmcnt(0)" ::: "memory")
#define VM_WAIT() asm volatile("s_waitcnt vmcnt(0)" ::: "memory")
__device__ __forceinline__ unsigned f2bf(float f) { unsigned u = __builtin_bit_cast(unsigned, f); return (u + 0x7fffu + ((u >> 16) & 1u)) >> 16; }
__device__ __forceinline__ unsigned pk2(float lo, float hi) { return f2bf(lo) | (f2bf(hi) << 16); }
__device__ __forceinline__ float bflo(unsigned w) { return __builtin_bit_cast(float, w << 16); }
__device__ __forceinline__ float bfhi(unsigned w) { return __builtin_bit_cast(float, w & 0xffff0000u); }
__device__ __forceinline__ float bf2f(bf16 b) { return __builtin_bit_cast(float, ((unsigned)b) << 16); }
__device__ __forceinline__ u32x4 pk8(f32x4 a, f32x4 b) { u32x4 w; w.x = pk2(a[0], a[1]); w.y = pk2(a[2], a[3]); w.z = pk2(b[0], b[1]); w.w = pk2(b[2], b[3]); return w; }
__device__ __forceinline__ void unpk8(u32x4 w, float (&f)[8]) { f[0] = bflo(w.x); f[1] = bfhi(w.x); f[2] = bflo(w.y); f[3] = bfhi(w.y); f[4] = bflo(w.z); f[5] = bfhi(w.z); f[6] = bflo(w.w); f[7] = bfhi(w.w); }
__device__ __forceinline__ float sigmoidf_(float x) { return __builtin_amdgcn_rcpf(1.0f + __expf(-x)); }
__device__ __forceinline__ float siluf_(float x) { return x * sigmoidf_(x); }
__device__ __forceinline__ float shx(float v, int m, int lane) { return __builtin_bit_cast(float, __builtin_amdgcn_ds_bpermute((lane ^ m) << 2, __builtin_bit_cast(int, v))); }
__device__ __forceinline__ float rdl(float v, int j) { return __builtin_bit_cast(float, __builtin_amdgcn_readlane(__builtin_bit_cast(int, v), j)); }
__device__ __forceinline__ float wave_sum(float v, int lane) {
#pragma unroll
    for (int o = 1; o < 64; o <<= 1) v += shx(v, o, lane);
    return v;
}
__device__ __forceinline__ float wave_max(float v, int lane) {
#pragma unroll
    for (int o = 1; o < 64; o <<= 1) v = fmaxf(v, shx(v, o, lane));
    return v;
}
__device__ __forceinline__ int win_of(int gi) { return 128 << (2 * gi); }
__device__ __forceinline__ int dil_of(int gi) { return 1 << (2 * gi); }
__device__ __forceinline__ int offw_p(int gi) { return gi == 0 ? OFF_W128_P : (gi == 1 ? OFF_W512_P : OFF_W2048_P); }
__device__ __forceinline__ int offw_s(int gi) { return gi == 0 ? OFF_W128_S : (gi == 1 ? OFF_W512_S : OFF_W2048_S); }

#define XB_TMO      128
#define XB_XCNT(j)  (256  + 64 * (j))
#define XB_XSUB(j)  (1280 + 64 * (j))
#define XB_XGEN(j)  (2304 + 64 * (j))
#define XB_TOP      3328
#define XB_TOPGEN   3392
#define XCD_BAR_WORDS 3456
#define XB_SPIN_CAP (1u << 18)

__device__ __forceinline__ unsigned xb_ld(unsigned* p)              { return __hip_atomic_load(p, __ATOMIC_RELAXED, __HIP_MEMORY_SCOPE_AGENT); }
__device__ __forceinline__ unsigned xb_add(unsigned* p, unsigned v) { return __hip_atomic_fetch_add(p, v, __ATOMIC_RELAXED, __HIP_MEMORY_SCOPE_AGENT); }
__device__ __forceinline__ unsigned xb_xcc_id() { return (unsigned)__builtin_amdgcn_s_getreg((3 << 11) | 20) & 0xFu; }
#define XB_SPIN(cond, bar) do { unsigned _sp = 0; while (cond) { __builtin_amdgcn_s_sleep(1); \
    if ((++_sp & 255u) == 0u) { if (xb_ld(&(bar)[XB_TMO])) break; if (_sp > XB_SPIN_CAP) { atomicAdd(&(bar)[XB_TMO], 1u); break; } } } } while (0)

struct XcdBarrier {
    unsigned* bar; unsigned x;
    volatile LAS unsigned* st;
};
__device__ __forceinline__ XcdBarrier xcd_barrier_post(unsigned* bar, volatile LAS unsigned* st) {
    XcdBarrier b; b.bar = bar; b.x = xb_xcc_id(); b.st = st;
    if (threadIdx.x == 0) (void)xb_add(&bar[XB_XCNT(b.x)], 1u);
    return b;
}
__device__ __forceinline__ void xcd_barrier_complete(unsigned* bar, unsigned x, unsigned& nloc, unsigned& nx) {
    const unsigned G = gridDim.x * gridDim.y * gridDim.z;
    unsigned sum, cnt, mine, sp = 0u;
    for (;;) {
        sum = 0u; cnt = 0u; mine = 0u;
#pragma unroll
        for (unsigned j = 0; j < 16; ++j) { const unsigned c = xb_ld(&bar[XB_XCNT(j)]); sum += c; cnt += (c > 0u) ? 1u : 0u; mine = (j == x) ? c : mine; }
        if (sum == G) break;
        __builtin_amdgcn_s_sleep(1);
        if ((++sp & 255u) == 0u) { if (xb_ld(&bar[XB_TMO])) break; if (sp > XB_SPIN_CAP) { atomicAdd(&bar[XB_TMO], 1u); break; } }
    }
    nloc = mine > 0u ? mine : 1u; nx = cnt > 0u ? cnt : 1u;
}
__device__ __forceinline__ void xcd_barrier(const XcdBarrier& b, const int tid) {
    asm volatile("s_waitcnt vmcnt(0)" ::: "memory");
    __syncthreads();
    if (tid == 0) {
        unsigned* bar = b.bar;
        __builtin_amdgcn_s_waitcnt(0);
        unsigned nloc = b.st[0], nx = b.st[1];
        if (nloc == 0u) { xcd_barrier_complete(bar, b.x, nloc, nx); b.st[0] = nloc; b.st[1] = nx; }
        const unsigned old = xb_add(&bar[XB_XSUB(b.x)], 1u);
        const unsigned gen = old / nloc;
        if (old + 1u == (gen + 1u) * nloc) {
            __builtin_amdgcn_fence(__ATOMIC_RELEASE, "agent");
            asm volatile("s_waitcnt vmcnt(0)" ::: "memory");
            const unsigned og = xb_add(&bar[XB_TOP], 1u);
            const unsigned tg = og / nx;
            if (og + 1u == (tg + 1u) * nx) xb_add(&bar[XB_TOPGEN], 1u);
            else XB_SPIN(xb_ld(&bar[XB_TOPGEN]) == tg, bar);
            __builtin_amdgcn_fence(__ATOMIC_ACQUIRE, "agent");
            xb_add(&bar[XB_XGEN(b.x)], 1u);
            asm volatile("s_waitcnt vmcnt(0)" ::: "memory");
        } else {
            XB_SPIN(xb_ld(&bar[XB_XGEN(b.x)]) == gen, bar);
            __builtin_amdgcn_fence(__ATOMIC_ACQUIRE, "agent");
            asm volatile("s_waitcnt vmcnt(0)" ::: "memory");
        }
    }
    __syncthreads();
}

constexpr int PT_OFF = LDSCTL_OFF;
constexpr int PT_OUT = 31, PT_WS = 32;
__device__ __forceinline__ const float* ldp(LAS unsigned char* lds, int i) {
    const unsigned long long v = *(volatile LAS unsigned long long*)(lds + PT_OFF + 8 * i);
    const unsigned lo = __builtin_amdgcn_readfirstlane((unsigned)v), hi = __builtin_amdgcn_readfirstlane((unsigned)(v >> 32));
    return (const float*)(((unsigned long long)hi << 32) | lo);
}

typedef f32x4 (&AccRef)[2][2][4][2];

__device__ __forceinline__ void row_decode(int row, int& kind, int& b, int& t) {
    if (row < MP) { kind = 0; b = row >> 12; t = row & 4095; }
    else if (row < MR) { kind = 1; b = (row - MP) >> 2; t = (row - MP) & 3; }
    else { kind = 2; b = 0; t = 0; }
}


typedef _Float16 h16x4 __attribute__((ext_vector_type(4)));
typedef _Float16 h16x8 __attribute__((ext_vector_type(8)));
constexpr size_t RAT_STRIDE = (size_t)MPAD * DM;

template <bool SK> __device__ __forceinline__ void scale_rows_rstd(AccRef acc, const unsigned long long* ss, int row0) {
#pragma unroll
    for (int ai = 0; ai < (SK ? 1 : 2); ++ai)
#pragma unroll
        for (int m = 0; m < (SK ? 2 : 4); ++m) {
            const float r = rsqrtf((float)ss[row0 + ai * 128 + m * 16] * (1.0f / (SS_FIX * DM)) + EPS);
#pragma unroll
            for (int bj = 0; bj < 2; ++bj)
#pragma unroll
                for (int n = 0; n < 2; ++n) acc[ai][bj][m][n] *= r;
        }
}

struct EpiSwiGLU {
    static constexpr bool PERM = false, AFTER_DRAIN = false, HAS_MID = false;
    unsigned char* ws; int nid;
    __device__ __forceinline__ void operator()(AccRef acc, const pg8::Unit& u, int wr, int wc, int fr, int fq) const { run<false>(acc, u, wr, wc, fr, fq); }
    template <bool SK> __device__ __forceinline__ void run(AccRef acc, const pg8::Unit& u, int wr, int wc, int fr_, int fq_) const {
        int fr = fr_, fq = fq_; asm volatile("" : "+v"(fr), "+v"(fq));
        bf16* H = (bf16*)(ws + WS_H);
        const int row0 = u.pm * 256 + wr * 64 + fr, col0 = u.pn * 128 + wc * 32 + 8 * fq;
        scale_rows_rstd<SK>(acc, (const unsigned long long*)(ws + WS_CTL + CTL_SS) + (size_t)nid * MPAD, row0);
#pragma unroll
        for (int ai = 0; ai < (SK ? 1 : 2); ++ai)
#pragma unroll
            for (int m = 0; m < (SK ? 2 : 4); ++m) {
                bf16* p = H + (size_t)(row0 + ai * 128 + m * 16) * DFF + col0;
                f32x4 h0, h1;
#pragma unroll
                for (int j = 0; j < 4; ++j) { h0[j] = siluf_(acc[ai][0][m][0][j]) * acc[ai][1][m][0][j]; h1[j] = siluf_(acc[ai][0][m][1][j]) * acc[ai][1][m][1][j]; }
                *(u32x4*)p = pk8(h0, h1);
            }
    }
};

struct EpiResid {
    static constexpr bool PERM = false, AFTER_DRAIN = false, HAS_MID = false;
    unsigned char* ws; LAS unsigned char* lds; float scale; int fin; int nid;
    __device__ __forceinline__ void operator()(AccRef acc, const pg8::Unit& u, int wr, int wc, int fr, int fq) const { run<false>(acc, u, wr, wc, fr, fq); }
    template <bool SK> __device__ __forceinline__ void run(AccRef acc, const pg8::Unit& u, int wr, int wc, int fr_, int fq_) const {
        int fr = fr_, fq = fq_; asm volatile("" : "+v"(fr), "+v"(fq));
        float* X = (float*)(ws + WS_X); bf16* XB = (bf16*)(ws + WS_XN);
        unsigned long long* ssp = (unsigned long long*)(ws + WS_CTL + CTL_SS) + (size_t)(nid < 0 ? 0 : nid) * MPAD;
        float* out = fin ? (float*)ldp(lds, PT_OUT) : nullptr;
        const float scale = (u.ri == 0) ? this->scale : 0.f; const int nid = (u.ri == 0) ? this->nid : -1;
        const int row0 = u.pm * 256 + wr * 64 + fr, col0 = u.pn * 256 + wc * 32 + 8 * fq;
#pragma unroll
        for (int ai = 0; ai < (SK ? 1 : 2); ++ai)
#pragma unroll
            for (int m = 0; m < (SK ? 2 : 4); ++m) {
                const int row = row0 + ai * 128 + m * 16;
                float* xr = X + (size_t)row * DM + col0;
                float sq = 0.f;
#pragma unroll
                for (int bj = 0; bj < 2; ++bj) {
                    const f32x4 v0 = *(f32x4*)(xr + bj * 128) + scale * acc[ai][bj][m][0], v1 = *(f32x4*)(xr + bj * 128 + 4) + scale * acc[ai][bj][m][1];
                    *(f32x4*)(xr + bj * 128) = v0; *(f32x4*)(xr + bj * 128 + 4) = v1;
                    if (out != nullptr && row < MR) { float* o = out + (size_t)row * DM + col0 + bj * 128; *(f32x4*)o = v0; *(f32x4*)(o + 4) = v1; }
                    *(u32x4*)(XB + (size_t)row * DM + col0 + bj * 128) = pk8(v0, v1);
                    sq += ((v0[0] * v0[0] + v0[1] * v0[1]) + (v0[2] * v0[2] + v0[3] * v0[3])) + ((v1[0] * v1[0] + v1[1] * v1[1]) + (v1[2] * v1[2] + v1[3] * v1[3]));
                }
                { const int ln = fq * 16 + fr; sq += shx(sq, 16, ln); sq += shx(sq, 32, ln); }
                if (nid >= 0 && fq == 0) atomicAdd(ssp + row, (unsigned long long)(sq * SS_FIX + 0.5f));
            }
    }
};

struct EpiMergeCat {
    static constexpr bool PERM = false, AFTER_DRAIN = false, HAS_MID = true;
    unsigned char* ws;
    __device__ __forceinline__ void apply(f32x4 (&acc)[2][2][4][2], const pg8::Unit& u, int s, int wr, int wc, int fr_, int fq_) const {
        int fr = fr_, fq = fq_; asm volatile("" : "+v"(fr), "+v"(fq));
        const _Float16* R = (const _Float16*)(ws + WS_GATE) + (size_t)s * RAT_STRIDE;
        const int row0 = u.pm * 256 + wr * 64 + fr, col0 = u.pn * 256 + wc * 32 + 8 * fq;
        h16x8 r[2][4][2];
#pragma unroll
        for (int ai = 0; ai < 2; ++ai)
#pragma unroll
            for (int m = 0; m < 4; ++m)
#pragma unroll
                for (int bj = 0; bj < 2; ++bj) r[ai][m][bj] = *(const h16x8*)(R + (size_t)(row0 + ai * 128 + m * 16) * DM + col0 + bj * 128);
#pragma unroll
        for (int ai = 0; ai < 2; ++ai)
#pragma unroll
            for (int m = 0; m < 4; ++m)
#pragma unroll
                for (int bj = 0; bj < 2; ++bj)
#pragma unroll
                    for (int j = 0; j < 4; ++j) { acc[ai][bj][m][0][j] *= (float)r[ai][m][bj][j]; acc[ai][bj][m][1][j] *= (float)r[ai][m][bj][4 + j]; }
    }
    __device__ __forceinline__ void mid(f32x4 (&acc)[2][2][4][2], const pg8::Unit& u, int t, int wr, int wc, int fr, int fq) const {
        apply(acc, u, (t == 8) ? 0 : (t == 12 ? 1 : 2), wr, wc, fr, fq);
    }
    __device__ __forceinline__ void operator()(AccRef acc, const pg8::Unit& u, int wr, int wc, int fr_, int fq_) const {
        apply(acc, u, 3, wr, wc, fr_, fq_);
        int fr = fr_, fq = fq_; asm volatile("" : "+v"(fr), "+v"(fq));
        bf16* MRG = (bf16*)(ws + WS_MRG);
        const int row0 = u.pm * 256 + wr * 64 + fr, col0 = u.pn * 256 + wc * 32 + 8 * fq;
#pragma unroll
        for (int ai = 0; ai < 2; ++ai)
#pragma unroll
            for (int m = 0; m < 4; ++m)
#pragma unroll
                for (int bj = 0; bj < 2; ++bj) *(u32x4*)(MRG + (size_t)(row0 + ai * 128 + m * 16) * DM + col0 + bj * 128) = pk8(acc[ai][bj][m][0], acc[ai][bj][m][1]);
    }
};
template <int MODE>
struct EpiMergeS {
    static constexpr bool PERM = false, AFTER_DRAIN = false, HAS_MID = false;
    unsigned char* ws; int br;
    template <bool SK> __device__ __forceinline__ void run(AccRef acc, const pg8::Unit& u, int wr, int wc, int fr, int fq) const {
        float* P = (float*)(ws + WS_PM); bf16* MRG = (bf16*)(ws + WS_MRG);
        const int row0 = u.pm * 256 + wr * 64 + fr, col0 = u.pn * 256 + wc * 32 + 8 * fq;
#pragma unroll
        for (int m = 0; m < 2; ++m) {
            const int row = row0 + m * 16;
#pragma unroll
            for (int bj = 0; bj < 2; ++bj) {
                const int c = col0 + bj * 128;
                float g[8];
                { const _Float16* R = (const _Float16*)(ws + WS_GATE) + (size_t)row * DM + c;
                  const h16x8 r3 = *(const h16x8*)(R + 3 * RAT_STRIDE);
#pragma unroll
                  for (int j = 0; j < 8; ++j) g[j] = (float)r3[j];
#pragma unroll
                  for (int s = 2; s >= 0; --s) if (s >= br) { const h16x8 rs = *(const h16x8*)(R + (size_t)s * RAT_STRIDE);
#pragma unroll
                      for (int j = 0; j < 8; ++j) g[j] *= (float)rs[j]; } }
                f32x4 v0, v1;
#pragma unroll
                for (int j = 0; j < 4; ++j) { v0[j] = g[j] * acc[0][bj][m][0][j]; v1[j] = g[4 + j] * acc[0][bj][m][1][j]; }
                float* pp = P + (size_t)(row - MP) * DM + c;
                if (MODE != 0) { v0 += *(const f32x4*)pp; v1 += *(const f32x4*)(pp + 4); }
                if (MODE == 2) *(u32x4*)(MRG + (size_t)row * DM + c) = pk8(v0, v1);
                else { *(f32x4*)pp = v0; *(f32x4*)(pp + 4) = v1; }
            }
        }
    }
};

struct EpiWin {
    static constexpr bool PERM = false, AFTER_DRAIN = false, HAS_MID = false;
    unsigned char* ws;
    const float *qgain, *kgain, *b_a;
    float* out; int layer; int nid;

    template <int ACT, bool SK>
    __device__ __forceinline__ void plain(AccRef acc, bf16* dst, int ldc, int cbase, int row0, int wc, int fq) const {
#pragma unroll
        for (int ai = 0; ai < (SK ? 1 : 2); ++ai)
#pragma unroll
            for (int m = 0; m < (SK ? 2 : 4); ++m) {
                bf16* p = dst + (size_t)(row0 + ai * 128 + m * 16) * ldc + cbase + wc * 32 + fq * 8;
#pragma unroll
                for (int bj = 0; bj < 2; ++bj) {
                    f32x4 v0 = acc[ai][bj][m][0], v1 = acc[ai][bj][m][1];
#pragma unroll
                    for (int j = 0; j < 4; ++j) {
                        if (ACT == 1) { v0[j] = sigmoidf_(v0[j]); v1[j] = sigmoidf_(v1[j]); }
                        if (ACT == 2) { v0[j] = siluf_(v0[j]); v1[j] = siluf_(v1[j]); }
                        if (ACT == 3) { v0[j] *= 0.125f; v1[j] *= 0.125f; }
                    }
                    *(u32x4*)(p + bj * 128) = pk8(v0, v1);
                }
            }
    }

    __device__ __forceinline__ void operator()(AccRef acc, const pg8::Unit& u, int wr, int wc, int fr, int fq) const { run<false>(acc, u, wr, wc, fr, fq); }
    template <bool SK> __device__ __forceinline__ void run(AccRef acc, const pg8::Unit& u, int wr, int wc, int fr_, int fq_) const {
        int fr = fr_, fq = fq_; asm volatile("" : "+v"(fr), "+v"(fq));
        const int pn = u.pn, row0 = u.pm * 256 + wr * 64 + fr, l = layer;
        scale_rows_rstd<SK>(acc, (const unsigned long long*)(ws + WS_CTL + CTL_SS) + (size_t)nid * MPAD, row0);
        if (pn < T_CB) {
            const int ch0 = 128 * pn + 32 * wc + 8 * fq;
#pragma unroll
            for (int ai = 0; ai < (SK ? 1 : 2); ++ai)
#pragma unroll
                for (int m = 0; m < (SK ? 2 : 4); ++m) {
                    const int row = row0 + ai * 128 + m * 16;
                    const f32x4 u0 = acc[ai][0][m][0] * acc[ai][1][m][0], u1 = acc[ai][0][m][1] * acc[ai][1][m][1];
                    *(u32x4*)((bf16*)(ws + WS_U) + (size_t)row * 512 + ch0) = pk8(u0, u1);
                    int kind, b, t; row_decode(row, kind, b, t);
                    if (kind == 0 && t >= SEQ - 2) { float* o = out + OFF_CONV_P + ((l * NB_P + b) * 2 + (t - (SEQ - 2))) * 512 + ch0; *(f32x4*)o = u0; *(f32x4*)(o + 4) = u1; }
                    if (kind == 1 && t >= TS - 2)  { float* o = out + OFF_CONV_S + ((l * NB_S + b) * 2 + (t - (TS - 2))) * 512 + ch0; *(f32x4*)o = u0; *(f32x4*)(o + 4) = u1; }
                }
        } else if (pn < T_Q) {
            plain<0, SK>(acc, (bf16*)(ws + WS_CB), 512, 256 * (pn - T_CB), row0, wc, fq);
        } else if (pn < T_V) {
            const bool isk = pn >= T_K; const int ti = isk ? pn - T_K : pn - T_Q; const int head = 4 * ti + wc;
            const float* gp = (isk ? kgain : qgain) + head * 64 + 8 * fq;
            f32x4 g[2][2];
#pragma unroll
            for (int bj = 0; bj < 2; ++bj) { g[bj][0] = *(const f32x4*)(gp + 32 * bj); g[bj][1] = *(const f32x4*)(gp + 32 * bj + 4); }
            bf16* dst = (bf16*)(ws + (isk ? WS_K : WS_Q));
            const int W = win_of(ti);
#pragma unroll
            for (int ai = 0; ai < (SK ? 1 : 2); ++ai)
#pragma unroll
                for (int m = 0; m < (SK ? 2 : 4); ++m) {
                    const int row = row0 + ai * 128 + m * 16;
                    float ss = 0.f;
#pragma unroll
                    for (int bj = 0; bj < 2; ++bj)
#pragma unroll
                        for (int n = 0; n < 2; ++n) { const f32x4 x = acc[ai][bj][m][n]; ss += (x[0] * x[0] + x[1] * x[1]) + (x[2] * x[2] + x[3] * x[3]); }
                    { const int ln = fq * 16 + fr; ss += shx(ss, 16, ln); ss += shx(ss, 32, ln); }
                    const float rs = rsqrtf(ss * (1.0f / 64.0f) + EPS);
                    int kind, b, t; row_decode(row, kind, b, t);
#pragma unroll
                    for (int bj = 0; bj < 2; ++bj) {
                        const f32x4 y0 = acc[ai][bj][m][0] * rs * g[bj][0], y1 = acc[ai][bj][m][1] * rs * g[bj][1];
                        *(u32x4*)(dst + (size_t)row * 768 + head * 64 + 32 * bj + 8 * fq) = pk8(y0, y1);
                        if (isk) {
                            const int e0 = 32 * bj + 8 * fq;
                            if (kind == 0 && t >= SEQ - W) { float* o = out + offw_p(ti) + ((((l * NB_P + b) * W + (t - (SEQ - W))) * 2 + 0) * 4 + wc) * 64 + e0; *(f32x4*)o = y0; *(f32x4*)(o + 4) = y1; }
                            if (kind == 1)                 { float* o = out + offw_s(ti) + ((((l * NB_S + b) * W + (W - TS + t)) * 2 + 0) * 4 + wc) * 64 + e0; *(f32x4*)o = y0; *(f32x4*)(o + 4) = y1; }
                        }
                    }
                }
        } else if (pn < T_GQ) {
            const int ti = pn - T_V;
            plain<0, SK>(acc, (bf16*)(ws + WS_V), 768, 256 * ti, row0, wc, fq);
            const int W = win_of(ti);
#pragma unroll
            for (int ai = 0; ai < (SK ? 1 : 2); ++ai)
#pragma unroll
                for (int m = 0; m < (SK ? 2 : 4); ++m) {
                    const int row = row0 + ai * 128 + m * 16;
                    int kind, b, t; row_decode(row, kind, b, t);
#pragma unroll
                    for (int bj = 0; bj < 2; ++bj) {
                        const int hh = 2 * bj + (wc >> 1), e0 = 32 * (wc & 1) + 8 * fq;
                        if (kind == 0 && t >= SEQ - W) { float* o = out + offw_p(ti) + ((((l * NB_P + b) * W + (t - (SEQ - W))) * 2 + 1) * 4 + hh) * 64 + e0; *(f32x4*)o = acc[ai][bj][m][0]; *(f32x4*)(o + 4) = acc[ai][bj][m][1]; }
                        if (kind == 1)                 { float* o = out + offw_s(ti) + ((((l * NB_S + b) * W + (W - TS + t)) * 2 + 1) * 4 + hh) * 64 + e0; *(f32x4*)o = acc[ai][bj][m][0]; *(f32x4*)(o + 4) = acc[ai][bj][m][1]; }
                    }
                }
        } else if (pn == T_GQ) {
            plain<3, SK>(acc, (bf16*)(ws + WS_GQ), 256, 0, row0, wc, fq);
        } else if (pn == T_GK) {
            plain<0, SK>(acc, (bf16*)(ws + WS_GK), 256, 0, row0, wc, fq);
        } else if (pn < T_GR) {
            plain<0, SK>(acc, (bf16*)(ws + WS_GV), 512, 256 * (pn - T_GV), row0, wc, fq);
        } else if (pn < T_Z) {
            plain<2, SK>(acc, (bf16*)(ws + WS_GR), 512, 256 * (pn - T_GR), row0, wc, fq);
        } else if (pn == T_Z) {
#pragma unroll
            for (int bj = 0; bj < 2; ++bj) {
                const int c0 = 128 * bj + 32 * wc + 8 * fq;
                const f32x4 b0 = *(const f32x4*)(b_a + c0), b1 = *(const f32x4*)(b_a + c0 + 4);
#pragma unroll
                for (int ai = 0; ai < (SK ? 1 : 2); ++ai)
#pragma unroll
                    for (int m = 0; m < (SK ? 2 : 4); ++m) {
                        const int row = row0 + ai * 128 + m * 16;
                        f32x4 z0 = acc[ai][bj][m][0] + b0, z1 = acc[ai][bj][m][1] + b1;
#pragma unroll
                        for (int j = 0; j < 4; ++j) {
                            z0[j] = (fminf(z0[j], 0.f) - __logf(1.0f + __expf(-fabsf(z0[j])))) * (1.0f / 16.0f);
                            z1[j] = (fminf(z1[j], 0.f) - __logf(1.0f + __expf(-fabsf(z1[j])))) * (1.0f / 16.0f);
                        }
                        float* o = (float*)(ws + WS_LA) + (size_t)row * 256 + c0; *(f32x4*)o = z0; *(f32x4*)(o + 4) = z1;
                    }
            }
        } else if (pn < T_GATE) {
            const int ti = pn - T_PIN;
            plain<0, SK>(acc, (bf16*)(ws + WS_PIN), 512, 256 * ti, row0, wc, fq);
#pragma unroll
            for (int ai = 0; ai < (SK ? 1 : 2); ++ai)
#pragma unroll
                for (int m = 0; m < (SK ? 2 : 4); ++m) {
                    const int row = row0 + ai * 128 + m * 16;
                    int kind, b, t; row_decode(row, kind, b, t);
#pragma unroll
                    for (int bj = 0; bj < 2; ++bj) {
                        const int c0 = 256 * ti + 128 * bj + 32 * wc + 8 * fq;
                        if (kind == 0 && t >= SEQ - 15) { float* o = out + OFF_POOL_P + ((l * NB_P + b) * 15 + (t - (SEQ - 15))) * 512 + c0; *(f32x4*)o = acc[ai][bj][m][0]; *(f32x4*)(o + 4) = acc[ai][bj][m][1]; }
                        if (kind == 1)                  { float* o = out + OFF_POOL_S + ((l * NB_S + b) * 15 + (15 - TS + t)) * 512 + c0; *(f32x4*)o = acc[ai][bj][m][0]; *(f32x4*)(o + 4) = acc[ai][bj][m][1]; }
                    }
                }
        } else {
            _Float16* R = (_Float16*)(ws + WS_GATE);
            const int c0 = 64 * (pn - T_GATE) + 16 * wc + 4 * fq;
#pragma unroll
            for (int ai = 0; ai < (SK ? 1 : 2); ++ai)
#pragma unroll
                for (int m = 0; m < (SK ? 2 : 4); ++m) {
                    const size_t o = (size_t)(row0 + ai * 128 + m * 16) * DM + c0;
                    h16x4 r0, r1, r2, r3;
#pragma unroll
                    for (int j = 0; j < 4; ++j) {
                        const float d0 = fminf(1.0f + __expf(-acc[ai][0][m][0][j]), 16384.f), d1 = fminf(1.0f + __expf(-acc[ai][0][m][1][j]), 16384.f);
                        const float d2 = fminf(1.0f + __expf(-acc[ai][1][m][0][j]), 16384.f), d3 = fminf(1.0f + __expf(-acc[ai][1][m][1][j]), 16384.f);
                        const float i0 = __builtin_amdgcn_rcpf(d0), i1 = __builtin_amdgcn_rcpf(d1), i2 = __builtin_amdgcn_rcpf(d2), i3 = __builtin_amdgcn_rcpf(d3);
                        r0[j] = (_Float16)fminf(d1 * i0, 65504.f); r1[j] = (_Float16)fminf(d2 * i1, 65504.f); r2[j] = (_Float16)fminf(d3 * i2, 65504.f); r3[j] = (_Float16)i3;
                    }
                    *(h16x4*)(R + o) = r0; *(h16x4*)(R + RAT_STRIDE + o) = r1; *(h16x4*)(R + 2 * RAT_STRIDE + o) = r2; *(h16x4*)(R + 3 * RAT_STRIDE + o) = r3;
                }
        }
    }
};

template <class Epi>
__device__ __forceinline__ void skinny_unit(LAS unsigned char* lds, const bf16* A, const bf16* Bt, int K, int su, const Epi E, int tid, int ld = 0) {
    if (ld == 0) ld = K;
    const int lane = tid & 63, w = __builtin_amdgcn_readfirstlane(tid >> 6), fr = lane & 15, g = lane >> 4;
    const int pn = su >> 2, wc = su & 3;
    const int nh = K >> 6, h0 = (w * nh) >> 3, h1 = ((w + 1) * nh) >> 3;
    f32x4 acc[2][2][2];
#pragma unroll
    for (int bj = 0; bj < 2; ++bj)
#pragma unroll
        for (int m = 0; m < 2; ++m)
#pragma unroll
            for (int n = 0; n < 2; ++n) acc[bj][m][n] = (f32x4){0.f, 0.f, 0.f, 0.f};
    const bf16* ap = A + (size_t)(MP + fr) * ld + 16 * g;
    const bf16* bp = Bt + (size_t)(256 * pn + 32 * wc + fr) * ld + 16 * g;
    for (int hc = h0; hc < h1; hc += 4) {
        bf16x8 a[4][2][2], b[4][2][2][2];
#pragma unroll
        for (int q = 0; q < 4; ++q) {
            const int hq = (hc + q < h1) ? hc + q : h1 - 1;
#pragma unroll
            for (int s = 0; s < 2; ++s) {
#pragma unroll
                for (int m = 0; m < 2; ++m) a[q][m][s] = *(const bf16x8*)(ap + (size_t)(16 * m) * ld + 64 * hq + 8 * s);
#pragma unroll
                for (int bj = 0; bj < 2; ++bj)
#pragma unroll
                    for (int n = 0; n < 2; ++n) b[q][bj][n][s] = *(const bf16x8*)(bp + (size_t)(128 * bj + 16 * n) * ld + 64 * hq + 8 * s);
            }
        }
#pragma unroll
        for (int q = 0; q < 4; ++q) {
            const bool ok = hc + q < h1;
#pragma unroll
            for (int s = 0; s < 2; ++s)
#pragma unroll
                for (int m = 0; m < 2; ++m) {
                    bf16x8 av = a[q][m][s];
                    if (!ok) av = (bf16x8){0, 0, 0, 0, 0, 0, 0, 0};
#pragma unroll
                    for (int bj = 0; bj < 2; ++bj)
#pragma unroll
                        for (int n = 0; n < 2; ++n) acc[bj][m][n] = __builtin_amdgcn_mfma_f32_16x16x32_bf16(b[q][bj][n][s], av, acc[bj][m][n], 0, 0, 0);
                }
        }
    }
    LAS f32x4* red = (LAS f32x4*)lds;
#pragma unroll
    for (int bj = 0; bj < 2; ++bj)
#pragma unroll
        for (int m = 0; m < 2; ++m)
#pragma unroll
            for (int n = 0; n < 2; ++n) red[(w * 8 + (bj * 4 + m * 2 + n)) * 64 + lane] = acc[bj][m][n];
    __syncthreads();
    if (w == 0) {
        f32x4 full[2][2][4][2];
#pragma unroll
        for (int bj = 0; bj < 2; ++bj)
#pragma unroll
            for (int m = 0; m < 2; ++m)
#pragma unroll
                for (int n = 0; n < 2; ++n) {
                    f32x4 s = red[(bj * 4 + m * 2 + n) * 64 + lane];
#pragma unroll
                    for (int ww = 1; ww < 8; ++ww) s += red[(ww * 8 + (bj * 4 + m * 2 + n)) * 64 + lane];
                    asm volatile("" : "+v"(s) :: "memory");
                    full[0][bj][m][n] = s;
                }
        pg8::Unit u; u.pm = MP / 256; u.pn = pn; u.ri = 0;
        E.template run<true>(full, u, 0, wc, fr, g);
    }
    __syncthreads();
}

__device__ __forceinline__ void skinny_merge_unit(LAS unsigned char* lds, unsigned char* ws, const bf16* Y, const bf16* U, int su, int tid) {
    const int lane = tid & 63, w = __builtin_amdgcn_readfirstlane(tid >> 6), fr = lane & 15, g = lane >> 4;
    const int pn = su >> 2, wc = su & 3;
    f32x4 acc[2][2][2];
#pragma unroll
    for (int bj = 0; bj < 2; ++bj)
#pragma unroll
        for (int m = 0; m < 2; ++m)
#pragma unroll
            for (int n = 0; n < 2; ++n) acc[bj][m][n] = (f32x4){0.f, 0.f, 0.f, 0.f};
    if (w < 7) {
        const bf16* ap = Y + (size_t)(MP + fr) * YK + 16 * g + 256 * w;
        const bf16* bp = U + (size_t)(256 * pn + 32 * wc + fr) * YK + 16 * g + 256 * w;
        bf16x8 a[4][2][2], b[4][2][2][2];
#pragma unroll
        for (int q = 0; q < 4; ++q)
#pragma unroll
            for (int s2 = 0; s2 < 2; ++s2) {
#pragma unroll
                for (int m = 0; m < 2; ++m) a[q][m][s2] = *(const bf16x8*)(ap + (size_t)(16 * m) * YK + 64 * q + 8 * s2);
#pragma unroll
                for (int bj = 0; bj < 2; ++bj)
#pragma unroll
                    for (int n = 0; n < 2; ++n) b[q][bj][n][s2] = *(const bf16x8*)(bp + (size_t)(128 * bj + 16 * n) * YK + 64 * q + 8 * s2);
            }
#pragma unroll
        for (int q = 0; q < 4; ++q)
#pragma unroll
            for (int s2 = 0; s2 < 2; ++s2)
#pragma unroll
                for (int m = 0; m < 2; ++m)
#pragma unroll
                    for (int bj = 0; bj < 2; ++bj)
#pragma unroll
                        for (int n = 0; n < 2; ++n) acc[bj][m][n] = __builtin_amdgcn_mfma_f32_16x16x32_bf16(b[q][bj][n][s2], a[q][m][s2], acc[bj][m][n], 0, 0, 0);
    }
    LAS f32x4* red = (LAS f32x4*)lds;
#pragma unroll
    for (int bj = 0; bj < 2; ++bj)
#pragma unroll
        for (int m = 0; m < 2; ++m)
#pragma unroll
            for (int n = 0; n < 2; ++n) red[(w * 8 + (bj * 4 + m * 2 + n)) * 64 + lane] = acc[bj][m][n];
    __syncthreads();
    if (w == 0) {
        bf16* MRG = (bf16*)(ws + WS_MRG);
        const int col0 = pn * 256 + wc * 32 + 8 * g;
#pragma unroll
        for (int m = 0; m < 2; ++m) {
            const int row = MP + 16 * m + fr;
#pragma unroll
            for (int bj = 0; bj < 2; ++bj) {
                const _Float16* R = (const _Float16*)(ws + WS_GATE) + (size_t)row * DM + col0 + bj * 128;
                const h16x8 r0 = *(const h16x8*)R, r1 = *(const h16x8*)(R + RAT_STRIDE), r2 = *(const h16x8*)(R + 2 * RAT_STRIDE), r3 = *(const h16x8*)(R + 3 * RAT_STRIDE);
                f32x4 o[2];
#pragma unroll
                for (int n = 0; n < 2; ++n) {
                    const int ti = bj * 4 + m * 2 + n;
                    const f32x4 pa = red[(0 * 8 + ti) * 64 + lane] + red[(1 * 8 + ti) * 64 + lane], pb = red[(2 * 8 + ti) * 64 + lane];
                    const f32x4 pc = red[(3 * 8 + ti) * 64 + lane] + red[(4 * 8 + ti) * 64 + lane], pd = red[(5 * 8 + ti) * 64 + lane] + red[(6 * 8 + ti) * 64 + lane];
#pragma unroll
                    for (int j = 0; j < 4; ++j) {
                        const float e3 = (float)r3[4 * n + j], e2 = (float)r2[4 * n + j] * e3, e1 = (float)r1[4 * n + j] * e2, e0 = (float)r0[4 * n + j] * e1;
                        o[n][j] = (e0 * pa[j] + e1 * pb[j]) + (e2 * pc[j] + e3 * pd[j]);
                    }
                }
                *(u32x4*)(MRG + (size_t)row * DM + col0 + bj * 128) = pk8(o[0], o[1]);
            }
        }
    }
    __syncthreads();
}

constexpr int IT_GU = 344 * 32, IT_D = 64 * 86, IT_IN = 448 * 32, IT_UPA = 64 * 8, IT_UPB = 64 * 4, IT_UPC = 64 * 8, IT_UPD = 64 * 8, IT_OUT = 64 * 32;
constexpr int IT_LAYER = 2 * IT_GU + 2 * IT_D + IT_IN + IT_UPA + IT_UPB + IT_UPC + IT_UPD + IT_OUT;
static_assert(IT_LAYER == 51200, "items per layer");

constexpr int PB_LAYER = 2 * 43 * 32 + 2 * 8 * 86 + 56 * 32 + 8 * 8 + 8 * 4 + 8 * 8 + 8 * 8 + 8 * 32;
static_assert(PB_LAYER == 6400, "blocks per layer");
constexpr int PB_P = 265;
constexpr int PB_PW_OFF = 69632;
struct BDesc { const float* src; const float* gain; bf16* dst; int ldw, K, kind, perm, aux0, aux1, aux2; };

__device__ __forceinline__ void pblk_decode(LAS unsigned char* lds, bf16* WB, int blk, int wave, int lane, BDesc& D) {
    const int l = blk / PB_LAYER; int r = blk % PB_LAYER;
    const int g = lane >> 3, c4 = lane & 7, bj = g >> 2, wc = g & 3;
    bf16* wl = WB + (size_t)l * WE_LAYER;
    const float* W; const float* gn = nullptr; int ldw, S0, k0, K, T, kind = 0, perm = 0, aux0 = 0; size_t woff;
    if (r < 2 * 1376) {
        const int f = r / 1376; r -= f * 1376; T = r % 43; const int kb = r / 43;
        const float* Wg = ldp(lds, f ? 28 : 9); const float* Wu = ldp(lds, f ? 29 : 10);
        W = (bj ? Wu : Wg) + (size_t)l * DM * DFF; ldw = DFF; S0 = 128 * T + 32 * wc; k0 = 64 * kb; K = DM; perm = 1; woff = f ? WE_GU2 : WE_GU1; gn = ldp(lds, f ? 27 : 8) + (size_t)l * DM;
    } else if ((r -= 2 * 1376) < 2 * 688) {
        const int f = r / 688; r -= f * 688; T = r % 8; const int kb = r / 8;
        W = ldp(lds, f ? 30 : 11) + (size_t)l * DFF * DM; ldw = DM; S0 = 256 * T + 32 * g; k0 = 64 * kb; K = DFF; perm = 1; woff = f ? WE_D2 : WE_D1;
    } else if ((r -= 2 * 688) < 1792) {
        T = r % 56; const int kb = r / 56, pn = T;
        W = ldp(lds, 13) + (size_t)l * DM * N_IN; ldw = N_IN; k0 = 64 * kb; K = DM; perm = 1; woff = WE_IN; gn = ldp(lds, 12) + (size_t)l * DM;
        if (pn == T_Z) { kind = 1; S0 = C_LR; }
        else if (pn < T_CB) S0 = (bj ? C_CH : C_CC) + 128 * pn + 32 * wc;
        else if (pn < T_Q) S0 = C_CB + 256 * (pn - T_CB) + 32 * g;
        else if (pn < T_K) S0 = C_AQ + 256 * (pn - T_Q) + 64 * wc + 32 * bj;
        else if (pn < T_V) S0 = C_AK + 256 * (pn - T_K) + 64 * wc + 32 * bj;
        else if (pn < T_GQ) S0 = C_AV + 256 * (pn - T_V) + 32 * g;
        else if (pn == T_GQ) S0 = C_GQ + 32 * g;
        else if (pn == T_GK) S0 = C_GK + 32 * g;
        else if (pn < T_GR) S0 = C_GV + 256 * (pn - T_GV) + 32 * g;
        else if (pn < T_Z) S0 = C_GR + 256 * (pn - T_GR) + 32 * g;
        else if (pn < T_GATE) S0 = C_PIN + 256 * (pn - T_PIN) + 32 * g;
        else { S0 = C_GATE + (2 * bj + (c4 >> 2)) * 2048 + 64 * (pn - T_GATE) + 16 * wc + 4 * (c4 & 3) - 4 * c4; perm = 0; }
    } else if ((r -= 1792) < 64) { T = r % 8; const int kb = r / 8; W = ldp(lds, 22) + (size_t)l * 512 * DM; ldw = DM; S0 = 256 * T + 32 * g; k0 = 64 * kb; K = YK; perm = 1; woff = WE_UPCAT + YO_A; }
    else if ((r -= 64) < 32) { T = r % 8; const int kb = r / 8; W = ldp(lds, 23) + (size_t)l * 256 * DM; ldw = DM; S0 = 256 * T + 32 * g; k0 = 64 * kb; K = YK; perm = 1; woff = WE_UPCAT + YO_B; }
    else if ((r -= 32) < 64) { T = r % 8; const int kb = r / 8; W = ldp(lds, 24) + (size_t)l * 512 * DM; ldw = DM; S0 = 256 * T + 32 * g; k0 = 64 * kb; K = YK; perm = 1; woff = WE_UPCAT + YO_C; }
    else if ((r -= 64) < 64) { T = r % 8; const int kb = r / 8; W = ldp(lds, 25) + (size_t)l * 512 * DM; ldw = DM; S0 = 256 * T; k0 = 64 * kb; K = YK; perm = 1; woff = WE_UPCAT + YO_D; kind = 2; aux0 = kb; }
    else { r -= 64; T = r % 8; const int kb = r / 8; W = ldp(lds, 26) + (size_t)l * DM * DM; ldw = DM; S0 = 256 * T + 32 * g; k0 = 64 * kb; K = DM; perm = 1; woff = WE_OUT; }
    if (kind == 0) D.src = W + (size_t)(k0 + 8 * wave) * ldw + S0 + 4 * c4;
    else D.src = W + (size_t)k0 * ldw + S0;
    D.gain = gn ? gn + k0 + 8 * wave : nullptr;
    D.dst = wl + woff + (size_t)(256 * T) * K + k0; D.ldw = ldw; D.K = K; D.kind = kind; D.perm = perm; D.aux0 = aux0; D.aux1 = l; D.aux2 = 0;
}
__device__ __forceinline__ void pblk_load(const BDesc& D, f32x4 (&v)[8]) {
    if (D.kind != 0) return;
#pragma unroll
    for (int i = 0; i < 8; ++i) v[i] = __builtin_nontemporal_load((const f32x4*)(D.src + (size_t)i * D.ldw));
}
__device__ __forceinline__ void pblk_writeout(LAS unsigned char* lds, bf16* dst, int K, int perm, int tid) {
    LAS float* tile = (LAS float*)(lds + RING_OFF);
    const int lane = tid & 63, wave = tid >> 6;
    LDS_WAIT(); __builtin_amdgcn_s_barrier(); asm volatile("" ::: "memory");
    const int c = lane & 7;
#pragma unroll
    for (int j = 0; j < 4; ++j) {
        const int rho = (lane >> 3) + 8 * j; const int cc = perm ? pg8::perm32(rho) : rho;
        const LAS float* s = tile + (8 * c) * PB_P + 33 * wave + cc;
        u32x4 o; o.x = pk2(s[0 * PB_P], s[1 * PB_P]); o.y = pk2(s[2 * PB_P], s[3 * PB_P]); o.z = pk2(s[4 * PB_P], s[5 * PB_P]); o.w = pk2(s[6 * PB_P], s[7 * PB_P]);
        *(u32x4*)(dst + (size_t)(32 * wave + rho) * K + 8 * c) = o;
    }
    LDS_WAIT(); __builtin_amdgcn_s_barrier(); asm volatile("" ::: "memory");
}
__device__ __forceinline__ void pblk_finish(LAS unsigned char* lds, const BDesc& D, const f32x4 (&v)[8], int tid) {
    if (D.kind != 0) return;
    LAS float* tile = (LAS float*)(lds + RING_OFF);
    const int lane = tid & 63, wave = tid >> 6;
    const int g = lane >> 3, c4 = lane & 7;
#pragma unroll
    for (int i = 0; i < 8; ++i) { const float gk = D.gain ? D.gain[i] : 1.0f; LAS float* s = tile + (8 * wave + i) * PB_P + 33 * g + 4 * c4; s[0] = v[i][0] * gk; s[1] = v[i][1] * gk; s[2] = v[i][2] * gk; s[3] = v[i][3] * gk; }
    pblk_writeout(lds, D.dst, D.K, D.perm, tid);
}
__device__ __forceinline__ void prologue_specials(LAS unsigned char* lds, bf16* WB, int bid, int G, int tid) {
    LAS float* tile = (LAS float*)(lds + RING_OFF);
#pragma unroll 1
    for (int s = bid; s < DEPTH * 96; s += G) {
        const int l = s / 96, r = s % 96;
        bf16* wl = WB + (size_t)l * WE_LAYER;
        if (r < 32) {
            const int kb = r;
            const float* A2 = ldp(lds, 17) + (size_t)l * 16 * 256; const float* gmix = ldp(lds, 12) + (size_t)l * DM;
            const float* Wk = ldp(lds, 13) + (size_t)l * DM * N_IN + (size_t)(64 * kb) * N_IN + C_LR;
            const int c = tid & 255, half = tid >> 8;
            float w2[16];
#pragma unroll
            for (int q = 0; q < 16; ++q) w2[q] = A2[q * 256 + c];
#pragma unroll 4
            for (int i = 0; i < 32; ++i) {
                const int kk = 32 * half + i;
                const f32x4* a = (const f32x4*)(Wk + (size_t)kk * N_IN);
                float sum = 0.f;
#pragma unroll
                for (int q = 0; q < 4; ++q) { const f32x4 av = a[q]; sum += av[0] * w2[4 * q] + av[1] * w2[4 * q + 1] + av[2] * w2[4 * q + 2] + av[3] * w2[4 * q + 3]; }
                tile[kk * PB_P + 33 * (c >> 5) + (c & 31)] = sum * gmix[64 * kb + kk];
            }
            pblk_writeout(lds, wl + WE_IN + (size_t)(256 * T_Z) * DM + 64 * kb, DM, 1, tid);
        } else {
            const int q = r - 32, T = q % 8, kb = q / 8, gg = kb >> 1, i0 = (kb & 1) * 64;
            LAS float* pw = (LAS float*)(lds + PB_PW_OFF);
            { const f32x4* src = (const f32x4*)(ldp(lds, 20) + ((size_t)l * 4 + gg) * 128 * 128 + (size_t)i0 * 128);
              for (int e = tid; e < 64 * 32; e += NTHR) ((LAS f32x4*)pw)[e] = src[e]; }
            LDS_WAIT(); __builtin_amdgcn_s_barrier(); asm volatile("" ::: "memory");
            const int n = tid & 255, half = tid >> 8;
            const float* SC = ldp(lds, 21) + (size_t)l * 512 + gg * 128;
            const float* UD = ldp(lds, 25) + (size_t)l * 512 * DM + (size_t)(gg * 128) * DM + 256 * T + n;
            float a[32];
#pragma unroll
            for (int j = 0; j < 32; ++j) a[j] = 0.f;
#pragma unroll 2
            for (int c = 0; c < 128; ++c) {
                const float uv = UD[(size_t)c * DM] * SC[c];
#pragma unroll
                for (int j = 0; j < 32; ++j) a[j] += pw[(32 * half + j) * 128 + c] * uv;
            }
#pragma unroll
            for (int j = 0; j < 32; ++j) tile[(32 * half + j) * PB_P + 33 * (n >> 5) + (n & 31)] = a[j];
            pblk_writeout(lds, wl + WE_UPCAT + YO_D + (size_t)(256 * T) * YK + 64 * kb, YK, 1, tid);
        }
    }
}
constexpr int DEFER_WG0 = 96, DEFER_WGS = 160, DEFER_PER_WG = 7, DEFER_N = DEFER_WGS * DEFER_PER_WG;
__device__ __forceinline__ bool pblk_deferred(int blk) {
    const int l = blk / PB_LAYER, r = blk % PB_LAYER;
    if (r < 1376) return l >= 1 && r < DEFER_N;
    if (r < 2 * 1376) return (r - 1376) < DEFER_N;
    return false;
}
__device__ __forceinline__ void prologue_blocks(LAS unsigned char* lds, bf16* WB, int first, int count, int start, int stride, int tid, bool skip_deferred) {
    const int lane = tid & 63, wave = __builtin_amdgcn_readfirstlane(tid >> 6);
    BDesc A, B, C; f32x4 va[8], vb[8], vc[8];
    int idx = start;
    if (idx >= count) return;
    pblk_decode(lds, WB, first + idx, wave, lane, A); if (skip_deferred && pblk_deferred(first + idx)) A.kind = 3; pblk_load(A, va);
    B = A;
#pragma unroll
    for (int i = 0; i < 8; ++i) vb[i] = va[i];
    if (idx + stride < count) { pblk_decode(lds, WB, first + idx + stride, wave, lane, B); if (skip_deferred && pblk_deferred(first + idx + stride)) B.kind = 3; pblk_load(B, vb); }
#pragma unroll 1
    for (;;) {
        const int nx2 = idx + 2 * stride;
        if (nx2 < count) { pblk_decode(lds, WB, first + nx2, wave, lane, C); if (skip_deferred && pblk_deferred(first + nx2)) C.kind = 3; pblk_load(C, vc); }
        pblk_finish(lds, A, va, tid);
        if (idx + stride >= count) break;
        idx += stride; A = B; B = C;
#pragma unroll
        for (int i = 0; i < 8; ++i) { va[i] = vb[i]; vb[i] = vc[i]; }
    }
}

__device__ __forceinline__ void x_init_pass(const float* xp, const float* xs, float* X, bf16* XB, unsigned long long* ss0, int gw, int NGW, int lane) {
    for (int row = gw; row < MPAD; row += NGW) {
        u32x2* o = (u32x2*)(XB + (size_t)row * DM) + lane; f32x4* xo = (f32x4*)(X + (size_t)row * DM) + lane;
        if (row >= MR) {
#pragma unroll
            for (int j = 0; j < 8; ++j) { u32x2 z; z.x = 0u; z.y = 0u; o[64 * j] = z; xo[64 * j] = (f32x4){0.f, 0.f, 0.f, 0.f}; }
            continue;
        }
        const f32x4* xr = (const f32x4*)(row < MP ? xp + (size_t)row * DM : xs + (size_t)(row - MP) * DM) + lane;
        float ss = 0.f;
#pragma unroll
        for (int j = 0; j < 8; ++j) { const f32x4 v = xr[64 * j]; ss += (v[0] * v[0] + v[1] * v[1]) + (v[2] * v[2] + v[3] * v[3]); xo[64 * j] = v; u32x2 w; w.x = pk2(v[0], v[1]); w.y = pk2(v[2], v[3]); o[64 * j] = w; }
        ss = wave_sum(ss, lane);
        if (lane == 0) ss0[row] = (unsigned long long)(ss * SS_FIX + 0.5f);
    }
}

constexpr int CC_N0 = DEPTH * NB_S * (128 - TS) * 128, CC_N1 = DEPTH * NB_S * (512 - TS) * 128, CC_N2 = DEPTH * NB_S * (2048 - TS) * 128, CACHE_COPY_N = CC_N0 + CC_N1 + CC_N2;
__device__ __forceinline__ void cache_copy_range(const float* c128, const float* c512, const float* c2048, float* out, int i0, int i1, int t, int nt) {
    for (int i = i0 + t; i < i1; i += nt) {
        int ii = i, gi = 0;
        if (ii >= CC_N0) { ii -= CC_N0; gi = 1; if (ii >= CC_N1) { ii -= CC_N1; gi = 2; } }
        const int W = win_of(gi), per = (W - TS) * 128, lb = ii / per, j = ii - lb * per;
        const f32x4* src = (const f32x4*)(gi == 0 ? c128 : (gi == 1 ? c512 : c2048)); f32x4* dst = (f32x4*)(out + offw_s(gi));
        __builtin_nontemporal_store(__builtin_nontemporal_load(src + (size_t)lb * W * 128 + TS * 128 + j), dst + (size_t)lb * W * 128 + j);
    }
}

__device__ __forceinline__ s16x4 ds_tr16(const LAS unsigned char* p) { return __builtin_amdgcn_ds_read_tr16_b64_v4i16((LAS s16x4*)p); }
__device__ __forceinline__ bf16x8 cat4(s16x4 a, s16x4 b) { bf16x8 r; r[0] = a[0]; r[1] = a[1]; r[2] = a[2]; r[3] = a[3]; r[4] = b[0]; r[5] = b[1]; r[6] = b[2]; r[7] = b[3]; return r; }
__device__ __forceinline__ bf16x8 pk8v(f32x4 a, f32x4 b) { const u32x4 w = pk8(a, b); return __builtin_bit_cast(bf16x8, w); }

constexpr int ATT_UNITS = NB_P * 12 * 32;
constexpr int ATT_PITCH = 144;
__device__ __forceinline__ void attn_unit(LAS unsigned char* lds, const bf16* Q, const bf16* K, const bf16* V, float* AO, float* LSE, int unit, int tid) {
    const int lane = tid & 63, w = tid >> 6, fr = lane & 15, g = lane >> 4;
    const int blk = unit & 31, bh = unit >> 5, h = bh % 12, b = bh / 12;
    const int gi = h >> 2, dl = dil_of(gi);
    const int r = blk % dl, nb = blk / dl;
    LAS unsigned char* Ks = lds; LAS unsigned char* Vs = lds + 256 * ATT_PITCH;
    for (int c = tid; c < 2048; c += NTHR) {
        const int ki = c >> 3, ch = c & 7, ksub = nb * 128 + ki - 128;
        u32x4 kv = {0u, 0u, 0u, 0u}, vv = {0u, 0u, 0u, 0u};
        if (ksub >= 0) { const size_t off = (size_t)(b * SEQ + r + dl * ksub) * 768 + h * 64 + ch * 8; kv = *(const u32x4*)(K + off); vv = *(const u32x4*)(V + off); }
        *(LAS u32x4*)(Ks + ki * ATT_PITCH + ch * 16) = kv; *(LAS u32x4*)(Vs + ki * ATT_PITCH + ch * 16) = vv;
    }
    __syncthreads();
    const int qi = 16 * w + fr;
    const int qtok = b * SEQ + r + dl * (nb * 128 + qi);
    const bf16x8 q0 = *(const bf16x8*)(Q + (size_t)qtok * 768 + h * 64 + 8 * g), q1 = *(const bf16x8*)(Q + (size_t)qtok * 768 + h * 64 + 32 + 8 * g);
    const int ks0 = w >> 1;
    f32x4 s[10];
#pragma unroll
    for (int tt = 0; tt < 10; ++tt) {
        const int T = 2 * ks0 + tt;
        const LAS unsigned char* kp = Ks + (16 * T + fr) * ATT_PITCH + 16 * g;
        const bf16x8 k0 = *(const LAS bf16x8*)kp, k1 = *(const LAS bf16x8*)(kp + 64);
        f32x4 a = {0.f, 0.f, 0.f, 0.f};
        a = __builtin_amdgcn_mfma_f32_16x16x32_bf16(k0, q0, a, 0, 0, 0);
        a = __builtin_amdgcn_mfma_f32_16x16x32_bf16(k1, q1, a, 0, 0, 0);
        s[tt] = a;
    }
    const float slope = exp2f(-8.0f * (float)(h + 1) / 12.0f) * (float)dl;
    float mx = -INFINITY;
#pragma unroll
    for (int tt = 0; tt < 10; ++tt)
#pragma unroll
        for (int j = 0; j < 4; ++j) {
            const int ki = 16 * (2 * ks0 + tt) + 4 * g + j, dist = qi - ki + 128, ksub = nb * 128 + ki - 128;
            const bool valid = (dist >= 0) && (dist <= 128) && (ksub >= 0);
            const float v = s[tt][j] * 0.125f - slope * (float)dist;
            s[tt][j] = valid ? v : -INFINITY;
            mx = fmaxf(mx, s[tt][j]);
        }
    mx = fmaxf(mx, shx(mx, 16, lane)); mx = fmaxf(mx, shx(mx, 32, lane));
    float ls = 0.f;
#pragma unroll
    for (int tt = 0; tt < 10; ++tt)
#pragma unroll
        for (int j = 0; j < 4; ++j) { const float p = __expf(s[tt][j] - mx); s[tt][j] = p; ls += p; }
    ls += shx(ls, 16, lane); ls += shx(ls, 32, lane);
    f32x4 o[4];
#pragma unroll
    for (int et = 0; et < 4; ++et) o[et] = (f32x4){0.f, 0.f, 0.f, 0.f};
    const int q4 = fr >> 2, p4 = fr & 3;
#pragma unroll
    for (int kk = 0; kk < 5; ++kk) {
        const bf16x8 pb = pk8v(s[2 * kk], s[2 * kk + 1]);
        const int rb = 32 * (ks0 + kk) + 4 * g + q4;
#pragma unroll
        for (int et = 0; et < 4; ++et) {
            const s16x4 v0 = ds_tr16(Vs + rb * ATT_PITCH + (16 * et + 4 * p4) * 2);
            const s16x4 v1 = ds_tr16(Vs + (rb + 16) * ATT_PITCH + (16 * et + 4 * p4) * 2);
            o[et] = __builtin_amdgcn_mfma_f32_16x16x32_bf16(cat4(v0, v1), pb, o[et], 0, 0, 0);
        }
    }
    const float inv = 1.0f / ls;
    float* ao = AO + (size_t)qtok * 768 + h * 64 + 4 * g;
#pragma unroll
    for (int et = 0; et < 4; ++et) *(f32x4*)(ao + 16 * et) = o[et] * inv;
    if (g == 0) LSE[(size_t)qtok * 12 + h] = mx + __logf(ls);
    __syncthreads();
}

__device__ __forceinline__ void attn_merge_pass(const float* AO, const float* LSE, bf16* YB, int gt, int NGT, int rep = 1) {
    for (int it0 = gt; it0 < rep * MR * 4 * 16; it0 += NGT) {
        const int it = it0 % (MR * 4 * 16);
        const int e4 = it & 15, slot = (it >> 4) & 3, tok = it >> 6;
        const float l0 = LSE[(size_t)tok * 12 + slot], l1 = LSE[(size_t)tok * 12 + 4 + slot], l2 = LSE[(size_t)tok * 12 + 8 + slot];
        const float m = fmaxf(l0, fmaxf(l1, l2));
        const float w0 = __expf(l0 - m), w1 = __expf(l1 - m), w2 = __expf(l2 - m), inv = 1.0f / (w0 + w1 + w2);
        const float* a = AO + (size_t)tok * 768 + slot * 64 + e4 * 4;
        const f32x4 y = (*(const f32x4*)a * w0 + *(const f32x4*)(a + 256) * w1 + *(const f32x4*)(a + 512) * w2) * inv;
        u32x2 wv; wv.x = pk2(y[0], y[1]); wv.y = pk2(y[2], y[3]);
        *(u32x2*)(YB + (size_t)tok * YK + YO_B + slot * 64 + e4 * 4) = wv;
    }
}

__device__ __forceinline__ float dot64_f32(const float (&q)[64], const float* k) {
    float s = 0.f;
#pragma unroll
    for (int c = 0; c < 16; ++c) { const f32x4 kv = ((const f32x4*)k)[c]; s += (q[4 * c] * kv[0] + q[4 * c + 1] * kv[1]) + (q[4 * c + 2] * kv[2] + q[4 * c + 3] * kv[3]); }
    return s;
}
__device__ __forceinline__ float dot64_bf(const float (&q)[64], const bf16* k) {
    float s = 0.f;
#pragma unroll
    for (int c = 0; c < 8; ++c) { const u32x4 w = ((const u32x4*)k)[c];
        s += (q[8 * c] * bflo(w.x) + q[8 * c + 1] * bfhi(w.x)) + (q[8 * c + 2] * bflo(w.y) + q[8 * c + 3] * bfhi(w.y)) + (q[8 * c + 4] * bflo(w.z) + q[8 * c + 5] * bfhi(w.z)) + (q[8 * c + 6] * bflo(w.w) + q[8 * c + 7] * bfhi(w.w)); }
    return s;
}
__device__ __forceinline__ void attn_sample_wave(const bf16* Q, const bf16* K, const bf16* V, const float* c128, const float* c512, const float* c2048, float* AO, float* LSE, int layer, int unit, int lane) {
    const int h = unit % 12, bt = unit / 12, t = bt & 3, b = bt >> 2;
    const int row = MP + b * TS + t;
    const int gi = h >> 2, slot = h & 3, dl = dil_of(gi), W = win_of(gi);
    const float* cache = (gi == 0 ? c128 : (gi == 1 ? c512 : c2048)) + (size_t)(layer * NB_S + b) * W * 512;
    float qf[64];
    { const u32x4* qp = (const u32x4*)(Q + (size_t)row * 768 + h * 64);
#pragma unroll
      for (int c = 0; c < 8; ++c) { const u32x4 w = qp[c]; qf[8 * c] = bflo(w.x) * 0.125f; qf[8 * c + 1] = bfhi(w.x) * 0.125f; qf[8 * c + 2] = bflo(w.y) * 0.125f; qf[8 * c + 3] = bfhi(w.y) * 0.125f;
          qf[8 * c + 4] = bflo(w.z) * 0.125f; qf[8 * c + 5] = bfhi(w.z) * 0.125f; qf[8 * c + 6] = bflo(w.w) * 0.125f; qf[8 * c + 7] = bfhi(w.w) * 0.125f; } }
    const float slope = exp2f(-8.0f * (float)(h + 1) / 12.0f) * (float)dl;
    float sc[3];
#pragma unroll
    for (int sj = 0; sj < 3; ++sj) {
        const int j = lane + 64 * sj;
        float d = -INFINITY;
        if (j <= 128) {
            const int idx = W + t - j * dl;
            if (idx >= W) d = dot64_bf(qf, K + (size_t)(MP + b * TS + (idx - W)) * 768 + h * 64);
            else d = dot64_f32(qf, cache + ((size_t)idx * 2 + 0) * 256 + slot * 64);
            d -= slope * (float)j;
        }
        sc[sj] = d;
    }
    const float mg = wave_max(fmaxf(sc[0], fmaxf(sc[1], sc[2])), lane);
    const float p0 = __expf(sc[0] - mg), p1 = __expf(sc[1] - mg), p2 = __expf(sc[2] - mg);
    const float lg = wave_sum(p0 + p1 + p2, lane);
    float acc = 0.f;
    const int jstart = (dl == 1) ? t + 1 : 1;
#pragma unroll 1
    for (int j = 0; j < jstart; ++j) acc += rdl(p0, j) * bf2f(V[(size_t)(MP + b * TS + (t - j * dl)) * 768 + h * 64 + lane]);
    const float* vbase = cache + 256 + slot * 64 + lane;
#pragma unroll 1
    for (int j0 = jstart; j0 <= 128; j0 += 32) {
        float vv[32];
#pragma unroll
        for (int i = 0; i < 32; ++i) { const int j = (j0 + i <= 128) ? j0 + i : 128; vv[i] = vbase[(size_t)(W + t - j * dl) * 512]; }
#pragma unroll
        for (int i = 0; i < 32; ++i) { const int j = j0 + i; const float pj = (j <= 128) ? rdl(j < 64 ? p0 : (j < 128 ? p1 : p2), j & 63) : 0.f; acc += pj * vv[i]; }
    }
    AO[(size_t)row * 768 + h * 64 + lane] = acc / lg;
    if (lane == 0) LSE[(size_t)row * 12 + h] = mg + __logf(lg);
}

__device__ __forceinline__ void conv_pool_pass(const bf16* CB, const bf16* U, const bf16* PIN, const float* conv_w, const float* st_conv, const float* st_pool, bf16* YA, bf16* YD, int layer, int gt, int NGT, int rep = 1) {
    for (int it0 = gt; it0 < rep * MPAD * 64; it0 += NGT) {
        const int it = it0 % (MPAD * 64); const int c8 = it & 63, row = it >> 6, ch = c8 * 8;
        int kind, b, t; row_decode(row, kind, b, t);
        if (kind == 2) { const u32x4 z = {0u, 0u, 0u, 0u}; *(u32x4*)(YA + (size_t)row * YK + YO_A + ch) = z; *(u32x4*)(YD + (size_t)row * YK + YO_D + ch) = z; continue; }
        float u0[8], u1[8], u2[8], cb[8];
        unpk8(*(const u32x4*)(U + (size_t)row * 512 + ch), u2);
        if (t >= 1) unpk8(*(const u32x4*)(U + (size_t)(row - 1) * 512 + ch), u1);
        else if (kind == 1) { const float* s = st_conv + ((size_t)(layer * NB_S + b) * 2 + 1) * 512 + ch; _Pragma("unroll") for (int j = 0; j < 8; ++j) u1[j] = s[j]; }
        else { _Pragma("unroll") for (int j = 0; j < 8; ++j) u1[j] = 0.f; }
        if (t >= 2) unpk8(*(const u32x4*)(U + (size_t)(row - 2) * 512 + ch), u0);
        else if (kind == 1) { const float* s = st_conv + ((size_t)(layer * NB_S + b) * 2 + t) * 512 + ch; _Pragma("unroll") for (int j = 0; j < 8; ++j) u0[j] = s[j]; }
        else { _Pragma("unroll") for (int j = 0; j < 8; ++j) u0[j] = 0.f; }
        unpk8(*(const u32x4*)(CB + (size_t)row * 512 + ch), cb);
        const float* cw = conv_w + (size_t)layer * 3 * 512 + ch;
        f32x4 ya0, ya1;
#pragma unroll
        for (int j = 0; j < 8; ++j) { const float z = cw[j] * u0[j] + cw[512 + j] * u1[j] + cw[1024 + j] * u2[j]; const float y = cb[j] * z; if (j < 4) ya0[j] = y; else ya1[j - 4] = y; }
        *(u32x4*)(YA + (size_t)row * YK + YO_A + ch) = pk8(ya0, ya1);
        const int grp = c8 >> 4, w = 2 << grp;
        float cur[8], sum[8];
        unpk8(*(const u32x4*)(PIN + (size_t)row * 512 + ch), cur);
#pragma unroll
        for (int j = 0; j < 8; ++j) sum[j] = cur[j];
        if (kind == 0) {
            u32x4 xr[15];
#pragma unroll
            for (int i = 1; i < 16; ++i) { const bool ok = (i < w) && (t - i >= 0); xr[i - 1] = *(const u32x4*)(PIN + (size_t)(ok ? row - i : row) * 512 + ch); }
#pragma unroll
            for (int i = 1; i < 16; ++i) { const bool ok = (i < w) && (t - i >= 0); float x[8]; unpk8(xr[i - 1], x); const float m = ok ? 1.f : 0.f;
#pragma unroll
                for (int j = 0; j < 8; ++j) sum[j] += m * x[j]; }
        } else {
            for (int i = 1; i < w; ++i) {
                const int tt = t - i;
                if (tt >= 0) { float x[8]; unpk8(*(const u32x4*)(PIN + (size_t)(row - i) * 512 + ch), x); _Pragma("unroll") for (int j = 0; j < 8; ++j) sum[j] += x[j]; }
                else { const float* s = st_pool + ((size_t)(layer * NB_S + b) * 15 + (15 + tt)) * 512 + ch; _Pragma("unroll") for (int j = 0; j < 8; ++j) sum[j] += s[j]; }
            }
        }
        const float cnt = (kind == 1) ? (float)w : fminf((float)w, (float)(t + 1));
        const float ic = 1.0f / cnt;
        f32x4 d0, d1;
#pragma unroll
        for (int j = 0; j < 8; ++j) { const float d = sum[j] * ic - cur[j]; if (j < 4) d0[j] = d; else d1[j - 4] = d; }
        *(u32x4*)(YD + (size_t)row * YK + YO_D + ch) = pk8(d0, d1);
    }
}

constexpr int GLA_UNITS = NB_P * 4 * 64;
constexpr int GP_K = 144, GP_V = 272;
constexpr int GLA_R0 = 0, GLA_R0_BYTES = 17408, GLA_QT = GLA_R0 + GLA_R0_BYTES, GLA_KT = GLA_QT + 64 * GP_K, GLA_VV = GLA_KT + 64 * GP_K, GLA_HALF = GLA_VV + 64 * GP_V;
static_assert(2 * GLA_HALF <= RING_BYTES, "GLA LDS");

__device__ __forceinline__ void gla_cumsum(LAS float* lb, const float* LA, int tok0, int h, int ht) {
    const int k = ht & 63, q = ht >> 6;
    float v[16]; float run = 0.f;
#pragma unroll
    for (int i = 0; i < 16; ++i) { run += LA[(size_t)(tok0 + 16 * q + i) * 256 + h * 64 + k]; v[i] = run; }
    LAS float* tot = lb + 4096;
    tot[q * 64 + k] = run;
    __syncthreads();
    float off = 0.f;
#pragma unroll
    for (int qq = 0; qq < 3; ++qq) off += (qq < q) ? tot[qq * 64 + k] : 0.f;
#pragma unroll
    for (int i = 0; i < 16; ++i) lb[(16 * q + i) * 64 + k] = v[i] + off;
    __syncthreads();
}

__device__ __forceinline__ void gla_ds_unit(LAS unsigned char* hl, const bf16* GK, const bf16* GV, const float* LA, float* DS, float* DEC, int unit, int ht) {
    const int n = unit & 63, bh = unit >> 6, h = bh & 3, b = bh >> 2;
    const int tok0 = b * SEQ + n * 64;
    const int lane = ht & 63, hw = ht >> 6, fr = lane & 15, g = lane >> 4;
    LAS float* lb = (LAS float*)(hl + GLA_R0);
    gla_cumsum(lb, LA, tok0, h, ht);
    for (int c = ht; c < 512; c += 256) {
        const int s = c >> 3, k0 = (c & 7) * 8;
        float kf[8]; unpk8(*(const u32x4*)(GK + (size_t)(tok0 + s) * 256 + h * 64 + k0), kf);
        f32x4 a0, a1;
#pragma unroll
        for (int j = 0; j < 8; ++j) { const float e = kf[j] * __expf(lb[63 * 64 + k0 + j] - lb[s * 64 + k0 + j]); if (j < 4) a0[j] = e; else a1[j - 4] = e; }
        *(LAS u32x4*)(hl + GLA_KT + s * GP_K + k0 * 2) = pk8(a0, a1);
    }
    for (int c = ht; c < 1024; c += 256) {
        const int s = c >> 4, v0 = (c & 15) * 8;
        *(LAS u32x4*)(hl + GLA_VV + s * GP_V + v0 * 2) = *(const u32x4*)(GV + (size_t)(tok0 + s) * 512 + h * 128 + v0);
    }
    if (ht < 64) DEC[(size_t)unit * 64 + ht] = __expf(lb[63 * 64 + ht]);
    __syncthreads();
    const int q4 = fr >> 2, p4 = fr & 3, kt = hw;
    float* dsb = DS + (size_t)unit * 64 * 128;
#pragma unroll
    for (int dvt = 0; dvt < 8; ++dvt) {
        f32x4 acc = {0.f, 0.f, 0.f, 0.f};
#pragma unroll
        for (int ks = 0; ks < 2; ++ks) {
            const int rb = 32 * ks + 4 * g + q4;
            const bf16x8 af = cat4(ds_tr16(hl + GLA_KT + rb * GP_K + (16 * kt + 4 * p4) * 2), ds_tr16(hl + GLA_KT + (rb + 16) * GP_K + (16 * kt + 4 * p4) * 2));
            const bf16x8 bf = cat4(ds_tr16(hl + GLA_VV + rb * GP_V + (16 * dvt + 4 * p4) * 2), ds_tr16(hl + GLA_VV + (rb + 16) * GP_V + (16 * dvt + 4 * p4) * 2));
            acc = __builtin_amdgcn_mfma_f32_16x16x32_bf16(af, bf, acc, 0, 0, 0);
        }
#pragma unroll
        for (int j = 0; j < 4; ++j) dsb[(size_t)(16 * kt + 4 * g + j) * 128 + 16 * dvt + fr] = acc[j];
    }
    __syncthreads();
}

__device__ __forceinline__ void gla_scan_pass(const float* DS, const float* DEC, bf16* SP, float* out, int layer, int gt, int rep = 1) {
    if (gt >= 8 * 64 * 128) return;
    for (int rr = 0; rr < rep; ++rr) {
    const int v = gt & 127, k = (gt >> 7) & 63, bh = gt >> 13;
    float S = 0.f;
    for (int n0 = 0; n0 < 64; n0 += 32) {
        float d[32], a[32];
#pragma unroll
        for (int i = 0; i < 32; ++i) { d[i] = DS[(((size_t)bh * 64 + n0 + i) * 64 + k) * 128 + v]; a[i] = DEC[((size_t)bh * 64 + n0 + i) * 64 + k]; }
#pragma unroll
        for (int i = 0; i < 32; ++i) { SP[(((size_t)bh * 64 + n0 + i) * 64 + k) * 128 + v] = (bf16)f2bf(S); S = a[i] * S + d[i]; }
    }
    out[OFF_GLA_P + (((size_t)layer * 8 + bh) * 64 + k) * 128 + v] = S;
    }
}

__device__ __forceinline__ void gla_out_unit(LAS unsigned char* hl, const bf16* GQ, const bf16* GK, const bf16* GV, const bf16* GR, const float* LA, const bf16* SP, const float* gnorm, bf16* YC, int unit, int ht) {
    const int n = unit & 63, bh = unit >> 6, h = bh & 3, b = bh >> 2;
    const int tok0 = b * SEQ + n * 64;
    const int lane = ht & 63, hw = ht >> 6, fr = lane & 15, g = lane >> 4;
    LAS float* lb = (LAS float*)(hl + GLA_R0);
    gla_cumsum(lb, LA, tok0, h, ht);
    for (int c = ht; c < 512; c += 256) {
        const int s = c >> 3, k0 = (c & 7) * 8;
        float qf[8], kf[8];
        unpk8(*(const u32x4*)(GQ + (size_t)(tok0 + s) * 256 + h * 64 + k0), qf);
        unpk8(*(const u32x4*)(GK + (size_t)(tok0 + s) * 256 + h * 64 + k0), kf);
        f32x4 a0, a1, c0, c1;
#pragma unroll
        for (int j = 0; j < 8; ++j) { const float bb = lb[s * 64 + k0 + j]; const float qe = qf[j] * __expf(bb), ke = kf[j] * __expf(-bb); if (j < 4) { a0[j] = qe; c0[j] = ke; } else { a1[j - 4] = qe; c1[j - 4] = ke; } }
        *(LAS u32x4*)(hl + GLA_QT + s * GP_K + k0 * 2) = pk8(a0, a1);
        *(LAS u32x4*)(hl + GLA_KT + s * GP_K + k0 * 2) = pk8(c0, c1);
    }
    for (int c = ht; c < 1024; c += 256) {
        const int s = c >> 4, v0 = (c & 15) * 8;
        *(LAS u32x4*)(hl + GLA_VV + s * GP_V + v0 * 2) = *(const u32x4*)(GV + (size_t)(tok0 + s) * 512 + h * 128 + v0);
    }
    __syncthreads();
    for (int c = ht; c < 1024; c += 256) {
        const int k = c >> 4, v0 = (c & 15) * 8;
        *(LAS u32x4*)(hl + GLA_R0 + k * GP_V + v0 * 2) = *(const u32x4*)(SP + ((size_t)unit * 64 + k) * 128 + v0);
    }
    __syncthreads();
    const int tt = hw, q4 = fr >> 2, p4 = fr & 3;
    f32x4 at[4];
    const LAS unsigned char* qrow = hl + GLA_QT + (16 * tt + fr) * GP_K;
    const bf16x8 qb0 = *(const LAS bf16x8*)(qrow + 16 * g), qb1 = *(const LAS bf16x8*)(qrow + 64 + 16 * g);
#pragma unroll
    for (int st = 0; st < 4; ++st) {
        const LAS unsigned char* krow = hl + GLA_KT + (16 * st + fr) * GP_K;
        f32x4 a = {0.f, 0.f, 0.f, 0.f};
        a = __builtin_amdgcn_mfma_f32_16x16x32_bf16(*(const LAS bf16x8*)(krow + 16 * g), qb0, a, 0, 0, 0);
        a = __builtin_amdgcn_mfma_f32_16x16x32_bf16(*(const LAS bf16x8*)(krow + 64 + 16 * g), qb1, a, 0, 0, 0);
#pragma unroll
        for (int j = 0; j < 4; ++j) { const int s = 16 * st + 4 * g + j, t = 16 * tt + fr; a[j] = (s <= t) ? a[j] : 0.f; }
        at[st] = a;
    }
    f32x4 o[8];
#pragma unroll
    for (int dvt = 0; dvt < 8; ++dvt) o[dvt] = (f32x4){0.f, 0.f, 0.f, 0.f};
#pragma unroll
    for (int ks = 0; ks < 2; ++ks) {
        const bf16x8 pb = pk8v(at[2 * ks], at[2 * ks + 1]);
        const int rb = 32 * ks + 4 * g + q4;
        const s16x4 qa = *(const LAS s16x4*)(qrow + (32 * ks + 4 * g) * 2), qc = *(const LAS s16x4*)(qrow + (32 * ks + 16 + 4 * g) * 2);
        const bf16x8 qp = cat4(qa, qc);
#pragma unroll
        for (int dvt = 0; dvt < 8; ++dvt) {
            const bf16x8 vf = cat4(ds_tr16(hl + GLA_VV + rb * GP_V + (16 * dvt + 4 * p4) * 2), ds_tr16(hl + GLA_VV + (rb + 16) * GP_V + (16 * dvt + 4 * p4) * 2));
            o[dvt] = __builtin_amdgcn_mfma_f32_16x16x32_bf16(vf, pb, o[dvt], 0, 0, 0);
            const bf16x8 sf = cat4(ds_tr16(hl + GLA_R0 + rb * GP_V + (16 * dvt + 4 * p4) * 2), ds_tr16(hl + GLA_R0 + (rb + 16) * GP_V + (16 * dvt + 4 * p4) * 2));
            o[dvt] = __builtin_amdgcn_mfma_f32_16x16x32_bf16(sf, qp, o[dvt], 0, 0, 0);
        }
    }
    float ss = 0.f;
#pragma unroll
    for (int dvt = 0; dvt < 8; ++dvt) ss += (o[dvt][0] * o[dvt][0] + o[dvt][1] * o[dvt][1]) + (o[dvt][2] * o[dvt][2] + o[dvt][3] * o[dvt][3]);
    ss += shx(ss, 16, lane); ss += shx(ss, 32, lane);
    const float rs = rsqrtf(ss * (1.0f / 128.0f) + EPS);
    const size_t orow = (size_t)(tok0 + 16 * tt + fr) * 512 + h * 128, yrow = (size_t)(tok0 + 16 * tt + fr) * YK + YO_C + h * 128;
#pragma unroll
    for (int dvt = 0; dvt < 8; ++dvt) {
        const int dv = 16 * dvt + 4 * g;
        const f32x4 gn = *(const f32x4*)(gnorm + dv);
        const u32x2 gw = *(const u32x2*)(GR + orow + dv);
        f32x4 y; y[0] = o[dvt][0] * rs * gn[0] * bflo(gw.x); y[1] = o[dvt][1] * rs * gn[1] * bfhi(gw.x); y[2] = o[dvt][2] * rs * gn[2] * bflo(gw.y); y[3] = o[dvt][3] * rs * gn[3] * bfhi(gw.y);
        u32x2 wv; wv.x = pk2(y[0], y[1]); wv.y = pk2(y[2], y[3]);
        *(u32x2*)(YC + yrow + dv) = wv;
    }
    __syncthreads();
}

__device__ __forceinline__ void gla_sample_unit(LAS float* red, const bf16* GQ, const bf16* GK, const bf16* GV, const bf16* GR, const float* LA, const float* st_gla, const float* gnorm, bf16* YC, float* out, int layer, int unit, int tid) {
    const int h = unit & 3, b = unit >> 2;
    const int dv = tid & 127, kq = tid >> 7;
    const float* s0 = st_gla + (((size_t)(layer * NB_S + b) * 4 + h) * 64 + 16 * kq) * 128 + dv;
    float S[16];
#pragma unroll
    for (int i = 0; i < 16; ++i) S[i] = s0[(size_t)i * 128];
#pragma unroll 1
    for (int t = 0; t < TS; ++t) {
        const int row = MP + b * TS + t;
        const float vv = bf2f(GV[(size_t)row * 512 + h * 128 + dv]);
        float po = 0.f;
#pragma unroll
        for (int i = 0; i < 16; ++i) {
            const int k = 16 * kq + i;
            const float a = __expf(LA[(size_t)row * 256 + h * 64 + k]);
            S[i] = a * S[i] + bf2f(GK[(size_t)row * 256 + h * 64 + k]) * vv;
            po += bf2f(GQ[(size_t)row * 256 + h * 64 + k]) * S[i];
        }
        red[kq * 128 + dv] = po;
        __syncthreads();
        float o = 0.f, sq = 0.f;
        if (kq == 0) { o = (red[dv] + red[128 + dv]) + (red[256 + dv] + red[384 + dv]); sq = o * o; }
        sq = wave_sum(sq, tid & 63);
        if (kq == 0 && (tid & 63) == 0) red[512 + (tid >> 6)] = sq;
        __syncthreads();
        if (kq == 0) {
            const float rs = rsqrtf((red[512] + red[513]) * (1.0f / 128.0f) + EPS);
            const float y = o * rs * gnorm[dv] * bf2f(GR[(size_t)row * 512 + h * 128 + dv]);
            YC[(size_t)row * YK + YO_C + h * 128 + dv] = (bf16)f2bf(y);
        }
        __syncthreads();
    }
    float* so = out + OFF_GLA_S + (((size_t)(layer * NB_S + b) * 4 + h) * 64 + 16 * kq) * 128 + dv;
#pragma unroll
    for (int i = 0; i < 16; ++i) so[(size_t)i * 128] = S[i];
}

constexpr int PH_PER_LAYER = 13, NPH = 1 + DEPTH * PH_PER_LAYER;
#define RM(bit) (1 + ((PROBE_DUP >> (bit)) & 1))
#define REP(bit) for (int rep_ = 0; rep_ < 1 + ((PROBE_DUP >> (bit)) & 1); ++rep_)
#ifndef PROBE_ALIGN_GU
#define PROBE_ALIGN_GU true
#endif
#ifndef PROBE_ALIGN_RES
#define PROBE_ALIGN_RES true
#endif
#ifndef PROBE_ALIGN_WIN
#define PROBE_ALIGN_WIN true
#endif
#ifndef MK_UNROLL_LAYERS
#define MK_UNROLL_LAYERS 1
#endif
#ifndef MK_PER_PHASE
#define MK_PER_PHASE 0
#endif

struct Args { const float* in[31]; float* out; unsigned char* ws; int ph_lo, ph_hi; };
static_assert(sizeof(Args) == 31 * 8 + 8 + 8 + 8, "Args has no padding");

__device__ __forceinline__ unsigned char* launder(unsigned char* p) { asm volatile("" : "+s"(p)); return p; }
__device__ __forceinline__ int opq_v(int x) { asm volatile("" : "+v"(x)); return x; }
__device__ __forceinline__ int opq_s(int x) { asm volatile("" : "+s"(x)); return x; }

#define IN(k) (lo <= (k) && (k) < hi)
#define SEAM(k) do { if (IN((k) + 1)) { XcdBarrier bar_; bar_.bar = (unsigned*)(WSP() + WS_CTL) + CW_BAR; bar_.x = xb_xcc_id(); bar_.st = (volatile LAS unsigned*)(lds + MISC_OFF) + 8; REP(13) xcd_barrier(bar_, tid); } } while (0)
#define GW (bid * NWAVES + wave)
#define NGW (G * NWAVES)
#define GT (bid * NTHR + tid)
#define NGT (G * NTHR)
#define WSP() launder((unsigned char*)ldp(lds, PT_WS))
#define IDS() const int wave = opq_s(wave0), lane = (int)__builtin_amdgcn_mbcnt_hi(~0u, __builtin_amdgcn_mbcnt_lo(~0u, (unsigned)opq_v(0))), tid = wave * 64 + lane, G = opq_s(G0), bid = opq_s(bid0); (void)lane; (void)wave; (void)G; (void)bid
struct Ctx { LAS unsigned char* lds; int tid0, wave0, G0, bid0, lo, hi; };
#define CTX_LOCALS() LAS unsigned char* lds = c.lds; const int tid0 = c.tid0, wave0 = c.wave0, G0 = c.G0, bid0 = c.bid0, lo = c.lo, hi = c.hi; (void)lds; (void)tid0; (void)wave0; (void)G0; (void)bid0; (void)lo; (void)hi

__device__ __forceinline__ void ff_part(const Ctx c, const int l, const int f) {
    CTX_LOCALS();
    const int pb = 1 + l * PH_PER_LAYER;
    const int fb = pb + (f ? 10 : 0);
    if (IN(fb + 1)) {
        { IDS(); unsigned char* ws = WSP(); const bf16* wl = (const bf16*)(ws + WS_W) + (size_t)l * WE_LAYER;
          pg8::Gemm g{(const bf16*)(ws + WS_XN), wl + (f ? WE_GU2 : WE_GU1), MP, NGU, DM}; pg8::StaticOrder S; S.init(MP, NGU, G, bid, RM(4));
          EpiSwiGLU E{ws, 3 * l + (f ? 2 : 0)};
          pg8::gemm_phase<EpiSwiGLU, pg8::StaticOrder, PROBE_ALIGN_GU, true>(lds + RING_OFF, g, S, E, tid); }
        { IDS(); unsigned char* ws = WSP(); const bf16* wl = (const bf16*)(ws + WS_W) + (size_t)l * WE_LAYER; EpiSwiGLU E{ws, 3 * l + (f ? 2 : 0)};
          for (int su = G - 1 - bid; su < RM(9) * (NGU / 64); su += G) skinny_unit<EpiSwiGLU>(lds + RING_OFF, (const bf16*)(ws + WS_XN), wl + (f ? WE_GU2 : WE_GU1), DM, su % (NGU / 64), E, tid); }
        { IDS(); unsigned char* ws = WSP();
          const int dfirst = (f == 0) ? l * PB_LAYER + 1376 : (l + 1) * PB_LAYER;
          if (G == 256 && bid >= DEFER_WG0 && (f == 0 || l < DEPTH - 1)) prologue_blocks(lds, (bf16*)(ws + WS_W), dfirst, DEFER_N, bid - DEFER_WG0, DEFER_WGS, tid, false);
          { const int slot = 2 * l + f; const int c0 = (int)((long)CACHE_COPY_N * slot / 10), c1 = (slot == 7) ? CACHE_COPY_N : (int)((long)CACHE_COPY_N * (slot + 1) / 10);
            if (G == 256) { if (bid >= DEFER_WG0) cache_copy_range(ldp(lds, 3), ldp(lds, 4), ldp(lds, 5), (float*)ldp(lds, PT_OUT), c0, c1, (bid - DEFER_WG0) * NTHR + tid, DEFER_WGS * NTHR); }
            else cache_copy_range(ldp(lds, 3), ldp(lds, 4), ldp(lds, 5), (float*)ldp(lds, PT_OUT), c0, c1, GT, NGT); } }
        IDS();
        SEAM(fb + 1);
    }
    if (IN(fb + 2)) {
        { IDS(); unsigned char* ws = WSP(); const bf16* wl = (const bf16*)(ws + WS_W) + (size_t)l * WE_LAYER;
          pg8::Gemm g{(const bf16*)(ws + WS_H), wl + (f ? WE_D2 : WE_D1), MP, DM, DFF}; pg8::StaticOrder S; S.init(MP, DM, G, bid, RM(10));
          EpiResid E{ws, lds, 0.5f, (f == 1 && l == DEPTH - 1) ? 1 : 0, (f == 0) ? 3 * l + 1 : (l < DEPTH - 1 ? 3 * l + 3 : -1)};
          pg8::gemm_phase<EpiResid, pg8::StaticOrder, PROBE_ALIGN_RES, true>(lds + RING_OFF, g, S, E, tid); }
        { IDS(); unsigned char* ws = WSP(); const bf16* wl = (const bf16*)(ws + WS_W) + (size_t)l * WE_LAYER; EpiResid E{ws, lds, 0.5f, (f == 1 && l == DEPTH - 1) ? 1 : 0, (f == 0) ? 3 * l + 1 : (l < DEPTH - 1 ? 3 * l + 3 : -1)};
          for (int su = G - 1 - bid; su < DM / 64; su += G) skinny_unit<EpiResid>(lds + RING_OFF, (const bf16*)(ws + WS_H), wl + (f ? WE_D2 : WE_D1), DFF, su, E, tid); }
        IDS();
        SEAM(fb + 2);
    }
}

__device__ __forceinline__ void mixer_part(const Ctx c, const int l) {
    CTX_LOCALS();
    const int pb = 1 + l * PH_PER_LAYER;
    if (IN(pb + 4)) {
        { IDS(); unsigned char* ws = WSP(); const bf16* wl = (const bf16*)(ws + WS_W) + (size_t)l * WE_LAYER;
          pg8::Gemm g{(const bf16*)(ws + WS_XN), wl + WE_IN, MP, NWIN, DM}; pg8::StaticOrder S; S.init(MP, NWIN, G, bid, RM(3));
          EpiWin E{ws, ldp(lds, 15) + (size_t)l * 768, ldp(lds, 16) + (size_t)l * 768, ldp(lds, 18) + (size_t)l * 256, (float*)ldp(lds, PT_OUT), l, 3 * l + 1};
          pg8::gemm_phase<EpiWin, pg8::StaticOrder, PROBE_ALIGN_WIN, true>(lds + RING_OFF, g, S, E, tid); }
        { IDS(); unsigned char* ws = WSP(); const bf16* wl = (const bf16*)(ws + WS_W) + (size_t)l * WE_LAYER;
          EpiWin E{ws, ldp(lds, 15) + (size_t)l * 768, ldp(lds, 16) + (size_t)l * 768, ldp(lds, 18) + (size_t)l * 256, (float*)ldp(lds, PT_OUT), l, 3 * l + 1};
          for (int su = G - 1 - bid; su < RM(9) * (NWIN / 64); su += G) skinny_unit<EpiWin>(lds + RING_OFF, (const bf16*)(ws + WS_XN), wl + WE_IN, DM, su % (NWIN / 64), E, tid); }
        IDS();
        SEAM(pb + 4);
    }
    if (IN(pb + 5)) {
        IDS();
        { unsigned char* ws = WSP();
          for (int u = bid; u < RM(1) * ATT_UNITS; u += G) attn_unit(lds, (const bf16*)(ws + WS_Q), (const bf16*)(ws + WS_K), (const bf16*)(ws + WS_V), (float*)(ws + WS_AO), (float*)(ws + WS_LSE), u % ATT_UNITS, tid); }
        { unsigned char* ws = WSP();
          for (int u2 = bid; u2 < RM(5) * (GLA_UNITS / 2); u2 += G) gla_ds_unit(lds + (tid >> 8) * GLA_HALF, (const bf16*)(ws + WS_GK), (const bf16*)(ws + WS_GV), (const float*)(ws + WS_LA), (float*)(ws + WS_DS), (float*)(ws + WS_DEC), 2 * (u2 % (GLA_UNITS / 2)) + (tid >> 8), tid & 255); }
        { unsigned char* ws = WSP();
          conv_pool_pass((const bf16*)(ws + WS_CB), (const bf16*)(ws + WS_U), (const bf16*)(ws + WS_PIN), ldp(lds, 14), ldp(lds, 2), ldp(lds, 7), (bf16*)(ws + WS_YCAT), (bf16*)(ws + WS_YCAT), l, GT, NGT, RM(6)); }
        REP(8) { const int su = (NGW - 1 - GW);
          if (su < NB_S * TS * 12) { unsigned char* ws = WSP(); attn_sample_wave((const bf16*)(ws + WS_Q), (const bf16*)(ws + WS_K), (const bf16*)(ws + WS_V), ldp(lds, 3), ldp(lds, 4), ldp(lds, 5), (float*)(ws + WS_AO), (float*)(ws + WS_LSE), l, su, lane); } }
        REP(8) { unsigned char* ws = WSP();
          for (int u = bid - 64; u >= 0 && u < NB_S * 4; u += G) gla_sample_unit((LAS float*)lds, (const bf16*)(ws + WS_GQ), (const bf16*)(ws + WS_GK), (const bf16*)(ws + WS_GV), (const bf16*)(ws + WS_GR), (const float*)(ws + WS_LA), ldp(lds, 6), ldp(lds, 19) + (size_t)l * 128, (bf16*)(ws + WS_YCAT), (float*)ldp(lds, PT_OUT), l, u, tid); }
        SEAM(pb + 5);
    }
    if (IN(pb + 6)) {
        IDS(); unsigned char* ws = WSP();
        gla_scan_pass((const float*)(ws + WS_DS), (const float*)(ws + WS_DEC), (bf16*)(ws + WS_SP), (float*)ldp(lds, PT_OUT), l, GT, RM(7));
        attn_merge_pass((const float*)(ws + WS_AO), (const float*)(ws + WS_LSE), (bf16*)(ws + WS_YCAT), GT, NGT, RM(7));
        SEAM(pb + 6);
    }
    if (IN(pb + 7)) {
        IDS(); unsigned char* ws = WSP();
        for (int u2 = bid; u2 < RM(5) * (GLA_UNITS / 2); u2 += G) gla_out_unit(lds + (tid >> 8) * GLA_HALF, (const bf16*)(ws + WS_GQ), (const bf16*)(ws + WS_GK), (const bf16*)(ws + WS_GV), (const bf16*)(ws + WS_GR), (const float*)(ws + WS_LA), (const bf16*)(ws + WS_SP), ldp(lds, 19) + (size_t)l * 128, (bf16*)(ws + WS_YCAT), 2 * (u2 % (GLA_UNITS / 2)) + (tid >> 8), tid & 255);
        SEAM(pb + 7);
    }
    if (IN(pb + 8)) {
        REP(11) {
        { IDS(); unsigned char* ws = WSP(); const bf16* wl = (const bf16*)(ws + WS_W) + (size_t)l * WE_LAYER; pg8::StaticOrder S; S.init(MP, DM, G, bid);
          pg8::Gemm g{(const bf16*)(ws + WS_YCAT), wl + WE_UPCAT, MP, DM, YK}; EpiMergeCat E{ws};
          pg8::gemm_phase<EpiMergeCat, pg8::StaticOrder, true, true>(lds + RING_OFF, g, S, E, tid); }
        { IDS(); unsigned char* ws = WSP(); const bf16* wl = (const bf16*)(ws + WS_W) + (size_t)l * WE_LAYER; const bf16* yc = (const bf16*)(ws + WS_YCAT); const bf16* uc = wl + WE_UPCAT;
          for (int su = G - 1 - bid; su < DM / 64; su += G) skinny_merge_unit(lds + RING_OFF, ws, yc, uc, su, tid); }
        }
        IDS();
        SEAM(pb + 8);
    }
    if (IN(pb + 9)) {
        { IDS(); unsigned char* ws = WSP(); const bf16* wl = (const bf16*)(ws + WS_W) + (size_t)l * WE_LAYER;
          pg8::Gemm g{(const bf16*)(ws + WS_MRG), wl + WE_OUT, MP, DM, DM}; pg8::StaticOrder S; S.init(MP, DM, G, bid, RM(12));
          EpiResid E{ws, lds, 1.0f, 0, 3 * l + 2};
#if (PROBE_DUP >> 14) & 1
          { pg8::Gemm g0{(const bf16*)(ws + WS_MRG), wl + WE_OUT, MP, DM, 256}; EpiResid E0{ws, lds, 0.0f, 0, -1};
            pg8::gemm_phase<EpiResid, pg8::StaticOrder, PROBE_ALIGN_RES, true>(lds + RING_OFF, g0, S, E0, tid); }
#endif
          pg8::gemm_phase<EpiResid, pg8::StaticOrder, PROBE_ALIGN_RES, true>(lds + RING_OFF, g, S, E, tid); }
        { IDS(); unsigned char* ws = WSP(); const bf16* wl = (const bf16*)(ws + WS_W) + (size_t)l * WE_LAYER; EpiResid E{ws, lds, 1.0f, 0, 3 * l + 2};
          for (int su = G - 1 - bid; su < DM / 64; su += G) skinny_unit<EpiResid>(lds + RING_OFF, (const bf16*)(ws + WS_MRG), wl + WE_OUT, DM, su, E, tid); }
        IDS();
        SEAM(pb + 9);
    }
}

__global__ void __launch_bounds__(NTHR, 2) fwd_kernel(Args args) {
    extern __shared__ __attribute__((aligned(16))) unsigned char lds_raw[];
    LAS unsigned char* lds = (LAS unsigned char*)lds_raw;
    const int tid0 = threadIdx.x; const int wave0 = __builtin_amdgcn_readfirstlane(tid0 >> 6);
    const int G0 = gridDim.x, bid0 = blockIdx.x;
    { const int tid = tid0; for (int u = tid; u < (LDS_BYTES - LDSCTL_OFF) / 4; u += NTHR) ((LAS unsigned*)(lds + LDSCTL_OFF))[u] = 0u; }
    __syncthreads();
    if (tid0 == 0) {
        LAS unsigned long long* pt = (LAS unsigned long long*)(lds + PT_OFF);
#pragma unroll
        for (int i = 0; i < 31; ++i) pt[i] = (unsigned long long)args.in[i];
        pt[PT_OUT] = (unsigned long long)args.out; pt[PT_WS] = (unsigned long long)args.ws;
    }
    __syncthreads();
    if (!MK_PER_PHASE) (void)xcd_barrier_post((unsigned*)(args.ws + WS_CTL) + CW_BAR, (volatile LAS unsigned*)(lds + MISC_OFF) + 8);
    const int lo = args.ph_lo, hi = args.ph_hi;

    if (IN(0)) {
        IDS(); unsigned char* ws = WSP(); float* out = (float*)ldp(lds, PT_OUT);
        REP(0) { prologue_blocks(lds, (bf16*)(ws + WS_W), 0, DEPTH * PB_LAYER, bid, G, tid, G == 256); prologue_specials(lds, (bf16*)(ws + WS_W), G - 1 - bid, G, tid); }
        x_init_pass(ldp(lds, 0), ldp(lds, 1), (float*)(ws + WS_X), (bf16*)(ws + WS_XN), (unsigned long long*)(ws + WS_CTL + CTL_SS), GW, NGW, lane);
        { const f32x4* src = (const f32x4*)ldp(lds, 7); f32x4* dst = (f32x4*)(out + OFF_POOL_S); const int per = 11 * 128;
          for (int i = GT; i < DEPTH * NB_S * per; i += NGT) { const int lb = i / per, j = i - lb * per; dst[(size_t)lb * 15 * 128 + j] = src[(size_t)lb * 15 * 128 + 4 * 128 + j]; } }
        SEAM(0);
    }

    { Ctx c; c.lds = lds; c.tid0 = tid0; c.wave0 = wave0; c.G0 = G0; c.bid0 = bid0; c.lo = lo; c.hi = hi;
#if MK_UNROLL_LAYERS
      ff_part(c, 0, 0); mixer_part(c, 0); ff_part(c, 0, 1); ff_part(c, 1, 0); mixer_part(c, 1); ff_part(c, 1, 1);
      ff_part(c, 2, 0); mixer_part(c, 2); ff_part(c, 2, 1); ff_part(c, 3, 0); mixer_part(c, 3); ff_part(c, 3, 1);
#else
      _Pragma("unroll 1") for (int l = 0; l < DEPTH; ++l) {
          _Pragma("unroll 1") for (int f = 0; f < 2; ++f) { ff_part(c, l, f); if (f == 0) mixer_part(c, l); }
      }
#endif
    }
#undef IN
#undef SEAM
}

extern "C" void kernel_launch(void* const* d_in, const int* in_sizes, int n_in, void* d_out, int out_size, void* d_ws, size_t ws_size, hipStream_t stream) {
    static int grid = 0;
    if (grid == 0) {
        if (n_in != 31 || out_size != OUT_TOTAL || ws_size < WS_END) { fprintf(stderr, "kernel_launch: expected 31 inputs, %d outputs, >= %zu bytes ws; got %d, %d, %zu\n", OUT_TOTAL, (size_t)WS_END, n_in, out_size, ws_size); grid = -1; return; }
        int dev = 0, cus = 0, per_cu = 0;
        if (hipGetDevice(&dev) != hipSuccess || hipDeviceGetAttribute(&cus, hipDeviceAttributeMultiprocessorCount, dev) != hipSuccess) { grid = -1; return; }
        if (hipFuncSetAttribute((const void*)fwd_kernel, hipFuncAttributeMaxDynamicSharedMemorySize, LDS_BYTES) != hipSuccess) { fprintf(stderr, "kernel_launch: hipFuncSetAttribute failed\n"); grid = -1; return; }
        if (hipOccupancyMaxActiveBlocksPerMultiprocessor(&per_cu, (const void*)fwd_kernel, NTHR, LDS_BYTES) != hipSuccess || per_cu < 1) fprintf(stderr, "kernel_launch: occupancy query says %d\n", per_cu);
        (void)hipGetLastError();
        grid = cus;
    }
    if (grid < 0) return;
    if (hipMemsetAsync((char*)d_ws + WS_CTL, 0, CTL_ZERO_BYTES, stream) != hipSuccess) return;
    Args a; memset(&a, 0, sizeof(a));
    for (int i = 0; i < 31; ++i) a.in[i] = (const float*)d_in[i];
    a.out = (float*)d_out; a.ws = (unsigned char*)d_ws;
#if MK_PER_PHASE
    for (int ph = 0; ph < NPH; ++ph) { a.ph_lo = ph; a.ph_hi = ph + 1; hipLaunchKernelGGL(fwd_kernel, dim3(grid), dim3(NTHR), LDS_BYTES, stream, a); }
#else
    a.ph_lo = 0; a.ph_hi = NPH;
    hipLaunchKernelGGL(fwd_kernel, dim3(grid), dim3(NTHR), LDS_BYTES, stream, a);
#endif
    const hipError_t le = hipPeekAtLastError();
    if (le != hipSuccess) fprintf(stderr, "kernel_launch: launch failed: %s\n", hipGetErrorName(le));
}
```

```cpp
#include <hip/hip_runtime.h>
#include <cstdio>
#include <cstdint>
#include <cstring>
#ifndef PROBE_DUP
#define PROBE_DUP 0
#endif
namespace pg8 {
#define PG8_LAS __attribute__((address_space(3)))
typedef unsigned short bf16_t;
typedef short bf16x8 __attribute__((ext_vector_type(8)));
typedef float f32x4 __attribute__((ext_vector_type(4)));
typedef unsigned u32x4 __attribute__((ext_vector_type(4)));
constexpr int BM = 256, BK = 64, HALF = 128, HTB = HALF * BK * 2  , STAGE_BYTES = 8 * HTB, NXCD = 8, WGM = 8;

__host__ __device__ __forceinline__ int lds_byte(int r, int c) { const int st = (r >> 4) * 2 + (c >> 5), rr = r & 15, cc = c & 31, ob = rr * 64 + cc * 2; return st * 1024 + (ob ^ (((ob >> 9) & 1) << 5)); }
__host__ __device__ __forceinline__ void stage_rc(int b, int& R, int& C) { const int st = b / 1024, sb = b % 1024, swz = sb ^ (((sb >> 9) & 1) << 5); R = (st >> 1) * 16 + swz / 64; C = (st & 1) * 32 + (swz % 64) / 2; }
__host__ __device__ __forceinline__ int perm32(int rho) { const int n = rho >> 4, i = rho & 15; return 8 * (i >> 2) + 4 * n + (i & 3); }

struct Unit { int pm, pn, ri; };
struct Gemm { const bf16_t* A; const bf16_t* Bt; int M, N, K; };

struct StaticOrder {
    int nM, nN, nwg, G, c, rep;
    __host__ __device__ void init(int M, int N, int G_, int c_, int rep_ = 1) { nM = M / BM; nN = N / BM; nwg = nM * nN; G = G_; c = c_; rep = rep_; }
    __host__ __device__ bool next(int i, Unit& u) const {
        const long L = (long)i * G + c; if (L >= (long)rep * nwg) return false;
        int wgid = (int)(L % nwg);
#if (PROBE_DUP >> 15) & 1
        if (L >= nwg) wgid = 0;
#endif
        { const int q = nwg / NXCD, r = nwg % NXCD, xcd = wgid % NXCD, off = wgid / NXCD; wgid = (xcd < r ? xcd * (q + 1) : r * (q + 1) + (xcd - r) * q) + off; }
        const int nig = WGM * nN, gid = wgid / nig, fm = gid * WGM, gsz = (nM - fm) < WGM ? (nM - fm) : WGM;
        u.pm = fm + ((wgid % nig) % gsz); u.pn = (wgid % nig) / gsz; u.ri = (int)(L / nwg); return true;
    }
    __device__ __forceinline__ void a_ready(const Unit&) const {}
    __device__ __forceinline__ void done(const Unit&) const {}
};

template <class Epi, class Sched, bool ALIGN_EPI = false, bool SP2 = false>
__device__ __forceinline__ void gemm_phase(PG8_LAS unsigned char* lds, const Gemm g, const Sched S, const Epi E, const int tid) {
    const int wid = __builtin_amdgcn_readfirstlane(tid >> 6), lane = tid & 63, wr = wid >> 2, wc = wid & 3, fr = lane & 15, fq = lane >> 4;
    const int K = g.K, nt = K / BK;
    unsigned voffA[2], voffB[2];
#pragma unroll
    for (int i = 0; i < 2; ++i) { int R, C; stage_rc(tid * 16 + i * 8192, R, C); const int Rb = Epi::PERM ? ((R & ~31) + perm32(R & 31)) : R;
        voffA[i] = (unsigned)(R * K + C) * 2u; voffB[i] = (unsigned)(Rb * K + C) * 2u; }
    const size_t kstep = (size_t)(BK * 2);
    const size_t hstep = (size_t)HALF * K * 2;
    const size_t tstep = 2 * hstep;
    const unsigned ldsw = (unsigned)wid * 1024u;
    const int aoff = lds_byte(wr * 64 + fr, fq * 8), boff = lds_byte(wc * 32 + fr, fq * 8);
#define PG8_SA(b, h) (((b) * 2 + (h)) * HTB)
#define PG8_SB(b, h) ((4 + (b) * 2 + (h)) * HTB)
#define PG8_STAGE(bufoff, gbase, voff) do { _Pragma("unroll") for (int _i = 0; _i < 2; ++_i) \
        __builtin_amdgcn_global_load_lds((const unsigned*)((const char*)(gbase) + (voff)[_i]), (PG8_LAS unsigned*)(lds + (bufoff) + ldsw + _i * 8192), 16, 0, 0); } while (0)
#define PG8_LDA(dst, b, h) do { _Pragma("unroll") for (int m = 0; m < 4; ++m) _Pragma("unroll") for (int k = 0; k < 2; ++k) dst[m][k] = *(const PG8_LAS bf16x8*)(lds + PG8_SA(b, h) + aoff + m * 2048 + k * 1024); } while (0)
#define PG8_LDB(dst, b, h) do { _Pragma("unroll") for (int n = 0; n < 2; ++n) _Pragma("unroll") for (int k = 0; k < 2; ++k) dst[n][k] = *(const PG8_LAS bf16x8*)(lds + PG8_SB(b, h) + boff + n * 2048 + k * 1024); } while (0)
#define PG8_MMA(ai, bj, At, Bt) do { __builtin_amdgcn_s_setprio(1); _Pragma("unroll") for (int m = 0; m < 4; ++m) _Pragma("unroll") for (int n = 0; n < 2; ++n) _Pragma("unroll") for (int k = 0; k < 2; ++k) \
        acc[ai][bj][m][n] = __builtin_amdgcn_mfma_f32_16x16x32_bf16(Bt[n][k], At[m][k], acc[ai][bj][m][n], 0, 0, 0); __builtin_amdgcn_s_setprio(0); } while (0)
#define PG8_WAIT_V(n) asm volatile("s_waitcnt vmcnt(" #n ")" ::: "memory")
#define PG8_WAIT_L(n) asm volatile("s_waitcnt lgkmcnt(" #n ")" ::: "memory")
#define PG8_BAR __builtin_amdgcn_s_barrier()
#define PG8_SCHED __builtin_amdgcn_sched_barrier(0)
    Unit cur, nxt; int ui = 0;
    if (!S.next(0, cur)) return;
    f32x4 acc[2][2][4][2];
#pragma unroll
    for (int a = 0; a < 2; ++a)
#pragma unroll
        for (int b = 0; b < 2; ++b)
#pragma unroll
            for (int m = 0; m < 4; ++m)
#pragma unroll
                for (int n = 0; n < 2; ++n) acc[a][b][m][n] = (f32x4){0.f, 0.f, 0.f, 0.f};
    bf16x8 At[4][2], B0[2][2], B1[2][2];
    const char* cA = (const char*)g.A + (size_t)cur.pm * tstep; const char* cB = (const char*)g.Bt + (size_t)cur.pn * tstep;
    S.a_ready(cur);
    if constexpr (SP2) {
        PG8_STAGE(PG8_SB(0, 0), cB, voffB); PG8_STAGE(PG8_SB(0, 1), cB + hstep, voffB); PG8_STAGE(PG8_SA(0, 0), cA, voffA); PG8_STAGE(PG8_SA(0, 1), cA + hstep, voffA);
        if (wr == 1) PG8_BAR;
        PG8_WAIT_V(2); PG8_BAR;
        PG8_STAGE(PG8_SB(1, 0), cB + kstep, voffB); PG8_STAGE(PG8_SA(1, 0), cA + kstep, voffA); PG8_STAGE(PG8_SB(1, 1), cB + hstep + kstep, voffB);
        PG8_WAIT_V(6); PG8_BAR;
    } else {
        PG8_STAGE(PG8_SB(0, 0), cB, voffB); PG8_STAGE(PG8_SA(0, 0), cA, voffA); PG8_STAGE(PG8_SB(0, 1), cB + hstep, voffB); PG8_STAGE(PG8_SA(0, 1), cA + hstep, voffA);
        if (wr == 1) PG8_BAR;
        PG8_WAIT_V(4); PG8_BAR;
        PG8_STAGE(PG8_SB(1, 0), cB + kstep, voffB); PG8_STAGE(PG8_SA(1, 0), cA + kstep, voffA); PG8_STAGE(PG8_SB(1, 1), cB + hstep + kstep, voffB);
        PG8_WAIT_V(6); PG8_BAR;
    }
    for (;;) {
        const bool has_next = S.next(ui + 1, nxt);
        const char* nA = has_next ? (const char*)g.A + (size_t)nxt.pm * tstep : cA; const char* nB = has_next ? (const char*)g.Bt + (size_t)nxt.pn * tstep : cB;
        for (int t = 0; t < nt; t += 2) {
            const bool last = (t == nt - 2);
            const char* a1 = cA + (size_t)(t + 1) * kstep;
            const char* a2 = last ? nA : cA + (size_t)(t + 2) * kstep; const char* b2 = last ? nB : cB + (size_t)(t + 2) * kstep;
            const char* a3 = a2 + kstep; const char* b3 = b2 + kstep;
            if (last && has_next) S.a_ready(nxt);
            if constexpr (Epi::HAS_MID) { if (t == 8 || t == 12 || t == 20) E.mid(acc, cur, t, wr, wc, fr, fq); }
            if constexpr (SP2) {
            PG8_LDB(B0, 0, 0); PG8_LDB(B1, 0, 1); PG8_SCHED; PG8_LDA(At, 0, 0); PG8_STAGE(PG8_SA(1, 1), a1 + hstep, voffA);
            PG8_WAIT_V(8); PG8_WAIT_L(0); PG8_BAR; PG8_MMA(0, 0, At, B0); PG8_MMA(0, 1, At, B1); PG8_BAR; PG8_SCHED;
            PG8_LDA(At, 0, 1); PG8_STAGE(PG8_SB(0, 0), b2, voffB); PG8_STAGE(PG8_SB(0, 1), b2 + hstep, voffB); PG8_STAGE(PG8_SA(0, 0), a2, voffA);
            PG8_WAIT_V(8); PG8_WAIT_L(0); PG8_BAR; PG8_MMA(1, 0, At, B0); PG8_MMA(1, 1, At, B1); PG8_BAR; PG8_SCHED;
            PG8_LDB(B0, 1, 0); PG8_LDB(B1, 1, 1); PG8_SCHED; PG8_LDA(At, 1, 0); PG8_STAGE(PG8_SA(0, 1), a2 + hstep, voffA);
            PG8_WAIT_V(8); PG8_WAIT_L(0); PG8_BAR; PG8_MMA(0, 0, At, B0); PG8_MMA(0, 1, At, B1); PG8_BAR; PG8_SCHED;
            PG8_LDA(At, 1, 1); PG8_STAGE(PG8_SB(1, 0), b3, voffB); PG8_STAGE(PG8_SB(1, 1), b3 + hstep, voffB); PG8_STAGE(PG8_SA(1, 0), a3, voffA);
            PG8_WAIT_V(8); PG8_WAIT_L(0); PG8_BAR; PG8_MMA(1, 0, At, B0); PG8_MMA(1, 1, At, B1); PG8_BAR; PG8_SCHED;
            } else {
            PG8_LDB(B0, 0, 0); PG8_SCHED; PG8_LDA(At, 0, 0); PG8_STAGE(PG8_SA(1, 1), a1 + hstep, voffA);
            PG8_WAIT_L(8); PG8_BAR; PG8_WAIT_L(0); PG8_MMA(0, 0, At, B0); PG8_BAR; PG8_SCHED;
            PG8_LDB(B1, 0, 1); PG8_STAGE(PG8_SB(0, 0), b2, voffB);
            PG8_BAR; PG8_WAIT_L(0); PG8_MMA(0, 1, At, B1); PG8_BAR;
            PG8_LDA(At, 0, 1); PG8_STAGE(PG8_SA(0, 0), a2, voffA);
            PG8_BAR; PG8_WAIT_L(0); PG8_MMA(1, 0, At, B0); PG8_BAR; PG8_SCHED;
            PG8_STAGE(PG8_SB(0, 1), b2 + hstep, voffB);
            PG8_WAIT_V(6); PG8_BAR; PG8_MMA(1, 1, At, B1); PG8_BAR;
            PG8_LDB(B0, 1, 0); PG8_SCHED; PG8_LDA(At, 1, 0); PG8_STAGE(PG8_SA(0, 1), a2 + hstep, voffA);
            PG8_WAIT_L(8); PG8_BAR; PG8_WAIT_L(0); PG8_MMA(0, 0, At, B0); PG8_BAR; PG8_SCHED;
            PG8_LDB(B1, 1, 1); PG8_STAGE(PG8_SB(1, 0), b3, voffB);
            PG8_BAR; PG8_WAIT_L(0); PG8_MMA(0, 1, At, B1); PG8_BAR;
            PG8_LDA(At, 1, 1); PG8_STAGE(PG8_SA(1, 0), a3, voffA);
            PG8_BAR; PG8_WAIT_L(0); PG8_MMA(1, 0, At, B0); PG8_BAR; PG8_SCHED;
            PG8_STAGE(PG8_SB(1, 1), b3 + hstep, voffB);
            PG8_WAIT_V(6); PG8_BAR; PG8_MMA(1, 1, At, B1); PG8_BAR;
            }
        }
        if constexpr (ALIGN_EPI) { if (wr == 0) PG8_BAR; }
        if constexpr (!Epi::AFTER_DRAIN) { E(acc, cur, wr, wc, fr, fq); S.done(cur); }
        if (!has_next) break;
#pragma unroll
        for (int a = 0; a < 2; ++a)
#pragma unroll
            for (int b = 0; b < 2; ++b)
#pragma unroll
                for (int m = 0; m < 4; ++m)
#pragma unroll
                    for (int n = 0; n < 2; ++n) acc[a][b][m][n] = (f32x4){0.f, 0.f, 0.f, 0.f};
        cur = nxt; cA = nA; cB = nB; ++ui;
        if constexpr (ALIGN_EPI) { if (wr == 1) PG8_BAR; }
    }
    PG8_WAIT_V(0);
    if constexpr (!ALIGN_EPI) { if (wr == 0) PG8_BAR; }
    PG8_BAR;
    if constexpr (Epi::AFTER_DRAIN) { E.fused(acc, cur, wr, wc, fr, fq, lds, wid, lane); S.done(cur); }
#undef PG8_SA
#undef PG8_SB
#undef PG8_STAGE
#undef PG8_LDA
#undef PG8_LDB
#undef PG8_MMA
#undef PG8_WAIT_V
#undef PG8_WAIT_L
#undef PG8_BAR
#undef PG8_SCHED
}
}

constexpr int DM = 2048, DFF = 5504, DEPTH = 4;
constexpr int SEQ = 4096, NB_P = 2, MP = NB_P * SEQ;
constexpr int NB_S = 8, TS = 4, MS = NB_S * TS;
constexpr int MR = MP + MS;
constexpr int MPAD = 8448;
constexpr int PAST = 16384;
constexpr int N_IN = 14096, NWIN = 14336;
constexpr int NGU = 2 * DFF;
constexpr float EPS = 1e-6f;
constexpr int NWAVES = 8, NTHR = 512;

constexpr int C_CB = 0, C_CC = 512, C_CH = 1024, C_AQ = 1536, C_AK = 2304, C_AV = 3072, C_GQ = 3840, C_GK = 4096, C_GV = 4352, C_GR = 4864, C_LR = 5376, C_PIN = 5392, C_GATE = 5904;
constexpr int T_CONV = 0, T_CB = 4, T_Q = 6, T_K = 9, T_V = 12, T_GQ = 15, T_GK = 16, T_GV = 17, T_GR = 19, T_Z = 21, T_PIN = 22, T_GATE = 24;

constexpr int OFF_YP = 0;
constexpr int OFF_YS = OFF_YP + MP * DM;
constexpr int OFF_CONV_P = OFF_YS + MS * DM;
constexpr int OFF_CONV_S = OFF_CONV_P + DEPTH * NB_P * 2 * 512;
constexpr int OFF_W128_P = OFF_CONV_S + DEPTH * NB_S * 2 * 512;
constexpr int OFF_W128_S = OFF_W128_P + DEPTH * NB_P * 128 * 512;
constexpr int OFF_W512_P = OFF_W128_S + DEPTH * NB_S * 128 * 512;
constexpr int OFF_W512_S = OFF_W512_P + DEPTH * NB_P * 512 * 512;
constexpr int OFF_W2048_P = OFF_W512_S + DEPTH * NB_S * 512 * 512;
constexpr int OFF_W2048_S = OFF_W2048_P + DEPTH * NB_P * 2048 * 512;
constexpr int OFF_GLA_P = OFF_W2048_S + DEPTH * NB_S * 2048 * 512;
constexpr int OFF_GLA_S = OFF_GLA_P + DEPTH * NB_P * 4 * 64 * 128;
constexpr int OFF_POOL_P = OFF_GLA_S + DEPTH * NB_S * 4 * 64 * 128;
constexpr int OFF_POOL_S = OFF_POOL_P + DEPTH * NB_P * 15 * 512;
constexpr int OUT_TOTAL = OFF_POOL_S + DEPTH * NB_S * 15 * 512;
static_assert(OUT_TOTAL == 73551872, "output size");

constexpr size_t MiB = 1u << 20;
constexpr size_t WS_CTL = 0, CTL_ZERO_BYTES = 1 * MiB;
constexpr size_t SZ_ROW2K_F32 = (size_t)MPAD * DM * 4, SZ_ROW2K_BF = (size_t)MPAD * DM * 2;
constexpr size_t WS_X = WS_CTL + CTL_ZERO_BYTES;
constexpr size_t WS_XN = WS_X + SZ_ROW2K_F32;
constexpr size_t WS_H = WS_XN + SZ_ROW2K_BF;
constexpr size_t WS_CB = WS_H + (size_t)MPAD * DFF * 2;
constexpr size_t WS_U = WS_CB + (size_t)MPAD * 512 * 2;
constexpr size_t WS_Q = WS_U + (size_t)MPAD * 512 * 2;
constexpr size_t WS_K = WS_Q + (size_t)MPAD * 768 * 2;
constexpr size_t WS_V = WS_K + (size_t)MPAD * 768 * 2;
constexpr size_t WS_GQ = WS_V + (size_t)MPAD * 768 * 2;
constexpr size_t WS_GK = WS_GQ + (size_t)MPAD * 256 * 2;
constexpr size_t WS_GV = WS_GK + (size_t)MPAD * 256 * 2;
constexpr size_t WS_GR = WS_GV + (size_t)MPAD * 512 * 2;
constexpr size_t WS_LA = WS_GR + (size_t)MPAD * 512 * 2;
constexpr size_t WS_PIN = WS_LA + (size_t)MPAD * 256 * 4;
constexpr size_t WS_GATE = WS_PIN + (size_t)MPAD * 512 * 2;
constexpr int YK = 1792, YO_A = 0, YO_B = 512, YO_C = 768, YO_D = 1280;
constexpr size_t WS_YCAT = WS_GATE + (size_t)MPAD * 8192 * 2;
constexpr size_t WS_AO = WS_YCAT + (size_t)MPAD * YK * 2;
constexpr size_t WS_LSE = WS_AO + (size_t)MPAD * 768 * 4;
constexpr size_t WS_DS = WS_LSE + (size_t)MPAD * 12 * 4;
constexpr size_t WS_DEC = WS_DS + (size_t)8 * 64 * 64 * 128 * 4;
constexpr size_t WS_SP = WS_DEC + (size_t)8 * 64 * 64 * 4;
constexpr size_t WS_PM = WS_SP + (size_t)8 * 64 * 64 * 128 * 2;
constexpr size_t WS_MRG = WS_PM + (size_t)(MPAD - MP) * DM * 4;
constexpr size_t WS_W = WS_MRG + SZ_ROW2K_BF;
constexpr size_t WE_GU1 = 0;
constexpr size_t WE_D1 = WE_GU1 + (size_t)NGU * DM;
constexpr size_t WE_IN = WE_D1 + (size_t)DM * DFF;
constexpr size_t WE_UPCAT = WE_IN + (size_t)NWIN * DM;
constexpr size_t WE_OUT = WE_UPCAT + (size_t)DM * YK;
constexpr size_t WE_GU2 = WE_OUT + (size_t)DM * DM;
constexpr size_t WE_D2 = WE_GU2 + (size_t)NGU * DM;
constexpr size_t WE_LAYER = WE_D2 + (size_t)DM * DFF;
static_assert(WE_LAYER == 104857600, "layer weights");
constexpr size_t WS_END = WS_W + (size_t)DEPTH * WE_LAYER * 2;
static_assert(WS_X % 256 == 0 && WS_W % 256 == 0 && WS_LSE % 256 == 0 && WS_DS % 256 == 0, "alignment");

constexpr int CW_BAR = 4096;
constexpr size_t CTL_SS = 65536;
constexpr float SS_FIX = 16777216.0f;
static_assert(CTL_SS + 12 * (size_t)MPAD * 8 <= CTL_ZERO_BYTES, "SS fits the zeroed control region");

constexpr int RING_OFF = 0, RING_BYTES = 131072;
constexpr int LDSCTL_OFF = RING_BYTES, MISC_OFF = LDSCTL_OFF + 320;
constexpr int LDS_BYTES = 147456;

#define GAS __attribute__((address_space(1)))
#define LAS __attribute__((address_space(3)))
typedef unsigned short bf16;
typedef unsigned u32x4 __attribute__((ext_vector_type(4)));
typedef unsigned u32x2 __attribute__((ext_vector_type(2)));
typedef float f32x4 __attribute__((ext_vector_type(4)));
typedef float f32x2 __attribute__((ext_vector_type(2)));
typedef short bf16x8 __attribute__((ext_vector_type(8)));
typedef short s16x4 __attribute__((ext_vector_type(4)));
#define LDS_WAIT() asm volatile("s_waitcnt lgkmcnt(0)" ::: "memory")
#define VM_WAIT() asm volatile("s_waitcnt vmcnt(0)" ::: "memory")
__device__ __forceinline__ unsigned f2bf(float f) { unsigned u = __builtin_bit_cast(unsigned, f); return (u + 0x7fffu + ((u >> 16) & 1u)) >> 16; }
__device__ __forceinline__ unsigned pk2(float lo, float hi) { return f2bf(lo) | (f2bf(hi) << 16); }
__device__ __forceinline__ float bflo(unsigned w) { return __builtin_bit_cast(float, w << 16); }
__device__ __forceinline__ float bfhi(unsigned w) { return __builtin_bit_cast(float, w & 0xffff0000u); }
__device__ __forceinline__ float bf2f(bf16 b) { return __builtin_bit_cast(float, ((unsigned)b) << 16); }
__device__ __forceinline__ u32x4 pk8(f32x4 a, f32x4 b) { u32x4 w; w.x = pk2(a[0], a[1]); w.y = pk2(a[2], a[3]); w.z = pk2(b[0], b[1]); w.w = pk2(b[2], b[3]); return w; }
__device__ __forceinline__ void unpk8(u32x4 w, float (&f)[8]) { f[0] = bflo(w.x); f[1] = bfhi(w.x); f[2] = bflo(w.y); f[3] = bfhi(w.y); f[4] = bflo(w.z); f[5] = bfhi(w.z); f[6] = bflo(w.w); f[7] = bfhi(w.w); }
__device__ __forceinline__ float sigmoidf_(float x) { return __builtin_amdgcn_rcpf(1.0f + __expf(-x)); }
__device__ __forceinline__ float siluf_(float x) { return x * sigmoidf_(x); }
__device__ __forceinline__ float shx(float v, int m, int lane) { return __builtin_bit_cast(float, __builtin_amdgcn_ds_bpermute((lane ^ m) << 2, __builtin_bit_cast(int, v))); }
__device__ __forceinline__ float rdl(float v, int j) { return __builtin_bit_cast(float, __builtin_amdgcn_readlane(__builtin_bit_cast(int, v), j)); }
__device__ __forceinline__ float wave_sum(float v, int lane) {
#pragma unroll
    for (int o = 1; o < 64; o <<= 1) v += shx(v, o, lane);
    return v;
}
__device__ __forceinline__ float wave_max(float v, int lane) {
#pragma unroll
    for (int o = 1; o < 64; o <<= 1) v = fmaxf(v, shx(v, o, lane));
    return v;
}
__device__ __forceinline__ int win_of(int gi) { return 128 << (2 * gi); }
__device__ __forceinline__ int dil_of(int gi) { return 1 << (2 * gi); }
__device__ __forceinline__ int offw_p(int gi) { return gi == 0 ? OFF_W128_P : (gi == 1 ? OFF_W512_P : OFF_W2048_P); }
__device__ __forceinline__ int offw_s(int gi) { return gi == 0 ? OFF_W128_S : (gi == 1 ? OFF_W512_S : OFF_W2048_S); }

#define XB_TMO      128
#define XB_XCNT(j)  (256  + 64 * (j))
#define XB_XSUB(j)  (1280 + 64 * (j))
#define XB_XGEN(j)  (2304 + 64 * (j))
#define XB_TOP      3328
#define XB_TOPGEN   3392
#define XCD_BAR_WORDS 3456
#define XB_SPIN_CAP (1u << 18)

__device__ __forceinline__ unsigned xb_ld(unsigned* p)              { return __hip_atomic_load(p, __ATOMIC_RELAXED, __HIP_MEMORY_SCOPE_AGENT); }
__device__ __forceinline__ unsigned xb_add(unsigned* p, unsigned v) { return __hip_atomic_fetch_add(p, v, __ATOMIC_RELAXED, __HIP_MEMORY_SCOPE_AGENT); }
__device__ __forceinline__ unsigned xb_xcc_id() { return (unsigned)__builtin_amdgcn_s_getreg((3 << 11) | 20) & 0xFu; }
#define XB_SPIN(cond, bar) do { unsigned _sp = 0; while (cond) { __builtin_amdgcn_s_sleep(1); \
    if ((++_sp & 255u) == 0u) { if (xb_ld(&(bar)[XB_TMO])) break; if (_sp > XB_SPIN_CAP) { atomicAdd(&(bar)[XB_TMO], 1u); break; } } } } while (0)

struct XcdBarrier {
    unsigned* bar; unsigned x;
    volatile LAS unsigned* st;
};
__device__ __forceinline__ XcdBarrier xcd_barrier_post(unsigned* bar, volatile LAS unsigned* st) {
    XcdBarrier b; b.bar = bar; b.x = xb_xcc_id(); b.st = st;
    if (threadIdx.x == 0) (void)xb_add(&bar[XB_XCNT(b.x)], 1u);
    return b;
}
__device__ __forceinline__ void xcd_barrier_complete(unsigned* bar, unsigned x, unsigned& nloc, unsigned& nx) {
    const unsigned G = gridDim.x * gridDim.y * gridDim.z;
    unsigned sum, cnt, mine, sp = 0u;
    for (;;) {
        sum = 0u; cnt = 0u; mine = 0u;
#pragma unroll
        for (unsigned j = 0; j < 16; ++j) { const unsigned c = xb_ld(&bar[XB_XCNT(j)]); sum += c; cnt += (c > 0u) ? 1u : 0u; mine = (j == x) ? c : mine; }
        if (sum == G) break;
        __builtin_amdgcn_s_sleep(1);
        if ((++sp & 255u) == 0u) { if (xb_ld(&bar[XB_TMO])) break; if (sp > XB_SPIN_CAP) { atomicAdd(&bar[XB_TMO], 1u); break; } }
    }
    nloc = mine > 0u ? mine : 1u; nx = cnt > 0u ? cnt : 1u;
}
__device__ __forceinline__ void xcd_barrier(const XcdBarrier& b, const int tid) {
    asm volatile("s_waitcnt vmcnt(0)" ::: "memory");
    __syncthreads();
    if (tid == 0) {
        unsigned* bar = b.bar;
        __builtin_amdgcn_s_waitcnt(0);
        unsigned nloc = b.st[0], nx = b.st[1];
        if (nloc == 0u) { xcd_barrier_complete(bar, b.x, nloc, nx); b.st[0] = nloc; b.st[1] = nx; }
        const unsigned old = xb_add(&bar[XB_XSUB(b.x)], 1u);
        const unsigned gen = old / nloc;
        if (old + 1u == (gen + 1u) * nloc) {
            __builtin_amdgcn_fence(__ATOMIC_RELEASE, "agent");
            asm volatile("s_waitcnt vmcnt(0)" ::: "memory");
            const unsigned og = xb_add(&bar[XB_TOP], 1u);
            const unsigned tg = og / nx;
            if (og + 1u == (tg + 1u) * nx) xb_add(&bar[XB_TOPGEN], 1u);
            else XB_SPIN(xb_ld(&bar[XB_TOPGEN]) == tg, bar);
            __builtin_amdgcn_fence(__ATOMIC_ACQUIRE, "agent");
            xb_add(&bar[XB_XGEN(b.x)], 1u);
            asm volatile("s_waitcnt vmcnt(0)" ::: "memory");
        } else {
            XB_SPIN(xb_ld(&bar[XB_XGEN(b.x)]) == gen, bar);
            __builtin_amdgcn_fence(__ATOMIC_ACQUIRE, "agent");
            asm volatile("s_waitcnt vmcnt(0)" ::: "memory");
        }
    }
    __syncthreads();
}

constexpr int PT_OFF = LDSCTL_OFF;
constexpr int PT_OUT = 31, PT_WS = 32;
__device__ __forceinline__ const float* ldp(LAS unsigned char* lds, int i) {
    const unsigned long long v = *(volatile LAS unsigned long long*)(lds + PT_OFF + 8 * i);
    const unsigned lo = __builtin_amdgcn_readfirstlane((unsigned)v), hi = __builtin_amdgcn_readfirstlane((unsigned)(v >> 32));
    return (const float*)(((unsigned long long)hi << 32) | lo);
}

typedef f32x4 (&AccRef)[2][2][4][2];

__device__ __forceinline__ void row_decode(int row, int& kind, int& b, int& t) {
    if (row < MP) { kind = 0; b = row >> 12; t = row & 4095; }
    else if (row < MR) { kind = 1; b = (row - MP) >> 2; t = (row - MP) & 3; }
    else { kind = 2; b = 0; t = 0; }
}


typedef _Float16 h16x4 __attribute__((ext_vector_type(4)));
typedef _Float16 h16x8 __attribute__((ext_vector_type(8)));
constexpr size_t RAT_STRIDE = (size_t)MPAD * DM;

template <bool SK> __device__ __forceinline__ void scale_rows_rstd(AccRef acc, const unsigned long long* ss, int row0) {
#pragma unroll
    for (int ai = 0; ai < (SK ? 1 : 2); ++ai)
#pragma unroll
        for (int m = 0; m < (SK ? 2 : 4); ++m) {
            const float r = rsqrtf((float)ss[row0 + ai * 128 + m * 16] * (1.0f / (SS_FIX * DM)) + EPS);
#pragma unroll
            for (int bj = 0; bj < 2; ++bj)
#pragma unroll
                for (int n = 0; n < 2; ++n) acc[ai][bj][m][n] *= r;
        }
}

struct EpiSwiGLU {
    static constexpr bool PERM = false, AFTER_DRAIN = false, HAS_MID = false;
    unsigned char* ws; int nid;
    __device__ __forceinline__ void operator()(AccRef acc, const pg8::Unit& u, int wr, int wc, int fr, int fq) const { run<false>(acc, u, wr, wc, fr, fq); }
    template <bool SK> __device__ __forceinline__ void run(AccRef acc, const pg8::Unit& u, int wr, int wc, int fr_, int fq_) const {
        int fr = fr_, fq = fq_; asm volatile("" : "+v"(fr), "+v"(fq));
        bf16* H = (bf16*)(ws + WS_H);
        const int row0 = u.pm * 256 + wr * 64 + fr, col0 = u.pn * 128 + wc * 32 + 8 * fq;
        scale_rows_rstd<SK>(acc, (const unsigned long long*)(ws + WS_CTL + CTL_SS) + (size_t)nid * MPAD, row0);
#pragma unroll
        for (int ai = 0; ai < (SK ? 1 : 2); ++ai)
#pragma unroll
            for (int m = 0; m < (SK ? 2 : 4); ++m) {
                bf16* p = H + (size_t)(row0 + ai * 128 + m * 16) * DFF + col0;
                f32x4 h0, h1;
#pragma unroll
                for (int j = 0; j < 4; ++j) { h0[j] = siluf_(acc[ai][0][m][0][j]) * acc[ai][1][m][0][j]; h1[j] = siluf_(acc[ai][0][m][1][j]) * acc[ai][1][m][1][j]; }
                *(u32x4*)p = pk8(h0, h1);
            }
    }
};

struct EpiResid {
    static constexpr bool PERM = false, AFTER_DRAIN = false, HAS_MID = false;
    unsigned char* ws; LAS unsigned char* lds; float scale; int fin; int nid;
    __device__ __forceinline__ void operator()(AccRef acc, const pg8::Unit& u, int wr, int wc, int fr, int fq) const { run<false>(acc, u, wr, wc, fr, fq); }
    template <bool SK> __device__ __forceinline__ void run(AccRef acc, const pg8::Unit& u, int wr, int wc, int fr_, int fq_) const {
        int fr = fr_, fq = fq_; asm volatile("" : "+v"(fr), "+v"(fq));
        bf16* XB = (bf16*)(ws + WS_XN);
        unsigned long long* ssp = (unsigned long long*)(ws + WS_CTL + CTL_SS) + (size_t)(nid < 0 ? 0 : nid) * MPAD;
        float* out = fin ? (float*)ldp(lds, PT_OUT) : nullptr;
        const float scale = (u.ri == 0) ? this->scale : 0.f; const int nid = (u.ri == 0) ? this->nid : -1;
        const int row0 = u.pm * 256 + wr * 64 + fr, col0 = u.pn * 256 + wc * 32 + 8 * fq;
#pragma unroll
        for (int ai = 0; ai < (SK ? 1 : 2); ++ai)
#pragma unroll
            for (int m = 0; m < (SK ? 2 : 4); ++m) {
                const int row = row0 + ai * 128 + m * 16;
                bf16* xr = XB + (size_t)row * DM + col0;
                float sq = 0.f;
#pragma unroll
                for (int bj = 0; bj < 2; ++bj) {
                    float xo[8]; unpk8(*(const u32x4*)(xr + bj * 128), xo);
                    f32x4 v0, v1;
#pragma unroll
                    for (int j = 0; j < 4; ++j) { v0[j] = xo[j] + scale * acc[ai][bj][m][0][j]; v1[j] = xo[4 + j] + scale * acc[ai][bj][m][1][j]; }
                    if (out != nullptr && row < MR) { float* o = out + (size_t)row * DM + col0 + bj * 128; *(f32x4*)o = v0; *(f32x4*)(o + 4) = v1; }
                    const u32x4 w = pk8(v0, v1);
                    *(u32x4*)(xr + bj * 128) = w;
                    float xn[8]; unpk8(w, xn);
#pragma unroll
                    for (int j = 0; j < 8; ++j) sq += xn[j] * xn[j];
                }
                { const int ln = fq * 16 + fr; sq += shx(sq, 16, ln); sq += shx(sq, 32, ln); }
                if (nid >= 0 && fq == 0) atomicAdd(ssp + row, (unsigned long long)(sq * SS_FIX + 0.5f));
            }
    }
};

struct EpiMergeCat {
    static constexpr bool PERM = false, AFTER_DRAIN = false, HAS_MID = true;
    unsigned char* ws;
    __device__ __forceinline__ void apply(f32x4 (&acc)[2][2][4][2], const pg8::Unit& u, int s, int wr, int wc, int fr_, int fq_) const {
        int fr = fr_, fq = fq_; asm volatile("" : "+v"(fr), "+v"(fq));
        const _Float16* R = (const _Float16*)(ws + WS_GATE) + (size_t)s * RAT_STRIDE;
        const int row0 = u.pm * 256 + wr * 64 + fr, col0 = u.pn * 256 + wc * 32 + 8 * fq;
        h16x8 r[2][4][2];
#pragma unroll
        for (int ai = 0; ai < 2; ++ai)
#pragma unroll
            for (int m = 0; m < 4; ++m)
#pragma unroll
                for (int bj = 0; bj < 2; ++bj) r[ai][m][bj] = *(const h16x8*)(R + (size_t)(row0 + ai * 128 + m * 16) * DM + col0 + bj * 128);
#pragma unroll
        for (int ai = 0; ai < 2; ++ai)
#pragma unroll
            for (int m = 0; m < 4; ++m)
#pragma unroll
                for (int bj = 0; bj < 2; ++bj)
#pragma unroll
                    for (int j = 0; j < 4; ++j) { acc[ai][bj][m][0][j] *= (float)r[ai][m][bj][j]; acc[ai][bj][m][1][j] *= (float)r[ai][m][bj][4 + j]; }
    }
    __device__ __forceinline__ void mid(f32x4 (&acc)[2][2][4][2], const pg8::Unit& u, int t, int wr, int wc, int fr, int fq) const {
        apply(acc, u, (t == 8) ? 0 : (t == 12 ? 1 : 2), wr, wc, fr, fq);
    }
    __device__ __forceinline__ void operator()(AccRef acc, const pg8::Unit& u, int wr, int wc, int fr_, int fq_) const {
        apply(acc, u, 3, wr, wc, fr_, fq_);
        int fr = fr_, fq = fq_; asm volatile("" : "+v"(fr), "+v"(fq));
        bf16* MRG = (bf16*)(ws + WS_MRG);
        const int row0 = u.pm * 256 + wr * 64 + fr, col0 = u.pn * 256 + wc * 32 + 8 * fq;
#pragma unroll
        for (int ai = 0; ai < 2; ++ai)
#pragma unroll
            for (int m = 0; m < 4; ++m)
#pragma unroll
                for (int bj = 0; bj < 2; ++bj) *(u32x4*)(MRG + (size_t)(row0 + ai * 128 + m * 16) * DM + col0 + bj * 128) = pk8(acc[ai][bj][m][0], acc[ai][bj][m][1]);
    }
};
template <int MODE>
struct EpiMergeS {
    static constexpr bool PERM = false, AFTER_DRAIN = false, HAS_MID = false;
    unsigned char* ws; int br;
    template <bool SK> __device__ __forceinline__ void run(AccRef acc, const pg8::Unit& u, int wr, int wc, int fr, int fq) const {
        float* P = (float*)(ws + WS_PM); bf16* MRG = (bf16*)(ws + WS_MRG);
        const int row0 = u.pm * 256 + wr * 64 + fr, col0 = u.pn * 256 + wc * 32 + 8 * fq;
#pragma unroll
        for (int m = 0; m < 2; ++m) {
            const int row = row0 + m * 16;
#pragma unroll
            for (int bj = 0; bj < 2; ++bj) {
                const int c = col0 + bj * 128;
                float g[8];
                { const _Float16* R = (const _Float16*)(ws + WS_GATE) + (size_t)row * DM + c;
                  const h16x8 r3 = *(const h16x8*)(R + 3 * RAT_STRIDE);
#pragma unroll
                  for (int j = 0; j < 8; ++j) g[j] = (float)r3[j];
#pragma unroll
                  for (int s = 2; s >= 0; --s) if (s >= br) { const h16x8 rs = *(const h16x8*)(R + (size_t)s * RAT_STRIDE);
#pragma unroll
                      for (int j = 0; j < 8; ++j) g[j] *= (float)rs[j]; } }
                f32x4 v0, v1;
#pragma unroll
                for (int j = 0; j < 4; ++j) { v0[j] = g[j] * acc[0][bj][m][0][j]; v1[j] = g[4 + j] * acc[0][bj][m][1][j]; }
                float* pp = P + (size_t)(row - MP) * DM + c;
                if (MODE != 0) { v0 += *(const f32x4*)pp; v1 += *(const f32x4*)(pp + 4); }
                if (MODE == 2) *(u32x4*)(MRG + (size_t)row * DM + c) = pk8(v0, v1);
                else { *(f32x4*)pp = v0; *(f32x4*)(pp + 4) = v1; }
            }
        }
    }
};

struct EpiWin {
    static constexpr bool PERM = false, AFTER_DRAIN = false, HAS_MID = false;
    unsigned char* ws;
    const float *qgain, *kgain, *b_a;
    float* out; int layer; int nid;

    template <int ACT, bool SK>
    __device__ __forceinline__ void plain(AccRef acc, bf16* dst, int ldc, int cbase, int row0, int wc, int fq) const {
#pragma unroll
        for (int ai = 0; ai < (SK ? 1 : 2); ++ai)
#pragma unroll
            for (int m = 0; m < (SK ? 2 : 4); ++m) {
                bf16* p = dst + (size_t)(row0 + ai * 128 + m * 16) * ldc + cbase + wc * 32 + fq * 8;
#pragma unroll
                for (int bj = 0; bj < 2; ++bj) {
                    f32x4 v0 = acc[ai][bj][m][0], v1 = acc[ai][bj][m][1];
#pragma unroll
                    for (int j = 0; j < 4; ++j) {
                        if (ACT == 1) { v0[j] = sigmoidf_(v0[j]); v1[j] = sigmoidf_(v1[j]); }
                        if (ACT == 2) { v0[j] = siluf_(v0[j]); v1[j] = siluf_(v1[j]); }
                        if (ACT == 3) { v0[j] *= 0.125f; v1[j] *= 0.125f; }
                    }
                    *(u32x4*)(p + bj * 128) = pk8(v0, v1);
                }
            }
    }

    __device__ __forceinline__ void operator()(AccRef acc, const pg8::Unit& u, int wr, int wc, int fr, int fq) const { run<false>(acc, u, wr, wc, fr, fq); }
    template <bool SK> __device__ __forceinline__ void run(AccRef acc, const pg8::Unit& u, int wr, int wc, int fr_, int fq_) const {
        int fr = fr_, fq = fq_; asm volatile("" : "+v"(fr), "+v"(fq));
        const int pn = u.pn, row0 = u.pm * 256 + wr * 64 + fr, l = layer;
        scale_rows_rstd<SK>(acc, (const unsigned long long*)(ws + WS_CTL + CTL_SS) + (size_t)nid * MPAD, row0);
        if (pn < T_CB) {
            const int ch0 = 128 * pn + 32 * wc + 8 * fq;
#pragma unroll
            for (int ai = 0; ai < (SK ? 1 : 2); ++ai)
#pragma unroll
                for (int m = 0; m < (SK ? 2 : 4); ++m) {
                    const int row = row0 + ai * 128 + m * 16;
                    const f32x4 u0 = acc[ai][0][m][0] * acc[ai][1][m][0], u1 = acc[ai][0][m][1] * acc[ai][1][m][1];
                    *(u32x4*)((bf16*)(ws + WS_U) + (size_t)row * 512 + ch0) = pk8(u0, u1);
                    int kind, b, t; row_decode(row, kind, b, t);
                    if (kind == 0 && t >= SEQ - 2) { float* o = out + OFF_CONV_P + ((l * NB_P + b) * 2 + (t - (SEQ - 2))) * 512 + ch0; *(f32x4*)o = u0; *(f32x4*)(o + 4) = u1; }
                    if (kind == 1 && t >= TS - 2)  { float* o = out + OFF_CONV_S + ((l * NB_S + b) * 2 + (t - (TS - 2))) * 512 + ch0; *(f32x4*)o = u0; *(f32x4*)(o + 4) = u1; }
                }
        } else if (pn < T_Q) {
            plain<0, SK>(acc, (bf16*)(ws + WS_CB), 512, 256 * (pn - T_CB), row0, wc, fq);
        } else if (pn < T_V) {
            const bool isk = pn >= T_K; const int ti = isk ? pn - T_K : pn - T_Q; const int head = 4 * ti + wc;
            const float* gp = (isk ? kgain : qgain) + head * 64 + 8 * fq;
            f32x4 g[2][2];
#pragma unroll
            for (int bj = 0; bj < 2; ++bj) { g[bj][0] = *(const f32x4*)(gp + 32 * bj); g[bj][1] = *(const f32x4*)(gp + 32 * bj + 4); }
            bf16* dst = (bf16*)(ws + (isk ? WS_K : WS_Q));
            const int W = win_of(ti);
#pragma unroll
            for (int ai = 0; ai < (SK ? 1 : 2); ++ai)
#pragma unroll
                for (int m = 0; m < (SK ? 2 : 4); ++m) {
                    const int row = row0 + ai * 128 + m * 16;
                    float ss = 0.f;
#pragma unroll
                    for (int bj = 0; bj < 2; ++bj)
#pragma unroll
                        for (int n = 0; n < 2; ++n) { const f32x4 x = acc[ai][bj][m][n]; ss += (x[0] * x[0] + x[1] * x[1]) + (x[2] * x[2] + x[3] * x[3]); }
                    { const int ln = fq * 16 + fr; ss += shx(ss, 16, ln); ss += shx(ss, 32, ln); }
                    const float rs = rsqrtf(ss * (1.0f / 64.0f) + EPS);
                    int kind, b, t; row_decode(row, kind, b, t);
#pragma unroll
                    for (int bj = 0; bj < 2; ++bj) {
                        const f32x4 y0 = acc[ai][bj][m][0] * rs * g[bj][0], y1 = acc[ai][bj][m][1] * rs * g[bj][1];
                        *(u32x4*)(dst + (size_t)row * 768 + head * 64 + 32 * bj + 8 * fq) = pk8(y0, y1);
                        if (isk) {
                            const int e0 = 32 * bj + 8 * fq;
                            if (kind == 0 && t >= SEQ - W) { float* o = out + offw_p(ti) + ((((l * NB_P + b) * W + (t - (SEQ - W))) * 2 + 0) * 4 + wc) * 64 + e0; *(f32x4*)o = y0; *(f32x4*)(o + 4) = y1; }
                            if (kind == 1)                 { float* o = out + offw_s(ti) + ((((l * NB_S + b) * W + (W - TS + t)) * 2 + 0) * 4 + wc) * 64 + e0; *(f32x4*)o = y0; *(f32x4*)(o + 4) = y1; }
                        }
                    }
                }
        } else if (pn < T_GQ) {
            const int ti = pn - T_V;
            plain<0, SK>(acc, (bf16*)(ws + WS_V), 768, 256 * ti, row0, wc, fq);
            const int W = win_of(ti);
#pragma unroll
            for (int ai = 0; ai < (SK ? 1 : 2); ++ai)
#pragma unroll
                for (int m = 0; m < (SK ? 2 : 4); ++m) {
                    const int row = row0 + ai * 128 + m * 16;
                    int kind, b, t; row_decode(row, kind, b, t);
#pragma unroll
                    for (int bj = 0; bj < 2; ++bj) {
                        const int hh = 2 * bj + (wc >> 1), e0 = 32 * (wc & 1) + 8 * fq;
                        if (kind == 0 && t >= SEQ - W) { float* o = out + offw_p(ti) + ((((l * NB_P + b) * W + (t - (SEQ - W))) * 2 + 1) * 4 + hh) * 64 + e0; *(f32x4*)o = acc[ai][bj][m][0]; *(f32x4*)(o + 4) = acc[ai][bj][m][1]; }
                        if (kind == 1)                 { float* o = out + offw_s(ti) + ((((l * NB_S + b) * W + (W - TS + t)) * 2 + 1) * 4 + hh) * 64 + e0; *(f32x4*)o = acc[ai][bj][m][0]; *(f32x4*)(o + 4) = acc[ai][bj][m][1]; }
                    }
                }
        } else if (pn == T_GQ) {
            plain<3, SK>(acc, (bf16*)(ws + WS_GQ), 256, 0, row0, wc, fq);
        } else if (pn == T_GK) {
            plain<0, SK>(acc, (bf16*)(ws + WS_GK), 256, 0, row0, wc, fq);
        } else if (pn < T_GR) {
            plain<0, SK>(acc, (bf16*)(ws + WS_GV), 512, 256 * (pn - T_GV), row0, wc, fq);
        } else if (pn < T_Z) {
            plain<2, SK>(acc, (bf16*)(ws + WS_GR), 512, 256 * (pn - T_GR), row0, wc, fq);
        } else if (pn == T_Z) {
#pragma unroll
            for (int bj = 0; bj < 2; ++bj) {
                const int c0 = 128 * bj + 32 * wc + 8 * fq;
                const f32x4 b0 = *(const f32x4*)(b_a + c0), b1 = *(const f32x4*)(b_a + c0 + 4);
#pragma unroll
                for (int ai = 0; ai < (SK ? 1 : 2); ++ai)
#pragma unroll
                    for (int m = 0; m < (SK ? 2 : 4); ++m) {
                        const int row = row0 + ai * 128 + m * 16;
                        f32x4 z0 = acc[ai][bj][m][0] + b0, z1 = acc[ai][bj][m][1] + b1;
#pragma unroll
                        for (int j = 0; j < 4; ++j) {
                            z0[j] = (fminf(z0[j], 0.f) - __logf(1.0f + __expf(-fabsf(z0[j])))) * (1.0f / 16.0f);
                            z1[j] = (fminf(z1[j], 0.f) - __logf(1.0f + __expf(-fabsf(z1[j])))) * (1.0f / 16.0f);
                        }
                        float* o = (float*)(ws + WS_LA) + (size_t)row * 256 + c0; *(f32x4*)o = z0; *(f32x4*)(o + 4) = z1;
                    }
            }
        } else if (pn < T_GATE) {
            const int ti = pn - T_PIN;
            plain<0, SK>(acc, (bf16*)(ws + WS_PIN), 512, 256 * ti, row0, wc, fq);
#pragma unroll
            for (int ai = 0; ai < (SK ? 1 : 2); ++ai)
#pragma unroll
                for (int m = 0; m < (SK ? 2 : 4); ++m) {
                    const int row = row0 + ai * 128 + m * 16;
                    int kind, b, t; row_decode(row, kind, b, t);
#pragma unroll
                    for (int bj = 0; bj < 2; ++bj) {
                        const int c0 = 256 * ti + 128 * bj + 32 * wc + 8 * fq;
                        if (kind == 0 && t >= SEQ - 15) { float* o = out + OFF_POOL_P + ((l * NB_P + b) * 15 + (t - (SEQ - 15))) * 512 + c0; *(f32x4*)o = acc[ai][bj][m][0]; *(f32x4*)(o + 4) = acc[ai][bj][m][1]; }
                        if (kind == 1)                  { float* o = out + OFF_POOL_S + ((l * NB_S + b) * 15 + (15 - TS + t)) * 512 + c0; *(f32x4*)o = acc[ai][bj][m][0]; *(f32x4*)(o + 4) = acc[ai][bj][m][1]; }
                    }
                }
        } else {
            _Float16* R = (_Float16*)(ws + WS_GATE);
            const int c0 = 64 * (pn - T_GATE) + 16 * wc + 4 * fq;
#pragma unroll
            for (int ai = 0; ai < (SK ? 1 : 2); ++ai)
#pragma unroll
                for (int m = 0; m < (SK ? 2 : 4); ++m) {
                    const size_t o = (size_t)(row0 + ai * 128 + m * 16) * DM + c0;
                    h16x4 r0, r1, r2, r3;
#pragma unroll
                    for (int j = 0; j < 4; ++j) {
                        const float d0 = fminf(1.0f + __expf(-acc[ai][0][m][0][j]), 16384.f), d1 = fminf(1.0f + __expf(-acc[ai][0][m][1][j]), 16384.f);
                        const float d2 = fminf(1.0f + __expf(-acc[ai][1][m][0][j]), 16384.f), d3 = fminf(1.0f + __expf(-acc[ai][1][m][1][j]), 16384.f);
                        const float i0 = __builtin_amdgcn_rcpf(d0), i1 = __builtin_amdgcn_rcpf(d1), i2 = __builtin_amdgcn_rcpf(d2), i3 = __builtin_amdgcn_rcpf(d3);
                        r0[j] = (_Float16)fminf(d1 * i0, 65504.f); r1[j] = (_Float16)fminf(d2 * i1, 65504.f); r2[j] = (_Float16)fminf(d3 * i2, 65504.f); r3[j] = (_Float16)i3;
                    }
                    *(h16x4*)(R + o) = r0; *(h16x4*)(R + RAT_STRIDE + o) = r1; *(h16x4*)(R + 2 * RAT_STRIDE + o) = r2; *(h16x4*)(R + 3 * RAT_STRIDE + o) = r3;
                }
        }
    }
};

template <class Epi>
__device__ __forceinline__ void skinny_unit(LAS unsigned char* lds, const bf16* A, const bf16* Bt, int K, int su, const Epi E, int tid, int ld = 0) {
    if (ld == 0) ld = K;
    const int lane = tid & 63, w = __builtin_amdgcn_readfirstlane(tid >> 6), fr = lane & 15, g = lane >> 4;
    const int pn = su >> 2, wc = su & 3;
    const int nh = K >> 6, h0 = (w * nh) >> 3, h1 = ((w + 1) * nh) >> 3;
    f32x4 acc[2][2][2];
#pragma unroll
    for (int bj = 0; bj < 2; ++bj)
#pragma unroll
        for (int m = 0; m < 2; ++m)
#pragma unroll
            for (int n = 0; n < 2; ++n) acc[bj][m][n] = (f32x4){0.f, 0.f, 0.f, 0.f};
    const bf16* ap = A + (size_t)(MP + fr) * ld + 16 * g;
    const bf16* bp = Bt + (size_t)(256 * pn + 32 * wc + fr) * ld + 16 * g;
    for (int hc = h0; hc < h1; hc += 4) {
        bf16x8 a[4][2][2], b[4][2][2][2];
#pragma unroll
        for (int q = 0; q < 4; ++q) {
            const int hq = (hc + q < h1) ? hc + q : h1 - 1;
#pragma unroll
            for (int s = 0; s < 2; ++s) {
#pragma unroll
                for (int m = 0; m < 2; ++m) a[q][m][s] = *(const bf16x8*)(ap + (size_t)(16 * m) * ld + 64 * hq + 8 * s);
#pragma unroll
                for (int bj = 0; bj < 2; ++bj)
#pragma unroll
                    for (int n = 0; n < 2; ++n) b[q][bj][n][s] = *(const bf16x8*)(bp + (size_t)(128 * bj + 16 * n) * ld + 64 * hq + 8 * s);
            }
        }
#pragma unroll
        for (int q = 0; q < 4; ++q) {
            const bool ok = hc + q < h1;
#pragma unroll
            for (int s = 0; s < 2; ++s)
#pragma unroll
                for (int m = 0; m < 2; ++m) {
                    bf16x8 av = a[q][m][s];
                    if (!ok) av = (bf16x8){0, 0, 0, 0, 0, 0, 0, 0};
#pragma unroll
                    for (int bj = 0; bj < 2; ++bj)
#pragma unroll
                        for (int n = 0; n < 2; ++n) acc[bj][m][n] = __builtin_amdgcn_mfma_f32_16x16x32_bf16(b[q][bj][n][s], av, acc[bj][m][n], 0, 0, 0);
                }
        }
    }
    LAS f32x4* red = (LAS f32x4*)lds;
#pragma unroll
    for (int bj = 0; bj < 2; ++bj)
#pragma unroll
        for (int m = 0; m < 2; ++m)
#pragma unroll
            for (int n = 0; n < 2; ++n) red[(w * 8 + (bj * 4 + m * 2 + n)) * 64 + lane] = acc[bj][m][n];
    __syncthreads();
    if (w == 0) {
        f32x4 full[2][2][4][2];
#pragma unroll
        for (int bj = 0; bj < 2; ++bj)
#pragma unroll
            for (int m = 0; m < 2; ++m)
#pragma unroll
                for (int n = 0; n < 2; ++n) {
                    f32x4 s = red[(bj * 4 + m * 2 + n) * 64 + lane];
#pragma unroll
                    for (int ww = 1; ww < 8; ++ww) s += red[(ww * 8 + (bj * 4 + m * 2 + n)) * 64 + lane];
                    asm volatile("" : "+v"(s) :: "memory");
                    full[0][bj][m][n] = s;
                }
        pg8::Unit u; u.pm = MP / 256; u.pn = pn; u.ri = 0;
        E.template run<true>(full, u, 0, wc, fr, g);
    }
    __syncthreads();
}

__device__ __forceinline__ void skinny_merge_unit(LAS unsigned char* lds, unsigned char* ws, const bf16* Y, const bf16* U, int su, int tid) {
    const int lane = tid & 63, w = __builtin_amdgcn_readfirstlane(tid >> 6), fr = lane & 15, g = lane >> 4;
    const int pn = su >> 2, wc = su & 3;
    f32x4 acc[2][2][2];
#pragma unroll
    for (int bj = 0; bj < 2; ++bj)
#pragma unroll
        for (int m = 0; m < 2; ++m)
#pragma unroll
            for (int n = 0; n < 2; ++n) acc[bj][m][n] = (f32x4){0.f, 0.f, 0.f, 0.f};
    if (w < 7) {
        const bf16* ap = Y + (size_t)(MP + fr) * YK + 16 * g + 256 * w;
        const bf16* bp = U + (size_t)(256 * pn + 32 * wc + fr) * YK + 16 * g + 256 * w;
        bf16x8 a[4][2][2], b[4][2][2][2];
#pragma unroll
        for (int q = 0; q < 4; ++q)
#pragma unroll
            for (int s2 = 0; s2 < 2; ++s2) {
#pragma unroll
                for (int m = 0; m < 2; ++m) a[q][m][s2] = *(const bf16x8*)(ap + (size_t)(16 * m) * YK + 64 * q + 8 * s2);
#pragma unroll
                for (int bj = 0; bj < 2; ++bj)
#pragma unroll
                    for (int n = 0; n < 2; ++n) b[q][bj][n][s2] = *(const bf16x8*)(bp + (size_t)(128 * bj + 16 * n) * YK + 64 * q + 8 * s2);
            }
#pragma unroll
        for (int q = 0; q < 4; ++q)
#pragma unroll
            for (int s2 = 0; s2 < 2; ++s2)
#pragma unroll
                for (int m = 0; m < 2; ++m)
#pragma unroll
                    for (int bj = 0; bj < 2; ++bj)
#pragma unroll
                        for (int n = 0; n < 2; ++n) acc[bj][m][n] = __builtin_amdgcn_mfma_f32_16x16x32_bf16(b[q][bj][n][s2], a[q][m][s2], acc[bj][m][n], 0, 0, 0);
    }
    LAS f32x4* red = (LAS f32x4*)lds;
#pragma unroll
    for (int bj = 0; bj < 2; ++bj)
#pragma unroll
        for (int m = 0; m < 2; ++m)
#pragma unroll
            for (int n = 0; n < 2; ++n) red[(w * 8 + (bj * 4 + m * 2 + n)) * 64 + lane] = acc[bj][m][n];
    __syncthreads();
    if (w == 0) {
        bf16* MRG = (bf16*)(ws + WS_MRG);
        const int col0 = pn * 256 + wc * 32 + 8 * g;
#pragma unroll
        for (int m = 0; m < 2; ++m) {
            const int row = MP + 16 * m + fr;
#pragma unroll
            for (int bj = 0; bj < 2; ++bj) {
                const _Float16* R = (const _Float16*)(ws + WS_GATE) + (size_t)row * DM + col0 + bj * 128;
                const h16x8 r0 = *(const h16x8*)R, r1 = *(const h16x8*)(R + RAT_STRIDE), r2 = *(const h16x8*)(R + 2 * RAT_STRIDE), r3 = *(const h16x8*)(R + 3 * RAT_STRIDE);
                f32x4 o[2];
#pragma unroll
                for (int n = 0; n < 2; ++n) {
                    const int ti = bj * 4 + m * 2 + n;
                    const f32x4 pa = red[(0 * 8 + ti) * 64 + lane] + red[(1 * 8 + ti) * 64 + lane], pb = red[(2 * 8 + ti) * 64 + lane];
                    const f32x4 pc = red[(3 * 8 + ti) * 64 + lane] + red[(4 * 8 + ti) * 64 + lane], pd = red[(5 * 8 + ti) * 64 + lane] + red[(6 * 8 + ti) * 64 + lane];
#pragma unroll
                    for (int j = 0; j < 4; ++j) {
                        const float e3 = (float)r3[4 * n + j], e2 = (float)r2[4 * n + j] * e3, e1 = (float)r1[4 * n + j] * e2, e0 = (float)r0[4 * n + j] * e1;
                        o[n][j] = (e0 * pa[j] + e1 * pb[j]) + (e2 * pc[j] + e3 * pd[j]);
                    }
                }
                *(u32x4*)(MRG + (size_t)row * DM + col0 + bj * 128) = pk8(o[0], o[1]);
            }
        }
    }
    __syncthreads();
}

constexpr int IT_GU = 344 * 32, IT_D = 64 * 86, IT_IN = 448 * 32, IT_UPA = 64 * 8, IT_UPB = 64 * 4, IT_UPC = 64 * 8, IT_UPD = 64 * 8, IT_OUT = 64 * 32;
constexpr int IT_LAYER = 2 * IT_GU + 2 * IT_D + IT_IN + IT_UPA + IT_UPB + IT_UPC + IT_UPD + IT_OUT;
static_assert(IT_LAYER == 51200, "items per layer");

constexpr int PB_LAYER = 2 * 43 * 32 + 2 * 8 * 86 + 56 * 32 + 8 * 8 + 8 * 4 + 8 * 8 + 8 * 8 + 8 * 32;
static_assert(PB_LAYER == 6400, "blocks per layer");
constexpr int PB_P = 265;
constexpr int PB_PW_OFF = 69632;
struct BDesc { const float* src; const float* gain; bf16* dst; int ldw, K, kind, perm, aux0, aux1, aux2; };

__device__ __forceinline__ void pblk_decode(LAS unsigned char* lds, bf16* WB, int blk, int wave, int lane, BDesc& D) {
    const int l = blk / PB_LAYER; int r = blk % PB_LAYER;
    const int g = lane >> 3, c4 = lane & 7, bj = g >> 2, wc = g & 3;
    bf16* wl = WB + (size_t)l * WE_LAYER;
    const float* W; const float* gn = nullptr; int ldw, S0, k0, K, T, kind = 0, perm = 0, aux0 = 0; size_t woff;
    if (r < 2 * 1376) {
        const int f = r / 1376; r -= f * 1376; T = r % 43; const int kb = r / 43;
        const float* Wg = ldp(lds, f ? 28 : 9); const float* Wu = ldp(lds, f ? 29 : 10);
        W = (bj ? Wu : Wg) + (size_t)l * DM * DFF; ldw = DFF; S0 = 128 * T + 32 * wc; k0 = 64 * kb; K = DM; perm = 1; woff = f ? WE_GU2 : WE_GU1; gn = ldp(lds, f ? 27 : 8) + (size_t)l * DM;
    } else if ((r -= 2 * 1376) < 2 * 688) {
        const int f = r / 688; r -= f * 688; T = r % 8; const int kb = r / 8;
        W = ldp(lds, f ? 30 : 11) + (size_t)l * DFF * DM; ldw = DM; S0 = 256 * T + 32 * g; k0 = 64 * kb; K = DFF; perm = 1; woff = f ? WE_D2 : WE_D1;
    } else if ((r -= 2 * 688) < 1792) {
        T = r % 56; const int kb = r / 56, pn = T;
        W = ldp(lds, 13) + (size_t)l * DM * N_IN; ldw = N_IN; k0 = 64 * kb; K = DM; perm = 1; woff = WE_IN; gn = ldp(lds, 12) + (size_t)l * DM;
        if (pn == T_Z) { kind = 1; S0 = C_LR; }
        else if (pn < T_CB) S0 = (bj ? C_CH : C_CC) + 128 * pn + 32 * wc;
        else if (pn < T_Q) S0 = C_CB + 256 * (pn - T_CB) + 32 * g;
        else if (pn < T_K) S0 = C_AQ + 256 * (pn - T_Q) + 64 * wc + 32 * bj;
        else if (pn < T_V) S0 = C_AK + 256 * (pn - T_K) + 64 * wc + 32 * bj;
        else if (pn < T_GQ) S0 = C_AV + 256 * (pn - T_V) + 32 * g;
        else if (pn == T_GQ) S0 = C_GQ + 32 * g;
        else if (pn == T_GK) S0 = C_GK + 32 * g;
        else if (pn < T_GR) S0 = C_GV + 256 * (pn - T_GV) + 32 * g;
        else if (pn < T_Z) S0 = C_GR + 256 * (pn - T_GR) + 32 * g;
        else if (pn < T_GATE) S0 = C_PIN + 256 * (pn - T_PIN) + 32 * g;
        else { S0 = C_GATE + (2 * bj + (c4 >> 2)) * 2048 + 64 * (pn - T_GATE) + 16 * wc + 4 * (c4 & 3) - 4 * c4; perm = 0; }
    } else if ((r -= 1792) < 64) { T = r % 8; const int kb = r / 8; W = ldp(lds, 22) + (size_t)l * 512 * DM; ldw = DM; S0 = 256 * T + 32 * g; k0 = 64 * kb; K = YK; perm = 1; woff = WE_UPCAT + YO_A; }
    else if ((r -= 64) < 32) { T = r % 8; const int kb = r / 8; W = ldp(lds, 23) + (size_t)l * 256 * DM; ldw = DM; S0 = 256 * T + 32 * g; k0 = 64 * kb; K = YK; perm = 1; woff = WE_UPCAT + YO_B; }
    else if ((r -= 32) < 64) { T = r % 8; const int kb = r / 8; W = ldp(lds, 24) + (size_t)l * 512 * DM; ldw = DM; S0 = 256 * T + 32 * g; k0 = 64 * kb; K = YK; perm = 1; woff = WE_UPCAT + YO_C; }
    else if ((r -= 64) < 64) { T = r % 8; const int kb = r / 8; W = ldp(lds, 25) + (size_t)l * 512 * DM; ldw = DM; S0 = 256 * T; k0 = 64 * kb; K = YK; perm = 1; woff = WE_UPCAT + YO_D; kind = 2; aux0 = kb; }
    else { r -= 64; T = r % 8; const int kb = r / 8; W = ldp(lds, 26) + (size_t)l * DM * DM; ldw = DM; S0 = 256 * T + 32 * g; k0 = 64 * kb; K = DM; perm = 1; woff = WE_OUT; }
    if (kind == 0) D.src = W + (size_t)(k0 + 8 * wave) * ldw + S0 + 4 * c4;
    else D.src = W + (size_t)k0 * ldw + S0;
    D.gain = gn ? gn + k0 + 8 * wave : nullptr;
    D.dst = wl + woff + (size_t)(256 * T) * K + k0; D.ldw = ldw; D.K = K; D.kind = kind; D.perm = perm; D.aux0 = aux0; D.aux1 = l; D.aux2 = 0;
}
__device__ __forceinline__ void pblk_load(const BDesc& D, f32x4 (&v)[8]) {
    if (D.kind != 0) return;
#pragma unroll
    for (int i = 0; i < 8; ++i) v[i] = __builtin_nontemporal_load((const f32x4*)(D.src + (size_t)i * D.ldw));
}
__device__ __forceinline__ void pblk_writeout(LAS unsigned char* lds, bf16* dst, int K, int perm, int tid) {
    LAS float* tile = (LAS float*)(lds + RING_OFF);
    const int lane = tid & 63, wave = tid >> 6;
    LDS_WAIT(); __builtin_amdgcn_s_barrier(); asm volatile("" ::: "memory");
    const int c = lane & 7;
#pragma unroll
    for (int j = 0; j < 4; ++j) {
        const int rho = (lane >> 3) + 8 * j; const int cc = perm ? pg8::perm32(rho) : rho;
        const LAS float* s = tile + (8 * c) * PB_P + 33 * wave + cc;
        u32x4 o; o.x = pk2(s[0 * PB_P], s[1 * PB_P]); o.y = pk2(s[2 * PB_P], s[3 * PB_P]); o.z = pk2(s[4 * PB_P], s[5 * PB_P]); o.w = pk2(s[6 * PB_P], s[7 * PB_P]);
        *(u32x4*)(dst + (size_t)(32 * wave + rho) * K + 8 * c) = o;
    }
    LDS_WAIT(); __builtin_amdgcn_s_barrier(); asm volatile("" ::: "memory");
}
__device__ __forceinline__ void pblk_finish(LAS unsigned char* lds, const BDesc& D, const f32x4 (&v)[8], int tid) {
    if (D.kind != 0) return;
    LAS float* tile = (LAS float*)(lds + RING_OFF);
    const int lane = tid & 63, wave = tid >> 6;
    const int g = lane >> 3, c4 = lane & 7;
#pragma unroll
    for (int i = 0; i < 8; ++i) { const float gk = D.gain ? D.gain[i] : 1.0f; LAS float* s = tile + (8 * wave + i) * PB_P + 33 * g + 4 * c4; s[0] = v[i][0] * gk; s[1] = v[i][1] * gk; s[2] = v[i][2] * gk; s[3] = v[i][3] * gk; }
    pblk_writeout(lds, D.dst, D.K, D.perm, tid);
}
__device__ __forceinline__ void prologue_specials(LAS unsigned char* lds, bf16* WB, int bid, int G, int tid) {
    LAS float* tile = (LAS float*)(lds + RING_OFF);
#pragma unroll 1
    for (int s = bid; s < DEPTH * 96; s += G) {
        const int l = s / 96, r = s % 96;
        bf16* wl = WB + (size_t)l * WE_LAYER;
        if (r < 32) {
            const int kb = r;
            const float* A2 = ldp(lds, 17) + (size_t)l * 16 * 256; const float* gmix = ldp(lds, 12) + (size_t)l * DM;
            const float* Wk = ldp(lds, 13) + (size_t)l * DM * N_IN + (size_t)(64 * kb) * N_IN + C_LR;
            const int c = tid & 255, half = tid >> 8;
            float w2[16];
#pragma unroll
            for (int q = 0; q < 16; ++q) w2[q] = A2[q * 256 + c];
#pragma unroll 4
            for (int i = 0; i < 32; ++i) {
                const int kk = 32 * half + i;
                const f32x4* a = (const f32x4*)(Wk + (size_t)kk * N_IN);
                float sum = 0.f;
#pragma unroll
                for (int q = 0; q < 4; ++q) { const f32x4 av = a[q]; sum += av[0] * w2[4 * q] + av[1] * w2[4 * q + 1] + av[2] * w2[4 * q + 2] + av[3] * w2[4 * q + 3]; }
                tile[kk * PB_P + 33 * (c >> 5) + (c & 31)] = sum * gmix[64 * kb + kk];
            }
            pblk_writeout(lds, wl + WE_IN + (size_t)(256 * T_Z) * DM + 64 * kb, DM, 1, tid);
        } else {
            const int q = r - 32, T = q % 8, kb = q / 8, gg = kb >> 1, i0 = (kb & 1) * 64;
            LAS float* pw = (LAS float*)(lds + PB_PW_OFF);
            { const f32x4* src = (const f32x4*)(ldp(lds, 20) + ((size_t)l * 4 + gg) * 128 * 128 + (size_t)i0 * 128);
              for (int e = tid; e < 64 * 32; e += NTHR) ((LAS f32x4*)pw)[e] = src[e]; }
            LDS_WAIT(); __builtin_amdgcn_s_barrier(); asm volatile("" ::: "memory");
            const int n = tid & 255, half = tid >> 8;
            const float* SC = ldp(lds, 21) + (size_t)l * 512 + gg * 128;
            const float* UD = ldp(lds, 25) + (size_t)l * 512 * DM + (size_t)(gg * 128) * DM + 256 * T + n;
            float a[32];
#pragma unroll
            for (int j = 0; j < 32; ++j) a[j] = 0.f;
#pragma unroll 2
            for (int c = 0; c < 128; ++c) {
                const float uv = UD[(size_t)c * DM] * SC[c];
#pragma unroll
                for (int j = 0; j < 32; ++j) a[j] += pw[(32 * half + j) * 128 + c] * uv;
            }
#pragma unroll
            for (int j = 0; j < 32; ++j) tile[(32 * half + j) * PB_P + 33 * (n >> 5) + (n & 31)] = a[j];
            pblk_writeout(lds, wl + WE_UPCAT + YO_D + (size_t)(256 * T) * YK + 64 * kb, YK, 1, tid);
        }
    }
}
constexpr int DEFER_WG0 = 96, DEFER_WGS = 160, DEFER_PER_WG = 7, DEFER_N = DEFER_WGS * DEFER_PER_WG;
__device__ __forceinline__ bool pblk_deferred(int blk) {
    const int l = blk / PB_LAYER, r = blk % PB_LAYER;
    if (r < 1376) return l >= 1 && r < DEFER_N;
    if (r < 2 * 1376) return (r - 1376) < DEFER_N;
    return false;
}
__device__ __forceinline__ void prologue_blocks(LAS unsigned char* lds, bf16* WB, int first, int count, int start, int stride, int tid, bool skip_deferred) {
    const int lane = tid & 63, wave = __builtin_amdgcn_readfirstlane(tid >> 6);
    BDesc A, B, C; f32x4 va[8], vb[8], vc[8];
    int idx = start;
    if (idx >= count) return;
    pblk_decode(lds, WB, first + idx, wave, lane, A); if (skip_deferred && pblk_deferred(first + idx)) A.kind = 3; pblk_load(A, va);
    B = A;
#pragma unroll
    for (int i = 0; i < 8; ++i) vb[i] = va[i];
    if (idx + stride < count) { pblk_decode(lds, WB, first + idx + stride, wave, lane, B); if (skip_deferred && pblk_deferred(first + idx + stride)) B.kind = 3; pblk_load(B, vb); }
#pragma unroll 1
    for (;;) {
        const int nx2 = idx + 2 * stride;
        if (nx2 < count) { pblk_decode(lds, WB, first + nx2, wave, lane, C); if (skip_deferred && pblk_deferred(first + nx2)) C.kind = 3; pblk_load(C, vc); }
        pblk_finish(lds, A, va, tid);
        if (idx + stride >= count) break;
        idx += stride; A = B; B = C;
#pragma unroll
        for (int i = 0; i < 8; ++i) { va[i] = vb[i]; vb[i] = vc[i]; }
    }
}

__device__ __forceinline__ void x_init_pass(const float* xp, const float* xs, bf16* XB, unsigned long long* ss0, int gw, int NGW, int lane) {
    for (int row = gw; row < MPAD; row += NGW) {
        u32x2* o = (u32x2*)(XB + (size_t)row * DM) + lane;
        if (row >= MR) {
#pragma unroll
            for (int j = 0; j < 8; ++j) { u32x2 z; z.x = 0u; z.y = 0u; o[64 * j] = z; }
            continue;
        }
        const f32x4* xr = (const f32x4*)(row < MP ? xp + (size_t)row * DM : xs + (size_t)(row - MP) * DM) + lane;
        float ss = 0.f;
#pragma unroll
        for (int j = 0; j < 8; ++j) { const f32x4 v = xr[64 * j]; u32x2 w; w.x = pk2(v[0], v[1]); w.y = pk2(v[2], v[3]); o[64 * j] = w;
            const float a0 = bflo(w.x), a1 = bfhi(w.x), a2 = bflo(w.y), a3 = bfhi(w.y); ss += (a0 * a0 + a1 * a1) + (a2 * a2 + a3 * a3); }
        ss = wave_sum(ss, lane);
        if (lane == 0) ss0[row] = (unsigned long long)(ss * SS_FIX + 0.5f);
    }
}

constexpr int CC_N0 = DEPTH * NB_S * (128 - TS) * 128, CC_N1 = DEPTH * NB_S * (512 - TS) * 128, CC_N2 = DEPTH * NB_S * (2048 - TS) * 128, CACHE_COPY_N = CC_N0 + CC_N1 + CC_N2;
__device__ __forceinline__ void cache_copy_range(const float* c128, const float* c512, const float* c2048, float* out, int i0, int i1, int t, int nt) {
    for (int i = i0 + t; i < i1; i += nt) {
        int ii = i, gi = 0;
        if (ii >= CC_N0) { ii -= CC_N0; gi = 1; if (ii >= CC_N1) { ii -= CC_N1; gi = 2; } }
        const int W = win_of(gi), per = (W - TS) * 128, lb = ii / per, j = ii - lb * per;
        const f32x4* src = (const f32x4*)(gi == 0 ? c128 : (gi == 1 ? c512 : c2048)); f32x4* dst = (f32x4*)(out + offw_s(gi));
        __builtin_nontemporal_store(__builtin_nontemporal_load(src + (size_t)lb * W * 128 + TS * 128 + j), dst + (size_t)lb * W * 128 + j);
    }
}

__device__ __forceinline__ s16x4 ds_tr16(const LAS unsigned char* p) { return __builtin_amdgcn_ds_read_tr16_b64_v4i16((LAS s16x4*)p); }
__device__ __forceinline__ bf16x8 cat4(s16x4 a, s16x4 b) { bf16x8 r; r[0] = a[0]; r[1] = a[1]; r[2] = a[2]; r[3] = a[3]; r[4] = b[0]; r[5] = b[1]; r[6] = b[2]; r[7] = b[3]; return r; }
__device__ __forceinline__ bf16x8 pk8v(f32x4 a, f32x4 b) { const u32x4 w = pk8(a, b); return __builtin_bit_cast(bf16x8, w); }

constexpr int ATT_UNITS = NB_P * 12 * 32;
constexpr int ATT_PITCH = 144;
__device__ __forceinline__ void attn_unit(LAS unsigned char* lds, const bf16* Q, const bf16* K, const bf16* V, float* AO, float* LSE, int unit, int tid) {
    const int lane = tid & 63, w = tid >> 6, fr = lane & 15, g = lane >> 4;
    const int blk = unit & 31, bh = unit >> 5, h = bh % 12, b = bh / 12;
    const int gi = h >> 2, dl = dil_of(gi);
    const int r = blk % dl, nb = blk / dl;
    LAS unsigned char* Ks = lds; LAS unsigned char* Vs = lds + 256 * ATT_PITCH;
    for (int c = tid; c < 2048; c += NTHR) {
        const int ki = c >> 3, ch = c & 7, ksub = nb * 128 + ki - 128;
        u32x4 kv = {0u, 0u, 0u, 0u}, vv = {0u, 0u, 0u, 0u};
        if (ksub >= 0) { const size_t off = (size_t)(b * SEQ + r + dl * ksub) * 768 + h * 64 + ch * 8; kv = *(const u32x4*)(K + off); vv = *(const u32x4*)(V + off); }
        *(LAS u32x4*)(Ks + ki * ATT_PITCH + ch * 16) = kv; *(LAS u32x4*)(Vs + ki * ATT_PITCH + ch * 16) = vv;
    }
    __syncthreads();
    const int qi = 16 * w + fr;
    const int qtok = b * SEQ + r + dl * (nb * 128 + qi);
    const bf16x8 q0 = *(const bf16x8*)(Q + (size_t)qtok * 768 + h * 64 + 8 * g), q1 = *(const bf16x8*)(Q + (size_t)qtok * 768 + h * 64 + 32 + 8 * g);
    const int ks0 = w >> 1;
    f32x4 s[10];
#pragma unroll
    for (int tt = 0; tt < 10; ++tt) {
        const int T = 2 * ks0 + tt;
        const LAS unsigned char* kp = Ks + (16 * T + fr) * ATT_PITCH + 16 * g;
        const bf16x8 k0 = *(const LAS bf16x8*)kp, k1 = *(const LAS bf16x8*)(kp + 64);
        f32x4 a = {0.f, 0.f, 0.f, 0.f};
        a = __builtin_amdgcn_mfma_f32_16x16x32_bf16(k0, q0, a, 0, 0, 0);
        a = __builtin_amdgcn_mfma_f32_16x16x32_bf16(k1, q1, a, 0, 0, 0);
        s[tt] = a;
    }
    const float slope = exp2f(-8.0f * (float)(h + 1) / 12.0f) * (float)dl;
    float mx = -INFINITY;
#pragma unroll
    for (int tt = 0; tt < 10; ++tt)
#pragma unroll
        for (int j = 0; j < 4; ++j) {
            const int ki = 16 * (2 * ks0 + tt) + 4 * g + j, dist = qi - ki + 128, ksub = nb * 128 + ki - 128;
            const bool valid = (dist >= 0) && (dist <= 128) && (ksub >= 0);
            const float v = s[tt][j] * 0.125f - slope * (float)dist;
            s[tt][j] = valid ? v : -INFINITY;
            mx = fmaxf(mx, s[tt][j]);
        }
    mx = fmaxf(mx, shx(mx, 16, lane)); mx = fmaxf(mx, shx(mx, 32, lane));
    float ls = 0.f;
#pragma unroll
    for (int tt = 0; tt < 10; ++tt)
#pragma unroll
        for (int j = 0; j < 4; ++j) { const float p = __expf(s[tt][j] - mx); s[tt][j] = p; ls += p; }
    ls += shx(ls, 16, lane); ls += shx(ls, 32, lane);
    f32x4 o[4];
#pragma unroll
    for (int et = 0; et < 4; ++et) o[et] = (f32x4){0.f, 0.f, 0.f, 0.f};
    const int q4 = fr >> 2, p4 = fr & 3;
#pragma unroll
    for (int kk = 0; kk < 5; ++kk) {
        const bf16x8 pb = pk8v(s[2 * kk], s[2 * kk + 1]);
        const int rb = 32 * (ks0 + kk) + 4 * g + q4;
#pragma unroll
        for (int et = 0; et < 4; ++et) {
            const s16x4 v0 = ds_tr16(Vs + rb * ATT_PITCH + (16 * et + 4 * p4) * 2);
            const s16x4 v1 = ds_tr16(Vs + (rb + 16) * ATT_PITCH + (16 * et + 4 * p4) * 2);
            o[et] = __builtin_amdgcn_mfma_f32_16x16x32_bf16(cat4(v0, v1), pb, o[et], 0, 0, 0);
        }
    }
    const float inv = 1.0f / ls;
    float* ao = AO + (size_t)qtok * 768 + h * 64 + 4 * g;
#pragma unroll
    for (int et = 0; et < 4; ++et) *(f32x4*)(ao + 16 * et) = o[et] * inv;
    if (g == 0) LSE[(size_t)qtok * 12 + h] = mx + __logf(ls);
    __syncthreads();
}

__device__ __forceinline__ void attn_merge_pass(const float* AO, const float* LSE, bf16* YB, int gt, int NGT, int rep = 1) {
    for (int it0 = gt; it0 < rep * MR * 4 * 16; it0 += NGT) {
        const int it = it0 % (MR * 4 * 16);
        const int e4 = it & 15, slot = (it >> 4) & 3, tok = it >> 6;
        const float l0 = LSE[(size_t)tok * 12 + slot], l1 = LSE[(size_t)tok * 12 + 4 + slot], l2 = LSE[(size_t)tok * 12 + 8 + slot];
        const float m = fmaxf(l0, fmaxf(l1, l2));
        const float w0 = __expf(l0 - m), w1 = __expf(l1 - m), w2 = __expf(l2 - m), inv = 1.0f / (w0 + w1 + w2);
        const float* a = AO + (size_t)tok * 768 + slot * 64 + e4 * 4;
        const f32x4 y = (*(const f32x4*)a * w0 + *(const f32x4*)(a + 256) * w1 + *(const f32x4*)(a + 512) * w2) * inv;
        u32x2 wv; wv.x = pk2(y[0], y[1]); wv.y = pk2(y[2], y[3]);
        *(u32x2*)(YB + (size_t)tok * YK + YO_B + slot * 64 + e4 * 4) = wv;
    }
}

__device__ __forceinline__ float dot64_f32(const float (&q)[64], const float* k) {
    float s = 0.f;
#pragma unroll
    for (int c = 0; c < 16; ++c) { const f32x4 kv = ((const f32x4*)k)[c]; s += (q[4 * c] * kv[0] + q[4 * c + 1] * kv[1]) + (q[4 * c + 2] * kv[2] + q[4 * c + 3] * kv[3]); }
    return s;
}
__device__ __forceinline__ float dot64_bf(const float (&q)[64], const bf16* k) {
    float s = 0.f;
#pragma unroll
    for (int c = 0; c < 8; ++c) { const u32x4 w = ((const u32x4*)k)[c];
        s += (q[8 * c] * bflo(w.x) + q[8 * c + 1] * bfhi(w.x)) + (q[8 * c + 2] * bflo(w.y) + q[8 * c + 3] * bfhi(w.y)) + (q[8 * c + 4] * bflo(w.z) + q[8 * c + 5] * bfhi(w.z)) + (q[8 * c + 6] * bflo(w.w) + q[8 * c + 7] * bfhi(w.w)); }
    return s;
}
__device__ __forceinline__ void attn_sample_wave(const bf16* Q, const bf16* K, const bf16* V, const float* c128, const float* c512, const float* c2048, float* AO, float* LSE, int layer, int unit, int lane) {
    const int h = unit % 12, bt = unit / 12, t = bt & 3, b = bt >> 2;
    const int row = MP + b * TS + t;
    const int gi = h >> 2, slot = h & 3, dl = dil_of(gi), W = win_of(gi);
    const float* cache = (gi == 0 ? c128 : (gi == 1 ? c512 : c2048)) + (size_t)(layer * NB_S + b) * W * 512;
    float qf[64];
    { const u32x4* qp = (const u32x4*)(Q + (size_t)row * 768 + h * 64);
#pragma unroll
      for (int c = 0; c < 8; ++c) { const u32x4 w = qp[c]; qf[8 * c] = bflo(w.x) * 0.125f; qf[8 * c + 1] = bfhi(w.x) * 0.125f; qf[8 * c + 2] = bflo(w.y) * 0.125f; qf[8 * c + 3] = bfhi(w.y) * 0.125f;
          qf[8 * c + 4] = bflo(w.z) * 0.125f; qf[8 * c + 5] = bfhi(w.z) * 0.125f; qf[8 * c + 6] = bflo(w.w) * 0.125f; qf[8 * c + 7] = bfhi(w.w) * 0.125f; } }
    const float slope = exp2f(-8.0f * (float)(h + 1) / 12.0f) * (float)dl;
    float sc[3];
#pragma unroll
    for (int sj = 0; sj < 3; ++sj) {
        const int j = lane + 64 * sj;
        float d = -INFINITY;
        if (j <= 128) {
            const int idx = W + t - j * dl;
            if (idx >= W) d = dot64_bf(qf, K + (size_t)(MP + b * TS + (idx - W)) * 768 + h * 64);
            else d = dot64_f32(qf, cache + ((size_t)idx * 2 + 0) * 256 + slot * 64);
            d -= slope * (float)j;
        }
        sc[sj] = d;
    }
    const float mg = wave_max(fmaxf(sc[0], fmaxf(sc[1], sc[2])), lane);
    const float p0 = __expf(sc[0] - mg), p1 = __expf(sc[1] - mg), p2 = __expf(sc[2] - mg);
    const float lg = wave_sum(p0 + p1 + p2, lane);
    float acc = 0.f;
    const int jstart = (dl == 1) ? t + 1 : 1;
#pragma unroll 1
    for (int j = 0; j < jstart; ++j) acc += rdl(p0, j) * bf2f(V[(size_t)(MP + b * TS + (t - j * dl)) * 768 + h * 64 + lane]);
    const float* vbase = cache + 256 + slot * 64 + lane;
#pragma unroll 1
    for (int j0 = jstart; j0 <= 128; j0 += 32) {
        float vv[32];
#pragma unroll
        for (int i = 0; i < 32; ++i) { const int j = (j0 + i <= 128) ? j0 + i : 128; vv[i] = vbase[(size_t)(W + t - j * dl) * 512]; }
#pragma unroll
        for (int i = 0; i < 32; ++i) { const int j = j0 + i; const float pj = (j <= 128) ? rdl(j < 64 ? p0 : (j < 128 ? p1 : p2), j & 63) : 0.f; acc += pj * vv[i]; }
    }
    AO[(size_t)row * 768 + h * 64 + lane] = acc / lg;
    if (lane == 0) LSE[(size_t)row * 12 + h] = mg + __logf(lg);
}

__device__ __forceinline__ void conv_pool_pass(const bf16* CB, const bf16* U, const bf16* PIN, const float* conv_w, const float* st_conv, const float* st_pool, bf16* YA, bf16* YD, int layer, int gt, int NGT, int rep = 1) {
    for (int it0 = gt; it0 < rep * MPAD * 64; it0 += NGT) {
        const int it = it0 % (MPAD * 64); const int c8 = it & 63, row = it >> 6, ch = c8 * 8;
        int kind, b, t; row_decode(row, kind, b, t);
        if (kind == 2) { const u32x4 z = {0u, 0u, 0u, 0u}; *(u32x4*)(YA + (size_t)row * YK + YO_A + ch) = z; *(u32x4*)(YD + (size_t)row * YK + YO_D + ch) = z; continue; }
        float u0[8], u1[8], u2[8], cb[8];
        unpk8(*(const u32x4*)(U + (size_t)row * 512 + ch), u2);
        if (t >= 1) unpk8(*(const u32x4*)(U + (size_t)(row - 1) * 512 + ch), u1);
        else if (kind == 1) { const float* s = st_conv + ((size_t)(layer * NB_S + b) * 2 + 1) * 512 + ch; _Pragma("unroll") for (int j = 0; j < 8; ++j) u1[j] = s[j]; }
        else { _Pragma("unroll") for (int j = 0; j < 8; ++j) u1[j] = 0.f; }
        if (t >= 2) unpk8(*(const u32x4*)(U + (size_t)(row - 2) * 512 + ch), u0);
        else if (kind == 1) { const float* s = st_conv + ((size_t)(layer * NB_S + b) * 2 + t) * 512 + ch; _Pragma("unroll") for (int j = 0; j < 8; ++j) u0[j] = s[j]; }
        else { _Pragma("unroll") for (int j = 0; j < 8; ++j) u0[j] = 0.f; }
        unpk8(*(const u32x4*)(CB + (size_t)row * 512 + ch), cb);
        const float* cw = conv_w + (size_t)layer * 3 * 512 + ch;
        f32x4 ya0, ya1;
#pragma unroll
        for (int j = 0; j < 8; ++j) { const float z = cw[j] * u0[j] + cw[512 + j] * u1[j] + cw[1024 + j] * u2[j]; const float y = cb[j] * z; if (j < 4) ya0[j] = y; else ya1[j - 4] = y; }
        *(u32x4*)(YA + (size_t)row * YK + YO_A + ch) = pk8(ya0, ya1);
        const int grp = c8 >> 4, w = 2 << grp;
        float cur[8], sum[8];
        unpk8(*(const u32x4*)(PIN + (size_t)row * 512 + ch), cur);
#pragma unroll
        for (int j = 0; j < 8; ++j) sum[j] = cur[j];
        if (kind == 0) {
            u32x4 xr[15];
#pragma unroll
            for (int i = 1; i < 16; ++i) { const bool ok = (i < w) && (t - i >= 0); xr[i - 1] = *(const u32x4*)(PIN + (size_t)(ok ? row - i : row) * 512 + ch); }
#pragma unroll
            for (int i = 1; i < 16; ++i) { const bool ok = (i < w) && (t - i >= 0); float x[8]; unpk8(xr[i - 1], x); const float m = ok ? 1.f : 0.f;
#pragma unroll
                for (int j = 0; j < 8; ++j) sum[j] += m * x[j]; }
        } else {
            for (int i = 1; i < w; ++i) {
                const int tt = t - i;
                if (tt >= 0) { float x[8]; unpk8(*(const u32x4*)(PIN + (size_t)(row - i) * 512 + ch), x); _Pragma("unroll") for (int j = 0; j < 8; ++j) sum[j] += x[j]; }
                else { const float* s = st_pool + ((size_t)(layer * NB_S + b) * 15 + (15 + tt)) * 512 + ch; _Pragma("unroll") for (int j = 0; j < 8; ++j) sum[j] += s[j]; }
            }
        }
        const float cnt = (kind == 1) ? (float)w : fminf((float)w, (float)(t + 1));
        const float ic = 1.0f / cnt;
        f32x4 d0, d1;
#pragma unroll
        for (int j = 0; j < 8; ++j) { const float d = sum[j] * ic - cur[j]; if (j < 4) d0[j] = d; else d1[j - 4] = d; }
        *(u32x4*)(YD + (size_t)row * YK + YO_D + ch) = pk8(d0, d1);
    }
}

constexpr int GLA_UNITS = NB_P * 4 * 64;
constexpr int GP_K = 144, GP_V = 272;
constexpr int GLA_R0 = 0, GLA_R0_BYTES = 17408, GLA_QT = GLA_R0 + GLA_R0_BYTES, GLA_KT = GLA_QT + 64 * GP_K, GLA_VV = GLA_KT + 64 * GP_K, GLA_HALF = GLA_VV + 64 * GP_V;
static_assert(2 * GLA_HALF <= RING_BYTES, "GLA LDS");

__device__ __forceinline__ void gla_cumsum(LAS float* lb, const float* LA, int tok0, int h, int ht) {
    const int k = ht & 63, q = ht >> 6;
    float v[16]; float run = 0.f;
#pragma unroll
    for (int i = 0; i < 16; ++i) { run += LA[(size_t)(tok0 + 16 * q + i) * 256 + h * 64 + k]; v[i] = run; }
    LAS float* tot = lb + 4096;
    tot[q * 64 + k] = run;
    __syncthreads();
    float off = 0.f;
#pragma unroll
    for (int qq = 0; qq < 3; ++qq) off += (qq < q) ? tot[qq * 64 + k] : 0.f;
#pragma unroll
    for (int i = 0; i < 16; ++i) lb[(16 * q + i) * 64 + k] = v[i] + off;
    __syncthreads();
}

__device__ __forceinline__ void gla_ds_unit(LAS unsigned char* hl, const bf16* GK, const bf16* GV, const float* LA, float* DS, float* DEC, int unit, int ht) {
    const int n = unit & 63, bh = unit >> 6, h = bh & 3, b = bh >> 2;
    const int tok0 = b * SEQ + n * 64;
    const int lane = ht & 63, hw = ht >> 6, fr = lane & 15, g = lane >> 4;
    LAS float* lb = (LAS float*)(hl + GLA_R0);
    gla_cumsum(lb, LA, tok0, h, ht);
    for (int c = ht; c < 512; c += 256) {
        const int s = c >> 3, k0 = (c & 7) * 8;
        float kf[8]; unpk8(*(const u32x4*)(GK + (size_t)(tok0 + s) * 256 + h * 64 + k0), kf);
        f32x4 a0, a1;
#pragma unroll
        for (int j = 0; j < 8; ++j) { const float e = kf[j] * __expf(lb[63 * 64 + k0 + j] - lb[s * 64 + k0 + j]); if (j < 4) a0[j] = e; else a1[j - 4] = e; }
        *(LAS u32x4*)(hl + GLA_KT + s * GP_K + k0 * 2) = pk8(a0, a1);
    }
    for (int c = ht; c < 1024; c += 256) {
        const int s = c >> 4, v0 = (c & 15) * 8;
        *(LAS u32x4*)(hl + GLA_VV + s * GP_V + v0 * 2) = *(const u32x4*)(GV + (size_t)(tok0 + s) * 512 + h * 128 + v0);
    }
    if (ht < 64) DEC[(size_t)unit * 64 + ht] = __expf(lb[63 * 64 + ht]);
    __syncthreads();
    const int q4 = fr >> 2, p4 = fr & 3, kt = hw;
    float* dsb = DS + (size_t)unit * 64 * 128;
#pragma unroll
    for (int dvt = 0; dvt < 8; ++dvt) {
        f32x4 acc = {0.f, 0.f, 0.f, 0.f};
#pragma unroll
        for (int ks = 0; ks < 2; ++ks) {
            const int rb = 32 * ks + 4 * g + q4;
            const bf16x8 af = cat4(ds_tr16(hl + GLA_KT + rb * GP_K + (16 * kt + 4 * p4) * 2), ds_tr16(hl + GLA_KT + (rb + 16) * GP_K + (16 * kt + 4 * p4) * 2));
            const bf16x8 bf = cat4(ds_tr16(hl + GLA_VV + rb * GP_V + (16 * dvt + 4 * p4) * 2), ds_tr16(hl + GLA_VV + (rb + 16) * GP_V + (16 * dvt + 4 * p4) * 2));
            acc = __builtin_amdgcn_mfma_f32_16x16x32_bf16(af, bf, acc, 0, 0, 0);
        }
#pragma unroll
        for (int j = 0; j < 4; ++j) dsb[(size_t)(16 * kt + 4 * g + j) * 128 + 16 * dvt + fr] = acc[j];
    }
    __syncthreads();
}

__device__ __forceinline__ void gla_scan_pass(const float* DS, const float* DEC, bf16* SP, float* out, int layer, int gt, int rep = 1) {
    if (gt >= 8 * 64 * 128) return;
    for (int rr = 0; rr < rep; ++rr) {
    const int v = gt & 127, k = (gt >> 7) & 63, bh = gt >> 13;
    float S = 0.f;
    for (int n0 = 0; n0 < 64; n0 += 32) {
        float d[32], a[32];
#pragma unroll
        for (int i = 0; i < 32; ++i) { d[i] = DS[(((size_t)bh * 64 + n0 + i) * 64 + k) * 128 + v]; a[i] = DEC[((size_t)bh * 64 + n0 + i) * 64 + k]; }
#pragma unroll
        for (int i = 0; i < 32; ++i) { SP[(((size_t)bh * 64 + n0 + i) * 64 + k) * 128 + v] = (bf16)f2bf(S); S = a[i] * S + d[i]; }
    }
    out[OFF_GLA_P + (((size_t)layer * 8 + bh) * 64 + k) * 128 + v] = S;
    }
}

__device__ __forceinline__ void gla_out_unit(LAS unsigned char* hl, const bf16* GQ, const bf16* GK, const bf16* GV, const bf16* GR, const float* LA, const bf16* SP, const float* gnorm, bf16* YC, int unit, int ht) {
    const int n = unit & 63, bh = unit >> 6, h = bh & 3, b = bh >> 2;
    const int tok0 = b * SEQ + n * 64;
    const int lane = ht & 63, hw = ht >> 6, fr = lane & 15, g = lane >> 4;
    LAS float* lb = (LAS float*)(hl + GLA_R0);
    gla_cumsum(lb, LA, tok0, h, ht);
    for (int c = ht; c < 512; c += 256) {
        const int s = c >> 3, k0 = (c & 7) * 8;
        float qf[8], kf[8];
        unpk8(*(const u32x4*)(GQ + (size_t)(tok0 + s) * 256 + h * 64 + k0), qf);
        unpk8(*(const u32x4*)(GK + (size_t)(tok0 + s) * 256 + h * 64 + k0), kf);
        f32x4 a0, a1, c0, c1;
#pragma unroll
        for (int j = 0; j < 8; ++j) { const float bb = lb[s * 64 + k0 + j]; const float qe = qf[j] * __expf(bb), ke = kf[j] * __expf(-bb); if (j < 4) { a0[j] = qe; c0[j] = ke; } else { a1[j - 4] = qe; c1[j - 4] = ke; } }
        *(LAS u32x4*)(hl + GLA_QT + s * GP_K + k0 * 2) = pk8(a0, a1);
        *(LAS u32x4*)(hl + GLA_KT + s * GP_K + k0 * 2) = pk8(c0, c1);
    }
    for (int c = ht; c < 1024; c += 256) {
        const int s = c >> 4, v0 = (c & 15) * 8;
        *(LAS u32x4*)(hl + GLA_VV + s * GP_V + v0 * 2) = *(const u32x4*)(GV + (size_t)(tok0 + s) * 512 + h * 128 + v0);
    }
    __syncthreads();
    for (int c = ht; c < 1024; c += 256) {
        const int k = c >> 4, v0 = (c & 15) * 8;
        *(LAS u32x4*)(hl + GLA_R0 + k * GP_V + v0 * 2) = *(const u32x4*)(SP + ((size_t)unit * 64 + k) * 128 + v0);
    }
    __syncthreads();
    const int tt = hw, q4 = fr >> 2, p4 = fr & 3;
    f32x4 at[4];
    const LAS unsigned char* qrow = hl + GLA_QT + (16 * tt + fr) * GP_K;
    const bf16x8 qb0 = *(const LAS bf16x8*)(qrow + 16 * g), qb1 = *(const LAS bf16x8*)(qrow + 64 + 16 * g);
#pragma unroll
    for (int st = 0; st < 4; ++st) {
        const LAS unsigned char* krow = hl + GLA_KT + (16 * st + fr) * GP_K;
        f32x4 a = {0.f, 0.f, 0.f, 0.f};
        a = __builtin_amdgcn_mfma_f32_16x16x32_bf16(*(const LAS bf16x8*)(krow + 16 * g), qb0, a, 0, 0, 0);
        a = __builtin_amdgcn_mfma_f32_16x16x32_bf16(*(const LAS bf16x8*)(krow + 64 + 16 * g), qb1, a, 0, 0, 0);
#pragma unroll
        for (int j = 0; j < 4; ++j) { const int s = 16 * st + 4 * g + j, t = 16 * tt + fr; a[j] = (s <= t) ? a[j] : 0.f; }
        at[st] = a;
    }
    f32x4 o[8];
#pragma unroll
    for (int dvt = 0; dvt < 8; ++dvt) o[dvt] = (f32x4){0.f, 0.f, 0.f, 0.f};
#pragma unroll
    for (int ks = 0; ks < 2; ++ks) {
        const bf16x8 pb = pk8v(at[2 * ks], at[2 * ks + 1]);
        const int rb = 32 * ks + 4 * g + q4;
        const s16x4 qa = *(const LAS s16x4*)(qrow + (32 * ks + 4 * g) * 2), qc = *(const LAS s16x4*)(qrow + (32 * ks + 16 + 4 * g) * 2);
        const bf16x8 qp = cat4(qa, qc);
#pragma unroll
        for (int dvt = 0; dvt < 8; ++dvt) {
            const bf16x8 vf = cat4(ds_tr16(hl + GLA_VV + rb * GP_V + (16 * dvt + 4 * p4) * 2), ds_tr16(hl + GLA_VV + (rb + 16) * GP_V + (16 * dvt + 4 * p4) * 2));
            o[dvt] = __builtin_amdgcn_mfma_f32_16x16x32_bf16(vf, pb, o[dvt], 0, 0, 0);
            const bf16x8 sf = cat4(ds_tr16(hl + GLA_R0 + rb * GP_V + (16 * dvt + 4 * p4) * 2), ds_tr16(hl + GLA_R0 + (rb + 16) * GP_V + (16 * dvt + 4 * p4) * 2));
            o[dvt] = __builtin_amdgcn_mfma_f32_16x16x32_bf16(sf, qp, o[dvt], 0, 0, 0);
        }
    }
    float ss = 0.f;
#pragma unroll
    for (int dvt = 0; dvt < 8; ++dvt) ss += (o[dvt][0] * o[dvt][0] + o[dvt][1] * o[dvt][1]) + (o[dvt][2] * o[dvt][2] + o[dvt][3] * o[dvt][3]);
    ss += shx(ss, 16, lane); ss += shx(ss, 32, lane);
    const float rs = rsqrtf(ss * (1.0f / 128.0f) + EPS);
    const size_t orow = (size_t)(tok0 + 16 * tt + fr) * 512 + h * 128, yrow = (size_t)(tok0 + 16 * tt + fr) * YK + YO_C + h * 128;
#pragma unroll
    for (int dvt = 0; dvt < 8; ++dvt) {
        const int dv = 16 * dvt + 4 * g;
        const f32x4 gn = *(const f32x4*)(gnorm + dv);
        const u32x2 gw = *(const u32x2*)(GR + orow + dv);
        f32x4 y; y[0] = o[dvt][0] * rs * gn[0] * bflo(gw.x); y[1] = o[dvt][1] * rs * gn[1] * bfhi(gw.x); y[2] = o[dvt][2] * rs * gn[2] * bflo(gw.y); y[3] = o[dvt][3] * rs * gn[3] * bfhi(gw.y);
        u32x2 wv; wv.x = pk2(y[0], y[1]); wv.y = pk2(y[2], y[3]);
        *(u32x2*)(YC + yrow + dv) = wv;
    }
    __syncthreads();
}

__device__ __forceinline__ void gla_sample_unit(LAS float* red, const bf16* GQ, const bf16* GK, const bf16* GV, const bf16* GR, const float* LA, const float* st_gla, const float* gnorm, bf16* YC, float* out, int layer, int unit, int tid) {
    const int h = unit & 3, b = unit >> 2;
    const int dv = tid & 127, kq = tid >> 7;
    const float* s0 = st_gla + (((size_t)(layer * NB_S + b) * 4 + h) * 64 + 16 * kq) * 128 + dv;
    float S[16];
#pragma unroll
    for (int i = 0; i < 16; ++i) S[i] = s0[(size_t)i * 128];
#pragma unroll 1
    for (int t = 0; t < TS; ++t) {
        const int row = MP + b * TS + t;
        const float vv = bf2f(GV[(size_t)row * 512 + h * 128 + dv]);
        float po = 0.f;
#pragma unroll
        for (int i = 0; i < 16; ++i) {
            const int k = 16 * kq + i;
            const float a = __expf(LA[(size_t)row * 256 + h * 64 + k]);
            S[i] = a * S[i] + bf2f(GK[(size_t)row * 256 + h * 64 + k]) * vv;
            po += bf2f(GQ[(size_t)row * 256 + h * 64 + k]) * S[i];
        }
        red[kq * 128 + dv] = po;
        __syncthreads();
        float o = 0.f, sq = 0.f;
        if (kq == 0) { o = (red[dv] + red[128 + dv]) + (red[256 + dv] + red[384 + dv]); sq = o * o; }
        sq = wave_sum(sq, tid & 63);
        if (kq == 0 && (tid & 63) == 0) red[512 + (tid >> 6)] = sq;
        __syncthreads();
        if (kq == 0) {
            const float rs = rsqrtf((red[512] + red[513]) * (1.0f / 128.0f) + EPS);
            const float y = o * rs * gnorm[dv] * bf2f(GR[(size_t)row * 512 + h * 128 + dv]);
            YC[(size_t)row * YK + YO_C + h * 128 + dv] = (bf16)f2bf(y);
        }
        __syncthreads();
    }
    float* so = out + OFF_GLA_S + (((size_t)(layer * NB_S + b) * 4 + h) * 64 + 16 * kq) * 128 + dv;
#pragma unroll
    for (int i = 0; i < 16; ++i) so[(size_t)i * 128] = S[i];
}

constexpr int PH_PER_LAYER = 13, NPH = 1 + DEPTH * PH_PER_LAYER;
#define RM(bit) (1 + ((PROBE_DUP >> (bit)) & 1))
#define REP(bit) for (int rep_ = 0; rep_ < 1 + ((PROBE_DUP >> (bit)) & 1); ++rep_)
#ifndef PROBE_ALIGN_GU
#define PROBE_ALIGN_GU true
#endif
#ifndef PROBE_ALIGN_RES
#define PROBE_ALIGN_RES true
#endif
#ifndef PROBE_ALIGN_WIN
#define PROBE_ALIGN_WIN true
#endif
#ifndef MK_UNROLL_LAYERS
#define MK_UNROLL_LAYERS 1
#endif
#ifndef MK_PER_PHASE
#define MK_PER_PHASE 0
#endif

struct Args { const float* in[31]; float* out; unsigned char* ws; int ph_lo, ph_hi; };
static_assert(sizeof(Args) == 31 * 8 + 8 + 8 + 8, "Args has no padding");

__device__ __forceinline__ unsigned char* launder(unsigned char* p) { asm volatile("" : "+s"(p)); return p; }
__device__ __forceinline__ int opq_v(int x) { asm volatile("" : "+v"(x)); return x; }
__device__ __forceinline__ int opq_s(int x) { asm volatile("" : "+s"(x)); return x; }

#define IN(k) (lo <= (k) && (k) < hi)
#define SEAM(k) do { if (IN((k) + 1)) { XcdBarrier bar_; bar_.bar = (unsigned*)(WSP() + WS_CTL) + CW_BAR; bar_.x = xb_xcc_id(); bar_.st = (volatile LAS unsigned*)(lds + MISC_OFF) + 8; REP(13) xcd_barrier(bar_, tid); } } while (0)
#define GW (bid * NWAVES + wave)
#define NGW (G * NWAVES)
#define GT (bid * NTHR + tid)
#define NGT (G * NTHR)
#define WSP() launder((unsigned char*)ldp(lds, PT_WS))
#define IDS() const int wave = opq_s(wave0), lane = (int)__builtin_amdgcn_mbcnt_hi(~0u, __builtin_amdgcn_mbcnt_lo(~0u, (unsigned)opq_v(0))), tid = wave * 64 + lane, G = opq_s(G0), bid = opq_s(bid0); (void)lane; (void)wave; (void)G; (void)bid
struct Ctx { LAS unsigned char* lds; int tid0, wave0, G0, bid0, lo, hi; };
#define CTX_LOCALS() LAS unsigned char* lds = c.lds; const int tid0 = c.tid0, wave0 = c.wave0, G0 = c.G0, bid0 = c.bid0, lo = c.lo, hi = c.hi; (void)lds; (void)tid0; (void)wave0; (void)G0; (void)bid0; (void)lo; (void)hi

__device__ __forceinline__ void ff_part(const Ctx c, const int l, const int f) {
    CTX_LOCALS();
    const int pb = 1 + l * PH_PER_LAYER;
    const int fb = pb + (f ? 10 : 0);
    if (IN(fb + 1)) {
        { IDS(); unsigned char* ws = WSP(); const bf16* wl = (const bf16*)(ws + WS_W) + (size_t)l * WE_LAYER;
          pg8::Gemm g{(const bf16*)(ws + WS_XN), wl + (f ? WE_GU2 : WE_GU1), MP, NGU, DM}; pg8::StaticOrder S; S.init(MP, NGU, G, bid, RM(4));
          EpiSwiGLU E{ws, 3 * l + (f ? 2 : 0)};
          pg8::gemm_phase<EpiSwiGLU, pg8::StaticOrder, PROBE_ALIGN_GU, true>(lds + RING_OFF, g, S, E, tid); }
        { IDS(); unsigned char* ws = WSP(); const bf16* wl = (const bf16*)(ws + WS_W) + (size_t)l * WE_LAYER; EpiSwiGLU E{ws, 3 * l + (f ? 2 : 0)};
          for (int su = G - 1 - bid; su < RM(9) * (NGU / 64); su += G) skinny_unit<EpiSwiGLU>(lds + RING_OFF, (const bf16*)(ws + WS_XN), wl + (f ? WE_GU2 : WE_GU1), DM, su % (NGU / 64), E, tid); }
        { IDS(); unsigned char* ws = WSP();
          const int dfirst = (f == 0) ? l * PB_LAYER + 1376 : (l + 1) * PB_LAYER;
          if (G == 256 && bid >= DEFER_WG0 && (f == 0 || l < DEPTH - 1)) prologue_blocks(lds, (bf16*)(ws + WS_W), dfirst, DEFER_N, bid - DEFER_WG0, DEFER_WGS, tid, false);
          { const int slot = 2 * l + f; const int c0 = (int)((long)CACHE_COPY_N * slot / 10), c1 = (slot == 7) ? CACHE_COPY_N : (int)((long)CACHE_COPY_N * (slot + 1) / 10);
            if (G == 256) { if (bid >= DEFER_WG0) cache_copy_range(ldp(lds, 3), ldp(lds, 4), ldp(lds, 5), (float*)ldp(lds, PT_OUT), c0, c1, (bid - DEFER_WG0) * NTHR + tid, DEFER_WGS * NTHR); }
            else cache_copy_range(ldp(lds, 3), ldp(lds, 4), ldp(lds, 5), (float*)ldp(lds, PT_OUT), c0, c1, GT, NGT); } }
        IDS();
        SEAM(fb + 1);
    }
    if (IN(fb + 2)) {
        { IDS(); unsigned char* ws = WSP(); const bf16* wl = (const bf16*)(ws + WS_W) + (size_t)l * WE_LAYER;
          pg8::Gemm g{(const bf16*)(ws + WS_H), wl + (f ? WE_D2 : WE_D1), MP, DM, DFF}; pg8::StaticOrder S; S.init(MP, DM, G, bid, RM(10));
          EpiResid E{ws, lds, 0.5f, (f == 1 && l == DEPTH - 1) ? 1 : 0, (f == 0) ? 3 * l + 1 : (l < DEPTH - 1 ? 3 * l + 3 : -1)};
          pg8::gemm_phase<EpiResid, pg8::StaticOrder, PROBE_ALIGN_RES, true>(lds + RING_OFF, g, S, E, tid); }
        { IDS(); unsigned char* ws = WSP(); const bf16* wl = (const bf16*)(ws + WS_W) + (size_t)l * WE_LAYER; EpiResid E{ws, lds, 0.5f, (f == 1 && l == DEPTH - 1) ? 1 : 0, (f == 0) ? 3 * l + 1 : (l < DEPTH - 1 ? 3 * l + 3 : -1)};
          for (int su = G - 1 - bid; su < DM / 64; su += G) skinny_unit<EpiResid>(lds + RING_OFF, (const bf16*)(ws + WS_H), wl + (f ? WE_D2 : WE_D1), DFF, su, E, tid); }
        IDS();
        SEAM(fb + 2);
    }
}

__device__ __forceinline__ void mixer_part(const Ctx c, const int l) {
    CTX_LOCALS();
    const int pb = 1 + l * PH_PER_LAYER;
    if (IN(pb + 4)) {
        { IDS(); unsigned char* ws = WSP(); const bf16* wl = (const bf16*)(ws + WS_W) + (size_t)l * WE_LAYER;
          pg8::Gemm g{(const bf16*)(ws + WS_XN), wl + WE_IN, MP, NWIN, DM}; pg8::StaticOrder S; S.init(MP, NWIN, G, bid, RM(3));
          EpiWin E{ws, ldp(lds, 15) + (size_t)l * 768, ldp(lds, 16) + (size_t)l * 768, ldp(lds, 18) + (size_t)l * 256, (float*)ldp(lds, PT_OUT), l, 3 * l + 1};
          pg8::gemm_phase<EpiWin, pg8::StaticOrder, PROBE_ALIGN_WIN, true>(lds + RING_OFF, g, S, E, tid); }
        { IDS(); unsigned char* ws = WSP(); const bf16* wl = (const bf16*)(ws + WS_W) + (size_t)l * WE_LAYER;
          EpiWin E{ws, ldp(lds, 15) + (size_t)l * 768, ldp(lds, 16) + (size_t)l * 768, ldp(lds, 18) + (size_t)l * 256, (float*)ldp(lds, PT_OUT), l, 3 * l + 1};
          for (int su = G - 1 - bid; su < RM(9) * (NWIN / 64); su += G) skinny_unit<EpiWin>(lds + RING_OFF, (const bf16*)(ws + WS_XN), wl + WE_IN, DM, su % (NWIN / 64), E, tid); }
        IDS();
        SEAM(pb + 4);
    }
    if (IN(pb + 5)) {
        IDS();
        { unsigned char* ws = WSP();
          for (int u = bid; u < RM(1) * ATT_UNITS; u += G) attn_unit(lds, (const bf16*)(ws + WS_Q), (const bf16*)(ws + WS_K), (const bf16*)(ws + WS_V), (float*)(ws + WS_AO), (float*)(ws + WS_LSE), u % ATT_UNITS, tid); }
        { unsigned char* ws = WSP();
          for (int u2 = bid; u2 < RM(5) * (GLA_UNITS / 2); u2 += G) gla_ds_unit(lds + (tid >> 8) * GLA_HALF, (const bf16*)(ws + WS_GK), (const bf16*)(ws + WS_GV), (const float*)(ws + WS_LA), (float*)(ws + WS_DS), (float*)(ws + WS_DEC), 2 * (u2 % (GLA_UNITS / 2)) + (tid >> 8), tid & 255); }
        { unsigned char* ws = WSP();
          conv_pool_pass((const bf16*)(ws + WS_CB), (const bf16*)(ws + WS_U), (const bf16*)(ws + WS_PIN), ldp(lds, 14), ldp(lds, 2), ldp(lds, 7), (bf16*)(ws + WS_YCAT), (bf16*)(ws + WS_YCAT), l, GT, NGT, RM(6)); }
        REP(8) { const int su = (NGW - 1 - GW);
          if (su < NB_S * TS * 12) { unsigned char* ws = WSP(); attn_sample_wave((const bf16*)(ws + WS_Q), (const bf16*)(ws + WS_K), (const bf16*)(ws + WS_V), ldp(lds, 3), ldp(lds, 4), ldp(lds, 5), (float*)(ws + WS_AO), (float*)(ws + WS_LSE), l, su, lane); } }
        REP(8) { unsigned char* ws = WSP();
          for (int u = bid - 64; u >= 0 && u < NB_S * 4; u += G) gla_sample_unit((LAS float*)lds, (const bf16*)(ws + WS_GQ), (const bf16*)(ws + WS_GK), (const bf16*)(ws + WS_GV), (const bf16*)(ws + WS_GR), (const float*)(ws + WS_LA), ldp(lds, 6), ldp(lds, 19) + (size_t)l * 128, (bf16*)(ws + WS_YCAT), (float*)ldp(lds, PT_OUT), l, u, tid); }
        SEAM(pb + 5);
    }
    if (IN(pb + 6)) {
        IDS(); unsigned char* ws = WSP();
        gla_scan_pass((const float*)(ws + WS_DS), (const float*)(ws + WS_DEC), (bf16*)(ws + WS_SP), (float*)ldp(lds, PT_OUT), l, GT, RM(7));
        attn_merge_pass((const float*)(ws + WS_AO), (const float*)(ws + WS_LSE), (bf16*)(ws + WS_YCAT), GT, NGT, RM(7));
        SEAM(pb + 6);
    }
    if (IN(pb + 7)) {
        IDS(); unsigned char* ws = WSP();
        for (int u2 = bid; u2 < RM(5) * (GLA_UNITS / 2); u2 += G) gla_out_unit(lds + (tid >> 8) * GLA_HALF, (const bf16*)(ws + WS_GQ), (const bf16*)(ws + WS_GK), (const bf16*)(ws + WS_GV), (const bf16*)(ws + WS_GR), (const float*)(ws + WS_LA), (const bf16*)(ws + WS_SP), ldp(lds, 19) + (size_t)l * 128, (bf16*)(ws + WS_YCAT), 2 * (u2 % (GLA_UNITS / 2)) + (tid >> 8), tid & 255);
        SEAM(pb + 7);
    }
    if (IN(pb + 8)) {
        REP(11) {
        { IDS(); unsigned char* ws = WSP(); const bf16* wl = (const bf16*)(ws + WS_W) + (size_t)l * WE_LAYER; pg8::StaticOrder S; S.init(MP, DM, G, bid);
          pg8::Gemm g{(const bf16*)(ws + WS_YCAT), wl + WE_UPCAT, MP, DM, YK}; EpiMergeCat E{ws};
          pg8::gemm_phase<EpiMergeCat, pg8::StaticOrder, true, true>(lds + RING_OFF, g, S, E, tid); }
        { IDS(); unsigned char* ws = WSP(); const bf16* wl = (const bf16*)(ws + WS_W) + (size_t)l * WE_LAYER; const bf16* yc = (const bf16*)(ws + WS_YCAT); const bf16* uc = wl + WE_UPCAT;
          for (int su = G - 1 - bid; su < DM / 64; su += G) skinny_merge_unit(lds + RING_OFF, ws, yc, uc, su, tid); }
        }
        IDS();
        SEAM(pb + 8);
    }
    if (IN(pb + 9)) {
        { IDS(); unsigned char* ws = WSP(); const bf16* wl = (const bf16*)(ws + WS_W) + (size_t)l * WE_LAYER;
          pg8::Gemm g{(const bf16*)(ws + WS_MRG), wl + WE_OUT, MP, DM, DM}; pg8::StaticOrder S; S.init(MP, DM, G, bid, RM(12));
          EpiResid E{ws, lds, 1.0f, 0, 3 * l + 2};
#if (PROBE_DUP >> 14) & 1
          { pg8::Gemm g0{(const bf16*)(ws + WS_MRG), wl + WE_OUT, MP, DM, 256}; EpiResid E0{ws, lds, 0.0f, 0, -1};
            pg8::gemm_phase<EpiResid, pg8::StaticOrder, PROBE_ALIGN_RES, true>(lds + RING_OFF, g0, S, E0, tid); }
#endif
          pg8::gemm_phase<EpiResid, pg8::StaticOrder, PROBE_ALIGN_RES, true>(lds + RING_OFF, g, S, E, tid); }
        { IDS(); unsigned char* ws = WSP(); const bf16* wl = (const bf16*)(ws + WS_W) + (size_t)l * WE_LAYER; EpiResid E{ws, lds, 1.0f, 0, 3 * l + 2};
          for (int su = G - 1 - bid; su < DM / 64; su += G) skinny_unit<EpiResid>(lds + RING_OFF, (const bf16*)(ws + WS_MRG), wl + WE_OUT, DM, su, E, tid); }
        IDS();
        SEAM(pb + 9);
    }
}

__global__ void __launch_bounds__(NTHR, 2) fwd_kernel(Args args) {
    extern __shared__ __attribute__((aligned(16))) unsigned char lds_raw[];
    LAS unsigned char* lds = (LAS unsigned char*)lds_raw;
    const int tid0 = threadIdx.x; const int wave0 = __builtin_amdgcn_readfirstlane(tid0 >> 6);
    const int G0 = gridDim.x, bid0 = blockIdx.x;
    { const int tid = tid0; for (int u = tid; u < (LDS_BYTES - LDSCTL_OFF) / 4; u += NTHR) ((LAS unsigned*)(lds + LDSCTL_OFF))[u] = 0u; }
    __syncthreads();
    if (tid0 == 0) {
        LAS unsigned long long* pt = (LAS unsigned long long*)(lds + PT_OFF);
#pragma unroll
        for (int i = 0; i < 31; ++i) pt[i] = (unsigned long long)args.in[i];
        pt[PT_OUT] = (unsigned long long)args.out; pt[PT_WS] = (unsigned long long)args.ws;
    }
    __syncthreads();
    if (!MK_PER_PHASE) (void)xcd_barrier_post((unsigned*)(args.ws + WS_CTL) + CW_BAR, (volatile LAS unsigned*)(lds + MISC_OFF) + 8);
    const int lo = args.ph_lo, hi = args.ph_hi;

    if (IN(0)) {
        IDS(); unsigned char* ws = WSP(); float* out = (float*)ldp(lds, PT_OUT);
        REP(0) { prologue_blocks(lds, (bf16*)(ws + WS_W), 0, DEPTH * PB_LAYER, bid, G, tid, G == 256); prologue_specials(lds, (bf16*)(ws + WS_W), G - 1 - bid, G, tid); }
        x_init_pass(ldp(lds, 0), ldp(lds, 1), (bf16*)(ws + WS_XN), (unsigned long long*)(ws + WS_CTL + CTL_SS), GW, NGW, lane);
        { const f32x4* src = (const f32x4*)ldp(lds, 7); f32x4* dst = (f32x4*)(out + OFF_POOL_S); const int per = 11 * 128;
          for (int i = GT; i < DEPTH * NB_S * per; i += NGT) { const int lb = i / per, j = i - lb * per; dst[(size_t)lb * 15 * 128 + j] = src[(size_t)lb * 15 * 128 + 4 * 128 + j]; } }
        SEAM(0);
    }

    { Ctx c; c.lds = lds; c.tid0 = tid0; c.wave0 = wave0; c.G0 = G0; c.bid0 = bid0; c.lo = lo; c.hi = hi;
#if MK_UNROLL_LAYERS
      ff_part(c, 0, 0); mixer_part(c, 0); ff_part(c, 0, 1); ff_part(c, 1, 0); mixer_part(c, 1); ff_part(c, 1, 1);
      ff_part(c, 2, 0); mixer_part(c, 2); ff_part(c, 2, 1); ff_part(c, 3, 0); mixer_part(c, 3); ff_part(c, 3, 1);
#else
      _Pragma("unroll 1") for (int l = 0; l < DEPTH; ++l) {
          _Pragma("unroll 1") for (int f = 0; f < 2; ++f) { ff_part(c, l, f); if (f == 0) mixer_part(c, l); }
      }
#endif
    }
#undef IN
#undef SEAM
}

extern "C" void kernel_launch(void* const* d_in, const int* in_sizes, int n_in, void* d_out, int out_size, void* d_ws, size_t ws_size, hipStream_t stream) {
    static int grid = 0;
    if (grid == 0) {
        if (n_in != 31 || out_size != OUT_TOTAL || ws_size < WS_END) { fprintf(stderr, "kernel_launch: expected 31 inputs, %d outputs, >= %zu bytes ws; got %d, %d, %zu\n", OUT_TOTAL, (size_t)WS_END, n_in, out_size, ws_size); grid = -1; return; }
        int dev = 0, cus = 0, per_cu = 0;
        if (hipGetDevice(&dev) != hipSuccess || hipDeviceGetAttribute(&cus, hipDeviceAttributeMultiprocessorCount, dev) != hipSuccess) { grid = -1; return; }
        if (hipFuncSetAttribute((const void*)fwd_kernel, hipFuncAttributeMaxDynamicSharedMemorySize, LDS_BYTES) != hipSuccess) { fprintf(stderr, "kernel_launch: hipFuncSetAttribute failed\n"); grid = -1; return; }
        if (hipOccupancyMaxActiveBlocksPerMultiprocessor(&per_cu, (const void*)fwd_kernel, NTHR, LDS_BYTES) != hipSuccess || per_cu < 1) fprintf(stderr, "kernel_launch: occupancy query says %d\n", per_cu);
        (void)hipGetLastError();
        grid = cus;
    }
    if (grid < 0) return;
    if (hipMemsetAsync((char*)d_ws + WS_CTL, 0, CTL_ZERO_BYTES, stream) != hipSuccess) return;
    Args a; memset(&a, 0, sizeof(a));
    for (int i = 0; i < 31; ++i) a.in[i] = (const float*)d_in[i];
    a.out = (float*)d_out; a.ws = (unsigned char*)d_ws;
#if MK_PER_PHASE
    for (int ph = 0; ph < NPH; ++ph) { a.ph_lo = ph; a.ph_hi = ph + 1; hipLaunchKernelGGL(fwd_kernel, dim3(grid), dim3(NTHR), LDS_BYTES, stream, a); }
#else
    a.ph_lo = 0; a.ph_hi = NPH;
    hipLaunchKernelGGL(fwd_kernel, dim3(grid), dim3(NTHR), LDS_BYTES, stream, a);
#endif
    const hipError_t le = hipPeekAtLastError();
    if (le != hipSuccess) fprintf(stderr, "kernel_launch: launch failed: %s\n", hipGetErrorName(le));
}
```

```cpp
#include <hip/hip_runtime.h>
#include <cstdio>
#include <cstdint>
#include <cstring>
#ifndef PROBE_DUP
#define PROBE_DUP 0
#endif
namespace pg8 {
#define PG8_LAS __attribute__((address_space(3)))
typedef unsigned short bf16_t;
typedef short bf16x8 __attribute__((ext_vector_type(8)));
typedef float f32x4 __attribute__((ext_vector_type(4)));
typedef unsigned u32x4 __attribute__((ext_vector_type(4)));
constexpr int BM = 256, BK = 64, HALF = 128, HTB = HALF * BK * 2  , STAGE_BYTES = 8 * HTB, NXCD = 8, WGM = 8;

__host__ __device__ __forceinline__ int lds_byte(int r, int c) { const int st = (r >> 4) * 2 + (c >> 5), rr = r & 15, cc = c & 31, ob = rr * 64 + cc * 2; return st * 1024 + (ob ^ (((ob >> 9) & 1) << 5)); }
__host__ __device__ __forceinline__ void stage_rc(int b, int& R, int& C) { const int st = b / 1024, sb = b % 1024, swz = sb ^ (((sb >> 9) & 1) << 5); R = (st >> 1) * 16 + swz / 64; C = (st & 1) * 32 + (swz % 64) / 2; }
__host__ __device__ __forceinline__ int perm32(int rho) { const int n = rho >> 4, i = rho & 15; return 8 * (i >> 2) + 4 * n + (i & 3); }

struct Unit { int pm, pn, ri; };
struct Gemm { const bf16_t* A; const bf16_t* Bt; int M, N, K; };

struct StaticOrder {
    int nM, nN, nwg, G, c, rep;
    __host__ __device__ void init(int M, int N, int G_, int c_, int rep_ = 1) { nM = M / BM; nN = N / BM; nwg = nM * nN; G = G_; c = c_; rep = rep_; }
    __host__ __device__ bool next(int i, Unit& u) const {
        const long L = (long)i * G + c; if (L >= (long)rep * nwg) return false;
        int wgid = (int)(L % nwg);
#if (PROBE_DUP >> 15) & 1
        if (L >= nwg) wgid = 0;
#endif
        { const int q = nwg / NXCD, r = nwg % NXCD, xcd = wgid % NXCD, off = wgid / NXCD; wgid = (xcd < r ? xcd * (q + 1) : r * (q + 1) + (xcd - r) * q) + off; }
        const int nig = WGM * nN, gid = wgid / nig, fm = gid * WGM, gsz = (nM - fm) < WGM ? (nM - fm) : WGM;
        u.pm = fm + ((wgid % nig) % gsz); u.pn = (wgid % nig) / gsz; u.ri = (int)(L / nwg); return true;
    }
    __device__ __forceinline__ void a_ready(const Unit&) const {}
    __device__ __forceinline__ void done(const Unit&) const {}
};

template <class Epi, class Sched, bool ALIGN_EPI = false, bool SP2 = false>
__device__ __forceinline__ void gemm_phase(PG8_LAS unsigned char* lds, const Gemm g, const Sched S, const Epi E, const int tid) {
    const int wid = __builtin_amdgcn_readfirstlane(tid >> 6), lane = tid & 63, wr = wid >> 2, wc = wid & 3, fr = lane & 15, fq = lane >> 4;
    const int K = g.K, nt = K / BK;
    unsigned voffA[2], voffB[2];
#pragma unroll
    for (int i = 0; i < 2; ++i) { int R, C; stage_rc(tid * 16 + i * 8192, R, C); const int Rb = Epi::PERM ? ((R & ~31) + perm32(R & 31)) : R;
        voffA[i] = (unsigned)(R * K + C) * 2u; voffB[i] = (unsigned)(Rb * K + C) * 2u; }
    const size_t kstep = (size_t)(BK * 2);
    const size_t hstep = (size_t)HALF * K * 2;
    const size_t tstep = 2 * hstep;
    const unsigned ldsw = (unsigned)wid * 1024u;
    const int aoff = lds_byte(wr * 64 + fr, fq * 8), boff = lds_byte(wc * 32 + fr, fq * 8);
#define PG8_SA(b, h) (((b) * 2 + (h)) * HTB)
#define PG8_SB(b, h) ((4 + (b) * 2 + (h)) * HTB)
#define PG8_STAGE(bufoff, gbase, voff) do { _Pragma("unroll") for (int _i = 0; _i < 2; ++_i) \
        __builtin_amdgcn_global_load_lds((const unsigned*)((const char*)(gbase) + (voff)[_i]), (PG8_LAS unsigned*)(lds + (bufoff) + ldsw + _i * 8192), 16, 0, 0); } while (0)
#define PG8_LDA(dst, b, h) do { _Pragma("unroll") for (int m = 0; m < 4; ++m) _Pragma("unroll") for (int k = 0; k < 2; ++k) dst[m][k] = *(const PG8_LAS bf16x8*)(lds + PG8_SA(b, h) + aoff + m * 2048 + k * 1024); } while (0)
#define PG8_LDB(dst, b, h) do { _Pragma("unroll") for (int n = 0; n < 2; ++n) _Pragma("unroll") for (int k = 0; k < 2; ++k) dst[n][k] = *(const PG8_LAS bf16x8*)(lds + PG8_SB(b, h) + boff + n * 2048 + k * 1024); } while (0)
#define PG8_MMA(ai, bj, At, Bt) do { __builtin_amdgcn_s_setprio(1); _Pragma("unroll") for (int m = 0; m < 4; ++m) _Pragma("unroll") for (int n = 0; n < 2; ++n) _Pragma("unroll") for (int k = 0; k < 2; ++k) \
        acc[ai][bj][m][n] = __builtin_amdgcn_mfma_f32_16x16x32_bf16(Bt[n][k], At[m][k], acc[ai][bj][m][n], 0, 0, 0); __builtin_amdgcn_s_setprio(0); } while (0)
#define PG8_WAIT_V(n) asm volatile("s_waitcnt vmcnt(" #n ")" ::: "memory")
#define PG8_WAIT_L(n) asm volatile("s_waitcnt lgkmcnt(" #n ")" ::: "memory")
#define PG8_BAR __builtin_amdgcn_s_barrier()
#define PG8_SCHED __builtin_amdgcn_sched_barrier(0)
    Unit cur, nxt; int ui = 0;
    if (!S.next(0, cur)) return;
    f32x4 acc[2][2][4][2];
#pragma unroll
    for (int a = 0; a < 2; ++a)
#pragma unroll
        for (int b = 0; b < 2; ++b)
#pragma unroll
            for (int m = 0; m < 4; ++m)
#pragma unroll
                for (int n = 0; n < 2; ++n) acc[a][b][m][n] = (f32x4){0.f, 0.f, 0.f, 0.f};
    bf16x8 At[4][2], B0[2][2], B1[2][2];
    const char* cA = (const char*)g.A + (size_t)cur.pm * tstep; const char* cB = (const char*)g.Bt + (size_t)cur.pn * tstep;
    S.a_ready(cur);
    if constexpr (SP2) {
        PG8_STAGE(PG8_SB(0, 0), cB, voffB); PG8_STAGE(PG8_SB(0, 1), cB + hstep, voffB); PG8_STAGE(PG8_SA(0, 0), cA, voffA); PG8_STAGE(PG8_SA(0, 1), cA + hstep, voffA);
        if (wr == 1) PG8_BAR;
        PG8_WAIT_V(2); PG8_BAR;
        PG8_STAGE(PG8_SB(1, 0), cB + kstep, voffB); PG8_STAGE(PG8_SA(1, 0), cA + kstep, voffA); PG8_STAGE(PG8_SB(1, 1), cB + hstep + kstep, voffB);
        PG8_WAIT_V(6); PG8_BAR;
    } else {
        PG8_STAGE(PG8_SB(0, 0), cB, voffB); PG8_STAGE(PG8_SA(0, 0), cA, voffA); PG8_STAGE(PG8_SB(0, 1), cB + hstep, voffB); PG8_STAGE(PG8_SA(0, 1), cA + hstep, voffA);
        if (wr == 1) PG8_BAR;
        PG8_WAIT_V(4); PG8_BAR;
        PG8_STAGE(PG8_SB(1, 0), cB + kstep, voffB); PG8_STAGE(PG8_SA(1, 0), cA + kstep, voffA); PG8_STAGE(PG8_SB(1, 1), cB + hstep + kstep, voffB);
        PG8_WAIT_V(6); PG8_BAR;
    }
    for (;;) {
        const bool has_next = S.next(ui + 1, nxt);
        const char* nA = has_next ? (const char*)g.A + (size_t)nxt.pm * tstep : cA; const char* nB = has_next ? (const char*)g.Bt + (size_t)nxt.pn * tstep : cB;
        for (int t = 0; t < nt; t += 2) {
            const bool last = (t == nt - 2);
            const char* a1 = cA + (size_t)(t + 1) * kstep;
            const char* a2 = last ? nA : cA + (size_t)(t + 2) * kstep; const char* b2 = last ? nB : cB + (size_t)(t + 2) * kstep;
            const char* a3 = a2 + kstep; const char* b3 = b2 + kstep;
            if (last && has_next) S.a_ready(nxt);
            if constexpr (Epi::HAS_MID) { if (t == 8 || t == 12 || t == 20) E.mid(acc, cur, t, wr, wc, fr, fq); }
            if constexpr (SP2) {
            PG8_LDB(B0, 0, 0); PG8_LDB(B1, 0, 1); PG8_SCHED; PG8_LDA(At, 0, 0); PG8_STAGE(PG8_SA(1, 1), a1 + hstep, voffA);
            PG8_WAIT_V(8); PG8_WAIT_L(0); PG8_BAR; PG8_MMA(0, 0, At, B0); PG8_MMA(0, 1, At, B1); PG8_BAR; PG8_SCHED;
            PG8_LDA(At, 0, 1); PG8_STAGE(PG8_SB(0, 0), b2, voffB); PG8_STAGE(PG8_SB(0, 1), b2 + hstep, voffB); PG8_STAGE(PG8_SA(0, 0), a2, voffA);
            PG8_WAIT_V(8); PG8_WAIT_L(0); PG8_BAR; PG8_MMA(1, 0, At, B0); PG8_MMA(1, 1, At, B1); PG8_BAR; PG8_SCHED;
            PG8_LDB(B0, 1, 0); PG8_LDB(B1, 1, 1); PG8_SCHED; PG8_LDA(At, 1, 0); PG8_STAGE(PG8_SA(0, 1), a2 + hstep, voffA);
            PG8_WAIT_V(8); PG8_WAIT_L(0); PG8_BAR; PG8_MMA(0, 0, At, B0); PG8_MMA(0, 1, At, B1); PG8_BAR; PG8_SCHED;
            PG8_LDA(At, 1, 1); PG8_STAGE(PG8_SB(1, 0), b3, voffB); PG8_STAGE(PG8_SB(1, 1), b3 + hstep, voffB); PG8_STAGE(PG8_SA(1, 0), a3, voffA);
            PG8_WAIT_V(8); PG8_WAIT_L(0); PG8_BAR; PG8_MMA(1, 0, At, B0); PG8_MMA(1, 1, At, B1); PG8_BAR; PG8_SCHED;
            } else {
            PG8_LDB(B0, 0, 0); PG8_SCHED; PG8_LDA(At, 0, 0); PG8_STAGE(PG8_SA(1, 1), a1 + hstep, voffA);
            PG8_WAIT_L(8); PG8_BAR; PG8_WAIT_L(0); PG8_MMA(0, 0, At, B0); PG8_BAR; PG8_SCHED;
            PG8_LDB(B1, 0, 1); PG8_STAGE(PG8_SB(0, 0), b2, voffB);
            PG8_BAR; PG8_WAIT_L(0); PG8_MMA(0, 1, At, B1); PG8_BAR;
            PG8_LDA(At, 0, 1); PG8_STAGE(PG8_SA(0, 0), a2, voffA);
            PG8_BAR; PG8_WAIT_L(0); PG8_MMA(1, 0, At, B0); PG8_BAR; PG8_SCHED;
            PG8_STAGE(PG8_SB(0, 1), b2 + hstep, voffB);
            PG8_WAIT_V(6); PG8_BAR; PG8_MMA(1, 1, At, B1); PG8_BAR;
            PG8_LDB(B0, 1, 0); PG8_SCHED; PG8_LDA(At, 1, 0); PG8_STAGE(PG8_SA(0, 1), a2 + hstep, voffA);
            PG8_WAIT_L(8); PG8_BAR; PG8_WAIT_L(0); PG8_MMA(0, 0, At, B0); PG8_BAR; PG8_SCHED;
            PG8_LDB(B1, 1, 1); PG8_STAGE(PG8_SB(1, 0), b3, voffB);
            PG8_BAR; PG8_WAIT_L(0); PG8_MMA(0, 1, At, B1); PG8_BAR;
            PG8_LDA(At, 1, 1); PG8_STAGE(PG8_SA(1, 0), a3, voffA);
            PG8_BAR; PG8_WAIT_L(0); PG8_MMA(1, 0, At, B0); PG8_BAR; PG8_SCHED;
            PG8_STAGE(PG8_SB(1, 1), b3 + hstep, voffB);
            PG8_WAIT_V(6); PG8_BAR; PG8_MMA(1, 1, At, B1); PG8_BAR;
            }
        }
        if constexpr (ALIGN_EPI) { if (wr == 0) PG8_BAR; }
        if constexpr (!Epi::AFTER_DRAIN) { E(acc, cur, wr, wc, fr, fq); S.done(cur); }
        if (!has_next) break;
#pragma unroll
        for (int a = 0; a < 2; ++a)
#pragma unroll
            for (int b = 0; b < 2; ++b)
#pragma unroll
                for (int m = 0; m < 4; ++m)
#pragma unroll
                    for (int n = 0; n < 2; ++n) acc[a][b][m][n] = (f32x4){0.f, 0.f, 0.f, 0.f};
        cur = nxt; cA = nA; cB = nB; ++ui;
        if constexpr (ALIGN_EPI) { if (wr == 1) PG8_BAR; }
    }
    PG8_WAIT_V(0);
    if constexpr (!ALIGN_EPI) { if (wr == 0) PG8_BAR; }
    PG8_BAR;
    if constexpr (Epi::AFTER_DRAIN) { E.fused(acc, cur, wr, wc, fr, fq, lds, wid, lane); S.done(cur); }
#undef PG8_SA
#undef PG8_SB
#undef PG8_STAGE
#undef PG8_LDA
#undef PG8_LDB
#undef PG8_MMA
#undef PG8_WAIT_V
#undef PG8_WAIT_L
#undef PG8_BAR
#undef PG8_SCHED
}
}

constexpr int DM = 2048, DFF = 5504, DEPTH = 4;
constexpr int SEQ = 4096, NB_P = 2, MP = NB_P * SEQ;
constexpr int NB_S = 8, TS = 4, MS = NB_S * TS;
constexpr int MR = MP + MS;
constexpr int MPAD = 8448;
constexpr int PAST = 16384;
constexpr int N_IN = 14096, NWIN = 14336;
constexpr int NGU = 2 * DFF;
constexpr float EPS = 1e-6f;
constexpr int NWAVES = 8, NTHR = 512;

constexpr int C_CB = 0, C_CC = 512, C_CH = 1024, C_AQ = 1536, C_AK = 2304, C_AV = 3072, C_GQ = 3840, C_GK = 4096, C_GV = 4352, C_GR = 4864, C_LR = 5376, C_PIN = 5392, C_GATE = 5904;
constexpr int T_CONV = 0, T_CB = 4, T_Q = 6, T_K = 9, T_V = 12, T_GQ = 15, T_GK = 16, T_GV = 17, T_GR = 19, T_Z = 21, T_PIN = 22, T_GATE = 24;

constexpr int OFF_YP = 0;
constexpr int OFF_YS = OFF_YP + MP * DM;
constexpr int OFF_CONV_P = OFF_YS + MS * DM;
constexpr int OFF_CONV_S = OFF_CONV_P + DEPTH * NB_P * 2 * 512;
constexpr int OFF_W128_P = OFF_CONV_S + DEPTH * NB_S * 2 * 512;
constexpr int OFF_W128_S = OFF_W128_P + DEPTH * NB_P * 128 * 512;
constexpr int OFF_W512_P = OFF_W128_S + DEPTH * NB_S * 128 * 512;
constexpr int OFF_W512_S = OFF_W512_P + DEPTH * NB_P * 512 * 512;
constexpr int OFF_W2048_P = OFF_W512_S + DEPTH * NB_S * 512 * 512;
constexpr int OFF_W2048_S = OFF_W2048_P + DEPTH * NB_P * 2048 * 512;
constexpr int OFF_GLA_P = OFF_W2048_S + DEPTH * NB_S * 2048 * 512;
constexpr int OFF_GLA_S = OFF_GLA_P + DEPTH * NB_P * 4 * 64 * 128;
constexpr int OFF_POOL_P = OFF_GLA_S + DEPTH * NB_S * 4 * 64 * 128;
constexpr int OFF_POOL_S = OFF_POOL_P + DEPTH * NB_P * 15 * 512;
constexpr int OUT_TOTAL = OFF_POOL_S + DEPTH * NB_S * 15 * 512;
static_assert(OUT_TOTAL == 73551872, "output size");

constexpr size_t MiB = 1u << 20;
constexpr size_t WS_CTL = 0, CTL_ZERO_BYTES = 1 * MiB;
constexpr size_t SZ_ROW2K_F32 = (size_t)MPAD * DM * 4, SZ_ROW2K_BF = (size_t)MPAD * DM * 2;
constexpr size_t WS_X = WS_CTL + CTL_ZERO_BYTES;
constexpr size_t WS_XN = WS_X + SZ_ROW2K_F32;
constexpr size_t WS_H = WS_XN + SZ_ROW2K_BF;
constexpr size_t WS_CB = WS_H + (size_t)MPAD * DFF * 2;
constexpr size_t WS_U = WS_CB + (size_t)MPAD * 512 * 2;
constexpr size_t WS_Q = WS_U + (size_t)MPAD * 512 * 2;
constexpr size_t WS_K = WS_Q + (size_t)MPAD * 768 * 2;
constexpr size_t WS_V = WS_K + (size_t)MPAD * 768 * 2;
constexpr size_t WS_GQ = WS_V + (size_t)MPAD * 768 * 2;
constexpr size_t WS_GK = WS_GQ + (size_t)MPAD * 256 * 2;
constexpr size_t WS_GV = WS_GK + (size_t)MPAD * 256 * 2;
constexpr size_t WS_GR = WS_GV + (size_t)MPAD * 512 * 2;
constexpr size_t WS_LA = WS_GR + (size_t)MPAD * 512 * 2;
constexpr size_t WS_PIN = WS_LA + (size_t)MPAD * 256 * 4;
constexpr size_t WS_GATE = WS_PIN + (size_t)MPAD * 512 * 2;
constexpr int YK = 1792, YO_A = 0, YO_B = 512, YO_C = 768, YO_D = 1280;
constexpr size_t WS_YCAT = WS_GATE + (size_t)MPAD * 8192 * 2;
constexpr size_t WS_AO = WS_YCAT + (size_t)MPAD * YK * 2;
constexpr size_t WS_LSE = WS_AO + (size_t)MPAD * 768 * 4;
constexpr size_t WS_DS = WS_LSE + (size_t)MPAD * 12 * 4;
constexpr size_t WS_DEC = WS_DS + (size_t)8 * 64 * 64 * 128 * 4;
constexpr size_t WS_SP = WS_DEC + (size_t)8 * 64 * 64 * 4;
constexpr size_t WS_PM = WS_SP + (size_t)8 * 64 * 64 * 128 * 2;
constexpr size_t WS_MRG = WS_PM + (size_t)(MPAD - MP) * DM * 4;
constexpr size_t WS_W = WS_MRG + SZ_ROW2K_BF;
constexpr size_t WE_GU1 = 0;
constexpr size_t WE_D1 = WE_GU1 + (size_t)NGU * DM;
constexpr size_t WE_IN = WE_D1 + (size_t)DM * DFF;
constexpr size_t WE_UPCAT = WE_IN + (size_t)NWIN * DM;
constexpr size_t WE_OUT = WE_UPCAT + (size_t)DM * YK;
constexpr size_t WE_GU2 = WE_OUT + (size_t)DM * DM;
constexpr size_t WE_D2 = WE_GU2 + (size_t)NGU * DM;
constexpr size_t WE_LAYER = WE_D2 + (size_t)DM * DFF;
static_assert(WE_LAYER == 104857600, "layer weights");
constexpr size_t WS_END = WS_W + (size_t)DEPTH * WE_LAYER * 2;
static_assert(WS_X % 256 == 0 && WS_W % 256 == 0 && WS_LSE % 256 == 0 && WS_DS % 256 == 0, "alignment");

constexpr int CW_BAR = 4096;
constexpr size_t CTL_SS = 65536;
constexpr float SS_FIX = 16777216.0f;
static_assert(CTL_SS + 12 * (size_t)MPAD * 8 <= CTL_ZERO_BYTES, "SS fits the zeroed control region");

constexpr int RING_OFF = 0, RING_BYTES = 131072;
constexpr int LDSCTL_OFF = RING_BYTES, MISC_OFF = LDSCTL_OFF + 320;
constexpr int LDS_BYTES = 147456;

#define GAS __attribute__((address_space(1)))
#define LAS __attribute__((address_space(3)))
typedef unsigned short bf16;
typedef unsigned u32x4 __attribute__((ext_vector_type(4)));
typedef unsigned u32x2 __attribute__((ext_vector_type(2)));
typedef float f32x4 __attribute__((ext_vector_type(4)));
typedef float f32x2 __attribute__((ext_vector_type(2)));
typedef short bf16x8 __attribute__((ext_vector_type(8)));
typedef short s16x4 __attribute__((ext_vector_type(4)));
#define LDS_WAIT() asm volatile("s_waitcnt lgkmcnt(0)" ::: "memory")
#define VM_WAIT() asm volatile("s_waitcnt vmcnt(0)" ::: "memory")
__device__ __forceinline__ unsigned f2bf(float f) { unsigned u = __builtin_bit_cast(unsigned, f); return (u + 0x7fffu + ((u >> 16) & 1u)) >> 16; }
__device__ __forceinline__ unsigned pk2(float lo, float hi) { return f2bf(lo) | (f2bf(hi) << 16); }
__device__ __forceinline__ float bflo(unsigned w) { return __builtin_bit_cast(float, w << 16); }
__device__ __forceinline__ float bfhi(unsigned w) { return __builtin_bit_cast(float, w & 0xffff0000u); }
__device__ __forceinline__ float bf2f(bf16 b) { return __builtin_bit_cast(float, ((unsigned)b) << 16); }
__device__ __forceinline__ u32x4 pk8(f32x4 a, f32x4 b) { u32x4 w; w.x = pk2(a[0], a[1]); w.y = pk2(a[2], a[3]); w.z = pk2(b[0], b[1]); w.w = pk2(b[2], b[3]); return w; }
__device__ __forceinline__ void unpk8(u32x4 w, float (&f)[8]) { f[0] = bflo(w.x); f[1] = bfhi(w.x); f[2] = bflo(w.y); f[3] = bfhi(w.y); f[4] = bflo(w.z); f[5] = bfhi(w.z); f[6] = bflo(w.w); f[7] = bfhi(w.w); }
__device__ __forceinline__ float sigmoidf_(float x) { return __builtin_amdgcn_rcpf(1.0f + __expf(-x)); }
__device__ __forceinline__ float siluf_(float x) { return x * sigmoidf_(x); }
__device__ __forceinline__ float shx(float v, int m, int lane) { return __builtin_bit_cast(float, __builtin_amdgcn_ds_bpermute((lane ^ m) << 2, __builtin_bit_cast(int, v))); }
__device__ __forceinline__ float rdl(float v, int j) { return __builtin_bit_cast(float, __builtin_amdgcn_readlane(__builtin_bit_cast(int, v), j)); }
__device__ __forceinline__ float wave_sum(float v, int lane) {
#pragma unroll
    for (int o = 1; o < 64; o <<= 1) v += shx(v, o, lane);
    return v;
}
__device__ __forceinline__ float wave_max(float v, int lane) {
#pragma unroll
    for (int o = 1; o < 64; o <<= 1) v = fmaxf(v, shx(v, o, lane));
    return v;
}
__device__ __forceinline__ int win_of(int gi) { return 128 << (2 * gi); }
__device__ __forceinline__ int dil_of(int gi) { return 1 << (2 * gi); }
__device__ __forceinline__ int offw_p(int gi) { return gi == 0 ? OFF_W128_P : (gi == 1 ? OFF_W512_P : OFF_W2048_P); }
__device__ __forceinline__ int offw_s(int gi) { return gi == 0 ? OFF_W128_S : (gi == 1 ? OFF_W512_S : OFF_W2048_S); }

#define XB_TMO      128
#define XB_XCNT(j)  (256  + 64 * (j))
#define XB_XSUB(j)  (1280 + 64 * (j))
#define XB_XGEN(j)  (2304 + 64 * (j))
#define XB_TOP      3328
#define XB_TOPGEN   3392
#define XCD_BAR_WORDS 3456
#define XB_SPIN_CAP (1u << 18)

__device__ __forceinline__ unsigned xb_ld(unsigned* p)              { return __hip_atomic_load(p, __ATOMIC_RELAXED, __HIP_MEMORY_SCOPE_AGENT); }
__device__ __forceinline__ unsigned xb_add(unsigned* p, unsigned v) { return __hip_atomic_fetch_add(p, v, __ATOMIC_RELAXED, __HIP_MEMORY_SCOPE_AGENT); }
__device__ __forceinline__ unsigned xb_xcc_id() { return (unsigned)__builtin_amdgcn_s_getreg((3 << 11) | 20) & 0xFu; }
#define XB_SPIN(cond, bar) do { unsigned _sp = 0; while (cond) { __builtin_amdgcn_s_sleep(1); \
    if ((++_sp & 255u) == 0u) { if (xb_ld(&(bar)[XB_TMO])) break; if (_sp > XB_SPIN_CAP) { atomicAdd(&(bar)[XB_TMO], 1u); break; } } } } while (0)

struct XcdBarrier {
    unsigned* bar; unsigned x;
    volatile LAS unsigned* st;
};
__device__ __forceinline__ XcdBarrier xcd_barrier_post(unsigned* bar, volatile LAS unsigned* st) {
    XcdBarrier b; b.bar = bar; b.x = xb_xcc_id(); b.st = st;
    if (threadIdx.x == 0) (void)xb_add(&bar[XB_XCNT(b.x)], 1u);
    return b;
}
__device__ __forceinline__ void xcd_barrier_complete(unsigned* bar, unsigned x, unsigned& nloc, unsigned& nx) {
    const unsigned G = gridDim.x * gridDim.y * gridDim.z;
    unsigned sum, cnt, mine, sp = 0u;
    for (;;) {
        sum = 0u; cnt = 0u; mine = 0u;
#pragma unroll
        for (unsigned j = 0; j < 16; ++j) { const unsigned c = xb_ld(&bar[XB_XCNT(j)]); sum += c; cnt += (c > 0u) ? 1u : 0u; mine = (j == x) ? c : mine; }
        if (sum == G) break;
        __builtin_amdgcn_s_sleep(1);
        if ((++sp & 255u) == 0u) { if (xb_ld(&bar[XB_TMO])) break; if (sp > XB_SPIN_CAP) { atomicAdd(&bar[XB_TMO], 1u); break; } }
    }
    nloc = mine > 0u ? mine : 1u; nx = cnt > 0u ? cnt : 1u;
}
__device__ __forceinline__ void xcd_barrier(const XcdBarrier& b, const int tid) {
    asm volatile("s_waitcnt vmcnt(0)" ::: "memory");
    __syncthreads();
    if (tid == 0) {
        unsigned* bar = b.bar;
        __builtin_amdgcn_s_waitcnt(0);
        unsigned nloc = b.st[0], nx = b.st[1];
        if (nloc == 0u) { xcd_barrier_complete(bar, b.x, nloc, nx); b.st[0] = nloc; b.st[1] = nx; }
        const unsigned old = xb_add(&bar[XB_XSUB(b.x)], 1u);
        const unsigned gen = old / nloc;
        if (old + 1u == (gen + 1u) * nloc) {
            __builtin_amdgcn_fence(__ATOMIC_RELEASE, "agent");
            asm volatile("s_waitcnt vmcnt(0)" ::: "memory");
            const unsigned og = xb_add(&bar[XB_TOP], 1u);
            const unsigned tg = og / nx;
            if (og + 1u == (tg + 1u) * nx) xb_add(&bar[XB_TOPGEN], 1u);
            else XB_SPIN(xb_ld(&bar[XB_TOPGEN]) == tg, bar);
            __builtin_amdgcn_fence(__ATOMIC_ACQUIRE, "agent");
            xb_add(&bar[XB_XGEN(b.x)], 1u);
            asm volatile("s_waitcnt vmcnt(0)" ::: "memory");
        } else {
            XB_SPIN(xb_ld(&bar[XB_XGEN(b.x)]) == gen, bar);
            __builtin_amdgcn_fence(__ATOMIC_ACQUIRE, "agent");
            asm volatile("s_waitcnt vmcnt(0)" ::: "memory");
        }
    }
    __syncthreads();
}

constexpr int PT_OFF = LDSCTL_OFF;
constexpr int PT_OUT = 31, PT_WS = 32;
__device__ __forceinline__ const float* ldp(LAS unsigned char* lds, int i) {
    const unsigned long long v = *(volatile LAS unsigned long long*)(lds + PT_OFF + 8 * i);
    const unsigned lo = __builtin_amdgcn_readfirstlane((unsigned)v), hi = __builtin_amdgcn_readfirstlane((unsigned)(v >> 32));
    return (const float*)(((unsigned long long)hi << 32) | lo);
}

typedef f32x4 (&AccRef)[2][2][4][2];

__device__ __forceinline__ void row_decode(int row, int& kind, int& b, int& t) {
    if (row < MP) { kind = 0; b = row >> 12; t = row & 4095; }
    else if (row < MR) { kind = 1; b = (row - MP) >> 2; t = (row - MP) & 3; }
    else { kind = 2; b = 0; t = 0; }
}


#ifndef EPI_NT
#define EPI_NT 0
#endif
#if EPI_NT
#define EPI_ST(ptr, val) __builtin_nontemporal_store((val), (ptr))
#else
#define EPI_ST(ptr, val) (*(ptr) = (val))
#endif
typedef _Float16 h16x4 __attribute__((ext_vector_type(4)));
typedef _Float16 h16x8 __attribute__((ext_vector_type(8)));
constexpr size_t RAT_STRIDE = (size_t)MPAD * DM;

template <bool SK> __device__ __forceinline__ void scale_rows_rstd(AccRef acc, const unsigned long long* ss, int row0) {
#pragma unroll
    for (int ai = 0; ai < (SK ? 1 : 2); ++ai)
#pragma unroll
        for (int m = 0; m < (SK ? 2 : 4); ++m) {
            const float r = rsqrtf((float)ss[row0 + ai * 128 + m * 16] * (1.0f / (SS_FIX * DM)) + EPS);
#pragma unroll
            for (int bj = 0; bj < 2; ++bj)
#pragma unroll
                for (int n = 0; n < 2; ++n) acc[ai][bj][m][n] *= r;
        }
}

struct EpiSwiGLU {
    static constexpr bool PERM = false, AFTER_DRAIN = false, HAS_MID = false;
    unsigned char* ws; int nid;
    __device__ __forceinline__ void operator()(AccRef acc, const pg8::Unit& u, int wr, int wc, int fr, int fq) const { run<false>(acc, u, wr, wc, fr, fq); }
    template <bool SK> __device__ __forceinline__ void run(AccRef acc, const pg8::Unit& u, int wr, int wc, int fr_, int fq_) const {
        int fr = fr_, fq = fq_; asm volatile("" : "+v"(fr), "+v"(fq));
        bf16* H = (bf16*)(ws + WS_H);
        const int row0 = u.pm * 256 + wr * 64 + fr, col0 = u.pn * 128 + wc * 32 + 8 * fq;
        scale_rows_rstd<SK>(acc, (const unsigned long long*)(ws + WS_CTL + CTL_SS) + (size_t)nid * MPAD, row0);
#pragma unroll
        for (int ai = 0; ai < (SK ? 1 : 2); ++ai)
#pragma unroll
            for (int m = 0; m < (SK ? 2 : 4); ++m) {
                bf16* p = H + (size_t)(row0 + ai * 128 + m * 16) * DFF + col0;
                f32x4 h0, h1;
#pragma unroll
                for (int j = 0; j < 4; ++j) { h0[j] = siluf_(acc[ai][0][m][0][j]) * acc[ai][1][m][0][j]; h1[j] = siluf_(acc[ai][0][m][1][j]) * acc[ai][1][m][1][j]; }
                EPI_ST((u32x4*)p, pk8(h0, h1));
            }
    }
};

struct EpiResid {
    static constexpr bool PERM = false, AFTER_DRAIN = false, HAS_MID = false;
    unsigned char* ws; LAS unsigned char* lds; float scale; int fin; int nid;
    __device__ __forceinline__ void operator()(AccRef acc, const pg8::Unit& u, int wr, int wc, int fr, int fq) const { run<false>(acc, u, wr, wc, fr, fq); }
    template <bool SK> __device__ __forceinline__ void run(AccRef acc, const pg8::Unit& u, int wr, int wc, int fr_, int fq_) const {
        int fr = fr_, fq = fq_; asm volatile("" : "+v"(fr), "+v"(fq));
        bf16* XB = (bf16*)(ws + WS_XN);
        unsigned long long* ssp = (unsigned long long*)(ws + WS_CTL + CTL_SS) + (size_t)(nid < 0 ? 0 : nid) * MPAD;
        float* out = fin ? (float*)ldp(lds, PT_OUT) : nullptr;
        const float scale = (u.ri == 0) ? this->scale : 0.f; const int nid = (u.ri == 0) ? this->nid : -1;
        const int row0 = u.pm * 256 + wr * 64 + fr, col0 = u.pn * 256 + wc * 32 + 8 * fq;
#pragma unroll
        for (int ai = 0; ai < (SK ? 1 : 2); ++ai)
#pragma unroll
            for (int m = 0; m < (SK ? 2 : 4); ++m) {
                const int row = row0 + ai * 128 + m * 16;
                bf16* xr = XB + (size_t)row * DM + col0;
                float sq = 0.f;
#pragma unroll
                for (int bj = 0; bj < 2; ++bj) {
                    float xo[8]; unpk8(*(const u32x4*)(xr + bj * 128), xo);
                    f32x4 v0, v1;
#pragma unroll
                    for (int j = 0; j < 4; ++j) { v0[j] = xo[j] + scale * acc[ai][bj][m][0][j]; v1[j] = xo[4 + j] + scale * acc[ai][bj][m][1][j]; }
                    if (out != nullptr && row < MR) { float* o = out + (size_t)row * DM + col0 + bj * 128; *(f32x4*)o = v0; *(f32x4*)(o + 4) = v1; }
                    const u32x4 w = pk8(v0, v1);
                    EPI_ST((u32x4*)(xr + bj * 128), w);
                    float xn[8]; unpk8(w, xn);
#pragma unroll
                    for (int j = 0; j < 8; ++j) sq += xn[j] * xn[j];
                }
                { const int ln = fq * 16 + fr; sq += shx(sq, 16, ln); sq += shx(sq, 32, ln); }
                if (nid >= 0 && fq == 0) atomicAdd(ssp + row, (unsigned long long)(sq * SS_FIX + 0.5f));
            }
    }
};

struct EpiMergeCat {
    static constexpr bool PERM = false, AFTER_DRAIN = false, HAS_MID = true;
    unsigned char* ws;
    __device__ __forceinline__ void apply(f32x4 (&acc)[2][2][4][2], const pg8::Unit& u, int s, int wr, int wc, int fr_, int fq_) const {
        int fr = fr_, fq = fq_; asm volatile("" : "+v"(fr), "+v"(fq));
        const _Float16* R = (const _Float16*)(ws + WS_GATE) + (size_t)s * RAT_STRIDE;
        const int row0 = u.pm * 256 + wr * 64 + fr, col0 = u.pn * 256 + wc * 32 + 8 * fq;
        h16x8 r[2][4][2];
#pragma unroll
        for (int ai = 0; ai < 2; ++ai)
#pragma unroll
            for (int m = 0; m < 4; ++m)
#pragma unroll
                for (int bj = 0; bj < 2; ++bj) r[ai][m][bj] = *(const h16x8*)(R + (size_t)(row0 + ai * 128 + m * 16) * DM + col0 + bj * 128);
#pragma unroll
        for (int ai = 0; ai < 2; ++ai)
#pragma unroll
            for (int m = 0; m < 4; ++m)
#pragma unroll
                for (int bj = 0; bj < 2; ++bj)
#pragma unroll
                    for (int j = 0; j < 4; ++j) { acc[ai][bj][m][0][j] *= (float)r[ai][m][bj][j]; acc[ai][bj][m][1][j] *= (float)r[ai][m][bj][4 + j]; }
    }
    __device__ __forceinline__ void mid(f32x4 (&acc)[2][2][4][2], const pg8::Unit& u, int t, int wr, int wc, int fr, int fq) const {
        apply(acc, u, (t == 8) ? 0 : (t == 12 ? 1 : 2), wr, wc, fr, fq);
    }
    __device__ __forceinline__ void operator()(AccRef acc, const pg8::Unit& u, int wr, int wc, int fr_, int fq_) const {
        apply(acc, u, 3, wr, wc, fr_, fq_);
        int fr = fr_, fq = fq_; asm volatile("" : "+v"(fr), "+v"(fq));
        bf16* MRG = (bf16*)(ws + WS_MRG);
        const int row0 = u.pm * 256 + wr * 64 + fr, col0 = u.pn * 256 + wc * 32 + 8 * fq;
#pragma unroll
        for (int ai = 0; ai < 2; ++ai)
#pragma unroll
            for (int m = 0; m < 4; ++m)
#pragma unroll
                for (int bj = 0; bj < 2; ++bj) EPI_ST((u32x4*)(MRG + (size_t)(row0 + ai * 128 + m * 16) * DM + col0 + bj * 128), pk8(acc[ai][bj][m][0], acc[ai][bj][m][1]));
    }
};
template <int MODE>
struct EpiMergeS {
    static constexpr bool PERM = false, AFTER_DRAIN = false, HAS_MID = false;
    unsigned char* ws; int br;
    template <bool SK> __device__ __forceinline__ void run(AccRef acc, const pg8::Unit& u, int wr, int wc, int fr, int fq) const {
        float* P = (float*)(ws + WS_PM); bf16* MRG = (bf16*)(ws + WS_MRG);
        const int row0 = u.pm * 256 + wr * 64 + fr, col0 = u.pn * 256 + wc * 32 + 8 * fq;
#pragma unroll
        for (int m = 0; m < 2; ++m) {
            const int row = row0 + m * 16;
#pragma unroll
            for (int bj = 0; bj < 2; ++bj) {
                const int c = col0 + bj * 128;
                float g[8];
                { const _Float16* R = (const _Float16*)(ws + WS_GATE) + (size_t)row * DM + c;
                  const h16x8 r3 = *(const h16x8*)(R + 3 * RAT_STRIDE);
#pragma unroll
                  for (int j = 0; j < 8; ++j) g[j] = (float)r3[j];
#pragma unroll
                  for (int s = 2; s >= 0; --s) if (s >= br) { const h16x8 rs = *(const h16x8*)(R + (size_t)s * RAT_STRIDE);
#pragma unroll
                      for (int j = 0; j < 8; ++j) g[j] *= (float)rs[j]; } }
                f32x4 v0, v1;
#pragma unroll
                for (int j = 0; j < 4; ++j) { v0[j] = g[j] * acc[0][bj][m][0][j]; v1[j] = g[4 + j] * acc[0][bj][m][1][j]; }
                float* pp = P + (size_t)(row - MP) * DM + c;
                if (MODE != 0) { v0 += *(const f32x4*)pp; v1 += *(const f32x4*)(pp + 4); }
                if (MODE == 2) *(u32x4*)(MRG + (size_t)row * DM + c) = pk8(v0, v1);
                else { *(f32x4*)pp = v0; *(f32x4*)(pp + 4) = v1; }
            }
        }
    }
};

struct EpiWin {
    static constexpr bool PERM = false, AFTER_DRAIN = false, HAS_MID = false;
    unsigned char* ws;
    const float *qgain, *kgain, *b_a;
    float* out; int layer; int nid;

    template <int ACT, bool SK>
    __device__ __forceinline__ void plain(AccRef acc, bf16* dst, int ldc, int cbase, int row0, int wc, int fq) const {
#pragma unroll
        for (int ai = 0; ai < (SK ? 1 : 2); ++ai)
#pragma unroll
            for (int m = 0; m < (SK ? 2 : 4); ++m) {
                bf16* p = dst + (size_t)(row0 + ai * 128 + m * 16) * ldc + cbase + wc * 32 + fq * 8;
#pragma unroll
                for (int bj = 0; bj < 2; ++bj) {
                    f32x4 v0 = acc[ai][bj][m][0], v1 = acc[ai][bj][m][1];
#pragma unroll
                    for (int j = 0; j < 4; ++j) {
                        if (ACT == 1) { v0[j] = sigmoidf_(v0[j]); v1[j] = sigmoidf_(v1[j]); }
                        if (ACT == 2) { v0[j] = siluf_(v0[j]); v1[j] = siluf_(v1[j]); }
                        if (ACT == 3) { v0[j] *= 0.125f; v1[j] *= 0.125f; }
                    }
                    EPI_ST((u32x4*)(p + bj * 128), pk8(v0, v1));
                }
            }
    }

    __device__ __forceinline__ void operator()(AccRef acc, const pg8::Unit& u, int wr, int wc, int fr, int fq) const { run<false>(acc, u, wr, wc, fr, fq); }
    template <bool SK> __device__ __forceinline__ void run(AccRef acc, const pg8::Unit& u, int wr, int wc, int fr_, int fq_) const {
        int fr = fr_, fq = fq_; asm volatile("" : "+v"(fr), "+v"(fq));
        const int pn = u.pn, row0 = u.pm * 256 + wr * 64 + fr, l = layer;
        scale_rows_rstd<SK>(acc, (const unsigned long long*)(ws + WS_CTL + CTL_SS) + (size_t)nid * MPAD, row0);
        if (pn < T_CB) {
            const int ch0 = 128 * pn + 32 * wc + 8 * fq;
#pragma unroll
            for (int ai = 0; ai < (SK ? 1 : 2); ++ai)
#pragma unroll
                for (int m = 0; m < (SK ? 2 : 4); ++m) {
                    const int row = row0 + ai * 128 + m * 16;
                    const f32x4 u0 = acc[ai][0][m][0] * acc[ai][1][m][0], u1 = acc[ai][0][m][1] * acc[ai][1][m][1];
                    *(u32x4*)((bf16*)(ws + WS_U) + (size_t)row * 512 + ch0) = pk8(u0, u1);
                    int kind, b, t; row_decode(row, kind, b, t);
                    if (kind == 0 && t >= SEQ - 2) { float* o = out + OFF_CONV_P + ((l * NB_P + b) * 2 + (t - (SEQ - 2))) * 512 + ch0; *(f32x4*)o = u0; *(f32x4*)(o + 4) = u1; }
                    if (kind == 1 && t >= TS - 2)  { float* o = out + OFF_CONV_S + ((l * NB_S + b) * 2 + (t - (TS - 2))) * 512 + ch0; *(f32x4*)o = u0; *(f32x4*)(o + 4) = u1; }
                }
        } else if (pn < T_Q) {
            plain<0, SK>(acc, (bf16*)(ws + WS_CB), 512, 256 * (pn - T_CB), row0, wc, fq);
        } else if (pn < T_V) {
            const bool isk = pn >= T_K; const int ti = isk ? pn - T_K : pn - T_Q; const int head = 4 * ti + wc;
            const float* gp = (isk ? kgain : qgain) + head * 64 + 8 * fq;
            f32x4 g[2][2];
#pragma unroll
            for (int bj = 0; bj < 2; ++bj) { g[bj][0] = *(const f32x4*)(gp + 32 * bj); g[bj][1] = *(const f32x4*)(gp + 32 * bj + 4); }
            bf16* dst = (bf16*)(ws + (isk ? WS_K : WS_Q));
            const int W = win_of(ti);
#pragma unroll
            for (int ai = 0; ai < (SK ? 1 : 2); ++ai)
#pragma unroll
                for (int m = 0; m < (SK ? 2 : 4); ++m) {
                    const int row = row0 + ai * 128 + m * 16;
                    float ss = 0.f;
#pragma unroll
                    for (int bj = 0; bj < 2; ++bj)
#pragma unroll
                        for (int n = 0; n < 2; ++n) { const f32x4 x = acc[ai][bj][m][n]; ss += (x[0] * x[0] + x[1] * x[1]) + (x[2] * x[2] + x[3] * x[3]); }
                    { const int ln = fq * 16 + fr; ss += shx(ss, 16, ln); ss += shx(ss, 32, ln); }
                    const float rs = rsqrtf(ss * (1.0f / 64.0f) + EPS);
                    int kind, b, t; row_decode(row, kind, b, t);
#pragma unroll
                    for (int bj = 0; bj < 2; ++bj) {
                        const f32x4 y0 = acc[ai][bj][m][0] * rs * g[bj][0], y1 = acc[ai][bj][m][1] * rs * g[bj][1];
                        *(u32x4*)(dst + (size_t)row * 768 + head * 64 + 32 * bj + 8 * fq) = pk8(y0, y1);
                        if (isk) {
                            const int e0 = 32 * bj + 8 * fq;
                            if (kind == 0 && t >= SEQ - W) { float* o = out + offw_p(ti) + ((((l * NB_P + b) * W + (t - (SEQ - W))) * 2 + 0) * 4 + wc) * 64 + e0; *(f32x4*)o = y0; *(f32x4*)(o + 4) = y1; }
                            if (kind == 1)                 { float* o = out + offw_s(ti) + ((((l * NB_S + b) * W + (W - TS + t)) * 2 + 0) * 4 + wc) * 64 + e0; *(f32x4*)o = y0; *(f32x4*)(o + 4) = y1; }
                        }
                    }
                }
        } else if (pn < T_GQ) {
            const int ti = pn - T_V;
            plain<0, SK>(acc, (bf16*)(ws + WS_V), 768, 256 * ti, row0, wc, fq);
            const int W = win_of(ti);
#pragma unroll
            for (int ai = 0; ai < (SK ? 1 : 2); ++ai)
#pragma unroll
                for (int m = 0; m < (SK ? 2 : 4); ++m) {
                    const int row = row0 + ai * 128 + m * 16;
                    int kind, b, t; row_decode(row, kind, b, t);
#pragma unroll
                    for (int bj = 0; bj < 2; ++bj) {
                        const int hh = 2 * bj + (wc >> 1), e0 = 32 * (wc & 1) + 8 * fq;
                        if (kind == 0 && t >= SEQ - W) { float* o = out + offw_p(ti) + ((((l * NB_P + b) * W + (t - (SEQ - W))) * 2 + 1) * 4 + hh) * 64 + e0; *(f32x4*)o = acc[ai][bj][m][0]; *(f32x4*)(o + 4) = acc[ai][bj][m][1]; }
                        if (kind == 1)                 { float* o = out + offw_s(ti) + ((((l * NB_S + b) * W + (W - TS + t)) * 2 + 1) * 4 + hh) * 64 + e0; *(f32x4*)o = acc[ai][bj][m][0]; *(f32x4*)(o + 4) = acc[ai][bj][m][1]; }
                    }
                }
        } else if (pn == T_GQ) {
            plain<3, SK>(acc, (bf16*)(ws + WS_GQ), 256, 0, row0, wc, fq);
        } else if (pn == T_GK) {
            plain<0, SK>(acc, (bf16*)(ws + WS_GK), 256, 0, row0, wc, fq);
        } else if (pn < T_GR) {
            plain<0, SK>(acc, (bf16*)(ws + WS_GV), 512, 256 * (pn - T_GV), row0, wc, fq);
        } else if (pn < T_Z) {
            plain<2, SK>(acc, (bf16*)(ws + WS_GR), 512, 256 * (pn - T_GR), row0, wc, fq);
        } else if (pn == T_Z) {
#pragma unroll
            for (int bj = 0; bj < 2; ++bj) {
                const int c0 = 128 * bj + 32 * wc + 8 * fq;
                const f32x4 b0 = *(const f32x4*)(b_a + c0), b1 = *(const f32x4*)(b_a + c0 + 4);
#pragma unroll
                for (int ai = 0; ai < (SK ? 1 : 2); ++ai)
#pragma unroll
                    for (int m = 0; m < (SK ? 2 : 4); ++m) {
                        const int row = row0 + ai * 128 + m * 16;
                        f32x4 z0 = acc[ai][bj][m][0] + b0, z1 = acc[ai][bj][m][1] + b1;
#pragma unroll
                        for (int j = 0; j < 4; ++j) {
                            z0[j] = (fminf(z0[j], 0.f) - __logf(1.0f + __expf(-fabsf(z0[j])))) * (1.0f / 16.0f);
                            z1[j] = (fminf(z1[j], 0.f) - __logf(1.0f + __expf(-fabsf(z1[j])))) * (1.0f / 16.0f);
                        }
                        float* o = (float*)(ws + WS_LA) + (size_t)row * 256 + c0; *(f32x4*)o = z0; *(f32x4*)(o + 4) = z1;
                    }
            }
        } else if (pn < T_GATE) {
            const int ti = pn - T_PIN;
            plain<0, SK>(acc, (bf16*)(ws + WS_PIN), 512, 256 * ti, row0, wc, fq);
#pragma unroll
            for (int ai = 0; ai < (SK ? 1 : 2); ++ai)
#pragma unroll
                for (int m = 0; m < (SK ? 2 : 4); ++m) {
                    const int row = row0 + ai * 128 + m * 16;
                    int kind, b, t; row_decode(row, kind, b, t);
#pragma unroll
                    for (int bj = 0; bj < 2; ++bj) {
                        const int c0 = 256 * ti + 128 * bj + 32 * wc + 8 * fq;
                        if (kind == 0 && t >= SEQ - 15) { float* o = out + OFF_POOL_P + ((l * NB_P + b) * 15 + (t - (SEQ - 15))) * 512 + c0; *(f32x4*)o = acc[ai][bj][m][0]; *(f32x4*)(o + 4) = acc[ai][bj][m][1]; }
                        if (kind == 1)                  { float* o = out + OFF_POOL_S + ((l * NB_S + b) * 15 + (15 - TS + t)) * 512 + c0; *(f32x4*)o = acc[ai][bj][m][0]; *(f32x4*)(o + 4) = acc[ai][bj][m][1]; }
                    }
                }
        } else {
            _Float16* R = (_Float16*)(ws + WS_GATE);
            const int c0 = 64 * (pn - T_GATE) + 16 * wc + 4 * fq;
#pragma unroll
            for (int ai = 0; ai < (SK ? 1 : 2); ++ai)
#pragma unroll
                for (int m = 0; m < (SK ? 2 : 4); ++m) {
                    const size_t o = (size_t)(row0 + ai * 128 + m * 16) * DM + c0;
                    h16x4 r0, r1, r2, r3;
#pragma unroll
                    for (int j = 0; j < 4; ++j) {
                        const float d0 = fminf(1.0f + __expf(-acc[ai][0][m][0][j]), 16384.f), d1 = fminf(1.0f + __expf(-acc[ai][0][m][1][j]), 16384.f);
                        const float d2 = fminf(1.0f + __expf(-acc[ai][1][m][0][j]), 16384.f), d3 = fminf(1.0f + __expf(-acc[ai][1][m][1][j]), 16384.f);
                        const float i0 = __builtin_amdgcn_rcpf(d0), i1 = __builtin_amdgcn_rcpf(d1), i2 = __builtin_amdgcn_rcpf(d2), i3 = __builtin_amdgcn_rcpf(d3);
                        r0[j] = (_Float16)fminf(d1 * i0, 65504.f); r1[j] = (_Float16)fminf(d2 * i1, 65504.f); r2[j] = (_Float16)fminf(d3 * i2, 65504.f); r3[j] = (_Float16)i3;
                    }
                    EPI_ST((h16x4*)(R + o), r0); EPI_ST((h16x4*)(R + RAT_STRIDE + o), r1); EPI_ST((h16x4*)(R + 2 * RAT_STRIDE + o), r2); EPI_ST((h16x4*)(R + 3 * RAT_STRIDE + o), r3);
                }
        }
    }
};

template <class Epi>
__device__ __forceinline__ void skinny_unit(LAS unsigned char* lds, const bf16* A, const bf16* Bt, int K, int su, const Epi E, int tid, int ld = 0) {
    if (ld == 0) ld = K;
    const int lane = tid & 63, w = __builtin_amdgcn_readfirstlane(tid >> 6), fr = lane & 15, g = lane >> 4;
    const int pn = su >> 2, wc = su & 3;
    const int nh = K >> 6, h0 = (w * nh) >> 3, h1 = ((w + 1) * nh) >> 3;
    f32x4 acc[2][2][2];
#pragma unroll
    for (int bj = 0; bj < 2; ++bj)
#pragma unroll
        for (int m = 0; m < 2; ++m)
#pragma unroll
            for (int n = 0; n < 2; ++n) acc[bj][m][n] = (f32x4){0.f, 0.f, 0.f, 0.f};
    const bf16* ap = A + (size_t)(MP + fr) * ld + 16 * g;
    const bf16* bp = Bt + (size_t)(256 * pn + 32 * wc + fr) * ld + 16 * g;
    for (int hc = h0; hc < h1; hc += 4) {
        bf16x8 a[4][2][2], b[4][2][2][2];
#pragma unroll
        for (int q = 0; q < 4; ++q) {
            const int hq = (hc + q < h1) ? hc + q : h1 - 1;
#pragma unroll
            for (int s = 0; s < 2; ++s) {
#pragma unroll
                for (int m = 0; m < 2; ++m) a[q][m][s] = *(const bf16x8*)(ap + (size_t)(16 * m) * ld + 64 * hq + 8 * s);
#pragma unroll
                for (int bj = 0; bj < 2; ++bj)
#pragma unroll
                    for (int n = 0; n < 2; ++n) b[q][bj][n][s] = *(const bf16x8*)(bp + (size_t)(128 * bj + 16 * n) * ld + 64 * hq + 8 * s);
            }
        }
#pragma unroll
        for (int q = 0; q < 4; ++q) {
            const bool ok = hc + q < h1;
#pragma unroll
            for (int s = 0; s < 2; ++s)
#pragma unroll
                for (int m = 0; m < 2; ++m) {
                    bf16x8 av = a[q][m][s];
                    if (!ok) av = (bf16x8){0, 0, 0, 0, 0, 0, 0, 0};
#pragma unroll
                    for (int bj = 0; bj < 2; ++bj)
#pragma unroll
                        for (int n = 0; n < 2; ++n) acc[bj][m][n] = __builtin_amdgcn_mfma_f32_16x16x32_bf16(b[q][bj][n][s], av, acc[bj][m][n], 0, 0, 0);
                }
        }
    }
    LAS f32x4* red = (LAS f32x4*)lds;
#pragma unroll
    for (int bj = 0; bj < 2; ++bj)
#pragma unroll
        for (int m = 0; m < 2; ++m)
#pragma unroll
            for (int n = 0; n < 2; ++n) red[(w * 8 + (bj * 4 + m * 2 + n)) * 64 + lane] = acc[bj][m][n];
    __syncthreads();
    if (w == 0) {
        f32x4 full[2][2][4][2];
#pragma unroll
        for (int bj = 0; bj < 2; ++bj)
#pragma unroll
            for (int m = 0; m < 2; ++m)
#pragma unroll
                for (int n = 0; n < 2; ++n) {
                    f32x4 s = red[(bj * 4 + m * 2 + n) * 64 + lane];
#pragma unroll
                    for (int ww = 1; ww < 8; ++ww) s += red[(ww * 8 + (bj * 4 + m * 2 + n)) * 64 + lane];
                    asm volatile("" : "+v"(s) :: "memory");
                    full[0][bj][m][n] = s;
                }
        pg8::Unit u; u.pm = MP / 256; u.pn = pn; u.ri = 0;
        E.template run<true>(full, u, 0, wc, fr, g);
    }
    __syncthreads();
}

__device__ __forceinline__ void skinny_merge_unit(LAS unsigned char* lds, unsigned char* ws, const bf16* Y, const bf16* U, int su, int tid) {
    const int lane = tid & 63, w = __builtin_amdgcn_readfirstlane(tid >> 6), fr = lane & 15, g = lane >> 4;
    const int pn = su >> 2, wc = su & 3;
    f32x4 acc[2][2][2];
#pragma unroll
    for (int bj = 0; bj < 2; ++bj)
#pragma unroll
        for (int m = 0; m < 2; ++m)
#pragma unroll
            for (int n = 0; n < 2; ++n) acc[bj][m][n] = (f32x4){0.f, 0.f, 0.f, 0.f};
    if (w < 7) {
        const bf16* ap = Y + (size_t)(MP + fr) * YK + 16 * g + 256 * w;
        const bf16* bp = U + (size_t)(256 * pn + 32 * wc + fr) * YK + 16 * g + 256 * w;
        bf16x8 a[4][2][2], b[4][2][2][2];
#pragma unroll
        for (int q = 0; q < 4; ++q)
#pragma unroll
            for (int s2 = 0; s2 < 2; ++s2) {
#pragma unroll
                for (int m = 0; m < 2; ++m) a[q][m][s2] = *(const bf16x8*)(ap + (size_t)(16 * m) * YK + 64 * q + 8 * s2);
#pragma unroll
                for (int bj = 0; bj < 2; ++bj)
#pragma unroll
                    for (int n = 0; n < 2; ++n) b[q][bj][n][s2] = *(const bf16x8*)(bp + (size_t)(128 * bj + 16 * n) * YK + 64 * q + 8 * s2);
            }
#pragma unroll
        for (int q = 0; q < 4; ++q)
#pragma unroll
            for (int s2 = 0; s2 < 2; ++s2)
#pragma unroll
                for (int m = 0; m < 2; ++m)
#pragma unroll
                    for (int bj = 0; bj < 2; ++bj)
#pragma unroll
                        for (int n = 0; n < 2; ++n) acc[bj][m][n] = __builtin_amdgcn_mfma_f32_16x16x32_bf16(b[q][bj][n][s2], a[q][m][s2], acc[bj][m][n], 0, 0, 0);
    }
    LAS f32x4* red = (LAS f32x4*)lds;
#pragma unroll
    for (int bj = 0; bj < 2; ++bj)
#pragma unroll
        for (int m = 0; m < 2; ++m)
#pragma unroll
            for (int n = 0; n < 2; ++n) red[(w * 8 + (bj * 4 + m * 2 + n)) * 64 + lane] = acc[bj][m][n];
    __syncthreads();
    if (w == 0) {
        bf16* MRG = (bf16*)(ws + WS_MRG);
        const int col0 = pn * 256 + wc * 32 + 8 * g;
#pragma unroll
        for (int m = 0; m < 2; ++m) {
            const int row = MP + 16 * m + fr;
#pragma unroll
            for (int bj = 0; bj < 2; ++bj) {
                const _Float16* R = (const _Float16*)(ws + WS_GATE) + (size_t)row * DM + col0 + bj * 128;
                const h16x8 r0 = *(const h16x8*)R, r1 = *(const h16x8*)(R + RAT_STRIDE), r2 = *(const h16x8*)(R + 2 * RAT_STRIDE), r3 = *(const h16x8*)(R + 3 * RAT_STRIDE);
                f32x4 o[2];
#pragma unroll
                for (int n = 0; n < 2; ++n) {
                    const int ti = bj * 4 + m * 2 + n;
                    const f32x4 pa = red[(0 * 8 + ti) * 64 + lane] + red[(1 * 8 + ti) * 64 + lane], pb = red[(2 * 8 + ti) * 64 + lane];
                    const f32x4 pc = red[(3 * 8 + ti) * 64 + lane] + red[(4 * 8 + ti) * 64 + lane], pd = red[(5 * 8 + ti) * 64 + lane] + red[(6 * 8 + ti) * 64 + lane];
#pragma unroll
                    for (int j = 0; j < 4; ++j) {
                        const float e3 = (float)r3[4 * n + j], e2 = (float)r2[4 * n + j] * e3, e1 = (float)r1[4 * n + j] * e2, e0 = (float)r0[4 * n + j] * e1;
                        o[n][j] = (e0 * pa[j] + e1 * pb[j]) + (e2 * pc[j] + e3 * pd[j]);
                    }
                }
                *(u32x4*)(MRG + (size_t)row * DM + col0 + bj * 128) = pk8(o[0], o[1]);
            }
        }
    }
    __syncthreads();
}

constexpr int IT_GU = 344 * 32, IT_D = 64 * 86, IT_IN = 448 * 32, IT_UPA = 64 * 8, IT_UPB = 64 * 4, IT_UPC = 64 * 8, IT_UPD = 64 * 8, IT_OUT = 64 * 32;
constexpr int IT_LAYER = 2 * IT_GU + 2 * IT_D + IT_IN + IT_UPA + IT_UPB + IT_UPC + IT_UPD + IT_OUT;
static_assert(IT_LAYER == 51200, "items per layer");

constexpr int PB_LAYER = 2 * 43 * 32 + 2 * 8 * 86 + 56 * 32 + 8 * 8 + 8 * 4 + 8 * 8 + 8 * 8 + 8 * 32;
static_assert(PB_LAYER == 6400, "blocks per layer");
constexpr int PB_P = 265;
constexpr int PB_PW_OFF = 69632;
struct BDesc { const float* src; const float* gain; bf16* dst; int ldw, K, kind, perm, aux0, aux1, aux2; };

__device__ __forceinline__ void pblk_decode(LAS unsigned char* lds, bf16* WB, int blk, int wave, int lane, BDesc& D) {
    const int l = blk / PB_LAYER; int r = blk % PB_LAYER;
    const int g = lane >> 3, c4 = lane & 7, bj = g >> 2, wc = g & 3;
    bf16* wl = WB + (size_t)l * WE_LAYER;
    const float* W; const float* gn = nullptr; int ldw, S0, k0, K, T, kind = 0, perm = 0, aux0 = 0; size_t woff;
    if (r < 2 * 1376) {
        const int f = r / 1376; r -= f * 1376; T = r % 43; const int kb = r / 43;
        const float* Wg = ldp(lds, f ? 28 : 9); const float* Wu = ldp(lds, f ? 29 : 10);
        W = (bj ? Wu : Wg) + (size_t)l * DM * DFF; ldw = DFF; S0 = 128 * T + 32 * wc; k0 = 64 * kb; K = DM; perm = 1; woff = f ? WE_GU2 : WE_GU1; gn = ldp(lds, f ? 27 : 8) + (size_t)l * DM;
    } else if ((r -= 2 * 1376) < 2 * 688) {
        const int f = r / 688; r -= f * 688; T = r % 8; const int kb = r / 8;
        W = ldp(lds, f ? 30 : 11) + (size_t)l * DFF * DM; ldw = DM; S0 = 256 * T + 32 * g; k0 = 64 * kb; K = DFF; perm = 1; woff = f ? WE_D2 : WE_D1;
    } else if ((r -= 2 * 688) < 1792) {
        T = r % 56; const int kb = r / 56, pn = T;
        W = ldp(lds, 13) + (size_t)l * DM * N_IN; ldw = N_IN; k0 = 64 * kb; K = DM; perm = 1; woff = WE_IN; gn = ldp(lds, 12) + (size_t)l * DM;
        if (pn == T_Z) { kind = 1; S0 = C_LR; }
        else if (pn < T_CB) S0 = (bj ? C_CH : C_CC) + 128 * pn + 32 * wc;
        else if (pn < T_Q) S0 = C_CB + 256 * (pn - T_CB) + 32 * g;
        else if (pn < T_K) S0 = C_AQ + 256 * (pn - T_Q) + 64 * wc + 32 * bj;
        else if (pn < T_V) S0 = C_AK + 256 * (pn - T_K) + 64 * wc + 32 * bj;
        else if (pn < T_GQ) S0 = C_AV + 256 * (pn - T_V) + 32 * g;
        else if (pn == T_GQ) S0 = C_GQ + 32 * g;
        else if (pn == T_GK) S0 = C_GK + 32 * g;
        else if (pn < T_GR) S0 = C_GV + 256 * (pn - T_GV) + 32 * g;
        else if (pn < T_Z) S0 = C_GR + 256 * (pn - T_GR) + 32 * g;
        else if (pn < T_GATE) S0 = C_PIN + 256 * (pn - T_PIN) + 32 * g;
        else { S0 = C_GATE + (2 * bj + (c4 >> 2)) * 2048 + 64 * (pn - T_GATE) + 16 * wc + 4 * (c4 & 3) - 4 * c4; perm = 0; }
    } else if ((r -= 1792) < 64) { T = r % 8; const int kb = r / 8; W = ldp(lds, 22) + (size_t)l * 512 * DM; ldw = DM; S0 = 256 * T + 32 * g; k0 = 64 * kb; K = YK; perm = 1; woff = WE_UPCAT + YO_A; }
    else if ((r -= 64) < 32) { T = r % 8; const int kb = r / 8; W = ldp(lds, 23) + (size_t)l * 256 * DM; ldw = DM; S0 = 256 * T + 32 * g; k0 = 64 * kb; K = YK; perm = 1; woff = WE_UPCAT + YO_B; }
    else if ((r -= 32) < 64) { T = r % 8; const int kb = r / 8; W = ldp(lds, 24) + (size_t)l * 512 * DM; ldw = DM; S0 = 256 * T + 32 * g; k0 = 64 * kb; K = YK; perm = 1; woff = WE_UPCAT + YO_C; }
    else if ((r -= 64) < 64) { T = r % 8; const int kb = r / 8; W = ldp(lds, 25) + (size_t)l * 512 * DM; ldw = DM; S0 = 256 * T; k0 = 64 * kb; K = YK; perm = 1; woff = WE_UPCAT + YO_D; kind = 2; aux0 = kb; }
    else { r -= 64; T = r % 8; const int kb = r / 8; W = ldp(lds, 26) + (size_t)l * DM * DM; ldw = DM; S0 = 256 * T + 32 * g; k0 = 64 * kb; K = DM; perm = 1; woff = WE_OUT; }
    if (kind == 0) D.src = W + (size_t)(k0 + 8 * wave) * ldw + S0 + 4 * c4;
    else D.src = W + (size_t)k0 * ldw + S0;
    D.gain = gn ? gn + k0 + 8 * wave : nullptr;
    D.dst = wl + woff + (size_t)(256 * T) * K + k0; D.ldw = ldw; D.K = K; D.kind = kind; D.perm = perm; D.aux0 = aux0; D.aux1 = l; D.aux2 = 0;
}
__device__ __forceinline__ void pblk_load(const BDesc& D, f32x4 (&v)[8]) {
    if (D.kind != 0) return;
#pragma unroll
    for (int i = 0; i < 8; ++i) v[i] = __builtin_nontemporal_load((const f32x4*)(D.src + (size_t)i * D.ldw));
}
__device__ __forceinline__ void pblk_writeout(LAS unsigned char* lds, bf16* dst, int K, int perm, int tid) {
    LAS float* tile = (LAS float*)(lds + RING_OFF);
    const int lane = tid & 63, wave = tid >> 6;
    LDS_WAIT(); __builtin_amdgcn_s_barrier(); asm volatile("" ::: "memory");
    const int c = lane & 7;
#pragma unroll
    for (int j = 0; j < 4; ++j) {
        const int rho = (lane >> 3) + 8 * j; const int cc = perm ? pg8::perm32(rho) : rho;
        const LAS float* s = tile + (8 * c) * PB_P + 33 * wave + cc;
        u32x4 o; o.x = pk2(s[0 * PB_P], s[1 * PB_P]); o.y = pk2(s[2 * PB_P], s[3 * PB_P]); o.z = pk2(s[4 * PB_P], s[5 * PB_P]); o.w = pk2(s[6 * PB_P], s[7 * PB_P]);
        *(u32x4*)(dst + (size_t)(32 * wave + rho) * K + 8 * c) = o;
    }
    LDS_WAIT(); __builtin_amdgcn_s_barrier(); asm volatile("" ::: "memory");
}
__device__ __forceinline__ void pblk_finish(LAS unsigned char* lds, const BDesc& D, const f32x4 (&v)[8], int tid) {
    if (D.kind != 0) return;
    LAS float* tile = (LAS float*)(lds + RING_OFF);
    const int lane = tid & 63, wave = tid >> 6;
    const int g = lane >> 3, c4 = lane & 7;
#pragma unroll
    for (int i = 0; i < 8; ++i) { const float gk = D.gain ? D.gain[i] : 1.0f; LAS float* s = tile + (8 * wave + i) * PB_P + 33 * g + 4 * c4; s[0] = v[i][0] * gk; s[1] = v[i][1] * gk; s[2] = v[i][2] * gk; s[3] = v[i][3] * gk; }
    pblk_writeout(lds, D.dst, D.K, D.perm, tid);
}
__device__ __forceinline__ void prologue_specials(LAS unsigned char* lds, bf16* WB, int bid, int G, int tid) {
    LAS float* tile = (LAS float*)(lds + RING_OFF);
#pragma unroll 1
    for (int s = bid; s < DEPTH * 96; s += G) {
        const int l = s / 96, r = s % 96;
        bf16* wl = WB + (size_t)l * WE_LAYER;
        if (r < 32) {
            const int kb = r;
            const float* A2 = ldp(lds, 17) + (size_t)l * 16 * 256; const float* gmix = ldp(lds, 12) + (size_t)l * DM;
            const float* Wk = ldp(lds, 13) + (size_t)l * DM * N_IN + (size_t)(64 * kb) * N_IN + C_LR;
            const int c = tid & 255, half = tid >> 8;
            float w2[16];
#pragma unroll
            for (int q = 0; q < 16; ++q) w2[q] = A2[q * 256 + c];
#pragma unroll 4
            for (int i = 0; i < 32; ++i) {
                const int kk = 32 * half + i;
                const f32x4* a = (const f32x4*)(Wk + (size_t)kk * N_IN);
                float sum = 0.f;
#pragma unroll
                for (int q = 0; q < 4; ++q) { const f32x4 av = a[q]; sum += av[0] * w2[4 * q] + av[1] * w2[4 * q + 1] + av[2] * w2[4 * q + 2] + av[3] * w2[4 * q + 3]; }
                tile[kk * PB_P + 33 * (c >> 5) + (c & 31)] = sum * gmix[64 * kb + kk];
            }
            pblk_writeout(lds, wl + WE_IN + (size_t)(256 * T_Z) * DM + 64 * kb, DM, 1, tid);
        } else {
            const int q = r - 32, T = q % 8, kb = q / 8, gg = kb >> 1, i0 = (kb & 1) * 64;
            LAS float* pw = (LAS float*)(lds + PB_PW_OFF);
            { const f32x4* src = (const f32x4*)(ldp(lds, 20) + ((size_t)l * 4 + gg) * 128 * 128 + (size_t)i0 * 128);
              for (int e = tid; e < 64 * 32; e += NTHR) ((LAS f32x4*)pw)[e] = src[e]; }
            LDS_WAIT(); __builtin_amdgcn_s_barrier(); asm volatile("" ::: "memory");
            const int n = tid & 255, half = tid >> 8;
            const float* SC = ldp(lds, 21) + (size_t)l * 512 + gg * 128;
            const float* UD = ldp(lds, 25) + (size_t)l * 512 * DM + (size_t)(gg * 128) * DM + 256 * T + n;
            float a[32];
#pragma unroll
            for (int j = 0; j < 32; ++j) a[j] = 0.f;
#pragma unroll 2
            for (int c = 0; c < 128; ++c) {
                const float uv = UD[(size_t)c * DM] * SC[c];
#pragma unroll
                for (int j = 0; j < 32; ++j) a[j] += pw[(32 * half + j) * 128 + c] * uv;
            }
#pragma unroll
            for (int j = 0; j < 32; ++j) tile[(32 * half + j) * PB_P + 33 * (n >> 5) + (n & 31)] = a[j];
            pblk_writeout(lds, wl + WE_UPCAT + YO_D + (size_t)(256 * T) * YK + 64 * kb, YK, 1, tid);
        }
    }
}
constexpr int DEFER_WG0 = 96, DEFER_WGS = 160, DEFER_PER_WG = 7, DEFER_N = DEFER_WGS * DEFER_PER_WG;
__device__ __forceinline__ bool pblk_deferred(int blk) {
    const int l = blk / PB_LAYER, r = blk % PB_LAYER;
    if (r < 1376) return l >= 1 && r < DEFER_N;
    if (r < 2 * 1376) return (r - 1376) < DEFER_N;
    return false;
}
#define PB_STEP(CUR, VCUR, NXT2, VNXT2) { const int nx2 = idx + 2 * stride; \
        if (nx2 < count) { pblk_decode(lds, WB, first + nx2, wave, lane, NXT2); if (skip_deferred && pblk_deferred(first + nx2)) NXT2.kind = 3; pblk_load(NXT2, VNXT2); } \
        pblk_finish(lds, CUR, VCUR, tid); \
        if (idx + stride >= count) break; idx += stride; }
__device__ __forceinline__ void prologue_blocks(LAS unsigned char* lds, bf16* WB, int first, int count, int start, int stride, int tid, bool skip_deferred) {
    const int lane = tid & 63, wave = __builtin_amdgcn_readfirstlane(tid >> 6);
    BDesc A, B, C; f32x4 va[8], vb[8], vc[8];
    int idx = start;
    if (idx >= count) return;
    pblk_decode(lds, WB, first + idx, wave, lane, A); if (skip_deferred && pblk_deferred(first + idx)) A.kind = 3; pblk_load(A, va);
    B.kind = 3;
    if (idx + stride < count) { pblk_decode(lds, WB, first + idx + stride, wave, lane, B); if (skip_deferred && pblk_deferred(first + idx + stride)) B.kind = 3; pblk_load(B, vb); }
#pragma unroll 1
    for (;;) {
        PB_STEP(A, va, C, vc)
        PB_STEP(B, vb, A, va)
        PB_STEP(C, vc, B, vb)
    }
}
#undef PB_STEP

__device__ __forceinline__ void x_init_pass(const float* xp, const float* xs, bf16* XB, unsigned long long* ss0, int gw, int NGW, int lane) {
    for (int row = gw; row < MPAD; row += NGW) {
        u32x2* o = (u32x2*)(XB + (size_t)row * DM) + lane;
        if (row >= MR) {
#pragma unroll
            for (int j = 0; j < 8; ++j) { u32x2 z; z.x = 0u; z.y = 0u; o[64 * j] = z; }
            continue;
        }
        const f32x4* xr = (const f32x4*)(row < MP ? xp + (size_t)row * DM : xs + (size_t)(row - MP) * DM) + lane;
        float ss = 0.f;
#pragma unroll
        for (int j = 0; j < 8; ++j) { const f32x4 v = xr[64 * j]; u32x2 w; w.x = pk2(v[0], v[1]); w.y = pk2(v[2], v[3]); o[64 * j] = w;
            const float a0 = bflo(w.x), a1 = bfhi(w.x), a2 = bflo(w.y), a3 = bfhi(w.y); ss += (a0 * a0 + a1 * a1) + (a2 * a2 + a3 * a3); }
        ss = wave_sum(ss, lane);
        if (lane == 0) ss0[row] = (unsigned long long)(ss * SS_FIX + 0.5f);
    }
}

constexpr int CC_N0 = DEPTH * NB_S * (128 - TS) * 128, CC_N1 = DEPTH * NB_S * (512 - TS) * 128, CC_N2 = DEPTH * NB_S * (2048 - TS) * 128, CACHE_COPY_N = CC_N0 + CC_N1 + CC_N2;
__device__ __forceinline__ void cache_copy_range(const float* c128, const float* c512, const float* c2048, float* out, int i0, int i1, int t, int nt) {
    for (int i = i0 + t; i < i1; i += nt) {
        int ii = i, gi = 0;
        if (ii >= CC_N0) { ii -= CC_N0; gi = 1; if (ii >= CC_N1) { ii -= CC_N1; gi = 2; } }
        const int W = win_of(gi), per = (W - TS) * 128, lb = ii / per, j = ii - lb * per;
        const f32x4* src = (const f32x4*)(gi == 0 ? c128 : (gi == 1 ? c512 : c2048)); f32x4* dst = (f32x4*)(out + offw_s(gi));
        __builtin_nontemporal_store(__builtin_nontemporal_load(src + (size_t)lb * W * 128 + TS * 128 + j), dst + (size_t)lb * W * 128 + j);
    }
}

__device__ __forceinline__ s16x4 ds_tr16(const LAS unsigned char* p) { return __builtin_amdgcn_ds_read_tr16_b64_v4i16((LAS s16x4*)p); }
__device__ __forceinline__ bf16x8 cat4(s16x4 a, s16x4 b) { bf16x8 r; r[0] = a[0]; r[1] = a[1]; r[2] = a[2]; r[3] = a[3]; r[4] = b[0]; r[5] = b[1]; r[6] = b[2]; r[7] = b[3]; return r; }
__device__ __forceinline__ bf16x8 pk8v(f32x4 a, f32x4 b) { const u32x4 w = pk8(a, b); return __builtin_bit_cast(bf16x8, w); }

constexpr int ATT_UNITS = NB_P * 12 * 32;
constexpr int ATT_PITCH = 144;
__device__ __forceinline__ void attn_unit(LAS unsigned char* lds, const bf16* Q, const bf16* K, const bf16* V, float* AO, float* LSE, int unit, int tid) {
    const int lane = tid & 63, w = tid >> 6, fr = lane & 15, g = lane >> 4;
    const int blk = unit & 31, bh = unit >> 5, h = bh % 12, b = bh / 12;
    const int gi = h >> 2, dl = dil_of(gi);
    const int r = blk % dl, nb = blk / dl;
    LAS unsigned char* Ks = lds; LAS unsigned char* Vs = lds + 256 * ATT_PITCH;
    for (int c = tid; c < 2048; c += NTHR) {
        const int ki = c >> 3, ch = c & 7, ksub = nb * 128 + ki - 128;
        u32x4 kv = {0u, 0u, 0u, 0u}, vv = {0u, 0u, 0u, 0u};
        if (ksub >= 0) { const size_t off = (size_t)(b * SEQ + r + dl * ksub) * 768 + h * 64 + ch * 8; kv = *(const u32x4*)(K + off); vv = *(const u32x4*)(V + off); }
        *(LAS u32x4*)(Ks + ki * ATT_PITCH + ch * 16) = kv; *(LAS u32x4*)(Vs + ki * ATT_PITCH + ch * 16) = vv;
    }
    __syncthreads();
    const int qi = 16 * w + fr;
    const int qtok = b * SEQ + r + dl * (nb * 128 + qi);
    const bf16x8 q0 = *(const bf16x8*)(Q + (size_t)qtok * 768 + h * 64 + 8 * g), q1 = *(const bf16x8*)(Q + (size_t)qtok * 768 + h * 64 + 32 + 8 * g);
    const int ks0 = w >> 1;
    f32x4 s[10];
#pragma unroll
    for (int tt = 0; tt < 10; ++tt) {
        const int T = 2 * ks0 + tt;
        const LAS unsigned char* kp = Ks + (16 * T + fr) * ATT_PITCH + 16 * g;
        const bf16x8 k0 = *(const LAS bf16x8*)kp, k1 = *(const LAS bf16x8*)(kp + 64);
        f32x4 a = {0.f, 0.f, 0.f, 0.f};
        a = __builtin_amdgcn_mfma_f32_16x16x32_bf16(k0, q0, a, 0, 0, 0);
        a = __builtin_amdgcn_mfma_f32_16x16x32_bf16(k1, q1, a, 0, 0, 0);
        s[tt] = a;
    }
    const float slope = exp2f(-8.0f * (float)(h + 1) / 12.0f) * (float)dl;
    float mx = -INFINITY;
#pragma unroll
    for (int tt = 0; tt < 10; ++tt)
#pragma unroll
        for (int j = 0; j < 4; ++j) {
            const int ki = 16 * (2 * ks0 + tt) + 4 * g + j, dist = qi - ki + 128, ksub = nb * 128 + ki - 128;
            const bool valid = (dist >= 0) && (dist <= 128) && (ksub >= 0);
            const float v = s[tt][j] * 0.125f - slope * (float)dist;
            s[tt][j] = valid ? v : -INFINITY;
            mx = fmaxf(mx, s[tt][j]);
        }
    mx = fmaxf(mx, shx(mx, 16, lane)); mx = fmaxf(mx, shx(mx, 32, lane));
    float ls = 0.f;
#pragma unroll
    for (int tt = 0; tt < 10; ++tt)
#pragma unroll
        for (int j = 0; j < 4; ++j) { const float p = __expf(s[tt][j] - mx); s[tt][j] = p; ls += p; }
    ls += shx(ls, 16, lane); ls += shx(ls, 32, lane);
    f32x4 o[4];
#pragma unroll
    for (int et = 0; et < 4; ++et) o[et] = (f32x4){0.f, 0.f, 0.f, 0.f};
    const int q4 = fr >> 2, p4 = fr & 3;
#pragma unroll
    for (int kk = 0; kk < 5; ++kk) {
        const bf16x8 pb = pk8v(s[2 * kk], s[2 * kk + 1]);
        const int rb = 32 * (ks0 + kk) + 4 * g + q4;
#pragma unroll
        for (int et = 0; et < 4; ++et) {
            const s16x4 v0 = ds_tr16(Vs + rb * ATT_PITCH + (16 * et + 4 * p4) * 2);
            const s16x4 v1 = ds_tr16(Vs + (rb + 16) * ATT_PITCH + (16 * et + 4 * p4) * 2);
            o[et] = __builtin_amdgcn_mfma_f32_16x16x32_bf16(cat4(v0, v1), pb, o[et], 0, 0, 0);
        }
    }
    const float inv = 1.0f / ls;
    float* ao = AO + (size_t)qtok * 768 + h * 64 + 4 * g;
#pragma unroll
    for (int et = 0; et < 4; ++et) *(f32x4*)(ao + 16 * et) = o[et] * inv;
    if (g == 0) LSE[(size_t)qtok * 12 + h] = mx + __logf(ls);
    __syncthreads();
}

__device__ __forceinline__ void attn_merge_pass(const float* AO, const float* LSE, bf16* YB, int gt, int NGT, int rep = 1) {
    for (int it0 = gt; it0 < rep * MR * 4 * 16; it0 += NGT) {
        const int it = it0 % (MR * 4 * 16);
        const int e4 = it & 15, slot = (it >> 4) & 3, tok = it >> 6;
        const float l0 = LSE[(size_t)tok * 12 + slot], l1 = LSE[(size_t)tok * 12 + 4 + slot], l2 = LSE[(size_t)tok * 12 + 8 + slot];
        const float m = fmaxf(l0, fmaxf(l1, l2));
        const float w0 = __expf(l0 - m), w1 = __expf(l1 - m), w2 = __expf(l2 - m), inv = 1.0f / (w0 + w1 + w2);
        const float* a = AO + (size_t)tok * 768 + slot * 64 + e4 * 4;
        const f32x4 y = (*(const f32x4*)a * w0 + *(const f32x4*)(a + 256) * w1 + *(const f32x4*)(a + 512) * w2) * inv;
        u32x2 wv; wv.x = pk2(y[0], y[1]); wv.y = pk2(y[2], y[3]);
        *(u32x2*)(YB + (size_t)tok * YK + YO_B + slot * 64 + e4 * 4) = wv;
    }
}

__device__ __forceinline__ float dot64_f32(const float (&q)[64], const float* k) {
    float s = 0.f;
#pragma unroll
    for (int c = 0; c < 16; ++c) { const f32x4 kv = ((const f32x4*)k)[c]; s += (q[4 * c] * kv[0] + q[4 * c + 1] * kv[1]) + (q[4 * c + 2] * kv[2] + q[4 * c + 3] * kv[3]); }
    return s;
}
__device__ __forceinline__ float dot64_bf(const float (&q)[64], const bf16* k) {
    float s = 0.f;
#pragma unroll
    for (int c = 0; c < 8; ++c) { const u32x4 w = ((const u32x4*)k)[c];
        s += (q[8 * c] * bflo(w.x) + q[8 * c + 1] * bfhi(w.x)) + (q[8 * c + 2] * bflo(w.y) + q[8 * c + 3] * bfhi(w.y)) + (q[8 * c + 4] * bflo(w.z) + q[8 * c + 5] * bfhi(w.z)) + (q[8 * c + 6] * bflo(w.w) + q[8 * c + 7] * bfhi(w.w)); }
    return s;
}
__device__ __forceinline__ void attn_sample_wave(const bf16* Q, const bf16* K, const bf16* V, const float* c128, const float* c512, const float* c2048, float* AO, float* LSE, int layer, int unit, int lane) {
    const int h = unit % 12, bt = unit / 12, t = bt & 3, b = bt >> 2;
    const int row = MP + b * TS + t;
    const int gi = h >> 2, slot = h & 3, dl = dil_of(gi), W = win_of(gi);
    const float* cache = (gi == 0 ? c128 : (gi == 1 ? c512 : c2048)) + (size_t)(layer * NB_S + b) * W * 512;
    float qf[64];
    { const u32x4* qp = (const u32x4*)(Q + (size_t)row * 768 + h * 64);
#pragma unroll
      for (int c = 0; c < 8; ++c) { const u32x4 w = qp[c]; qf[8 * c] = bflo(w.x) * 0.125f; qf[8 * c + 1] = bfhi(w.x) * 0.125f; qf[8 * c + 2] = bflo(w.y) * 0.125f; qf[8 * c + 3] = bfhi(w.y) * 0.125f;
          qf[8 * c + 4] = bflo(w.z) * 0.125f; qf[8 * c + 5] = bfhi(w.z) * 0.125f; qf[8 * c + 6] = bflo(w.w) * 0.125f; qf[8 * c + 7] = bfhi(w.w) * 0.125f; } }
    const float slope = exp2f(-8.0f * (float)(h + 1) / 12.0f) * (float)dl;
    float sc[3];
#pragma unroll
    for (int sj = 0; sj < 3; ++sj) {
        const int j = lane + 64 * sj;
        float d = -INFINITY;
        if (j <= 128) {
            const int idx = W + t - j * dl;
            if (idx >= W) d = dot64_bf(qf, K + (size_t)(MP + b * TS + (idx - W)) * 768 + h * 64);
            else d = dot64_f32(qf, cache + ((size_t)idx * 2 + 0) * 256 + slot * 64);
            d -= slope * (float)j;
        }
        sc[sj] = d;
    }
    const float mg = wave_max(fmaxf(sc[0], fmaxf(sc[1], sc[2])), lane);
    const float p0 = __expf(sc[0] - mg), p1 = __expf(sc[1] - mg), p2 = __expf(sc[2] - mg);
    const float lg = wave_sum(p0 + p1 + p2, lane);
    float acc = 0.f;
    const int jstart = (dl == 1) ? t + 1 : 1;
#pragma unroll 1
    for (int j = 0; j < jstart; ++j) acc += rdl(p0, j) * bf2f(V[(size_t)(MP + b * TS + (t - j * dl)) * 768 + h * 64 + lane]);
    const float* vbase = cache + 256 + slot * 64 + lane;
#pragma unroll 1
    for (int j0 = jstart; j0 <= 128; j0 += 32) {
        float vv[32];
#pragma unroll
        for (int i = 0; i < 32; ++i) { const int j = (j0 + i <= 128) ? j0 + i : 128; vv[i] = vbase[(size_t)(W + t - j * dl) * 512]; }
#pragma unroll
        for (int i = 0; i < 32; ++i) { const int j = j0 + i; const float pj = (j <= 128) ? rdl(j < 64 ? p0 : (j < 128 ? p1 : p2), j & 63) : 0.f; acc += pj * vv[i]; }
    }
    AO[(size_t)row * 768 + h * 64 + lane] = acc / lg;
    if (lane == 0) LSE[(size_t)row * 12 + h] = mg + __logf(lg);
}

__device__ __forceinline__ void conv_pool_pass(const bf16* CB, const bf16* U, const bf16* PIN, const float* conv_w, const float* st_conv, const float* st_pool, bf16* YA, bf16* YD, int layer, int gt, int NGT, int rep = 1) {
    for (int it0 = gt; it0 < rep * MPAD * 64; it0 += NGT) {
        const int it = it0 % (MPAD * 64); const int c8 = it & 63, row = it >> 6, ch = c8 * 8;
        int kind, b, t; row_decode(row, kind, b, t);
        if (kind == 2) { const u32x4 z = {0u, 0u, 0u, 0u}; *(u32x4*)(YA + (size_t)row * YK + YO_A + ch) = z; *(u32x4*)(YD + (size_t)row * YK + YO_D + ch) = z; continue; }
        float u0[8], u1[8], u2[8], cb[8];
        unpk8(*(const u32x4*)(U + (size_t)row * 512 + ch), u2);
        if (t >= 1) unpk8(*(const u32x4*)(U + (size_t)(row - 1) * 512 + ch), u1);
        else if (kind == 1) { const float* s = st_conv + ((size_t)(layer * NB_S + b) * 2 + 1) * 512 + ch; _Pragma("unroll") for (int j = 0; j < 8; ++j) u1[j] = s[j]; }
        else { _Pragma("unroll") for (int j = 0; j < 8; ++j) u1[j] = 0.f; }
        if (t >= 2) unpk8(*(const u32x4*)(U + (size_t)(row - 2) * 512 + ch), u0);
        else if (kind == 1) { const float* s = st_conv + ((size_t)(layer * NB_S + b) * 2 + t) * 512 + ch; _Pragma("unroll") for (int j = 0; j < 8; ++j) u0[j] = s[j]; }
        else { _Pragma("unroll") for (int j = 0; j < 8; ++j) u0[j] = 0.f; }
        unpk8(*(const u32x4*)(CB + (size_t)row * 512 + ch), cb);
        const float* cw = conv_w + (size_t)layer * 3 * 512 + ch;
        f32x4 ya0, ya1;
#pragma unroll
        for (int j = 0; j < 8; ++j) { const float z = cw[j] * u0[j] + cw[512 + j] * u1[j] + cw[1024 + j] * u2[j]; const float y = cb[j] * z; if (j < 4) ya0[j] = y; else ya1[j - 4] = y; }
        *(u32x4*)(YA + (size_t)row * YK + YO_A + ch) = pk8(ya0, ya1);
        const int grp = c8 >> 4, w = 2 << grp;
        float cur[8], sum[8];
        unpk8(*(const u32x4*)(PIN + (size_t)row * 512 + ch), cur);
#pragma unroll
        for (int j = 0; j < 8; ++j) sum[j] = cur[j];
        if (kind == 0) {
            u32x4 xr[15];
#pragma unroll
            for (int i = 1; i < 16; ++i) { const bool ok = (i < w) && (t - i >= 0); xr[i - 1] = *(const u32x4*)(PIN + (size_t)(ok ? row - i : row) * 512 + ch); }
#pragma unroll
            for (int i = 1; i < 16; ++i) { const bool ok = (i < w) && (t - i >= 0); float x[8]; unpk8(xr[i - 1], x); const float m = ok ? 1.f : 0.f;
#pragma unroll
                for (int j = 0; j < 8; ++j) sum[j] += m * x[j]; }
        } else {
            for (int i = 1; i < w; ++i) {
                const int tt = t - i;
                if (tt >= 0) { float x[8]; unpk8(*(const u32x4*)(PIN + (size_t)(row - i) * 512 + ch), x); _Pragma("unroll") for (int j = 0; j < 8; ++j) sum[j] += x[j]; }
                else { const float* s = st_pool + ((size_t)(layer * NB_S + b) * 15 + (15 + tt)) * 512 + ch; _Pragma("unroll") for (int j = 0; j < 8; ++j) sum[j] += s[j]; }
            }
        }
        const float cnt = (kind == 1) ? (float)w : fminf((float)w, (float)(t + 1));
        const float ic = 1.0f / cnt;
        f32x4 d0, d1;
#pragma unroll
        for (int j = 0; j < 8; ++j) { const float d = sum[j] * ic - cur[j]; if (j < 4) d0[j] = d; else d1[j - 4] = d; }
        *(u32x4*)(YD + (size_t)row * YK + YO_D + ch) = pk8(d0, d1);
    }
}

constexpr int GLA_UNITS = NB_P * 4 * 64;
constexpr int GP_K = 144, GP_V = 272;
constexpr int GLA_R0 = 0, GLA_R0_BYTES = 17408, GLA_QT = GLA_R0 + GLA_R0_BYTES, GLA_KT = GLA_QT + 64 * GP_K, GLA_VV = GLA_KT + 64 * GP_K, GLA_HALF = GLA_VV + 64 * GP_V;
static_assert(2 * GLA_HALF <= RING_BYTES, "GLA LDS");

__device__ __forceinline__ void gla_cumsum(LAS float* lb, const float* LA, int tok0, int h, int ht) {
    const int k = ht & 63, q = ht >> 6;
    float v[16]; float run = 0.f;
#pragma unroll
    for (int i = 0; i < 16; ++i) { run += LA[(size_t)(tok0 + 16 * q + i) * 256 + h * 64 + k]; v[i] = run; }
    LAS float* tot = lb + 4096;
    tot[q * 64 + k] = run;
    __syncthreads();
    float off = 0.f;
#pragma unroll
    for (int qq = 0; qq < 3; ++qq) off += (qq < q) ? tot[qq * 64 + k] : 0.f;
#pragma unroll
    for (int i = 0; i < 16; ++i) lb[(16 * q + i) * 64 + k] = v[i] + off;
    __syncthreads();
}

__device__ __forceinline__ void gla_ds_unit(LAS unsigned char* hl, const bf16* GK, const bf16* GV, const float* LA, float* DS, float* DEC, int unit, int ht) {
    const int n = unit & 63, bh = unit >> 6, h = bh & 3, b = bh >> 2;
    const int tok0 = b * SEQ + n * 64;
    const int lane = ht & 63, hw = ht >> 6, fr = lane & 15, g = lane >> 4;
    LAS float* lb = (LAS float*)(hl + GLA_R0);
    gla_cumsum(lb, LA, tok0, h, ht);
    for (int c = ht; c < 512; c += 256) {
        const int s = c >> 3, k0 = (c & 7) * 8;
        float kf[8]; unpk8(*(const u32x4*)(GK + (size_t)(tok0 + s) * 256 + h * 64 + k0), kf);
        f32x4 a0, a1;
#pragma unroll
        for (int j = 0; j < 8; ++j) { const float e = kf[j] * __expf(lb[63 * 64 + k0 + j] - lb[s * 64 + k0 + j]); if (j < 4) a0[j] = e; else a1[j - 4] = e; }
        *(LAS u32x4*)(hl + GLA_KT + s * GP_K + k0 * 2) = pk8(a0, a1);
    }
    for (int c = ht; c < 1024; c += 256) {
        const int s = c >> 4, v0 = (c & 15) * 8;
        *(LAS u32x4*)(hl + GLA_VV + s * GP_V + v0 * 2) = *(const u32x4*)(GV + (size_t)(tok0 + s) * 512 + h * 128 + v0);
    }
    if (ht < 64) DEC[(size_t)unit * 64 + ht] = __expf(lb[63 * 64 + ht]);
    __syncthreads();
    const int q4 = fr >> 2, p4 = fr & 3, kt = hw;
    float* dsb = DS + (size_t)unit * 64 * 128;
#pragma unroll
    for (int dvt = 0; dvt < 8; ++dvt) {
        f32x4 acc = {0.f, 0.f, 0.f, 0.f};
#pragma unroll
        for (int ks = 0; ks < 2; ++ks) {
            const int rb = 32 * ks + 4 * g + q4;
            const bf16x8 af = cat4(ds_tr16(hl + GLA_KT + rb * GP_K + (16 * kt + 4 * p4) * 2), ds_tr16(hl + GLA_KT + (rb + 16) * GP_K + (16 * kt + 4 * p4) * 2));
            const bf16x8 bf = cat4(ds_tr16(hl + GLA_VV + rb * GP_V + (16 * dvt + 4 * p4) * 2), ds_tr16(hl + GLA_VV + (rb + 16) * GP_V + (16 * dvt + 4 * p4) * 2));
            acc = __builtin_amdgcn_mfma_f32_16x16x32_bf16(af, bf, acc, 0, 0, 0);
        }
#pragma unroll
        for (int j = 0; j < 4; ++j) dsb[(size_t)(16 * kt + 4 * g + j) * 128 + 16 * dvt + fr] = acc[j];
    }
    __syncthreads();
}

__device__ __forceinline__ void gla_scan_pass(const float* DS, const float* DEC, bf16* SP, float* out, int layer, int gt, int rep = 1) {
    if (gt >= 8 * 64 * 128) return;
    for (int rr = 0; rr < rep; ++rr) {
    const int v = gt & 127, k = (gt >> 7) & 63, bh = gt >> 13;
    float S = 0.f;
    for (int n0 = 0; n0 < 64; n0 += 32) {
        float d[32], a[32];
#pragma unroll
        for (int i = 0; i < 32; ++i) { d[i] = DS[(((size_t)bh * 64 + n0 + i) * 64 + k) * 128 + v]; a[i] = DEC[((size_t)bh * 64 + n0 + i) * 64 + k]; }
#pragma unroll
        for (int i = 0; i < 32; ++i) { SP[(((size_t)bh * 64 + n0 + i) * 64 + k) * 128 + v] = (bf16)f2bf(S); S = a[i] * S + d[i]; }
    }
    out[OFF_GLA_P + (((size_t)layer * 8 + bh) * 64 + k) * 128 + v] = S;
    }
}

__device__ __forceinline__ void gla_out_unit(LAS unsigned char* hl, const bf16* GQ, const bf16* GK, const bf16* GV, const bf16* GR, const float* LA, const bf16* SP, const float* gnorm, bf16* YC, int unit, int ht) {
    const int n = unit & 63, bh = unit >> 6, h = bh & 3, b = bh >> 2;
    const int tok0 = b * SEQ + n * 64;
    const int lane = ht & 63, hw = ht >> 6, fr = lane & 15, g = lane >> 4;
    LAS float* lb = (LAS float*)(hl + GLA_R0);
    gla_cumsum(lb, LA, tok0, h, ht);
    for (int c = ht; c < 512; c += 256) {
        const int s = c >> 3, k0 = (c & 7) * 8;
        float qf[8], kf[8];
        unpk8(*(const u32x4*)(GQ + (size_t)(tok0 + s) * 256 + h * 64 + k0), qf);
        unpk8(*(const u32x4*)(GK + (size_t)(tok0 + s) * 256 + h * 64 + k0), kf);
        f32x4 a0, a1, c0, c1;
#pragma unroll
        for (int j = 0; j < 8; ++j) { const float bb = lb[s * 64 + k0 + j]; const float qe = qf[j] * __expf(bb), ke = kf[j] * __expf(-bb); if (j < 4) { a0[j] = qe; c0[j] = ke; } else { a1[j - 4] = qe; c1[j - 4] = ke; } }
        *(LAS u32x4*)(hl + GLA_QT + s * GP_K + k0 * 2) = pk8(a0, a1);
        *(LAS u32x4*)(hl + GLA_KT + s * GP_K + k0 * 2) = pk8(c0, c1);
    }
    for (int c = ht; c < 1024; c += 256) {
        const int s = c >> 4, v0 = (c & 15) * 8;
        *(LAS u32x4*)(hl + GLA_VV + s * GP_V + v0 * 2) = *(const u32x4*)(GV + (size_t)(tok0 + s) * 512 + h * 128 + v0);
    }
    __syncthreads();
    for (int c = ht; c < 1024; c += 256) {
        const int k = c >> 4, v0 = (c & 15) * 8;
        *(LAS u32x4*)(hl + GLA_R0 + k * GP_V + v0 * 2) = *(const u32x4*)(SP + ((size_t)unit * 64 + k) * 128 + v0);
    }
    __syncthreads();
    const int tt = hw, q4 = fr >> 2, p4 = fr & 3;
    f32x4 at[4];
    const LAS unsigned char* qrow = hl + GLA_QT + (16 * tt + fr) * GP_K;
    const bf16x8 qb0 = *(const LAS bf16x8*)(qrow + 16 * g), qb1 = *(const LAS bf16x8*)(qrow + 64 + 16 * g);
#pragma unroll
    for (int st = 0; st < 4; ++st) {
        const LAS unsigned char* krow = hl + GLA_KT + (16 * st + fr) * GP_K;
        f32x4 a = {0.f, 0.f, 0.f, 0.f};
        a = __builtin_amdgcn_mfma_f32_16x16x32_bf16(*(const LAS bf16x8*)(krow + 16 * g), qb0, a, 0, 0, 0);
        a = __builtin_amdgcn_mfma_f32_16x16x32_bf16(*(const LAS bf16x8*)(krow + 64 + 16 * g), qb1, a, 0, 0, 0);
#pragma unroll
        for (int j = 0; j < 4; ++j) { const int s = 16 * st + 4 * g + j, t = 16 * tt + fr; a[j] = (s <= t) ? a[j] : 0.f; }
        at[st] = a;
    }
    f32x4 o[8];
#pragma unroll
    for (int dvt = 0; dvt < 8; ++dvt) o[dvt] = (f32x4){0.f, 0.f, 0.f, 0.f};
#pragma unroll
    for (int ks = 0; ks < 2; ++ks) {
        const bf16x8 pb = pk8v(at[2 * ks], at[2 * ks + 1]);
        const int rb = 32 * ks + 4 * g + q4;
        const s16x4 qa = *(const LAS s16x4*)(qrow + (32 * ks + 4 * g) * 2), qc = *(const LAS s16x4*)(qrow + (32 * ks + 16 + 4 * g) * 2);
        const bf16x8 qp = cat4(qa, qc);
#pragma unroll
        for (int dvt = 0; dvt < 8; ++dvt) {
            const bf16x8 vf = cat4(ds_tr16(hl + GLA_VV + rb * GP_V + (16 * dvt + 4 * p4) * 2), ds_tr16(hl + GLA_VV + (rb + 16) * GP_V + (16 * dvt + 4 * p4) * 2));
            o[dvt] = __builtin_amdgcn_mfma_f32_16x16x32_bf16(vf, pb, o[dvt], 0, 0, 0);
            const bf16x8 sf = cat4(ds_tr16(hl + GLA_R0 + rb * GP_V + (16 * dvt + 4 * p4) * 2), ds_tr16(hl + GLA_R0 + (rb + 16) * GP_V + (16 * dvt + 4 * p4) * 2));
            o[dvt] = __builtin_amdgcn_mfma_f32_16x16x32_bf16(sf, qp, o[dvt], 0, 0, 0);
        }
    }
    float ss = 0.f;
#pragma unroll
    for (int dvt = 0; dvt < 8; ++dvt) ss += (o[dvt][0] * o[dvt][0] + o[dvt][1] * o[dvt][1]) + (o[dvt][2] * o[dvt][2] + o[dvt][3] * o[dvt][3]);
    ss += shx(ss, 16, lane); ss += shx(ss, 32, lane);
    const float rs = rsqrtf(ss * (1.0f / 128.0f) + EPS);
    const size_t orow = (size_t)(tok0 + 16 * tt + fr) * 512 + h * 128, yrow = (size_t)(tok0 + 16 * tt + fr) * YK + YO_C + h * 128;
#pragma unroll
    for (int dvt = 0; dvt < 8; ++dvt) {
        const int dv = 16 * dvt + 4 * g;
        const f32x4 gn = *(const f32x4*)(gnorm + dv);
        const u32x2 gw = *(const u32x2*)(GR + orow + dv);
        f32x4 y; y[0] = o[dvt][0] * rs * gn[0] * bflo(gw.x); y[1] = o[dvt][1] * rs * gn[1] * bfhi(gw.x); y[2] = o[dvt][2] * rs * gn[2] * bflo(gw.y); y[3] = o[dvt][3] * rs * gn[3] * bfhi(gw.y);
        u32x2 wv; wv.x = pk2(y[0], y[1]); wv.y = pk2(y[2], y[3]);
        *(u32x2*)(YC + yrow + dv) = wv;
    }
    __syncthreads();
}

__device__ __forceinline__ void gla_sample_unit(LAS float* red, const bf16* GQ, const bf16* GK, const bf16* GV, const bf16* GR, const float* LA, const float* st_gla, const float* gnorm, bf16* YC, float* out, int layer, int unit, int tid) {
    const int h = unit & 3, b = unit >> 2;
    const int dv = tid & 127, kq = tid >> 7;
    const float* s0 = st_gla + (((size_t)(layer * NB_S + b) * 4 + h) * 64 + 16 * kq) * 128 + dv;
    float S[16];
#pragma unroll
    for (int i = 0; i < 16; ++i) S[i] = s0[(size_t)i * 128];
#pragma unroll 1
    for (int t = 0; t < TS; ++t) {
        const int row = MP + b * TS + t;
        const float vv = bf2f(GV[(size_t)row * 512 + h * 128 + dv]);
        float po = 0.f;
#pragma unroll
        for (int i = 0; i < 16; ++i) {
            const int k = 16 * kq + i;
            const float a = __expf(LA[(size_t)row * 256 + h * 64 + k]);
            S[i] = a * S[i] + bf2f(GK[(size_t)row * 256 + h * 64 + k]) * vv;
            po += bf2f(GQ[(size_t)row * 256 + h * 64 + k]) * S[i];
        }
        red[kq * 128 + dv] = po;
        __syncthreads();
        float o = 0.f, sq = 0.f;
        if (kq == 0) { o = (red[dv] + red[128 + dv]) + (red[256 + dv] + red[384 + dv]); sq = o * o; }
        sq = wave_sum(sq, tid & 63);
        if (kq == 0 && (tid & 63) == 0) red[512 + (tid >> 6)] = sq;
        __syncthreads();
        if (kq == 0) {
            const float rs = rsqrtf((red[512] + red[513]) * (1.0f / 128.0f) + EPS);
            const float y = o * rs * gnorm[dv] * bf2f(GR[(size_t)row * 512 + h * 128 + dv]);
            YC[(size_t)row * YK + YO_C + h * 128 + dv] = (bf16)f2bf(y);
        }
        __syncthreads();
    }
    float* so = out + OFF_GLA_S + (((size_t)(layer * NB_S + b) * 4 + h) * 64 + 16 * kq) * 128 + dv;
#pragma unroll
    for (int i = 0; i < 16; ++i) so[(size_t)i * 128] = S[i];
}

constexpr int PH_PER_LAYER = 13, NPH = 1 + DEPTH * PH_PER_LAYER;
#define RM(bit) (1 + ((PROBE_DUP >> (bit)) & 1))
#define REP(bit) for (int rep_ = 0; rep_ < 1 + ((PROBE_DUP >> (bit)) & 1); ++rep_)
#ifndef PROBE_SP2
#define PROBE_SP2 true
#endif
#ifndef PROBE_ALIGN_GU
#define PROBE_ALIGN_GU true
#endif
#ifndef PROBE_ALIGN_RES
#define PROBE_ALIGN_RES true
#endif
#ifndef PROBE_ALIGN_WIN
#define PROBE_ALIGN_WIN true
#endif
#ifndef MK_UNROLL_LAYERS
#define MK_UNROLL_LAYERS 1
#endif
#ifndef MK_PER_PHASE
#define MK_PER_PHASE 0
#endif

struct Args { const float* in[31]; float* out; unsigned char* ws; int ph_lo, ph_hi; };
static_assert(sizeof(Args) == 31 * 8 + 8 + 8 + 8, "Args has no padding");

__device__ __forceinline__ unsigned char* launder(unsigned char* p) { asm volatile("" : "+s"(p)); return p; }
__device__ __forceinline__ int opq_v(int x) { asm volatile("" : "+v"(x)); return x; }
__device__ __forceinline__ int opq_s(int x) { asm volatile("" : "+s"(x)); return x; }

#define IN(k) (lo <= (k) && (k) < hi)
#define SEAM(k) do { if (IN((k) + 1)) { XcdBarrier bar_; bar_.bar = (unsigned*)(WSP() + WS_CTL) + CW_BAR; bar_.x = xb_xcc_id(); bar_.st = (volatile LAS unsigned*)(lds + MISC_OFF) + 8; REP(13) xcd_barrier(bar_, tid); } } while (0)
#define GW (bid * NWAVES + wave)
#define NGW (G * NWAVES)
#define GT (bid * NTHR + tid)
#define NGT (G * NTHR)
#define WSP() launder((unsigned char*)ldp(lds, PT_WS))
#define IDS() const int wave = opq_s(wave0), lane = (int)__builtin_amdgcn_mbcnt_hi(~0u, __builtin_amdgcn_mbcnt_lo(~0u, (unsigned)opq_v(0))), tid = wave * 64 + lane, G = opq_s(G0), bid = opq_s(bid0); (void)lane; (void)wave; (void)G; (void)bid
struct Ctx { LAS unsigned char* lds; int tid0, wave0, G0, bid0, lo, hi; };
#define CTX_LOCALS() LAS unsigned char* lds = c.lds; const int tid0 = c.tid0, wave0 = c.wave0, G0 = c.G0, bid0 = c.bid0, lo = c.lo, hi = c.hi; (void)lds; (void)tid0; (void)wave0; (void)G0; (void)bid0; (void)lo; (void)hi

__device__ __forceinline__ void ff_part(const Ctx c, const int l, const int f) {
    CTX_LOCALS();
    const int pb = 1 + l * PH_PER_LAYER;
    const int fb = pb + (f ? 10 : 0);
    if (IN(fb + 1)) {
        { IDS(); unsigned char* ws = WSP(); const bf16* wl = (const bf16*)(ws + WS_W) + (size_t)l * WE_LAYER;
          pg8::Gemm g{(const bf16*)(ws + WS_XN), wl + (f ? WE_GU2 : WE_GU1), MP, NGU, DM}; pg8::StaticOrder S; S.init(MP, NGU, G, bid, RM(4));
          EpiSwiGLU E{ws, 3 * l + (f ? 2 : 0)};
          pg8::gemm_phase<EpiSwiGLU, pg8::StaticOrder, PROBE_ALIGN_GU, PROBE_SP2>(lds + RING_OFF, g, S, E, tid); }
        { IDS(); unsigned char* ws = WSP(); const bf16* wl = (const bf16*)(ws + WS_W) + (size_t)l * WE_LAYER; EpiSwiGLU E{ws, 3 * l + (f ? 2 : 0)};
          for (int su = G - 1 - bid; su < RM(9) * (NGU / 64); su += G) skinny_unit<EpiSwiGLU>(lds + RING_OFF, (const bf16*)(ws + WS_XN), wl + (f ? WE_GU2 : WE_GU1), DM, su % (NGU / 64), E, tid); }
        { IDS(); unsigned char* ws = WSP();
          const int dfirst = (f == 0) ? l * PB_LAYER + 1376 : (l + 1) * PB_LAYER;
          if (G == 256 && bid >= DEFER_WG0 && (f == 0 || l < DEPTH - 1)) prologue_blocks(lds, (bf16*)(ws + WS_W), dfirst, DEFER_N, bid - DEFER_WG0, DEFER_WGS, tid, false);
          { const int slot = 2 * l + f; const int c0 = (int)((long)CACHE_COPY_N * slot / 10), c1 = (slot == 7) ? CACHE_COPY_N : (int)((long)CACHE_COPY_N * (slot + 1) / 10);
            if (G == 256) { if (bid >= DEFER_WG0) cache_copy_range(ldp(lds, 3), ldp(lds, 4), ldp(lds, 5), (float*)ldp(lds, PT_OUT), c0, c1, (bid - DEFER_WG0) * NTHR + tid, DEFER_WGS * NTHR); }
            else cache_copy_range(ldp(lds, 3), ldp(lds, 4), ldp(lds, 5), (float*)ldp(lds, PT_OUT), c0, c1, GT, NGT); } }
        IDS();
        SEAM(fb + 1);
    }
    if (IN(fb + 2)) {
        { IDS(); unsigned char* ws = WSP(); const bf16* wl = (const bf16*)(ws + WS_W) + (size_t)l * WE_LAYER;
          pg8::Gemm g{(const bf16*)(ws + WS_H), wl + (f ? WE_D2 : WE_D1), MP, DM, DFF}; pg8::StaticOrder S; S.init(MP, DM, G, bid, RM(10));
          EpiResid E{ws, lds, 0.5f, (f == 1 && l == DEPTH - 1) ? 1 : 0, (f == 0) ? 3 * l + 1 : (l < DEPTH - 1 ? 3 * l + 3 : -1)};
          pg8::gemm_phase<EpiResid, pg8::StaticOrder, PROBE_ALIGN_RES, PROBE_SP2>(lds + RING_OFF, g, S, E, tid); }
        { IDS(); unsigned char* ws = WSP(); const bf16* wl = (const bf16*)(ws + WS_W) + (size_t)l * WE_LAYER; EpiResid E{ws, lds, 0.5f, (f == 1 && l == DEPTH - 1) ? 1 : 0, (f == 0) ? 3 * l + 1 : (l < DEPTH - 1 ? 3 * l + 3 : -1)};
          for (int su = G - 1 - bid; su < DM / 64; su += G) skinny_unit<EpiResid>(lds + RING_OFF, (const bf16*)(ws + WS_H), wl + (f ? WE_D2 : WE_D1), DFF, su, E, tid); }
        IDS();
        SEAM(fb + 2);
    }
}

__device__ __forceinline__ void mixer_part(const Ctx c, const int l) {
    CTX_LOCALS();
    const int pb = 1 + l * PH_PER_LAYER;
    if (IN(pb + 4)) {
        { IDS(); unsigned char* ws = WSP(); const bf16* wl = (const bf16*)(ws + WS_W) + (size_t)l * WE_LAYER;
          pg8::Gemm g{(const bf16*)(ws + WS_XN), wl + WE_IN, MP, NWIN, DM}; pg8::StaticOrder S; S.init(MP, NWIN, G, bid, RM(3));
          EpiWin E{ws, ldp(lds, 15) + (size_t)l * 768, ldp(lds, 16) + (size_t)l * 768, ldp(lds, 18) + (size_t)l * 256, (float*)ldp(lds, PT_OUT), l, 3 * l + 1};
          pg8::gemm_phase<EpiWin, pg8::StaticOrder, PROBE_ALIGN_WIN, PROBE_SP2>(lds + RING_OFF, g, S, E, tid); }
        { IDS(); unsigned char* ws = WSP(); const bf16* wl = (const bf16*)(ws + WS_W) + (size_t)l * WE_LAYER;
          EpiWin E{ws, ldp(lds, 15) + (size_t)l * 768, ldp(lds, 16) + (size_t)l * 768, ldp(lds, 18) + (size_t)l * 256, (float*)ldp(lds, PT_OUT), l, 3 * l + 1};
          for (int su = G - 1 - bid; su < RM(9) * (NWIN / 64); su += G) skinny_unit<EpiWin>(lds + RING_OFF, (const bf16*)(ws + WS_XN), wl + WE_IN, DM, su % (NWIN / 64), E, tid); }
        IDS();
        SEAM(pb + 4);
    }
    if (IN(pb + 5)) {
        IDS();
        { unsigned char* ws = WSP();
          for (int u = bid; u < RM(1) * ATT_UNITS; u += G) attn_unit(lds, (const bf16*)(ws + WS_Q), (const bf16*)(ws + WS_K), (const bf16*)(ws + WS_V), (float*)(ws + WS_AO), (float*)(ws + WS_LSE), u % ATT_UNITS, tid); }
        { unsigned char* ws = WSP();
          for (int u2 = bid; u2 < RM(5) * (GLA_UNITS / 2); u2 += G) gla_ds_unit(lds + (tid >> 8) * GLA_HALF, (const bf16*)(ws + WS_GK), (const bf16*)(ws + WS_GV), (const float*)(ws + WS_LA), (float*)(ws + WS_DS), (float*)(ws + WS_DEC), 2 * (u2 % (GLA_UNITS / 2)) + (tid >> 8), tid & 255); }
        { unsigned char* ws = WSP();
          conv_pool_pass((const bf16*)(ws + WS_CB), (const bf16*)(ws + WS_U), (const bf16*)(ws + WS_PIN), ldp(lds, 14), ldp(lds, 2), ldp(lds, 7), (bf16*)(ws + WS_YCAT), (bf16*)(ws + WS_YCAT), l, GT, NGT, RM(6)); }
        REP(8) { const int su = (NGW - 1 - GW);
          if (su < NB_S * TS * 12) { unsigned char* ws = WSP(); attn_sample_wave((const bf16*)(ws + WS_Q), (const bf16*)(ws + WS_K), (const bf16*)(ws + WS_V), ldp(lds, 3), ldp(lds, 4), ldp(lds, 5), (float*)(ws + WS_AO), (float*)(ws + WS_LSE), l, su, lane); } }
        REP(8) { unsigned char* ws = WSP();
          for (int u = bid - 64; u >= 0 && u < NB_S * 4; u += G) gla_sample_unit((LAS float*)lds, (const bf16*)(ws + WS_GQ), (const bf16*)(ws + WS_GK), (const bf16*)(ws + WS_GV), (const bf16*)(ws + WS_GR), (const float*)(ws + WS_LA), ldp(lds, 6), ldp(lds, 19) + (size_t)l * 128, (bf16*)(ws + WS_YCAT), (float*)ldp(lds, PT_OUT), l, u, tid); }
        SEAM(pb + 5);
    }
    if (IN(pb + 6)) {
        IDS(); unsigned char* ws = WSP();
        gla_scan_pass((const float*)(ws + WS_DS), (const float*)(ws + WS_DEC), (bf16*)(ws + WS_SP), (float*)ldp(lds, PT_OUT), l, GT, RM(7));
        attn_merge_pass((const float*)(ws + WS_AO), (const float*)(ws + WS_LSE), (bf16*)(ws + WS_YCAT), GT, NGT, RM(7));
        SEAM(pb + 6);
    }
    if (IN(pb + 7)) {
        IDS(); unsigned char* ws = WSP();
        for (int u2 = bid; u2 < RM(5) * (GLA_UNITS / 2); u2 += G) gla_out_unit(lds + (tid >> 8) * GLA_HALF, (const bf16*)(ws + WS_GQ), (const bf16*)(ws + WS_GK), (const bf16*)(ws + WS_GV), (const bf16*)(ws + WS_GR), (const float*)(ws + WS_LA), (const bf16*)(ws + WS_SP), ldp(lds, 19) + (size_t)l * 128, (bf16*)(ws + WS_YCAT), 2 * (u2 % (GLA_UNITS / 2)) + (tid >> 8), tid & 255);
        SEAM(pb + 7);
    }
    if (IN(pb + 8)) {
        REP(11) {
        { IDS(); unsigned char* ws = WSP(); const bf16* wl = (const bf16*)(ws + WS_W) + (size_t)l * WE_LAYER; pg8::StaticOrder S; S.init(MP, DM, G, bid);
          pg8::Gemm g{(const bf16*)(ws + WS_YCAT), wl + WE_UPCAT, MP, DM, YK}; EpiMergeCat E{ws};
          pg8::gemm_phase<EpiMergeCat, pg8::StaticOrder, true, PROBE_SP2>(lds + RING_OFF, g, S, E, tid); }
        { IDS(); unsigned char* ws = WSP(); const bf16* wl = (const bf16*)(ws + WS_W) + (size_t)l * WE_LAYER; const bf16* yc = (const bf16*)(ws + WS_YCAT); const bf16* uc = wl + WE_UPCAT;
          for (int su = G - 1 - bid; su < DM / 64; su += G) skinny_merge_unit(lds + RING_OFF, ws, yc, uc, su, tid); }
        }
        IDS();
        SEAM(pb + 8);
    }
    if (IN(pb + 9)) {
        { IDS(); unsigned char* ws = WSP(); const bf16* wl = (const bf16*)(ws + WS_W) + (size_t)l * WE_LAYER;
          pg8::Gemm g{(const bf16*)(ws + WS_MRG), wl + WE_OUT, MP, DM, DM}; pg8::StaticOrder S; S.init(MP, DM, G, bid, RM(12));
          EpiResid E{ws, lds, 1.0f, 0, 3 * l + 2};
#if (PROBE_DUP >> 14) & 1
          { pg8::Gemm g0{(const bf16*)(ws + WS_MRG), wl + WE_OUT, MP, DM, 256}; EpiResid E0{ws, lds, 0.0f, 0, -1};
            pg8::gemm_phase<EpiResid, pg8::StaticOrder, PROBE_ALIGN_RES, PROBE_SP2>(lds + RING_OFF, g0, S, E0, tid); }
#endif
          pg8::gemm_phase<EpiResid, pg8::StaticOrder, PROBE_ALIGN_RES, PROBE_SP2>(lds + RING_OFF, g, S, E, tid); }
        { IDS(); unsigned char* ws = WSP(); const bf16* wl = (const bf16*)(ws + WS_W) + (size_t)l * WE_LAYER; EpiResid E{ws, lds, 1.0f, 0, 3 * l + 2};
          for (int su = G - 1 - bid; su < DM / 64; su += G) skinny_unit<EpiResid>(lds + RING_OFF, (const bf16*)(ws + WS_MRG), wl + WE_OUT, DM, su, E, tid); }
        IDS();
        SEAM(pb + 9);
    }
}

__global__ void __launch_bounds__(NTHR, 2) fwd_kernel(Args args) {
    extern __shared__ __attribute__((aligned(16))) unsigned char lds_raw[];
    LAS unsigned char* lds = (LAS unsigned char*)lds_raw;
    const int tid0 = threadIdx.x; const int wave0 = __builtin_amdgcn_readfirstlane(tid0 >> 6);
    const int G0 = gridDim.x, bid0 = blockIdx.x;
    { const int tid = tid0; for (int u = tid; u < (LDS_BYTES - LDSCTL_OFF) / 4; u += NTHR) ((LAS unsigned*)(lds + LDSCTL_OFF))[u] = 0u; }
    __syncthreads();
    if (tid0 == 0) {
        LAS unsigned long long* pt = (LAS unsigned long long*)(lds + PT_OFF);
#pragma unroll
        for (int i = 0; i < 31; ++i) pt[i] = (unsigned long long)args.in[i];
        pt[PT_OUT] = (unsigned long long)args.out; pt[PT_WS] = (unsigned long long)args.ws;
    }
    __syncthreads();
    if (!MK_PER_PHASE) (void)xcd_barrier_post((unsigned*)(args.ws + WS_CTL) + CW_BAR, (volatile LAS unsigned*)(lds + MISC_OFF) + 8);
    const int lo = args.ph_lo, hi = args.ph_hi;

    if (IN(0)) {
        IDS(); unsigned char* ws = WSP(); float* out = (float*)ldp(lds, PT_OUT);
        REP(0) { prologue_blocks(lds, (bf16*)(ws + WS_W), 0, DEPTH * PB_LAYER, bid, G, tid, G == 256); prologue_specials(lds, (bf16*)(ws + WS_W), G - 1 - bid, G, tid); }
        x_init_pass(ldp(lds, 0), ldp(lds, 1), (bf16*)(ws + WS_XN), (unsigned long long*)(ws + WS_CTL + CTL_SS), GW, NGW, lane);
        { const f32x4* src = (const f32x4*)ldp(lds, 7); f32x4* dst = (f32x4*)(out + OFF_POOL_S); const int per = 11 * 128;
          for (int i = GT; i < DEPTH * NB_S * per; i += NGT) { const int lb = i / per, j = i - lb * per; dst[(size_t)lb * 15 * 128 + j] = src[(size_t)lb * 15 * 128 + 4 * 128 + j]; } }
        SEAM(0);
    }

    { Ctx c; c.lds = lds; c.tid0 = tid0; c.wave0 = wave0; c.G0 = G0; c.bid0 = bid0; c.lo = lo; c.hi = hi;
#if MK_UNROLL_LAYERS
      ff_part(c, 0, 0); mixer_part(c, 0); ff_part(c, 0, 1); ff_part(c, 1, 0); mixer_part(c, 1); ff_part(c, 1, 1);
      ff_part(c, 2, 0); mixer_part(c, 2); ff_part(c, 2, 1); ff_part(c, 3, 0); mixer_part(c, 3); ff_part(c, 3, 1);
#else
      _Pragma("unroll 1") for (int l = 0; l < DEPTH; ++l) {
          _Pragma("unroll 1") for (int f = 0; f < 2; ++f) { ff_part(c, l, f); if (f == 0) mixer_part(c, l); }
      }
#endif
    }
#undef IN
#undef SEAM
}

extern "C" void kernel_launch(void* const* d_in, const int* in_sizes, int n_in, void* d_out, int out_size, void* d_ws, size_t ws_size, hipStream_t stream) {
    static int grid = 0;
    if (grid == 0) {
        if (n_in != 31 || out_size != OUT_TOTAL || ws_size < WS_END) { fprintf(stderr, "kernel_launch: expected 31 inputs, %d outputs, >= %zu bytes ws; got %d, %d, %zu\n", OUT_TOTAL, (size_t)WS_END, n_in, out_size, ws_size); grid = -1; return; }
        int dev = 0, cus = 0, per_cu = 0;
        if (hipGetDevice(&dev) != hipSuccess || hipDeviceGetAttribute(&cus, hipDeviceAttributeMultiprocessorCount, dev) != hipSuccess) { grid = -1; return; }
        if (hipFuncSetAttribute((const void*)fwd_kernel, hipFuncAttributeMaxDynamicSharedMemorySize, LDS_BYTES) != hipSuccess) { fprintf(stderr, "kernel_launch: hipFuncSetAttribute failed\n"); grid = -1; return; }
        if (hipOccupancyMaxActiveBlocksPerMultiprocessor(&per_cu, (const void*)fwd_kernel, NTHR, LDS_BYTES) != hipSuccess || per_cu < 1) fprintf(stderr, "kernel_launch: occupancy query says %d\n", per_cu);
        (void)hipGetLastError();
        grid = cus;
    }
    if (grid < 0) return;
    if (hipMemsetAsync((char*)d_ws + WS_CTL, 0, CTL_ZERO_BYTES, stream) != hipSuccess) return;
    Args a; memset(&a, 0, sizeof(a));
    for (int i = 0; i < 31; ++i) a.in[i] = (const float*)d_in[i];
    a.out = (float*)d_out; a.ws = (unsigned char*)d_ws;
#if MK_PER_PHASE
    for (int ph = 0; ph < NPH; ++ph) { a.ph_lo = ph; a.ph_hi = ph + 1; hipLaunchKernelGGL(fwd_kernel, dim3(grid), dim3(NTHR), LDS_BYTES, stream, a); }
#else
    a.ph_lo = 0; a.ph_hi = NPH;
    hipLaunchKernelGGL(fwd_kernel, dim3(grid), dim3(NTHR), LDS_BYTES, stream, a);
#endif
    const hipError_t le = hipPeekAtLastError();
    if (le != hipSuccess) fprintf(stderr, "kernel_launch: launch failed: %s\n", hipGetErrorName(le));
}
```

```cpp
#include <hip/hip_runtime.h>
#include <cstdio>
#include <cstdint>
#include <cstring>
#ifndef PROBE_DUP
#define PROBE_DUP 0
#endif
namespace pg8 {
#define PG8_LAS __attribute__((address_space(3)))
typedef unsigned short bf16_t;
typedef short bf16x8 __attribute__((ext_vector_type(8)));
typedef float f32x4 __attribute__((ext_vector_type(4)));
typedef unsigned u32x4 __attribute__((ext_vector_type(4)));
constexpr int BM = 256, BK = 64, HALF = 128, HTB = HALF * BK * 2  , STAGE_BYTES = 8 * HTB, NXCD = 8, WGM = 8;

__host__ __device__ __forceinline__ int lds_byte(int r, int c) { const int st = (r >> 4) * 2 + (c >> 5), rr = r & 15, cc = c & 31, ob = rr * 64 + cc * 2; return st * 1024 + (ob ^ (((ob >> 9) & 1) << 5)); }
__host__ __device__ __forceinline__ void stage_rc(int b, int& R, int& C) { const int st = b / 1024, sb = b % 1024, swz = sb ^ (((sb >> 9) & 1) << 5); R = (st >> 1) * 16 + swz / 64; C = (st & 1) * 32 + (swz % 64) / 2; }
__host__ __device__ __forceinline__ int perm32(int rho) { const int n = rho >> 4, i = rho & 15; return 8 * (i >> 2) + 4 * n + (i & 3); }

struct Unit { int pm, pn, ri; };
struct Gemm { const bf16_t* A; const bf16_t* Bt; int M, N, K; };

struct StaticOrder {
    int nM, nN, nwg, G, c, rep;
    __host__ __device__ void init(int M, int N, int G_, int c_, int rep_ = 1) { nM = M / BM; nN = N / BM; nwg = nM * nN; G = G_; c = c_; rep = rep_; }
    __host__ __device__ bool next(int i, Unit& u) const {
        const long L = (long)i * G + c; if (L >= (long)rep * nwg) return false;
        int wgid = (int)(L % nwg);
#if (PROBE_DUP >> 15) & 1
        if (L >= nwg) wgid = 0;
#endif
        { const int q = nwg / NXCD, r = nwg % NXCD, xcd = wgid % NXCD, off = wgid / NXCD; wgid = (xcd < r ? xcd * (q + 1) : r * (q + 1) + (xcd - r) * q) + off; }
        const int nig = WGM * nN, gid = wgid / nig, fm = gid * WGM, gsz = (nM - fm) < WGM ? (nM - fm) : WGM;
        u.pm = fm + ((wgid % nig) % gsz); u.pn = (wgid % nig) / gsz; u.ri = (int)(L / nwg); return true;
    }
    __device__ __forceinline__ void a_ready(const Unit&) const {}
    __device__ __forceinline__ void done(const Unit&) const {}
};

template <class Epi, class Sched, bool ALIGN_EPI = false, bool SP2 = false>
__device__ __forceinline__ void gemm_phase(PG8_LAS unsigned char* lds, const Gemm g, const Sched S, const Epi E, const int tid) {
    const int wid = __builtin_amdgcn_readfirstlane(tid >> 6), lane = tid & 63, wr = wid >> 2, wc = wid & 3, fr = lane & 15, fq = lane >> 4;
    const int K = g.K, nt = K / BK;
    unsigned voffA[2], voffB[2];
#pragma unroll
    for (int i = 0; i < 2; ++i) { int R, C; stage_rc(tid * 16 + i * 8192, R, C); const int Rb = Epi::PERM ? ((R & ~31) + perm32(R & 31)) : R;
        voffA[i] = (unsigned)(R * K + C) * 2u; voffB[i] = (unsigned)(tid * 16 + i * 8192); (void)Rb; }
    const size_t kstep = (size_t)(BK * 2);
    const size_t hstep = (size_t)HALF * K * 2;
    const size_t tstep = 2 * hstep;
    const size_t kstepB = 32768, hstepB = 16384, tstepB = (size_t)nt * 32768;
    const unsigned ldsw = (unsigned)wid * 1024u;
    const int aoff = lds_byte(wr * 64 + fr, fq * 8), boff = lds_byte(wc * 32 + fr, fq * 8);
#define PG8_SA(b, h) (((b) * 2 + (h)) * HTB)
#define PG8_SB(b, h) ((4 + (b) * 2 + (h)) * HTB)
#define PG8_STAGE(bufoff, gbase, voff) do { _Pragma("unroll") for (int _i = 0; _i < 2; ++_i) \
        __builtin_amdgcn_global_load_lds((const unsigned*)((const char*)(gbase) + (voff)[_i]), (PG8_LAS unsigned*)(lds + (bufoff) + ldsw + _i * 8192), 16, 0, 0); } while (0)
#define PG8_LDA(dst, b, h) do { _Pragma("unroll") for (int m = 0; m < 4; ++m) _Pragma("unroll") for (int k = 0; k < 2; ++k) dst[m][k] = *(const PG8_LAS bf16x8*)(lds + PG8_SA(b, h) + aoff + m * 2048 + k * 1024); } while (0)
#define PG8_LDB(dst, b, h) do { _Pragma("unroll") for (int n = 0; n < 2; ++n) _Pragma("unroll") for (int k = 0; k < 2; ++k) dst[n][k] = *(const PG8_LAS bf16x8*)(lds + PG8_SB(b, h) + boff + n * 2048 + k * 1024); } while (0)
#define PG8_MMA(ai, bj, At, Bt) do { __builtin_amdgcn_s_setprio(1); _Pragma("unroll") for (int m = 0; m < 4; ++m) _Pragma("unroll") for (int n = 0; n < 2; ++n) _Pragma("unroll") for (int k = 0; k < 2; ++k) \
        acc[ai][bj][m][n] = __builtin_amdgcn_mfma_f32_16x16x32_bf16(Bt[n][k], At[m][k], acc[ai][bj][m][n], 0, 0, 0); __builtin_amdgcn_s_setprio(0); } while (0)
#define PG8_WAIT_V(n) asm volatile("s_waitcnt vmcnt(" #n ")" ::: "memory")
#define PG8_WAIT_L(n) asm volatile("s_waitcnt lgkmcnt(" #n ")" ::: "memory")
#define PG8_BAR __builtin_amdgcn_s_barrier()
#define PG8_SCHED __builtin_amdgcn_sched_barrier(0)
    Unit cur, nxt; int ui = 0;
    if (!S.next(0, cur)) return;
    f32x4 acc[2][2][4][2];
#pragma unroll
    for (int a = 0; a < 2; ++a)
#pragma unroll
        for (int b = 0; b < 2; ++b)
#pragma unroll
            for (int m = 0; m < 4; ++m)
#pragma unroll
                for (int n = 0; n < 2; ++n) acc[a][b][m][n] = (f32x4){0.f, 0.f, 0.f, 0.f};
    bf16x8 At[4][2], B0[2][2], B1[2][2];
    const char* cA = (const char*)g.A + (size_t)cur.pm * tstep; const char* cB = (const char*)g.Bt + (size_t)cur.pn * tstepB;
    S.a_ready(cur);
    if constexpr (SP2) {
        PG8_STAGE(PG8_SB(0, 0), cB, voffB); PG8_STAGE(PG8_SB(0, 1), cB + hstepB, voffB); PG8_STAGE(PG8_SA(0, 0), cA, voffA); PG8_STAGE(PG8_SA(0, 1), cA + hstep, voffA);
        if (wr == 1) PG8_BAR;
        PG8_WAIT_V(2); PG8_BAR;
        PG8_STAGE(PG8_SB(1, 0), cB + kstepB, voffB); PG8_STAGE(PG8_SA(1, 0), cA + kstep, voffA); PG8_STAGE(PG8_SB(1, 1), cB + hstepB + kstepB, voffB);
        PG8_WAIT_V(6); PG8_BAR;
    } else {
        PG8_STAGE(PG8_SB(0, 0), cB, voffB); PG8_STAGE(PG8_SA(0, 0), cA, voffA); PG8_STAGE(PG8_SB(0, 1), cB + hstepB, voffB); PG8_STAGE(PG8_SA(0, 1), cA + hstep, voffA);
        if (wr == 1) PG8_BAR;
        PG8_WAIT_V(4); PG8_BAR;
        PG8_STAGE(PG8_SB(1, 0), cB + kstepB, voffB); PG8_STAGE(PG8_SA(1, 0), cA + kstep, voffA); PG8_STAGE(PG8_SB(1, 1), cB + hstepB + kstepB, voffB);
        PG8_WAIT_V(6); PG8_BAR;
    }
    for (;;) {
        const bool has_next = S.next(ui + 1, nxt);
        const char* nA = has_next ? (const char*)g.A + (size_t)nxt.pm * tstep : cA; const char* nB = has_next ? (const char*)g.Bt + (size_t)nxt.pn * tstepB : cB;
        for (int t = 0; t < nt; t += 2) {
            const bool last = (t == nt - 2);
            const char* a1 = cA + (size_t)(t + 1) * kstep;
            const char* a2 = last ? nA : cA + (size_t)(t + 2) * kstep; const char* b2 = last ? nB : cB + (size_t)(t + 2) * kstepB;
            const char* a3 = a2 + kstep; const char* b3 = b2 + kstepB;
            if (last && has_next) S.a_ready(nxt);
            if constexpr (Epi::HAS_MID) { if (t == 8 || t == 12 || t == 20) E.mid(acc, cur, t, wr, wc, fr, fq); }
            if constexpr (SP2) {
            PG8_LDB(B0, 0, 0); PG8_LDB(B1, 0, 1); PG8_SCHED; PG8_LDA(At, 0, 0); PG8_STAGE(PG8_SA(1, 1), a1 + hstep, voffA);
            PG8_WAIT_V(8); PG8_WAIT_L(0); PG8_BAR; PG8_MMA(0, 0, At, B0); PG8_MMA(0, 1, At, B1); PG8_BAR; PG8_SCHED;
            PG8_LDA(At, 0, 1); PG8_STAGE(PG8_SB(0, 0), b2, voffB); PG8_STAGE(PG8_SB(0, 1), b2 + hstepB, voffB); PG8_STAGE(PG8_SA(0, 0), a2, voffA);
            PG8_WAIT_V(8); PG8_WAIT_L(0); PG8_BAR; PG8_MMA(1, 0, At, B0); PG8_MMA(1, 1, At, B1); PG8_BAR; PG8_SCHED;
            PG8_LDB(B0, 1, 0); PG8_LDB(B1, 1, 1); PG8_SCHED; PG8_LDA(At, 1, 0); PG8_STAGE(PG8_SA(0, 1), a2 + hstep, voffA);
            PG8_WAIT_V(8); PG8_WAIT_L(0); PG8_BAR; PG8_MMA(0, 0, At, B0); PG8_MMA(0, 1, At, B1); PG8_BAR; PG8_SCHED;
            PG8_LDA(At, 1, 1); PG8_STAGE(PG8_SB(1, 0), b3, voffB); PG8_STAGE(PG8_SB(1, 1), b3 + hstepB, voffB); PG8_STAGE(PG8_SA(1, 0), a3, voffA);
            PG8_WAIT_V(8); PG8_WAIT_L(0); PG8_BAR; PG8_MMA(1, 0, At, B0); PG8_MMA(1, 1, At, B1); PG8_BAR; PG8_SCHED;
            } else {
            PG8_LDB(B0, 0, 0); PG8_SCHED; PG8_LDA(At, 0, 0); PG8_STAGE(PG8_SA(1, 1), a1 + hstep, voffA);
            PG8_WAIT_L(8); PG8_BAR; PG8_WAIT_L(0); PG8_MMA(0, 0, At, B0); PG8_BAR; PG8_SCHED;
            PG8_LDB(B1, 0, 1); PG8_STAGE(PG8_SB(0, 0), b2, voffB);
            PG8_BAR; PG8_WAIT_L(0); PG8_MMA(0, 1, At, B1); PG8_BAR;
            PG8_LDA(At, 0, 1); PG8_STAGE(PG8_SA(0, 0), a2, voffA);
            PG8_BAR; PG8_WAIT_L(0); PG8_MMA(1, 0, At, B0); PG8_BAR; PG8_SCHED;
            PG8_STAGE(PG8_SB(0, 1), b2 + hstepB, voffB);
            PG8_WAIT_V(6); PG8_BAR; PG8_MMA(1, 1, At, B1); PG8_BAR;
            PG8_LDB(B0, 1, 0); PG8_SCHED; PG8_LDA(At, 1, 0); PG8_STAGE(PG8_SA(0, 1), a2 + hstep, voffA);
            PG8_WAIT_L(8); PG8_BAR; PG8_WAIT_L(0); PG8_MMA(0, 0, At, B0); PG8_BAR; PG8_SCHED;
            PG8_LDB(B1, 1, 1); PG8_STAGE(PG8_SB(1, 0), b3, voffB);
            PG8_BAR; PG8_WAIT_L(0); PG8_MMA(0, 1, At, B1); PG8_BAR;
            PG8_LDA(At, 1, 1); PG8_STAGE(PG8_SA(1, 0), a3, voffA);
            PG8_BAR; PG8_WAIT_L(0); PG8_MMA(1, 0, At, B0); PG8_BAR; PG8_SCHED;
            PG8_STAGE(PG8_SB(1, 1), b3 + hstepB, voffB);
            PG8_WAIT_V(6); PG8_BAR; PG8_MMA(1, 1, At, B1); PG8_BAR;
            }
        }
        if constexpr (ALIGN_EPI) { if (wr == 0) PG8_BAR; }
        if constexpr (!Epi::AFTER_DRAIN) { E(acc, cur, wr, wc, fr, fq); S.done(cur); }
        if (!has_next) break;
#pragma unroll
        for (int a = 0; a < 2; ++a)
#pragma unroll
            for (int b = 0; b < 2; ++b)
#pragma unroll
                for (int m = 0; m < 4; ++m)
#pragma unroll
                    for (int n = 0; n < 2; ++n) acc[a][b][m][n] = (f32x4){0.f, 0.f, 0.f, 0.f};
        cur = nxt; cA = nA; cB = nB; ++ui;
        if constexpr (ALIGN_EPI) { if (wr == 1) PG8_BAR; }
    }
    PG8_WAIT_V(0);
    if constexpr (!ALIGN_EPI) { if (wr == 0) PG8_BAR; }
    PG8_BAR;
    if constexpr (Epi::AFTER_DRAIN) { E.fused(acc, cur, wr, wc, fr, fq, lds, wid, lane); S.done(cur); }
#undef PG8_SA
#undef PG8_SB
#undef PG8_STAGE
#undef PG8_LDA
#undef PG8_LDB
#undef PG8_MMA
#undef PG8_WAIT_V
#undef PG8_WAIT_L
#undef PG8_BAR
#undef PG8_SCHED
}
}

constexpr int DM = 2048, DFF = 5504, DEPTH = 4;
constexpr int SEQ = 4096, NB_P = 2, MP = NB_P * SEQ;
constexpr int NB_S = 8, TS = 4, MS = NB_S * TS;
constexpr int MR = MP + MS;
constexpr int MPAD = 8448;
constexpr int PAST = 16384;
constexpr int N_IN = 14096, NWIN = 14336;
constexpr int NGU = 2 * DFF;
constexpr float EPS = 1e-6f;
constexpr int NWAVES = 8, NTHR = 512;

constexpr int C_CB = 0, C_CC = 512, C_CH = 1024, C_AQ = 1536, C_AK = 2304, C_AV = 3072, C_GQ = 3840, C_GK = 4096, C_GV = 4352, C_GR = 4864, C_LR = 5376, C_PIN = 5392, C_GATE = 5904;
constexpr int T_CONV = 0, T_CB = 4, T_Q = 6, T_K = 9, T_V = 12, T_GQ = 15, T_GK = 16, T_GV = 17, T_GR = 19, T_Z = 21, T_PIN = 22, T_GATE = 24;

constexpr int OFF_YP = 0;
constexpr int OFF_YS = OFF_YP + MP * DM;
constexpr int OFF_CONV_P = OFF_YS + MS * DM;
constexpr int OFF_CONV_S = OFF_CONV_P + DEPTH * NB_P * 2 * 512;
constexpr int OFF_W128_P = OFF_CONV_S + DEPTH * NB_S * 2 * 512;
constexpr int OFF_W128_S = OFF_W128_P + DEPTH * NB_P * 128 * 512;
constexpr int OFF_W512_P = OFF_W128_S + DEPTH * NB_S * 128 * 512;
constexpr int OFF_W512_S = OFF_W512_P + DEPTH * NB_P * 512 * 512;
constexpr int OFF_W2048_P = OFF_W512_S + DEPTH * NB_S * 512 * 512;
constexpr int OFF_W2048_S = OFF_W2048_P + DEPTH * NB_P * 2048 * 512;
constexpr int OFF_GLA_P = OFF_W2048_S + DEPTH * NB_S * 2048 * 512;
constexpr int OFF_GLA_S = OFF_GLA_P + DEPTH * NB_P * 4 * 64 * 128;
constexpr int OFF_POOL_P = OFF_GLA_S + DEPTH * NB_S * 4 * 64 * 128;
constexpr int OFF_POOL_S = OFF_POOL_P + DEPTH * NB_P * 15 * 512;
constexpr int OUT_TOTAL = OFF_POOL_S + DEPTH * NB_S * 15 * 512;
static_assert(OUT_TOTAL == 73551872, "output size");

constexpr size_t MiB = 1u << 20;
constexpr size_t WS_CTL = 0, CTL_ZERO_BYTES = 1 * MiB;
constexpr size_t SZ_ROW2K_F32 = (size_t)MPAD * DM * 4, SZ_ROW2K_BF = (size_t)MPAD * DM * 2;
constexpr size_t WS_X = WS_CTL + CTL_ZERO_BYTES;
constexpr size_t WS_XN = WS_X + SZ_ROW2K_F32;
constexpr size_t WS_H = WS_XN + SZ_ROW2K_BF;
constexpr size_t WS_CB = WS_H + (size_t)MPAD * DFF * 2;
constexpr size_t WS_U = WS_CB + (size_t)MPAD * 512 * 2;
constexpr size_t WS_Q = WS_U + (size_t)MPAD * 512 * 2;
constexpr size_t WS_K = WS_Q + (size_t)MPAD * 768 * 2;
constexpr size_t WS_V = WS_K + (size_t)MPAD * 768 * 2;
constexpr size_t WS_GQ = WS_V + (size_t)MPAD * 768 * 2;
constexpr size_t WS_GK = WS_GQ + (size_t)MPAD * 256 * 2;
constexpr size_t WS_GV = WS_GK + (size_t)MPAD * 256 * 2;
constexpr size_t WS_GR = WS_GV + (size_t)MPAD * 512 * 2;
constexpr size_t WS_LA = WS_GR + (size_t)MPAD * 512 * 2;
constexpr size_t WS_PIN = WS_LA + (size_t)MPAD * 256 * 4;
constexpr size_t WS_GATE = WS_PIN + (size_t)MPAD * 512 * 2;
constexpr int YK = 1792, YO_A = 0, YO_B = 512, YO_C = 768, YO_D = 1280;
constexpr size_t WS_YCAT = WS_GATE + (size_t)MPAD * 8192 * 2;
constexpr size_t WS_AO = WS_YCAT + (size_t)MPAD * YK * 2;
constexpr size_t WS_LSE = WS_AO + (size_t)MPAD * 768 * 4;
constexpr size_t WS_DS = WS_LSE + (size_t)MPAD * 12 * 4;
constexpr size_t WS_DEC = WS_DS + (size_t)8 * 64 * 64 * 128 * 4;
constexpr size_t WS_SP = WS_DEC + (size_t)8 * 64 * 64 * 4;
constexpr size_t WS_PM = WS_SP + (size_t)8 * 64 * 64 * 128 * 2;
constexpr size_t WS_MRG = WS_PM + (size_t)(MPAD - MP) * DM * 4;
constexpr size_t WS_W = WS_MRG + SZ_ROW2K_BF;
constexpr size_t WE_GU1 = 0;
constexpr size_t WE_D1 = WE_GU1 + (size_t)NGU * DM;
constexpr size_t WE_IN = WE_D1 + (size_t)DM * DFF;
constexpr size_t WE_UPCAT = WE_IN + (size_t)NWIN * DM;
constexpr size_t WE_OUT = WE_UPCAT + (size_t)DM * YK;
constexpr size_t WE_GU2 = WE_OUT + (size_t)DM * DM;
constexpr size_t WE_D2 = WE_GU2 + (size_t)NGU * DM;
constexpr size_t WE_LAYER = WE_D2 + (size_t)DM * DFF;
static_assert(WE_LAYER == 104857600, "layer weights");
constexpr size_t WS_END = WS_W + (size_t)DEPTH * WE_LAYER * 2;
static_assert(WS_X % 256 == 0 && WS_W % 256 == 0 && WS_LSE % 256 == 0 && WS_DS % 256 == 0, "alignment");

constexpr int CW_BAR = 4096;
constexpr size_t CTL_SS = 65536;
constexpr float SS_FIX = 16777216.0f;
static_assert(CTL_SS + 12 * (size_t)MPAD * 8 <= CTL_ZERO_BYTES, "SS fits the zeroed control region");

constexpr int RING_OFF = 0, RING_BYTES = 131072;
constexpr int LDSCTL_OFF = RING_BYTES, MISC_OFF = LDSCTL_OFF + 320;
constexpr int LDS_BYTES = 147456;

#define GAS __attribute__((address_space(1)))
#define LAS __attribute__((address_space(3)))
typedef unsigned short bf16;
typedef unsigned u32x4 __attribute__((ext_vector_type(4)));
typedef unsigned u32x2 __attribute__((ext_vector_type(2)));
typedef float f32x4 __attribute__((ext_vector_type(4)));
typedef float f32x2 __attribute__((ext_vector_type(2)));
typedef short bf16x8 __attribute__((ext_vector_type(8)));
typedef short s16x4 __attribute__((ext_vector_type(4)));
#define LDS_WAIT() asm volatile("s_waitcnt lgkmcnt(0)" ::: "memory")
#define VM_WAIT() asm volatile("s_waitcnt vmcnt(0)" ::: "memory")
__device__ __forceinline__ unsigned f2bf(float f) { unsigned u = __builtin_bit_cast(unsigned, f); return (u + 0x7fffu + ((u >> 16) & 1u)) >> 16; }
__device__ __forceinline__ unsigned pk2(float lo, float hi) { return f2bf(lo) | (f2bf(hi) << 16); }
__device__ __forceinline__ float bflo(unsigned w) { return __builtin_bit_cast(float, w << 16); }
__device__ __forceinline__ float bfhi(unsigned w) { return __builtin_bit_cast(float, w & 0xffff0000u); }
__device__ __forceinline__ float bf2f(bf16 b) { return __builtin_bit_cast(float, ((unsigned)b) << 16); }
__device__ __forceinline__ u32x4 pk8(f32x4 a, f32x4 b) { u32x4 w; w.x = pk2(a[0], a[1]); w.y = pk2(a[2], a[3]); w.z = pk2(b[0], b[1]); w.w = pk2(b[2], b[3]); return w; }
__device__ __forceinline__ void unpk8(u32x4 w, float (&f)[8]) { f[0] = bflo(w.x); f[1] = bfhi(w.x); f[2] = bflo(w.y); f[3] = bfhi(w.y); f[4] = bflo(w.z); f[5] = bfhi(w.z); f[6] = bflo(w.w); f[7] = bfhi(w.w); }
__device__ __forceinline__ float sigmoidf_(float x) { return __builtin_amdgcn_rcpf(1.0f + __expf(-x)); }
__device__ __forceinline__ float siluf_(float x) { return x * sigmoidf_(x); }
__device__ __forceinline__ float shx(float v, int m, int lane) { return __builtin_bit_cast(float, __builtin_amdgcn_ds_bpermute((lane ^ m) << 2, __builtin_bit_cast(int, v))); }
__device__ __forceinline__ float rdl(float v, int j) { return __builtin_bit_cast(float, __builtin_amdgcn_readlane(__builtin_bit_cast(int, v), j)); }
__device__ __forceinline__ float wave_sum(float v, int lane) {
#pragma unroll
    for (int o = 1; o < 64; o <<= 1) v += shx(v, o, lane);
    return v;
}
__device__ __forceinline__ float wave_max(float v, int lane) {
#pragma unroll
    for (int o = 1; o < 64; o <<= 1) v = fmaxf(v, shx(v, o, lane));
    return v;
}
__device__ __forceinline__ int win_of(int gi) { return 128 << (2 * gi); }
__device__ __forceinline__ int dil_of(int gi) { return 1 << (2 * gi); }
__device__ __forceinline__ int offw_p(int gi) { return gi == 0 ? OFF_W128_P : (gi == 1 ? OFF_W512_P : OFF_W2048_P); }
__device__ __forceinline__ int offw_s(int gi) { return gi == 0 ? OFF_W128_S : (gi == 1 ? OFF_W512_S : OFF_W2048_S); }

#define XB_TMO      128
#define XB_XCNT(j)  (256  + 64 * (j))
#define XB_XSUB(j)  (1280 + 64 * (j))
#define XB_XGEN(j)  (2304 + 64 * (j))
#define XB_TOP      3328
#define XB_TOPGEN   3392
#define XCD_BAR_WORDS 3456
#define XB_SPIN_CAP (1u << 18)

__device__ __forceinline__ unsigned xb_ld(unsigned* p)              { return __hip_atomic_load(p, __ATOMIC_RELAXED, __HIP_MEMORY_SCOPE_AGENT); }
__device__ __forceinline__ unsigned xb_add(unsigned* p, unsigned v) { return __hip_atomic_fetch_add(p, v, __ATOMIC_RELAXED, __HIP_MEMORY_SCOPE_AGENT); }
__device__ __forceinline__ unsigned xb_xcc_id() { return (unsigned)__builtin_amdgcn_s_getreg((3 << 11) | 20) & 0xFu; }
#define XB_SPIN(cond, bar) do { unsigned _sp = 0; while (cond) { __builtin_amdgcn_s_sleep(1); \
    if ((++_sp & 255u) == 0u) { if (xb_ld(&(bar)[XB_TMO])) break; if (_sp > XB_SPIN_CAP) { atomicAdd(&(bar)[XB_TMO], 1u); break; } } } } while (0)

struct XcdBarrier {
    unsigned* bar; unsigned x;
    volatile LAS unsigned* st;
};
__device__ __forceinline__ XcdBarrier xcd_barrier_post(unsigned* bar, volatile LAS unsigned* st) {
    XcdBarrier b; b.bar = bar; b.x = xb_xcc_id(); b.st = st;
    if (threadIdx.x == 0) (void)xb_add(&bar[XB_XCNT(b.x)], 1u);
    return b;
}
__device__ __forceinline__ void xcd_barrier_complete(unsigned* bar, unsigned x, unsigned& nloc, unsigned& nx) {
    const unsigned G = gridDim.x * gridDim.y * gridDim.z;
    unsigned sum, cnt, mine, sp = 0u;
    for (;;) {
        sum = 0u; cnt = 0u; mine = 0u;
#pragma unroll
        for (unsigned j = 0; j < 16; ++j) { const unsigned c = xb_ld(&bar[XB_XCNT(j)]); sum += c; cnt += (c > 0u) ? 1u : 0u; mine = (j == x) ? c : mine; }
        if (sum == G) break;
        __builtin_amdgcn_s_sleep(1);
        if ((++sp & 255u) == 0u) { if (xb_ld(&bar[XB_TMO])) break; if (sp > XB_SPIN_CAP) { atomicAdd(&bar[XB_TMO], 1u); break; } }
    }
    nloc = mine > 0u ? mine : 1u; nx = cnt > 0u ? cnt : 1u;
}
__device__ __forceinline__ void xcd_barrier(const XcdBarrier& b, const int tid) {
    asm volatile("s_waitcnt vmcnt(0)" ::: "memory");
    __syncthreads();
    if (tid == 0) {
        unsigned* bar = b.bar;
        __builtin_amdgcn_s_waitcnt(0);
        unsigned nloc = b.st[0], nx = b.st[1];
        if (nloc == 0u) { xcd_barrier_complete(bar, b.x, nloc, nx); b.st[0] = nloc; b.st[1] = nx; }
        const unsigned old = xb_add(&bar[XB_XSUB(b.x)], 1u);
        const unsigned gen = old / nloc;
        if (old + 1u == (gen + 1u) * nloc) {
            __builtin_amdgcn_fence(__ATOMIC_RELEASE, "agent");
            asm volatile("s_waitcnt vmcnt(0)" ::: "memory");
            const unsigned og = xb_add(&bar[XB_TOP], 1u);
            const unsigned tg = og / nx;
            if (og + 1u == (tg + 1u) * nx) xb_add(&bar[XB_TOPGEN], 1u);
            else XB_SPIN(xb_ld(&bar[XB_TOPGEN]) == tg, bar);
            __builtin_amdgcn_fence(__ATOMIC_ACQUIRE, "agent");
            xb_add(&bar[XB_XGEN(b.x)], 1u);
            asm volatile("s_waitcnt vmcnt(0)" ::: "memory");
        } else {
            XB_SPIN(xb_ld(&bar[XB_XGEN(b.x)]) == gen, bar);
            __builtin_amdgcn_fence(__ATOMIC_ACQUIRE, "agent");
            asm volatile("s_waitcnt vmcnt(0)" ::: "memory");
        }
    }
    __syncthreads();
}

constexpr int PT_OFF = LDSCTL_OFF;
constexpr int PT_OUT = 31, PT_WS = 32;
__device__ __forceinline__ const float* ldp(LAS unsigned char* lds, int i) {
    const unsigned long long v = *(volatile LAS unsigned long long*)(lds + PT_OFF + 8 * i);
    const unsigned lo = __builtin_amdgcn_readfirstlane((unsigned)v), hi = __builtin_amdgcn_readfirstlane((unsigned)(v >> 32));
    return (const float*)(((unsigned long long)hi << 32) | lo);
}

typedef f32x4 (&AccRef)[2][2][4][2];

__device__ __forceinline__ void row_decode(int row, int& kind, int& b, int& t) {
    if (row < MP) { kind = 0; b = row >> 12; t = row & 4095; }
    else if (row < MR) { kind = 1; b = (row - MP) >> 2; t = (row - MP) & 3; }
    else { kind = 2; b = 0; t = 0; }
}


#ifndef EPI_NT
#define EPI_NT 0
#endif
#if EPI_NT
#define EPI_ST(ptr, val) __builtin_nontemporal_store((val), (ptr))
#else
#define EPI_ST(ptr, val) (*(ptr) = (val))
#endif
typedef _Float16 h16x4 __attribute__((ext_vector_type(4)));
typedef _Float16 h16x8 __attribute__((ext_vector_type(8)));
constexpr size_t RAT_STRIDE = (size_t)MPAD * DM;

template <bool SK> __device__ __forceinline__ void scale_rows_rstd(AccRef acc, const unsigned long long* ss, int row0) {
#pragma unroll
    for (int ai = 0; ai < (SK ? 1 : 2); ++ai)
#pragma unroll
        for (int m = 0; m < (SK ? 2 : 4); ++m) {
            const float r = rsqrtf((float)ss[row0 + ai * 128 + m * 16] * (1.0f / (SS_FIX * DM)) + EPS);
#pragma unroll
            for (int bj = 0; bj < 2; ++bj)
#pragma unroll
                for (int n = 0; n < 2; ++n) acc[ai][bj][m][n] *= r;
        }
}

struct EpiSwiGLU {
    static constexpr bool PERM = false, AFTER_DRAIN = false, HAS_MID = false;
    unsigned char* ws; int nid;
    __device__ __forceinline__ void operator()(AccRef acc, const pg8::Unit& u, int wr, int wc, int fr, int fq) const { run<false>(acc, u, wr, wc, fr, fq); }
    template <bool SK> __device__ __forceinline__ void run(AccRef acc, const pg8::Unit& u, int wr, int wc, int fr_, int fq_) const {
        int fr = fr_, fq = fq_; asm volatile("" : "+v"(fr), "+v"(fq));
        bf16* H = (bf16*)(ws + WS_H);
        const int row0 = u.pm * 256 + wr * 64 + fr, col0 = u.pn * 128 + wc * 32 + 8 * fq;
        scale_rows_rstd<SK>(acc, (const unsigned long long*)(ws + WS_CTL + CTL_SS) + (size_t)nid * MPAD, row0);
#pragma unroll
        for (int ai = 0; ai < (SK ? 1 : 2); ++ai)
#pragma unroll
            for (int m = 0; m < (SK ? 2 : 4); ++m) {
                bf16* p = H + (size_t)(row0 + ai * 128 + m * 16) * DFF + col0;
                f32x4 h0, h1;
#pragma unroll
                for (int j = 0; j < 4; ++j) { h0[j] = siluf_(acc[ai][0][m][0][j]) * acc[ai][1][m][0][j]; h1[j] = siluf_(acc[ai][0][m][1][j]) * acc[ai][1][m][1][j]; }
                EPI_ST((u32x4*)p, pk8(h0, h1));
            }
    }
};

struct EpiResid {
    static constexpr bool PERM = false, AFTER_DRAIN = false, HAS_MID = false;
    unsigned char* ws; LAS unsigned char* lds; float scale; int fin; int nid;
    __device__ __forceinline__ void operator()(AccRef acc, const pg8::Unit& u, int wr, int wc, int fr, int fq) const { run<false>(acc, u, wr, wc, fr, fq); }
    template <bool SK> __device__ __forceinline__ void run(AccRef acc, const pg8::Unit& u, int wr, int wc, int fr_, int fq_) const {
        int fr = fr_, fq = fq_; asm volatile("" : "+v"(fr), "+v"(fq));
        bf16* XB = (bf16*)(ws + WS_XN);
        unsigned long long* ssp = (unsigned long long*)(ws + WS_CTL + CTL_SS) + (size_t)(nid < 0 ? 0 : nid) * MPAD;
        float* out = fin ? (float*)ldp(lds, PT_OUT) : nullptr;
        const float scale = (u.ri == 0) ? this->scale : 0.f; const int nid = (u.ri == 0) ? this->nid : -1;
        const int row0 = u.pm * 256 + wr * 64 + fr, col0 = u.pn * 256 + wc * 32 + 8 * fq;
#pragma unroll
        for (int ai = 0; ai < (SK ? 1 : 2); ++ai)
#pragma unroll
            for (int m = 0; m < (SK ? 2 : 4); ++m) {
                const int row = row0 + ai * 128 + m * 16;
                bf16* xr = XB + (size_t)row * DM + col0;
                float sq = 0.f;
#pragma unroll
                for (int bj = 0; bj < 2; ++bj) {
                    float xo[8]; unpk8(*(const u32x4*)(xr + bj * 128), xo);
                    f32x4 v0, v1;
#pragma unroll
                    for (int j = 0; j < 4; ++j) { v0[j] = xo[j] + scale * acc[ai][bj][m][0][j]; v1[j] = xo[4 + j] + scale * acc[ai][bj][m][1][j]; }
                    if (out != nullptr && row < MR) { float* o = out + (size_t)row * DM + col0 + bj * 128; *(f32x4*)o = v0; *(f32x4*)(o + 4) = v1; }
                    const u32x4 w = pk8(v0, v1);
                    EPI_ST((u32x4*)(xr + bj * 128), w);
                    float xn[8]; unpk8(w, xn);
#pragma unroll
                    for (int j = 0; j < 8; ++j) sq += xn[j] * xn[j];
                }
                { const int ln = fq * 16 + fr; sq += shx(sq, 16, ln); sq += shx(sq, 32, ln); }
                if (nid >= 0 && fq == 0) atomicAdd(ssp + row, (unsigned long long)(sq * SS_FIX + 0.5f));
            }
    }
};

struct EpiMergeCat {
    static constexpr bool PERM = false, AFTER_DRAIN = false, HAS_MID = true;
    unsigned char* ws;
    __device__ __forceinline__ void apply(f32x4 (&acc)[2][2][4][2], const pg8::Unit& u, int s, int wr, int wc, int fr_, int fq_) const {
        int fr = fr_, fq = fq_; asm volatile("" : "+v"(fr), "+v"(fq));
        const _Float16* R = (const _Float16*)(ws + WS_GATE) + (size_t)s * RAT_STRIDE;
        const int row0 = u.pm * 256 + wr * 64 + fr, col0 = u.pn * 256 + wc * 32 + 8 * fq;
        h16x8 r[2][4][2];
#pragma unroll
        for (int ai = 0; ai < 2; ++ai)
#pragma unroll
            for (int m = 0; m < 4; ++m)
#pragma unroll
                for (int bj = 0; bj < 2; ++bj) r[ai][m][bj] = *(const h16x8*)(R + (size_t)(row0 + ai * 128 + m * 16) * DM + col0 + bj * 128);
#pragma unroll
        for (int ai = 0; ai < 2; ++ai)
#pragma unroll
            for (int m = 0; m < 4; ++m)
#pragma unroll
                for (int bj = 0; bj < 2; ++bj)
#pragma unroll
                    for (int j = 0; j < 4; ++j) { acc[ai][bj][m][0][j] *= (float)r[ai][m][bj][j]; acc[ai][bj][m][1][j] *= (float)r[ai][m][bj][4 + j]; }
    }
    __device__ __forceinline__ void mid(f32x4 (&acc)[2][2][4][2], const pg8::Unit& u, int t, int wr, int wc, int fr, int fq) const {
        apply(acc, u, (t == 8) ? 0 : (t == 12 ? 1 : 2), wr, wc, fr, fq);
    }
    __device__ __forceinline__ void operator()(AccRef acc, const pg8::Unit& u, int wr, int wc, int fr_, int fq_) const {
        apply(acc, u, 3, wr, wc, fr_, fq_);
        int fr = fr_, fq = fq_; asm volatile("" : "+v"(fr), "+v"(fq));
        bf16* MRG = (bf16*)(ws + WS_MRG);
        const int row0 = u.pm * 256 + wr * 64 + fr, col0 = u.pn * 256 + wc * 32 + 8 * fq;
#pragma unroll
        for (int ai = 0; ai < 2; ++ai)
#pragma unroll
            for (int m = 0; m < 4; ++m)
#pragma unroll
                for (int bj = 0; bj < 2; ++bj) EPI_ST((u32x4*)(MRG + (size_t)(row0 + ai * 128 + m * 16) * DM + col0 + bj * 128), pk8(acc[ai][bj][m][0], acc[ai][bj][m][1]));
    }
};
template <int MODE>
struct EpiMergeS {
    static constexpr bool PERM = false, AFTER_DRAIN = false, HAS_MID = false;
    unsigned char* ws; int br;
    template <bool SK> __device__ __forceinline__ void run(AccRef acc, const pg8::Unit& u, int wr, int wc, int fr, int fq) const {
        float* P = (float*)(ws + WS_PM); bf16* MRG = (bf16*)(ws + WS_MRG);
        const int row0 = u.pm * 256 + wr * 64 + fr, col0 = u.pn * 256 + wc * 32 + 8 * fq;
#pragma unroll
        for (int m = 0; m < 2; ++m) {
            const int row = row0 + m * 16;
#pragma unroll
            for (int bj = 0; bj < 2; ++bj) {
                const int c = col0 + bj * 128;
                float g[8];
                { const _Float16* R = (const _Float16*)(ws + WS_GATE) + (size_t)row * DM + c;
                  const h16x8 r3 = *(const h16x8*)(R + 3 * RAT_STRIDE);
#pragma unroll
                  for (int j = 0; j < 8; ++j) g[j] = (float)r3[j];
#pragma unroll
                  for (int s = 2; s >= 0; --s) if (s >= br) { const h16x8 rs = *(const h16x8*)(R + (size_t)s * RAT_STRIDE);
#pragma unroll
                      for (int j = 0; j < 8; ++j) g[j] *= (float)rs[j]; } }
                f32x4 v0, v1;
#pragma unroll
                for (int j = 0; j < 4; ++j) { v0[j] = g[j] * acc[0][bj][m][0][j]; v1[j] = g[4 + j] * acc[0][bj][m][1][j]; }
                float* pp = P + (size_t)(row - MP) * DM + c;
                if (MODE != 0) { v0 += *(const f32x4*)pp; v1 += *(const f32x4*)(pp + 4); }
                if (MODE == 2) *(u32x4*)(MRG + (size_t)row * DM + c) = pk8(v0, v1);
                else { *(f32x4*)pp = v0; *(f32x4*)(pp + 4) = v1; }
            }
        }
    }
};

struct EpiWin {
    static constexpr bool PERM = false, AFTER_DRAIN = false, HAS_MID = false;
    unsigned char* ws;
    const float *qgain, *kgain, *b_a;
    float* out; int layer; int nid;

    template <int ACT, bool SK>
    __device__ __forceinline__ void plain(AccRef acc, bf16* dst, int ldc, int cbase, int row0, int wc, int fq) const {
#pragma unroll
        for (int ai = 0; ai < (SK ? 1 : 2); ++ai)
#pragma unroll
            for (int m = 0; m < (SK ? 2 : 4); ++m) {
                bf16* p = dst + (size_t)(row0 + ai * 128 + m * 16) * ldc + cbase + wc * 32 + fq * 8;
#pragma unroll
                for (int bj = 0; bj < 2; ++bj) {
                    f32x4 v0 = acc[ai][bj][m][0], v1 = acc[ai][bj][m][1];
#pragma unroll
                    for (int j = 0; j < 4; ++j) {
                        if (ACT == 1) { v0[j] = sigmoidf_(v0[j]); v1[j] = sigmoidf_(v1[j]); }
                        if (ACT == 2) { v0[j] = siluf_(v0[j]); v1[j] = siluf_(v1[j]); }
                        if (ACT == 3) { v0[j] *= 0.125f; v1[j] *= 0.125f; }
                    }
                    EPI_ST((u32x4*)(p + bj * 128), pk8(v0, v1));
                }
            }
    }

    __device__ __forceinline__ void operator()(AccRef acc, const pg8::Unit& u, int wr, int wc, int fr, int fq) const { run<false>(acc, u, wr, wc, fr, fq); }
    template <bool SK> __device__ __forceinline__ void run(AccRef acc, const pg8::Unit& u, int wr, int wc, int fr_, int fq_) const {
        int fr = fr_, fq = fq_; asm volatile("" : "+v"(fr), "+v"(fq));
        const int pn = u.pn, row0 = u.pm * 256 + wr * 64 + fr, l = layer;
        scale_rows_rstd<SK>(acc, (const unsigned long long*)(ws + WS_CTL + CTL_SS) + (size_t)nid * MPAD, row0);
        if (pn < T_CB) {
            const int ch0 = 128 * pn + 32 * wc + 8 * fq;
#pragma unroll
            for (int ai = 0; ai < (SK ? 1 : 2); ++ai)
#pragma unroll
                for (int m = 0; m < (SK ? 2 : 4); ++m) {
                    const int row = row0 + ai * 128 + m * 16;
                    const f32x4 u0 = acc[ai][0][m][0] * acc[ai][1][m][0], u1 = acc[ai][0][m][1] * acc[ai][1][m][1];
                    *(u32x4*)((bf16*)(ws + WS_U) + (size_t)row * 512 + ch0) = pk8(u0, u1);
                    int kind, b, t; row_decode(row, kind, b, t);
                    if (kind == 0 && t >= SEQ - 2) { float* o = out + OFF_CONV_P + ((l * NB_P + b) * 2 + (t - (SEQ - 2))) * 512 + ch0; *(f32x4*)o = u0; *(f32x4*)(o + 4) = u1; }
                    if (kind == 1 && t >= TS - 2)  { float* o = out + OFF_CONV_S + ((l * NB_S + b) * 2 + (t - (TS - 2))) * 512 + ch0; *(f32x4*)o = u0; *(f32x4*)(o + 4) = u1; }
                }
        } else if (pn < T_Q) {
            plain<0, SK>(acc, (bf16*)(ws + WS_CB), 512, 256 * (pn - T_CB), row0, wc, fq);
        } else if (pn < T_V) {
            const bool isk = pn >= T_K; const int ti = isk ? pn - T_K : pn - T_Q; const int head = 4 * ti + wc;
            const float* gp = (isk ? kgain : qgain) + head * 64 + 8 * fq;
            f32x4 g[2][2];
#pragma unroll
            for (int bj = 0; bj < 2; ++bj) { g[bj][0] = *(const f32x4*)(gp + 32 * bj); g[bj][1] = *(const f32x4*)(gp + 32 * bj + 4); }
            bf16* dst = (bf16*)(ws + (isk ? WS_K : WS_Q));
            const int W = win_of(ti);
#pragma unroll
            for (int ai = 0; ai < (SK ? 1 : 2); ++ai)
#pragma unroll
                for (int m = 0; m < (SK ? 2 : 4); ++m) {
                    const int row = row0 + ai * 128 + m * 16;
                    float ss = 0.f;
#pragma unroll
                    for (int bj = 0; bj < 2; ++bj)
#pragma unroll
                        for (int n = 0; n < 2; ++n) { const f32x4 x = acc[ai][bj][m][n]; ss += (x[0] * x[0] + x[1] * x[1]) + (x[2] * x[2] + x[3] * x[3]); }
                    { const int ln = fq * 16 + fr; ss += shx(ss, 16, ln); ss += shx(ss, 32, ln); }
                    const float rs = rsqrtf(ss * (1.0f / 64.0f) + EPS);
                    int kind, b, t; row_decode(row, kind, b, t);
#pragma unroll
                    for (int bj = 0; bj < 2; ++bj) {
                        const f32x4 y0 = acc[ai][bj][m][0] * rs * g[bj][0], y1 = acc[ai][bj][m][1] * rs * g[bj][1];
                        *(u32x4*)(dst + (size_t)row * 768 + head * 64 + 32 * bj + 8 * fq) = pk8(y0, y1);
                        if (isk) {
                            const int e0 = 32 * bj + 8 * fq;
                            if (kind == 0 && t >= SEQ - W) { float* o = out + offw_p(ti) + ((((l * NB_P + b) * W + (t - (SEQ - W))) * 2 + 0) * 4 + wc) * 64 + e0; *(f32x4*)o = y0; *(f32x4*)(o + 4) = y1; }
                            if (kind == 1)                 { float* o = out + offw_s(ti) + ((((l * NB_S + b) * W + (W - TS + t)) * 2 + 0) * 4 + wc) * 64 + e0; *(f32x4*)o = y0; *(f32x4*)(o + 4) = y1; }
                        }
                    }
                }
        } else if (pn < T_GQ) {
            const int ti = pn - T_V;
            plain<0, SK>(acc, (bf16*)(ws + WS_V), 768, 256 * ti, row0, wc, fq);
            const int W = win_of(ti);
#pragma unroll
            for (int ai = 0; ai < (SK ? 1 : 2); ++ai)
#pragma unroll
                for (int m = 0; m < (SK ? 2 : 4); ++m) {
                    const int row = row0 + ai * 128 + m * 16;
                    int kind, b, t; row_decode(row, kind, b, t);
#pragma unroll
                    for (int bj = 0; bj < 2; ++bj) {
                        const int hh = 2 * bj + (wc >> 1), e0 = 32 * (wc & 1) + 8 * fq;
                        if (kind == 0 && t >= SEQ - W) { float* o = out + offw_p(ti) + ((((l * NB_P + b) * W + (t - (SEQ - W))) * 2 + 1) * 4 + hh) * 64 + e0; *(f32x4*)o = acc[ai][bj][m][0]; *(f32x4*)(o + 4) = acc[ai][bj][m][1]; }
                        if (kind == 1)                 { float* o = out + offw_s(ti) + ((((l * NB_S + b) * W + (W - TS + t)) * 2 + 1) * 4 + hh) * 64 + e0; *(f32x4*)o = acc[ai][bj][m][0]; *(f32x4*)(o + 4) = acc[ai][bj][m][1]; }
                    }
                }
        } else if (pn == T_GQ) {
            plain<3, SK>(acc, (bf16*)(ws + WS_GQ), 256, 0, row0, wc, fq);
        } else if (pn == T_GK) {
            plain<0, SK>(acc, (bf16*)(ws + WS_GK), 256, 0, row0, wc, fq);
        } else if (pn < T_GR) {
            plain<0, SK>(acc, (bf16*)(ws + WS_GV), 512, 256 * (pn - T_GV), row0, wc, fq);
        } else if (pn < T_Z) {
            plain<2, SK>(acc, (bf16*)(ws + WS_GR), 512, 256 * (pn - T_GR), row0, wc, fq);
        } else if (pn == T_Z) {
#pragma unroll
            for (int bj = 0; bj < 2; ++bj) {
                const int c0 = 128 * bj + 32 * wc + 8 * fq;
                const f32x4 b0 = *(const f32x4*)(b_a + c0), b1 = *(const f32x4*)(b_a + c0 + 4);
#pragma unroll
                for (int ai = 0; ai < (SK ? 1 : 2); ++ai)
#pragma unroll
                    for (int m = 0; m < (SK ? 2 : 4); ++m) {
                        const int row = row0 + ai * 128 + m * 16;
                        f32x4 z0 = acc[ai][bj][m][0] + b0, z1 = acc[ai][bj][m][1] + b1;
#pragma unroll
                        for (int j = 0; j < 4; ++j) {
                            z0[j] = (fminf(z0[j], 0.f) - __logf(1.0f + __expf(-fabsf(z0[j])))) * (1.0f / 16.0f);
                            z1[j] = (fminf(z1[j], 0.f) - __logf(1.0f + __expf(-fabsf(z1[j])))) * (1.0f / 16.0f);
                        }
                        float* o = (float*)(ws + WS_LA) + (size_t)row * 256 + c0; *(f32x4*)o = z0; *(f32x4*)(o + 4) = z1;
                    }
            }
        } else if (pn < T_GATE) {
            const int ti = pn - T_PIN;
            plain<0, SK>(acc, (bf16*)(ws + WS_PIN), 512, 256 * ti, row0, wc, fq);
#pragma unroll
            for (int ai = 0; ai < (SK ? 1 : 2); ++ai)
#pragma unroll
                for (int m = 0; m < (SK ? 2 : 4); ++m) {
                    const int row = row0 + ai * 128 + m * 16;
                    int kind, b, t; row_decode(row, kind, b, t);
#pragma unroll
                    for (int bj = 0; bj < 2; ++bj) {
                        const int c0 = 256 * ti + 128 * bj + 32 * wc + 8 * fq;
                        if (kind == 0 && t >= SEQ - 15) { float* o = out + OFF_POOL_P + ((l * NB_P + b) * 15 + (t - (SEQ - 15))) * 512 + c0; *(f32x4*)o = acc[ai][bj][m][0]; *(f32x4*)(o + 4) = acc[ai][bj][m][1]; }
                        if (kind == 1)                  { float* o = out + OFF_POOL_S + ((l * NB_S + b) * 15 + (15 - TS + t)) * 512 + c0; *(f32x4*)o = acc[ai][bj][m][0]; *(f32x4*)(o + 4) = acc[ai][bj][m][1]; }
                    }
                }
        } else {
            _Float16* R = (_Float16*)(ws + WS_GATE);
            const int c0 = 64 * (pn - T_GATE) + 16 * wc + 4 * fq;
#pragma unroll
            for (int ai = 0; ai < (SK ? 1 : 2); ++ai)
#pragma unroll
                for (int m = 0; m < (SK ? 2 : 4); ++m) {
                    const size_t o = (size_t)(row0 + ai * 128 + m * 16) * DM + c0;
                    h16x4 r0, r1, r2, r3;
#pragma unroll
                    for (int j = 0; j < 4; ++j) {
                        const float d0 = fminf(1.0f + __expf(-acc[ai][0][m][0][j]), 16384.f), d1 = fminf(1.0f + __expf(-acc[ai][0][m][1][j]), 16384.f);
                        const float d2 = fminf(1.0f + __expf(-acc[ai][1][m][0][j]), 16384.f), d3 = fminf(1.0f + __expf(-acc[ai][1][m][1][j]), 16384.f);
                        const float i0 = __builtin_amdgcn_rcpf(d0), i1 = __builtin_amdgcn_rcpf(d1), i2 = __builtin_amdgcn_rcpf(d2), i3 = __builtin_amdgcn_rcpf(d3);
                        r0[j] = (_Float16)fminf(d1 * i0, 65504.f); r1[j] = (_Float16)fminf(d2 * i1, 65504.f); r2[j] = (_Float16)fminf(d3 * i2, 65504.f); r3[j] = (_Float16)i3;
                    }
                    EPI_ST((h16x4*)(R + o), r0); EPI_ST((h16x4*)(R + RAT_STRIDE + o), r1); EPI_ST((h16x4*)(R + 2 * RAT_STRIDE + o), r2); EPI_ST((h16x4*)(R + 3 * RAT_STRIDE + o), r3);
                }
        }
    }
};

__device__ __forceinline__ unsigned wt_lane(int wc, int fr, int g) { return (unsigned)(wc * 4096 + (g >> 1) * 1024 + ((fr * 64 + 32 * (g & 1)) ^ ((fr >> 3) << 5))); }
template <class Epi>
__device__ __forceinline__ void skinny_unit(LAS unsigned char* lds, const bf16* A, const bf16* Bt, int K, int su, const Epi E, int tid, int ld = 0) {
    if (ld == 0) ld = K;
    const int lane = tid & 63, w = __builtin_amdgcn_readfirstlane(tid >> 6), fr = lane & 15, g = lane >> 4;
    const int pn = su >> 2, wc = su & 3;
    const int nh = K >> 6, h0 = (w * nh) >> 3, h1 = ((w + 1) * nh) >> 3;
    f32x4 acc[2][2][2];
#pragma unroll
    for (int bj = 0; bj < 2; ++bj)
#pragma unroll
        for (int m = 0; m < 2; ++m)
#pragma unroll
            for (int n = 0; n < 2; ++n) acc[bj][m][n] = (f32x4){0.f, 0.f, 0.f, 0.f};
    const bf16* ap = A + (size_t)(MP + fr) * ld + 16 * g;
    const char* bp = (const char*)Bt + (size_t)pn * nh * 32768 + wt_lane(wc, fr, g);
    for (int hc = h0; hc < h1; hc += 4) {
        bf16x8 a[4][2][2], b[4][2][2][2];
#pragma unroll
        for (int q = 0; q < 4; ++q) {
            const int hq = (hc + q < h1) ? hc + q : h1 - 1;
#pragma unroll
            for (int s = 0; s < 2; ++s) {
#pragma unroll
                for (int m = 0; m < 2; ++m) a[q][m][s] = *(const bf16x8*)(ap + (size_t)(16 * m) * ld + 64 * hq + 8 * s);
#pragma unroll
                for (int bj = 0; bj < 2; ++bj)
#pragma unroll
                    for (int n = 0; n < 2; ++n) b[q][bj][n][s] = *(const bf16x8*)(bp + (size_t)hq * 32768 + bj * 16384 + n * 2048 + s * 16);
            }
        }
#pragma unroll
        for (int q = 0; q < 4; ++q) {
            const bool ok = hc + q < h1;
#pragma unroll
            for (int s = 0; s < 2; ++s)
#pragma unroll
                for (int m = 0; m < 2; ++m) {
                    bf16x8 av = a[q][m][s];
                    if (!ok) av = (bf16x8){0, 0, 0, 0, 0, 0, 0, 0};
#pragma unroll
                    for (int bj = 0; bj < 2; ++bj)
#pragma unroll
                        for (int n = 0; n < 2; ++n) acc[bj][m][n] = __builtin_amdgcn_mfma_f32_16x16x32_bf16(b[q][bj][n][s], av, acc[bj][m][n], 0, 0, 0);
                }
        }
    }
    LAS f32x4* red = (LAS f32x4*)lds;
#pragma unroll
    for (int bj = 0; bj < 2; ++bj)
#pragma unroll
        for (int m = 0; m < 2; ++m)
#pragma unroll
            for (int n = 0; n < 2; ++n) red[(w * 8 + (bj * 4 + m * 2 + n)) * 64 + lane] = acc[bj][m][n];
    __syncthreads();
    if (w == 0) {
        f32x4 full[2][2][4][2];
#pragma unroll
        for (int bj = 0; bj < 2; ++bj)
#pragma unroll
            for (int m = 0; m < 2; ++m)
#pragma unroll
                for (int n = 0; n < 2; ++n) {
                    f32x4 s = red[(bj * 4 + m * 2 + n) * 64 + lane];
#pragma unroll
                    for (int ww = 1; ww < 8; ++ww) s += red[(ww * 8 + (bj * 4 + m * 2 + n)) * 64 + lane];
                    asm volatile("" : "+v"(s) :: "memory");
                    full[0][bj][m][n] = s;
                }
        pg8::Unit u; u.pm = MP / 256; u.pn = pn; u.ri = 0;
        E.template run<true>(full, u, 0, wc, fr, g);
    }
    __syncthreads();
}

__device__ __forceinline__ void skinny_merge_unit(LAS unsigned char* lds, unsigned char* ws, const bf16* Y, const bf16* U, int su, int tid) {
    const int lane = tid & 63, w = __builtin_amdgcn_readfirstlane(tid >> 6), fr = lane & 15, g = lane >> 4;
    const int pn = su >> 2, wc = su & 3;
    f32x4 acc[2][2][2];
#pragma unroll
    for (int bj = 0; bj < 2; ++bj)
#pragma unroll
        for (int m = 0; m < 2; ++m)
#pragma unroll
            for (int n = 0; n < 2; ++n) acc[bj][m][n] = (f32x4){0.f, 0.f, 0.f, 0.f};
    if (w < 7) {
        const bf16* ap = Y + (size_t)(MP + fr) * YK + 16 * g + 256 * w;
        const char* bp = (const char*)U + (size_t)(pn * (YK / 64) + 4 * w) * 32768 + wt_lane(wc, fr, g);
        bf16x8 a[4][2][2], b[4][2][2][2];
#pragma unroll
        for (int q = 0; q < 4; ++q)
#pragma unroll
            for (int s2 = 0; s2 < 2; ++s2) {
#pragma unroll
                for (int m = 0; m < 2; ++m) a[q][m][s2] = *(const bf16x8*)(ap + (size_t)(16 * m) * YK + 64 * q + 8 * s2);
#pragma unroll
                for (int bj = 0; bj < 2; ++bj)
#pragma unroll
                    for (int n = 0; n < 2; ++n) b[q][bj][n][s2] = *(const bf16x8*)(bp + (size_t)q * 32768 + bj * 16384 + n * 2048 + s2 * 16);
            }
#pragma unroll
        for (int q = 0; q < 4; ++q)
#pragma unroll
            for (int s2 = 0; s2 < 2; ++s2)
#pragma unroll
                for (int m = 0; m < 2; ++m)
#pragma unroll
                    for (int bj = 0; bj < 2; ++bj)
#pragma unroll
                        for (int n = 0; n < 2; ++n) acc[bj][m][n] = __builtin_amdgcn_mfma_f32_16x16x32_bf16(b[q][bj][n][s2], a[q][m][s2], acc[bj][m][n], 0, 0, 0);
    }
    LAS f32x4* red = (LAS f32x4*)lds;
#pragma unroll
    for (int bj = 0; bj < 2; ++bj)
#pragma unroll
        for (int m = 0; m < 2; ++m)
#pragma unroll
            for (int n = 0; n < 2; ++n) red[(w * 8 + (bj * 4 + m * 2 + n)) * 64 + lane] = acc[bj][m][n];
    __syncthreads();
    if (w == 0) {
        bf16* MRG = (bf16*)(ws + WS_MRG);
        const int col0 = pn * 256 + wc * 32 + 8 * g;
#pragma unroll
        for (int m = 0; m < 2; ++m) {
            const int row = MP + 16 * m + fr;
#pragma unroll
            for (int bj = 0; bj < 2; ++bj) {
                const _Float16* R = (const _Float16*)(ws + WS_GATE) + (size_t)row * DM + col0 + bj * 128;
                const h16x8 r0 = *(const h16x8*)R, r1 = *(const h16x8*)(R + RAT_STRIDE), r2 = *(const h16x8*)(R + 2 * RAT_STRIDE), r3 = *(const h16x8*)(R + 3 * RAT_STRIDE);
                f32x4 o[2];
#pragma unroll
                for (int n = 0; n < 2; ++n) {
                    const int ti = bj * 4 + m * 2 + n;
                    const f32x4 pa = red[(0 * 8 + ti) * 64 + lane] + red[(1 * 8 + ti) * 64 + lane], pb = red[(2 * 8 + ti) * 64 + lane];
                    const f32x4 pc = red[(3 * 8 + ti) * 64 + lane] + red[(4 * 8 + ti) * 64 + lane], pd = red[(5 * 8 + ti) * 64 + lane] + red[(6 * 8 + ti) * 64 + lane];
#pragma unroll
                    for (int j = 0; j < 4; ++j) {
                        const float e3 = (float)r3[4 * n + j], e2 = (float)r2[4 * n + j] * e3, e1 = (float)r1[4 * n + j] * e2, e0 = (float)r0[4 * n + j] * e1;
                        o[n][j] = (e0 * pa[j] + e1 * pb[j]) + (e2 * pc[j] + e3 * pd[j]);
                    }
                }
                *(u32x4*)(MRG + (size_t)row * DM + col0 + bj * 128) = pk8(o[0], o[1]);
            }
        }
    }
    __syncthreads();
}

constexpr int IT_GU = 344 * 32, IT_D = 64 * 86, IT_IN = 448 * 32, IT_UPA = 64 * 8, IT_UPB = 64 * 4, IT_UPC = 64 * 8, IT_UPD = 64 * 8, IT_OUT = 64 * 32;
constexpr int IT_LAYER = 2 * IT_GU + 2 * IT_D + IT_IN + IT_UPA + IT_UPB + IT_UPC + IT_UPD + IT_OUT;
static_assert(IT_LAYER == 51200, "items per layer");

constexpr int PB_LAYER = 2 * 43 * 32 + 2 * 8 * 86 + 56 * 32 + 8 * 8 + 8 * 4 + 8 * 8 + 8 * 8 + 8 * 32;
static_assert(PB_LAYER == 6400, "blocks per layer");
constexpr int PB_P = 265;
constexpr int PB_PW_OFF = 69632;
struct BDesc { const float* src; const float* gain; bf16* dst; int ldw, K, kind, perm, aux0, aux1, aux2; };

__device__ __forceinline__ void pblk_decode(LAS unsigned char* lds, bf16* WB, int blk, int wave, int lane, BDesc& D) {
    const int l = blk / PB_LAYER; int r = blk % PB_LAYER;
    const int g = lane >> 3, c4 = lane & 7, bj = g >> 2, wc = g & 3;
    bf16* wl = WB + (size_t)l * WE_LAYER;
    const float* W; const float* gn = nullptr; int ldw, S0, k0, K, T, kind = 0, perm = 0, aux0 = 0, yo = 0; size_t woff;
    if (r < 2 * 1376) {
        const int f = r / 1376; r -= f * 1376; T = r % 43; const int kb = r / 43;
        const float* Wg = ldp(lds, f ? 28 : 9); const float* Wu = ldp(lds, f ? 29 : 10);
        W = (bj ? Wu : Wg) + (size_t)l * DM * DFF; ldw = DFF; S0 = 128 * T + 32 * wc; k0 = 64 * kb; K = DM; perm = 1; woff = f ? WE_GU2 : WE_GU1; gn = ldp(lds, f ? 27 : 8) + (size_t)l * DM;
    } else if ((r -= 2 * 1376) < 2 * 688) {
        const int f = r / 688; r -= f * 688; T = r % 8; const int kb = r / 8;
        W = ldp(lds, f ? 30 : 11) + (size_t)l * DFF * DM; ldw = DM; S0 = 256 * T + 32 * g; k0 = 64 * kb; K = DFF; perm = 1; woff = f ? WE_D2 : WE_D1;
    } else if ((r -= 2 * 688) < 1792) {
        T = r % 56; const int kb = r / 56, pn = T;
        W = ldp(lds, 13) + (size_t)l * DM * N_IN; ldw = N_IN; k0 = 64 * kb; K = DM; perm = 1; woff = WE_IN; gn = ldp(lds, 12) + (size_t)l * DM;
        if (pn == T_Z) { kind = 1; S0 = C_LR; }
        else if (pn < T_CB) S0 = (bj ? C_CH : C_CC) + 128 * pn + 32 * wc;
        else if (pn < T_Q) S0 = C_CB + 256 * (pn - T_CB) + 32 * g;
        else if (pn < T_K) S0 = C_AQ + 256 * (pn - T_Q) + 64 * wc + 32 * bj;
        else if (pn < T_V) S0 = C_AK + 256 * (pn - T_K) + 64 * wc + 32 * bj;
        else if (pn < T_GQ) S0 = C_AV + 256 * (pn - T_V) + 32 * g;
        else if (pn == T_GQ) S0 = C_GQ + 32 * g;
        else if (pn == T_GK) S0 = C_GK + 32 * g;
        else if (pn < T_GR) S0 = C_GV + 256 * (pn - T_GV) + 32 * g;
        else if (pn < T_Z) S0 = C_GR + 256 * (pn - T_GR) + 32 * g;
        else if (pn < T_GATE) S0 = C_PIN + 256 * (pn - T_PIN) + 32 * g;
        else { S0 = C_GATE + (2 * bj + (c4 >> 2)) * 2048 + 64 * (pn - T_GATE) + 16 * wc + 4 * (c4 & 3) - 4 * c4; perm = 0; }
    } else if ((r -= 1792) < 64) { T = r % 8; const int kb = r / 8; W = ldp(lds, 22) + (size_t)l * 512 * DM; ldw = DM; S0 = 256 * T + 32 * g; k0 = 64 * kb; K = YK; perm = 1; woff = WE_UPCAT; yo = YO_A; }
    else if ((r -= 64) < 32) { T = r % 8; const int kb = r / 8; W = ldp(lds, 23) + (size_t)l * 256 * DM; ldw = DM; S0 = 256 * T + 32 * g; k0 = 64 * kb; K = YK; perm = 1; woff = WE_UPCAT; yo = YO_B; }
    else if ((r -= 32) < 64) { T = r % 8; const int kb = r / 8; W = ldp(lds, 24) + (size_t)l * 512 * DM; ldw = DM; S0 = 256 * T + 32 * g; k0 = 64 * kb; K = YK; perm = 1; woff = WE_UPCAT; yo = YO_C; }
    else if ((r -= 64) < 64) { T = r % 8; const int kb = r / 8; W = ldp(lds, 25) + (size_t)l * 512 * DM; ldw = DM; S0 = 256 * T; k0 = 64 * kb; K = YK; perm = 1; woff = WE_UPCAT; yo = YO_D; kind = 2; aux0 = kb; }
    else { r -= 64; T = r % 8; const int kb = r / 8; W = ldp(lds, 26) + (size_t)l * DM * DM; ldw = DM; S0 = 256 * T + 32 * g; k0 = 64 * kb; K = DM; perm = 1; woff = WE_OUT; }
    if (kind == 0) D.src = W + (size_t)(k0 + 8 * wave) * ldw + S0 + 4 * c4;
    else D.src = W + (size_t)k0 * ldw + S0;
    D.gain = gn ? gn + k0 + 8 * wave : nullptr;
    D.dst = wl + woff + ((size_t)T * (K >> 6) + ((yo + k0) >> 6)) * 16384; D.ldw = ldw; D.K = K; D.kind = kind; D.perm = perm; D.aux0 = aux0; D.aux1 = l; D.aux2 = 0;
}
__device__ __forceinline__ void pblk_load(const BDesc& D, f32x4 (&v)[8]) {
    if (D.kind != 0) return;
#pragma unroll
    for (int i = 0; i < 8; ++i) v[i] = __builtin_nontemporal_load((const f32x4*)(D.src + (size_t)i * D.ldw));
}
template <int MODE = 0>
__device__ __forceinline__ void pblk_writeout(LAS unsigned char* lds, bf16* dst, int K, int perm, int tid) {
    LAS float* tile = (LAS float*)(lds + RING_OFF);
    const int lane = tid & 63, wave = tid >> 6;
    LDS_WAIT(); __builtin_amdgcn_s_barrier(); asm volatile("" ::: "memory");
    const int c = lane & 7;
#pragma unroll
    for (int j = 0; j < 4; ++j) {
        const int rho = (lane >> 3) + 8 * j; const int cc = perm ? pg8::perm32(rho) : rho;
        const LAS float* s = tile + (8 * c) * PB_P + 33 * wave + cc;
        u32x4 o; o.x = pk2(s[0 * PB_P], s[1 * PB_P]); o.y = pk2(s[2 * PB_P], s[3 * PB_P]); o.z = pk2(s[4 * PB_P], s[5 * PB_P]); o.w = pk2(s[6 * PB_P], s[7 * PB_P]);
        if (MODE == 0) *(u32x4*)((char*)dst + (wave >> 2) * 16384 + pg8::lds_byte(32 * (wave & 3) + rho, 8 * c)) = o; else asm volatile("" :: "v"(o));
    }
    LDS_WAIT(); __builtin_amdgcn_s_barrier(); asm volatile("" ::: "memory");
}
template <int MODE = 0>
__device__ __forceinline__ void pblk_finish(LAS unsigned char* lds, const BDesc& D, const f32x4 (&v)[8], int tid) {
    if (D.kind != 0) return;
    if (MODE == 2) { _Pragma("unroll") for (int i = 0; i < 8; ++i) asm volatile("" :: "v"(v[i])); return; }
    LAS float* tile = (LAS float*)(lds + RING_OFF);
    const int lane = tid & 63, wave = tid >> 6;
    const int g = lane >> 3, c4 = lane & 7;
#pragma unroll
    for (int i = 0; i < 8; ++i) { const float gk = D.gain ? D.gain[i] : 1.0f; LAS float* s = tile + (8 * wave + i) * PB_P + 33 * g + 4 * c4; s[0] = v[i][0] * gk; s[1] = v[i][1] * gk; s[2] = v[i][2] * gk; s[3] = v[i][3] * gk; }
    pblk_writeout<MODE>(lds, D.dst, D.K, D.perm, tid);
}
__device__ __forceinline__ void prologue_specials(LAS unsigned char* lds, bf16* WB, int bid, int G, int tid) {
    LAS float* tile = (LAS float*)(lds + RING_OFF);
#pragma unroll 1
    for (int s = bid; s < DEPTH * 96; s += G) {
        const int l = s / 96, r = s % 96;
        bf16* wl = WB + (size_t)l * WE_LAYER;
        if (r < 32) {
            const int kb = r;
            const float* A2 = ldp(lds, 17) + (size_t)l * 16 * 256; const float* gmix = ldp(lds, 12) + (size_t)l * DM;
            const float* Wk = ldp(lds, 13) + (size_t)l * DM * N_IN + (size_t)(64 * kb) * N_IN + C_LR;
            const int c = tid & 255, half = tid >> 8;
            float w2[16];
#pragma unroll
            for (int q = 0; q < 16; ++q) w2[q] = A2[q * 256 + c];
#pragma unroll 4
            for (int i = 0; i < 32; ++i) {
                const int kk = 32 * half + i;
                const f32x4* a = (const f32x4*)(Wk + (size_t)kk * N_IN);
                float sum = 0.f;
#pragma unroll
                for (int q = 0; q < 4; ++q) { const f32x4 av = a[q]; sum += av[0] * w2[4 * q] + av[1] * w2[4 * q + 1] + av[2] * w2[4 * q + 2] + av[3] * w2[4 * q + 3]; }
                tile[kk * PB_P + 33 * (c >> 5) + (c & 31)] = sum * gmix[64 * kb + kk];
            }
            pblk_writeout(lds, wl + WE_IN + ((size_t)T_Z * (DM / 64) + kb) * 16384, DM, 1, tid);
        } else {
            const int q = r - 32, T = q % 8, kb = q / 8, gg = kb >> 1, i0 = (kb & 1) * 64;
            LAS float* pw = (LAS float*)(lds + PB_PW_OFF);
            { const f32x4* src = (const f32x4*)(ldp(lds, 20) + ((size_t)l * 4 + gg) * 128 * 128 + (size_t)i0 * 128);
              for (int e = tid; e < 64 * 32; e += NTHR) ((LAS f32x4*)pw)[e] = src[e]; }
            LDS_WAIT(); __builtin_amdgcn_s_barrier(); asm volatile("" ::: "memory");
            const int n = tid & 255, half = tid >> 8;
            const float* SC = ldp(lds, 21) + (size_t)l * 512 + gg * 128;
            const float* UD = ldp(lds, 25) + (size_t)l * 512 * DM + (size_t)(gg * 128) * DM + 256 * T + n;
            float a[32];
#pragma unroll
            for (int j = 0; j < 32; ++j) a[j] = 0.f;
#pragma unroll 2
            for (int c = 0; c < 128; ++c) {
                const float uv = UD[(size_t)c * DM] * SC[c];
#pragma unroll
                for (int j = 0; j < 32; ++j) a[j] += pw[(32 * half + j) * 128 + c] * uv;
            }
#pragma unroll
            for (int j = 0; j < 32; ++j) tile[(32 * half + j) * PB_P + 33 * (n >> 5) + (n & 31)] = a[j];
            pblk_writeout(lds, wl + WE_UPCAT + ((size_t)T * (YK / 64) + YO_D / 64 + kb) * 16384, YK, 1, tid);
        }
    }
}
constexpr int DEFER_WG0 = 96, DEFER_WGS = 160, DEFER_PER_WG = 7, DEFER_N = DEFER_WGS * DEFER_PER_WG;
__device__ __forceinline__ bool pblk_deferred(int blk) {
    const int l = blk / PB_LAYER, r = blk % PB_LAYER;
    if (r < 1376) return l >= 1 && r < DEFER_N;
    if (r < 2 * 1376) return (r - 1376) < DEFER_N;
    return false;
}
#define PB_STEP(CUR, VCUR, NXT2, VNXT2) { const int nx2 = idx + 2 * stride; \
        if (nx2 < count) { pblk_decode(lds, WB, first + nx2, wave, lane, NXT2); if (skip_deferred && pblk_deferred(first + nx2)) NXT2.kind = 3; pblk_load(NXT2, VNXT2); } \
        pblk_finish<MODE>(lds, CUR, VCUR, tid); \
        if (idx + stride >= count) break; idx += stride; }
template <int MODE = 0>
__device__ __forceinline__ void prologue_blocks(LAS unsigned char* lds, bf16* WB, int first, int count, int start, int stride, int tid, bool skip_deferred) {
    const int lane = tid & 63, wave = __builtin_amdgcn_readfirstlane(tid >> 6);
    BDesc A, B, C; f32x4 va[8], vb[8], vc[8];
    int idx = start;
    if (idx >= count) return;
    pblk_decode(lds, WB, first + idx, wave, lane, A); if (skip_deferred && pblk_deferred(first + idx)) A.kind = 3; pblk_load(A, va);
    B.kind = 3;
    if (idx + stride < count) { pblk_decode(lds, WB, first + idx + stride, wave, lane, B); if (skip_deferred && pblk_deferred(first + idx + stride)) B.kind = 3; pblk_load(B, vb); }
#pragma unroll 1
    for (;;) {
        PB_STEP(A, va, C, vc)
        PB_STEP(B, vb, A, va)
        PB_STEP(C, vc, B, vb)
    }
}
#undef PB_STEP

__device__ __forceinline__ void x_init_pass(const float* xp, const float* xs, bf16* XB, unsigned long long* ss0, int gw, int NGW, int lane) {
    for (int row = gw; row < MPAD; row += NGW) {
        u32x2* o = (u32x2*)(XB + (size_t)row * DM) + lane;
        if (row >= MR) {
#pragma unroll
            for (int j = 0; j < 8; ++j) { u32x2 z; z.x = 0u; z.y = 0u; o[64 * j] = z; }
            continue;
        }
        const f32x4* xr = (const f32x4*)(row < MP ? xp + (size_t)row * DM : xs + (size_t)(row - MP) * DM) + lane;
        float ss = 0.f;
#pragma unroll
        for (int j = 0; j < 8; ++j) { const f32x4 v = xr[64 * j]; u32x2 w; w.x = pk2(v[0], v[1]); w.y = pk2(v[2], v[3]); o[64 * j] = w;
            const float a0 = bflo(w.x), a1 = bfhi(w.x), a2 = bflo(w.y), a3 = bfhi(w.y); ss += (a0 * a0 + a1 * a1) + (a2 * a2 + a3 * a3); }
        ss = wave_sum(ss, lane);
        if (lane == 0) ss0[row] = (unsigned long long)(ss * SS_FIX + 0.5f);
    }
}

constexpr int CC_N0 = DEPTH * NB_S * (128 - TS) * 128, CC_N1 = DEPTH * NB_S * (512 - TS) * 128, CC_N2 = DEPTH * NB_S * (2048 - TS) * 128, CACHE_COPY_N = CC_N0 + CC_N1 + CC_N2;
__device__ __forceinline__ void cache_copy_range(const float* c128, const float* c512, const float* c2048, float* out, int i0, int i1, int t, int nt) {
    for (int i = i0 + t; i < i1; i += nt) {
        int ii = i, gi = 0;
        if (ii >= CC_N0) { ii -= CC_N0; gi = 1; if (ii >= CC_N1) { ii -= CC_N1; gi = 2; } }
        const int W = win_of(gi), per = (W - TS) * 128, lb = ii / per, j = ii - lb * per;
        const f32x4* src = (const f32x4*)(gi == 0 ? c128 : (gi == 1 ? c512 : c2048)); f32x4* dst = (f32x4*)(out + offw_s(gi));
        __builtin_nontemporal_store(__builtin_nontemporal_load(src + (size_t)lb * W * 128 + TS * 128 + j), dst + (size_t)lb * W * 128 + j);
    }
}

__device__ __forceinline__ s16x4 ds_tr16(const LAS unsigned char* p) { return __builtin_amdgcn_ds_read_tr16_b64_v4i16((LAS s16x4*)p); }
__device__ __forceinline__ bf16x8 cat4(s16x4 a, s16x4 b) { bf16x8 r; r[0] = a[0]; r[1] = a[1]; r[2] = a[2]; r[3] = a[3]; r[4] = b[0]; r[5] = b[1]; r[6] = b[2]; r[7] = b[3]; return r; }
__device__ __forceinline__ bf16x8 pk8v(f32x4 a, f32x4 b) { const u32x4 w = pk8(a, b); return __builtin_bit_cast(bf16x8, w); }

constexpr int ATT_UNITS = NB_P * 12 * 32;
constexpr int ATT_PITCH = 144;
__device__ __forceinline__ void attn_unit(LAS unsigned char* lds, const bf16* Q, const bf16* K, const bf16* V, float* AO, float* LSE, int unit, int tid) {
    const int lane = tid & 63, w = tid >> 6, fr = lane & 15, g = lane >> 4;
    const int blk = unit & 31, bh = unit >> 5, h = bh % 12, b = bh / 12;
    const int gi = h >> 2, dl = dil_of(gi);
    const int r = blk % dl, nb = blk / dl;
    LAS unsigned char* Ks = lds; LAS unsigned char* Vs = lds + 256 * ATT_PITCH;
    for (int c = tid; c < 2048; c += NTHR) {
        const int ki = c >> 3, ch = c & 7, ksub = nb * 128 + ki - 128;
        u32x4 kv = {0u, 0u, 0u, 0u}, vv = {0u, 0u, 0u, 0u};
        if (ksub >= 0) { const size_t off = (size_t)(b * SEQ + r + dl * ksub) * 768 + h * 64 + ch * 8; kv = *(const u32x4*)(K + off); vv = *(const u32x4*)(V + off); }
        *(LAS u32x4*)(Ks + ki * ATT_PITCH + ch * 16) = kv; *(LAS u32x4*)(Vs + ki * ATT_PITCH + ch * 16) = vv;
    }
    __syncthreads();
    const int qi = 16 * w + fr;
    const int qtok = b * SEQ + r + dl * (nb * 128 + qi);
    const bf16x8 q0 = *(const bf16x8*)(Q + (size_t)qtok * 768 + h * 64 + 8 * g), q1 = *(const bf16x8*)(Q + (size_t)qtok * 768 + h * 64 + 32 + 8 * g);
    const int ks0 = w >> 1;
    f32x4 s[10];
#pragma unroll
    for (int tt = 0; tt < 10; ++tt) {
        const int T = 2 * ks0 + tt;
        const LAS unsigned char* kp = Ks + (16 * T + fr) * ATT_PITCH + 16 * g;
        const bf16x8 k0 = *(const LAS bf16x8*)kp, k1 = *(const LAS bf16x8*)(kp + 64);
        f32x4 a = {0.f, 0.f, 0.f, 0.f};
        a = __builtin_amdgcn_mfma_f32_16x16x32_bf16(k0, q0, a, 0, 0, 0);
        a = __builtin_amdgcn_mfma_f32_16x16x32_bf16(k1, q1, a, 0, 0, 0);
        s[tt] = a;
    }
    const float slope = exp2f(-8.0f * (float)(h + 1) / 12.0f) * (float)dl;
    float mx = -INFINITY;
#pragma unroll
    for (int tt = 0; tt < 10; ++tt)
#pragma unroll
        for (int j = 0; j < 4; ++j) {
            const int ki = 16 * (2 * ks0 + tt) + 4 * g + j, dist = qi - ki + 128, ksub = nb * 128 + ki - 128;
            const bool valid = (dist >= 0) && (dist <= 128) && (ksub >= 0);
            const float v = s[tt][j] * 0.125f - slope * (float)dist;
            s[tt][j] = valid ? v : -INFINITY;
            mx = fmaxf(mx, s[tt][j]);
        }
    mx = fmaxf(mx, shx(mx, 16, lane)); mx = fmaxf(mx, shx(mx, 32, lane));
    float ls = 0.f;
#pragma unroll
    for (int tt = 0; tt < 10; ++tt)
#pragma unroll
        for (int j = 0; j < 4; ++j) { const float p = __expf(s[tt][j] - mx); s[tt][j] = p; ls += p; }
    ls += shx(ls, 16, lane); ls += shx(ls, 32, lane);
    f32x4 o[4];
#pragma unroll
    for (int et = 0; et < 4; ++et) o[et] = (f32x4){0.f, 0.f, 0.f, 0.f};
    const int q4 = fr >> 2, p4 = fr & 3;
#pragma unroll
    for (int kk = 0; kk < 5; ++kk) {
        const bf16x8 pb = pk8v(s[2 * kk], s[2 * kk + 1]);
        const int rb = 32 * (ks0 + kk) + 4 * g + q4;
#pragma unroll
        for (int et = 0; et < 4; ++et) {
            const s16x4 v0 = ds_tr16(Vs + rb * ATT_PITCH + (16 * et + 4 * p4) * 2);
            const s16x4 v1 = ds_tr16(Vs + (rb + 16) * ATT_PITCH + (16 * et + 4 * p4) * 2);
            o[et] = __builtin_amdgcn_mfma_f32_16x16x32_bf16(cat4(v0, v1), pb, o[et], 0, 0, 0);
        }
    }
    const float inv = 1.0f / ls;
    float* ao = AO + (size_t)qtok * 768 + h * 64 + 4 * g;
#pragma unroll
    for (int et = 0; et < 4; ++et) *(f32x4*)(ao + 16 * et) = o[et] * inv;
    if (g == 0) LSE[(size_t)qtok * 12 + h] = mx + __logf(ls);
    __syncthreads();
}

__device__ __forceinline__ void attn_merge_pass(const float* AO, const float* LSE, bf16* YB, int gt, int NGT, int rep = 1) {
    for (int it0 = gt; it0 < rep * MR * 4 * 16; it0 += NGT) {
        const int it = it0 % (MR * 4 * 16);
        const int e4 = it & 15, slot = (it >> 4) & 3, tok = it >> 6;
        const float l0 = LSE[(size_t)tok * 12 + slot], l1 = LSE[(size_t)tok * 12 + 4 + slot], l2 = LSE[(size_t)tok * 12 + 8 + slot];
        const float m = fmaxf(l0, fmaxf(l1, l2));
        const float w0 = __expf(l0 - m), w1 = __expf(l1 - m), w2 = __expf(l2 - m), inv = 1.0f / (w0 + w1 + w2);
        const float* a = AO + (size_t)tok * 768 + slot * 64 + e4 * 4;
        const f32x4 y = (*(const f32x4*)a * w0 + *(const f32x4*)(a + 256) * w1 + *(const f32x4*)(a + 512) * w2) * inv;
        u32x2 wv; wv.x = pk2(y[0], y[1]); wv.y = pk2(y[2], y[3]);
        *(u32x2*)(YB + (size_t)tok * YK + YO_B + slot * 64 + e4 * 4) = wv;
    }
}

__device__ __forceinline__ float dot64_f32(const float (&q)[64], const float* k) {
    float s = 0.f;
#pragma unroll
    for (int c = 0; c < 16; ++c) { const f32x4 kv = ((const f32x4*)k)[c]; s += (q[4 * c] * kv[0] + q[4 * c + 1] * kv[1]) + (q[4 * c + 2] * kv[2] + q[4 * c + 3] * kv[3]); }
    return s;
}
__device__ __forceinline__ float dot64_bf(const float (&q)[64], const bf16* k) {
    float s = 0.f;
#pragma unroll
    for (int c = 0; c < 8; ++c) { const u32x4 w = ((const u32x4*)k)[c];
        s += (q[8 * c] * bflo(w.x) + q[8 * c + 1] * bfhi(w.x)) + (q[8 * c + 2] * bflo(w.y) + q[8 * c + 3] * bfhi(w.y)) + (q[8 * c + 4] * bflo(w.z) + q[8 * c + 5] * bfhi(w.z)) + (q[8 * c + 6] * bflo(w.w) + q[8 * c + 7] * bfhi(w.w)); }
    return s;
}
__device__ __forceinline__ void attn_sample_wave(const bf16* Q, const bf16* K, const bf16* V, const float* c128, const float* c512, const float* c2048, float* AO, float* LSE, int layer, int unit, int lane) {
    const int h = unit % 12, bt = unit / 12, t = bt & 3, b = bt >> 2;
    const int row = MP + b * TS + t;
    const int gi = h >> 2, slot = h & 3, dl = dil_of(gi), W = win_of(gi);
    const float* cache = (gi == 0 ? c128 : (gi == 1 ? c512 : c2048)) + (size_t)(layer * NB_S + b) * W * 512;
    float qf[64];
    { const u32x4* qp = (const u32x4*)(Q + (size_t)row * 768 + h * 64);
#pragma unroll
      for (int c = 0; c < 8; ++c) { const u32x4 w = qp[c]; qf[8 * c] = bflo(w.x) * 0.125f; qf[8 * c + 1] = bfhi(w.x) * 0.125f; qf[8 * c + 2] = bflo(w.y) * 0.125f; qf[8 * c + 3] = bfhi(w.y) * 0.125f;
          qf[8 * c + 4] = bflo(w.z) * 0.125f; qf[8 * c + 5] = bfhi(w.z) * 0.125f; qf[8 * c + 6] = bflo(w.w) * 0.125f; qf[8 * c + 7] = bfhi(w.w) * 0.125f; } }
    const float slope = exp2f(-8.0f * (float)(h + 1) / 12.0f) * (float)dl;
    float sc[3];
#pragma unroll
    for (int sj = 0; sj < 3; ++sj) {
        const int j = lane + 64 * sj;
        float d = -INFINITY;
        if (j <= 128) {
            const int idx = W + t - j * dl;
            if (idx >= W) d = dot64_bf(qf, K + (size_t)(MP + b * TS + (idx - W)) * 768 + h * 64);
            else d = dot64_f32(qf, cache + ((size_t)idx * 2 + 0) * 256 + slot * 64);
            d -= slope * (float)j;
        }
        sc[sj] = d;
    }
    const float mg = wave_max(fmaxf(sc[0], fmaxf(sc[1], sc[2])), lane);
    const float p0 = __expf(sc[0] - mg), p1 = __expf(sc[1] - mg), p2 = __expf(sc[2] - mg);
    const float lg = wave_sum(p0 + p1 + p2, lane);
    float acc = 0.f;
    const int jstart = (dl == 1) ? t + 1 : 1;
#pragma unroll 1
    for (int j = 0; j < jstart; ++j) acc += rdl(p0, j) * bf2f(V[(size_t)(MP + b * TS + (t - j * dl)) * 768 + h * 64 + lane]);
    const float* vbase = cache + 256 + slot * 64 + lane;
#pragma unroll 1
    for (int j0 = jstart; j0 <= 128; j0 += 32) {
        float vv[32];
#pragma unroll
        for (int i = 0; i < 32; ++i) { const int j = (j0 + i <= 128) ? j0 + i : 128; vv[i] = vbase[(size_t)(W + t - j * dl) * 512]; }
#pragma unroll
        for (int i = 0; i < 32; ++i) { const int j = j0 + i; const float pj = (j <= 128) ? rdl(j < 64 ? p0 : (j < 128 ? p1 : p2), j & 63) : 0.f; acc += pj * vv[i]; }
    }
    AO[(size_t)row * 768 + h * 64 + lane] = acc / lg;
    if (lane == 0) LSE[(size_t)row * 12 + h] = mg + __logf(lg);
}

__device__ __forceinline__ void conv_pool_pass(const bf16* CB, const bf16* U, const bf16* PIN, const float* conv_w, const float* st_conv, const float* st_pool, bf16* YA, bf16* YD, int layer, int gt, int NGT, int rep = 1) {
    for (int it0 = gt; it0 < rep * MPAD * 64; it0 += NGT) {
        const int it = it0 % (MPAD * 64); const int c8 = it & 63, row = it >> 6, ch = c8 * 8;
        int kind, b, t; row_decode(row, kind, b, t);
        if (kind == 2) { const u32x4 z = {0u, 0u, 0u, 0u}; *(u32x4*)(YA + (size_t)row * YK + YO_A + ch) = z; *(u32x4*)(YD + (size_t)row * YK + YO_D + ch) = z; continue; }
        float u0[8], u1[8], u2[8], cb[8];
        unpk8(*(const u32x4*)(U + (size_t)row * 512 + ch), u2);
        if (t >= 1) unpk8(*(const u32x4*)(U + (size_t)(row - 1) * 512 + ch), u1);
        else if (kind == 1) { const float* s = st_conv + ((size_t)(layer * NB_S + b) * 2 + 1) * 512 + ch; _Pragma("unroll") for (int j = 0; j < 8; ++j) u1[j] = s[j]; }
        else { _Pragma("unroll") for (int j = 0; j < 8; ++j) u1[j] = 0.f; }
        if (t >= 2) unpk8(*(const u32x4*)(U + (size_t)(row - 2) * 512 + ch), u0);
        else if (kind == 1) { const float* s = st_conv + ((size_t)(layer * NB_S + b) * 2 + t) * 512 + ch; _Pragma("unroll") for (int j = 0; j < 8; ++j) u0[j] = s[j]; }
        else { _Pragma("unroll") for (int j = 0; j < 8; ++j) u0[j] = 0.f; }
        unpk8(*(const u32x4*)(CB + (size_t)row * 512 + ch), cb);
        const float* cw = conv_w + (size_t)layer * 3 * 512 + ch;
        f32x4 ya0, ya1;
#pragma unroll
        for (int j = 0; j < 8; ++j) { const float z = cw[j] * u0[j] + cw[512 + j] * u1[j] + cw[1024 + j] * u2[j]; const float y = cb[j] * z; if (j < 4) ya0[j] = y; else ya1[j - 4] = y; }
        *(u32x4*)(YA + (size_t)row * YK + YO_A + ch) = pk8(ya0, ya1);
        const int grp = c8 >> 4, w = 2 << grp;
        float cur[8], sum[8];
        unpk8(*(const u32x4*)(PIN + (size_t)row * 512 + ch), cur);
#pragma unroll
        for (int j = 0; j < 8; ++j) sum[j] = cur[j];
        if (kind == 0) {
            u32x4 xr[15];
#pragma unroll
            for (int i = 1; i < 16; ++i) { const bool ok = (i < w) && (t - i >= 0); xr[i - 1] = *(const u32x4*)(PIN + (size_t)(ok ? row - i : row) * 512 + ch); }
#pragma unroll
            for (int i = 1; i < 16; ++i) { const bool ok = (i < w) && (t - i >= 0); float x[8]; unpk8(xr[i - 1], x); const float m = ok ? 1.f : 0.f;
#pragma unroll
                for (int j = 0; j < 8; ++j) sum[j] += m * x[j]; }
        } else {
            for (int i = 1; i < w; ++i) {
                const int tt = t - i;
                if (tt >= 0) { float x[8]; unpk8(*(const u32x4*)(PIN + (size_t)(row - i) * 512 + ch), x); _Pragma("unroll") for (int j = 0; j < 8; ++j) sum[j] += x[j]; }
                else { const float* s = st_pool + ((size_t)(layer * NB_S + b) * 15 + (15 + tt)) * 512 + ch; _Pragma("unroll") for (int j = 0; j < 8; ++j) sum[j] += s[j]; }
            }
        }
        const float cnt = (kind == 1) ? (float)w : fminf((float)w, (float)(t + 1));
        const float ic = 1.0f / cnt;
        f32x4 d0, d1;
#pragma unroll
        for (int j = 0; j < 8; ++j) { const float d = sum[j] * ic - cur[j]; if (j < 4) d0[j] = d; else d1[j - 4] = d; }
        *(u32x4*)(YD + (size_t)row * YK + YO_D + ch) = pk8(d0, d1);
    }
}

constexpr int GLA_UNITS = NB_P * 4 * 64;
constexpr int GP_K = 144, GP_V = 272;
constexpr int GLA_R0 = 0, GLA_R0_BYTES = 17408, GLA_QT = GLA_R0 + GLA_R0_BYTES, GLA_KT = GLA_QT + 64 * GP_K, GLA_VV = GLA_KT + 64 * GP_K, GLA_HALF = GLA_VV + 64 * GP_V;
static_assert(2 * GLA_HALF <= RING_BYTES, "GLA LDS");

__device__ __forceinline__ void gla_cumsum(LAS float* lb, const float* LA, int tok0, int h, int ht) {
    const int k = ht & 63, q = ht >> 6;
    float v[16]; float run = 0.f;
#pragma unroll
    for (int i = 0; i < 16; ++i) { run += LA[(size_t)(tok0 + 16 * q + i) * 256 + h * 64 + k]; v[i] = run; }
    LAS float* tot = lb + 4096;
    tot[q * 64 + k] = run;
    __syncthreads();
    float off = 0.f;
#pragma unroll
    for (int qq = 0; qq < 3; ++qq) off += (qq < q) ? tot[qq * 64 + k] : 0.f;
#pragma unroll
    for (int i = 0; i < 16; ++i) lb[(16 * q + i) * 64 + k] = v[i] + off;
    __syncthreads();
}

__device__ __forceinline__ void gla_ds_unit(LAS unsigned char* hl, const bf16* GK, const bf16* GV, const float* LA, float* DS, float* DEC, int unit, int ht) {
    const int n = unit & 63, bh = unit >> 6, h = bh & 3, b = bh >> 2;
    const int tok0 = b * SEQ + n * 64;
    const int lane = ht & 63, hw = ht >> 6, fr = lane & 15, g = lane >> 4;
    LAS float* lb = (LAS float*)(hl + GLA_R0);
    gla_cumsum(lb, LA, tok0, h, ht);
    for (int c = ht; c < 512; c += 256) {
        const int s = c >> 3, k0 = (c & 7) * 8;
        float kf[8]; unpk8(*(const u32x4*)(GK + (size_t)(tok0 + s) * 256 + h * 64 + k0), kf);
        f32x4 a0, a1;
#pragma unroll
        for (int j = 0; j < 8; ++j) { const float e = kf[j] * __expf(lb[63 * 64 + k0 + j] - lb[s * 64 + k0 + j]); if (j < 4) a0[j] = e; else a1[j - 4] = e; }
        *(LAS u32x4*)(hl + GLA_KT + s * GP_K + k0 * 2) = pk8(a0, a1);
    }
    for (int c = ht; c < 1024; c += 256) {
        const int s = c >> 4, v0 = (c & 15) * 8;
        *(LAS u32x4*)(hl + GLA_VV + s * GP_V + v0 * 2) = *(const u32x4*)(GV + (size_t)(tok0 + s) * 512 + h * 128 + v0);
    }
    if (ht < 64) DEC[(size_t)unit * 64 + ht] = __expf(lb[63 * 64 + ht]);
    __syncthreads();
    const int q4 = fr >> 2, p4 = fr & 3, kt = hw;
    float* dsb = DS + (size_t)unit * 64 * 128;
#pragma unroll
    for (int dvt = 0; dvt < 8; ++dvt) {
        f32x4 acc = {0.f, 0.f, 0.f, 0.f};
#pragma unroll
        for (int ks = 0; ks < 2; ++ks) {
            const int rb = 32 * ks + 4 * g + q4;
            const bf16x8 af = cat4(ds_tr16(hl + GLA_KT + rb * GP_K + (16 * kt + 4 * p4) * 2), ds_tr16(hl + GLA_KT + (rb + 16) * GP_K + (16 * kt + 4 * p4) * 2));
            const bf16x8 bf = cat4(ds_tr16(hl + GLA_VV + rb * GP_V + (16 * dvt + 4 * p4) * 2), ds_tr16(hl + GLA_VV + (rb + 16) * GP_V + (16 * dvt + 4 * p4) * 2));
            acc = __builtin_amdgcn_mfma_f32_16x16x32_bf16(af, bf, acc, 0, 0, 0);
        }
#pragma unroll
        for (int j = 0; j < 4; ++j) dsb[(size_t)(16 * kt + 4 * g + j) * 128 + 16 * dvt + fr] = acc[j];
    }
    __syncthreads();
}

__device__ __forceinline__ void gla_scan_pass(const float* DS, const float* DEC, bf16* SP, float* out, int layer, int gt, int rep = 1) {
    if (gt >= 8 * 64 * 128) return;
    for (int rr = 0; rr < rep; ++rr) {
    const int v = gt & 127, k = (gt >> 7) & 63, bh = gt >> 13;
    float S = 0.f;
    for (int n0 = 0; n0 < 64; n0 += 32) {
        float d[32], a[32];
#pragma unroll
        for (int i = 0; i < 32; ++i) { d[i] = DS[(((size_t)bh * 64 + n0 + i) * 64 + k) * 128 + v]; a[i] = DEC[((size_t)bh * 64 + n0 + i) * 64 + k]; }
#pragma unroll
        for (int i = 0; i < 32; ++i) { SP[(((size_t)bh * 64 + n0 + i) * 64 + k) * 128 + v] = (bf16)f2bf(S); S = a[i] * S + d[i]; }
    }
    out[OFF_GLA_P + (((size_t)layer * 8 + bh) * 64 + k) * 128 + v] = S;
    }
}

__device__ __forceinline__ void gla_out_unit(LAS unsigned char* hl, const bf16* GQ, const bf16* GK, const bf16* GV, const bf16* GR, const float* LA, const bf16* SP, const float* gnorm, bf16* YC, int unit, int ht) {
    const int n = unit & 63, bh = unit >> 6, h = bh & 3, b = bh >> 2;
    const int tok0 = b * SEQ + n * 64;
    const int lane = ht & 63, hw = ht >> 6, fr = lane & 15, g = lane >> 4;
    LAS float* lb = (LAS float*)(hl + GLA_R0);
    gla_cumsum(lb, LA, tok0, h, ht);
    for (int c = ht; c < 512; c += 256) {
        const int s = c >> 3, k0 = (c & 7) * 8;
        float qf[8], kf[8];
        unpk8(*(const u32x4*)(GQ + (size_t)(tok0 + s) * 256 + h * 64 + k0), qf);
        unpk8(*(const u32x4*)(GK + (size_t)(tok0 + s) * 256 + h * 64 + k0), kf);
        f32x4 a0, a1, c0, c1;
#pragma unroll
        for (int j = 0; j < 8; ++j) { const float bb = lb[s * 64 + k0 + j]; const float qe = qf[j] * __expf(bb), ke = kf[j] * __expf(-bb); if (j < 4) { a0[j] = qe; c0[j] = ke; } else { a1[j - 4] = qe; c1[j - 4] = ke; } }
        *(LAS u32x4*)(hl + GLA_QT + s * GP_K + k0 * 2) = pk8(a0, a1);
        *(LAS u32x4*)(hl + GLA_KT + s * GP_K + k0 * 2) = pk8(c0, c1);
    }
    for (int c = ht; c < 1024; c += 256) {
        const int s = c >> 4, v0 = (c & 15) * 8;
        *(LAS u32x4*)(hl + GLA_VV + s * GP_V + v0 * 2) = *(const u32x4*)(GV + (size_t)(tok0 + s) * 512 + h * 128 + v0);
    }
    __syncthreads();
    for (int c = ht; c < 1024; c += 256) {
        const int k = c >> 4, v0 = (c & 15) * 8;
        *(LAS u32x4*)(hl + GLA_R0 + k * GP_V + v0 * 2) = *(const u32x4*)(SP + ((size_t)unit * 64 + k) * 128 + v0);
    }
    __syncthreads();
    const int tt = hw, q4 = fr >> 2, p4 = fr & 3;
    f32x4 at[4];
    const LAS unsigned char* qrow = hl + GLA_QT + (16 * tt + fr) * GP_K;
    const bf16x8 qb0 = *(const LAS bf16x8*)(qrow + 16 * g), qb1 = *(const LAS bf16x8*)(qrow + 64 + 16 * g);
#pragma unroll
    for (int st = 0; st < 4; ++st) {
        const LAS unsigned char* krow = hl + GLA_KT + (16 * st + fr) * GP_K;
        f32x4 a = {0.f, 0.f, 0.f, 0.f};
        a = __builtin_amdgcn_mfma_f32_16x16x32_bf16(*(const LAS bf16x8*)(krow + 16 * g), qb0, a, 0, 0, 0);
        a = __builtin_amdgcn_mfma_f32_16x16x32_bf16(*(const LAS bf16x8*)(krow + 64 + 16 * g), qb1, a, 0, 0, 0);
#pragma unroll
        for (int j = 0; j < 4; ++j) { const int s = 16 * st + 4 * g + j, t = 16 * tt + fr; a[j] = (s <= t) ? a[j] : 0.f; }
        at[st] = a;
    }
    f32x4 o[8];
#pragma unroll
    for (int dvt = 0; dvt < 8; ++dvt) o[dvt] = (f32x4){0.f, 0.f, 0.f, 0.f};
#pragma unroll
    for (int ks = 0; ks < 2; ++ks) {
        const bf16x8 pb = pk8v(at[2 * ks], at[2 * ks + 1]);
        const int rb = 32 * ks + 4 * g + q4;
        const s16x4 qa = *(const LAS s16x4*)(qrow + (32 * ks + 4 * g) * 2), qc = *(const LAS s16x4*)(qrow + (32 * ks + 16 + 4 * g) * 2);
        const bf16x8 qp = cat4(qa, qc);
#pragma unroll
        for (int dvt = 0; dvt < 8; ++dvt) {
            const bf16x8 vf = cat4(ds_tr16(hl + GLA_VV + rb * GP_V + (16 * dvt + 4 * p4) * 2), ds_tr16(hl + GLA_VV + (rb + 16) * GP_V + (16 * dvt + 4 * p4) * 2));
            o[dvt] = __builtin_amdgcn_mfma_f32_16x16x32_bf16(vf, pb, o[dvt], 0, 0, 0);
            const bf16x8 sf = cat4(ds_tr16(hl + GLA_R0 + rb * GP_V + (16 * dvt + 4 * p4) * 2), ds_tr16(hl + GLA_R0 + (rb + 16) * GP_V + (16 * dvt + 4 * p4) * 2));
            o[dvt] = __builtin_amdgcn_mfma_f32_16x16x32_bf16(sf, qp, o[dvt], 0, 0, 0);
        }
    }
    float ss = 0.f;
#pragma unroll
    for (int dvt = 0; dvt < 8; ++dvt) ss += (o[dvt][0] * o[dvt][0] + o[dvt][1] * o[dvt][1]) + (o[dvt][2] * o[dvt][2] + o[dvt][3] * o[dvt][3]);
    ss += shx(ss, 16, lane); ss += shx(ss, 32, lane);
    const float rs = rsqrtf(ss * (1.0f / 128.0f) + EPS);
    const size_t orow = (size_t)(tok0 + 16 * tt + fr) * 512 + h * 128, yrow = (size_t)(tok0 + 16 * tt + fr) * YK + YO_C + h * 128;
#pragma unroll
    for (int dvt = 0; dvt < 8; ++dvt) {
        const int dv = 16 * dvt + 4 * g;
        const f32x4 gn = *(const f32x4*)(gnorm + dv);
        const u32x2 gw = *(const u32x2*)(GR + orow + dv);
        f32x4 y; y[0] = o[dvt][0] * rs * gn[0] * bflo(gw.x); y[1] = o[dvt][1] * rs * gn[1] * bfhi(gw.x); y[2] = o[dvt][2] * rs * gn[2] * bflo(gw.y); y[3] = o[dvt][3] * rs * gn[3] * bfhi(gw.y);
        u32x2 wv; wv.x = pk2(y[0], y[1]); wv.y = pk2(y[2], y[3]);
        *(u32x2*)(YC + yrow + dv) = wv;
    }
    __syncthreads();
}

__device__ __forceinline__ void gla_sample_unit(LAS float* red, const bf16* GQ, const bf16* GK, const bf16* GV, const bf16* GR, const float* LA, const float* st_gla, const float* gnorm, bf16* YC, float* out, int layer, int unit, int tid) {
    const int h = unit & 3, b = unit >> 2;
    const int dv = tid & 127, kq = tid >> 7;
    const float* s0 = st_gla + (((size_t)(layer * NB_S + b) * 4 + h) * 64 + 16 * kq) * 128 + dv;
    float S[16];
#pragma unroll
    for (int i = 0; i < 16; ++i) S[i] = s0[(size_t)i * 128];
#pragma unroll 1
    for (int t = 0; t < TS; ++t) {
        const int row = MP + b * TS + t;
        const float vv = bf2f(GV[(size_t)row * 512 + h * 128 + dv]);
        float po = 0.f;
#pragma unroll
        for (int i = 0; i < 16; ++i) {
            const int k = 16 * kq + i;
            const float a = __expf(LA[(size_t)row * 256 + h * 64 + k]);
            S[i] = a * S[i] + bf2f(GK[(size_t)row * 256 + h * 64 + k]) * vv;
            po += bf2f(GQ[(size_t)row * 256 + h * 64 + k]) * S[i];
        }
        red[kq * 128 + dv] = po;
        __syncthreads();
        float o = 0.f, sq = 0.f;
        if (kq == 0) { o = (red[dv] + red[128 + dv]) + (red[256 + dv] + red[384 + dv]); sq = o * o; }
        sq = wave_sum(sq, tid & 63);
        if (kq == 0 && (tid & 63) == 0) red[512 + (tid >> 6)] = sq;
        __syncthreads();
        if (kq == 0) {
            const float rs = rsqrtf((red[512] + red[513]) * (1.0f / 128.0f) + EPS);
            const float y = o * rs * gnorm[dv] * bf2f(GR[(size_t)row * 512 + h * 128 + dv]);
            YC[(size_t)row * YK + YO_C + h * 128 + dv] = (bf16)f2bf(y);
        }
        __syncthreads();
    }
    float* so = out + OFF_GLA_S + (((size_t)(layer * NB_S + b) * 4 + h) * 64 + 16 * kq) * 128 + dv;
#pragma unroll
    for (int i = 0; i < 16; ++i) so[(size_t)i * 128] = S[i];
}

constexpr int PH_PER_LAYER = 13, NPH = 1 + DEPTH * PH_PER_LAYER;
#define RM(bit) (1 + ((PROBE_DUP >> (bit)) & 1))
#define REP(bit) for (int rep_ = 0; rep_ < 1 + ((PROBE_DUP >> (bit)) & 1); ++rep_)
#ifndef PROBE_SP2
#define PROBE_SP2 true
#endif
#ifndef PROBE_ALIGN_GU
#define PROBE_ALIGN_GU true
#endif
#ifndef PROBE_ALIGN_RES
#define PROBE_ALIGN_RES true
#endif
#ifndef PROBE_ALIGN_WIN
#define PROBE_ALIGN_WIN true
#endif
#ifndef MK_UNROLL_LAYERS
#define MK_UNROLL_LAYERS 1
#endif
#ifndef MK_PER_PHASE
#define MK_PER_PHASE 0
#endif

struct Args { const float* in[31]; float* out; unsigned char* ws; int ph_lo, ph_hi; };
static_assert(sizeof(Args) == 31 * 8 + 8 + 8 + 8, "Args has no padding");

__device__ __forceinline__ unsigned char* launder(unsigned char* p) { asm volatile("" : "+s"(p)); return p; }
__device__ __forceinline__ int opq_v(int x) { asm volatile("" : "+v"(x)); return x; }
__device__ __forceinline__ int opq_s(int x) { asm volatile("" : "+s"(x)); return x; }

#define IN(k) (lo <= (k) && (k) < hi)
#define SEAM(k) do { if (IN((k) + 1)) { XcdBarrier bar_; bar_.bar = (unsigned*)(WSP() + WS_CTL) + CW_BAR; bar_.x = xb_xcc_id(); bar_.st = (volatile LAS unsigned*)(lds + MISC_OFF) + 8; REP(13) xcd_barrier(bar_, tid); } } while (0)
#define GW (bid * NWAVES + wave)
#define NGW (G * NWAVES)
#define GT (bid * NTHR + tid)
#define NGT (G * NTHR)
#define WSP() launder((unsigned char*)ldp(lds, PT_WS))
#define IDS() const int wave = opq_s(wave0), lane = (int)__builtin_amdgcn_mbcnt_hi(~0u, __builtin_amdgcn_mbcnt_lo(~0u, (unsigned)opq_v(0))), tid = wave * 64 + lane, G = opq_s(G0), bid = opq_s(bid0); (void)lane; (void)wave; (void)G; (void)bid
struct Ctx { LAS unsigned char* lds; int tid0, wave0, G0, bid0, lo, hi; };
#define CTX_LOCALS() LAS unsigned char* lds = c.lds; const int tid0 = c.tid0, wave0 = c.wave0, G0 = c.G0, bid0 = c.bid0, lo = c.lo, hi = c.hi; (void)lds; (void)tid0; (void)wave0; (void)G0; (void)bid0; (void)lo; (void)hi

__device__ __forceinline__ void ff_part(const Ctx c, const int l, const int f) {
    CTX_LOCALS();
    const int pb = 1 + l * PH_PER_LAYER;
    const int fb = pb + (f ? 10 : 0);
    if (IN(fb + 1)) {
        { IDS(); unsigned char* ws = WSP(); const bf16* wl = (const bf16*)(ws + WS_W) + (size_t)l * WE_LAYER;
          pg8::Gemm g{(const bf16*)(ws + WS_XN), wl + (f ? WE_GU2 : WE_GU1), MP, NGU, DM}; pg8::StaticOrder S; S.init(MP, NGU, G, bid, RM(4));
          EpiSwiGLU E{ws, 3 * l + (f ? 2 : 0)};
          pg8::gemm_phase<EpiSwiGLU, pg8::StaticOrder, PROBE_ALIGN_GU, PROBE_SP2>(lds + RING_OFF, g, S, E, tid); }
        { IDS(); unsigned char* ws = WSP(); const bf16* wl = (const bf16*)(ws + WS_W) + (size_t)l * WE_LAYER; EpiSwiGLU E{ws, 3 * l + (f ? 2 : 0)};
          for (int su = G - 1 - bid; su < RM(9) * (NGU / 64); su += G) skinny_unit<EpiSwiGLU>(lds + RING_OFF, (const bf16*)(ws + WS_XN), wl + (f ? WE_GU2 : WE_GU1), DM, su % (NGU / 64), E, tid); }
        { IDS(); unsigned char* ws = WSP();
          const int dfirst = (f == 0) ? l * PB_LAYER + 1376 : (l + 1) * PB_LAYER;
          if (G == 256 && bid >= DEFER_WG0 && (f == 0 || l < DEPTH - 1)) prologue_blocks(lds, (bf16*)(ws + WS_W), dfirst, DEFER_N, bid - DEFER_WG0, DEFER_WGS, tid, false);
          { const int slot = 2 * l + f; const int c0 = (int)((long)CACHE_COPY_N * slot / 10), c1 = (slot == 7) ? CACHE_COPY_N : (int)((long)CACHE_COPY_N * (slot + 1) / 10);
            if (G == 256) { if (bid >= DEFER_WG0) cache_copy_range(ldp(lds, 3), ldp(lds, 4), ldp(lds, 5), (float*)ldp(lds, PT_OUT), c0, c1, (bid - DEFER_WG0) * NTHR + tid, DEFER_WGS * NTHR); }
            else cache_copy_range(ldp(lds, 3), ldp(lds, 4), ldp(lds, 5), (float*)ldp(lds, PT_OUT), c0, c1, GT, NGT); } }
        IDS();
        SEAM(fb + 1);
    }
    if (IN(fb + 2)) {
        { IDS(); unsigned char* ws = WSP(); const bf16* wl = (const bf16*)(ws + WS_W) + (size_t)l * WE_LAYER;
          pg8::Gemm g{(const bf16*)(ws + WS_H), wl + (f ? WE_D2 : WE_D1), MP, DM, DFF}; pg8::StaticOrder S; S.init(MP, DM, G, bid, RM(10));
          EpiResid E{ws, lds, 0.5f, (f == 1 && l == DEPTH - 1) ? 1 : 0, (f == 0) ? 3 * l + 1 : (l < DEPTH - 1 ? 3 * l + 3 : -1)};
          pg8::gemm_phase<EpiResid, pg8::StaticOrder, PROBE_ALIGN_RES, PROBE_SP2>(lds + RING_OFF, g, S, E, tid); }
        { IDS(); unsigned char* ws = WSP(); const bf16* wl = (const bf16*)(ws + WS_W) + (size_t)l * WE_LAYER; EpiResid E{ws, lds, 0.5f, (f == 1 && l == DEPTH - 1) ? 1 : 0, (f == 0) ? 3 * l + 1 : (l < DEPTH - 1 ? 3 * l + 3 : -1)};
          for (int su = G - 1 - bid; su < DM / 64; su += G) skinny_unit<EpiResid>(lds + RING_OFF, (const bf16*)(ws + WS_H), wl + (f ? WE_D2 : WE_D1), DFF, su, E, tid); }
        IDS();
        SEAM(fb + 2);
    }
}

__device__ __forceinline__ void mixer_part(const Ctx c, const int l) {
    CTX_LOCALS();
    const int pb = 1 + l * PH_PER_LAYER;
    if (IN(pb + 4)) {
        { IDS(); unsigned char* ws = WSP(); const bf16* wl = (const bf16*)(ws + WS_W) + (size_t)l * WE_LAYER;
          pg8::Gemm g{(const bf16*)(ws + WS_XN), wl + WE_IN, MP, NWIN, DM}; pg8::StaticOrder S; S.init(MP, NWIN, G, bid, RM(3));
          EpiWin E{ws, ldp(lds, 15) + (size_t)l * 768, ldp(lds, 16) + (size_t)l * 768, ldp(lds, 18) + (size_t)l * 256, (float*)ldp(lds, PT_OUT), l, 3 * l + 1};
          pg8::gemm_phase<EpiWin, pg8::StaticOrder, PROBE_ALIGN_WIN, PROBE_SP2>(lds + RING_OFF, g, S, E, tid); }
        { IDS(); unsigned char* ws = WSP(); const bf16* wl = (const bf16*)(ws + WS_W) + (size_t)l * WE_LAYER;
          EpiWin E{ws, ldp(lds, 15) + (size_t)l * 768, ldp(lds, 16) + (size_t)l * 768, ldp(lds, 18) + (size_t)l * 256, (float*)ldp(lds, PT_OUT), l, 3 * l + 1};
          for (int su = G - 1 - bid; su < RM(9) * (NWIN / 64); su += G) skinny_unit<EpiWin>(lds + RING_OFF, (const bf16*)(ws + WS_XN), wl + WE_IN, DM, su % (NWIN / 64), E, tid); }
        IDS();
        SEAM(pb + 4);
    }
    if (IN(pb + 5)) {
        IDS();
        { unsigned char* ws = WSP();
          for (int u = bid; u < RM(1) * ATT_UNITS; u += G) attn_unit(lds, (const bf16*)(ws + WS_Q), (const bf16*)(ws + WS_K), (const bf16*)(ws + WS_V), (float*)(ws + WS_AO), (float*)(ws + WS_LSE), u % ATT_UNITS, tid); }
        { unsigned char* ws = WSP();
          for (int u2 = bid; u2 < RM(5) * (GLA_UNITS / 2); u2 += G) gla_ds_unit(lds + (tid >> 8) * GLA_HALF, (const bf16*)(ws + WS_GK), (const bf16*)(ws + WS_GV), (const float*)(ws + WS_LA), (float*)(ws + WS_DS), (float*)(ws + WS_DEC), 2 * (u2 % (GLA_UNITS / 2)) + (tid >> 8), tid & 255); }
        { unsigned char* ws = WSP();
          conv_pool_pass((const bf16*)(ws + WS_CB), (const bf16*)(ws + WS_U), (const bf16*)(ws + WS_PIN), ldp(lds, 14), ldp(lds, 2), ldp(lds, 7), (bf16*)(ws + WS_YCAT), (bf16*)(ws + WS_YCAT), l, GT, NGT, RM(6)); }
        REP(8) { const int su = (NGW - 1 - GW);
          if (su < NB_S * TS * 12) { unsigned char* ws = WSP(); attn_sample_wave((const bf16*)(ws + WS_Q), (const bf16*)(ws + WS_K), (const bf16*)(ws + WS_V), ldp(lds, 3), ldp(lds, 4), ldp(lds, 5), (float*)(ws + WS_AO), (float*)(ws + WS_LSE), l, su, lane); } }
        REP(8) { unsigned char* ws = WSP();
          for (int u = bid - 64; u >= 0 && u < NB_S * 4; u += G) gla_sample_unit((LAS float*)lds, (const bf16*)(ws + WS_GQ), (const bf16*)(ws + WS_GK), (const bf16*)(ws + WS_GV), (const bf16*)(ws + WS_GR), (const float*)(ws + WS_LA), ldp(lds, 6), ldp(lds, 19) + (size_t)l * 128, (bf16*)(ws + WS_YCAT), (float*)ldp(lds, PT_OUT), l, u, tid); }
        SEAM(pb + 5);
    }
    if (IN(pb + 6)) {
        IDS(); unsigned char* ws = WSP();
        gla_scan_pass((const float*)(ws + WS_DS), (const float*)(ws + WS_DEC), (bf16*)(ws + WS_SP), (float*)ldp(lds, PT_OUT), l, GT, RM(7));
        attn_merge_pass((const float*)(ws + WS_AO), (const float*)(ws + WS_LSE), (bf16*)(ws + WS_YCAT), GT, NGT, RM(7));
        SEAM(pb + 6);
    }
    if (IN(pb + 7)) {
        IDS(); unsigned char* ws = WSP();
        for (int u2 = bid; u2 < RM(5) * (GLA_UNITS / 2); u2 += G) gla_out_unit(lds + (tid >> 8) * GLA_HALF, (const bf16*)(ws + WS_GQ), (const bf16*)(ws + WS_GK), (const bf16*)(ws + WS_GV), (const bf16*)(ws + WS_GR), (const float*)(ws + WS_LA), (const bf16*)(ws + WS_SP), ldp(lds, 19) + (size_t)l * 128, (bf16*)(ws + WS_YCAT), 2 * (u2 % (GLA_UNITS / 2)) + (tid >> 8), tid & 255);
        SEAM(pb + 7);
    }
    if (IN(pb + 8)) {
        REP(11) {
        { IDS(); unsigned char* ws = WSP(); const bf16* wl = (const bf16*)(ws + WS_W) + (size_t)l * WE_LAYER; pg8::StaticOrder S; S.init(MP, DM, G, bid);
          pg8::Gemm g{(const bf16*)(ws + WS_YCAT), wl + WE_UPCAT, MP, DM, YK}; EpiMergeCat E{ws};
          pg8::gemm_phase<EpiMergeCat, pg8::StaticOrder, true, PROBE_SP2>(lds + RING_OFF, g, S, E, tid); }
        { IDS(); unsigned char* ws = WSP(); const bf16* wl = (const bf16*)(ws + WS_W) + (size_t)l * WE_LAYER; const bf16* yc = (const bf16*)(ws + WS_YCAT); const bf16* uc = wl + WE_UPCAT;
          for (int su = G - 1 - bid; su < DM / 64; su += G) skinny_merge_unit(lds + RING_OFF, ws, yc, uc, su, tid); }
        }
        IDS();
        SEAM(pb + 8);
    }
    if (IN(pb + 9)) {
        { IDS(); unsigned char* ws = WSP(); const bf16* wl = (const bf16*)(ws + WS_W) + (size_t)l * WE_LAYER;
          pg8::Gemm g{(const bf16*)(ws + WS_MRG), wl + WE_OUT, MP, DM, DM}; pg8::StaticOrder S; S.init(MP, DM, G, bid, RM(12));
          EpiResid E{ws, lds, 1.0f, 0, 3 * l + 2};
#if (PROBE_DUP >> 14) & 1
          { pg8::Gemm g0{(const bf16*)(ws + WS_MRG), wl + WE_OUT, MP, DM, 256}; EpiResid E0{ws, lds, 0.0f, 0, -1};
            pg8::gemm_phase<EpiResid, pg8::StaticOrder, PROBE_ALIGN_RES, PROBE_SP2>(lds + RING_OFF, g0, S, E0, tid); }
#endif
          pg8::gemm_phase<EpiResid, pg8::StaticOrder, PROBE_ALIGN_RES, PROBE_SP2>(lds + RING_OFF, g, S, E, tid); }
        { IDS(); unsigned char* ws = WSP(); const bf16* wl = (const bf16*)(ws + WS_W) + (size_t)l * WE_LAYER; EpiResid E{ws, lds, 1.0f, 0, 3 * l + 2};
          for (int su = G - 1 - bid; su < DM / 64; su += G) skinny_unit<EpiResid>(lds + RING_OFF, (const bf16*)(ws + WS_MRG), wl + WE_OUT, DM, su, E, tid); }
        IDS();
        SEAM(pb + 9);
    }
}

__global__ void __launch_bounds__(NTHR, 2) fwd_kernel(Args args) {
    extern __shared__ __attribute__((aligned(16))) unsigned char lds_raw[];
    LAS unsigned char* lds = (LAS unsigned char*)lds_raw;
    const int tid0 = threadIdx.x; const int wave0 = __builtin_amdgcn_readfirstlane(tid0 >> 6);
    const int G0 = gridDim.x, bid0 = blockIdx.x;
    { const int tid = tid0; for (int u = tid; u < (LDS_BYTES - LDSCTL_OFF) / 4; u += NTHR) ((LAS unsigned*)(lds + LDSCTL_OFF))[u] = 0u; }
    __syncthreads();
    if (tid0 == 0) {
        LAS unsigned long long* pt = (LAS unsigned long long*)(lds + PT_OFF);
#pragma unroll
        for (int i = 0; i < 31; ++i) pt[i] = (unsigned long long)args.in[i];
        pt[PT_OUT] = (unsigned long long)args.out; pt[PT_WS] = (unsigned long long)args.ws;
    }
    __syncthreads();
    if (!MK_PER_PHASE) (void)xcd_barrier_post((unsigned*)(args.ws + WS_CTL) + CW_BAR, (volatile LAS unsigned*)(lds + MISC_OFF) + 8);
    const int lo = args.ph_lo, hi = args.ph_hi;

    if (IN(0)) {
        IDS(); unsigned char* ws = WSP(); float* out = (float*)ldp(lds, PT_OUT);
        REP(0) { prologue_blocks(lds, (bf16*)(ws + WS_W), 0, DEPTH * PB_LAYER, bid, G, tid, G == 256); prologue_specials(lds, (bf16*)(ws + WS_W), G - 1 - bid, G, tid); }
#if (PROBE_DUP >> 16) & 1
        prologue_blocks<1>(lds, (bf16*)(ws + WS_W), 0, DEPTH * PB_LAYER, bid, G, tid, G == 256);
#endif
#if (PROBE_DUP >> 17) & 1
        prologue_blocks<2>(lds, (bf16*)(ws + WS_W), 0, DEPTH * PB_LAYER, bid, G, tid, G == 256);
#endif
        x_init_pass(ldp(lds, 0), ldp(lds, 1), (bf16*)(ws + WS_XN), (unsigned long long*)(ws + WS_CTL + CTL_SS), GW, NGW, lane);
        { const f32x4* src = (const f32x4*)ldp(lds, 7); f32x4* dst = (f32x4*)(out + OFF_POOL_S); const int per = 11 * 128;
          for (int i = GT; i < DEPTH * NB_S * per; i += NGT) { const int lb = i / per, j = i - lb * per; dst[(size_t)lb * 15 * 128 + j] = src[(size_t)lb * 15 * 128 + 4 * 128 + j]; } }
        SEAM(0);
    }

    { Ctx c; c.lds = lds; c.tid0 = tid0; c.wave0 = wave0; c.G0 = G0; c.bid0 = bid0; c.lo = lo; c.hi = hi;
#if MK_UNROLL_LAYERS
      ff_part(c, 0, 0); mixer_part(c, 0); ff_part(c, 0, 1); ff_part(c, 1, 0); mixer_part(c, 1); ff_part(c, 1, 1);
      ff_part(c, 2, 0); mixer_part(c, 2); ff_part(c, 2, 1); ff_part(c, 3, 0); mixer_part(c, 3); ff_part(c, 3, 1);
#else
      _Pragma("unroll 1") for (int l = 0; l < DEPTH; ++l) {
          _Pragma("unroll 1") for (int f = 0; f < 2; ++f) { ff_part(c, l, f); if (f == 0) mixer_part(c, l); }
      }
#endif
    }
#undef IN
#undef SEAM
}

extern "C" void kernel_launch(void* const* d_in, const int* in_sizes, int n_in, void* d_out, int out_size, void* d_ws, size_t ws_size, hipStream_t stream) {
    static int grid = 0;
    if (grid == 0) {
        if (n_in != 31 || out_size != OUT_TOTAL || ws_size < WS_END) { fprintf(stderr, "kernel_launch: expected 31 inputs, %d outputs, >= %zu bytes ws; got %d, %d, %zu\n", OUT_TOTAL, (size_t)WS_END, n_in, out_size, ws_size); grid = -1; return; }
        int dev = 0, cus = 0, per_cu = 0;
        if (hipGetDevice(&dev) != hipSuccess || hipDeviceGetAttribute(&cus, hipDeviceAttributeMultiprocessorCount, dev) != hipSuccess) { grid = -1; return; }
        if (hipFuncSetAttribute((const void*)fwd_kernel, hipFuncAttributeMaxDynamicSharedMemorySize, LDS_BYTES) != hipSuccess) { fprintf(stderr, "kernel_launch: hipFuncSetAttribute failed\n"); grid = -1; return; }
        if (hipOccupancyMaxActiveBlocksPerMultiprocessor(&per_cu, (const void*)fwd_kernel, NTHR, LDS_BYTES) != hipSuccess || per_cu < 1) fprintf(stderr, "kernel_launch: occupancy query says %d\n", per_cu);
        (void)hipGetLastError();
        grid = cus;
    }
    if (grid < 0) return;
    if (hipMemsetAsync((char*)d_ws + WS_CTL, 0, CTL_ZERO_BYTES, stream) != hipSuccess) return;
    Args a; memset(&a, 0, sizeof(a));
    for (int i = 0; i < 31; ++i) a.in[i] = (const float*)d_in[i];
    a.out = (float*)d_out; a.ws = (unsigned char*)d_ws;
#if MK_PER_PHASE
    for (int ph = 0; ph < NPH; ++ph) { a.ph_lo = ph; a.ph_hi = ph + 1; hipLaunchKernelGGL(fwd_kernel, dim3(grid), dim3(NTHR), LDS_BYTES, stream, a); }
#else
    a.ph_lo = 0; a.ph_hi = NPH;
    hipLaunchKernelGGL(fwd_kernel, dim3(grid), dim3(NTHR), LDS_BYTES, stream, a);
#endif
    const hipError_t le = hipPeekAtLastError();
    if (le != hipSuccess) fprintf(stderr, "kernel_launch: launch failed: %s\n", hipGetErrorName(le));
}
```

```cpp
#include <hip/hip_runtime.h>
#include <cstdio>
#include <cstdint>
#include <cstring>
#ifndef PROBE_DUP
#define PROBE_DUP 0
#endif
namespace pg8 {
#define PG8_LAS __attribute__((address_space(3)))
typedef unsigned short bf16_t;
typedef short bf16x8 __attribute__((ext_vector_type(8)));
typedef float f32x4 __attribute__((ext_vector_type(4)));
typedef unsigned u32x4 __attribute__((ext_vector_type(4)));
constexpr int BM = 256, BK = 64, HALF = 128, HTB = HALF * BK * 2  , STAGE_BYTES = 8 * HTB, NXCD = 8, WGM = 8;

__host__ __device__ __forceinline__ int lds_byte(int r, int c) { const int st = (r >> 4) * 2 + (c >> 5), rr = r & 15, cc = c & 31, ob = rr * 64 + cc * 2; return st * 1024 + (ob ^ (((ob >> 9) & 1) << 5)); }
__host__ __device__ __forceinline__ void stage_rc(int b, int& R, int& C) { const int st = b / 1024, sb = b % 1024, swz = sb ^ (((sb >> 9) & 1) << 5); R = (st >> 1) * 16 + swz / 64; C = (st & 1) * 32 + (swz % 64) / 2; }
__host__ __device__ __forceinline__ int perm32(int rho) { const int n = rho >> 4, i = rho & 15; return 8 * (i >> 2) + 4 * n + (i & 3); }

struct Unit { int pm, pn, ri; };
struct Gemm { const bf16_t* A; const bf16_t* Bt; int M, N, K; };

struct StaticOrder {
    int nM, nN, nwg, G, c, rep;
    __host__ __device__ void init(int M, int N, int G_, int c_, int rep_ = 1) { nM = M / BM; nN = N / BM; nwg = nM * nN; G = G_; c = c_; rep = rep_; }
    __host__ __device__ bool next(int i, Unit& u) const {
        const long L = (long)i * G + c; if (L >= (long)rep * nwg) return false;
        int wgid = (int)(L % nwg);
#if (PROBE_DUP >> 15) & 1
        if (L >= nwg) wgid = 0;
#endif
        { const int q = nwg / NXCD, r = nwg % NXCD, xcd = wgid % NXCD, off = wgid / NXCD; wgid = (xcd < r ? xcd * (q + 1) : r * (q + 1) + (xcd - r) * q) + off; }
        const int nig = WGM * nN, gid = wgid / nig, fm = gid * WGM, gsz = (nM - fm) < WGM ? (nM - fm) : WGM;
        u.pm = fm + ((wgid % nig) % gsz); u.pn = (wgid % nig) / gsz; u.ri = (int)(L / nwg); return true;
    }
    __device__ __forceinline__ void a_ready(const Unit&) const {}
    __device__ __forceinline__ void done(const Unit&) const {}
};

template <class Epi, class Sched, bool ALIGN_EPI = false, bool SP2 = false>
__device__ __forceinline__ void gemm_phase(PG8_LAS unsigned char* lds, const Gemm g, const Sched S, const Epi E, const int tid) {
    const int wid = __builtin_amdgcn_readfirstlane(tid >> 6), lane = tid & 63, wr = wid >> 2, wc = wid & 3, fr = lane & 15, fq = lane >> 4;
    const int K = g.K, nt = K / BK;
    unsigned voffA[2], voffB[2];
#pragma unroll
    for (int i = 0; i < 2; ++i) { int R, C; stage_rc(tid * 16 + i * 8192, R, C); const int Rb = Epi::PERM ? ((R & ~31) + perm32(R & 31)) : R;
        voffA[i] = (unsigned)(R * K + C) * 2u; voffB[i] = (unsigned)(tid * 16 + i * 8192); (void)Rb; }
    const size_t kstep = (size_t)(BK * 2);
    const size_t hstep = (size_t)HALF * K * 2;
    const size_t tstep = 2 * hstep;
    const size_t kstepB = 32768, hstepB = 16384, tstepB = (size_t)nt * 32768;
    const unsigned ldsw = (unsigned)wid * 1024u;
    const int aoff = lds_byte(wr * 64 + fr, fq * 8), boff = lds_byte(wc * 32 + fr, fq * 8);
#define PG8_SA(b, h) (((b) * 2 + (h)) * HTB)
#define PG8_SB(b, h) ((4 + (b) * 2 + (h)) * HTB)
#define PG8_STAGE(bufoff, gbase, voff) do { _Pragma("unroll") for (int _i = 0; _i < 2; ++_i) \
        __builtin_amdgcn_global_load_lds((const unsigned*)((const char*)(gbase) + (voff)[_i]), (PG8_LAS unsigned*)(lds + (bufoff) + ldsw + _i * 8192), 16, 0, 0); } while (0)
#define PG8_LDA(dst, b, h) do { _Pragma("unroll") for (int m = 0; m < 4; ++m) _Pragma("unroll") for (int k = 0; k < 2; ++k) dst[m][k] = *(const PG8_LAS bf16x8*)(lds + PG8_SA(b, h) + aoff + m * 2048 + k * 1024); } while (0)
#define PG8_LDB(dst, b, h) do { _Pragma("unroll") for (int n = 0; n < 2; ++n) _Pragma("unroll") for (int k = 0; k < 2; ++k) dst[n][k] = *(const PG8_LAS bf16x8*)(lds + PG8_SB(b, h) + boff + n * 2048 + k * 1024); } while (0)
#define PG8_MMA(ai, bj, At, Bt) do { __builtin_amdgcn_s_setprio(1); _Pragma("unroll") for (int m = 0; m < 4; ++m) _Pragma("unroll") for (int n = 0; n < 2; ++n) _Pragma("unroll") for (int k = 0; k < 2; ++k) \
        acc[ai][bj][m][n] = __builtin_amdgcn_mfma_f32_16x16x32_bf16(Bt[n][k], At[m][k], acc[ai][bj][m][n], 0, 0, 0); __builtin_amdgcn_s_setprio(0); } while (0)
#define PG8_WAIT_V(n) asm volatile("s_waitcnt vmcnt(" #n ")" ::: "memory")
#define PG8_WAIT_L(n) asm volatile("s_waitcnt lgkmcnt(" #n ")" ::: "memory")
#define PG8_BAR __builtin_amdgcn_s_barrier()
#define PG8_SCHED __builtin_amdgcn_sched_barrier(0)
    Unit cur, nxt; int ui = 0;
    if (!S.next(0, cur)) return;
    f32x4 acc[2][2][4][2];
#pragma unroll
    for (int a = 0; a < 2; ++a)
#pragma unroll
        for (int b = 0; b < 2; ++b)
#pragma unroll
            for (int m = 0; m < 4; ++m)
#pragma unroll
                for (int n = 0; n < 2; ++n) acc[a][b][m][n] = (f32x4){0.f, 0.f, 0.f, 0.f};
    bf16x8 At[4][2], B0[2][2], B1[2][2];
    const char* cA = (const char*)g.A + (size_t)cur.pm * tstep; const char* cB = (const char*)g.Bt + (size_t)cur.pn * tstepB;
    S.a_ready(cur);
    if constexpr (SP2) {
        PG8_STAGE(PG8_SB(0, 0), cB, voffB); PG8_STAGE(PG8_SB(0, 1), cB + hstepB, voffB); PG8_STAGE(PG8_SA(0, 0), cA, voffA); PG8_STAGE(PG8_SA(0, 1), cA + hstep, voffA);
        if (wr == 1) PG8_BAR;
        PG8_WAIT_V(2); PG8_BAR;
        PG8_STAGE(PG8_SB(1, 0), cB + kstepB, voffB); PG8_STAGE(PG8_SA(1, 0), cA + kstep, voffA); PG8_STAGE(PG8_SB(1, 1), cB + hstepB + kstepB, voffB);
        PG8_WAIT_V(6); PG8_BAR;
    } else {
        PG8_STAGE(PG8_SB(0, 0), cB, voffB); PG8_STAGE(PG8_SA(0, 0), cA, voffA); PG8_STAGE(PG8_SB(0, 1), cB + hstepB, voffB); PG8_STAGE(PG8_SA(0, 1), cA + hstep, voffA);
        if (wr == 1) PG8_BAR;
        PG8_WAIT_V(4); PG8_BAR;
        PG8_STAGE(PG8_SB(1, 0), cB + kstepB, voffB); PG8_STAGE(PG8_SA(1, 0), cA + kstep, voffA); PG8_STAGE(PG8_SB(1, 1), cB + hstepB + kstepB, voffB);
        PG8_WAIT_V(6); PG8_BAR;
    }
    for (;;) {
        const bool has_next = S.next(ui + 1, nxt);
        const char* nA = has_next ? (const char*)g.A + (size_t)nxt.pm * tstep : cA; const char* nB = has_next ? (const char*)g.Bt + (size_t)nxt.pn * tstepB : cB;
        for (int t = 0; t < nt; t += 2) {
            const bool last = (t == nt - 2);
            const char* a1 = cA + (size_t)(t + 1) * kstep;
            const char* a2 = last ? nA : cA + (size_t)(t + 2) * kstep; const char* b2 = last ? nB : cB + (size_t)(t + 2) * kstepB;
            const char* a3 = a2 + kstep; const char* b3 = b2 + kstepB;
            if (last && has_next) S.a_ready(nxt);
            if constexpr (Epi::HAS_MID) { if (t == 8 || t == 12 || t == 20) E.mid(acc, cur, t, wr, wc, fr, fq); }
            if constexpr (SP2) {
            PG8_LDB(B0, 0, 0); PG8_LDB(B1, 0, 1); PG8_SCHED; PG8_LDA(At, 0, 0); PG8_STAGE(PG8_SA(1, 1), a1 + hstep, voffA);
            PG8_WAIT_V(8); PG8_WAIT_L(0); PG8_BAR; PG8_MMA(0, 0, At, B0); PG8_MMA(0, 1, At, B1); PG8_BAR; PG8_SCHED;
            PG8_LDA(At, 0, 1); PG8_STAGE(PG8_SB(0, 0), b2, voffB); PG8_STAGE(PG8_SB(0, 1), b2 + hstepB, voffB); PG8_STAGE(PG8_SA(0, 0), a2, voffA);
            PG8_WAIT_V(8); PG8_WAIT_L(0); PG8_BAR; PG8_MMA(1, 0, At, B0); PG8_MMA(1, 1, At, B1); PG8_BAR; PG8_SCHED;
            PG8_LDB(B0, 1, 0); PG8_LDB(B1, 1, 1); PG8_SCHED; PG8_LDA(At, 1, 0); PG8_STAGE(PG8_SA(0, 1), a2 + hstep, voffA);
            PG8_WAIT_V(8); PG8_WAIT_L(0); PG8_BAR; PG8_MMA(0, 0, At, B0); PG8_MMA(0, 1, At, B1); PG8_BAR; PG8_SCHED;
            PG8_LDA(At, 1, 1); PG8_STAGE(PG8_SB(1, 0), b3, voffB); PG8_STAGE(PG8_SB(1, 1), b3 + hstepB, voffB); PG8_STAGE(PG8_SA(1, 0), a3, voffA);
            PG8_WAIT_V(8); PG8_WAIT_L(0); PG8_BAR; PG8_MMA(1, 0, At, B0); PG8_MMA(1, 1, At, B1); PG8_BAR; PG8_SCHED;
            } else {
            PG8_LDB(B0, 0, 0); PG8_SCHED; PG8_LDA(At, 0, 0); PG8_STAGE(PG8_SA(1, 1), a1 + hstep, voffA);
            PG8_WAIT_L(8); PG8_BAR; PG8_WAIT_L(0); PG8_MMA(0, 0, At, B0); PG8_BAR; PG8_SCHED;
            PG8_LDB(B1, 0, 1); PG8_STAGE(PG8_SB(0, 0), b2, voffB);
            PG8_BAR; PG8_WAIT_L(0); PG8_MMA(0, 1, At, B1); PG8_BAR;
            PG8_LDA(At, 0, 1); PG8_STAGE(PG8_SA(0, 0), a2, voffA);
            PG8_BAR; PG8_WAIT_L(0); PG8_MMA(1, 0, At, B0); PG8_BAR; PG8_SCHED;
            PG8_STAGE(PG8_SB(0, 1), b2 + hstepB, voffB);
            PG8_WAIT_V(6); PG8_BAR; PG8_MMA(1, 1, At, B1); PG8_BAR;
            PG8_LDB(B0, 1, 0); PG8_SCHED; PG8_LDA(At, 1, 0); PG8_STAGE(PG8_SA(0, 1), a2 + hstep, voffA);
            PG8_WAIT_L(8); PG8_BAR; PG8_WAIT_L(0); PG8_MMA(0, 0, At, B0); PG8_BAR; PG8_SCHED;
            PG8_LDB(B1, 1, 1); PG8_STAGE(PG8_SB(1, 0), b3, voffB);
            PG8_BAR; PG8_WAIT_L(0); PG8_MMA(0, 1, At, B1); PG8_BAR;
            PG8_LDA(At, 1, 1); PG8_STAGE(PG8_SA(1, 0), a3, voffA);
            PG8_BAR; PG8_WAIT_L(0); PG8_MMA(1, 0, At, B0); PG8_BAR; PG8_SCHED;
            PG8_STAGE(PG8_SB(1, 1), b3 + hstepB, voffB);
            PG8_WAIT_V(6); PG8_BAR; PG8_MMA(1, 1, At, B1); PG8_BAR;
            }
        }
        if constexpr (ALIGN_EPI) { if (wr == 0) PG8_BAR; }
        if constexpr (!Epi::AFTER_DRAIN) { E(acc, cur, wr, wc, fr, fq); S.done(cur); }
        if (!has_next) break;
#pragma unroll
        for (int a = 0; a < 2; ++a)
#pragma unroll
            for (int b = 0; b < 2; ++b)
#pragma unroll
                for (int m = 0; m < 4; ++m)
#pragma unroll
                    for (int n = 0; n < 2; ++n) acc[a][b][m][n] = (f32x4){0.f, 0.f, 0.f, 0.f};
        cur = nxt; cA = nA; cB = nB; ++ui;
        if constexpr (ALIGN_EPI) { if (wr == 1) PG8_BAR; }
    }
    PG8_WAIT_V(0);
    if constexpr (!ALIGN_EPI) { if (wr == 0) PG8_BAR; }
    PG8_BAR;
    if constexpr (Epi::AFTER_DRAIN) { E.fused(acc, cur, wr, wc, fr, fq, lds, wid, lane); S.done(cur); }
#undef PG8_SA
#undef PG8_SB
#undef PG8_STAGE
#undef PG8_LDA
#undef PG8_LDB
#undef PG8_MMA
#undef PG8_WAIT_V
#undef PG8_WAIT_L
#undef PG8_BAR
#undef PG8_SCHED
}
}

constexpr int DM = 2048, DFF = 5504, DEPTH = 4;
constexpr int SEQ = 4096, NB_P = 2, MP = NB_P * SEQ;
constexpr int NB_S = 8, TS = 4, MS = NB_S * TS;
constexpr int MR = MP + MS;
constexpr int MPAD = 8448;
constexpr int PAST = 16384;
constexpr int N_IN = 14096, NWIN = 14336;
constexpr int NGU = 2 * DFF;
constexpr float EPS = 1e-6f;
constexpr int NWAVES = 8, NTHR = 512;

constexpr int C_CB = 0, C_CC = 512, C_CH = 1024, C_AQ = 1536, C_AK = 2304, C_AV = 3072, C_GQ = 3840, C_GK = 4096, C_GV = 4352, C_GR = 4864, C_LR = 5376, C_PIN = 5392, C_GATE = 5904;
constexpr int T_CONV = 0, T_CB = 4, T_Q = 6, T_K = 9, T_V = 12, T_GQ = 15, T_GK = 16, T_GV = 17, T_GR = 19, T_Z = 21, T_PIN = 22, T_GATE = 24;

constexpr int OFF_YP = 0;
constexpr int OFF_YS = OFF_YP + MP * DM;
constexpr int OFF_CONV_P = OFF_YS + MS * DM;
constexpr int OFF_CONV_S = OFF_CONV_P + DEPTH * NB_P * 2 * 512;
constexpr int OFF_W128_P = OFF_CONV_S + DEPTH * NB_S * 2 * 512;
constexpr int OFF_W128_S = OFF_W128_P + DEPTH * NB_P * 128 * 512;
constexpr int OFF_W512_P = OFF_W128_S + DEPTH * NB_S * 128 * 512;
constexpr int OFF_W512_S = OFF_W512_P + DEPTH * NB_P * 512 * 512;
constexpr int OFF_W2048_P = OFF_W512_S + DEPTH * NB_S * 512 * 512;
constexpr int OFF_W2048_S = OFF_W2048_P + DEPTH * NB_P * 2048 * 512;
constexpr int OFF_GLA_P = OFF_W2048_S + DEPTH * NB_S * 2048 * 512;
constexpr int OFF_GLA_S = OFF_GLA_P + DEPTH * NB_P * 4 * 64 * 128;
constexpr int OFF_POOL_P = OFF_GLA_S + DEPTH * NB_S * 4 * 64 * 128;
constexpr int OFF_POOL_S = OFF_POOL_P + DEPTH * NB_P * 15 * 512;
constexpr int OUT_TOTAL = OFF_POOL_S + DEPTH * NB_S * 15 * 512;
static_assert(OUT_TOTAL == 73551872, "output size");

constexpr size_t MiB = 1u << 20;
constexpr size_t WS_CTL = 0, CTL_ZERO_BYTES = 1 * MiB;
constexpr size_t SZ_ROW2K_F32 = (size_t)MPAD * DM * 4, SZ_ROW2K_BF = (size_t)MPAD * DM * 2;
constexpr size_t WS_X = WS_CTL + CTL_ZERO_BYTES;
constexpr size_t WS_XN = WS_X + SZ_ROW2K_F32;
constexpr size_t WS_H = WS_XN + SZ_ROW2K_BF;
constexpr size_t WS_CB = WS_H + (size_t)MPAD * DFF * 2;
constexpr size_t WS_U = WS_CB + (size_t)MPAD * 512 * 2;
constexpr size_t WS_Q = WS_U + (size_t)MPAD * 512 * 2;
constexpr size_t WS_K = WS_Q + (size_t)MPAD * 768 * 2;
constexpr size_t WS_V = WS_K + (size_t)MPAD * 768 * 2;
constexpr size_t WS_GQ = WS_V + (size_t)MPAD * 768 * 2;
constexpr size_t WS_GK = WS_GQ + (size_t)MPAD * 256 * 2;
constexpr size_t WS_GV = WS_GK + (size_t)MPAD * 256 * 2;
constexpr size_t WS_GR = WS_GV + (size_t)MPAD * 512 * 2;
constexpr size_t WS_LA = WS_GR + (size_t)MPAD * 512 * 2;
constexpr size_t WS_PIN = WS_LA + (size_t)MPAD * 256 * 4;
constexpr size_t WS_GATE = WS_PIN + (size_t)MPAD * 512 * 2;
constexpr int YK = 1792, YO_A = 0, YO_B = 512, YO_C = 768, YO_D = 1280;
constexpr size_t WS_YCAT = WS_GATE + (size_t)MPAD * 8192 * 2;
constexpr size_t WS_AO = WS_YCAT + (size_t)MPAD * YK * 2;
constexpr size_t WS_LSE = WS_AO + (size_t)MPAD * 768 * 4;
constexpr size_t WS_DS = WS_LSE + (size_t)MPAD * 12 * 4;
constexpr size_t WS_DEC = WS_DS + (size_t)8 * 64 * 64 * 128 * 4;
constexpr size_t WS_SP = WS_DEC + (size_t)8 * 64 * 64 * 4;
constexpr size_t WS_PM = WS_SP + (size_t)8 * 64 * 64 * 128 * 2;
constexpr size_t WS_MRG = WS_PM + (size_t)(MPAD - MP) * DM * 4;
constexpr size_t WS_W = WS_MRG + SZ_ROW2K_BF;
constexpr size_t WE_GU1 = 0;
constexpr size_t WE_D1 = WE_GU1 + (size_t)NGU * DM;
constexpr size_t WE_IN = WE_D1 + (size_t)DM * DFF;
constexpr size_t WE_UPCAT = WE_IN + (size_t)NWIN * DM;
constexpr size_t WE_OUT = WE_UPCAT + (size_t)DM * YK;
constexpr size_t WE_GU2 = WE_OUT + (size_t)DM * DM;
constexpr size_t WE_D2 = WE_GU2 + (size_t)NGU * DM;
constexpr size_t WE_LAYER = WE_D2 + (size_t)DM * DFF;
static_assert(WE_LAYER == 104857600, "layer weights");
constexpr size_t WS_END = WS_W + (size_t)DEPTH * WE_LAYER * 2;
static_assert(WS_X % 256 == 0 && WS_W % 256 == 0 && WS_LSE % 256 == 0 && WS_DS % 256 == 0, "alignment");

constexpr int CW_BAR = 4096;
constexpr size_t CTL_SS = 65536;
constexpr float SS_FIX = 16777216.0f;
static_assert(CTL_SS + 12 * (size_t)MPAD * 8 <= CTL_ZERO_BYTES, "SS fits the zeroed control region");

constexpr int RING_OFF = 0, RING_BYTES = 131072;
constexpr int LDSCTL_OFF = RING_BYTES, MISC_OFF = LDSCTL_OFF + 320;
constexpr int LDS_BYTES = 147456;

#define GAS __attribute__((address_space(1)))
#define LAS __attribute__((address_space(3)))
#define GAS __attribute__((address_space(1)))
typedef unsigned short bf16;
typedef unsigned u32x4 __attribute__((ext_vector_type(4)));
typedef unsigned u32x2 __attribute__((ext_vector_type(2)));
typedef float f32x4 __attribute__((ext_vector_type(4)));
typedef float f32x2 __attribute__((ext_vector_type(2)));
typedef short bf16x8 __attribute__((ext_vector_type(8)));
typedef short s16x4 __attribute__((ext_vector_type(4)));
#define LDS_WAIT() asm volatile("s_waitcnt lgkmcnt(0)" ::: "memory")
#define VM_WAIT() asm volatile("s_waitcnt vmcnt(0)" ::: "memory")
__device__ __forceinline__ unsigned f2bf(float f) { unsigned u = __builtin_bit_cast(unsigned, f); return (u + 0x7fffu + ((u >> 16) & 1u)) >> 16; }
__device__ __forceinline__ unsigned pk2(float lo, float hi) { return f2bf(lo) | (f2bf(hi) << 16); }
__device__ __forceinline__ float bflo(unsigned w) { return __builtin_bit_cast(float, w << 16); }
__device__ __forceinline__ float bfhi(unsigned w) { return __builtin_bit_cast(float, w & 0xffff0000u); }
__device__ __forceinline__ float bf2f(bf16 b) { return __builtin_bit_cast(float, ((unsigned)b) << 16); }
__device__ __forceinline__ u32x4 pk8(f32x4 a, f32x4 b) { u32x4 w; w.x = pk2(a[0], a[1]); w.y = pk2(a[2], a[3]); w.z = pk2(b[0], b[1]); w.w = pk2(b[2], b[3]); return w; }
__device__ __forceinline__ void unpk8(u32x4 w, float (&f)[8]) { f[0] = bflo(w.x); f[1] = bfhi(w.x); f[2] = bflo(w.y); f[3] = bfhi(w.y); f[4] = bflo(w.z); f[5] = bfhi(w.z); f[6] = bflo(w.w); f[7] = bfhi(w.w); }
__device__ __forceinline__ float sigmoidf_(float x) { return __builtin_amdgcn_rcpf(1.0f + __expf(-x)); }
__device__ __forceinline__ float siluf_(float x) { return x * sigmoidf_(x); }
__device__ __forceinline__ float shx(float v, int m, int lane) { return __builtin_bit_cast(float, __builtin_amdgcn_ds_bpermute((lane ^ m) << 2, __builtin_bit_cast(int, v))); }
__device__ __forceinline__ float rdl(float v, int j) { return __builtin_bit_cast(float, __builtin_amdgcn_readlane(__builtin_bit_cast(int, v), j)); }
__device__ __forceinline__ float wave_sum(float v, int lane) {
#pragma unroll
    for (int o = 1; o < 64; o <<= 1) v += shx(v, o, lane);
    return v;
}
__device__ __forceinline__ float wave_max(float v, int lane) {
#pragma unroll
    for (int o = 1; o < 64; o <<= 1) v = fmaxf(v, shx(v, o, lane));
    return v;
}
__device__ __forceinline__ int win_of(int gi) { return 128 << (2 * gi); }
__device__ __forceinline__ int dil_of(int gi) { return 1 << (2 * gi); }
__device__ __forceinline__ int offw_p(int gi) { return gi == 0 ? OFF_W128_P : (gi == 1 ? OFF_W512_P : OFF_W2048_P); }
__device__ __forceinline__ int offw_s(int gi) { return gi == 0 ? OFF_W128_S : (gi == 1 ? OFF_W512_S : OFF_W2048_S); }

#define XB_TMO      128
#define XB_XCNT(j)  (256  + 64 * (j))
#define XB_XSUB(j)  (1280 + 64 * (j))
#define XB_XGEN(j)  (2304 + 64 * (j))
#define XB_TOP      3328
#define XB_TOPGEN   3392
#define XCD_BAR_WORDS 3456
#define XB_SPIN_CAP (1u << 18)

__device__ __forceinline__ unsigned xb_ld(unsigned* p)              { return __hip_atomic_load(p, __ATOMIC_RELAXED, __HIP_MEMORY_SCOPE_AGENT); }
__device__ __forceinline__ unsigned xb_add(unsigned* p, unsigned v) { return __hip_atomic_fetch_add(p, v, __ATOMIC_RELAXED, __HIP_MEMORY_SCOPE_AGENT); }
__device__ __forceinline__ unsigned xb_xcc_id() { return (unsigned)__builtin_amdgcn_s_getreg((3 << 11) | 20) & 0xFu; }
#define XB_SPIN(cond, bar) do { unsigned _sp = 0; while (cond) { __builtin_amdgcn_s_sleep(1); \
    if ((++_sp & 255u) == 0u) { if (xb_ld(&(bar)[XB_TMO])) break; if (_sp > XB_SPIN_CAP) { atomicAdd(&(bar)[XB_TMO], 1u); break; } } } } while (0)

struct XcdBarrier {
    unsigned* bar; unsigned x;
    volatile LAS unsigned* st;
};
__device__ __forceinline__ XcdBarrier xcd_barrier_post(unsigned* bar, volatile LAS unsigned* st) {
    XcdBarrier b; b.bar = bar; b.x = xb_xcc_id(); b.st = st;
    if (threadIdx.x == 0) (void)xb_add(&bar[XB_XCNT(b.x)], 1u);
    return b;
}
__device__ __forceinline__ void xcd_barrier_complete(unsigned* bar, unsigned x, unsigned& nloc, unsigned& nx) {
    const unsigned G = gridDim.x * gridDim.y * gridDim.z;
    unsigned sum, cnt, mine, sp = 0u;
    for (;;) {
        sum = 0u; cnt = 0u; mine = 0u;
#pragma unroll
        for (unsigned j = 0; j < 16; ++j) { const unsigned c = xb_ld(&bar[XB_XCNT(j)]); sum += c; cnt += (c > 0u) ? 1u : 0u; mine = (j == x) ? c : mine; }
        if (sum == G) break;
        __builtin_amdgcn_s_sleep(1);
        if ((++sp & 255u) == 0u) { if (xb_ld(&bar[XB_TMO])) break; if (sp > XB_SPIN_CAP) { atomicAdd(&bar[XB_TMO], 1u); break; } }
    }
    nloc = mine > 0u ? mine : 1u; nx = cnt > 0u ? cnt : 1u;
}
__device__ __forceinline__ void xcd_barrier(const XcdBarrier& b, const int tid) {
    asm volatile("s_waitcnt vmcnt(0)" ::: "memory");
    __syncthreads();
    if (tid == 0) {
        unsigned* bar = b.bar;
        __builtin_amdgcn_s_waitcnt(0);
        unsigned nloc = b.st[0], nx = b.st[1];
        if (nloc == 0u) { xcd_barrier_complete(bar, b.x, nloc, nx); b.st[0] = nloc; b.st[1] = nx; }
        const unsigned old = xb_add(&bar[XB_XSUB(b.x)], 1u);
        const unsigned gen = old / nloc;
        if (old + 1u == (gen + 1u) * nloc) {
            __builtin_amdgcn_fence(__ATOMIC_RELEASE, "agent");
            asm volatile("s_waitcnt vmcnt(0)" ::: "memory");
            const unsigned og = xb_add(&bar[XB_TOP], 1u);
            const unsigned tg = og / nx;
            if (og + 1u == (tg + 1u) * nx) xb_add(&bar[XB_TOPGEN], 1u);
            else XB_SPIN(xb_ld(&bar[XB_TOPGEN]) == tg, bar);
            __builtin_amdgcn_fence(__ATOMIC_ACQUIRE, "agent");
            xb_add(&bar[XB_XGEN(b.x)], 1u);
            asm volatile("s_waitcnt vmcnt(0)" ::: "memory");
        } else {
            XB_SPIN(xb_ld(&bar[XB_XGEN(b.x)]) == gen, bar);
            __builtin_amdgcn_fence(__ATOMIC_ACQUIRE, "agent");
            asm volatile("s_waitcnt vmcnt(0)" ::: "memory");
        }
    }
    __syncthreads();
}

constexpr int PT_OFF = LDSCTL_OFF;
constexpr int PT_OUT = 31, PT_WS = 32;
__device__ __forceinline__ const float* ldp(LAS unsigned char* lds, int i) {
    const unsigned long long v = *(volatile LAS unsigned long long*)(lds + PT_OFF + 8 * i);
    const unsigned lo = __builtin_amdgcn_readfirstlane((unsigned)v), hi = __builtin_amdgcn_readfirstlane((unsigned)(v >> 32));
    return (const float*)(const GAS float*)(((unsigned long long)hi << 32) | lo);
}

typedef f32x4 (&AccRef)[2][2][4][2];

__device__ __forceinline__ void row_decode(int row, int& kind, int& b, int& t) {
    if (row < MP) { kind = 0; b = row >> 12; t = row & 4095; }
    else if (row < MR) { kind = 1; b = (row - MP) >> 2; t = (row - MP) & 3; }
    else { kind = 2; b = 0; t = 0; }
}


#ifndef EPI_NT
#define EPI_NT 0
#endif
#if EPI_NT
#define EPI_ST(ptr, val) __builtin_nontemporal_store((val), (ptr))
#else
#define EPI_ST(ptr, val) (*(ptr) = (val))
#endif
typedef _Float16 h16x4 __attribute__((ext_vector_type(4)));
typedef _Float16 h16x8 __attribute__((ext_vector_type(8)));
constexpr size_t RAT_STRIDE = (size_t)MPAD * DM;

template <bool SK> __device__ __forceinline__ void scale_rows_rstd(AccRef acc, const unsigned long long* ss, int row0) {
#pragma unroll
    for (int ai = 0; ai < (SK ? 1 : 2); ++ai)
#pragma unroll
        for (int m = 0; m < (SK ? 2 : 4); ++m) {
            const float r = rsqrtf((float)ss[row0 + ai * 128 + m * 16] * (1.0f / (SS_FIX * DM)) + EPS);
#pragma unroll
            for (int bj = 0; bj < 2; ++bj)
#pragma unroll
                for (int n = 0; n < 2; ++n) acc[ai][bj][m][n] *= r;
        }
}

struct EpiSwiGLU {
    static constexpr bool PERM = false, AFTER_DRAIN = false, HAS_MID = false;
    unsigned char* ws; int nid;
    __device__ __forceinline__ void operator()(AccRef acc, const pg8::Unit& u, int wr, int wc, int fr, int fq) const { run<false>(acc, u, wr, wc, fr, fq); }
    template <bool SK> __device__ __forceinline__ void run(AccRef acc, const pg8::Unit& u, int wr, int wc, int fr_, int fq_) const {
        int fr = fr_, fq = fq_; asm volatile("" : "+v"(fr), "+v"(fq));
        bf16* H = (bf16*)(ws + WS_H);
        const int row0 = u.pm * 256 + wr * 64 + fr, col0 = u.pn * 128 + wc * 32 + 8 * fq;
        scale_rows_rstd<SK>(acc, (const unsigned long long*)(ws + WS_CTL + CTL_SS) + (size_t)nid * MPAD, row0);
#pragma unroll
        for (int ai = 0; ai < (SK ? 1 : 2); ++ai)
#pragma unroll
            for (int m = 0; m < (SK ? 2 : 4); ++m) {
                bf16* p = H + (size_t)(row0 + ai * 128 + m * 16) * DFF + col0;
                f32x4 h0, h1;
#pragma unroll
                for (int j = 0; j < 4; ++j) { h0[j] = siluf_(acc[ai][0][m][0][j]) * acc[ai][1][m][0][j]; h1[j] = siluf_(acc[ai][0][m][1][j]) * acc[ai][1][m][1][j]; }
                EPI_ST((u32x4*)p, pk8(h0, h1));
            }
    }
};

struct EpiResid {
    static constexpr bool PERM = false, AFTER_DRAIN = false, HAS_MID = false;
    unsigned char* ws; LAS unsigned char* lds; float scale; int fin; int nid;
    __device__ __forceinline__ void operator()(AccRef acc, const pg8::Unit& u, int wr, int wc, int fr, int fq) const { run<false>(acc, u, wr, wc, fr, fq); }
    template <bool SK> __device__ __forceinline__ void run(AccRef acc, const pg8::Unit& u, int wr, int wc, int fr_, int fq_) const {
        int fr = fr_, fq = fq_; asm volatile("" : "+v"(fr), "+v"(fq));
        bf16* XB = (bf16*)(ws + WS_XN);
        unsigned long long* ssp = (unsigned long long*)(ws + WS_CTL + CTL_SS) + (size_t)(nid < 0 ? 0 : nid) * MPAD;
        float* out = fin ? (float*)ldp(lds, PT_OUT) : nullptr;
        const float scale = (u.ri == 0) ? this->scale : 0.f; const int nid = (u.ri == 0) ? this->nid : -1;
        const int row0 = u.pm * 256 + wr * 64 + fr, col0 = u.pn * 256 + wc * 32 + 8 * fq;
#pragma unroll
        for (int ai = 0; ai < (SK ? 1 : 2); ++ai)
#pragma unroll
            for (int m = 0; m < (SK ? 2 : 4); ++m) {
                const int row = row0 + ai * 128 + m * 16;
                bf16* xr = XB + (size_t)row * DM + col0;
                float sq = 0.f;
#pragma unroll
                for (int bj = 0; bj < 2; ++bj) {
                    float xo[8]; unpk8(*(const u32x4*)(xr + bj * 128), xo);
                    f32x4 v0, v1;
#pragma unroll
                    for (int j = 0; j < 4; ++j) { v0[j] = xo[j] + scale * acc[ai][bj][m][0][j]; v1[j] = xo[4 + j] + scale * acc[ai][bj][m][1][j]; }
                    if (out != nullptr && row < MR) { float* o = out + (size_t)row * DM + col0 + bj * 128; *(f32x4*)o = v0; *(f32x4*)(o + 4) = v1; }
                    const u32x4 w = pk8(v0, v1);
                    EPI_ST((u32x4*)(xr + bj * 128), w);
                    float xn[8]; unpk8(w, xn);
#pragma unroll
                    for (int j = 0; j < 8; ++j) sq += xn[j] * xn[j];
                }
                { const int ln = fq * 16 + fr; sq += shx(sq, 16, ln); sq += shx(sq, 32, ln); }
                if (nid >= 0 && fq == 0) atomicAdd(ssp + row, (unsigned long long)(sq * SS_FIX + 0.5f));
            }
    }
};

struct EpiMergeCat {
    static constexpr bool PERM = false, AFTER_DRAIN = false, HAS_MID = true;
    unsigned char* ws;
    __device__ __forceinline__ void apply(f32x4 (&acc)[2][2][4][2], const pg8::Unit& u, int s, int wr, int wc, int fr_, int fq_) const {
        int fr = fr_, fq = fq_; asm volatile("" : "+v"(fr), "+v"(fq));
        const _Float16* R = (const _Float16*)(ws + WS_GATE) + (size_t)s * RAT_STRIDE;
        const int row0 = u.pm * 256 + wr * 64 + fr, col0 = u.pn * 256 + wc * 32 + 8 * fq;
        h16x8 r[2][4][2];
#pragma unroll
        for (int ai = 0; ai < 2; ++ai)
#pragma unroll
            for (int m = 0; m < 4; ++m)
#pragma unroll
                for (int bj = 0; bj < 2; ++bj) r[ai][m][bj] = *(const h16x8*)(R + (size_t)(row0 + ai * 128 + m * 16) * DM + col0 + bj * 128);
#pragma unroll
        for (int ai = 0; ai < 2; ++ai)
#pragma unroll
            for (int m = 0; m < 4; ++m)
#pragma unroll
                for (int bj = 0; bj < 2; ++bj)
#pragma unroll
                    for (int j = 0; j < 4; ++j) { acc[ai][bj][m][0][j] *= (float)r[ai][m][bj][j]; acc[ai][bj][m][1][j] *= (float)r[ai][m][bj][4 + j]; }
    }
    __device__ __forceinline__ void mid(f32x4 (&acc)[2][2][4][2], const pg8::Unit& u, int t, int wr, int wc, int fr, int fq) const {
        apply(acc, u, (t == 8) ? 0 : (t == 12 ? 1 : 2), wr, wc, fr, fq);
    }
    __device__ __forceinline__ void operator()(AccRef acc, const pg8::Unit& u, int wr, int wc, int fr_, int fq_) const {
        apply(acc, u, 3, wr, wc, fr_, fq_);
        int fr = fr_, fq = fq_; asm volatile("" : "+v"(fr), "+v"(fq));
        bf16* MRG = (bf16*)(ws + WS_MRG);
        const int row0 = u.pm * 256 + wr * 64 + fr, col0 = u.pn * 256 + wc * 32 + 8 * fq;
#pragma unroll
        for (int ai = 0; ai < 2; ++ai)
#pragma unroll
            for (int m = 0; m < 4; ++m)
#pragma unroll
                for (int bj = 0; bj < 2; ++bj) EPI_ST((u32x4*)(MRG + (size_t)(row0 + ai * 128 + m * 16) * DM + col0 + bj * 128), pk8(acc[ai][bj][m][0], acc[ai][bj][m][1]));
    }
};
template <int MODE>
struct EpiMergeS {
    static constexpr bool PERM = false, AFTER_DRAIN = false, HAS_MID = false;
    unsigned char* ws; int br;
    template <bool SK> __device__ __forceinline__ void run(AccRef acc, const pg8::Unit& u, int wr, int wc, int fr, int fq) const {
        float* P = (float*)(ws + WS_PM); bf16* MRG = (bf16*)(ws + WS_MRG);
        const int row0 = u.pm * 256 + wr * 64 + fr, col0 = u.pn * 256 + wc * 32 + 8 * fq;
#pragma unroll
        for (int m = 0; m < 2; ++m) {
            const int row = row0 + m * 16;
#pragma unroll
            for (int bj = 0; bj < 2; ++bj) {
                const int c = col0 + bj * 128;
                float g[8];
                { const _Float16* R = (const _Float16*)(ws + WS_GATE) + (size_t)row * DM + c;
                  const h16x8 r3 = *(const h16x8*)(R + 3 * RAT_STRIDE);
#pragma unroll
                  for (int j = 0; j < 8; ++j) g[j] = (float)r3[j];
#pragma unroll
                  for (int s = 2; s >= 0; --s) if (s >= br) { const h16x8 rs = *(const h16x8*)(R + (size_t)s * RAT_STRIDE);
#pragma unroll
                      for (int j = 0; j < 8; ++j) g[j] *= (float)rs[j]; } }
                f32x4 v0, v1;
#pragma unroll
                for (int j = 0; j < 4; ++j) { v0[j] = g[j] * acc[0][bj][m][0][j]; v1[j] = g[4 + j] * acc[0][bj][m][1][j]; }
                float* pp = P + (size_t)(row - MP) * DM + c;
                if (MODE != 0) { v0 += *(const f32x4*)pp; v1 += *(const f32x4*)(pp + 4); }
                if (MODE == 2) *(u32x4*)(MRG + (size_t)row * DM + c) = pk8(v0, v1);
                else { *(f32x4*)pp = v0; *(f32x4*)(pp + 4) = v1; }
            }
        }
    }
};

struct EpiWin {
    static constexpr bool PERM = false, AFTER_DRAIN = false, HAS_MID = false;
    unsigned char* ws;
    const float *qgain, *kgain, *b_a;
    float* out; int layer; int nid;

    template <int ACT, bool SK>
    __device__ __forceinline__ void plain(AccRef acc, bf16* dst, int ldc, int cbase, int row0, int wc, int fq) const {
#pragma unroll
        for (int ai = 0; ai < (SK ? 1 : 2); ++ai)
#pragma unroll
            for (int m = 0; m < (SK ? 2 : 4); ++m) {
                bf16* p = dst + (size_t)(row0 + ai * 128 + m * 16) * ldc + cbase + wc * 32 + fq * 8;
#pragma unroll
                for (int bj = 0; bj < 2; ++bj) {
                    f32x4 v0 = acc[ai][bj][m][0], v1 = acc[ai][bj][m][1];
#pragma unroll
                    for (int j = 0; j < 4; ++j) {
                        if (ACT == 1) { v0[j] = sigmoidf_(v0[j]); v1[j] = sigmoidf_(v1[j]); }
                        if (ACT == 2) { v0[j] = siluf_(v0[j]); v1[j] = siluf_(v1[j]); }
                        if (ACT == 3) { v0[j] *= 0.125f; v1[j] *= 0.125f; }
                    }
                    EPI_ST((u32x4*)(p + bj * 128), pk8(v0, v1));
                }
            }
    }

    __device__ __forceinline__ void operator()(AccRef acc, const pg8::Unit& u, int wr, int wc, int fr, int fq) const { run<false>(acc, u, wr, wc, fr, fq); }
    template <bool SK> __device__ __forceinline__ void run(AccRef acc, const pg8::Unit& u, int wr, int wc, int fr_, int fq_) const {
        int fr = fr_, fq = fq_; asm volatile("" : "+v"(fr), "+v"(fq));
        const int pn = u.pn, row0 = u.pm * 256 + wr * 64 + fr, l = layer;
        scale_rows_rstd<SK>(acc, (const unsigned long long*)(ws + WS_CTL + CTL_SS) + (size_t)nid * MPAD, row0);
        if (pn < T_CB) {
            const int ch0 = 128 * pn + 32 * wc + 8 * fq;
#pragma unroll
            for (int ai = 0; ai < (SK ? 1 : 2); ++ai)
#pragma unroll
                for (int m = 0; m < (SK ? 2 : 4); ++m) {
                    const int row = row0 + ai * 128 + m * 16;
                    const f32x4 u0 = acc[ai][0][m][0] * acc[ai][1][m][0], u1 = acc[ai][0][m][1] * acc[ai][1][m][1];
                    *(u32x4*)((bf16*)(ws + WS_U) + (size_t)row * 512 + ch0) = pk8(u0, u1);
                    int kind, b, t; row_decode(row, kind, b, t);
                    if (kind == 0 && t >= SEQ - 2) { float* o = out + OFF_CONV_P + ((l * NB_P + b) * 2 + (t - (SEQ - 2))) * 512 + ch0; *(f32x4*)o = u0; *(f32x4*)(o + 4) = u1; }
                    if (kind == 1 && t >= TS - 2)  { float* o = out + OFF_CONV_S + ((l * NB_S + b) * 2 + (t - (TS - 2))) * 512 + ch0; *(f32x4*)o = u0; *(f32x4*)(o + 4) = u1; }
                }
        } else if (pn < T_Q) {
            plain<0, SK>(acc, (bf16*)(ws + WS_CB), 512, 256 * (pn - T_CB), row0, wc, fq);
        } else if (pn < T_V) {
            const bool isk = pn >= T_K; const int ti = isk ? pn - T_K : pn - T_Q; const int head = 4 * ti + wc;
            const float* gp = (isk ? kgain : qgain) + head * 64 + 8 * fq;
            f32x4 g[2][2];
#pragma unroll
            for (int bj = 0; bj < 2; ++bj) { g[bj][0] = *(const f32x4*)(gp + 32 * bj); g[bj][1] = *(const f32x4*)(gp + 32 * bj + 4); }
            bf16* dst = (bf16*)(ws + (isk ? WS_K : WS_Q));
            const int W = win_of(ti);
#pragma unroll
            for (int ai = 0; ai < (SK ? 1 : 2); ++ai)
#pragma unroll
                for (int m = 0; m < (SK ? 2 : 4); ++m) {
                    const int row = row0 + ai * 128 + m * 16;
                    float ss = 0.f;
#pragma unroll
                    for (int bj = 0; bj < 2; ++bj)
#pragma unroll
                        for (int n = 0; n < 2; ++n) { const f32x4 x = acc[ai][bj][m][n]; ss += (x[0] * x[0] + x[1] * x[1]) + (x[2] * x[2] + x[3] * x[3]); }
                    { const int ln = fq * 16 + fr; ss += shx(ss, 16, ln); ss += shx(ss, 32, ln); }
                    const float rs = rsqrtf(ss * (1.0f / 64.0f) + EPS);
                    int kind, b, t; row_decode(row, kind, b, t);
#pragma unroll
                    for (int bj = 0; bj < 2; ++bj) {
                        const f32x4 y0 = acc[ai][bj][m][0] * rs * g[bj][0], y1 = acc[ai][bj][m][1] * rs * g[bj][1];
                        *(u32x4*)(dst + (size_t)row * 768 + head * 64 + 32 * bj + 8 * fq) = pk8(y0, y1);
                        if (isk) {
                            const int e0 = 32 * bj + 8 * fq;
                            if (kind == 0 && t >= SEQ - W) { float* o = out + offw_p(ti) + ((((l * NB_P + b) * W + (t - (SEQ - W))) * 2 + 0) * 4 + wc) * 64 + e0; *(f32x4*)o = y0; *(f32x4*)(o + 4) = y1; }
                            if (kind == 1)                 { float* o = out + offw_s(ti) + ((((l * NB_S + b) * W + (W - TS + t)) * 2 + 0) * 4 + wc) * 64 + e0; *(f32x4*)o = y0; *(f32x4*)(o + 4) = y1; }
                        }
                    }
                }
        } else if (pn < T_GQ) {
            const int ti = pn - T_V;
            plain<0, SK>(acc, (bf16*)(ws + WS_V), 768, 256 * ti, row0, wc, fq);
            const int W = win_of(ti);
#pragma unroll
            for (int ai = 0; ai < (SK ? 1 : 2); ++ai)
#pragma unroll
                for (int m = 0; m < (SK ? 2 : 4); ++m) {
                    const int row = row0 + ai * 128 + m * 16;
                    int kind, b, t; row_decode(row, kind, b, t);
#pragma unroll
                    for (int bj = 0; bj < 2; ++bj) {
                        const int hh = 2 * bj + (wc >> 1), e0 = 32 * (wc & 1) + 8 * fq;
                        if (kind == 0 && t >= SEQ - W) { float* o = out + offw_p(ti) + ((((l * NB_P + b) * W + (t - (SEQ - W))) * 2 + 1) * 4 + hh) * 64 + e0; *(f32x4*)o = acc[ai][bj][m][0]; *(f32x4*)(o + 4) = acc[ai][bj][m][1]; }
                        if (kind == 1)                 { float* o = out + offw_s(ti) + ((((l * NB_S + b) * W + (W - TS + t)) * 2 + 1) * 4 + hh) * 64 + e0; *(f32x4*)o = acc[ai][bj][m][0]; *(f32x4*)(o + 4) = acc[ai][bj][m][1]; }
                    }
                }
        } else if (pn == T_GQ) {
            plain<3, SK>(acc, (bf16*)(ws + WS_GQ), 256, 0, row0, wc, fq);
        } else if (pn == T_GK) {
            plain<0, SK>(acc, (bf16*)(ws + WS_GK), 256, 0, row0, wc, fq);
        } else if (pn < T_GR) {
            plain<0, SK>(acc, (bf16*)(ws + WS_GV), 512, 256 * (pn - T_GV), row0, wc, fq);
        } else if (pn < T_Z) {
            plain<2, SK>(acc, (bf16*)(ws + WS_GR), 512, 256 * (pn - T_GR), row0, wc, fq);
        } else if (pn == T_Z) {
#pragma unroll
            for (int bj = 0; bj < 2; ++bj) {
                const int c0 = 128 * bj + 32 * wc + 8 * fq;
                const f32x4 b0 = *(const f32x4*)(b_a + c0), b1 = *(const f32x4*)(b_a + c0 + 4);
#pragma unroll
                for (int ai = 0; ai < (SK ? 1 : 2); ++ai)
#pragma unroll
                    for (int m = 0; m < (SK ? 2 : 4); ++m) {
                        const int row = row0 + ai * 128 + m * 16;
                        f32x4 z0 = acc[ai][bj][m][0] + b0, z1 = acc[ai][bj][m][1] + b1;
#pragma unroll
                        for (int j = 0; j < 4; ++j) {
                            z0[j] = (fminf(z0[j], 0.f) - __logf(1.0f + __expf(-fabsf(z0[j])))) * (1.0f / 16.0f);
                            z1[j] = (fminf(z1[j], 0.f) - __logf(1.0f + __expf(-fabsf(z1[j])))) * (1.0f / 16.0f);
                        }
                        float* o = (float*)(ws + WS_LA) + (size_t)row * 256 + c0; *(f32x4*)o = z0; *(f32x4*)(o + 4) = z1;
                    }
            }
        } else if (pn < T_GATE) {
            const int ti = pn - T_PIN;
            plain<0, SK>(acc, (bf16*)(ws + WS_PIN), 512, 256 * ti, row0, wc, fq);
#pragma unroll
            for (int ai = 0; ai < (SK ? 1 : 2); ++ai)
#pragma unroll
                for (int m = 0; m < (SK ? 2 : 4); ++m) {
                    const int row = row0 + ai * 128 + m * 16;
                    int kind, b, t; row_decode(row, kind, b, t);
#pragma unroll
                    for (int bj = 0; bj < 2; ++bj) {
                        const int c0 = 256 * ti + 128 * bj + 32 * wc + 8 * fq;
                        if (kind == 0 && t >= SEQ - 15) { float* o = out + OFF_POOL_P + ((l * NB_P + b) * 15 + (t - (SEQ - 15))) * 512 + c0; *(f32x4*)o = acc[ai][bj][m][0]; *(f32x4*)(o + 4) = acc[ai][bj][m][1]; }
                        if (kind == 1)                  { float* o = out + OFF_POOL_S + ((l * NB_S + b) * 15 + (15 - TS + t)) * 512 + c0; *(f32x4*)o = acc[ai][bj][m][0]; *(f32x4*)(o + 4) = acc[ai][bj][m][1]; }
                    }
                }
        } else {
            _Float16* R = (_Float16*)(ws + WS_GATE);
            const int c0 = 64 * (pn - T_GATE) + 16 * wc + 4 * fq;
#pragma unroll
            for (int ai = 0; ai < (SK ? 1 : 2); ++ai)
#pragma unroll
                for (int m = 0; m < (SK ? 2 : 4); ++m) {
                    const size_t o = (size_t)(row0 + ai * 128 + m * 16) * DM + c0;
                    h16x4 r0, r1, r2, r3;
#pragma unroll
                    for (int j = 0; j < 4; ++j) {
                        const float d0 = fminf(1.0f + __expf(-acc[ai][0][m][0][j]), 16384.f), d1 = fminf(1.0f + __expf(-acc[ai][0][m][1][j]), 16384.f);
                        const float d2 = fminf(1.0f + __expf(-acc[ai][1][m][0][j]), 16384.f), d3 = fminf(1.0f + __expf(-acc[ai][1][m][1][j]), 16384.f);
                        const float i0 = __builtin_amdgcn_rcpf(d0), i1 = __builtin_amdgcn_rcpf(d1), i2 = __builtin_amdgcn_rcpf(d2), i3 = __builtin_amdgcn_rcpf(d3);
                        r0[j] = (_Float16)fminf(d1 * i0, 65504.f); r1[j] = (_Float16)fminf(d2 * i1, 65504.f); r2[j] = (_Float16)fminf(d3 * i2, 65504.f); r3[j] = (_Float16)i3;
                    }
                    EPI_ST((h16x4*)(R + o), r0); EPI_ST((h16x4*)(R + RAT_STRIDE + o), r1); EPI_ST((h16x4*)(R + 2 * RAT_STRIDE + o), r2); EPI_ST((h16x4*)(R + 3 * RAT_STRIDE + o), r3);
                }
        }
    }
};

__device__ __forceinline__ unsigned wt_lane(int wc, int fr, int g) { return (unsigned)(wc * 4096 + (g >> 1) * 1024 + ((fr * 64 + 32 * (g & 1)) ^ ((fr >> 3) << 5))); }
template <class Epi>
__device__ __forceinline__ void skinny_unit(LAS unsigned char* lds, const bf16* A, const bf16* Bt, int K, int su, const Epi E, int tid, int ld = 0) {
    if (ld == 0) ld = K;
    const int lane = tid & 63, w = __builtin_amdgcn_readfirstlane(tid >> 6), fr = lane & 15, g = lane >> 4;
    const int pn = su >> 2, wc = su & 3;
    const int nh = K >> 6, h0 = (w * nh) >> 3, h1 = ((w + 1) * nh) >> 3;
    f32x4 acc[2][2][2];
#pragma unroll
    for (int bj = 0; bj < 2; ++bj)
#pragma unroll
        for (int m = 0; m < 2; ++m)
#pragma unroll
            for (int n = 0; n < 2; ++n) acc[bj][m][n] = (f32x4){0.f, 0.f, 0.f, 0.f};
    const bf16* ap = A + (size_t)(MP + fr) * ld + 16 * g;
    const char* bp = (const char*)Bt + (size_t)pn * nh * 32768 + wt_lane(wc, fr, g);
    for (int hc = h0; hc < h1; hc += 4) {
        bf16x8 a[4][2][2], b[4][2][2][2];
#pragma unroll
        for (int q = 0; q < 4; ++q) {
            const int hq = (hc + q < h1) ? hc + q : h1 - 1;
#pragma unroll
            for (int s = 0; s < 2; ++s) {
#pragma unroll
                for (int m = 0; m < 2; ++m) a[q][m][s] = *(const bf16x8*)(ap + (size_t)(16 * m) * ld + 64 * hq + 8 * s);
#pragma unroll
                for (int bj = 0; bj < 2; ++bj)
#pragma unroll
                    for (int n = 0; n < 2; ++n) b[q][bj][n][s] = *(const bf16x8*)(bp + (size_t)hq * 32768 + bj * 16384 + n * 2048 + s * 16);
            }
        }
#pragma unroll
        for (int q = 0; q < 4; ++q) {
            const bool ok = hc + q < h1;
#pragma unroll
            for (int s = 0; s < 2; ++s)
#pragma unroll
                for (int m = 0; m < 2; ++m) {
                    bf16x8 av = a[q][m][s];
                    if (!ok) av = (bf16x8){0, 0, 0, 0, 0, 0, 0, 0};
#pragma unroll
                    for (int bj = 0; bj < 2; ++bj)
#pragma unroll
                        for (int n = 0; n < 2; ++n) acc[bj][m][n] = __builtin_amdgcn_mfma_f32_16x16x32_bf16(b[q][bj][n][s], av, acc[bj][m][n], 0, 0, 0);
                }
        }
    }
    LAS f32x4* red = (LAS f32x4*)lds;
#pragma unroll
    for (int bj = 0; bj < 2; ++bj)
#pragma unroll
        for (int m = 0; m < 2; ++m)
#pragma unroll
            for (int n = 0; n < 2; ++n) red[(w * 8 + (bj * 4 + m * 2 + n)) * 64 + lane] = acc[bj][m][n];
    __syncthreads();
    if (w == 0) {
        f32x4 full[2][2][4][2];
#pragma unroll
        for (int bj = 0; bj < 2; ++bj)
#pragma unroll
            for (int m = 0; m < 2; ++m)
#pragma unroll
                for (int n = 0; n < 2; ++n) {
                    f32x4 s = red[(bj * 4 + m * 2 + n) * 64 + lane];
#pragma unroll
                    for (int ww = 1; ww < 8; ++ww) s += red[(ww * 8 + (bj * 4 + m * 2 + n)) * 64 + lane];
                    asm volatile("" : "+v"(s) :: "memory");
                    full[0][bj][m][n] = s;
                }
        pg8::Unit u; u.pm = MP / 256; u.pn = pn; u.ri = 0;
        E.template run<true>(full, u, 0, wc, fr, g);
    }
    __syncthreads();
}

__device__ __forceinline__ void skinny_merge_unit(LAS unsigned char* lds, unsigned char* ws, const bf16* Y, const bf16* U, int su, int tid) {
    const int lane = tid & 63, w = __builtin_amdgcn_readfirstlane(tid >> 6), fr = lane & 15, g = lane >> 4;
    const int pn = su >> 2, wc = su & 3;
    f32x4 acc[2][2][2];
#pragma unroll
    for (int bj = 0; bj < 2; ++bj)
#pragma unroll
        for (int m = 0; m < 2; ++m)
#pragma unroll
            for (int n = 0; n < 2; ++n) acc[bj][m][n] = (f32x4){0.f, 0.f, 0.f, 0.f};
    if (w < 7) {
        const bf16* ap = Y + (size_t)(MP + fr) * YK + 16 * g + 256 * w;
        const char* bp = (const char*)U + (size_t)(pn * (YK / 64) + 4 * w) * 32768 + wt_lane(wc, fr, g);
        bf16x8 a[4][2][2], b[4][2][2][2];
#pragma unroll
        for (int q = 0; q < 4; ++q)
#pragma unroll
            for (int s2 = 0; s2 < 2; ++s2) {
#pragma unroll
                for (int m = 0; m < 2; ++m) a[q][m][s2] = *(const bf16x8*)(ap + (size_t)(16 * m) * YK + 64 * q + 8 * s2);
#pragma unroll
                for (int bj = 0; bj < 2; ++bj)
#pragma unroll
                    for (int n = 0; n < 2; ++n) b[q][bj][n][s2] = *(const bf16x8*)(bp + (size_t)q * 32768 + bj * 16384 + n * 2048 + s2 * 16);
            }
#pragma unroll
        for (int q = 0; q < 4; ++q)
#pragma unroll
            for (int s2 = 0; s2 < 2; ++s2)
#pragma unroll
                for (int m = 0; m < 2; ++m)
#pragma unroll
                    for (int bj = 0; bj < 2; ++bj)
#pragma unroll
                        for (int n = 0; n < 2; ++n) acc[bj][m][n] = __builtin_amdgcn_mfma_f32_16x16x32_bf16(b[q][bj][n][s2], a[q][m][s2], acc[bj][m][n], 0, 0, 0);
    }
    LAS f32x4* red = (LAS f32x4*)lds;
#pragma unroll
    for (int bj = 0; bj < 2; ++bj)
#pragma unroll
        for (int m = 0; m < 2; ++m)
#pragma unroll
            for (int n = 0; n < 2; ++n) red[(w * 8 + (bj * 4 + m * 2 + n)) * 64 + lane] = acc[bj][m][n];
    __syncthreads();
    if (w == 0) {
        bf16* MRG = (bf16*)(ws + WS_MRG);
        const int col0 = pn * 256 + wc * 32 + 8 * g;
#pragma unroll
        for (int m = 0; m < 2; ++m) {
            const int row = MP + 16 * m + fr;
#pragma unroll
            for (int bj = 0; bj < 2; ++bj) {
                const _Float16* R = (const _Float16*)(ws + WS_GATE) + (size_t)row * DM + col0 + bj * 128;
                const h16x8 r0 = *(const h16x8*)R, r1 = *(const h16x8*)(R + RAT_STRIDE), r2 = *(const h16x8*)(R + 2 * RAT_STRIDE), r3 = *(const h16x8*)(R + 3 * RAT_STRIDE);
                f32x4 o[2];
#pragma unroll
                for (int n = 0; n < 2; ++n) {
                    const int ti = bj * 4 + m * 2 + n;
                    const f32x4 pa = red[(0 * 8 + ti) * 64 + lane] + red[(1 * 8 + ti) * 64 + lane], pb = red[(2 * 8 + ti) * 64 + lane];
                    const f32x4 pc = red[(3 * 8 + ti) * 64 + lane] + red[(4 * 8 + ti) * 64 + lane], pd = red[(5 * 8 + ti) * 64 + lane] + red[(6 * 8 + ti) * 64 + lane];
#pragma unroll
                    for (int j = 0; j < 4; ++j) {
                        const float e3 = (float)r3[4 * n + j], e2 = (float)r2[4 * n + j] * e3, e1 = (float)r1[4 * n + j] * e2, e0 = (float)r0[4 * n + j] * e1;
                        o[n][j] = (e0 * pa[j] + e1 * pb[j]) + (e2 * pc[j] + e3 * pd[j]);
                    }
                }
                *(u32x4*)(MRG + (size_t)row * DM + col0 + bj * 128) = pk8(o[0], o[1]);
            }
        }
    }
    __syncthreads();
}

constexpr int IT_GU = 344 * 32, IT_D = 64 * 86, IT_IN = 448 * 32, IT_UPA = 64 * 8, IT_UPB = 64 * 4, IT_UPC = 64 * 8, IT_UPD = 64 * 8, IT_OUT = 64 * 32;
constexpr int IT_LAYER = 2 * IT_GU + 2 * IT_D + IT_IN + IT_UPA + IT_UPB + IT_UPC + IT_UPD + IT_OUT;
static_assert(IT_LAYER == 51200, "items per layer");

constexpr int PB_LAYER = 2 * 43 * 32 + 2 * 8 * 86 + 56 * 32 + 8 * 8 + 8 * 4 + 8 * 8 + 8 * 8 + 8 * 32;
static_assert(PB_LAYER == 6400, "blocks per layer");
constexpr int PB_P = 265;
constexpr int PB_PW_OFF = 69632;
struct BDesc { const float* src; const float* gain; bf16* dst; int ldw, K, kind, perm, aux0, aux1, aux2; };

__device__ __forceinline__ void pblk_decode(LAS unsigned char* lds, bf16* WB, int blk, int wave, int lane, BDesc& D) {
    const int l = blk / PB_LAYER; int r = blk % PB_LAYER;
    const int g = lane >> 3, c4 = lane & 7, bj = g >> 2, wc = g & 3;
    int wi, wi2, gi = -1, ldw, S0, k0, K, T, perm = 1, yo = 0; size_t wofs, woff;
    if (r < 2 * 1376) {
        const int f = r / 1376; r -= f * 1376; T = r % 43; const int kb = r / 43;
        wi = f ? 28 : 9; wi2 = f ? 29 : 10; wofs = (size_t)l * DM * DFF; ldw = DFF; S0 = 128 * T + 32 * wc; k0 = 64 * kb; K = DM; woff = f ? WE_GU2 : WE_GU1; gi = f ? 27 : 8;
    } else if ((r -= 2 * 1376) < 2 * 688) {
        const int f = r / 688; r -= f * 688; T = r % 8; const int kb = r / 8;
        wi = wi2 = f ? 30 : 11; wofs = (size_t)l * DFF * DM; ldw = DM; S0 = 256 * T + 32 * g; k0 = 64 * kb; K = DFF; woff = f ? WE_D2 : WE_D1;
    } else if ((r -= 2 * 688) < 1792) {
        T = r % 56; const int kb = r / 56, pn = T;
        wi = wi2 = 13; wofs = (size_t)l * DM * N_IN; ldw = N_IN; k0 = 64 * kb; K = DM; woff = WE_IN; gi = 12;
        if (pn < T_CB) S0 = (bj ? C_CH : C_CC) + 128 * pn + 32 * wc;
        else if (pn < T_Q) S0 = C_CB + 256 * (pn - T_CB) + 32 * g;
        else if (pn < T_K) S0 = C_AQ + 256 * (pn - T_Q) + 64 * wc + 32 * bj;
        else if (pn < T_V) S0 = C_AK + 256 * (pn - T_K) + 64 * wc + 32 * bj;
        else if (pn < T_GQ) S0 = C_AV + 256 * (pn - T_V) + 32 * g;
        else if (pn == T_GQ) S0 = C_GQ + 32 * g;
        else if (pn == T_GK) S0 = C_GK + 32 * g;
        else if (pn < T_GR) S0 = C_GV + 256 * (pn - T_GV) + 32 * g;
        else if (pn < T_Z) S0 = C_GR + 256 * (pn - T_GR) + 32 * g;
        else if (pn == T_Z) S0 = C_LR;
        else if (pn < T_GATE) S0 = C_PIN + 256 * (pn - T_PIN) + 32 * g;
        else { S0 = C_GATE + (2 * bj + (c4 >> 2)) * 2048 + 64 * (pn - T_GATE) + 16 * wc + 4 * (c4 & 3) - 4 * c4; perm = 0; }
    } else {
        r -= 1792; K = YK; woff = WE_UPCAT; ldw = DM; int kb;
        if (r < 64) { T = r % 8; kb = r / 8; wi = 22; wofs = (size_t)l * 512 * DM; yo = YO_A; }
        else if ((r -= 64) < 32) { T = r % 8; kb = r / 8; wi = 23; wofs = (size_t)l * 256 * DM; yo = YO_B; }
        else if ((r -= 32) < 64) { T = r % 8; kb = r / 8; wi = 24; wofs = (size_t)l * 512 * DM; yo = YO_C; }
        else if ((r -= 64) < 64) { T = r % 8; kb = r / 8; wi = 25; wofs = (size_t)l * 512 * DM; yo = YO_D; }
        else { r -= 64; T = r % 8; kb = r / 8; wi = 26; wofs = (size_t)l * DM * DM; K = DM; woff = WE_OUT; }
        wi2 = wi; S0 = 256 * T + 32 * g; k0 = 64 * kb;
    }
    const float* W0 = ldp(lds, wi); const float* W1 = ldp(lds, wi2); const float* gbase = ldp(lds, gi >= 0 ? gi : 8);
    D.src = (bj ? W1 : W0) + wofs + (size_t)(k0 + 8 * wave) * ldw + S0 + 4 * c4;
    D.gain = gi >= 0 ? gbase + (size_t)l * DM + k0 + 8 * wave : gbase;
    D.dst = WB + (size_t)l * WE_LAYER + woff + ((size_t)T * (K >> 6) + ((yo + k0) >> 6)) * 16384; D.ldw = ldw; D.K = K; D.kind = 0; D.perm = perm; D.aux0 = 0; D.aux1 = l; D.aux2 = gi >= 0;
}
__device__ __forceinline__ void pblk_load(const BDesc& D, f32x4 (&v)[8], f32x4 (&gv)[2]) {
#pragma unroll
    for (int i = 0; i < 8; ++i) v[i] = __builtin_nontemporal_load((const f32x4*)(D.src + (size_t)i * D.ldw));
    gv[0] = *(const f32x4*)D.gain; gv[1] = *(const f32x4*)(D.gain + 4);
}
template <int MODE = 0>
__device__ __forceinline__ void pblk_writeout(LAS unsigned char* lds, bf16* dst, int K, int perm, int tid) {
    LAS float* tile = (LAS float*)(lds + RING_OFF);
    const int lane = tid & 63, wave = tid >> 6;
    LDS_WAIT(); __builtin_amdgcn_s_barrier(); asm volatile("" ::: "memory");
    const int c = lane & 7;
#pragma unroll
    for (int j = 0; j < 4; ++j) {
        const int rho = (lane >> 3) + 8 * j; const int cc = perm ? pg8::perm32(rho) : rho;
        const LAS float* s = tile + (8 * c) * PB_P + 33 * wave + cc;
        u32x4 o; o.x = pk2(s[0 * PB_P], s[1 * PB_P]); o.y = pk2(s[2 * PB_P], s[3 * PB_P]); o.z = pk2(s[4 * PB_P], s[5 * PB_P]); o.w = pk2(s[6 * PB_P], s[7 * PB_P]);
        if (MODE == 0) *(u32x4*)((char*)dst + (wave >> 2) * 16384 + pg8::lds_byte(32 * (wave & 3) + rho, 8 * c)) = o; else asm volatile("" :: "v"(o));
    }
    LDS_WAIT(); __builtin_amdgcn_s_barrier(); asm volatile("" ::: "memory");
}
template <int MODE = 0>
__device__ __forceinline__ void pblk_finish(LAS unsigned char* lds, const BDesc& D, const f32x4 (&v)[8], const f32x4 (&gv)[2], int tid) {
    if (MODE == 2) { _Pragma("unroll") for (int i = 0; i < 8; ++i) asm volatile("" :: "v"(v[i])); return; }
    f32x4 g0 = gv[0], g1 = gv[1]; asm volatile("" : "+v"(g0), "+v"(g1) :: "memory");
    LAS float* tile = (LAS float*)(lds + RING_OFF);
    const int lane = tid & 63, wave = tid >> 6;
    const int g = lane >> 3, c4 = lane & 7;
#pragma unroll
    for (int i = 0; i < 8; ++i) { const float gk = D.aux2 ? (i < 4 ? g0[i & 3] : g1[i & 3]) : 1.0f; LAS float* s = tile + (8 * wave + i) * PB_P + 33 * g + 4 * c4; s[0] = v[i][0] * gk; s[1] = v[i][1] * gk; s[2] = v[i][2] * gk; s[3] = v[i][3] * gk; }
    pblk_writeout<MODE>(lds, D.dst, D.K, D.perm, tid);
}
__device__ __forceinline__ void prologue_specials(LAS unsigned char* lds, bf16* WB, int bid, int G, int tid) {
    LAS float* tile = (LAS float*)(lds + RING_OFF);
#pragma unroll 1
    for (int s = bid; s < DEPTH * 96; s += G) {
        const int l = s / 96, r = s % 96;
        bf16* wl = WB + (size_t)l * WE_LAYER;
        if (r < 32) {
            const int kb = r;
            const float* A2 = ldp(lds, 17) + (size_t)l * 16 * 256; const float* gmix = ldp(lds, 12) + (size_t)l * DM;
            const float* Wk = ldp(lds, 13) + (size_t)l * DM * N_IN + (size_t)(64 * kb) * N_IN + C_LR;
            const int c = tid & 255, half = tid >> 8;
            float w2[16];
#pragma unroll
            for (int q = 0; q < 16; ++q) w2[q] = A2[q * 256 + c];
#pragma unroll 4
            for (int i = 0; i < 32; ++i) {
                const int kk = 32 * half + i;
                const f32x4* a = (const f32x4*)(Wk + (size_t)kk * N_IN);
                float sum = 0.f;
#pragma unroll
                for (int q = 0; q < 4; ++q) { const f32x4 av = a[q]; sum += av[0] * w2[4 * q] + av[1] * w2[4 * q + 1] + av[2] * w2[4 * q + 2] + av[3] * w2[4 * q + 3]; }
                tile[kk * PB_P + 33 * (c >> 5) + (c & 31)] = sum * gmix[64 * kb + kk];
            }
            pblk_writeout(lds, wl + WE_IN + ((size_t)T_Z * (DM / 64) + kb) * 16384, DM, 1, tid);
        } else {
            const int q = r - 32, T = q % 8, kb = q / 8, gg = kb >> 1, i0 = (kb & 1) * 64;
            LAS float* pw = (LAS float*)(lds + PB_PW_OFF);
            { const f32x4* src = (const f32x4*)(ldp(lds, 20) + ((size_t)l * 4 + gg) * 128 * 128 + (size_t)i0 * 128);
              for (int e = tid; e < 64 * 32; e += NTHR) ((LAS f32x4*)pw)[e] = src[e]; }
            LDS_WAIT(); __builtin_amdgcn_s_barrier(); asm volatile("" ::: "memory");
            const int n = tid & 255, half = tid >> 8;
            const float* SC = ldp(lds, 21) + (size_t)l * 512 + gg * 128;
            const float* UD = ldp(lds, 25) + (size_t)l * 512 * DM + (size_t)(gg * 128) * DM + 256 * T + n;
            float a[32];
#pragma unroll
            for (int j = 0; j < 32; ++j) a[j] = 0.f;
#pragma unroll 2
            for (int c = 0; c < 128; ++c) {
                const float uv = UD[(size_t)c * DM] * SC[c];
#pragma unroll
                for (int j = 0; j < 32; ++j) a[j] += pw[(32 * half + j) * 128 + c] * uv;
            }
#pragma unroll
            for (int j = 0; j < 32; ++j) tile[(32 * half + j) * PB_P + 33 * (n >> 5) + (n & 31)] = a[j];
            pblk_writeout(lds, wl + WE_UPCAT + ((size_t)T * (YK / 64) + YO_D / 64 + kb) * 16384, YK, 1, tid);
        }
    }
}
constexpr int DEFER_WG0 = 96, DEFER_WGS = 160, DEFER_PER_WG = 9, DEFER_N = (DEFER_WGS * DEFER_PER_WG < 1376) ? DEFER_WGS * DEFER_PER_WG : 1376;
__device__ __forceinline__ bool pblk_deferred(int blk) {
    const int l = blk / PB_LAYER, r = blk % PB_LAYER;
    if (r < 1376) return l >= 1 && r < DEFER_N;
    if (r < 2 * 1376) return (r - 1376) < DEFER_N;
    return false;
}
__device__ __forceinline__ bool pblk_special(int blk) {
    int r = blk % PB_LAYER - (2 * 1376 + 2 * 688);
    if (r < 0) return false;
    if (r < 1792) return (r % 56) == T_Z;
    r -= 1792 + 64 + 32 + 64; return r >= 0 && r < 64;
}
#define PB_NEXT(I) { while (cand < count && ((skip_deferred && pblk_deferred(first + cand)) || pblk_special(first + cand))) cand += stride; I = cand < count ? cand : -1; cand += stride; }
#define PB_LOAD(D, V, GV, I) { pblk_decode(lds, WB, first + ((I) >= 0 ? (I) : i0), wave, lane, D); if ((I) < 0) { D.src = dummy; D.ldw = 0; } pblk_load(D, V, GV); }
#define PB_STEP(CUR, VCUR, GCUR, INEXT, NXT2, VNXT2, GNXT2, INXT2) { PB_NEXT(INXT2); \
        PB_LOAD(NXT2, VNXT2, GNXT2, INXT2) \
        pblk_finish<MODE>(lds, CUR, VCUR, GCUR, tid); \
        if (INEXT < 0) break; }
template <int MODE = 0>
__device__ __forceinline__ void prologue_blocks(LAS unsigned char* lds, bf16* WB, int first, int count, int start, int stride, int tid, bool skip_deferred) {
    const int lane = tid & 63, wave = __builtin_amdgcn_readfirstlane(tid >> 6);
    BDesc A, B, C; f32x4 va[8], vb[8], vc[8], ga[2], gb[2], gc[2];
    int cand = start, ia, ib, ic;
    PB_NEXT(ia); if (ia < 0) return;
    const int i0 = ia; const float* dummy = ldp(lds, 8) + 4 * lane;
    PB_LOAD(A, va, ga, ia)
    PB_NEXT(ib);
    PB_LOAD(B, vb, gb, ib)
#pragma unroll 1
    for (;;) {
        PB_STEP(A, va, ga, ib, C, vc, gc, ic)
        PB_STEP(B, vb, gb, ic, A, va, ga, ia)
        PB_STEP(C, vc, gc, ia, B, vb, gb, ib)
    }
}
#undef PB_STEP
#undef PB_LOAD
#undef PB_NEXT

__device__ __forceinline__ void x_init_pass(const float* xp, const float* xs, bf16* XB, unsigned long long* ss0, int gw, int NGW, int lane) {
    for (int row = gw; row < MPAD; row += NGW) {
        u32x2* o = (u32x2*)(XB + (size_t)row * DM) + lane;
        if (row >= MR) {
#pragma unroll
            for (int j = 0; j < 8; ++j) { u32x2 z; z.x = 0u; z.y = 0u; o[64 * j] = z; }
            continue;
        }
        const f32x4* xr = (const f32x4*)(row < MP ? xp + (size_t)row * DM : xs + (size_t)(row - MP) * DM) + lane;
        float ss = 0.f;
#pragma unroll
        for (int j = 0; j < 8; ++j) { const f32x4 v = xr[64 * j]; u32x2 w; w.x = pk2(v[0], v[1]); w.y = pk2(v[2], v[3]); o[64 * j] = w;
            const float a0 = bflo(w.x), a1 = bfhi(w.x), a2 = bflo(w.y), a3 = bfhi(w.y); ss += (a0 * a0 + a1 * a1) + (a2 * a2 + a3 * a3); }
        ss = wave_sum(ss, lane);
        if (lane == 0) ss0[row] = (unsigned long long)(ss * SS_FIX + 0.5f);
    }
}

constexpr int CC_N0 = DEPTH * NB_S * (128 - TS) * 128, CC_N1 = DEPTH * NB_S * (512 - TS) * 128, CC_N2 = DEPTH * NB_S * (2048 - TS) * 128, CACHE_COPY_N = CC_N0 + CC_N1 + CC_N2;
__device__ __forceinline__ void cache_copy_range(const float* c128, const float* c512, const float* c2048, float* out, int i0, int i1, int t, int nt) {
    for (int i = i0 + t; i < i1; i += nt) {
        int ii = i, gi = 0;
        if (ii >= CC_N0) { ii -= CC_N0; gi = 1; if (ii >= CC_N1) { ii -= CC_N1; gi = 2; } }
        const int W = win_of(gi), per = (W - TS) * 128, lb = ii / per, j = ii - lb * per;
        const f32x4* src = (const f32x4*)(gi == 0 ? c128 : (gi == 1 ? c512 : c2048)); f32x4* dst = (f32x4*)(out + offw_s(gi));
        __builtin_nontemporal_store(__builtin_nontemporal_load(src + (size_t)lb * W * 128 + TS * 128 + j), dst + (size_t)lb * W * 128 + j);
    }
}

__device__ __forceinline__ s16x4 ds_tr16(const LAS unsigned char* p) { return __builtin_amdgcn_ds_read_tr16_b64_v4i16((LAS s16x4*)p); }
__device__ __forceinline__ bf16x8 cat4(s16x4 a, s16x4 b) { bf16x8 r; r[0] = a[0]; r[1] = a[1]; r[2] = a[2]; r[3] = a[3]; r[4] = b[0]; r[5] = b[1]; r[6] = b[2]; r[7] = b[3]; return r; }
__device__ __forceinline__ bf16x8 pk8v(f32x4 a, f32x4 b) { const u32x4 w = pk8(a, b); return __builtin_bit_cast(bf16x8, w); }

constexpr int ATT_UNITS = NB_P * 12 * 32;
constexpr int ATT_PITCH = 144;
__device__ __forceinline__ void attn_unit(LAS unsigned char* lds, const bf16* Q, const bf16* K, const bf16* V, float* AO, float* LSE, int unit, int tid) {
    const int lane = tid & 63, w = tid >> 6, fr = lane & 15, g = lane >> 4;
    const int blk = unit & 31, bh = unit >> 5, h = bh % 12, b = bh / 12;
    const int gi = h >> 2, dl = dil_of(gi);
    const int r = blk % dl, nb = blk / dl;
    LAS unsigned char* Ks = lds; LAS unsigned char* Vs = lds + 256 * ATT_PITCH;
    for (int c = tid; c < 2048; c += NTHR) {
        const int ki = c >> 3, ch = c & 7, ksub = nb * 128 + ki - 128;
        u32x4 kv = {0u, 0u, 0u, 0u}, vv = {0u, 0u, 0u, 0u};
        if (ksub >= 0) { const size_t off = (size_t)(b * SEQ + r + dl * ksub) * 768 + h * 64 + ch * 8; kv = *(const u32x4*)(K + off); vv = *(const u32x4*)(V + off); }
        *(LAS u32x4*)(Ks + ki * ATT_PITCH + ch * 16) = kv; *(LAS u32x4*)(Vs + ki * ATT_PITCH + ch * 16) = vv;
    }
    __syncthreads();
    const int qi = 16 * w + fr;
    const int qtok = b * SEQ + r + dl * (nb * 128 + qi);
    const bf16x8 q0 = *(const bf16x8*)(Q + (size_t)qtok * 768 + h * 64 + 8 * g), q1 = *(const bf16x8*)(Q + (size_t)qtok * 768 + h * 64 + 32 + 8 * g);
    const int ks0 = w >> 1;
    f32x4 s[10];
#pragma unroll
    for (int tt = 0; tt < 10; ++tt) {
        const int T = 2 * ks0 + tt;
        const LAS unsigned char* kp = Ks + (16 * T + fr) * ATT_PITCH + 16 * g;
        const bf16x8 k0 = *(const LAS bf16x8*)kp, k1 = *(const LAS bf16x8*)(kp + 64);
        f32x4 a = {0.f, 0.f, 0.f, 0.f};
        a = __builtin_amdgcn_mfma_f32_16x16x32_bf16(k0, q0, a, 0, 0, 0);
        a = __builtin_amdgcn_mfma_f32_16x16x32_bf16(k1, q1, a, 0, 0, 0);
        s[tt] = a;
    }
    const float slope = exp2f(-8.0f * (float)(h + 1) / 12.0f) * (float)dl;
    float mx = -INFINITY;
#pragma unroll
    for (int tt = 0; tt < 10; ++tt)
#pragma unroll
        for (int j = 0; j < 4; ++j) {
            const int ki = 16 * (2 * ks0 + tt) + 4 * g + j, dist = qi - ki + 128, ksub = nb * 128 + ki - 128;
            const bool valid = (dist >= 0) && (dist <= 128) && (ksub >= 0);
            const float v = s[tt][j] * 0.125f - slope * (float)dist;
            s[tt][j] = valid ? v : -INFINITY;
            mx = fmaxf(mx, s[tt][j]);
        }
    mx = fmaxf(mx, shx(mx, 16, lane)); mx = fmaxf(mx, shx(mx, 32, lane));
    float ls = 0.f;
#pragma unroll
    for (int tt = 0; tt < 10; ++tt)
#pragma unroll
        for (int j = 0; j < 4; ++j) { const float p = __expf(s[tt][j] - mx); s[tt][j] = p; ls += p; }
    ls += shx(ls, 16, lane); ls += shx(ls, 32, lane);
    f32x4 o[4];
#pragma unroll
    for (int et = 0; et < 4; ++et) o[et] = (f32x4){0.f, 0.f, 0.f, 0.f};
    const int q4 = fr >> 2, p4 = fr & 3;
#pragma unroll
    for (int kk = 0; kk < 5; ++kk) {
        const bf16x8 pb = pk8v(s[2 * kk], s[2 * kk + 1]);
        const int rb = 32 * (ks0 + kk) + 4 * g + q4;
#pragma unroll
        for (int et = 0; et < 4; ++et) {
            const s16x4 v0 = ds_tr16(Vs + rb * ATT_PITCH + (16 * et + 4 * p4) * 2);
            const s16x4 v1 = ds_tr16(Vs + (rb + 16) * ATT_PITCH + (16 * et + 4 * p4) * 2);
            o[et] = __builtin_amdgcn_mfma_f32_16x16x32_bf16(cat4(v0, v1), pb, o[et], 0, 0, 0);
        }
    }
    const float inv = 1.0f / ls;
    float* ao = AO + (size_t)qtok * 768 + h * 64 + 4 * g;
#pragma unroll
    for (int et = 0; et < 4; ++et) *(f32x4*)(ao + 16 * et) = o[et] * inv;
    if (g == 0) LSE[(size_t)qtok * 12 + h] = mx + __logf(ls);
    __syncthreads();
}

__device__ __forceinline__ void attn_merge_pass(const float* AO, const float* LSE, bf16* YB, int gt, int NGT, int rep = 1) {
    for (int it0 = gt; it0 < rep * MR * 4 * 16; it0 += NGT) {
        const int it = it0 % (MR * 4 * 16);
        const int e4 = it & 15, slot = (it >> 4) & 3, tok = it >> 6;
        const float l0 = LSE[(size_t)tok * 12 + slot], l1 = LSE[(size_t)tok * 12 + 4 + slot], l2 = LSE[(size_t)tok * 12 + 8 + slot];
        const float m = fmaxf(l0, fmaxf(l1, l2));
        const float w0 = __expf(l0 - m), w1 = __expf(l1 - m), w2 = __expf(l2 - m), inv = 1.0f / (w0 + w1 + w2);
        const float* a = AO + (size_t)tok * 768 + slot * 64 + e4 * 4;
        const f32x4 y = (*(const f32x4*)a * w0 + *(const f32x4*)(a + 256) * w1 + *(const f32x4*)(a + 512) * w2) * inv;
        u32x2 wv; wv.x = pk2(y[0], y[1]); wv.y = pk2(y[2], y[3]);
        *(u32x2*)(YB + (size_t)tok * YK + YO_B + slot * 64 + e4 * 4) = wv;
    }
}

__device__ __forceinline__ float dot64_f32(const float (&q)[64], const float* k) {
    float s = 0.f;
#pragma unroll
    for (int c = 0; c < 16; ++c) { const f32x4 kv = ((const f32x4*)k)[c]; s += (q[4 * c] * kv[0] + q[4 * c + 1] * kv[1]) + (q[4 * c + 2] * kv[2] + q[4 * c + 3] * kv[3]); }
    return s;
}
__device__ __forceinline__ float dot64_bf(const float (&q)[64], const bf16* k) {
    float s = 0.f;
#pragma unroll
    for (int c = 0; c < 8; ++c) { const u32x4 w = ((const u32x4*)k)[c];
        s += (q[8 * c] * bflo(w.x) + q[8 * c + 1] * bfhi(w.x)) + (q[8 * c + 2] * bflo(w.y) + q[8 * c + 3] * bfhi(w.y)) + (q[8 * c + 4] * bflo(w.z) + q[8 * c + 5] * bfhi(w.z)) + (q[8 * c + 6] * bflo(w.w) + q[8 * c + 7] * bfhi(w.w)); }
    return s;
}
__device__ __forceinline__ void attn_sample_wave(const bf16* Q, const bf16* K, const bf16* V, const float* c128, const float* c512, const float* c2048, float* AO, float* LSE, int layer, int unit, int lane) {
    const int h = unit % 12, bt = unit / 12, t = bt & 3, b = bt >> 2;
    const int row = MP + b * TS + t;
    const int gi = h >> 2, slot = h & 3, dl = dil_of(gi), W = win_of(gi);
    const float* cache = (gi == 0 ? c128 : (gi == 1 ? c512 : c2048)) + (size_t)(layer * NB_S + b) * W * 512;
    float qf[64];
    { const u32x4* qp = (const u32x4*)(Q + (size_t)row * 768 + h * 64);
#pragma unroll
      for (int c = 0; c < 8; ++c) { const u32x4 w = qp[c]; qf[8 * c] = bflo(w.x) * 0.125f; qf[8 * c + 1] = bfhi(w.x) * 0.125f; qf[8 * c + 2] = bflo(w.y) * 0.125f; qf[8 * c + 3] = bfhi(w.y) * 0.125f;
          qf[8 * c + 4] = bflo(w.z) * 0.125f; qf[8 * c + 5] = bfhi(w.z) * 0.125f; qf[8 * c + 6] = bflo(w.w) * 0.125f; qf[8 * c + 7] = bfhi(w.w) * 0.125f; } }
    const float slope = exp2f(-8.0f * (float)(h + 1) / 12.0f) * (float)dl;
    float sc[3];
#pragma unroll
    for (int sj = 0; sj < 3; ++sj) {
        const int j = lane + 64 * sj;
        float d = -INFINITY;
        if (j <= 128) {
            const int idx = W + t - j * dl;
            if (idx >= W) d = dot64_bf(qf, K + (size_t)(MP + b * TS + (idx - W)) * 768 + h * 64);
            else d = dot64_f32(qf, cache + ((size_t)idx * 2 + 0) * 256 + slot * 64);
            d -= slope * (float)j;
        }
        sc[sj] = d;
    }
    const float mg = wave_max(fmaxf(sc[0], fmaxf(sc[1], sc[2])), lane);
    const float p0 = __expf(sc[0] - mg), p1 = __expf(sc[1] - mg), p2 = __expf(sc[2] - mg);
    const float lg = wave_sum(p0 + p1 + p2, lane);
    float acc = 0.f;
    const int jstart = (dl == 1) ? t + 1 : 1;
#pragma unroll 1
    for (int j = 0; j < jstart; ++j) acc += rdl(p0, j) * bf2f(V[(size_t)(MP + b * TS + (t - j * dl)) * 768 + h * 64 + lane]);
    const float* vbase = cache + 256 + slot * 64 + lane;
#pragma unroll 1
    for (int j0 = jstart; j0 <= 128; j0 += 32) {
        float vv[32];
#pragma unroll
        for (int i = 0; i < 32; ++i) { const int j = (j0 + i <= 128) ? j0 + i : 128; vv[i] = vbase[(size_t)(W + t - j * dl) * 512]; }
#pragma unroll
        for (int i = 0; i < 32; ++i) { const int j = j0 + i; const float pj = (j <= 128) ? rdl(j < 64 ? p0 : (j < 128 ? p1 : p2), j & 63) : 0.f; acc += pj * vv[i]; }
    }
    AO[(size_t)row * 768 + h * 64 + lane] = acc / lg;
    if (lane == 0) LSE[(size_t)row * 12 + h] = mg + __logf(lg);
}

__device__ __forceinline__ void conv_pool_pass(const bf16* CB, const bf16* U, const bf16* PIN, const float* conv_w, const float* st_conv, const float* st_pool, bf16* YA, bf16* YD, int layer, int gt, int NGT, int rep = 1) {
    for (int it0 = gt; it0 < rep * MPAD * 64; it0 += NGT) {
        const int it = it0 % (MPAD * 64); const int c8 = it & 63, row = it >> 6, ch = c8 * 8;
        int kind, b, t; row_decode(row, kind, b, t);
        if (kind == 2) { const u32x4 z = {0u, 0u, 0u, 0u}; *(u32x4*)(YA + (size_t)row * YK + YO_A + ch) = z; *(u32x4*)(YD + (size_t)row * YK + YO_D + ch) = z; continue; }
        float u0[8], u1[8], u2[8], cb[8];
        unpk8(*(const u32x4*)(U + (size_t)row * 512 + ch), u2);
        if (t >= 1) unpk8(*(const u32x4*)(U + (size_t)(row - 1) * 512 + ch), u1);
        else if (kind == 1) { const float* s = st_conv + ((size_t)(layer * NB_S + b) * 2 + 1) * 512 + ch; _Pragma("unroll") for (int j = 0; j < 8; ++j) u1[j] = s[j]; }
        else { _Pragma("unroll") for (int j = 0; j < 8; ++j) u1[j] = 0.f; }
        if (t >= 2) unpk8(*(const u32x4*)(U + (size_t)(row - 2) * 512 + ch), u0);
        else if (kind == 1) { const float* s = st_conv + ((size_t)(layer * NB_S + b) * 2 + t) * 512 + ch; _Pragma("unroll") for (int j = 0; j < 8; ++j) u0[j] = s[j]; }
        else { _Pragma("unroll") for (int j = 0; j < 8; ++j) u0[j] = 0.f; }
        unpk8(*(const u32x4*)(CB + (size_t)row * 512 + ch), cb);
        const float* cw = conv_w + (size_t)layer * 3 * 512 + ch;
        f32x4 ya0, ya1;
#pragma unroll
        for (int j = 0; j < 8; ++j) { const float z = cw[j] * u0[j] + cw[512 + j] * u1[j] + cw[1024 + j] * u2[j]; const float y = cb[j] * z; if (j < 4) ya0[j] = y; else ya1[j - 4] = y; }
        *(u32x4*)(YA + (size_t)row * YK + YO_A + ch) = pk8(ya0, ya1);
        const int grp = c8 >> 4, w = 2 << grp;
        float cur[8], sum[8];
        unpk8(*(const u32x4*)(PIN + (size_t)row * 512 + ch), cur);
#pragma unroll
        for (int j = 0; j < 8; ++j) sum[j] = cur[j];
        if (kind == 0) {
            u32x4 xr[15];
#pragma unroll
            for (int i = 1; i < 16; ++i) { const bool ok = (i < w) && (t - i >= 0); xr[i - 1] = *(const u32x4*)(PIN + (size_t)(ok ? row - i : row) * 512 + ch); }
#pragma unroll
            for (int i = 1; i < 16; ++i) { const bool ok = (i < w) && (t - i >= 0); float x[8]; unpk8(xr[i - 1], x); const float m = ok ? 1.f : 0.f;
#pragma unroll
                for (int j = 0; j < 8; ++j) sum[j] += m * x[j]; }
        } else {
            for (int i = 1; i < w; ++i) {
                const int tt = t - i;
                if (tt >= 0) { float x[8]; unpk8(*(const u32x4*)(PIN + (size_t)(row - i) * 512 + ch), x); _Pragma("unroll") for (int j = 0; j < 8; ++j) sum[j] += x[j]; }
                else { const float* s = st_pool + ((size_t)(layer * NB_S + b) * 15 + (15 + tt)) * 512 + ch; _Pragma("unroll") for (int j = 0; j < 8; ++j) sum[j] += s[j]; }
            }
        }
        const float cnt = (kind == 1) ? (float)w : fminf((float)w, (float)(t + 1));
        const float ic = 1.0f / cnt;
        f32x4 d0, d1;
#pragma unroll
        for (int j = 0; j < 8; ++j) { const float d = sum[j] * ic - cur[j]; if (j < 4) d0[j] = d; else d1[j - 4] = d; }
        *(u32x4*)(YD + (size_t)row * YK + YO_D + ch) = pk8(d0, d1);
    }
}

constexpr int GLA_UNITS = NB_P * 4 * 64;
constexpr int GP_K = 144, GP_V = 272;
constexpr int GLA_R0 = 0, GLA_R0_BYTES = 17408, GLA_QT = GLA_R0 + GLA_R0_BYTES, GLA_KT = GLA_QT + 64 * GP_K, GLA_VV = GLA_KT + 64 * GP_K, GLA_HALF = GLA_VV + 64 * GP_V;
static_assert(2 * GLA_HALF <= RING_BYTES, "GLA LDS");

__device__ __forceinline__ void gla_cumsum(LAS float* lb, const float* LA, int tok0, int h, int ht) {
    const int k = ht & 63, q = ht >> 6;
    float v[16]; float run = 0.f;
#pragma unroll
    for (int i = 0; i < 16; ++i) { run += LA[(size_t)(tok0 + 16 * q + i) * 256 + h * 64 + k]; v[i] = run; }
    LAS float* tot = lb + 4096;
    tot[q * 64 + k] = run;
    __syncthreads();
    float off = 0.f;
#pragma unroll
    for (int qq = 0; qq < 3; ++qq) off += (qq < q) ? tot[qq * 64 + k] : 0.f;
#pragma unroll
    for (int i = 0; i < 16; ++i) lb[(16 * q + i) * 64 + k] = v[i] + off;
    __syncthreads();
}

__device__ __forceinline__ void gla_ds_unit(LAS unsigned char* hl, const bf16* GK, const bf16* GV, const float* LA, float* DS, float* DEC, int unit, int ht) {
    const int n = unit & 63, bh = unit >> 6, h = bh & 3, b = bh >> 2;
    const int tok0 = b * SEQ + n * 64;
    const int lane = ht & 63, hw = ht >> 6, fr = lane & 15, g = lane >> 4;
    LAS float* lb = (LAS float*)(hl + GLA_R0);
    gla_cumsum(lb, LA, tok0, h, ht);
    for (int c = ht; c < 512; c += 256) {
        const int s = c >> 3, k0 = (c & 7) * 8;
        float kf[8]; unpk8(*(const u32x4*)(GK + (size_t)(tok0 + s) * 256 + h * 64 + k0), kf);
        f32x4 a0, a1;
#pragma unroll
        for (int j = 0; j < 8; ++j) { const float e = kf[j] * __expf(lb[63 * 64 + k0 + j] - lb[s * 64 + k0 + j]); if (j < 4) a0[j] = e; else a1[j - 4] = e; }
        *(LAS u32x4*)(hl + GLA_KT + s * GP_K + k0 * 2) = pk8(a0, a1);
    }
    for (int c = ht; c < 1024; c += 256) {
        const int s = c >> 4, v0 = (c & 15) * 8;
        *(LAS u32x4*)(hl + GLA_VV + s * GP_V + v0 * 2) = *(const u32x4*)(GV + (size_t)(tok0 + s) * 512 + h * 128 + v0);
    }
    if (ht < 64) DEC[(size_t)unit * 64 + ht] = __expf(lb[63 * 64 + ht]);
    __syncthreads();
    const int q4 = fr >> 2, p4 = fr & 3, kt = hw;
    float* dsb = DS + (size_t)unit * 64 * 128;
#pragma unroll
    for (int dvt = 0; dvt < 8; ++dvt) {
        f32x4 acc = {0.f, 0.f, 0.f, 0.f};
#pragma unroll
        for (int ks = 0; ks < 2; ++ks) {
            const int rb = 32 * ks + 4 * g + q4;
            const bf16x8 af = cat4(ds_tr16(hl + GLA_KT + rb * GP_K + (16 * kt + 4 * p4) * 2), ds_tr16(hl + GLA_KT + (rb + 16) * GP_K + (16 * kt + 4 * p4) * 2));
            const bf16x8 bf = cat4(ds_tr16(hl + GLA_VV + rb * GP_V + (16 * dvt + 4 * p4) * 2), ds_tr16(hl + GLA_VV + (rb + 16) * GP_V + (16 * dvt + 4 * p4) * 2));
            acc = __builtin_amdgcn_mfma_f32_16x16x32_bf16(af, bf, acc, 0, 0, 0);
        }
#pragma unroll
        for (int j = 0; j < 4; ++j) dsb[(size_t)(16 * kt + 4 * g + j) * 128 + 16 * dvt + fr] = acc[j];
    }
    __syncthreads();
}

__device__ __forceinline__ void gla_scan_pass(const float* DS, const float* DEC, bf16* SP, float* out, int layer, int gt, int rep = 1) {
    if (gt >= 8 * 64 * 128) return;
    for (int rr = 0; rr < rep; ++rr) {
    const int v = gt & 127, k = (gt >> 7) & 63, bh = gt >> 13;
    float S = 0.f;
    for (int n0 = 0; n0 < 64; n0 += 32) {
        float d[32], a[32];
#pragma unroll
        for (int i = 0; i < 32; ++i) { d[i] = DS[(((size_t)bh * 64 + n0 + i) * 64 + k) * 128 + v]; a[i] = DEC[((size_t)bh * 64 + n0 + i) * 64 + k]; }
#pragma unroll
        for (int i = 0; i < 32; ++i) { SP[(((size_t)bh * 64 + n0 + i) * 64 + k) * 128 + v] = (bf16)f2bf(S); S = a[i] * S + d[i]; }
    }
    out[OFF_GLA_P + (((size_t)layer * 8 + bh) * 64 + k) * 128 + v] = S;
    }
}

__device__ __forceinline__ void gla_out_unit(LAS unsigned char* hl, const bf16* GQ, const bf16* GK, const bf16* GV, const bf16* GR, const float* LA, const bf16* SP, const float* gnorm, bf16* YC, int unit, int ht) {
    const int n = unit & 63, bh = unit >> 6, h = bh & 3, b = bh >> 2;
    const int tok0 = b * SEQ + n * 64;
    const int lane = ht & 63, hw = ht >> 6, fr = lane & 15, g = lane >> 4;
    LAS float* lb = (LAS float*)(hl + GLA_R0);
    gla_cumsum(lb, LA, tok0, h, ht);
    for (int c = ht; c < 512; c += 256) {
        const int s = c >> 3, k0 = (c & 7) * 8;
        float qf[8], kf[8];
        unpk8(*(const u32x4*)(GQ + (size_t)(tok0 + s) * 256 + h * 64 + k0), qf);
        unpk8(*(const u32x4*)(GK + (size_t)(tok0 + s) * 256 + h * 64 + k0), kf);
        f32x4 a0, a1, c0, c1;
#pragma unroll
        for (int j = 0; j < 8; ++j) { const float bb = lb[s * 64 + k0 + j]; const float qe = qf[j] * __expf(bb), ke = kf[j] * __expf(-bb); if (j < 4) { a0[j] = qe; c0[j] = ke; } else { a1[j - 4] = qe; c1[j - 4] = ke; } }
        *(LAS u32x4*)(hl + GLA_QT + s * GP_K + k0 * 2) = pk8(a0, a1);
        *(LAS u32x4*)(hl + GLA_KT + s * GP_K + k0 * 2) = pk8(c0, c1);
    }
    for (int c = ht; c < 1024; c += 256) {
        const int s = c >> 4, v0 = (c & 15) * 8;
        *(LAS u32x4*)(hl + GLA_VV + s * GP_V + v0 * 2) = *(const u32x4*)(GV + (size_t)(tok0 + s) * 512 + h * 128 + v0);
    }
    __syncthreads();
    for (int c = ht; c < 1024; c += 256) {
        const int k = c >> 4, v0 = (c & 15) * 8;
        *(LAS u32x4*)(hl + GLA_R0 + k * GP_V + v0 * 2) = *(const u32x4*)(SP + ((size_t)unit * 64 + k) * 128 + v0);
    }
    __syncthreads();
    const int tt = hw, q4 = fr >> 2, p4 = fr & 3;
    f32x4 at[4];
    const LAS unsigned char* qrow = hl + GLA_QT + (16 * tt + fr) * GP_K;
    const bf16x8 qb0 = *(const LAS bf16x8*)(qrow + 16 * g), qb1 = *(const LAS bf16x8*)(qrow + 64 + 16 * g);
#pragma unroll
    for (int st = 0; st < 4; ++st) {
        const LAS unsigned char* krow = hl + GLA_KT + (16 * st + fr) * GP_K;
        f32x4 a = {0.f, 0.f, 0.f, 0.f};
        a = __builtin_amdgcn_mfma_f32_16x16x32_bf16(*(const LAS bf16x8*)(krow + 16 * g), qb0, a, 0, 0, 0);
        a = __builtin_amdgcn_mfma_f32_16x16x32_bf16(*(const LAS bf16x8*)(krow + 64 + 16 * g), qb1, a, 0, 0, 0);
#pragma unroll
        for (int j = 0; j < 4; ++j) { const int s = 16 * st + 4 * g + j, t = 16 * tt + fr; a[j] = (s <= t) ? a[j] : 0.f; }
        at[st] = a;
    }
    f32x4 o[8];
#pragma unroll
    for (int dvt = 0; dvt < 8; ++dvt) o[dvt] = (f32x4){0.f, 0.f, 0.f, 0.f};
#pragma unroll
    for (int ks = 0; ks < 2; ++ks) {
        const bf16x8 pb = pk8v(at[2 * ks], at[2 * ks + 1]);
        const int rb = 32 * ks + 4 * g + q4;
        const s16x4 qa = *(const LAS s16x4*)(qrow + (32 * ks + 4 * g) * 2), qc = *(const LAS s16x4*)(qrow + (32 * ks + 16 + 4 * g) * 2);
        const bf16x8 qp = cat4(qa, qc);
#pragma unroll
        for (int dvt = 0; dvt < 8; ++dvt) {
            const bf16x8 vf = cat4(ds_tr16(hl + GLA_VV + rb * GP_V + (16 * dvt + 4 * p4) * 2), ds_tr16(hl + GLA_VV + (rb + 16) * GP_V + (16 * dvt + 4 * p4) * 2));
            o[dvt] = __builtin_amdgcn_mfma_f32_16x16x32_bf16(vf, pb, o[dvt], 0, 0, 0);
            const bf16x8 sf = cat4(ds_tr16(hl + GLA_R0 + rb * GP_V + (16 * dvt + 4 * p4) * 2), ds_tr16(hl + GLA_R0 + (rb + 16) * GP_V + (16 * dvt + 4 * p4) * 2));
            o[dvt] = __builtin_amdgcn_mfma_f32_16x16x32_bf16(sf, qp, o[dvt], 0, 0, 0);
        }
    }
    float ss = 0.f;
#pragma unroll
    for (int dvt = 0; dvt < 8; ++dvt) ss += (o[dvt][0] * o[dvt][0] + o[dvt][1] * o[dvt][1]) + (o[dvt][2] * o[dvt][2] + o[dvt][3] * o[dvt][3]);
    ss += shx(ss, 16, lane); ss += shx(ss, 32, lane);
    const float rs = rsqrtf(ss * (1.0f / 128.0f) + EPS);
    const size_t orow = (size_t)(tok0 + 16 * tt + fr) * 512 + h * 128, yrow = (size_t)(tok0 + 16 * tt + fr) * YK + YO_C + h * 128;
#pragma unroll
    for (int dvt = 0; dvt < 8; ++dvt) {
        const int dv = 16 * dvt + 4 * g;
        const f32x4 gn = *(const f32x4*)(gnorm + dv);
        const u32x2 gw = *(const u32x2*)(GR + orow + dv);
        f32x4 y; y[0] = o[dvt][0] * rs * gn[0] * bflo(gw.x); y[1] = o[dvt][1] * rs * gn[1] * bfhi(gw.x); y[2] = o[dvt][2] * rs * gn[2] * bflo(gw.y); y[3] = o[dvt][3] * rs * gn[3] * bfhi(gw.y);
        u32x2 wv; wv.x = pk2(y[0], y[1]); wv.y = pk2(y[2], y[3]);
        *(u32x2*)(YC + yrow + dv) = wv;
    }
    __syncthreads();
}

__device__ __forceinline__ void gla_sample_unit(LAS float* red, const bf16* GQ, const bf16* GK, const bf16* GV, const bf16* GR, const float* LA, const float* st_gla, const float* gnorm, bf16* YC, float* out, int layer, int unit, int tid) {
    const int h = unit & 3, b = unit >> 2;
    const int dv = tid & 127, kq = tid >> 7;
    const float* s0 = st_gla + (((size_t)(layer * NB_S + b) * 4 + h) * 64 + 16 * kq) * 128 + dv;
    float S[16];
#pragma unroll
    for (int i = 0; i < 16; ++i) S[i] = s0[(size_t)i * 128];
#pragma unroll 1
    for (int t = 0; t < TS; ++t) {
        const int row = MP + b * TS + t;
        const float vv = bf2f(GV[(size_t)row * 512 + h * 128 + dv]);
        float po = 0.f;
#pragma unroll
        for (int i = 0; i < 16; ++i) {
            const int k = 16 * kq + i;
            const float a = __expf(LA[(size_t)row * 256 + h * 64 + k]);
            S[i] = a * S[i] + bf2f(GK[(size_t)row * 256 + h * 64 + k]) * vv;
            po += bf2f(GQ[(size_t)row * 256 + h * 64 + k]) * S[i];
        }
        red[kq * 128 + dv] = po;
        __syncthreads();
        float o = 0.f, sq = 0.f;
        if (kq == 0) { o = (red[dv] + red[128 + dv]) + (red[256 + dv] + red[384 + dv]); sq = o * o; }
        sq = wave_sum(sq, tid & 63);
        if (kq == 0 && (tid & 63) == 0) red[512 + (tid >> 6)] = sq;
        __syncthreads();
        if (kq == 0) {
            const float rs = rsqrtf((red[512] + red[513]) * (1.0f / 128.0f) + EPS);
            const float y = o * rs * gnorm[dv] * bf2f(GR[(size_t)row * 512 + h * 128 + dv]);
            YC[(size_t)row * YK + YO_C + h * 128 + dv] = (bf16)f2bf(y);
        }
        __syncthreads();
    }
    float* so = out + OFF_GLA_S + (((size_t)(layer * NB_S + b) * 4 + h) * 64 + 16 * kq) * 128 + dv;
#pragma unroll
    for (int i = 0; i < 16; ++i) so[(size_t)i * 128] = S[i];
}

constexpr int PH_PER_LAYER = 13, NPH = 1 + DEPTH * PH_PER_LAYER;
#define RM(bit) (1 + ((PROBE_DUP >> (bit)) & 1))
#define REP(bit) for (int rep_ = 0; rep_ < 1 + ((PROBE_DUP >> (bit)) & 1); ++rep_)
#ifndef PROBE_SP2
#define PROBE_SP2 true
#endif
#ifndef PROBE_ALIGN_GU
#define PROBE_ALIGN_GU true
#endif
#ifndef PROBE_ALIGN_RES
#define PROBE_ALIGN_RES true
#endif
#ifndef PROBE_ALIGN_WIN
#define PROBE_ALIGN_WIN true
#endif
#ifndef MK_UNROLL_LAYERS
#define MK_UNROLL_LAYERS 1
#endif
#ifndef MK_PER_PHASE
#define MK_PER_PHASE 0
#endif

struct Args { const float* in[31]; float* out; unsigned char* ws; int ph_lo, ph_hi; };
static_assert(sizeof(Args) == 31 * 8 + 8 + 8 + 8, "Args has no padding");

__device__ __forceinline__ unsigned char* launder(unsigned char* p) { unsigned long long v = (unsigned long long)p; asm volatile("" : "+s"(v)); return (unsigned char*)(GAS unsigned char*)v; }
__device__ __forceinline__ int opq_v(int x) { asm volatile("" : "+v"(x)); return x; }
__device__ __forceinline__ int opq_s(int x) { asm volatile("" : "+s"(x)); return x; }

#define IN(k) (lo <= (k) && (k) < hi)
#define SEAM(k) do { if (IN((k) + 1)) { XcdBarrier bar_; bar_.bar = (unsigned*)(WSP() + WS_CTL) + CW_BAR; bar_.x = xb_xcc_id(); bar_.st = (volatile LAS unsigned*)(lds + MISC_OFF) + 8; REP(13) xcd_barrier(bar_, tid); } } while (0)
#define GW (bid * NWAVES + wave)
#define NGW (G * NWAVES)
#define GT (bid * NTHR + tid)
#define NGT (G * NTHR)
#define WSP() launder((unsigned char*)ldp(lds, PT_WS))
#define IDS() const int wave = opq_s(wave0), lane = (int)__builtin_amdgcn_mbcnt_hi(~0u, __builtin_amdgcn_mbcnt_lo(~0u, (unsigned)opq_v(0))), tid = wave * 64 + lane, G = opq_s(G0), bid = opq_s(bid0); (void)lane; (void)wave; (void)G; (void)bid
struct Ctx { LAS unsigned char* lds; int tid0, wave0, G0, bid0, lo, hi; };
#define CTX_LOCALS() LAS unsigned char* lds = c.lds; const int tid0 = c.tid0, wave0 = c.wave0, G0 = c.G0, bid0 = c.bid0, lo = c.lo, hi = c.hi; (void)lds; (void)tid0; (void)wave0; (void)G0; (void)bid0; (void)lo; (void)hi

__device__ __forceinline__ void ff_part(const Ctx c, const int l, const int f) {
    CTX_LOCALS();
    const int pb = 1 + l * PH_PER_LAYER;
    const int fb = pb + (f ? 10 : 0);
    if (IN(fb + 1)) {
        { IDS(); unsigned char* ws = WSP(); const bf16* wl = (const bf16*)(ws + WS_W) + (size_t)l * WE_LAYER;
          pg8::Gemm g{(const bf16*)(ws + WS_XN), wl + (f ? WE_GU2 : WE_GU1), MP, NGU, DM}; pg8::StaticOrder S; S.init(MP, NGU, G, bid, RM(4));
          EpiSwiGLU E{ws, 3 * l + (f ? 2 : 0)};
          pg8::gemm_phase<EpiSwiGLU, pg8::StaticOrder, PROBE_ALIGN_GU, PROBE_SP2>(lds + RING_OFF, g, S, E, tid); }
        { IDS(); unsigned char* ws = WSP(); const bf16* wl = (const bf16*)(ws + WS_W) + (size_t)l * WE_LAYER; EpiSwiGLU E{ws, 3 * l + (f ? 2 : 0)};
          for (int su = G - 1 - bid; su < RM(9) * (NGU / 64); su += G) skinny_unit<EpiSwiGLU>(lds + RING_OFF, (const bf16*)(ws + WS_XN), wl + (f ? WE_GU2 : WE_GU1), DM, su % (NGU / 64), E, tid); }
        { IDS(); unsigned char* ws = WSP();
          const int dfirst = (f == 0) ? l * PB_LAYER + 1376 : (l + 1) * PB_LAYER;
          if (G == 256 && bid >= DEFER_WG0 && (f == 0 || l < DEPTH - 1)) prologue_blocks(lds, (bf16*)(ws + WS_W), dfirst, DEFER_N, bid - DEFER_WG0, DEFER_WGS, tid, false);
          { const int slot = 2 * l + f; const int c0 = (int)((long)CACHE_COPY_N * slot / 10), c1 = (slot == 7) ? CACHE_COPY_N : (int)((long)CACHE_COPY_N * (slot + 1) / 10);
            if (G == 256) { if (bid >= DEFER_WG0) cache_copy_range(ldp(lds, 3), ldp(lds, 4), ldp(lds, 5), (float*)ldp(lds, PT_OUT), c0, c1, (bid - DEFER_WG0) * NTHR + tid, DEFER_WGS * NTHR); }
            else cache_copy_range(ldp(lds, 3), ldp(lds, 4), ldp(lds, 5), (float*)ldp(lds, PT_OUT), c0, c1, GT, NGT); } }
        IDS();
        SEAM(fb + 1);
    }
    if (IN(fb + 2)) {
        { IDS(); unsigned char* ws = WSP(); const bf16* wl = (const bf16*)(ws + WS_W) + (size_t)l * WE_LAYER;
          pg8::Gemm g{(const bf16*)(ws + WS_H), wl + (f ? WE_D2 : WE_D1), MP, DM, DFF}; pg8::StaticOrder S; S.init(MP, DM, G, bid, RM(10));
          EpiResid E{ws, lds, 0.5f, (f == 1 && l == DEPTH - 1) ? 1 : 0, (f == 0) ? 3 * l + 1 : (l < DEPTH - 1 ? 3 * l + 3 : -1)};
          pg8::gemm_phase<EpiResid, pg8::StaticOrder, PROBE_ALIGN_RES, PROBE_SP2>(lds + RING_OFF, g, S, E, tid); }
        { IDS(); unsigned char* ws = WSP(); const bf16* wl = (const bf16*)(ws + WS_W) + (size_t)l * WE_LAYER; EpiResid E{ws, lds, 0.5f, (f == 1 && l == DEPTH - 1) ? 1 : 0, (f == 0) ? 3 * l + 1 : (l < DEPTH - 1 ? 3 * l + 3 : -1)};
          for (int su = G - 1 - bid; su < DM / 64; su += G) skinny_unit<EpiResid>(lds + RING_OFF, (const bf16*)(ws + WS_H), wl + (f ? WE_D2 : WE_D1), DFF, su, E, tid); }
        IDS();
        SEAM(fb + 2);
    }
}

__device__ __forceinline__ void mixer_part(const Ctx c, const int l) {
    CTX_LOCALS();
    const int pb = 1 + l * PH_PER_LAYER;
    if (IN(pb + 4)) {
        { IDS(); unsigned char* ws = WSP(); const bf16* wl = (const bf16*)(ws + WS_W) + (size_t)l * WE_LAYER;
          pg8::Gemm g{(const bf16*)(ws + WS_XN), wl + WE_IN, MP, NWIN, DM}; pg8::StaticOrder S; S.init(MP, NWIN, G, bid, RM(3));
          EpiWin E{ws, ldp(lds, 15) + (size_t)l * 768, ldp(lds, 16) + (size_t)l * 768, ldp(lds, 18) + (size_t)l * 256, (float*)ldp(lds, PT_OUT), l, 3 * l + 1};
          pg8::gemm_phase<EpiWin, pg8::StaticOrder, PROBE_ALIGN_WIN, PROBE_SP2>(lds + RING_OFF, g, S, E, tid); }
        { IDS(); unsigned char* ws = WSP(); const bf16* wl = (const bf16*)(ws + WS_W) + (size_t)l * WE_LAYER;
          EpiWin E{ws, ldp(lds, 15) + (size_t)l * 768, ldp(lds, 16) + (size_t)l * 768, ldp(lds, 18) + (size_t)l * 256, (float*)ldp(lds, PT_OUT), l, 3 * l + 1};
          for (int su = G - 1 - bid; su < RM(9) * (NWIN / 64); su += G) skinny_unit<EpiWin>(lds + RING_OFF, (const bf16*)(ws + WS_XN), wl + WE_IN, DM, su % (NWIN / 64), E, tid); }
        IDS();
        SEAM(pb + 4);
    }
    if (IN(pb + 5)) {
        IDS();
        { unsigned char* ws = WSP();
          for (int u = bid; u < RM(1) * ATT_UNITS; u += G) attn_unit(lds, (const bf16*)(ws + WS_Q), (const bf16*)(ws + WS_K), (const bf16*)(ws + WS_V), (float*)(ws + WS_AO), (float*)(ws + WS_LSE), u % ATT_UNITS, tid); }
        { unsigned char* ws = WSP();
          for (int u2 = bid; u2 < RM(5) * (GLA_UNITS / 2); u2 += G) gla_ds_unit(lds + (tid >> 8) * GLA_HALF, (const bf16*)(ws + WS_GK), (const bf16*)(ws + WS_GV), (const float*)(ws + WS_LA), (float*)(ws + WS_DS), (float*)(ws + WS_DEC), 2 * (u2 % (GLA_UNITS / 2)) + (tid >> 8), tid & 255); }
        { unsigned char* ws = WSP();
          conv_pool_pass((const bf16*)(ws + WS_CB), (const bf16*)(ws + WS_U), (const bf16*)(ws + WS_PIN), ldp(lds, 14), ldp(lds, 2), ldp(lds, 7), (bf16*)(ws + WS_YCAT), (bf16*)(ws + WS_YCAT), l, GT, NGT, RM(6)); }
        REP(8) { const int su = (NGW - 1 - GW);
          if (su < NB_S * TS * 12) { unsigned char* ws = WSP(); attn_sample_wave((const bf16*)(ws + WS_Q), (const bf16*)(ws + WS_K), (const bf16*)(ws + WS_V), ldp(lds, 3), ldp(lds, 4), ldp(lds, 5), (float*)(ws + WS_AO), (float*)(ws + WS_LSE), l, su, lane); } }
        REP(8) { unsigned char* ws = WSP();
          for (int u = bid - 64; u >= 0 && u < NB_S * 4; u += G) gla_sample_unit((LAS float*)lds, (const bf16*)(ws + WS_GQ), (const bf16*)(ws + WS_GK), (const bf16*)(ws + WS_GV), (const bf16*)(ws + WS_GR), (const float*)(ws + WS_LA), ldp(lds, 6), ldp(lds, 19) + (size_t)l * 128, (bf16*)(ws + WS_YCAT), (float*)ldp(lds, PT_OUT), l, u, tid); }
        SEAM(pb + 5);
    }
    if (IN(pb + 6)) {
        IDS(); unsigned char* ws = WSP();
        gla_scan_pass((const float*)(ws + WS_DS), (const float*)(ws + WS_DEC), (bf16*)(ws + WS_SP), (float*)ldp(lds, PT_OUT), l, GT, RM(7));
        attn_merge_pass((const float*)(ws + WS_AO), (const float*)(ws + WS_LSE), (bf16*)(ws + WS_YCAT), GT, NGT, RM(7));
        SEAM(pb + 6);
    }
    if (IN(pb + 7)) {
        IDS(); unsigned char* ws = WSP();
        for (int u2 = bid; u2 < RM(5) * (GLA_UNITS / 2); u2 += G) gla_out_unit(lds + (tid >> 8) * GLA_HALF, (const bf16*)(ws + WS_GQ), (const bf16*)(ws + WS_GK), (const bf16*)(ws + WS_GV), (const bf16*)(ws + WS_GR), (const float*)(ws + WS_LA), (const bf16*)(ws + WS_SP), ldp(lds, 19) + (size_t)l * 128, (bf16*)(ws + WS_YCAT), 2 * (u2 % (GLA_UNITS / 2)) + (tid >> 8), tid & 255);
        SEAM(pb + 7);
    }
    if (IN(pb + 8)) {
        REP(11) {
        { IDS(); unsigned char* ws = WSP(); const bf16* wl = (const bf16*)(ws + WS_W) + (size_t)l * WE_LAYER; pg8::StaticOrder S; S.init(MP, DM, G, bid);
          pg8::Gemm g{(const bf16*)(ws + WS_YCAT), wl + WE_UPCAT, MP, DM, YK}; EpiMergeCat E{ws};
          pg8::gemm_phase<EpiMergeCat, pg8::StaticOrder, true, PROBE_SP2>(lds + RING_OFF, g, S, E, tid); }
        { IDS(); unsigned char* ws = WSP(); const bf16* wl = (const bf16*)(ws + WS_W) + (size_t)l * WE_LAYER; const bf16* yc = (const bf16*)(ws + WS_YCAT); const bf16* uc = wl + WE_UPCAT;
          for (int su = G - 1 - bid; su < DM / 64; su += G) skinny_merge_unit(lds + RING_OFF, ws, yc, uc, su, tid); }
        }
        IDS();
        SEAM(pb + 8);
    }
    if (IN(pb + 9)) {
        { IDS(); unsigned char* ws = WSP(); const bf16* wl = (const bf16*)(ws + WS_W) + (size_t)l * WE_LAYER;
          pg8::Gemm g{(const bf16*)(ws + WS_MRG), wl + WE_OUT, MP, DM, DM}; pg8::StaticOrder S; S.init(MP, DM, G, bid, RM(12));
          EpiResid E{ws, lds, 1.0f, 0, 3 * l + 2};
#if (PROBE_DUP >> 14) & 1
          { pg8::Gemm g0{(const bf16*)(ws + WS_MRG), wl + WE_OUT, MP, DM, 256}; EpiResid E0{ws, lds, 0.0f, 0, -1};
            pg8::gemm_phase<EpiResid, pg8::StaticOrder, PROBE_ALIGN_RES, PROBE_SP2>(lds + RING_OFF, g0, S, E0, tid); }
#endif
          pg8::gemm_phase<EpiResid, pg8::StaticOrder, PROBE_ALIGN_RES, PROBE_SP2>(lds + RING_OFF, g, S, E, tid); }
        { IDS(); unsigned char* ws = WSP(); const bf16* wl = (const bf16*)(ws + WS_W) + (size_t)l * WE_LAYER; EpiResid E{ws, lds, 1.0f, 0, 3 * l + 2};
          for (int su = G - 1 - bid; su < DM / 64; su += G) skinny_unit<EpiResid>(lds + RING_OFF, (const bf16*)(ws + WS_MRG), wl + WE_OUT, DM, su, E, tid); }
        IDS();
        SEAM(pb + 9);
    }
}

__global__ void __launch_bounds__(NTHR, 2) fwd_kernel(Args args) {
    extern __shared__ __attribute__((aligned(16))) unsigned char lds_raw[];
    LAS unsigned char* lds = (LAS unsigned char*)lds_raw;
    const int tid0 = threadIdx.x; const int wave0 = __builtin_amdgcn_readfirstlane(tid0 >> 6);
    const int G0 = gridDim.x, bid0 = blockIdx.x;
    { const int tid = tid0; for (int u = tid; u < (LDS_BYTES - LDSCTL_OFF) / 4; u += NTHR) ((LAS unsigned*)(lds + LDSCTL_OFF))[u] = 0u; }
    __syncthreads();
    if (tid0 == 0) {
        LAS unsigned long long* pt = (LAS unsigned long long*)(lds + PT_OFF);
#pragma unroll
        for (int i = 0; i < 31; ++i) pt[i] = (unsigned long long)args.in[i];
        pt[PT_OUT] = (unsigned long long)args.out; pt[PT_WS] = (unsigned long long)args.ws;
    }
    __syncthreads();
    if (!MK_PER_PHASE) (void)xcd_barrier_post((unsigned*)(args.ws + WS_CTL) + CW_BAR, (volatile LAS unsigned*)(lds + MISC_OFF) + 8);
    const int lo = args.ph_lo, hi = args.ph_hi;

    if (IN(0)) {
        IDS(); unsigned char* ws = WSP(); float* out = (float*)ldp(lds, PT_OUT);
        REP(0) { prologue_blocks(lds, (bf16*)(ws + WS_W), 0, DEPTH * PB_LAYER, bid, G, tid, G == 256); prologue_specials(lds, (bf16*)(ws + WS_W), G - 1 - bid, G, tid); }
#if (PROBE_DUP >> 16) & 1
        prologue_blocks<1>(lds, (bf16*)(ws + WS_W), 0, DEPTH * PB_LAYER, bid, G, tid, G == 256);
#endif
#if (PROBE_DUP >> 17) & 1
        prologue_blocks<2>(lds, (bf16*)(ws + WS_W), 0, DEPTH * PB_LAYER, bid, G, tid, G == 256);
#endif
        x_init_pass(ldp(lds, 0), ldp(lds, 1), (bf16*)(ws + WS_XN), (unsigned long long*)(ws + WS_CTL + CTL_SS), GW, NGW, lane);
        { const f32x4* src = (const f32x4*)ldp(lds, 7); f32x4* dst = (f32x4*)(out + OFF_POOL_S); const int per = 11 * 128;
          for (int i = GT; i < DEPTH * NB_S * per; i += NGT) { const int lb = i / per, j = i - lb * per; dst[(size_t)lb * 15 * 128 + j] = src[(size_t)lb * 15 * 128 + 4 * 128 + j]; } }
        SEAM(0);
    }

    { Ctx c; c.lds = lds; c.tid0 = tid0; c.wave0 = wave0; c.G0 = G0; c.bid0 = bid0; c.lo = lo; c.hi = hi;
#if MK_UNROLL_LAYERS
      ff_part(c, 0, 0); mixer_part(c, 0); ff_part(c, 0, 1); ff_part(c, 1, 0); mixer_part(c, 1); ff_part(c, 1, 1);
      ff_part(c, 2, 0); mixer_part(c, 2); ff_part(c, 2, 1); ff_part(c, 3, 0); mixer_part(c, 3); ff_part(c, 3, 1);
#else
      _Pragma("unroll 1") for (int l = 0; l < DEPTH; ++l) {
          _Pragma("unroll 1") for (int f = 0; f < 2; ++f) { ff_part(c, l, f); if (f == 0) mixer_part(c, l); }
      }
#endif
    }
#undef IN
#undef SEAM
}

extern "C" void kernel_launch(void* const* d_in, const int* in_sizes, int n_in, void* d_out, int out_size, void* d_ws, size_t ws_size, hipStream_t stream) {
    static int grid = 0;
    if (grid == 0) {
        if (n_in != 31 || out_size != OUT_TOTAL || ws_size < WS_END) { fprintf(stderr, "kernel_launch: expected 31 inputs, %d outputs, >= %zu bytes ws; got %d, %d, %zu\n", OUT_TOTAL, (size_t)WS_END, n_in, out_size, ws_size); grid = -1; return; }
        int dev = 0, cus = 0, per_cu = 0;
        if (hipGetDevice(&dev) != hipSuccess || hipDeviceGetAttribute(&cus, hipDeviceAttributeMultiprocessorCount, dev) != hipSuccess) { grid = -1; return; }
        if (hipFuncSetAttribute((const void*)fwd_kernel, hipFuncAttributeMaxDynamicSharedMemorySize, LDS_BYTES) != hipSuccess) { fprintf(stderr, "kernel_launch: hipFuncSetAttribute failed\n"); grid = -1; return; }
        if (hipOccupancyMaxActiveBlocksPerMultiprocessor(&per_cu, (const void*)fwd_kernel, NTHR, LDS_BYTES) != hipSuccess || per_cu < 1) fprintf(stderr, "kernel_launch: occupancy query says %d\n", per_cu);
        (void)hipGetLastError();
        grid = cus;
    }
    if (grid < 0) return;
    if (hipMemsetAsync((char*)d_ws + WS_CTL, 0, CTL_ZERO_BYTES, stream) != hipSuccess) return;
    Args a; memset(&a, 0, sizeof(a));
    for (int i = 0; i < 31; ++i) a.in[i] = (const float*)d_in[i];
    a.out = (float*)d_out; a.ws = (unsigned char*)d_ws;
#if MK_PER_PHASE
    for (int ph = 0; ph < NPH; ++ph) { a.ph_lo = ph; a.ph_hi = ph + 1; hipLaunchKernelGGL(fwd_kernel, dim3(grid), dim3(NTHR), LDS_BYTES, stream, a); }
#else
    a.ph_lo = 0; a.ph_hi = NPH;
    hipLaunchKernelGGL(fwd_kernel, dim3(grid), dim3(NTHR), LDS_BYTES, stream, a);
#endif
    const hipError_t le = hipPeekAtLastError();
    if (le != hipSuccess) fprintf(stderr, "kernel_launch: launch failed: %s\n", hipGetErrorName(le));
}
```

```cpp
#include <hip/hip_runtime.h>
#include <cstdio>
#include <cstdint>
#include <cstring>
#ifndef PROBE_DUP
#define PROBE_DUP 0
#endif
namespace pg8 {
#define PG8_LAS __attribute__((address_space(3)))
typedef unsigned short bf16_t;
typedef short bf16x8 __attribute__((ext_vector_type(8)));
typedef float f32x4 __attribute__((ext_vector_type(4)));
typedef unsigned u32x4 __attribute__((ext_vector_type(4)));
constexpr int BM = 256, BK = 64, HALF = 128, HTB = HALF * BK * 2  , STAGE_BYTES = 8 * HTB, NXCD = 8, WGM = 8;

__host__ __device__ __forceinline__ int lds_byte(int r, int c) { const int st = (r >> 4) * 2 + (c >> 5), rr = r & 15, cc = c & 31, ob = rr * 64 + cc * 2; return st * 1024 + (ob ^ (((ob >> 9) & 1) << 5)); }
__host__ __device__ __forceinline__ void stage_rc(int b, int& R, int& C) { const int st = b / 1024, sb = b % 1024, swz = sb ^ (((sb >> 9) & 1) << 5); R = (st >> 1) * 16 + swz / 64; C = (st & 1) * 32 + (swz % 64) / 2; }
__host__ __device__ __forceinline__ int perm32(int rho) { const int n = rho >> 4, i = rho & 15; return 8 * (i >> 2) + 4 * n + (i & 3); }

struct Unit { int pm, pn, ri; };
struct Gemm { const bf16_t* A; const bf16_t* Bt; int M, N, K; };

struct StaticOrder {
    int nM, nN, nwg, G, c, rep;
    __host__ __device__ void init(int M, int N, int G_, int c_, int rep_ = 1) { nM = M / BM; nN = N / BM; nwg = nM * nN; G = G_; c = c_; rep = rep_; }
    __host__ __device__ bool next(int i, Unit& u) const {
        const long L = (long)i * G + c; if (L >= (long)rep * nwg) return false;
        int wgid = (int)(L % nwg);
#if (PROBE_DUP >> 15) & 1
        if (L >= nwg) wgid = 0;
#endif
        { const int q = nwg / NXCD, r = nwg % NXCD, xcd = wgid % NXCD, off = wgid / NXCD; wgid = (xcd < r ? xcd * (q + 1) : r * (q + 1) + (xcd - r) * q) + off; }
        const int nig = WGM * nN, gid = wgid / nig, fm = gid * WGM, gsz = (nM - fm) < WGM ? (nM - fm) : WGM;
        u.pm = fm + ((wgid % nig) % gsz); u.pn = (wgid % nig) / gsz; u.ri = (int)(L / nwg); return true;
    }
    __device__ __forceinline__ void a_ready(const Unit&) const {}
    __device__ __forceinline__ void done(const Unit&) const {}
};

template <class Epi, class Sched, bool ALIGN_EPI = false, bool SP2 = false, bool A_TILED = false>
__device__ __forceinline__ void gemm_phase(PG8_LAS unsigned char* lds, const Gemm g, const Sched S, const Epi E, const int tid) {
    const int wid = __builtin_amdgcn_readfirstlane(tid >> 6), lane = tid & 63, wr = wid >> 2, wc = wid & 3, fr = lane & 15, fq = lane >> 4;
    const int K = g.K, nt = K / BK;
    unsigned voffA[2], voffB[2];
#pragma unroll
    for (int i = 0; i < 2; ++i) { int R, C; stage_rc(tid * 16 + i * 8192, R, C); const int Rb = Epi::PERM ? ((R & ~31) + perm32(R & 31)) : R;
        voffA[i] = A_TILED ? (unsigned)(tid * 16 + i * 8192) : (unsigned)(R * K + C) * 2u; voffB[i] = (unsigned)(tid * 16 + i * 8192); (void)Rb; }
    const size_t kstep = A_TILED ? (size_t)32768 : (size_t)(BK * 2);
    const size_t hstep = A_TILED ? (size_t)16384 : (size_t)HALF * K * 2;
    const size_t tstep = A_TILED ? (size_t)nt * 32768 : 2 * hstep;
    const size_t kstepB = 32768, hstepB = 16384, tstepB = (size_t)nt * 32768;
    const unsigned ldsw = (unsigned)wid * 1024u;
    const int aoff = lds_byte(wr * 64 + fr, fq * 8), boff = lds_byte(wc * 32 + fr, fq * 8);
#define PG8_SA(b, h) (((b) * 2 + (h)) * HTB)
#define PG8_SB(b, h) ((4 + (b) * 2 + (h)) * HTB)
#define PG8_STAGE(bufoff, gbase, voff) do { _Pragma("unroll") for (int _i = 0; _i < 2; ++_i) \
        __builtin_amdgcn_global_load_lds((const unsigned*)((const char*)(gbase) + (voff)[_i]), (PG8_LAS unsigned*)(lds + (bufoff) + ldsw + _i * 8192), 16, 0, 0); } while (0)
#define PG8_LDA(dst, b, h) do { _Pragma("unroll") for (int m = 0; m < 4; ++m) _Pragma("unroll") for (int k = 0; k < 2; ++k) dst[m][k] = *(const PG8_LAS bf16x8*)(lds + PG8_SA(b, h) + aoff + m * 2048 + k * 1024); } while (0)
#define PG8_LDB(dst, b, h) do { _Pragma("unroll") for (int n = 0; n < 2; ++n) _Pragma("unroll") for (int k = 0; k < 2; ++k) dst[n][k] = *(const PG8_LAS bf16x8*)(lds + PG8_SB(b, h) + boff + n * 2048 + k * 1024); } while (0)
#define PG8_MMA(ai, bj, At, Bt) do { __builtin_amdgcn_s_setprio(1); _Pragma("unroll") for (int m = 0; m < 4; ++m) _Pragma("unroll") for (int n = 0; n < 2; ++n) _Pragma("unroll") for (int k = 0; k < 2; ++k) \
        acc[ai][bj][m][n] = __builtin_amdgcn_mfma_f32_16x16x32_bf16(Bt[n][k], At[m][k], acc[ai][bj][m][n], 0, 0, 0); __builtin_amdgcn_s_setprio(0); } while (0)
#define PG8_WAIT_V(n) asm volatile("s_waitcnt vmcnt(" #n ")" ::: "memory")
#define PG8_WAIT_L(n) asm volatile("s_waitcnt lgkmcnt(" #n ")" ::: "memory")
#define PG8_BAR __builtin_amdgcn_s_barrier()
#define PG8_SCHED __builtin_amdgcn_sched_barrier(0)
    Unit cur, nxt; int ui = 0;
    if (!S.next(0, cur)) return;
    f32x4 acc[2][2][4][2];
#pragma unroll
    for (int a = 0; a < 2; ++a)
#pragma unroll
        for (int b = 0; b < 2; ++b)
#pragma unroll
            for (int m = 0; m < 4; ++m)
#pragma unroll
                for (int n = 0; n < 2; ++n) acc[a][b][m][n] = (f32x4){0.f, 0.f, 0.f, 0.f};
    bf16x8 At[4][2], B0[2][2], B1[2][2];
    const char* cA = (const char*)g.A + (size_t)cur.pm * tstep; const char* cB = (const char*)g.Bt + (size_t)cur.pn * tstepB;
    S.a_ready(cur);
    if constexpr (SP2) {
        PG8_STAGE(PG8_SB(0, 0), cB, voffB); PG8_STAGE(PG8_SB(0, 1), cB + hstepB, voffB); PG8_STAGE(PG8_SA(0, 0), cA, voffA); PG8_STAGE(PG8_SA(0, 1), cA + hstep, voffA);
        if (wr == 1) PG8_BAR;
        PG8_WAIT_V(2); PG8_BAR;
        PG8_STAGE(PG8_SB(1, 0), cB + kstepB, voffB); PG8_STAGE(PG8_SA(1, 0), cA + kstep, voffA); PG8_STAGE(PG8_SB(1, 1), cB + hstepB + kstepB, voffB);
        PG8_WAIT_V(6); PG8_BAR;
    } else {
        PG8_STAGE(PG8_SB(0, 0), cB, voffB); PG8_STAGE(PG8_SA(0, 0), cA, voffA); PG8_STAGE(PG8_SB(0, 1), cB + hstepB, voffB); PG8_STAGE(PG8_SA(0, 1), cA + hstep, voffA);
        if (wr == 1) PG8_BAR;
        PG8_WAIT_V(4); PG8_BAR;
        PG8_STAGE(PG8_SB(1, 0), cB + kstepB, voffB); PG8_STAGE(PG8_SA(1, 0), cA + kstep, voffA); PG8_STAGE(PG8_SB(1, 1), cB + hstepB + kstepB, voffB);
        PG8_WAIT_V(6); PG8_BAR;
    }
    for (;;) {
        const bool has_next = S.next(ui + 1, nxt);
        const char* nA = has_next ? (const char*)g.A + (size_t)nxt.pm * tstep : cA; const char* nB = has_next ? (const char*)g.Bt + (size_t)nxt.pn * tstepB : cB;
        for (int t = 0; t < nt; t += 2) {
            const bool last = (t == nt - 2);
            const char* a1 = cA + (size_t)(t + 1) * kstep;
            const char* a2 = last ? nA : cA + (size_t)(t + 2) * kstep; const char* b2 = last ? nB : cB + (size_t)(t + 2) * kstepB;
            const char* a3 = a2 + kstep; const char* b3 = b2 + kstepB;
            if (last && has_next) S.a_ready(nxt);
            if constexpr (Epi::HAS_MID) { if (t == 8 || t == 12 || t == 20) E.mid(acc, cur, t, wr, wc, fr, fq); }
            if constexpr (SP2) {
            PG8_LDB(B0, 0, 0); PG8_LDB(B1, 0, 1); PG8_SCHED; PG8_LDA(At, 0, 0); PG8_STAGE(PG8_SA(1, 1), a1 + hstep, voffA);
            PG8_WAIT_V(8); PG8_WAIT_L(0); PG8_BAR; PG8_MMA(0, 0, At, B0); PG8_MMA(0, 1, At, B1); PG8_BAR; PG8_SCHED;
            PG8_LDA(At, 0, 1); PG8_STAGE(PG8_SB(0, 0), b2, voffB); PG8_STAGE(PG8_SB(0, 1), b2 + hstepB, voffB); PG8_STAGE(PG8_SA(0, 0), a2, voffA);
            PG8_WAIT_V(8); PG8_WAIT_L(0); PG8_BAR; PG8_MMA(1, 0, At, B0); PG8_MMA(1, 1, At, B1); PG8_BAR; PG8_SCHED;
            PG8_LDB(B0, 1, 0); PG8_LDB(B1, 1, 1); PG8_SCHED; PG8_LDA(At, 1, 0); PG8_STAGE(PG8_SA(0, 1), a2 + hstep, voffA);
            PG8_WAIT_V(8); PG8_WAIT_L(0); PG8_BAR; PG8_MMA(0, 0, At, B0); PG8_MMA(0, 1, At, B1); PG8_BAR; PG8_SCHED;
            PG8_LDA(At, 1, 1); PG8_STAGE(PG8_SB(1, 0), b3, voffB); PG8_STAGE(PG8_SB(1, 1), b3 + hstepB, voffB); PG8_STAGE(PG8_SA(1, 0), a3, voffA);
            PG8_WAIT_V(8); PG8_WAIT_L(0); PG8_BAR; PG8_MMA(1, 0, At, B0); PG8_MMA(1, 1, At, B1); PG8_BAR; PG8_SCHED;
            } else {
            PG8_LDB(B0, 0, 0); PG8_SCHED; PG8_LDA(At, 0, 0); PG8_STAGE(PG8_SA(1, 1), a1 + hstep, voffA);
            PG8_WAIT_L(8); PG8_BAR; PG8_WAIT_L(0); PG8_MMA(0, 0, At, B0); PG8_BAR; PG8_SCHED;
            PG8_LDB(B1, 0, 1); PG8_STAGE(PG8_SB(0, 0), b2, voffB);
            PG8_BAR; PG8_WAIT_L(0); PG8_MMA(0, 1, At, B1); PG8_BAR;
            PG8_LDA(At, 0, 1); PG8_STAGE(PG8_SA(0, 0), a2, voffA);
            PG8_BAR; PG8_WAIT_L(0); PG8_MMA(1, 0, At, B0); PG8_BAR; PG8_SCHED;
            PG8_STAGE(PG8_SB(0, 1), b2 + hstepB, voffB);
            PG8_WAIT_V(6); PG8_BAR; PG8_MMA(1, 1, At, B1); PG8_BAR;
            PG8_LDB(B0, 1, 0); PG8_SCHED; PG8_LDA(At, 1, 0); PG8_STAGE(PG8_SA(0, 1), a2 + hstep, voffA);
            PG8_WAIT_L(8); PG8_BAR; PG8_WAIT_L(0); PG8_MMA(0, 0, At, B0); PG8_BAR; PG8_SCHED;
            PG8_LDB(B1, 1, 1); PG8_STAGE(PG8_SB(1, 0), b3, voffB);
            PG8_BAR; PG8_WAIT_L(0); PG8_MMA(0, 1, At, B1); PG8_BAR;
            PG8_LDA(At, 1, 1); PG8_STAGE(PG8_SA(1, 0), a3, voffA);
            PG8_BAR; PG8_WAIT_L(0); PG8_MMA(1, 0, At, B0); PG8_BAR; PG8_SCHED;
            PG8_STAGE(PG8_SB(1, 1), b3 + hstepB, voffB);
            PG8_WAIT_V(6); PG8_BAR; PG8_MMA(1, 1, At, B1); PG8_BAR;
            }
        }
        if constexpr (ALIGN_EPI) { if (wr == 0) PG8_BAR; }
        if constexpr (!Epi::AFTER_DRAIN) { E(acc, cur, wr, wc, fr, fq); S.done(cur); }
        if (!has_next) break;
#pragma unroll
        for (int a = 0; a < 2; ++a)
#pragma unroll
            for (int b = 0; b < 2; ++b)
#pragma unroll
                for (int m = 0; m < 4; ++m)
#pragma unroll
                    for (int n = 0; n < 2; ++n) acc[a][b][m][n] = (f32x4){0.f, 0.f, 0.f, 0.f};
        cur = nxt; cA = nA; cB = nB; ++ui;
        if constexpr (ALIGN_EPI) { if (wr == 1) PG8_BAR; }
    }
    PG8_WAIT_V(0);
    if constexpr (!ALIGN_EPI) { if (wr == 0) PG8_BAR; }
    PG8_BAR;
    if constexpr (Epi::AFTER_DRAIN) { E.fused(acc, cur, wr, wc, fr, fq, lds, wid, lane); S.done(cur); }
#undef PG8_SA
#undef PG8_SB
#undef PG8_STAGE
#undef PG8_LDA
#undef PG8_LDB
#undef PG8_MMA
#undef PG8_WAIT_V
#undef PG8_WAIT_L
#undef PG8_BAR
#undef PG8_SCHED
}
}

constexpr int DM = 2048, DFF = 5504, DEPTH = 4;
constexpr int SEQ = 4096, NB_P = 2, MP = NB_P * SEQ;
constexpr int NB_S = 8, TS = 4, MS = NB_S * TS;
constexpr int MR = MP + MS;
constexpr int MPAD = 8448;
constexpr int PAST = 16384;
constexpr int N_IN = 14096, NWIN = 14336;
constexpr int NGU = 2 * DFF;
constexpr float EPS = 1e-6f;
constexpr int NWAVES = 8, NTHR = 512;

constexpr int C_CB = 0, C_CC = 512, C_CH = 1024, C_AQ = 1536, C_AK = 2304, C_AV = 3072, C_GQ = 3840, C_GK = 4096, C_GV = 4352, C_GR = 4864, C_LR = 5376, C_PIN = 5392, C_GATE = 5904;
constexpr int T_CONV = 0, T_CB = 4, T_Q = 6, T_K = 9, T_V = 12, T_GQ = 15, T_GK = 16, T_GV = 17, T_GR = 19, T_Z = 21, T_PIN = 22, T_GATE = 24;

constexpr int OFF_YP = 0;
constexpr int OFF_YS = OFF_YP + MP * DM;
constexpr int OFF_CONV_P = OFF_YS + MS * DM;
constexpr int OFF_CONV_S = OFF_CONV_P + DEPTH * NB_P * 2 * 512;
constexpr int OFF_W128_P = OFF_CONV_S + DEPTH * NB_S * 2 * 512;
constexpr int OFF_W128_S = OFF_W128_P + DEPTH * NB_P * 128 * 512;
constexpr int OFF_W512_P = OFF_W128_S + DEPTH * NB_S * 128 * 512;
constexpr int OFF_W512_S = OFF_W512_P + DEPTH * NB_P * 512 * 512;
constexpr int OFF_W2048_P = OFF_W512_S + DEPTH * NB_S * 512 * 512;
constexpr int OFF_W2048_S = OFF_W2048_P + DEPTH * NB_P * 2048 * 512;
constexpr int OFF_GLA_P = OFF_W2048_S + DEPTH * NB_S * 2048 * 512;
constexpr int OFF_GLA_S = OFF_GLA_P + DEPTH * NB_P * 4 * 64 * 128;
constexpr int OFF_POOL_P = OFF_GLA_S + DEPTH * NB_S * 4 * 64 * 128;
constexpr int OFF_POOL_S = OFF_POOL_P + DEPTH * NB_P * 15 * 512;
constexpr int OUT_TOTAL = OFF_POOL_S + DEPTH * NB_S * 15 * 512;
static_assert(OUT_TOTAL == 73551872, "output size");

constexpr size_t MiB = 1u << 20;
constexpr size_t WS_CTL = 0, CTL_ZERO_BYTES = 1 * MiB;
constexpr size_t SZ_ROW2K_F32 = (size_t)MPAD * DM * 4, SZ_ROW2K_BF = (size_t)MPAD * DM * 2;
constexpr size_t WS_X = WS_CTL + CTL_ZERO_BYTES;
constexpr size_t WS_XN = WS_X + SZ_ROW2K_F32;
constexpr size_t WS_H = WS_XN + SZ_ROW2K_BF;
constexpr size_t WS_CB = WS_H + (size_t)MPAD * DFF * 2;
constexpr size_t WS_U = WS_CB + (size_t)MPAD * 512 * 2;
constexpr size_t WS_Q = WS_U + (size_t)MPAD * 512 * 2;
constexpr size_t WS_K = WS_Q + (size_t)MPAD * 768 * 2;
constexpr size_t WS_V = WS_K + (size_t)MPAD * 768 * 2;
constexpr size_t WS_GQ = WS_V + (size_t)MPAD * 768 * 2;
constexpr size_t WS_GK = WS_GQ + (size_t)MPAD * 256 * 2;
constexpr size_t WS_GV = WS_GK + (size_t)MPAD * 256 * 2;
constexpr size_t WS_GR = WS_GV + (size_t)MPAD * 512 * 2;
constexpr size_t WS_LA = WS_GR + (size_t)MPAD * 512 * 2;
constexpr size_t WS_PIN = WS_LA + (size_t)MPAD * 256 * 4;
constexpr size_t WS_GATE = WS_PIN + (size_t)MPAD * 512 * 2;
constexpr int YK = 1792, YO_A = 0, YO_B = 512, YO_C = 768, YO_D = 1280;
constexpr size_t WS_YCAT = WS_GATE + (size_t)MPAD * 8192 * 2;
constexpr size_t WS_AO = WS_YCAT + (size_t)MPAD * YK * 2;
constexpr size_t WS_LSE = WS_AO + (size_t)MPAD * 768 * 4;
constexpr size_t WS_DS = WS_LSE + (size_t)MPAD * 12 * 4;
constexpr size_t WS_DEC = WS_DS + (size_t)8 * 64 * 64 * 128 * 4;
constexpr size_t WS_SP = WS_DEC + (size_t)8 * 64 * 64 * 4;
constexpr size_t WS_PM = WS_SP + (size_t)8 * 64 * 64 * 128 * 2;
constexpr size_t WS_MRG = WS_PM + (size_t)(MPAD - MP) * DM * 4;
constexpr size_t WS_W = WS_MRG + SZ_ROW2K_BF;
constexpr size_t WE_GU1 = 0;
constexpr size_t WE_D1 = WE_GU1 + (size_t)NGU * DM;
constexpr size_t WE_IN = WE_D1 + (size_t)DM * DFF;
constexpr size_t WE_UPCAT = WE_IN + (size_t)NWIN * DM;
constexpr size_t WE_OUT = WE_UPCAT + (size_t)DM * YK;
constexpr size_t WE_GU2 = WE_OUT + (size_t)DM * DM;
constexpr size_t WE_D2 = WE_GU2 + (size_t)NGU * DM;
constexpr size_t WE_LAYER = WE_D2 + (size_t)DM * DFF;
static_assert(WE_LAYER == 104857600, "layer weights");
constexpr size_t WS_END = WS_W + (size_t)DEPTH * WE_LAYER * 2;
static_assert(WS_X % 256 == 0 && WS_W % 256 == 0 && WS_LSE % 256 == 0 && WS_DS % 256 == 0, "alignment");

constexpr int CW_BAR = 4096;
constexpr size_t CTL_SS = 65536;
constexpr float SS_FIX = 16777216.0f;
static_assert(CTL_SS + 12 * (size_t)MPAD * 8 <= CTL_ZERO_BYTES, "SS fits the zeroed control region");

constexpr int RING_OFF = 0, RING_BYTES = 131072;
constexpr int LDSCTL_OFF = RING_BYTES, MISC_OFF = LDSCTL_OFF + 320;
constexpr int LDS_BYTES = 147456;

#define GAS __attribute__((address_space(1)))
#define LAS __attribute__((address_space(3)))
#define GAS __attribute__((address_space(1)))
typedef unsigned short bf16;
typedef unsigned u32x4 __attribute__((ext_vector_type(4)));
typedef unsigned u32x2 __attribute__((ext_vector_type(2)));
typedef float f32x4 __attribute__((ext_vector_type(4)));
typedef float f32x2 __attribute__((ext_vector_type(2)));
typedef short bf16x8 __attribute__((ext_vector_type(8)));
typedef short s16x4 __attribute__((ext_vector_type(4)));
#define LDS_WAIT() asm volatile("s_waitcnt lgkmcnt(0)" ::: "memory")
#define VM_WAIT() asm volatile("s_waitcnt vmcnt(0)" ::: "memory")
__device__ __forceinline__ unsigned f2bf(float f) { unsigned u = __builtin_bit_cast(unsigned, f); return (u + 0x7fffu + ((u >> 16) & 1u)) >> 16; }
__device__ __forceinline__ unsigned pk2(float lo, float hi) { return f2bf(lo) | (f2bf(hi) << 16); }
__device__ __forceinline__ float bflo(unsigned w) { return __builtin_bit_cast(float, w << 16); }
__device__ __forceinline__ float bfhi(unsigned w) { return __builtin_bit_cast(float, w & 0xffff0000u); }
__device__ __forceinline__ float bf2f(bf16 b) { return __builtin_bit_cast(float, ((unsigned)b) << 16); }
__device__ __forceinline__ u32x4 pk8(f32x4 a, f32x4 b) { u32x4 w; w.x = pk2(a[0], a[1]); w.y = pk2(a[2], a[3]); w.z = pk2(b[0], b[1]); w.w = pk2(b[2], b[3]); return w; }
__device__ __forceinline__ void unpk8(u32x4 w, float (&f)[8]) { f[0] = bflo(w.x); f[1] = bfhi(w.x); f[2] = bflo(w.y); f[3] = bfhi(w.y); f[4] = bflo(w.z); f[5] = bfhi(w.z); f[6] = bflo(w.w); f[7] = bfhi(w.w); }
__device__ __forceinline__ float sigmoidf_(float x) { return __builtin_amdgcn_rcpf(1.0f + __expf(-x)); }
__device__ __forceinline__ float siluf_(float x) { return x * sigmoidf_(x); }
__device__ __forceinline__ float shx(float v, int m, int lane) { return __builtin_bit_cast(float, __builtin_amdgcn_ds_bpermute((lane ^ m) << 2, __builtin_bit_cast(int, v))); }
__device__ __forceinline__ float rdl(float v, int j) { return __builtin_bit_cast(float, __builtin_amdgcn_readlane(__builtin_bit_cast(int, v), j)); }
__device__ __forceinline__ float wave_sum(float v, int lane) {
#pragma unroll
    for (int o = 1; o < 64; o <<= 1) v += shx(v, o, lane);
    return v;
}
__device__ __forceinline__ float wave_max(float v, int lane) {
#pragma unroll
    for (int o = 1; o < 64; o <<= 1) v = fmaxf(v, shx(v, o, lane));
    return v;
}
__device__ __forceinline__ int win_of(int gi) { return 128 << (2 * gi); }
__device__ __forceinline__ int dil_of(int gi) { return 1 << (2 * gi); }
__device__ __forceinline__ int offw_p(int gi) { return gi == 0 ? OFF_W128_P : (gi == 1 ? OFF_W512_P : OFF_W2048_P); }
__device__ __forceinline__ int offw_s(int gi) { return gi == 0 ? OFF_W128_S : (gi == 1 ? OFF_W512_S : OFF_W2048_S); }

#define XB_TMO      128
#define XB_XCNT(j)  (256  + 64 * (j))
#define XB_XSUB(j)  (1280 + 64 * (j))
#define XB_XGEN(j)  (2304 + 64 * (j))
#define XB_TOP      3328
#define XB_TOPGEN   3392
#define XCD_BAR_WORDS 3456
#define XB_SPIN_CAP (1u << 18)

__device__ __forceinline__ unsigned xb_ld(unsigned* p)              { return __hip_atomic_load(p, __ATOMIC_RELAXED, __HIP_MEMORY_SCOPE_AGENT); }
__device__ __forceinline__ unsigned xb_add(unsigned* p, unsigned v) { return __hip_atomic_fetch_add(p, v, __ATOMIC_RELAXED, __HIP_MEMORY_SCOPE_AGENT); }
__device__ __forceinline__ unsigned xb_xcc_id() { return (unsigned)__builtin_amdgcn_s_getreg((3 << 11) | 20) & 0xFu; }
#define XB_SPIN(cond, bar) do { unsigned _sp = 0; while (cond) { __builtin_amdgcn_s_sleep(1); \
    if ((++_sp & 255u) == 0u) { if (xb_ld(&(bar)[XB_TMO])) break; if (_sp > XB_SPIN_CAP) { atomicAdd(&(bar)[XB_TMO], 1u); break; } } } } while (0)

struct XcdBarrier {
    unsigned* bar; unsigned x;
    volatile LAS unsigned* st;
};
__device__ __forceinline__ XcdBarrier xcd_barrier_post(unsigned* bar, volatile LAS unsigned* st) {
    XcdBarrier b; b.bar = bar; b.x = xb_xcc_id(); b.st = st;
    if (threadIdx.x == 0) (void)xb_add(&bar[XB_XCNT(b.x)], 1u);
    return b;
}
__device__ __forceinline__ void xcd_barrier_complete(unsigned* bar, unsigned x, unsigned& nloc, unsigned& nx) {
    const unsigned G = gridDim.x * gridDim.y * gridDim.z;
    unsigned sum, cnt, mine, sp = 0u;
    for (;;) {
        sum = 0u; cnt = 0u; mine = 0u;
#pragma unroll
        for (unsigned j = 0; j < 16; ++j) { const unsigned c = xb_ld(&bar[XB_XCNT(j)]); sum += c; cnt += (c > 0u) ? 1u : 0u; mine = (j == x) ? c : mine; }
        if (sum == G) break;
        __builtin_amdgcn_s_sleep(1);
        if ((++sp & 255u) == 0u) { if (xb_ld(&bar[XB_TMO])) break; if (sp > XB_SPIN_CAP) { atomicAdd(&bar[XB_TMO], 1u); break; } }
    }
    nloc = mine > 0u ? mine : 1u; nx = cnt > 0u ? cnt : 1u;
}
__device__ __forceinline__ void xcd_barrier(const XcdBarrier& b, const int tid) {
    asm volatile("s_waitcnt vmcnt(0)" ::: "memory");
    __syncthreads();
    if (tid == 0) {
        unsigned* bar = b.bar;
        __builtin_amdgcn_s_waitcnt(0);
        unsigned nloc = b.st[0], nx = b.st[1];
        if (nloc == 0u) { xcd_barrier_complete(bar, b.x, nloc, nx); b.st[0] = nloc; b.st[1] = nx; }
        const unsigned old = xb_add(&bar[XB_XSUB(b.x)], 1u);
        const unsigned gen = old / nloc;
        if (old + 1u == (gen + 1u) * nloc) {
            __builtin_amdgcn_fence(__ATOMIC_RELEASE, "agent");
            asm volatile("s_waitcnt vmcnt(0)" ::: "memory");
            const unsigned og = xb_add(&bar[XB_TOP], 1u);
            const unsigned tg = og / nx;
            if (og + 1u == (tg + 1u) * nx) xb_add(&bar[XB_TOPGEN], 1u);
            else XB_SPIN(xb_ld(&bar[XB_TOPGEN]) == tg, bar);
            __builtin_amdgcn_fence(__ATOMIC_ACQUIRE, "agent");
            xb_add(&bar[XB_XGEN(b.x)], 1u);
            asm volatile("s_waitcnt vmcnt(0)" ::: "memory");
        } else {
            XB_SPIN(xb_ld(&bar[XB_XGEN(b.x)]) == gen, bar);
            __builtin_amdgcn_fence(__ATOMIC_ACQUIRE, "agent");
            asm volatile("s_waitcnt vmcnt(0)" ::: "memory");
        }
    }
    __syncthreads();
}

constexpr int PT_OFF = LDSCTL_OFF;
constexpr int PT_OUT = 31, PT_WS = 32;
__device__ __forceinline__ const float* ldp(LAS unsigned char* lds, int i) {
    const unsigned long long v = *(volatile LAS unsigned long long*)(lds + PT_OFF + 8 * i);
    const unsigned lo = __builtin_amdgcn_readfirstlane((unsigned)v), hi = __builtin_amdgcn_readfirstlane((unsigned)(v >> 32));
    return (const float*)(const GAS float*)(((unsigned long long)hi << 32) | lo);
}

typedef f32x4 (&AccRef)[2][2][4][2];

__device__ __forceinline__ void row_decode(int row, int& kind, int& b, int& t) {
    if (row < MP) { kind = 0; b = row >> 12; t = row & 4095; }
    else if (row < MR) { kind = 1; b = (row - MP) >> 2; t = (row - MP) & 3; }
    else { kind = 2; b = 0; t = 0; }
}


#ifndef EPI_NT
#define EPI_NT 0
#endif
#if EPI_NT
#define EPI_ST(ptr, val) __builtin_nontemporal_store((val), (ptr))
#else
#define EPI_ST(ptr, val) (*(ptr) = (val))
#endif
typedef _Float16 h16x4 __attribute__((ext_vector_type(4)));
typedef _Float16 h16x8 __attribute__((ext_vector_type(8)));
constexpr size_t RAT_STRIDE = (size_t)MPAD * DM;

template <bool SK> __device__ __forceinline__ void scale_rows_rstd(AccRef acc, const unsigned long long* ss, int row0) {
#pragma unroll
    for (int ai = 0; ai < (SK ? 1 : 2); ++ai)
#pragma unroll
        for (int m = 0; m < (SK ? 2 : 4); ++m) {
            const float r = rsqrtf((float)ss[row0 + ai * 128 + m * 16] * (1.0f / (SS_FIX * DM)) + EPS);
#pragma unroll
            for (int bj = 0; bj < 2; ++bj)
#pragma unroll
                for (int n = 0; n < 2; ++n) acc[ai][bj][m][n] *= r;
        }
}

struct EpiSwiGLU {
    static constexpr bool PERM = false, AFTER_DRAIN = false, HAS_MID = false;
    unsigned char* ws; int nid;
    __device__ __forceinline__ void operator()(AccRef acc, const pg8::Unit& u, int wr, int wc, int fr, int fq) const { run<false>(acc, u, wr, wc, fr, fq); }
    template <bool SK> __device__ __forceinline__ void run(AccRef acc, const pg8::Unit& u, int wr, int wc, int fr_, int fq_) const {
        int fr = fr_, fq = fq_; asm volatile("" : "+v"(fr), "+v"(fq));
        bf16* H = (bf16*)(ws + WS_H);
        const int row0 = u.pm * 256 + wr * 64 + fr, col0 = u.pn * 128 + wc * 32 + 8 * fq;
        scale_rows_rstd<SK>(acc, (const unsigned long long*)(ws + WS_CTL + CTL_SS) + (size_t)nid * MPAD, row0);
#pragma unroll
        for (int ai = 0; ai < (SK ? 1 : 2); ++ai)
#pragma unroll
            for (int m = 0; m < (SK ? 2 : 4); ++m) {
                bf16* p = SK ? H + (size_t)(row0 + ai * 128 + m * 16) * DFF + col0
                             : (bf16*)((char*)H + ((size_t)(u.pm * (DFF / 64) + 2 * u.pn + (wc >> 1)) * 2 + ai) * 16384 + ((4 * wr + m) * 2 + (wc & 1)) * 1024 + ((fr * 64 + 16 * fq) ^ ((fr >> 3) << 5)));
                f32x4 h0, h1;
#pragma unroll
                for (int j = 0; j < 4; ++j) { h0[j] = siluf_(acc[ai][0][m][0][j]) * acc[ai][1][m][0][j]; h1[j] = siluf_(acc[ai][0][m][1][j]) * acc[ai][1][m][1][j]; }
                EPI_ST((u32x4*)p, pk8(h0, h1));
            }
    }
};

struct EpiResid {
    static constexpr bool PERM = false, AFTER_DRAIN = false, HAS_MID = false;
    unsigned char* ws; LAS unsigned char* lds; float scale; int fin; int nid;
    __device__ __forceinline__ void operator()(AccRef acc, const pg8::Unit& u, int wr, int wc, int fr, int fq) const { run<false>(acc, u, wr, wc, fr, fq); }
    template <bool SK> __device__ __forceinline__ void run(AccRef acc, const pg8::Unit& u, int wr, int wc, int fr_, int fq_) const {
        int fr = fr_, fq = fq_; asm volatile("" : "+v"(fr), "+v"(fq));
        bf16* XB = (bf16*)(ws + WS_XN);
        unsigned long long* ssp = (unsigned long long*)(ws + WS_CTL + CTL_SS) + (size_t)(nid < 0 ? 0 : nid) * MPAD;
        float* out = fin ? (float*)ldp(lds, PT_OUT) : nullptr;
        const float scale = (u.ri == 0) ? this->scale : 0.f; const int nid = (u.ri == 0) ? this->nid : -1;
        const int row0 = u.pm * 256 + wr * 64 + fr, col0 = u.pn * 256 + wc * 32 + 8 * fq;
#pragma unroll
        for (int ai = 0; ai < (SK ? 1 : 2); ++ai)
#pragma unroll
            for (int m = 0; m < (SK ? 2 : 4); ++m) {
                const int row = row0 + ai * 128 + m * 16;
                char* xr = (char*)XB + (SK ? ((size_t)row * DM + col0) * 2
                                           : ((size_t)(u.pm * (DM / 64) + 4 * u.pn + (wc >> 1)) * 2 + ai) * 16384 + ((4 * wr + m) * 2 + (wc & 1)) * 1024 + ((fr * 64 + 16 * fq) ^ ((fr >> 3) << 5)));
                constexpr size_t BJS = SK ? 256 : 65536;
                float sq = 0.f;
#pragma unroll
                for (int bj = 0; bj < 2; ++bj) {
                    float xo[8]; unpk8(*(const u32x4*)(xr + bj * BJS), xo);
                    f32x4 v0, v1;
#pragma unroll
                    for (int j = 0; j < 4; ++j) { v0[j] = xo[j] + scale * acc[ai][bj][m][0][j]; v1[j] = xo[4 + j] + scale * acc[ai][bj][m][1][j]; }
                    if (out != nullptr && row < MR) { float* o = out + (size_t)row * DM + col0 + bj * 128; *(f32x4*)o = v0; *(f32x4*)(o + 4) = v1; }
                    const u32x4 w = pk8(v0, v1);
                    EPI_ST((u32x4*)(xr + bj * BJS), w);
                    float xn[8]; unpk8(w, xn);
#pragma unroll
                    for (int j = 0; j < 8; ++j) sq += xn[j] * xn[j];
                }
                { const int ln = fq * 16 + fr; sq += shx(sq, 16, ln); sq += shx(sq, 32, ln); }
                if (nid >= 0 && fq == 0) atomicAdd(ssp + row, (unsigned long long)(sq * SS_FIX + 0.5f));
            }
    }
};

struct EpiMergeCat {
    static constexpr bool PERM = false, AFTER_DRAIN = false, HAS_MID = true;
    unsigned char* ws;
    __device__ __forceinline__ void apply(f32x4 (&acc)[2][2][4][2], const pg8::Unit& u, int s, int wr, int wc, int fr_, int fq_) const {
        int fr = fr_, fq = fq_; asm volatile("" : "+v"(fr), "+v"(fq));
        const _Float16* R = (const _Float16*)(ws + WS_GATE) + (size_t)s * RAT_STRIDE;
        const int row0 = u.pm * 256 + wr * 64 + fr, col0 = u.pn * 256 + wc * 32 + 8 * fq;
        h16x8 r[2][4][2];
#pragma unroll
        for (int ai = 0; ai < 2; ++ai)
#pragma unroll
            for (int m = 0; m < 4; ++m)
#pragma unroll
                for (int bj = 0; bj < 2; ++bj) r[ai][m][bj] = *(const h16x8*)(R + (size_t)(row0 + ai * 128 + m * 16) * DM + col0 + bj * 128);
#pragma unroll
        for (int ai = 0; ai < 2; ++ai)
#pragma unroll
            for (int m = 0; m < 4; ++m)
#pragma unroll
                for (int bj = 0; bj < 2; ++bj)
#pragma unroll
                    for (int j = 0; j < 4; ++j) { acc[ai][bj][m][0][j] *= (float)r[ai][m][bj][j]; acc[ai][bj][m][1][j] *= (float)r[ai][m][bj][4 + j]; }
    }
    __device__ __forceinline__ void mid(f32x4 (&acc)[2][2][4][2], const pg8::Unit& u, int t, int wr, int wc, int fr, int fq) const {
        apply(acc, u, (t == 8) ? 0 : (t == 12 ? 1 : 2), wr, wc, fr, fq);
    }
    __device__ __forceinline__ void operator()(AccRef acc, const pg8::Unit& u, int wr, int wc, int fr_, int fq_) const {
        apply(acc, u, 3, wr, wc, fr_, fq_);
        int fr = fr_, fq = fq_; asm volatile("" : "+v"(fr), "+v"(fq));
        bf16* MRG = (bf16*)(ws + WS_MRG);
        const int row0 = u.pm * 256 + wr * 64 + fr, col0 = u.pn * 256 + wc * 32 + 8 * fq;
#pragma unroll
        for (int ai = 0; ai < 2; ++ai)
#pragma unroll
            for (int m = 0; m < 4; ++m)
#pragma unroll
                for (int bj = 0; bj < 2; ++bj)
                    EPI_ST((u32x4*)((char*)MRG + ((size_t)(u.pm * (DM / 64) + 4 * u.pn + 2 * bj + (wc >> 1)) * 2 + ai) * 16384 + ((4 * wr + m) * 2 + (wc & 1)) * 1024 + ((fr * 64 + 16 * fq) ^ ((fr >> 3) << 5))),
                           pk8(acc[ai][bj][m][0], acc[ai][bj][m][1]));
    }
};
template <int MODE>
struct EpiMergeS {
    static constexpr bool PERM = false, AFTER_DRAIN = false, HAS_MID = false;
    unsigned char* ws; int br;
    template <bool SK> __device__ __forceinline__ void run(AccRef acc, const pg8::Unit& u, int wr, int wc, int fr, int fq) const {
        float* P = (float*)(ws + WS_PM); bf16* MRG = (bf16*)(ws + WS_MRG);
        const int row0 = u.pm * 256 + wr * 64 + fr, col0 = u.pn * 256 + wc * 32 + 8 * fq;
#pragma unroll
        for (int m = 0; m < 2; ++m) {
            const int row = row0 + m * 16;
#pragma unroll
            for (int bj = 0; bj < 2; ++bj) {
                const int c = col0 + bj * 128;
                float g[8];
                { const _Float16* R = (const _Float16*)(ws + WS_GATE) + (size_t)row * DM + c;
                  const h16x8 r3 = *(const h16x8*)(R + 3 * RAT_STRIDE);
#pragma unroll
                  for (int j = 0; j < 8; ++j) g[j] = (float)r3[j];
#pragma unroll
                  for (int s = 2; s >= 0; --s) if (s >= br) { const h16x8 rs = *(const h16x8*)(R + (size_t)s * RAT_STRIDE);
#pragma unroll
                      for (int j = 0; j < 8; ++j) g[j] *= (float)rs[j]; } }
                f32x4 v0, v1;
#pragma unroll
                for (int j = 0; j < 4; ++j) { v0[j] = g[j] * acc[0][bj][m][0][j]; v1[j] = g[4 + j] * acc[0][bj][m][1][j]; }
                float* pp = P + (size_t)(row - MP) * DM + c;
                if (MODE != 0) { v0 += *(const f32x4*)pp; v1 += *(const f32x4*)(pp + 4); }
                if (MODE == 2) *(u32x4*)(MRG + (size_t)row * DM + c) = pk8(v0, v1);
                else { *(f32x4*)pp = v0; *(f32x4*)(pp + 4) = v1; }
            }
        }
    }
};

struct EpiWin {
    static constexpr bool PERM = false, AFTER_DRAIN = false, HAS_MID = false;
    unsigned char* ws;
    const float *qgain, *kgain, *b_a;
    float* out; int layer; int nid;

    template <int ACT, bool SK>
    __device__ __forceinline__ void plain(AccRef acc, bf16* dst, int ldc, int cbase, int row0, int wc, int fq) const {
#pragma unroll
        for (int ai = 0; ai < (SK ? 1 : 2); ++ai)
#pragma unroll
            for (int m = 0; m < (SK ? 2 : 4); ++m) {
                bf16* p = dst + (size_t)(row0 + ai * 128 + m * 16) * ldc + cbase + wc * 32 + fq * 8;
#pragma unroll
                for (int bj = 0; bj < 2; ++bj) {
                    f32x4 v0 = acc[ai][bj][m][0], v1 = acc[ai][bj][m][1];
#pragma unroll
                    for (int j = 0; j < 4; ++j) {
                        if (ACT == 1) { v0[j] = sigmoidf_(v0[j]); v1[j] = sigmoidf_(v1[j]); }
                        if (ACT == 2) { v0[j] = siluf_(v0[j]); v1[j] = siluf_(v1[j]); }
                        if (ACT == 3) { v0[j] *= 0.125f; v1[j] *= 0.125f; }
                    }
                    EPI_ST((u32x4*)(p + bj * 128), pk8(v0, v1));
                }
            }
    }

    __device__ __forceinline__ void operator()(AccRef acc, const pg8::Unit& u, int wr, int wc, int fr, int fq) const { run<false>(acc, u, wr, wc, fr, fq); }
    template <bool SK> __device__ __forceinline__ void run(AccRef acc, const pg8::Unit& u, int wr, int wc, int fr_, int fq_) const {
        int fr = fr_, fq = fq_; asm volatile("" : "+v"(fr), "+v"(fq));
        const int pn = u.pn, row0 = u.pm * 256 + wr * 64 + fr, l = layer;
        scale_rows_rstd<SK>(acc, (const unsigned long long*)(ws + WS_CTL + CTL_SS) + (size_t)nid * MPAD, row0);
        if (pn < T_CB) {
            const int ch0 = 128 * pn + 32 * wc + 8 * fq;
#pragma unroll
            for (int ai = 0; ai < (SK ? 1 : 2); ++ai)
#pragma unroll
                for (int m = 0; m < (SK ? 2 : 4); ++m) {
                    const int row = row0 + ai * 128 + m * 16;
                    const f32x4 u0 = acc[ai][0][m][0] * acc[ai][1][m][0], u1 = acc[ai][0][m][1] * acc[ai][1][m][1];
                    *(u32x4*)((bf16*)(ws + WS_U) + (size_t)row * 512 + ch0) = pk8(u0, u1);
                    int kind, b, t; row_decode(row, kind, b, t);
                    if (kind == 0 && t >= SEQ - 2) { float* o = out + OFF_CONV_P + ((l * NB_P + b) * 2 + (t - (SEQ - 2))) * 512 + ch0; *(f32x4*)o = u0; *(f32x4*)(o + 4) = u1; }
                    if (kind == 1 && t >= TS - 2)  { float* o = out + OFF_CONV_S + ((l * NB_S + b) * 2 + (t - (TS - 2))) * 512 + ch0; *(f32x4*)o = u0; *(f32x4*)(o + 4) = u1; }
                }
        } else if (pn < T_Q) {
            plain<0, SK>(acc, (bf16*)(ws + WS_CB), 512, 256 * (pn - T_CB), row0, wc, fq);
        } else if (pn < T_V) {
            const bool isk = pn >= T_K; const int ti = isk ? pn - T_K : pn - T_Q; const int head = 4 * ti + wc;
            const float* gp = (isk ? kgain : qgain) + head * 64 + 8 * fq;
            f32x4 g[2][2];
#pragma unroll
            for (int bj = 0; bj < 2; ++bj) { g[bj][0] = *(const f32x4*)(gp + 32 * bj); g[bj][1] = *(const f32x4*)(gp + 32 * bj + 4); }
            bf16* dst = (bf16*)(ws + (isk ? WS_K : WS_Q));
            const int W = win_of(ti);
#pragma unroll
            for (int ai = 0; ai < (SK ? 1 : 2); ++ai)
#pragma unroll
                for (int m = 0; m < (SK ? 2 : 4); ++m) {
                    const int row = row0 + ai * 128 + m * 16;
                    float ss = 0.f;
#pragma unroll
                    for (int bj = 0; bj < 2; ++bj)
#pragma unroll
                        for (int n = 0; n < 2; ++n) { const f32x4 x = acc[ai][bj][m][n]; ss += (x[0] * x[0] + x[1] * x[1]) + (x[2] * x[2] + x[3] * x[3]); }
                    { const int ln = fq * 16 + fr; ss += shx(ss, 16, ln); ss += shx(ss, 32, ln); }
                    const float rs = rsqrtf(ss * (1.0f / 64.0f) + EPS);
                    int kind, b, t; row_decode(row, kind, b, t);
#pragma unroll
                    for (int bj = 0; bj < 2; ++bj) {
                        const f32x4 y0 = acc[ai][bj][m][0] * rs * g[bj][0], y1 = acc[ai][bj][m][1] * rs * g[bj][1];
                        *(u32x4*)(dst + (size_t)row * 768 + head * 64 + 32 * bj + 8 * fq) = pk8(y0, y1);
                        if (isk) {
                            const int e0 = 32 * bj + 8 * fq;
                            if (kind == 0 && t >= SEQ - W) { float* o = out + offw_p(ti) + ((((l * NB_P + b) * W + (t - (SEQ - W))) * 2 + 0) * 4 + wc) * 64 + e0; *(f32x4*)o = y0; *(f32x4*)(o + 4) = y1; }
                            if (kind == 1)                 { float* o = out + offw_s(ti) + ((((l * NB_S + b) * W + (W - TS + t)) * 2 + 0) * 4 + wc) * 64 + e0; *(f32x4*)o = y0; *(f32x4*)(o + 4) = y1; }
                        }
                    }
                }
        } else if (pn < T_GQ) {
            const int ti = pn - T_V;
            plain<0, SK>(acc, (bf16*)(ws + WS_V), 768, 256 * ti, row0, wc, fq);
            const int W = win_of(ti);
#pragma unroll
            for (int ai = 0; ai < (SK ? 1 : 2); ++ai)
#pragma unroll
                for (int m = 0; m < (SK ? 2 : 4); ++m) {
                    const int row = row0 + ai * 128 + m * 16;
                    int kind, b, t; row_decode(row, kind, b, t);
#pragma unroll
                    for (int bj = 0; bj < 2; ++bj) {
                        const int hh = 2 * bj + (wc >> 1), e0 = 32 * (wc & 1) + 8 * fq;
                        if (kind == 0 && t >= SEQ - W) { float* o = out + offw_p(ti) + ((((l * NB_P + b) * W + (t - (SEQ - W))) * 2 + 1) * 4 + hh) * 64 + e0; *(f32x4*)o = acc[ai][bj][m][0]; *(f32x4*)(o + 4) = acc[ai][bj][m][1]; }
                        if (kind == 1)                 { float* o = out + offw_s(ti) + ((((l * NB_S + b) * W + (W - TS + t)) * 2 + 1) * 4 + hh) * 64 + e0; *(f32x4*)o = acc[ai][bj][m][0]; *(f32x4*)(o + 4) = acc[ai][bj][m][1]; }
                    }
                }
        } else if (pn == T_GQ) {
            plain<3, SK>(acc, (bf16*)(ws + WS_GQ), 256, 0, row0, wc, fq);
        } else if (pn == T_GK) {
            plain<0, SK>(acc, (bf16*)(ws + WS_GK), 256, 0, row0, wc, fq);
        } else if (pn < T_GR) {
            plain<0, SK>(acc, (bf16*)(ws + WS_GV), 512, 256 * (pn - T_GV), row0, wc, fq);
        } else if (pn < T_Z) {
            plain<2, SK>(acc, (bf16*)(ws + WS_GR), 512, 256 * (pn - T_GR), row0, wc, fq);
        } else if (pn == T_Z) {
#pragma unroll
            for (int bj = 0; bj < 2; ++bj) {
                const int c0 = 128 * bj + 32 * wc + 8 * fq;
                const f32x4 b0 = *(const f32x4*)(b_a + c0), b1 = *(const f32x4*)(b_a + c0 + 4);
#pragma unroll
                for (int ai = 0; ai < (SK ? 1 : 2); ++ai)
#pragma unroll
                    for (int m = 0; m < (SK ? 2 : 4); ++m) {
                        const int row = row0 + ai * 128 + m * 16;
                        f32x4 z0 = acc[ai][bj][m][0] + b0, z1 = acc[ai][bj][m][1] + b1;
#pragma unroll
                        for (int j = 0; j < 4; ++j) {
                            z0[j] = (fminf(z0[j], 0.f) - __logf(1.0f + __expf(-fabsf(z0[j])))) * (1.0f / 16.0f);
                            z1[j] = (fminf(z1[j], 0.f) - __logf(1.0f + __expf(-fabsf(z1[j])))) * (1.0f / 16.0f);
                        }
                        float* o = (float*)(ws + WS_LA) + (size_t)row * 256 + c0; *(f32x4*)o = z0; *(f32x4*)(o + 4) = z1;
                    }
            }
        } else if (pn < T_GATE) {
            const int ti = pn - T_PIN;
            plain<0, SK>(acc, (bf16*)(ws + WS_PIN), 512, 256 * ti, row0, wc, fq);
#pragma unroll
            for (int ai = 0; ai < (SK ? 1 : 2); ++ai)
#pragma unroll
                for (int m = 0; m < (SK ? 2 : 4); ++m) {
                    const int row = row0 + ai * 128 + m * 16;
                    int kind, b, t; row_decode(row, kind, b, t);
#pragma unroll
                    for (int bj = 0; bj < 2; ++bj) {
                        const int c0 = 256 * ti + 128 * bj + 32 * wc + 8 * fq;
                        if (kind == 0 && t >= SEQ - 15) { float* o = out + OFF_POOL_P + ((l * NB_P + b) * 15 + (t - (SEQ - 15))) * 512 + c0; *(f32x4*)o = acc[ai][bj][m][0]; *(f32x4*)(o + 4) = acc[ai][bj][m][1]; }
                        if (kind == 1)                  { float* o = out + OFF_POOL_S + ((l * NB_S + b) * 15 + (15 - TS + t)) * 512 + c0; *(f32x4*)o = acc[ai][bj][m][0]; *(f32x4*)(o + 4) = acc[ai][bj][m][1]; }
                    }
                }
        } else {
            _Float16* R = (_Float16*)(ws + WS_GATE);
            const int c0 = 64 * (pn - T_GATE) + 16 * wc + 4 * fq;
#pragma unroll
            for (int ai = 0; ai < (SK ? 1 : 2); ++ai)
#pragma unroll
                for (int m = 0; m < (SK ? 2 : 4); ++m) {
                    const size_t o = (size_t)(row0 + ai * 128 + m * 16) * DM + c0;
                    h16x4 r0, r1, r2, r3;
#pragma unroll
                    for (int j = 0; j < 4; ++j) {
                        const float d0 = fminf(1.0f + __expf(-acc[ai][0][m][0][j]), 16384.f), d1 = fminf(1.0f + __expf(-acc[ai][0][m][1][j]), 16384.f);
                        const float d2 = fminf(1.0f + __expf(-acc[ai][1][m][0][j]), 16384.f), d3 = fminf(1.0f + __expf(-acc[ai][1][m][1][j]), 16384.f);
                        const float i0 = __builtin_amdgcn_rcpf(d0), i1 = __builtin_amdgcn_rcpf(d1), i2 = __builtin_amdgcn_rcpf(d2), i3 = __builtin_amdgcn_rcpf(d3);
                        r0[j] = (_Float16)fminf(d1 * i0, 65504.f); r1[j] = (_Float16)fminf(d2 * i1, 65504.f); r2[j] = (_Float16)fminf(d3 * i2, 65504.f); r3[j] = (_Float16)i3;
                    }
                    EPI_ST((h16x4*)(R + o), r0); EPI_ST((h16x4*)(R + RAT_STRIDE + o), r1); EPI_ST((h16x4*)(R + 2 * RAT_STRIDE + o), r2); EPI_ST((h16x4*)(R + 3 * RAT_STRIDE + o), r3);
                }
        }
    }
};

__device__ __forceinline__ unsigned wt_lane(int wc, int fr, int g) { return (unsigned)(wc * 4096 + (g >> 1) * 1024 + ((fr * 64 + 32 * (g & 1)) ^ ((fr >> 3) << 5))); }
template <class Epi>
__device__ __forceinline__ void skinny_unit(LAS unsigned char* lds, const bf16* A, const bf16* Bt, int K, int su, const Epi E, int tid, int ld = 0) {
    if (ld == 0) ld = K;
    const int lane = tid & 63, w = __builtin_amdgcn_readfirstlane(tid >> 6), fr = lane & 15, g = lane >> 4;
    const int pn = su >> 2, wc = su & 3;
    const int nh = K >> 6, h0 = (w * nh) >> 3, h1 = ((w + 1) * nh) >> 3;
    f32x4 acc[2][2][2];
#pragma unroll
    for (int bj = 0; bj < 2; ++bj)
#pragma unroll
        for (int m = 0; m < 2; ++m)
#pragma unroll
            for (int n = 0; n < 2; ++n) acc[bj][m][n] = (f32x4){0.f, 0.f, 0.f, 0.f};
    const bf16* ap = A + (size_t)(MP + fr) * ld + 16 * g;
    const char* bp = (const char*)Bt + (size_t)pn * nh * 32768 + wt_lane(wc, fr, g);
    for (int hc = h0; hc < h1; hc += 4) {
        bf16x8 a[4][2][2], b[4][2][2][2];
#pragma unroll
        for (int q = 0; q < 4; ++q) {
            const int hq = (hc + q < h1) ? hc + q : h1 - 1;
#pragma unroll
            for (int s = 0; s < 2; ++s) {
#pragma unroll
                for (int m = 0; m < 2; ++m) a[q][m][s] = *(const bf16x8*)(ap + (size_t)(16 * m) * ld + 64 * hq + 8 * s);
#pragma unroll
                for (int bj = 0; bj < 2; ++bj)
#pragma unroll
                    for (int n = 0; n < 2; ++n) b[q][bj][n][s] = *(const bf16x8*)(bp + (size_t)hq * 32768 + bj * 16384 + n * 2048 + s * 16);
            }
        }
#pragma unroll
        for (int q = 0; q < 4; ++q) {
            const bool ok = hc + q < h1;
#pragma unroll
            for (int s = 0; s < 2; ++s)
#pragma unroll
                for (int m = 0; m < 2; ++m) {
                    bf16x8 av = a[q][m][s];
                    if (!ok) av = (bf16x8){0, 0, 0, 0, 0, 0, 0, 0};
#pragma unroll
                    for (int bj = 0; bj < 2; ++bj)
#pragma unroll
                        for (int n = 0; n < 2; ++n) acc[bj][m][n] = __builtin_amdgcn_mfma_f32_16x16x32_bf16(b[q][bj][n][s], av, acc[bj][m][n], 0, 0, 0);
                }
        }
    }
    LAS f32x4* red = (LAS f32x4*)lds;
#pragma unroll
    for (int bj = 0; bj < 2; ++bj)
#pragma unroll
        for (int m = 0; m < 2; ++m)
#pragma unroll
            for (int n = 0; n < 2; ++n) red[(w * 8 + (bj * 4 + m * 2 + n)) * 64 + lane] = acc[bj][m][n];
    __syncthreads();
    if (w == 0) {
        f32x4 full[2][2][4][2];
#pragma unroll
        for (int bj = 0; bj < 2; ++bj)
#pragma unroll
            for (int m = 0; m < 2; ++m)
#pragma unroll
                for (int n = 0; n < 2; ++n) {
                    f32x4 s = red[(bj * 4 + m * 2 + n) * 64 + lane];
#pragma unroll
                    for (int ww = 1; ww < 8; ++ww) s += red[(ww * 8 + (bj * 4 + m * 2 + n)) * 64 + lane];
                    asm volatile("" : "+v"(s) :: "memory");
                    full[0][bj][m][n] = s;
                }
        pg8::Unit u; u.pm = MP / 256; u.pn = pn; u.ri = 0;
        E.template run<true>(full, u, 0, wc, fr, g);
    }
    __syncthreads();
}

__device__ __forceinline__ void skinny_merge_unit(LAS unsigned char* lds, unsigned char* ws, const bf16* Y, const bf16* U, int su, int tid) {
    const int lane = tid & 63, w = __builtin_amdgcn_readfirstlane(tid >> 6), fr = lane & 15, g = lane >> 4;
    const int pn = su >> 2, wc = su & 3;
    f32x4 acc[2][2][2];
#pragma unroll
    for (int bj = 0; bj < 2; ++bj)
#pragma unroll
        for (int m = 0; m < 2; ++m)
#pragma unroll
            for (int n = 0; n < 2; ++n) acc[bj][m][n] = (f32x4){0.f, 0.f, 0.f, 0.f};
    if (w < 7) {
        const bf16* ap = Y + (size_t)(MP + fr) * YK + 16 * g + 256 * w;
        const char* bp = (const char*)U + (size_t)(pn * (YK / 64) + 4 * w) * 32768 + wt_lane(wc, fr, g);
        bf16x8 a[4][2][2], b[4][2][2][2];
#pragma unroll
        for (int q = 0; q < 4; ++q)
#pragma unroll
            for (int s2 = 0; s2 < 2; ++s2) {
#pragma unroll
                for (int m = 0; m < 2; ++m) a[q][m][s2] = *(const bf16x8*)(ap + (size_t)(16 * m) * YK + 64 * q + 8 * s2);
#pragma unroll
                for (int bj = 0; bj < 2; ++bj)
#pragma unroll
                    for (int n = 0; n < 2; ++n) b[q][bj][n][s2] = *(const bf16x8*)(bp + (size_t)q * 32768 + bj * 16384 + n * 2048 + s2 * 16);
            }
#pragma unroll
        for (int q = 0; q < 4; ++q)
#pragma unroll
            for (int s2 = 0; s2 < 2; ++s2)
#pragma unroll
                for (int m = 0; m < 2; ++m)
#pragma unroll
                    for (int bj = 0; bj < 2; ++bj)
#pragma unroll
                        for (int n = 0; n < 2; ++n) acc[bj][m][n] = __builtin_amdgcn_mfma_f32_16x16x32_bf16(b[q][bj][n][s2], a[q][m][s2], acc[bj][m][n], 0, 0, 0);
    }
    LAS f32x4* red = (LAS f32x4*)lds;
#pragma unroll
    for (int bj = 0; bj < 2; ++bj)
#pragma unroll
        for (int m = 0; m < 2; ++m)
#pragma unroll
            for (int n = 0; n < 2; ++n) red[(w * 8 + (bj * 4 + m * 2 + n)) * 64 + lane] = acc[bj][m][n];
    __syncthreads();
    if (w == 0) {
        bf16* MRG = (bf16*)(ws + WS_MRG);
        const int col0 = pn * 256 + wc * 32 + 8 * g;
#pragma unroll
        for (int m = 0; m < 2; ++m) {
            const int row = MP + 16 * m + fr;
#pragma unroll
            for (int bj = 0; bj < 2; ++bj) {
                const _Float16* R = (const _Float16*)(ws + WS_GATE) + (size_t)row * DM + col0 + bj * 128;
                const h16x8 r0 = *(const h16x8*)R, r1 = *(const h16x8*)(R + RAT_STRIDE), r2 = *(const h16x8*)(R + 2 * RAT_STRIDE), r3 = *(const h16x8*)(R + 3 * RAT_STRIDE);
                f32x4 o[2];
#pragma unroll
                for (int n = 0; n < 2; ++n) {
                    const int ti = bj * 4 + m * 2 + n;
                    const f32x4 pa = red[(0 * 8 + ti) * 64 + lane] + red[(1 * 8 + ti) * 64 + lane], pb = red[(2 * 8 + ti) * 64 + lane];
                    const f32x4 pc = red[(3 * 8 + ti) * 64 + lane] + red[(4 * 8 + ti) * 64 + lane], pd = red[(5 * 8 + ti) * 64 + lane] + red[(6 * 8 + ti) * 64 + lane];
#pragma unroll
                    for (int j = 0; j < 4; ++j) {
                        const float e3 = (float)r3[4 * n + j], e2 = (float)r2[4 * n + j] * e3, e1 = (float)r1[4 * n + j] * e2, e0 = (float)r0[4 * n + j] * e1;
                        o[n][j] = (e0 * pa[j] + e1 * pb[j]) + (e2 * pc[j] + e3 * pd[j]);
                    }
                }
                *(u32x4*)(MRG + (size_t)row * DM + col0 + bj * 128) = pk8(o[0], o[1]);
            }
        }
    }
    __syncthreads();
}

constexpr int IT_GU = 344 * 32, IT_D = 64 * 86, IT_IN = 448 * 32, IT_UPA = 64 * 8, IT_UPB = 64 * 4, IT_UPC = 64 * 8, IT_UPD = 64 * 8, IT_OUT = 64 * 32;
constexpr int IT_LAYER = 2 * IT_GU + 2 * IT_D + IT_IN + IT_UPA + IT_UPB + IT_UPC + IT_UPD + IT_OUT;
static_assert(IT_LAYER == 51200, "items per layer");

constexpr int PB_LAYER = 2 * 43 * 32 + 2 * 8 * 86 + 56 * 32 + 8 * 8 + 8 * 4 + 8 * 8 + 8 * 8 + 8 * 32;
static_assert(PB_LAYER == 6400, "blocks per layer");
constexpr int PB_P = 265;
constexpr int PB_PW_OFF = 69632;
struct BDesc { const float* src; const float* gain; bf16* dst; int ldw, K, kind, perm, aux0, aux1, aux2; };

__device__ __forceinline__ void pblk_decode(LAS unsigned char* lds, bf16* WB, int blk, int wave, int lane, BDesc& D) {
    const int l = blk / PB_LAYER; int r = blk % PB_LAYER;
    const int g = lane >> 3, c4 = lane & 7, bj = g >> 2, wc = g & 3;
    int wi, wi2, gi = -1, ldw, S0, k0, K, T, perm = 1, yo = 0; size_t wofs, woff;
    if (r < 2 * 1376) {
        const int f = r / 1376; r -= f * 1376; T = r % 43; const int kb = r / 43;
        wi = f ? 28 : 9; wi2 = f ? 29 : 10; wofs = (size_t)l * DM * DFF; ldw = DFF; S0 = 128 * T + 32 * wc; k0 = 64 * kb; K = DM; woff = f ? WE_GU2 : WE_GU1; gi = f ? 27 : 8;
    } else if ((r -= 2 * 1376) < 2 * 688) {
        const int f = r / 688; r -= f * 688; T = r % 8; const int kb = r / 8;
        wi = wi2 = f ? 30 : 11; wofs = (size_t)l * DFF * DM; ldw = DM; S0 = 256 * T + 32 * g; k0 = 64 * kb; K = DFF; woff = f ? WE_D2 : WE_D1;
    } else if ((r -= 2 * 688) < 1792) {
        T = r % 56; const int kb = r / 56, pn = T;
        wi = wi2 = 13; wofs = (size_t)l * DM * N_IN; ldw = N_IN; k0 = 64 * kb; K = DM; woff = WE_IN; gi = 12;
        if (pn < T_CB) S0 = (bj ? C_CH : C_CC) + 128 * pn + 32 * wc;
        else if (pn < T_Q) S0 = C_CB + 256 * (pn - T_CB) + 32 * g;
        else if (pn < T_K) S0 = C_AQ + 256 * (pn - T_Q) + 64 * wc + 32 * bj;
        else if (pn < T_V) S0 = C_AK + 256 * (pn - T_K) + 64 * wc + 32 * bj;
        else if (pn < T_GQ) S0 = C_AV + 256 * (pn - T_V) + 32 * g;
        else if (pn == T_GQ) S0 = C_GQ + 32 * g;
        else if (pn == T_GK) S0 = C_GK + 32 * g;
        else if (pn < T_GR) S0 = C_GV + 256 * (pn - T_GV) + 32 * g;
        else if (pn < T_Z) S0 = C_GR + 256 * (pn - T_GR) + 32 * g;
        else if (pn == T_Z) S0 = C_LR;
        else if (pn < T_GATE) S0 = C_PIN + 256 * (pn - T_PIN) + 32 * g;
        else { S0 = C_GATE + (2 * bj + (c4 >> 2)) * 2048 + 64 * (pn - T_GATE) + 16 * wc + 4 * (c4 & 3) - 4 * c4; perm = 0; }
    } else {
        r -= 1792; K = YK; woff = WE_UPCAT; ldw = DM; int kb;
        if (r < 64) { T = r % 8; kb = r / 8; wi = 22; wofs = (size_t)l * 512 * DM; yo = YO_A; }
        else if ((r -= 64) < 32) { T = r % 8; kb = r / 8; wi = 23; wofs = (size_t)l * 256 * DM; yo = YO_B; }
        else if ((r -= 32) < 64) { T = r % 8; kb = r / 8; wi = 24; wofs = (size_t)l * 512 * DM; yo = YO_C; }
        else if ((r -= 64) < 64) { T = r % 8; kb = r / 8; wi = 25; wofs = (size_t)l * 512 * DM; yo = YO_D; }
        else { r -= 64; T = r % 8; kb = r / 8; wi = 26; wofs = (size_t)l * DM * DM; K = DM; woff = WE_OUT; }
        wi2 = wi; S0 = 256 * T + 32 * g; k0 = 64 * kb;
    }
    const float* W0 = ldp(lds, wi); const float* W1 = ldp(lds, wi2); const float* gbase = ldp(lds, gi >= 0 ? gi : 8);
    D.src = (bj ? W1 : W0) + wofs + (size_t)(k0 + 8 * wave) * ldw + S0 + 4 * c4;
    D.gain = gi >= 0 ? gbase + (size_t)l * DM + k0 + 8 * wave : gbase;
    D.dst = WB + (size_t)l * WE_LAYER + woff + ((size_t)T * (K >> 6) + ((yo + k0) >> 6)) * 16384; D.ldw = ldw; D.K = K; D.kind = 0; D.perm = perm; D.aux0 = 0; D.aux1 = l; D.aux2 = gi >= 0;
}
__device__ __forceinline__ void pblk_load(const BDesc& D, f32x4 (&v)[8], f32x4 (&gv)[2]) {
#pragma unroll
    for (int i = 0; i < 8; ++i) v[i] = __builtin_nontemporal_load((const f32x4*)(D.src + (size_t)i * D.ldw));
    gv[0] = *(const f32x4*)D.gain; gv[1] = *(const f32x4*)(D.gain + 4);
}
template <int MODE = 0>
__device__ __forceinline__ void pblk_writeout(LAS unsigned char* lds, bf16* dst, int K, int perm, int tid) {
    LAS float* tile = (LAS float*)(lds + RING_OFF);
    const int lane = tid & 63, wave = tid >> 6;
    LDS_WAIT(); __builtin_amdgcn_s_barrier(); asm volatile("" ::: "memory");
    const int c = lane & 7;
#pragma unroll
    for (int j = 0; j < 4; ++j) {
        const int rho = (lane >> 3) + 8 * j; const int cc = perm ? pg8::perm32(rho) : rho;
        const LAS float* s = tile + (8 * c) * PB_P + 33 * wave + cc;
        u32x4 o; o.x = pk2(s[0 * PB_P], s[1 * PB_P]); o.y = pk2(s[2 * PB_P], s[3 * PB_P]); o.z = pk2(s[4 * PB_P], s[5 * PB_P]); o.w = pk2(s[6 * PB_P], s[7 * PB_P]);
        if (MODE == 0) *(u32x4*)((char*)dst + (wave >> 2) * 16384 + pg8::lds_byte(32 * (wave & 3) + rho, 8 * c)) = o; else asm volatile("" :: "v"(o));
    }
    LDS_WAIT(); __builtin_amdgcn_s_barrier(); asm volatile("" ::: "memory");
}
template <int MODE = 0>
__device__ __forceinline__ void pblk_finish(LAS unsigned char* lds, const BDesc& D, const f32x4 (&v)[8], const f32x4 (&gv)[2], int tid) {
    if (MODE == 2) { _Pragma("unroll") for (int i = 0; i < 8; ++i) asm volatile("" :: "v"(v[i])); return; }
    f32x4 g0 = gv[0], g1 = gv[1]; asm volatile("" : "+v"(g0), "+v"(g1) :: "memory");
    LAS float* tile = (LAS float*)(lds + RING_OFF);
    const int lane = tid & 63, wave = tid >> 6;
    const int g = lane >> 3, c4 = lane & 7;
#pragma unroll
    for (int i = 0; i < 8; ++i) { const float gk = D.aux2 ? (i < 4 ? g0[i & 3] : g1[i & 3]) : 1.0f; LAS float* s = tile + (8 * wave + i) * PB_P + 33 * g + 4 * c4; s[0] = v[i][0] * gk; s[1] = v[i][1] * gk; s[2] = v[i][2] * gk; s[3] = v[i][3] * gk; }
    pblk_writeout<MODE>(lds, D.dst, D.K, D.perm, tid);
}
__device__ __forceinline__ void prologue_specials(LAS unsigned char* lds, bf16* WB, int bid, int G, int tid) {
    LAS float* tile = (LAS float*)(lds + RING_OFF);
#pragma unroll 1
    for (int s = bid; s < DEPTH * 96; s += G) {
        const int l = s / 96, r = s % 96;
        bf16* wl = WB + (size_t)l * WE_LAYER;
        if (r < 32) {
            const int kb = r;
            const float* A2 = ldp(lds, 17) + (size_t)l * 16 * 256; const float* gmix = ldp(lds, 12) + (size_t)l * DM;
            const float* Wk = ldp(lds, 13) + (size_t)l * DM * N_IN + (size_t)(64 * kb) * N_IN + C_LR;
            const int c = tid & 255, half = tid >> 8;
            float w2[16];
#pragma unroll
            for (int q = 0; q < 16; ++q) w2[q] = A2[q * 256 + c];
#pragma unroll 4
            for (int i = 0; i < 32; ++i) {
                const int kk = 32 * half + i;
                const f32x4* a = (const f32x4*)(Wk + (size_t)kk * N_IN);
                float sum = 0.f;
#pragma unroll
                for (int q = 0; q < 4; ++q) { const f32x4 av = a[q]; sum += av[0] * w2[4 * q] + av[1] * w2[4 * q + 1] + av[2] * w2[4 * q + 2] + av[3] * w2[4 * q + 3]; }
                tile[kk * PB_P + 33 * (c >> 5) + (c & 31)] = sum * gmix[64 * kb + kk];
            }
            pblk_writeout(lds, wl + WE_IN + ((size_t)T_Z * (DM / 64) + kb) * 16384, DM, 1, tid);
        } else {
            const int q = r - 32, T = q % 8, kb = q / 8, gg = kb >> 1, i0 = (kb & 1) * 64;
            LAS float* pw = (LAS float*)(lds + PB_PW_OFF);
            { const f32x4* src = (const f32x4*)(ldp(lds, 20) + ((size_t)l * 4 + gg) * 128 * 128 + (size_t)i0 * 128);
              for (int e = tid; e < 64 * 32; e += NTHR) ((LAS f32x4*)pw)[e] = src[e]; }
            LDS_WAIT(); __builtin_amdgcn_s_barrier(); asm volatile("" ::: "memory");
            const int n = tid & 255, half = tid >> 8;
            const float* SC = ldp(lds, 21) + (size_t)l * 512 + gg * 128;
            const float* UD = ldp(lds, 25) + (size_t)l * 512 * DM + (size_t)(gg * 128) * DM + 256 * T + n;
            float a[32];
#pragma unroll
            for (int j = 0; j < 32; ++j) a[j] = 0.f;
#pragma unroll 2
            for (int c = 0; c < 128; ++c) {
                const float uv = UD[(size_t)c * DM] * SC[c];
#pragma unroll
                for (int j = 0; j < 32; ++j) a[j] += pw[(32 * half + j) * 128 + c] * uv;
            }
#pragma unroll
            for (int j = 0; j < 32; ++j) tile[(32 * half + j) * PB_P + 33 * (n >> 5) + (n & 31)] = a[j];
            pblk_writeout(lds, wl + WE_UPCAT + ((size_t)T * (YK / 64) + YO_D / 64 + kb) * 16384, YK, 1, tid);
        }
    }
}
constexpr int DEFER_WG0 = 96, DEFER_WGS = 160, DEFER_PER_WG = 9, DEFER_N = (DEFER_WGS * DEFER_PER_WG < 1376) ? DEFER_WGS * DEFER_PER_WG : 1376;
constexpr int DEFER_X = 224;
static_assert(DEFER_N == 1376, "the slot list jumps from the end of a gate|up matrix to a down matrix");
__device__ __forceinline__ bool pblk_deferred(int blk) {
    const int l = blk / PB_LAYER, r = blk % PB_LAYER;
    if (r < 1376) return l >= 1 && r < DEFER_N;
    if (r < 2 * 1376) return (r - 1376) < DEFER_N;
    if (r < 2 * 1376 + 688) return l >= 1 && (r - 2 * 1376) < DEFER_X;
    if (r < 2 * 1376 + 2 * 688) return (r - 2 * 1376 - 688) < DEFER_X;
    return false;
}
__device__ __forceinline__ bool pblk_special(int blk) {
    int r = blk % PB_LAYER - (2 * 1376 + 2 * 688);
    if (r < 0) return false;
    if (r < 1792) return (r % 56) == T_Z;
    r -= 1792 + 64 + 32 + 64; return r >= 0 && r < 64;
}
#define PB_BLK(i) (first + (i) + ((i) >= jump_at ? jump : 0))
#define PB_NEXT(I) { while (cand < count && ((skip_deferred && pblk_deferred(PB_BLK(cand))) || pblk_special(PB_BLK(cand)))) cand += stride; I = cand < count ? cand : -1; cand += stride; }
#define PB_LOAD(D, V, GV, I) { const int li_ = (I) >= 0 ? (I) : i0; pblk_decode(lds, WB, PB_BLK(li_), wave, lane, D); if ((I) < 0) { D.src = dummy; D.ldw = 0; } pblk_load(D, V, GV); }
#define PB_STEP(CUR, VCUR, GCUR, INEXT, NXT2, VNXT2, GNXT2, INXT2) { PB_NEXT(INXT2); \
        PB_LOAD(NXT2, VNXT2, GNXT2, INXT2) \
        pblk_finish<MODE>(lds, CUR, VCUR, GCUR, tid); \
        if (INEXT < 0) break; }
template <int MODE = 0>
__device__ __forceinline__ void prologue_blocks(LAS unsigned char* lds, bf16* WB, int first, int count, int start, int stride, int tid, bool skip_deferred, int jump_at = 0x7fffffff, int jump = 0) {
    const int lane = tid & 63, wave = __builtin_amdgcn_readfirstlane(tid >> 6);
    BDesc A, B, C; f32x4 va[8], vb[8], vc[8], ga[2], gb[2], gc[2];
    int cand = start, ia, ib, ic;
    PB_NEXT(ia); if (ia < 0) return;
    const int i0 = ia; const float* dummy = ldp(lds, 8) + 4 * lane;
    PB_LOAD(A, va, ga, ia)
    PB_NEXT(ib);
    PB_LOAD(B, vb, gb, ib)
#pragma unroll 1
    for (;;) {
        PB_STEP(A, va, ga, ib, C, vc, gc, ic)
        PB_STEP(B, vb, gb, ic, A, va, ga, ia)
        PB_STEP(C, vc, gc, ia, B, vb, gb, ib)
    }
}
#undef PB_STEP
#undef PB_LOAD
#undef PB_NEXT
#undef PB_BLK

__device__ __forceinline__ void x_init_pass(const float* xp, const float* xs, bf16* XB, unsigned long long* ss0, int gw, int NGW, int lane) {
    for (int row = gw; row < MPAD; row += NGW) {
        u32x2* o = (u32x2*)(XB + (size_t)row * DM) + lane;
        if (row < MP) {
            const int R = row & 127, C = 4 * (lane & 15);
            o = (u32x2*)((char*)XB + ((size_t)((row >> 8) * (DM / 64) + (lane >> 4)) * 2 + ((row >> 7) & 1)) * 16384 + pg8::lds_byte(R, C));
        }
        const int ostep = row < MP ? 4 * 32768 / 8 : 64;
        if (row >= MR) {
#pragma unroll
            for (int j = 0; j < 8; ++j) { u32x2 z; z.x = 0u; z.y = 0u; o[ostep * j] = z; }
            continue;
        }
        const f32x4* xr = (const f32x4*)(row < MP ? xp + (size_t)row * DM : xs + (size_t)(row - MP) * DM) + lane;
        float ss = 0.f;
#pragma unroll
        for (int j = 0; j < 8; ++j) { const f32x4 v = xr[64 * j]; u32x2 w; w.x = pk2(v[0], v[1]); w.y = pk2(v[2], v[3]); o[ostep * j] = w;
            const float a0 = bflo(w.x), a1 = bfhi(w.x), a2 = bflo(w.y), a3 = bfhi(w.y); ss += (a0 * a0 + a1 * a1) + (a2 * a2 + a3 * a3); }
        ss = wave_sum(ss, lane);
        if (lane == 0) ss0[row] = (unsigned long long)(ss * SS_FIX + 0.5f);
    }
}

constexpr int CC_N0 = DEPTH * NB_S * (128 - TS) * 128, CC_N1 = DEPTH * NB_S * (512 - TS) * 128, CC_N2 = DEPTH * NB_S * (2048 - TS) * 128, CACHE_COPY_N = CC_N0 + CC_N1 + CC_N2;
__device__ __forceinline__ void cache_copy_range(const float* c128, const float* c512, const float* c2048, float* out, int i0, int i1, int t, int nt) {
    for (int i = i0 + t; i < i1; i += nt) {
        int ii = i, gi = 0;
        if (ii >= CC_N0) { ii -= CC_N0; gi = 1; if (ii >= CC_N1) { ii -= CC_N1; gi = 2; } }
        const int W = win_of(gi), per = (W - TS) * 128, lb = ii / per, j = ii - lb * per;
        const f32x4* src = (const f32x4*)(gi == 0 ? c128 : (gi == 1 ? c512 : c2048)); f32x4* dst = (f32x4*)(out + offw_s(gi));
        __builtin_nontemporal_store(__builtin_nontemporal_load(src + (size_t)lb * W * 128 + TS * 128 + j), dst + (size_t)lb * W * 128 + j);
    }
}

__device__ __forceinline__ s16x4 ds_tr16(const LAS unsigned char* p) { return __builtin_amdgcn_ds_read_tr16_b64_v4i16((LAS s16x4*)p); }
__device__ __forceinline__ bf16x8 cat4(s16x4 a, s16x4 b) { bf16x8 r; r[0] = a[0]; r[1] = a[1]; r[2] = a[2]; r[3] = a[3]; r[4] = b[0]; r[5] = b[1]; r[6] = b[2]; r[7] = b[3]; return r; }
__device__ __forceinline__ bf16x8 pk8v(f32x4 a, f32x4 b) { const u32x4 w = pk8(a, b); return __builtin_bit_cast(bf16x8, w); }

constexpr int ATT_UNITS = NB_P * 12 * 32;
constexpr int ATT_PITCH = 144;
__device__ __forceinline__ void attn_unit(LAS unsigned char* lds, const bf16* Q, const bf16* K, const bf16* V, float* AO, float* LSE, int unit, int tid) {
    const int lane = tid & 63, w = tid >> 6, fr = lane & 15, g = lane >> 4;
    const int blk = unit & 31, bh = unit >> 5, h = bh % 12, b = bh / 12;
    const int gi = h >> 2, dl = dil_of(gi);
    const int r = blk % dl, nb = blk / dl;
    LAS unsigned char* Ks = lds; LAS unsigned char* Vs = lds + 256 * ATT_PITCH;
    for (int c = tid; c < 2048; c += NTHR) {
        const int ki = c >> 3, ch = c & 7, ksub = nb * 128 + ki - 128;
        u32x4 kv = {0u, 0u, 0u, 0u}, vv = {0u, 0u, 0u, 0u};
        if (ksub >= 0) { const size_t off = (size_t)(b * SEQ + r + dl * ksub) * 768 + h * 64 + ch * 8; kv = *(const u32x4*)(K + off); vv = *(const u32x4*)(V + off); }
        *(LAS u32x4*)(Ks + ki * ATT_PITCH + ch * 16) = kv; *(LAS u32x4*)(Vs + ki * ATT_PITCH + ch * 16) = vv;
    }
    __syncthreads();
    const int qi = 16 * w + fr;
    const int qtok = b * SEQ + r + dl * (nb * 128 + qi);
    const bf16x8 q0 = *(const bf16x8*)(Q + (size_t)qtok * 768 + h * 64 + 8 * g), q1 = *(const bf16x8*)(Q + (size_t)qtok * 768 + h * 64 + 32 + 8 * g);
    const int ks0 = w >> 1;
    f32x4 s[10];
#pragma unroll
    for (int tt = 0; tt < 10; ++tt) {
        const int T = 2 * ks0 + tt;
        const LAS unsigned char* kp = Ks + (16 * T + fr) * ATT_PITCH + 16 * g;
        const bf16x8 k0 = *(const LAS bf16x8*)kp, k1 = *(const LAS bf16x8*)(kp + 64);
        f32x4 a = {0.f, 0.f, 0.f, 0.f};
        a = __builtin_amdgcn_mfma_f32_16x16x32_bf16(k0, q0, a, 0, 0, 0);
        a = __builtin_amdgcn_mfma_f32_16x16x32_bf16(k1, q1, a, 0, 0, 0);
        s[tt] = a;
    }
    const float slope = exp2f(-8.0f * (float)(h + 1) / 12.0f) * (float)dl;
    float mx = -INFINITY;
#pragma unroll
    for (int tt = 0; tt < 10; ++tt)
#pragma unroll
        for (int j = 0; j < 4; ++j) {
            const int ki = 16 * (2 * ks0 + tt) + 4 * g + j, dist = qi - ki + 128, ksub = nb * 128 + ki - 128;
            const bool valid = (dist >= 0) && (dist <= 128) && (ksub >= 0);
            const float v = s[tt][j] * 0.125f - slope * (float)dist;
            s[tt][j] = valid ? v : -INFINITY;
            mx = fmaxf(mx, s[tt][j]);
        }
    mx = fmaxf(mx, shx(mx, 16, lane)); mx = fmaxf(mx, shx(mx, 32, lane));
    float ls = 0.f;
#pragma unroll
    for (int tt = 0; tt < 10; ++tt)
#pragma unroll
        for (int j = 0; j < 4; ++j) { const float p = __expf(s[tt][j] - mx); s[tt][j] = p; ls += p; }
    ls += shx(ls, 16, lane); ls += shx(ls, 32, lane);
    f32x4 o[4];
#pragma unroll
    for (int et = 0; et < 4; ++et) o[et] = (f32x4){0.f, 0.f, 0.f, 0.f};
    const int q4 = fr >> 2, p4 = fr & 3;
#pragma unroll
    for (int kk = 0; kk < 5; ++kk) {
        const bf16x8 pb = pk8v(s[2 * kk], s[2 * kk + 1]);
        const int rb = 32 * (ks0 + kk) + 4 * g + q4;
#pragma unroll
        for (int et = 0; et < 4; ++et) {
            const s16x4 v0 = ds_tr16(Vs + rb * ATT_PITCH + (16 * et + 4 * p4) * 2);
            const s16x4 v1 = ds_tr16(Vs + (rb + 16) * ATT_PITCH + (16 * et + 4 * p4) * 2);
            o[et] = __builtin_amdgcn_mfma_f32_16x16x32_bf16(cat4(v0, v1), pb, o[et], 0, 0, 0);
        }
    }
    const float inv = 1.0f / ls;
    float* ao = AO + (size_t)qtok * 768 + h * 64 + 4 * g;
#pragma unroll
    for (int et = 0; et < 4; ++et) *(f32x4*)(ao + 16 * et) = o[et] * inv;
    if (g == 0) LSE[(size_t)qtok * 12 + h] = mx + __logf(ls);
    __syncthreads();
}

__device__ __forceinline__ void attn_merge_pass(const float* AO, const float* LSE, bf16* YB, int gt, int NGT, int rep = 1) {
    for (int it0 = gt; it0 < rep * MR * 4 * 16; it0 += NGT) {
        const int it = it0 % (MR * 4 * 16);
        const int e4 = it & 15, slot = (it >> 4) & 3, tok = it >> 6;
        const float l0 = LSE[(size_t)tok * 12 + slot], l1 = LSE[(size_t)tok * 12 + 4 + slot], l2 = LSE[(size_t)tok * 12 + 8 + slot];
        const float m = fmaxf(l0, fmaxf(l1, l2));
        const float w0 = __expf(l0 - m), w1 = __expf(l1 - m), w2 = __expf(l2 - m), inv = 1.0f / (w0 + w1 + w2);
        const float* a = AO + (size_t)tok * 768 + slot * 64 + e4 * 4;
        const f32x4 y = (*(const f32x4*)a * w0 + *(const f32x4*)(a + 256) * w1 + *(const f32x4*)(a + 512) * w2) * inv;
        u32x2 wv; wv.x = pk2(y[0], y[1]); wv.y = pk2(y[2], y[3]);
        *(u32x2*)(YB + (size_t)tok * YK + YO_B + slot * 64 + e4 * 4) = wv;
    }
}

__device__ __forceinline__ float dot64_f32(const float (&q)[64], const float* k) {
    float s = 0.f;
#pragma unroll
    for (int c = 0; c < 16; ++c) { const f32x4 kv = ((const f32x4*)k)[c]; s += (q[4 * c] * kv[0] + q[4 * c + 1] * kv[1]) + (q[4 * c + 2] * kv[2] + q[4 * c + 3] * kv[3]); }
    return s;
}
__device__ __forceinline__ float dot64_bf(const float (&q)[64], const bf16* k) {
    float s = 0.f;
#pragma unroll
    for (int c = 0; c < 8; ++c) { const u32x4 w = ((const u32x4*)k)[c];
        s += (q[8 * c] * bflo(w.x) + q[8 * c + 1] * bfhi(w.x)) + (q[8 * c + 2] * bflo(w.y) + q[8 * c + 3] * bfhi(w.y)) + (q[8 * c + 4] * bflo(w.z) + q[8 * c + 5] * bfhi(w.z)) + (q[8 * c + 6] * bflo(w.w) + q[8 * c + 7] * bfhi(w.w)); }
    return s;
}
__device__ __forceinline__ void attn_sample_wave(const bf16* Q, const bf16* K, const bf16* V, const float* c128, const float* c512, const float* c2048, float* AO, float* LSE, int layer, int unit, int lane) {
    const int h = unit % 12, bt = unit / 12, t = bt & 3, b = bt >> 2;
    const int row = MP + b * TS + t;
    const int gi = h >> 2, slot = h & 3, dl = dil_of(gi), W = win_of(gi);
    const float* cache = (gi == 0 ? c128 : (gi == 1 ? c512 : c2048)) + (size_t)(layer * NB_S + b) * W * 512;
    float qf[64];
    { const u32x4* qp = (const u32x4*)(Q + (size_t)row * 768 + h * 64);
#pragma unroll
      for (int c = 0; c < 8; ++c) { const u32x4 w = qp[c]; qf[8 * c] = bflo(w.x) * 0.125f; qf[8 * c + 1] = bfhi(w.x) * 0.125f; qf[8 * c + 2] = bflo(w.y) * 0.125f; qf[8 * c + 3] = bfhi(w.y) * 0.125f;
          qf[8 * c + 4] = bflo(w.z) * 0.125f; qf[8 * c + 5] = bfhi(w.z) * 0.125f; qf[8 * c + 6] = bflo(w.w) * 0.125f; qf[8 * c + 7] = bfhi(w.w) * 0.125f; } }
    const float slope = exp2f(-8.0f * (float)(h + 1) / 12.0f) * (float)dl;
    float sc[3];
#pragma unroll
    for (int sj = 0; sj < 3; ++sj) {
        const int j = lane + 64 * sj;
        float d = -INFINITY;
        if (j <= 128) {
            const int idx = W + t - j * dl;
            if (idx >= W) d = dot64_bf(qf, K + (size_t)(MP + b * TS + (idx - W)) * 768 + h * 64);
            else d = dot64_f32(qf, cache + ((size_t)idx * 2 + 0) * 256 + slot * 64);
            d -= slope * (float)j;
        }
        sc[sj] = d;
    }
    const float mg = wave_max(fmaxf(sc[0], fmaxf(sc[1], sc[2])), lane);
    const float p0 = __expf(sc[0] - mg), p1 = __expf(sc[1] - mg), p2 = __expf(sc[2] - mg);
    const float lg = wave_sum(p0 + p1 + p2, lane);
    float acc = 0.f;
    const int jstart = (dl == 1) ? t + 1 : 1;
#pragma unroll 1
    for (int j = 0; j < jstart; ++j) acc += rdl(p0, j) * bf2f(V[(size_t)(MP + b * TS + (t - j * dl)) * 768 + h * 64 + lane]);
    const float* vbase = cache + 256 + slot * 64 + lane;
#pragma unroll 1
    for (int j0 = jstart; j0 <= 128; j0 += 32) {
        float vv[32];
#pragma unroll
        for (int i = 0; i < 32; ++i) { const int j = (j0 + i <= 128) ? j0 + i : 128; vv[i] = vbase[(size_t)(W + t - j * dl) * 512]; }
#pragma unroll
        for (int i = 0; i < 32; ++i) { const int j = j0 + i; const float pj = (j <= 128) ? rdl(j < 64 ? p0 : (j < 128 ? p1 : p2), j & 63) : 0.f; acc += pj * vv[i]; }
    }
    AO[(size_t)row * 768 + h * 64 + lane] = acc / lg;
    if (lane == 0) LSE[(size_t)row * 12 + h] = mg + __logf(lg);
}

__device__ __forceinline__ void conv_pool_pass(const bf16* CB, const bf16* U, const bf16* PIN, const float* conv_w, const float* st_conv, const float* st_pool, bf16* YA, bf16* YD, int layer, int gt, int NGT, int rep = 1) {
    for (int it0 = gt; it0 < rep * MPAD * 64; it0 += NGT) {
        const int it = it0 % (MPAD * 64); const int c8 = it & 63, row = it >> 6, ch = c8 * 8;
        int kind, b, t; row_decode(row, kind, b, t);
        if (kind == 2) { const u32x4 z = {0u, 0u, 0u, 0u}; *(u32x4*)(YA + (size_t)row * YK + YO_A + ch) = z; *(u32x4*)(YD + (size_t)row * YK + YO_D + ch) = z; continue; }
        float u0[8], u1[8], u2[8], cb[8];
        unpk8(*(const u32x4*)(U + (size_t)row * 512 + ch), u2);
        if (t >= 1) unpk8(*(const u32x4*)(U + (size_t)(row - 1) * 512 + ch), u1);
        else if (kind == 1) { const float* s = st_conv + ((size_t)(layer * NB_S + b) * 2 + 1) * 512 + ch; _Pragma("unroll") for (int j = 0; j < 8; ++j) u1[j] = s[j]; }
        else { _Pragma("unroll") for (int j = 0; j < 8; ++j) u1[j] = 0.f; }
        if (t >= 2) unpk8(*(const u32x4*)(U + (size_t)(row - 2) * 512 + ch), u0);
        else if (kind == 1) { const float* s = st_conv + ((size_t)(layer * NB_S + b) * 2 + t) * 512 + ch; _Pragma("unroll") for (int j = 0; j < 8; ++j) u0[j] = s[j]; }
        else { _Pragma("unroll") for (int j = 0; j < 8; ++j) u0[j] = 0.f; }
        unpk8(*(const u32x4*)(CB + (size_t)row * 512 + ch), cb);
        const float* cw = conv_w + (size_t)layer * 3 * 512 + ch;
        f32x4 ya0, ya1;
#pragma unroll
        for (int j = 0; j < 8; ++j) { const float z = cw[j] * u0[j] + cw[512 + j] * u1[j] + cw[1024 + j] * u2[j]; const float y = cb[j] * z; if (j < 4) ya0[j] = y; else ya1[j - 4] = y; }
        *(u32x4*)(YA + (size_t)row * YK + YO_A + ch) = pk8(ya0, ya1);
        const int grp = c8 >> 4, w = 2 << grp;
        float cur[8], sum[8];
        unpk8(*(const u32x4*)(PIN + (size_t)row * 512 + ch), cur);
#pragma unroll
        for (int j = 0; j < 8; ++j) sum[j] = cur[j];
        if (kind == 0) {
            u32x4 xr[15];
#pragma unroll
            for (int i = 1; i < 16; ++i) { const bool ok = (i < w) && (t - i >= 0); xr[i - 1] = *(const u32x4*)(PIN + (size_t)(ok ? row - i : row) * 512 + ch); }
#pragma unroll
            for (int i = 1; i < 16; ++i) { const bool ok = (i < w) && (t - i >= 0); float x[8]; unpk8(xr[i - 1], x); const float m = ok ? 1.f : 0.f;
#pragma unroll
                for (int j = 0; j < 8; ++j) sum[j] += m * x[j]; }
        } else {
            for (int i = 1; i < w; ++i) {
                const int tt = t - i;
                if (tt >= 0) { float x[8]; unpk8(*(const u32x4*)(PIN + (size_t)(row - i) * 512 + ch), x); _Pragma("unroll") for (int j = 0; j < 8; ++j) sum[j] += x[j]; }
                else { const float* s = st_pool + ((size_t)(layer * NB_S + b) * 15 + (15 + tt)) * 512 + ch; _Pragma("unroll") for (int j = 0; j < 8; ++j) sum[j] += s[j]; }
            }
        }
        const float cnt = (kind == 1) ? (float)w : fminf((float)w, (float)(t + 1));
        const float ic = 1.0f / cnt;
        f32x4 d0, d1;
#pragma unroll
        for (int j = 0; j < 8; ++j) { const float d = sum[j] * ic - cur[j]; if (j < 4) d0[j] = d; else d1[j - 4] = d; }
        *(u32x4*)(YD + (size_t)row * YK + YO_D + ch) = pk8(d0, d1);
    }
}

constexpr int GLA_UNITS = NB_P * 4 * 64;
constexpr int GP_K = 144, GP_V = 272;
constexpr int GLA_R0 = 0, GLA_R0_BYTES = 17408, GLA_QT = GLA_R0 + GLA_R0_BYTES, GLA_KT = GLA_QT + 64 * GP_K, GLA_VV = GLA_KT + 64 * GP_K, GLA_HALF = GLA_VV + 64 * GP_V;
static_assert(2 * GLA_HALF <= RING_BYTES, "GLA LDS");

__device__ __forceinline__ void gla_cumsum(LAS float* lb, const float* LA, int tok0, int h, int ht) {
    const int k = ht & 63, q = ht >> 6;
    float v[16]; float run = 0.f;
#pragma unroll
    for (int i = 0; i < 16; ++i) { run += LA[(size_t)(tok0 + 16 * q + i) * 256 + h * 64 + k]; v[i] = run; }
    LAS float* tot = lb + 4096;
    tot[q * 64 + k] = run;
    __syncthreads();
    float off = 0.f;
#pragma unroll
    for (int qq = 0; qq < 3; ++qq) off += (qq < q) ? tot[qq * 64 + k] : 0.f;
#pragma unroll
    for (int i = 0; i < 16; ++i) lb[(16 * q + i) * 64 + k] = v[i] + off;
    __syncthreads();
}

__device__ __forceinline__ void gla_ds_unit(LAS unsigned char* hl, const bf16* GK, const bf16* GV, const float* LA, float* DS, float* DEC, int unit, int ht) {
    const int n = unit & 63, bh = unit >> 6, h = bh & 3, b = bh >> 2;
    const int tok0 = b * SEQ + n * 64;
    const int lane = ht & 63, hw = ht >> 6, fr = lane & 15, g = lane >> 4;
    LAS float* lb = (LAS float*)(hl + GLA_R0);
    gla_cumsum(lb, LA, tok0, h, ht);
    for (int c = ht; c < 512; c += 256) {
        const int s = c >> 3, k0 = (c & 7) * 8;
        float kf[8]; unpk8(*(const u32x4*)(GK + (size_t)(tok0 + s) * 256 + h * 64 + k0), kf);
        f32x4 a0, a1;
#pragma unroll
        for (int j = 0; j < 8; ++j) { const float e = kf[j] * __expf(lb[63 * 64 + k0 + j] - lb[s * 64 + k0 + j]); if (j < 4) a0[j] = e; else a1[j - 4] = e; }
        *(LAS u32x4*)(hl + GLA_KT + s * GP_K + k0 * 2) = pk8(a0, a1);
    }
    for (int c = ht; c < 1024; c += 256) {
        const int s = c >> 4, v0 = (c & 15) * 8;
        *(LAS u32x4*)(hl + GLA_VV + s * GP_V + v0 * 2) = *(const u32x4*)(GV + (size_t)(tok0 + s) * 512 + h * 128 + v0);
    }
    if (ht < 64) DEC[(size_t)unit * 64 + ht] = __expf(lb[63 * 64 + ht]);
    __syncthreads();
    const int q4 = fr >> 2, p4 = fr & 3, kt = hw;
    float* dsb = DS + (size_t)unit * 64 * 128;
#pragma unroll
    for (int dvt = 0; dvt < 8; ++dvt) {
        f32x4 acc = {0.f, 0.f, 0.f, 0.f};
#pragma unroll
        for (int ks = 0; ks < 2; ++ks) {
            const int rb = 32 * ks + 4 * g + q4;
            const bf16x8 af = cat4(ds_tr16(hl + GLA_KT + rb * GP_K + (16 * kt + 4 * p4) * 2), ds_tr16(hl + GLA_KT + (rb + 16) * GP_K + (16 * kt + 4 * p4) * 2));
            const bf16x8 bf = cat4(ds_tr16(hl + GLA_VV + rb * GP_V + (16 * dvt + 4 * p4) * 2), ds_tr16(hl + GLA_VV + (rb + 16) * GP_V + (16 * dvt + 4 * p4) * 2));
            acc = __builtin_amdgcn_mfma_f32_16x16x32_bf16(af, bf, acc, 0, 0, 0);
        }
#pragma unroll
        for (int j = 0; j < 4; ++j) dsb[(size_t)(16 * kt + 4 * g + j) * 128 + 16 * dvt + fr] = acc[j];
    }
    __syncthreads();
}

__device__ __forceinline__ void gla_scan_pass(const float* DS, const float* DEC, bf16* SP, float* out, int layer, int gt, int rep = 1) {
    if (gt >= 8 * 64 * 128) return;
    for (int rr = 0; rr < rep; ++rr) {
    const int v = gt & 127, k = (gt >> 7) & 63, bh = gt >> 13;
    float S = 0.f;
    for (int n0 = 0; n0 < 64; n0 += 32) {
        float d[32], a[32];
#pragma unroll
        for (int i = 0; i < 32; ++i) { d[i] = DS[(((size_t)bh * 64 + n0 + i) * 64 + k) * 128 + v]; a[i] = DEC[((size_t)bh * 64 + n0 + i) * 64 + k]; }
#pragma unroll
        for (int i = 0; i < 32; ++i) { SP[(((size_t)bh * 64 + n0 + i) * 64 + k) * 128 + v] = (bf16)f2bf(S); S = a[i] * S + d[i]; }
    }
    out[OFF_GLA_P + (((size_t)layer * 8 + bh) * 64 + k) * 128 + v] = S;
    }
}

__device__ __forceinline__ void gla_out_unit(LAS unsigned char* hl, const bf16* GQ, const bf16* GK, const bf16* GV, const bf16* GR, const float* LA, const bf16* SP, const float* gnorm, bf16* YC, int unit, int ht) {
    const int n = unit & 63, bh = unit >> 6, h = bh & 3, b = bh >> 2;
    const int tok0 = b * SEQ + n * 64;
    const int lane = ht & 63, hw = ht >> 6, fr = lane & 15, g = lane >> 4;
    LAS float* lb = (LAS float*)(hl + GLA_R0);
    gla_cumsum(lb, LA, tok0, h, ht);
    for (int c = ht; c < 512; c += 256) {
        const int s = c >> 3, k0 = (c & 7) * 8;
        float qf[8], kf[8];
        unpk8(*(const u32x4*)(GQ + (size_t)(tok0 + s) * 256 + h * 64 + k0), qf);
        unpk8(*(const u32x4*)(GK + (size_t)(tok0 + s) * 256 + h * 64 + k0), kf);
        f32x4 a0, a1, c0, c1;
#pragma unroll
        for (int j = 0; j < 8; ++j) { const float bb = lb[s * 64 + k0 + j]; const float qe = qf[j] * __expf(bb), ke = kf[j] * __expf(-bb); if (j < 4) { a0[j] = qe; c0[j] = ke; } else { a1[j - 4] = qe; c1[j - 4] = ke; } }
        *(LAS u32x4*)(hl + GLA_QT + s * GP_K + k0 * 2) = pk8(a0, a1);
        *(LAS u32x4*)(hl + GLA_KT + s * GP_K + k0 * 2) = pk8(c0, c1);
    }
    for (int c = ht; c < 1024; c += 256) {
        const int s = c >> 4, v0 = (c & 15) * 8;
        *(LAS u32x4*)(hl + GLA_VV + s * GP_V + v0 * 2) = *(const u32x4*)(GV + (size_t)(tok0 + s) * 512 + h * 128 + v0);
    }
    __syncthreads();
    for (int c = ht; c < 1024; c += 256) {
        const int k = c >> 4, v0 = (c & 15) * 8;
        *(LAS u32x4*)(hl + GLA_R0 + k * GP_V + v0 * 2) = *(const u32x4*)(SP + ((size_t)unit * 64 + k) * 128 + v0);
    }
    __syncthreads();
    const int tt = hw, q4 = fr >> 2, p4 = fr & 3;
    f32x4 at[4];
    const LAS unsigned char* qrow = hl + GLA_QT + (16 * tt + fr) * GP_K;
    const bf16x8 qb0 = *(const LAS bf16x8*)(qrow + 16 * g), qb1 = *(const LAS bf16x8*)(qrow + 64 + 16 * g);
#pragma unroll
    for (int st = 0; st < 4; ++st) {
        const LAS unsigned char* krow = hl + GLA_KT + (16 * st + fr) * GP_K;
        f32x4 a = {0.f, 0.f, 0.f, 0.f};
        a = __builtin_amdgcn_mfma_f32_16x16x32_bf16(*(const LAS bf16x8*)(krow + 16 * g), qb0, a, 0, 0, 0);
        a = __builtin_amdgcn_mfma_f32_16x16x32_bf16(*(const LAS bf16x8*)(krow + 64 + 16 * g), qb1, a, 0, 0, 0);
#pragma unroll
        for (int j = 0; j < 4; ++j) { const int s = 16 * st + 4 * g + j, t = 16 * tt + fr; a[j] = (s <= t) ? a[j] : 0.f; }
        at[st] = a;
    }
    f32x4 o[8];
#pragma unroll
    for (int dvt = 0; dvt < 8; ++dvt) o[dvt] = (f32x4){0.f, 0.f, 0.f, 0.f};
#pragma unroll
    for (int ks = 0; ks < 2; ++ks) {
        const bf16x8 pb = pk8v(at[2 * ks], at[2 * ks + 1]);
        const int rb = 32 * ks + 4 * g + q4;
        const s16x4 qa = *(const LAS s16x4*)(qrow + (32 * ks + 4 * g) * 2), qc = *(const LAS s16x4*)(qrow + (32 * ks + 16 + 4 * g) * 2);
        const bf16x8 qp = cat4(qa, qc);
#pragma unroll
        for (int dvt = 0; dvt < 8; ++dvt) {
            const bf16x8 vf = cat4(ds_tr16(hl + GLA_VV + rb * GP_V + (16 * dvt + 4 * p4) * 2), ds_tr16(hl + GLA_VV + (rb + 16) * GP_V + (16 * dvt + 4 * p4) * 2));
            o[dvt] = __builtin_amdgcn_mfma_f32_16x16x32_bf16(vf, pb, o[dvt], 0, 0, 0);
            const bf16x8 sf = cat4(ds_tr16(hl + GLA_R0 + rb * GP_V + (16 * dvt + 4 * p4) * 2), ds_tr16(hl + GLA_R0 + (rb + 16) * GP_V + (16 * dvt + 4 * p4) * 2));
            o[dvt] = __builtin_amdgcn_mfma_f32_16x16x32_bf16(sf, qp, o[dvt], 0, 0, 0);
        }
    }
    float ss = 0.f;
#pragma unroll
    for (int dvt = 0; dvt < 8; ++dvt) ss += (o[dvt][0] * o[dvt][0] + o[dvt][1] * o[dvt][1]) + (o[dvt][2] * o[dvt][2] + o[dvt][3] * o[dvt][3]);
    ss += shx(ss, 16, lane); ss += shx(ss, 32, lane);
    const float rs = rsqrtf(ss * (1.0f / 128.0f) + EPS);
    const size_t orow = (size_t)(tok0 + 16 * tt + fr) * 512 + h * 128, yrow = (size_t)(tok0 + 16 * tt + fr) * YK + YO_C + h * 128;
#pragma unroll
    for (int dvt = 0; dvt < 8; ++dvt) {
        const int dv = 16 * dvt + 4 * g;
        const f32x4 gn = *(const f32x4*)(gnorm + dv);
        const u32x2 gw = *(const u32x2*)(GR + orow + dv);
        f32x4 y; y[0] = o[dvt][0] * rs * gn[0] * bflo(gw.x); y[1] = o[dvt][1] * rs * gn[1] * bfhi(gw.x); y[2] = o[dvt][2] * rs * gn[2] * bflo(gw.y); y[3] = o[dvt][3] * rs * gn[3] * bfhi(gw.y);
        u32x2 wv; wv.x = pk2(y[0], y[1]); wv.y = pk2(y[2], y[3]);
        *(u32x2*)(YC + yrow + dv) = wv;
    }
    __syncthreads();
}

__device__ __forceinline__ void gla_sample_unit(LAS float* red, const bf16* GQ, const bf16* GK, const bf16* GV, const bf16* GR, const float* LA, const float* st_gla, const float* gnorm, bf16* YC, float* out, int layer, int unit, int tid) {
    const int h = unit & 3, b = unit >> 2;
    const int dv = tid & 127, kq = tid >> 7;
    const float* s0 = st_gla + (((size_t)(layer * NB_S + b) * 4 + h) * 64 + 16 * kq) * 128 + dv;
    float S[16];
#pragma unroll
    for (int i = 0; i < 16; ++i) S[i] = s0[(size_t)i * 128];
#pragma unroll 1
    for (int t = 0; t < TS; ++t) {
        const int row = MP + b * TS + t;
        const float vv = bf2f(GV[(size_t)row * 512 + h * 128 + dv]);
        float po = 0.f;
#pragma unroll
        for (int i = 0; i < 16; ++i) {
            const int k = 16 * kq + i;
            const float a = __expf(LA[(size_t)row * 256 + h * 64 + k]);
            S[i] = a * S[i] + bf2f(GK[(size_t)row * 256 + h * 64 + k]) * vv;
            po += bf2f(GQ[(size_t)row * 256 + h * 64 + k]) * S[i];
        }
        red[kq * 128 + dv] = po;
        __syncthreads();
        float o = 0.f, sq = 0.f;
        if (kq == 0) { o = (red[dv] + red[128 + dv]) + (red[256 + dv] + red[384 + dv]); sq = o * o; }
        sq = wave_sum(sq, tid & 63);
        if (kq == 0 && (tid & 63) == 0) red[512 + (tid >> 6)] = sq;
        __syncthreads();
        if (kq == 0) {
            const float rs = rsqrtf((red[512] + red[513]) * (1.0f / 128.0f) + EPS);
            const float y = o * rs * gnorm[dv] * bf2f(GR[(size_t)row * 512 + h * 128 + dv]);
            YC[(size_t)row * YK + YO_C + h * 128 + dv] = (bf16)f2bf(y);
        }
        __syncthreads();
    }
    float* so = out + OFF_GLA_S + (((size_t)(layer * NB_S + b) * 4 + h) * 64 + 16 * kq) * 128 + dv;
#pragma unroll
    for (int i = 0; i < 16; ++i) so[(size_t)i * 128] = S[i];
}

constexpr int PH_PER_LAYER = 13, NPH = 1 + DEPTH * PH_PER_LAYER;
#define RM(bit) (1 + ((PROBE_DUP >> (bit)) & 1))
#define REP(bit) for (int rep_ = 0; rep_ < 1 + ((PROBE_DUP >> (bit)) & 1); ++rep_)
#ifndef PROBE_SP2
#define PROBE_SP2 true
#endif
#ifndef PROBE_ALIGN_GU
#define PROBE_ALIGN_GU true
#endif
#ifndef PROBE_ALIGN_RES
#define PROBE_ALIGN_RES true
#endif
#ifndef PROBE_ALIGN_WIN
#define PROBE_ALIGN_WIN true
#endif
#ifndef MK_UNROLL_LAYERS
#define MK_UNROLL_LAYERS 1
#endif
#ifndef MK_PER_PHASE
#define MK_PER_PHASE 0
#endif

struct Args { const float* in[31]; float* out; unsigned char* ws; int ph_lo, ph_hi; };
static_assert(sizeof(Args) == 31 * 8 + 8 + 8 + 8, "Args has no padding");

__device__ __forceinline__ unsigned char* launder(unsigned char* p) { unsigned long long v = (unsigned long long)p; asm volatile("" : "+s"(v)); return (unsigned char*)(GAS unsigned char*)v; }
__device__ __forceinline__ int opq_v(int x) { asm volatile("" : "+v"(x)); return x; }
__device__ __forceinline__ int opq_s(int x) { asm volatile("" : "+s"(x)); return x; }

#define IN(k) (lo <= (k) && (k) < hi)
#define SEAM(k) do { if (IN((k) + 1)) { XcdBarrier bar_; bar_.bar = (unsigned*)(WSP() + WS_CTL) + CW_BAR; bar_.x = xb_xcc_id(); bar_.st = (volatile LAS unsigned*)(lds + MISC_OFF) + 8; REP(13) xcd_barrier(bar_, tid); } } while (0)
#define GW (bid * NWAVES + wave)
#define NGW (G * NWAVES)
#define GT (bid * NTHR + tid)
#define NGT (G * NTHR)
#define WSP() launder((unsigned char*)ldp(lds, PT_WS))
#define IDS() const int wave = opq_s(wave0), lane = (int)__builtin_amdgcn_mbcnt_hi(~0u, __builtin_amdgcn_mbcnt_lo(~0u, (unsigned)opq_v(0))), tid = wave * 64 + lane, G = opq_s(G0), bid = opq_s(bid0); (void)lane; (void)wave; (void)G; (void)bid
struct Ctx { LAS unsigned char* lds; int tid0, wave0, G0, bid0, lo, hi; };
#define CTX_LOCALS() LAS unsigned char* lds = c.lds; const int tid0 = c.tid0, wave0 = c.wave0, G0 = c.G0, bid0 = c.bid0, lo = c.lo, hi = c.hi; (void)lds; (void)tid0; (void)wave0; (void)G0; (void)bid0; (void)lo; (void)hi

__device__ __forceinline__ void ff_part(const Ctx c, const int l, const int f) {
    CTX_LOCALS();
    const int pb = 1 + l * PH_PER_LAYER;
    const int fb = pb + (f ? 10 : 0);
    if (IN(fb + 1)) {
        { IDS(); unsigned char* ws = WSP(); const bf16* wl = (const bf16*)(ws + WS_W) + (size_t)l * WE_LAYER;
          pg8::Gemm g{(const bf16*)(ws + WS_XN), wl + (f ? WE_GU2 : WE_GU1), MP, NGU, DM}; pg8::StaticOrder S; S.init(MP, NGU, G, bid, RM(4));
          EpiSwiGLU E{ws, 3 * l + (f ? 2 : 0)};
          pg8::gemm_phase<EpiSwiGLU, pg8::StaticOrder, PROBE_ALIGN_GU, PROBE_SP2, true>(lds + RING_OFF, g, S, E, tid); }
        { IDS(); unsigned char* ws = WSP(); const bf16* wl = (const bf16*)(ws + WS_W) + (size_t)l * WE_LAYER; EpiSwiGLU E{ws, 3 * l + (f ? 2 : 0)};
          for (int su = G - 1 - bid; su < RM(9) * (NGU / 64); su += G) skinny_unit<EpiSwiGLU>(lds + RING_OFF, (const bf16*)(ws + WS_XN), wl + (f ? WE_GU2 : WE_GU1), DM, su % (NGU / 64), E, tid); }
        { IDS(); unsigned char* ws = WSP();
          const int dfirst = (f == 0) ? l * PB_LAYER + 1376 : (l + 1) * PB_LAYER;
          if (G == 256 && bid >= DEFER_WG0 && (f == 0 || l < DEPTH - 1)) prologue_blocks(lds, (bf16*)(ws + WS_W), dfirst, DEFER_N + DEFER_X, bid - DEFER_WG0, DEFER_WGS, tid, false, DEFER_N, (f == 0) ? 688 : 1376);
          { const int slot = 2 * l + f; const int c0 = (int)((long)CACHE_COPY_N * slot / 10), c1 = (slot == 7) ? CACHE_COPY_N : (int)((long)CACHE_COPY_N * (slot + 1) / 10);
            if (G == 256) { if (bid >= DEFER_WG0) cache_copy_range(ldp(lds, 3), ldp(lds, 4), ldp(lds, 5), (float*)ldp(lds, PT_OUT), c0, c1, (bid - DEFER_WG0) * NTHR + tid, DEFER_WGS * NTHR); }
            else cache_copy_range(ldp(lds, 3), ldp(lds, 4), ldp(lds, 5), (float*)ldp(lds, PT_OUT), c0, c1, GT, NGT); } }
        IDS();
        SEAM(fb + 1);
    }
    if (IN(fb + 2)) {
        { IDS(); unsigned char* ws = WSP(); const bf16* wl = (const bf16*)(ws + WS_W) + (size_t)l * WE_LAYER;
          pg8::Gemm g{(const bf16*)(ws + WS_H), wl + (f ? WE_D2 : WE_D1), MP, DM, DFF}; pg8::StaticOrder S; S.init(MP, DM, G, bid, RM(10));
          EpiResid E{ws, lds, 0.5f, (f == 1 && l == DEPTH - 1) ? 1 : 0, (f == 0) ? 3 * l + 1 : (l < DEPTH - 1 ? 3 * l + 3 : -1)};
          pg8::gemm_phase<EpiResid, pg8::StaticOrder, PROBE_ALIGN_RES, PROBE_SP2, true>(lds + RING_OFF, g, S, E, tid); }
        { IDS(); unsigned char* ws = WSP(); const bf16* wl = (const bf16*)(ws + WS_W) + (size_t)l * WE_LAYER; EpiResid E{ws, lds, 0.5f, (f == 1 && l == DEPTH - 1) ? 1 : 0, (f == 0) ? 3 * l + 1 : (l < DEPTH - 1 ? 3 * l + 3 : -1)};
          for (int su = G - 1 - bid; su < DM / 64; su += G) skinny_unit<EpiResid>(lds + RING_OFF, (const bf16*)(ws + WS_H), wl + (f ? WE_D2 : WE_D1), DFF, su, E, tid); }
        IDS();
        SEAM(fb + 2);
    }
}

__device__ __forceinline__ void mixer_part(const Ctx c, const int l) {
    CTX_LOCALS();
    const int pb = 1 + l * PH_PER_LAYER;
    if (IN(pb + 4)) {
        { IDS(); unsigned char* ws = WSP(); const bf16* wl = (const bf16*)(ws + WS_W) + (size_t)l * WE_LAYER;
          pg8::Gemm g{(const bf16*)(ws + WS_XN), wl + WE_IN, MP, NWIN, DM}; pg8::StaticOrder S; S.init(MP, NWIN, G, bid, RM(3));
          EpiWin E{ws, ldp(lds, 15) + (size_t)l * 768, ldp(lds, 16) + (size_t)l * 768, ldp(lds, 18) + (size_t)l * 256, (float*)ldp(lds, PT_OUT), l, 3 * l + 1};
          pg8::gemm_phase<EpiWin, pg8::StaticOrder, PROBE_ALIGN_WIN, PROBE_SP2, true>(lds + RING_OFF, g, S, E, tid); }
        { IDS(); unsigned char* ws = WSP(); const bf16* wl = (const bf16*)(ws + WS_W) + (size_t)l * WE_LAYER;
          EpiWin E{ws, ldp(lds, 15) + (size_t)l * 768, ldp(lds, 16) + (size_t)l * 768, ldp(lds, 18) + (size_t)l * 256, (float*)ldp(lds, PT_OUT), l, 3 * l + 1};
          for (int su = G - 1 - bid; su < RM(9) * (NWIN / 64); su += G) skinny_unit<EpiWin>(lds + RING_OFF, (const bf16*)(ws + WS_XN), wl + WE_IN, DM, su % (NWIN / 64), E, tid); }
        IDS();
        SEAM(pb + 4);
    }
    if (IN(pb + 5)) {
        IDS();
        { unsigned char* ws = WSP();
          for (int u = bid; u < RM(1) * ATT_UNITS; u += G) attn_unit(lds, (const bf16*)(ws + WS_Q), (const bf16*)(ws + WS_K), (const bf16*)(ws + WS_V), (float*)(ws + WS_AO), (float*)(ws + WS_LSE), u % ATT_UNITS, tid); }
        { unsigned char* ws = WSP();
          for (int u2 = bid; u2 < RM(5) * (GLA_UNITS / 2); u2 += G) gla_ds_unit(lds + (tid >> 8) * GLA_HALF, (const bf16*)(ws + WS_GK), (const bf16*)(ws + WS_GV), (const float*)(ws + WS_LA), (float*)(ws + WS_DS), (float*)(ws + WS_DEC), 2 * (u2 % (GLA_UNITS / 2)) + (tid >> 8), tid & 255); }
        { unsigned char* ws = WSP();
          conv_pool_pass((const bf16*)(ws + WS_CB), (const bf16*)(ws + WS_U), (const bf16*)(ws + WS_PIN), ldp(lds, 14), ldp(lds, 2), ldp(lds, 7), (bf16*)(ws + WS_YCAT), (bf16*)(ws + WS_YCAT), l, GT, NGT, RM(6)); }
        REP(8) { const int su = (NGW - 1 - GW);
          if (su < NB_S * TS * 12) { unsigned char* ws = WSP(); attn_sample_wave((const bf16*)(ws + WS_Q), (const bf16*)(ws + WS_K), (const bf16*)(ws + WS_V), ldp(lds, 3), ldp(lds, 4), ldp(lds, 5), (float*)(ws + WS_AO), (float*)(ws + WS_LSE), l, su, lane); } }
        REP(8) { unsigned char* ws = WSP();
          for (int u = bid - 64; u >= 0 && u < NB_S * 4; u += G) gla_sample_unit((LAS float*)lds, (const bf16*)(ws + WS_GQ), (const bf16*)(ws + WS_GK), (const bf16*)(ws + WS_GV), (const bf16*)(ws + WS_GR), (const float*)(ws + WS_LA), ldp(lds, 6), ldp(lds, 19) + (size_t)l * 128, (bf16*)(ws + WS_YCAT), (float*)ldp(lds, PT_OUT), l, u, tid); }
        SEAM(pb + 5);
    }
    if (IN(pb + 6)) {
        IDS(); unsigned char* ws = WSP();
        gla_scan_pass((const float*)(ws + WS_DS), (const float*)(ws + WS_DEC), (bf16*)(ws + WS_SP), (float*)ldp(lds, PT_OUT), l, GT, RM(7));
        attn_merge_pass((const float*)(ws + WS_AO), (const float*)(ws + WS_LSE), (bf16*)(ws + WS_YCAT), GT, NGT, RM(7));
        SEAM(pb + 6);
    }
    if (IN(pb + 7)) {
        IDS(); unsigned char* ws = WSP();
        for (int u2 = bid; u2 < RM(5) * (GLA_UNITS / 2); u2 += G) gla_out_unit(lds + (tid >> 8) * GLA_HALF, (const bf16*)(ws + WS_GQ), (const bf16*)(ws + WS_GK), (const bf16*)(ws + WS_GV), (const bf16*)(ws + WS_GR), (const float*)(ws + WS_LA), (const bf16*)(ws + WS_SP), ldp(lds, 19) + (size_t)l * 128, (bf16*)(ws + WS_YCAT), 2 * (u2 % (GLA_UNITS / 2)) + (tid >> 8), tid & 255);
        SEAM(pb + 7);
    }
    if (IN(pb + 8)) {
        REP(11) {
        { IDS(); unsigned char* ws = WSP(); const bf16* wl = (const bf16*)(ws + WS_W) + (size_t)l * WE_LAYER; pg8::StaticOrder S; S.init(MP, DM, G, bid);
          pg8::Gemm g{(const bf16*)(ws + WS_YCAT), wl + WE_UPCAT, MP, DM, YK}; EpiMergeCat E{ws};
          pg8::gemm_phase<EpiMergeCat, pg8::StaticOrder, true, PROBE_SP2>(lds + RING_OFF, g, S, E, tid); }
        { IDS(); unsigned char* ws = WSP(); const bf16* wl = (const bf16*)(ws + WS_W) + (size_t)l * WE_LAYER; const bf16* yc = (const bf16*)(ws + WS_YCAT); const bf16* uc = wl + WE_UPCAT;
          for (int su = G - 1 - bid; su < DM / 64; su += G) skinny_merge_unit(lds + RING_OFF, ws, yc, uc, su, tid); }
        }
        IDS();
        SEAM(pb + 8);
    }
    if (IN(pb + 9)) {
        { IDS(); unsigned char* ws = WSP(); const bf16* wl = (const bf16*)(ws + WS_W) + (size_t)l * WE_LAYER;
          pg8::Gemm g{(const bf16*)(ws + WS_MRG), wl + WE_OUT, MP, DM, DM}; pg8::StaticOrder S; S.init(MP, DM, G, bid, RM(12));
          EpiResid E{ws, lds, 1.0f, 0, 3 * l + 2};
#if (PROBE_DUP >> 14) & 1
          { pg8::Gemm g0{(const bf16*)(ws + WS_MRG), wl + WE_OUT, MP, DM, 256}; EpiResid E0{ws, lds, 0.0f, 0, -1};
            pg8::gemm_phase<EpiResid, pg8::StaticOrder, PROBE_ALIGN_RES, PROBE_SP2>(lds + RING_OFF, g0, S, E0, tid); }
#endif
          pg8::gemm_phase<EpiResid, pg8::StaticOrder, PROBE_ALIGN_RES, PROBE_SP2, true>(lds + RING_OFF, g, S, E, tid); }
        { IDS(); unsigned char* ws = WSP(); const bf16* wl = (const bf16*)(ws + WS_W) + (size_t)l * WE_LAYER; EpiResid E{ws, lds, 1.0f, 0, 3 * l + 2};
          for (int su = G - 1 - bid; su < DM / 64; su += G) skinny_unit<EpiResid>(lds + RING_OFF, (const bf16*)(ws + WS_MRG), wl + WE_OUT, DM, su, E, tid); }
        IDS();
        SEAM(pb + 9);
    }
}

__global__ void __launch_bounds__(NTHR, 2) fwd_kernel(Args args) {
    extern __shared__ __attribute__((aligned(16))) unsigned char lds_raw[];
    LAS unsigned char* lds = (LAS unsigned char*)lds_raw;
    const int tid0 = threadIdx.x; const int wave0 = __builtin_amdgcn_readfirstlane(tid0 >> 6);
    const int G0 = gridDim.x, bid0 = blockIdx.x;
    { const int tid = tid0; for (int u = tid; u < (LDS_BYTES - LDSCTL_OFF) / 4; u += NTHR) ((LAS unsigned*)(lds + LDSCTL_OFF))[u] = 0u; }
    __syncthreads();
    if (tid0 == 0) {
        LAS unsigned long long* pt = (LAS unsigned long long*)(lds + PT_OFF);
#pragma unroll
        for (int i = 0; i < 31; ++i) pt[i] = (unsigned long long)args.in[i];
        pt[PT_OUT] = (unsigned long long)args.out; pt[PT_WS] = (unsigned long long)args.ws;
    }
    __syncthreads();
    if (!MK_PER_PHASE) (void)xcd_barrier_post((unsigned*)(args.ws + WS_CTL) + CW_BAR, (volatile LAS unsigned*)(lds + MISC_OFF) + 8);
    const int lo = args.ph_lo, hi = args.ph_hi;

    if (IN(0)) {
        IDS(); unsigned char* ws = WSP(); float* out = (float*)ldp(lds, PT_OUT);
        REP(0) { prologue_blocks(lds, (bf16*)(ws + WS_W), 0, DEPTH * PB_LAYER, bid, G, tid, G == 256); prologue_specials(lds, (bf16*)(ws + WS_W), G - 1 - bid, G, tid); }
#if (PROBE_DUP >> 16) & 1
        prologue_blocks<1>(lds, (bf16*)(ws + WS_W), 0, DEPTH * PB_LAYER, bid, G, tid, G == 256);
#endif
#if (PROBE_DUP >> 17) & 1
        prologue_blocks<2>(lds, (bf16*)(ws + WS_W), 0, DEPTH * PB_LAYER, bid, G, tid, G == 256);
#endif
        x_init_pass(ldp(lds, 0), ldp(lds, 1), (bf16*)(ws + WS_XN), (unsigned long long*)(ws + WS_CTL + CTL_SS), GW, NGW, lane);
        { const f32x4* src = (const f32x4*)ldp(lds, 7); f32x4* dst = (f32x4*)(out + OFF_POOL_S); const int per = 11 * 128;
          for (int i = GT; i < DEPTH * NB_S * per; i += NGT) { const int lb = i / per, j = i - lb * per; dst[(size_t)lb * 15 * 128 + j] = src[(size_t)lb * 15 * 128 + 4 * 128 + j]; } }
        SEAM(0);
    }

    { Ctx c; c.lds = lds; c.tid0 = tid0; c.wave0 = wave0; c.G0 = G0; c.bid0 = bid0; c.lo = lo; c.hi = hi;
#if MK_UNROLL_LAYERS
      ff_part(c, 0, 0); mixer_part(c, 0); ff_part(c, 0, 1); ff_part(c, 1, 0); mixer_part(c, 1); ff_part(c, 1, 1);
      ff_part(c, 2, 0); mixer_part(c, 2); ff_part(c, 2, 1); ff_part(c, 3, 0); mixer_part(c, 3); ff_part(c, 3, 1);
#else
      _Pragma("unroll 1") for (int l = 0; l < DEPTH; ++l) {
          _Pragma("unroll 1") for (int f = 0; f < 2; ++f) { ff_part(c, l, f); if (f == 0) mixer_part(c, l); }
      }
#endif
    }
#undef IN
#undef SEAM
}

extern "C" void kernel_launch(void* const* d_in, const int* in_sizes, int n_in, void* d_out, int out_size, void* d_ws, size_t ws_size, hipStream_t stream) {
    static int grid = 0;
    if (grid == 0) {
        if (n_in != 31 || out_size != OUT_TOTAL || ws_size < WS_END) { fprintf(stderr, "kernel_launch: expected 31 inputs, %d outputs, >= %zu bytes ws; got %d, %d, %zu\n", OUT_TOTAL, (size_t)WS_END, n_in, out_size, ws_size); grid = -1; return; }
        int dev = 0, cus = 0, per_cu = 0;
        if (hipGetDevice(&dev) != hipSuccess || hipDeviceGetAttribute(&cus, hipDeviceAttributeMultiprocessorCount, dev) != hipSuccess) { grid = -1; return; }
        if (hipFuncSetAttribute((const void*)fwd_kernel, hipFuncAttributeMaxDynamicSharedMemorySize, LDS_BYTES) != hipSuccess) { fprintf(stderr, "kernel_launch: hipFuncSetAttribute failed\n"); grid = -1; return; }
        if (hipOccupancyMaxActiveBlocksPerMultiprocessor(&per_cu, (const void*)fwd_kernel, NTHR, LDS_BYTES) != hipSuccess || per_cu < 1) fprintf(stderr, "kernel_launch: occupancy query says %d\n", per_cu);
        (void)hipGetLastError();
        grid = cus;
    }
    if (grid < 0) return;
    if (hipMemsetAsync((char*)d_ws + WS_CTL, 0, CTL_ZERO_BYTES, stream) != hipSuccess) return;
    Args a; memset(&a, 0, sizeof(a));
    for (int i = 0; i < 31; ++i) a.in[i] = (const float*)d_in[i];
    a.out = (float*)d_out; a.ws = (unsigned char*)d_ws;
#if MK_PER_PHASE
    for (int ph = 0; ph < NPH; ++ph) { a.ph_lo = ph; a.ph_hi = ph + 1; hipLaunchKernelGGL(fwd_kernel, dim3(grid), dim3(NTHR), LDS_BYTES, stream, a); }
#else
    a.ph_lo = 0; a.ph_hi = NPH;
    hipLaunchKernelGGL(fwd_kernel, dim3(grid), dim3(NTHR), LDS_BYTES, stream, a);
#endif
    const hipError_t le = hipPeekAtLastError();
    if (le != hipSuccess) fprintf(stderr, "kernel_launch: launch failed: %s\n", hipGetErrorName(le));
}
```

```cpp
#include <hip/hip_runtime.h>
#include <cstdio>
#include <cstdint>
#include <cstring>
#ifndef PROBE_DUP
#define PROBE_DUP 0
#endif
namespace pg8 {
#define PG8_LAS __attribute__((address_space(3)))
typedef unsigned short bf16_t;
typedef short bf16x8 __attribute__((ext_vector_type(8)));
typedef float f32x4 __attribute__((ext_vector_type(4)));
typedef unsigned u32x4 __attribute__((ext_vector_type(4)));
constexpr int BM = 256, BK = 64, HALF = 128, HTB = HALF * BK * 2  , STAGE_BYTES = 8 * HTB, NXCD = 8, WGM = 8;

__host__ __device__ __forceinline__ int lds_byte(int r, int c) { const int st = (r >> 4) * 2 + (c >> 5), rr = r & 15, cc = c & 31, ob = rr * 64 + cc * 2; return st * 1024 + (ob ^ (((ob >> 9) & 1) << 5)); }
__host__ __device__ __forceinline__ void stage_rc(int b, int& R, int& C) { const int st = b / 1024, sb = b % 1024, swz = sb ^ (((sb >> 9) & 1) << 5); R = (st >> 1) * 16 + swz / 64; C = (st & 1) * 32 + (swz % 64) / 2; }
__host__ __device__ __forceinline__ int perm32(int rho) { const int n = rho >> 4, i = rho & 15; return 8 * (i >> 2) + 4 * n + (i & 3); }

struct Unit { int pm, pn, ri; };
struct Gemm { const bf16_t* A; const bf16_t* Bt; int M, N, K; };

struct StaticOrder {
    int nM, nN, nwg, G, c, rep;
    __host__ __device__ void init(int M, int N, int G_, int c_, int rep_ = 1) { nM = M / BM; nN = N / BM; nwg = nM * nN; G = G_; c = c_; rep = rep_; }
    __host__ __device__ bool next(int i, Unit& u) const {
        const long L = (long)i * G + c; if (L >= (long)rep * nwg) return false;
        int wgid = (int)(L % nwg);
#if (PROBE_DUP >> 15) & 1
        if (L >= nwg) wgid = 0;
#endif
        { const int q = nwg / NXCD, r = nwg % NXCD, xcd = wgid % NXCD, off = wgid / NXCD; wgid = (xcd < r ? xcd * (q + 1) : r * (q + 1) + (xcd - r) * q) + off; }
        const int nig = WGM * nN, gid = wgid / nig, fm = gid * WGM, gsz = (nM - fm) < WGM ? (nM - fm) : WGM;
        u.pm = fm + ((wgid % nig) % gsz); u.pn = (wgid % nig) / gsz; u.ri = (int)(L / nwg); return true;
    }
    __device__ __forceinline__ void a_ready(const Unit&) const {}
    __device__ __forceinline__ void done(const Unit&) const {}
};

template <class Epi, class Sched, bool ALIGN_EPI = false, bool SP2 = false, bool A_TILED = false>
__device__ __forceinline__ void gemm_phase(PG8_LAS unsigned char* lds, const Gemm g, const Sched S, const Epi E, const int tid) {
    const int wid = __builtin_amdgcn_readfirstlane(tid >> 6), lane = tid & 63, wr = wid >> 2, wc = wid & 3, fr = lane & 15, fq = lane >> 4;
    const int K = g.K, nt = K / BK;
    unsigned voffA[2], voffB[2];
#pragma unroll
    for (int i = 0; i < 2; ++i) { int R, C; stage_rc(tid * 16 + i * 8192, R, C); const int Rb = Epi::PERM ? ((R & ~31) + perm32(R & 31)) : R;
        voffA[i] = A_TILED ? (unsigned)(tid * 16 + i * 8192) : (unsigned)(R * K + C) * 2u; voffB[i] = (unsigned)(tid * 16 + i * 8192); (void)Rb; }
    const size_t kstep = A_TILED ? (size_t)32768 : (size_t)(BK * 2);
    const size_t hstep = A_TILED ? (size_t)16384 : (size_t)HALF * K * 2;
    const size_t tstep = A_TILED ? (size_t)nt * 32768 : 2 * hstep;
    const size_t kstepB = 32768, hstepB = 16384, tstepB = (size_t)nt * 32768;
    const unsigned ldsw = (unsigned)wid * 1024u;
    const int aoff = lds_byte(wr * 64 + fr, fq * 8), boff = lds_byte(wc * 32 + fr, fq * 8);
#define PG8_SA(b, h) (((b) * 2 + (h)) * HTB)
#define PG8_SB(b, h) ((4 + (b) * 2 + (h)) * HTB)
#define PG8_STAGE(bufoff, gbase, voff) do { _Pragma("unroll") for (int _i = 0; _i < 2; ++_i) \
        __builtin_amdgcn_global_load_lds((const unsigned*)((const char*)(gbase) + (voff)[_i]), (PG8_LAS unsigned*)(lds + (bufoff) + ldsw + _i * 8192), 16, 0, 0); } while (0)
#define PG8_LDA(dst, b, h) do { _Pragma("unroll") for (int m = 0; m < 4; ++m) _Pragma("unroll") for (int k = 0; k < 2; ++k) dst[m][k] = *(const PG8_LAS bf16x8*)(lds + PG8_SA(b, h) + aoff + m * 2048 + k * 1024); } while (0)
#define PG8_LDB(dst, b, h) do { _Pragma("unroll") for (int n = 0; n < 2; ++n) _Pragma("unroll") for (int k = 0; k < 2; ++k) dst[n][k] = *(const PG8_LAS bf16x8*)(lds + PG8_SB(b, h) + boff + n * 2048 + k * 1024); } while (0)
#define PG8_MMA(ai, bj, At, Bt) do { __builtin_amdgcn_s_setprio(1); _Pragma("unroll") for (int m = 0; m < 4; ++m) _Pragma("unroll") for (int n = 0; n < 2; ++n) _Pragma("unroll") for (int k = 0; k < 2; ++k) \
        acc[ai][bj][m][n] = __builtin_amdgcn_mfma_f32_16x16x32_bf16(Bt[n][k], At[m][k], acc[ai][bj][m][n], 0, 0, 0); __builtin_amdgcn_s_setprio(0); } while (0)
#define PG8_WAIT_V(n) asm volatile("s_waitcnt vmcnt(" #n ")" ::: "memory")
#define PG8_WAIT_L(n) asm volatile("s_waitcnt lgkmcnt(" #n ")" ::: "memory")
#define PG8_BAR __builtin_amdgcn_s_barrier()
#define PG8_SCHED __builtin_amdgcn_sched_barrier(0)
    Unit cur, nxt; int ui = 0;
    if (!S.next(0, cur)) return;
    f32x4 acc[2][2][4][2];
#pragma unroll
    for (int a = 0; a < 2; ++a)
#pragma unroll
        for (int b = 0; b < 2; ++b)
#pragma unroll
            for (int m = 0; m < 4; ++m)
#pragma unroll
                for (int n = 0; n < 2; ++n) acc[a][b][m][n] = (f32x4){0.f, 0.f, 0.f, 0.f};
    bf16x8 At[4][2], B0[2][2], B1[2][2];
    const char* cA = (const char*)g.A + (size_t)cur.pm * tstep; const char* cB = (const char*)g.Bt + (size_t)cur.pn * tstepB;
    S.a_ready(cur);
    if constexpr (SP2) {
        PG8_STAGE(PG8_SB(0, 0), cB, voffB); PG8_STAGE(PG8_SB(0, 1), cB + hstepB, voffB); PG8_STAGE(PG8_SA(0, 0), cA, voffA); PG8_STAGE(PG8_SA(0, 1), cA + hstep, voffA);
        if (wr == 1) PG8_BAR;
        PG8_WAIT_V(2); PG8_BAR;
        PG8_STAGE(PG8_SB(1, 0), cB + kstepB, voffB); PG8_STAGE(PG8_SA(1, 0), cA + kstep, voffA); PG8_STAGE(PG8_SB(1, 1), cB + hstepB + kstepB, voffB);
        PG8_WAIT_V(6); PG8_BAR;
    } else {
        PG8_STAGE(PG8_SB(0, 0), cB, voffB); PG8_STAGE(PG8_SA(0, 0), cA, voffA); PG8_STAGE(PG8_SB(0, 1), cB + hstepB, voffB); PG8_STAGE(PG8_SA(0, 1), cA + hstep, voffA);
        if (wr == 1) PG8_BAR;
        PG8_WAIT_V(4); PG8_BAR;
        PG8_STAGE(PG8_SB(1, 0), cB + kstepB, voffB); PG8_STAGE(PG8_SA(1, 0), cA + kstep, voffA); PG8_STAGE(PG8_SB(1, 1), cB + hstepB + kstepB, voffB);
        PG8_WAIT_V(6); PG8_BAR;
    }
    for (;;) {
        const bool has_next = S.next(ui + 1, nxt);
        const char* nA = has_next ? (const char*)g.A + (size_t)nxt.pm * tstep : cA; const char* nB = has_next ? (const char*)g.Bt + (size_t)nxt.pn * tstepB : cB;
        for (int t = 0; t < nt; t += 2) {
            const bool last = (t == nt - 2);
            const char* a1 = cA + (size_t)(t + 1) * kstep;
            const char* a2 = last ? nA : cA + (size_t)(t + 2) * kstep; const char* b2 = last ? nB : cB + (size_t)(t + 2) * kstepB;
            const char* a3 = a2 + kstep; const char* b3 = b2 + kstepB;
            if (last && has_next) S.a_ready(nxt);
            if constexpr (Epi::HAS_MID) { if (t == 8 || t == 12 || t == 20) E.mid(acc, cur, t, wr, wc, fr, fq); }
            if constexpr (SP2) {
            PG8_LDB(B0, 0, 0); PG8_LDB(B1, 0, 1); PG8_SCHED; PG8_LDA(At, 0, 0); PG8_STAGE(PG8_SA(1, 1), a1 + hstep, voffA);
            PG8_WAIT_V(8); PG8_WAIT_L(0); PG8_BAR; PG8_MMA(0, 0, At, B0); PG8_MMA(0, 1, At, B1); PG8_BAR; PG8_SCHED;
            PG8_LDA(At, 0, 1); PG8_STAGE(PG8_SB(0, 0), b2, voffB); PG8_STAGE(PG8_SB(0, 1), b2 + hstepB, voffB); PG8_STAGE(PG8_SA(0, 0), a2, voffA);
            PG8_WAIT_V(8); PG8_WAIT_L(0); PG8_BAR; PG8_MMA(1, 0, At, B0); PG8_MMA(1, 1, At, B1); PG8_BAR; PG8_SCHED;
            PG8_LDB(B0, 1, 0); PG8_LDB(B1, 1, 1); PG8_SCHED; PG8_LDA(At, 1, 0); PG8_STAGE(PG8_SA(0, 1), a2 + hstep, voffA);
            PG8_WAIT_V(8); PG8_WAIT_L(0); PG8_BAR; PG8_MMA(0, 0, At, B0); PG8_MMA(0, 1, At, B1); PG8_BAR; PG8_SCHED;
            PG8_LDA(At, 1, 1); PG8_STAGE(PG8_SB(1, 0), b3, voffB); PG8_STAGE(PG8_SB(1, 1), b3 + hstepB, voffB); PG8_STAGE(PG8_SA(1, 0), a3, voffA);
            PG8_WAIT_V(8); PG8_WAIT_L(0); PG8_BAR; PG8_MMA(1, 0, At, B0); PG8_MMA(1, 1, At, B1); PG8_BAR; PG8_SCHED;
            } else {
            PG8_LDB(B0, 0, 0); PG8_SCHED; PG8_LDA(At, 0, 0); PG8_STAGE(PG8_SA(1, 1), a1 + hstep, voffA);
            PG8_WAIT_L(8); PG8_BAR; PG8_WAIT_L(0); PG8_MMA(0, 0, At, B0); PG8_BAR; PG8_SCHED;
            PG8_LDB(B1, 0, 1); PG8_STAGE(PG8_SB(0, 0), b2, voffB);
            PG8_BAR; PG8_WAIT_L(0); PG8_MMA(0, 1, At, B1); PG8_BAR;
            PG8_LDA(At, 0, 1); PG8_STAGE(PG8_SA(0, 0), a2, voffA);
            PG8_BAR; PG8_WAIT_L(0); PG8_MMA(1, 0, At, B0); PG8_BAR; PG8_SCHED;
            PG8_STAGE(PG8_SB(0, 1), b2 + hstepB, voffB);
            PG8_WAIT_V(6); PG8_BAR; PG8_MMA(1, 1, At, B1); PG8_BAR;
            PG8_LDB(B0, 1, 0); PG8_SCHED; PG8_LDA(At, 1, 0); PG8_STAGE(PG8_SA(0, 1), a2 + hstep, voffA);
            PG8_WAIT_L(8); PG8_BAR; PG8_WAIT_L(0); PG8_MMA(0, 0, At, B0); PG8_BAR; PG8_SCHED;
            PG8_LDB(B1, 1, 1); PG8_STAGE(PG8_SB(1, 0), b3, voffB);
            PG8_BAR; PG8_WAIT_L(0); PG8_MMA(0, 1, At, B1); PG8_BAR;
            PG8_LDA(At, 1, 1); PG8_STAGE(PG8_SA(1, 0), a3, voffA);
            PG8_BAR; PG8_WAIT_L(0); PG8_MMA(1, 0, At, B0); PG8_BAR; PG8_SCHED;
            PG8_STAGE(PG8_SB(1, 1), b3 + hstepB, voffB);
            PG8_WAIT_V(6); PG8_BAR; PG8_MMA(1, 1, At, B1); PG8_BAR;
            }
        }
        if constexpr (ALIGN_EPI) { if (wr == 0) PG8_BAR; }
        if constexpr (!Epi::AFTER_DRAIN) { E(acc, cur, wr, wc, fr, fq); S.done(cur); }
        if (!has_next) break;
#pragma unroll
        for (int a = 0; a < 2; ++a)
#pragma unroll
            for (int b = 0; b < 2; ++b)
#pragma unroll
                for (int m = 0; m < 4; ++m)
#pragma unroll
                    for (int n = 0; n < 2; ++n) acc[a][b][m][n] = (f32x4){0.f, 0.f, 0.f, 0.f};
        cur = nxt; cA = nA; cB = nB; ++ui;
        if constexpr (ALIGN_EPI) { if (wr == 1) PG8_BAR; }
    }
    PG8_WAIT_V(0);
    if constexpr (!ALIGN_EPI) { if (wr == 0) PG8_BAR; }
    PG8_BAR;
    if constexpr (Epi::AFTER_DRAIN) { E.fused(acc, cur, wr, wc, fr, fq, lds, wid, lane); S.done(cur); }
#undef PG8_SA
#undef PG8_SB
#undef PG8_STAGE
#undef PG8_LDA
#undef PG8_LDB
#undef PG8_MMA
#undef PG8_WAIT_V
#undef PG8_WAIT_L
#undef PG8_BAR
#undef PG8_SCHED
}
}

constexpr int DM = 2048, DFF = 5504, DEPTH = 4;
constexpr int SEQ = 4096, NB_P = 2, MP = NB_P * SEQ;
constexpr int NB_S = 8, TS = 4, MS = NB_S * TS;
constexpr int MR = MP + MS;
constexpr int MPAD = 8448;
constexpr int PAST = 16384;
constexpr int N_IN = 14096, NWIN = 14336;
constexpr int NGU = 2 * DFF;
constexpr float EPS = 1e-6f;
constexpr int NWAVES = 8, NTHR = 512;

constexpr int C_CB = 0, C_CC = 512, C_CH = 1024, C_AQ = 1536, C_AK = 2304, C_AV = 3072, C_GQ = 3840, C_GK = 4096, C_GV = 4352, C_GR = 4864, C_LR = 5376, C_PIN = 5392, C_GATE = 5904;
constexpr int T_CONV = 0, T_CB = 4, T_Q = 6, T_K = 9, T_V = 12, T_GQ = 15, T_GK = 16, T_GV = 17, T_GR = 19, T_Z = 21, T_PIN = 22, T_GATE = 24;

constexpr int OFF_YP = 0;
constexpr int OFF_YS = OFF_YP + MP * DM;
constexpr int OFF_CONV_P = OFF_YS + MS * DM;
constexpr int OFF_CONV_S = OFF_CONV_P + DEPTH * NB_P * 2 * 512;
constexpr int OFF_W128_P = OFF_CONV_S + DEPTH * NB_S * 2 * 512;
constexpr int OFF_W128_S = OFF_W128_P + DEPTH * NB_P * 128 * 512;
constexpr int OFF_W512_P = OFF_W128_S + DEPTH * NB_S * 128 * 512;
constexpr int OFF_W512_S = OFF_W512_P + DEPTH * NB_P * 512 * 512;
constexpr int OFF_W2048_P = OFF_W512_S + DEPTH * NB_S * 512 * 512;
constexpr int OFF_W2048_S = OFF_W2048_P + DEPTH * NB_P * 2048 * 512;
constexpr int OFF_GLA_P = OFF_W2048_S + DEPTH * NB_S * 2048 * 512;
constexpr int OFF_GLA_S = OFF_GLA_P + DEPTH * NB_P * 4 * 64 * 128;
constexpr int OFF_POOL_P = OFF_GLA_S + DEPTH * NB_S * 4 * 64 * 128;
constexpr int OFF_POOL_S = OFF_POOL_P + DEPTH * NB_P * 15 * 512;
constexpr int OUT_TOTAL = OFF_POOL_S + DEPTH * NB_S * 15 * 512;
static_assert(OUT_TOTAL == 73551872, "output size");

constexpr size_t MiB = 1u << 20;
constexpr size_t WS_CTL = 0, CTL_ZERO_BYTES = 1 * MiB;
constexpr size_t SZ_ROW2K_F32 = (size_t)MPAD * DM * 4, SZ_ROW2K_BF = (size_t)MPAD * DM * 2;
constexpr size_t WS_X = WS_CTL + CTL_ZERO_BYTES;
constexpr size_t WS_XN = WS_X + SZ_ROW2K_F32;
constexpr size_t WS_H = WS_XN + SZ_ROW2K_BF;
constexpr size_t WS_CB = WS_H + (size_t)MPAD * DFF * 2;
constexpr size_t WS_U = WS_CB + (size_t)MPAD * 512 * 2;
constexpr size_t WS_Q = WS_U + (size_t)MPAD * 512 * 2;
constexpr size_t WS_K = WS_Q + (size_t)MPAD * 768 * 2;
constexpr size_t WS_V = WS_K + (size_t)MPAD * 768 * 2;
constexpr size_t WS_GQ = WS_V + (size_t)MPAD * 768 * 2;
constexpr size_t WS_GK = WS_GQ + (size_t)MPAD * 256 * 2;
constexpr size_t WS_GV = WS_GK + (size_t)MPAD * 256 * 2;
constexpr size_t WS_GR = WS_GV + (size_t)MPAD * 512 * 2;
constexpr size_t WS_LA = WS_GR + (size_t)MPAD * 512 * 2;
constexpr size_t WS_PIN = WS_LA + (size_t)MPAD * 256 * 4;
constexpr size_t WS_GATE = WS_PIN + (size_t)MPAD * 512 * 2;
constexpr int YK = 1792, YO_A = 0, YO_B = 512, YO_C = 768, YO_D = 1280;
constexpr size_t WS_YCAT = WS_GATE + (size_t)MPAD * 8192 * 2;
constexpr size_t WS_AO = WS_YCAT + (size_t)MPAD * YK * 2;
constexpr size_t WS_LSE = WS_AO + (size_t)MPAD * 768 * 4;
constexpr size_t WS_DS = WS_LSE + (size_t)MPAD * 12 * 4;
constexpr size_t WS_DEC = WS_DS + (size_t)8 * 64 * 64 * 128 * 4;
constexpr size_t WS_SP = WS_DEC + (size_t)8 * 64 * 64 * 4;
constexpr size_t WS_PM = WS_SP + (size_t)8 * 64 * 64 * 128 * 2;
constexpr size_t WS_MRG = WS_PM + (size_t)(MPAD - MP) * DM * 4;
constexpr size_t WS_W = WS_MRG + SZ_ROW2K_BF;
constexpr size_t WE_GU1 = 0;
constexpr size_t WE_D1 = WE_GU1 + (size_t)NGU * DM;
constexpr size_t WE_IN = WE_D1 + (size_t)DM * DFF;
constexpr size_t WE_UPCAT = WE_IN + (size_t)NWIN * DM;
constexpr size_t WE_OUT = WE_UPCAT + (size_t)DM * YK;
constexpr size_t WE_GU2 = WE_OUT + (size_t)DM * DM;
constexpr size_t WE_D2 = WE_GU2 + (size_t)NGU * DM;
constexpr size_t WE_LAYER = WE_D2 + (size_t)DM * DFF;
static_assert(WE_LAYER == 104857600, "layer weights");
constexpr size_t WS_END = WS_W + (size_t)DEPTH * WE_LAYER * 2;
static_assert(WS_X % 256 == 0 && WS_W % 256 == 0 && WS_LSE % 256 == 0 && WS_DS % 256 == 0, "alignment");

constexpr int CW_BAR = 4096;
constexpr size_t CTL_SS = 65536;
constexpr float SS_FIX = 16777216.0f;
static_assert(CTL_SS + 12 * (size_t)MPAD * 8 <= CTL_ZERO_BYTES, "SS fits the zeroed control region");

constexpr int RING_OFF = 0, RING_BYTES = 131072;
constexpr int LDSCTL_OFF = RING_BYTES, MISC_OFF = LDSCTL_OFF + 320;
constexpr int LDS_BYTES = 147456;

#define GAS __attribute__((address_space(1)))
#define LAS __attribute__((address_space(3)))
#define GAS __attribute__((address_space(1)))
typedef unsigned short bf16;
typedef unsigned u32x4 __attribute__((ext_vector_type(4)));
typedef unsigned u32x2 __attribute__((ext_vector_type(2)));
typedef float f32x4 __attribute__((ext_vector_type(4)));
typedef float f32x2 __attribute__((ext_vector_type(2)));
typedef short bf16x8 __attribute__((ext_vector_type(8)));
typedef short s16x4 __attribute__((ext_vector_type(4)));
#define LDS_WAIT() asm volatile("s_waitcnt lgkmcnt(0)" ::: "memory")
#define VM_WAIT() asm volatile("s_waitcnt vmcnt(0)" ::: "memory")
__device__ __forceinline__ unsigned f2bf(float f) { unsigned u = __builtin_bit_cast(unsigned, f); return (u + 0x7fffu + ((u >> 16) & 1u)) >> 16; }
__device__ __forceinline__ unsigned pk2(float lo, float hi) { return f2bf(lo) | (f2bf(hi) << 16); }
__device__ __forceinline__ float bflo(unsigned w) { return __builtin_bit_cast(float, w << 16); }
__device__ __forceinline__ float bfhi(unsigned w) { return __builtin_bit_cast(float, w & 0xffff0000u); }
__device__ __forceinline__ float bf2f(bf16 b) { return __builtin_bit_cast(float, ((unsigned)b) << 16); }
__device__ __forceinline__ u32x4 pk8(f32x4 a, f32x4 b) { u32x4 w; w.x = pk2(a[0], a[1]); w.y = pk2(a[2], a[3]); w.z = pk2(b[0], b[1]); w.w = pk2(b[2], b[3]); return w; }
__device__ __forceinline__ void unpk8(u32x4 w, float (&f)[8]) { f[0] = bflo(w.x); f[1] = bfhi(w.x); f[2] = bflo(w.y); f[3] = bfhi(w.y); f[4] = bflo(w.z); f[5] = bfhi(w.z); f[6] = bflo(w.w); f[7] = bfhi(w.w); }
__device__ __forceinline__ float sigmoidf_(float x) { return __builtin_amdgcn_rcpf(1.0f + __expf(-x)); }
__device__ __forceinline__ float siluf_(float x) { return x * sigmoidf_(x); }
__device__ __forceinline__ float shx(float v, int m, int lane) { return __builtin_bit_cast(float, __builtin_amdgcn_ds_bpermute((lane ^ m) << 2, __builtin_bit_cast(int, v))); }
__device__ __forceinline__ float rdl(float v, int j) { return __builtin_bit_cast(float, __builtin_amdgcn_readlane(__builtin_bit_cast(int, v), j)); }
__device__ __forceinline__ float wave_sum(float v, int lane) {
#pragma unroll
    for (int o = 1; o < 64; o <<= 1) v += shx(v, o, lane);
    return v;
}
__device__ __forceinline__ float wave_max(float v, int lane) {
#pragma unroll
    for (int o = 1; o < 64; o <<= 1) v = fmaxf(v, shx(v, o, lane));
    return v;
}
__device__ __forceinline__ int win_of(int gi) { return 128 << (2 * gi); }
__device__ __forceinline__ int dil_of(int gi) { return 1 << (2 * gi); }
__device__ __forceinline__ int offw_p(int gi) { return gi == 0 ? OFF_W128_P : (gi == 1 ? OFF_W512_P : OFF_W2048_P); }
__device__ __forceinline__ int offw_s(int gi) { return gi == 0 ? OFF_W128_S : (gi == 1 ? OFF_W512_S : OFF_W2048_S); }

#define XB_TMO      128
#define XB_XCNT(j)  (256  + 64 * (j))
#define XB_XSUB(j)  (1280 + 64 * (j))
#define XB_XGEN(j)  (2304 + 64 * (j))
#define XB_TOP      3328
#define XB_TOPGEN   3392
#define XCD_BAR_WORDS 3456
#define XB_SPIN_CAP (1u << 18)

__device__ __forceinline__ unsigned xb_ld(unsigned* p)              { return __hip_atomic_load(p, __ATOMIC_RELAXED, __HIP_MEMORY_SCOPE_AGENT); }
__device__ __forceinline__ unsigned xb_add(unsigned* p, unsigned v) { return __hip_atomic_fetch_add(p, v, __ATOMIC_RELAXED, __HIP_MEMORY_SCOPE_AGENT); }
__device__ __forceinline__ unsigned xb_xcc_id() { return (unsigned)__builtin_amdgcn_s_getreg((3 << 11) | 20) & 0xFu; }
#define XB_SPIN(cond, bar) do { unsigned _sp = 0; while (cond) { __builtin_amdgcn_s_sleep(1); \
    if ((++_sp & 255u) == 0u) { if (xb_ld(&(bar)[XB_TMO])) break; if (_sp > XB_SPIN_CAP) { atomicAdd(&(bar)[XB_TMO], 1u); break; } } } } while (0)

struct XcdBarrier {
    unsigned* bar; unsigned x;
    volatile LAS unsigned* st;
};
__device__ __forceinline__ XcdBarrier xcd_barrier_post(unsigned* bar, volatile LAS unsigned* st) {
    XcdBarrier b; b.bar = bar; b.x = xb_xcc_id(); b.st = st;
    if (threadIdx.x == 0) (void)xb_add(&bar[XB_XCNT(b.x)], 1u);
    return b;
}
__device__ __forceinline__ void xcd_barrier_complete(unsigned* bar, unsigned x, unsigned& nloc, unsigned& nx) {
    const unsigned G = gridDim.x * gridDim.y * gridDim.z;
    unsigned sum, cnt, mine, sp = 0u;
    for (;;) {
        sum = 0u; cnt = 0u; mine = 0u;
#pragma unroll
        for (unsigned j = 0; j < 16; ++j) { const unsigned c = xb_ld(&bar[XB_XCNT(j)]); sum += c; cnt += (c > 0u) ? 1u : 0u; mine = (j == x) ? c : mine; }
        if (sum == G) break;
        __builtin_amdgcn_s_sleep(1);
        if ((++sp & 255u) == 0u) { if (xb_ld(&bar[XB_TMO])) break; if (sp > XB_SPIN_CAP) { atomicAdd(&bar[XB_TMO], 1u); break; } }
    }
    nloc = mine > 0u ? mine : 1u; nx = cnt > 0u ? cnt : 1u;
}
__device__ __forceinline__ void xcd_barrier(const XcdBarrier& b, const int tid) {
    asm volatile("s_waitcnt vmcnt(0)" ::: "memory");
    __syncthreads();
    if (tid == 0) {
        unsigned* bar = b.bar;
        __builtin_amdgcn_s_waitcnt(0);
        unsigned nloc = b.st[0], nx = b.st[1];
        if (nloc == 0u) { xcd_barrier_complete(bar, b.x, nloc, nx); b.st[0] = nloc; b.st[1] = nx; }
        const unsigned old = xb_add(&bar[XB_XSUB(b.x)], 1u);
        const unsigned gen = old / nloc;
        if (old + 1u == (gen + 1u) * nloc) {
            __builtin_amdgcn_fence(__ATOMIC_RELEASE, "agent");
            asm volatile("s_waitcnt vmcnt(0)" ::: "memory");
            const unsigned og = xb_add(&bar[XB_TOP], 1u);
            const unsigned tg = og / nx;
            if (og + 1u == (tg + 1u) * nx) xb_add(&bar[XB_TOPGEN], 1u);
            else XB_SPIN(xb_ld(&bar[XB_TOPGEN]) == tg, bar);
            __builtin_amdgcn_fence(__ATOMIC_ACQUIRE, "agent");
            xb_add(&bar[XB_XGEN(b.x)], 1u);
            asm volatile("s_waitcnt vmcnt(0)" ::: "memory");
        } else {
            XB_SPIN(xb_ld(&bar[XB_XGEN(b.x)]) == gen, bar);
            __builtin_amdgcn_fence(__ATOMIC_ACQUIRE, "agent");
            asm volatile("s_waitcnt vmcnt(0)" ::: "memory");
        }
    }
    __syncthreads();
}

constexpr int PT_OFF = LDSCTL_OFF;
constexpr int PT_OUT = 31, PT_WS = 32;
__device__ __forceinline__ const float* ldp(LAS unsigned char* lds, int i) {
    const unsigned long long v = *(volatile LAS unsigned long long*)(lds + PT_OFF + 8 * i);
    const unsigned lo = __builtin_amdgcn_readfirstlane((unsigned)v), hi = __builtin_amdgcn_readfirstlane((unsigned)(v >> 32));
    return (const float*)(const GAS float*)(((unsigned long long)hi << 32) | lo);
}

typedef f32x4 (&AccRef)[2][2][4][2];

__device__ __forceinline__ void row_decode(int row, int& kind, int& b, int& t) {
    if (row < MP) { kind = 0; b = row >> 12; t = row & 4095; }
    else if (row < MR) { kind = 1; b = (row - MP) >> 2; t = (row - MP) & 3; }
    else { kind = 2; b = 0; t = 0; }
}


#ifndef EPI_NT
#define EPI_NT 0
#endif
#if EPI_NT
#define EPI_ST(ptr, val) __builtin_nontemporal_store((val), (ptr))
#else
#define EPI_ST(ptr, val) (*(ptr) = (val))
#endif
typedef _Float16 h16x4 __attribute__((ext_vector_type(4)));
typedef _Float16 h16x8 __attribute__((ext_vector_type(8)));
constexpr size_t RAT_STRIDE = (size_t)MPAD * DM;

template <bool SK> __device__ __forceinline__ void scale_rows_rstd(AccRef acc, const unsigned long long* ss, int row0) {
#pragma unroll
    for (int ai = 0; ai < (SK ? 1 : 2); ++ai)
#pragma unroll
        for (int m = 0; m < (SK ? 2 : 4); ++m) {
            const float r = rsqrtf((float)ss[row0 + ai * 128 + m * 16] * (1.0f / (SS_FIX * DM)) + EPS);
#pragma unroll
            for (int bj = 0; bj < 2; ++bj)
#pragma unroll
                for (int n = 0; n < 2; ++n) acc[ai][bj][m][n] *= r;
        }
}

struct EpiSwiGLU {
    static constexpr bool PERM = false, AFTER_DRAIN = false, HAS_MID = false;
    unsigned char* ws; int nid;
    __device__ __forceinline__ void operator()(AccRef acc, const pg8::Unit& u, int wr, int wc, int fr, int fq) const { run<false>(acc, u, wr, wc, fr, fq); }
    template <bool SK> __device__ __forceinline__ void run(AccRef acc, const pg8::Unit& u, int wr, int wc, int fr_, int fq_) const {
        int fr = fr_, fq = fq_; asm volatile("" : "+v"(fr), "+v"(fq));
        bf16* H = (bf16*)(ws + WS_H);
        const int row0 = u.pm * 256 + wr * 64 + fr, col0 = u.pn * 128 + wc * 32 + 8 * fq;
        scale_rows_rstd<SK>(acc, (const unsigned long long*)(ws + WS_CTL + CTL_SS) + (size_t)nid * MPAD, row0);
#pragma unroll
        for (int ai = 0; ai < (SK ? 1 : 2); ++ai)
#pragma unroll
            for (int m = 0; m < (SK ? 2 : 4); ++m) {
                bf16* p = SK ? H + (size_t)(row0 + ai * 128 + m * 16) * DFF + col0
                             : (bf16*)((char*)H + ((size_t)(u.pm * (DFF / 64) + 2 * u.pn + (wc >> 1)) * 2 + ai) * 16384 + ((4 * wr + m) * 2 + (wc & 1)) * 1024 + ((fr * 64 + 16 * fq) ^ ((fr >> 3) << 5)));
                f32x4 h0, h1;
#pragma unroll
                for (int j = 0; j < 4; ++j) { h0[j] = siluf_(acc[ai][0][m][0][j]) * acc[ai][1][m][0][j]; h1[j] = siluf_(acc[ai][0][m][1][j]) * acc[ai][1][m][1][j]; }
                EPI_ST((u32x4*)p, pk8(h0, h1));
            }
    }
};

struct EpiResid {
    static constexpr bool PERM = false, AFTER_DRAIN = false, HAS_MID = false;
    unsigned char* ws; LAS unsigned char* lds; float scale; int fin; int nid;
    __device__ __forceinline__ void operator()(AccRef acc, const pg8::Unit& u, int wr, int wc, int fr, int fq) const { run<false>(acc, u, wr, wc, fr, fq); }
    template <bool SK> __device__ __forceinline__ void run(AccRef acc, const pg8::Unit& u, int wr, int wc, int fr_, int fq_) const {
        int fr = fr_, fq = fq_; asm volatile("" : "+v"(fr), "+v"(fq));
        bf16* XB = (bf16*)(ws + WS_XN);
        unsigned long long* ssp = (unsigned long long*)(ws + WS_CTL + CTL_SS) + (size_t)(nid < 0 ? 0 : nid) * MPAD;
        float* out = fin ? (float*)ldp(lds, PT_OUT) : nullptr;
        const float scale = (u.ri == 0) ? this->scale : 0.f; const int nid = (u.ri == 0) ? this->nid : -1;
        const int row0 = u.pm * 256 + wr * 64 + fr, col0 = u.pn * 256 + wc * 32 + 8 * fq;
#pragma unroll
        for (int ai = 0; ai < (SK ? 1 : 2); ++ai)
#pragma unroll
            for (int m = 0; m < (SK ? 2 : 4); ++m) {
                const int row = row0 + ai * 128 + m * 16;
                char* xr = (char*)XB + (SK ? ((size_t)row * DM + col0) * 2
                                           : ((size_t)(u.pm * (DM / 64) + 4 * u.pn + (wc >> 1)) * 2 + ai) * 16384 + ((4 * wr + m) * 2 + (wc & 1)) * 1024 + ((fr * 64 + 16 * fq) ^ ((fr >> 3) << 5)));
                constexpr size_t BJS = SK ? 256 : 65536;
                float sq = 0.f;
#pragma unroll
                for (int bj = 0; bj < 2; ++bj) {
                    float xo[8]; unpk8(*(const u32x4*)(xr + bj * BJS), xo);
                    f32x4 v0, v1;
#pragma unroll
                    for (int j = 0; j < 4; ++j) { v0[j] = xo[j] + scale * acc[ai][bj][m][0][j]; v1[j] = xo[4 + j] + scale * acc[ai][bj][m][1][j]; }
                    if (out != nullptr && row < MR) { float* o = out + (size_t)row * DM + col0 + bj * 128; *(f32x4*)o = v0; *(f32x4*)(o + 4) = v1; }
                    const u32x4 w = pk8(v0, v1);
                    EPI_ST((u32x4*)(xr + bj * BJS), w);
                    float xn[8]; unpk8(w, xn);
#pragma unroll
                    for (int j = 0; j < 8; ++j) sq += xn[j] * xn[j];
                }
                { const int ln = fq * 16 + fr; sq += shx(sq, 16, ln); sq += shx(sq, 32, ln); }
                if (nid >= 0 && fq == 0) atomicAdd(ssp + row, (unsigned long long)(sq * SS_FIX + 0.5f));
            }
    }
};

struct EpiMergeCat {
    static constexpr bool PERM = false, AFTER_DRAIN = false, HAS_MID = true;
    unsigned char* ws;
    __device__ __forceinline__ void apply(f32x4 (&acc)[2][2][4][2], const pg8::Unit& u, int s, int wr, int wc, int fr_, int fq_) const {
        int fr = fr_, fq = fq_; asm volatile("" : "+v"(fr), "+v"(fq));
        const _Float16* R = (const _Float16*)(ws + WS_GATE) + (size_t)s * RAT_STRIDE;
        const int row0 = u.pm * 256 + wr * 64 + fr, col0 = u.pn * 256 + wc * 32 + 8 * fq;
        h16x8 r[2][4][2];
#pragma unroll
        for (int ai = 0; ai < 2; ++ai)
#pragma unroll
            for (int m = 0; m < 4; ++m)
#pragma unroll
                for (int bj = 0; bj < 2; ++bj) r[ai][m][bj] = *(const h16x8*)(R + (size_t)(row0 + ai * 128 + m * 16) * DM + col0 + bj * 128);
#pragma unroll
        for (int ai = 0; ai < 2; ++ai)
#pragma unroll
            for (int m = 0; m < 4; ++m)
#pragma unroll
                for (int bj = 0; bj < 2; ++bj)
#pragma unroll
                    for (int j = 0; j < 4; ++j) { acc[ai][bj][m][0][j] *= (float)r[ai][m][bj][j]; acc[ai][bj][m][1][j] *= (float)r[ai][m][bj][4 + j]; }
    }
    __device__ __forceinline__ void mid(f32x4 (&acc)[2][2][4][2], const pg8::Unit& u, int t, int wr, int wc, int fr, int fq) const {
        apply(acc, u, (t == 8) ? 0 : (t == 12 ? 1 : 2), wr, wc, fr, fq);
    }
    __device__ __forceinline__ void operator()(AccRef acc, const pg8::Unit& u, int wr, int wc, int fr_, int fq_) const {
        apply(acc, u, 3, wr, wc, fr_, fq_);
        int fr = fr_, fq = fq_; asm volatile("" : "+v"(fr), "+v"(fq));
        bf16* MRG = (bf16*)(ws + WS_MRG);
        const int row0 = u.pm * 256 + wr * 64 + fr, col0 = u.pn * 256 + wc * 32 + 8 * fq;
#pragma unroll
        for (int ai = 0; ai < 2; ++ai)
#pragma unroll
            for (int m = 0; m < 4; ++m)
#pragma unroll
                for (int bj = 0; bj < 2; ++bj)
                    EPI_ST((u32x4*)((char*)MRG + ((size_t)(u.pm * (DM / 64) + 4 * u.pn + 2 * bj + (wc >> 1)) * 2 + ai) * 16384 + ((4 * wr + m) * 2 + (wc & 1)) * 1024 + ((fr * 64 + 16 * fq) ^ ((fr >> 3) << 5))),
                           pk8(acc[ai][bj][m][0], acc[ai][bj][m][1]));
    }
};
template <int MODE>
struct EpiMergeS {
    static constexpr bool PERM = false, AFTER_DRAIN = false, HAS_MID = false;
    unsigned char* ws; int br;
    template <bool SK> __device__ __forceinline__ void run(AccRef acc, const pg8::Unit& u, int wr, int wc, int fr, int fq) const {
        float* P = (float*)(ws + WS_PM); bf16* MRG = (bf16*)(ws + WS_MRG);
        const int row0 = u.pm * 256 + wr * 64 + fr, col0 = u.pn * 256 + wc * 32 + 8 * fq;
#pragma unroll
        for (int m = 0; m < 2; ++m) {
            const int row = row0 + m * 16;
#pragma unroll
            for (int bj = 0; bj < 2; ++bj) {
                const int c = col0 + bj * 128;
                float g[8];
                { const _Float16* R = (const _Float16*)(ws + WS_GATE) + (size_t)row * DM + c;
                  const h16x8 r3 = *(const h16x8*)(R + 3 * RAT_STRIDE);
#pragma unroll
                  for (int j = 0; j < 8; ++j) g[j] = (float)r3[j];
#pragma unroll
                  for (int s = 2; s >= 0; --s) if (s >= br) { const h16x8 rs = *(const h16x8*)(R + (size_t)s * RAT_STRIDE);
#pragma unroll
                      for (int j = 0; j < 8; ++j) g[j] *= (float)rs[j]; } }
                f32x4 v0, v1;
#pragma unroll
                for (int j = 0; j < 4; ++j) { v0[j] = g[j] * acc[0][bj][m][0][j]; v1[j] = g[4 + j] * acc[0][bj][m][1][j]; }
                float* pp = P + (size_t)(row - MP) * DM + c;
                if (MODE != 0) { v0 += *(const f32x4*)pp; v1 += *(const f32x4*)(pp + 4); }
                if (MODE == 2) *(u32x4*)(MRG + (size_t)row * DM + c) = pk8(v0, v1);
                else { *(f32x4*)pp = v0; *(f32x4*)(pp + 4) = v1; }
            }
        }
    }
};

struct EpiWin {
    static constexpr bool PERM = false, AFTER_DRAIN = false, HAS_MID = false;
    unsigned char* ws;
    const float *qgain, *kgain, *b_a;
    float* out; int layer; int nid;

    template <int ACT, bool SK>
    __device__ __forceinline__ void plain(AccRef acc, bf16* dst, int ldc, int cbase, int row0, int wc, int fq) const {
#pragma unroll
        for (int ai = 0; ai < (SK ? 1 : 2); ++ai)
#pragma unroll
            for (int m = 0; m < (SK ? 2 : 4); ++m) {
                bf16* p = dst + (size_t)(row0 + ai * 128 + m * 16) * ldc + cbase + wc * 32 + fq * 8;
#pragma unroll
                for (int bj = 0; bj < 2; ++bj) {
                    f32x4 v0 = acc[ai][bj][m][0], v1 = acc[ai][bj][m][1];
#pragma unroll
                    for (int j = 0; j < 4; ++j) {
                        if (ACT == 1) { v0[j] = sigmoidf_(v0[j]); v1[j] = sigmoidf_(v1[j]); }
                        if (ACT == 2) { v0[j] = siluf_(v0[j]); v1[j] = siluf_(v1[j]); }
                        if (ACT == 3) { v0[j] *= 0.125f; v1[j] *= 0.125f; }
                    }
                    EPI_ST((u32x4*)(p + bj * 128), pk8(v0, v1));
                }
            }
    }

    __device__ __forceinline__ void operator()(AccRef acc, const pg8::Unit& u, int wr, int wc, int fr, int fq) const { run<false>(acc, u, wr, wc, fr, fq); }
    template <bool SK> __device__ __forceinline__ void run(AccRef acc, const pg8::Unit& u, int wr, int wc, int fr_, int fq_) const {
        int fr = fr_, fq = fq_; asm volatile("" : "+v"(fr), "+v"(fq));
        const int pn = u.pn, row0 = u.pm * 256 + wr * 64 + fr, l = layer;
        scale_rows_rstd<SK>(acc, (const unsigned long long*)(ws + WS_CTL + CTL_SS) + (size_t)nid * MPAD, row0);
        if (pn < T_CB) {
            const int ch0 = 128 * pn + 32 * wc + 8 * fq;
#pragma unroll
            for (int ai = 0; ai < (SK ? 1 : 2); ++ai)
#pragma unroll
                for (int m = 0; m < (SK ? 2 : 4); ++m) {
                    const int row = row0 + ai * 128 + m * 16;
                    const f32x4 u0 = acc[ai][0][m][0] * acc[ai][1][m][0], u1 = acc[ai][0][m][1] * acc[ai][1][m][1];
                    *(u32x4*)((bf16*)(ws + WS_U) + (size_t)row * 512 + ch0) = pk8(u0, u1);
                    int kind, b, t; row_decode(row, kind, b, t);
                    if (kind == 0 && t >= SEQ - 2) { float* o = out + OFF_CONV_P + ((l * NB_P + b) * 2 + (t - (SEQ - 2))) * 512 + ch0; *(f32x4*)o = u0; *(f32x4*)(o + 4) = u1; }
                    if (kind == 1 && t >= TS - 2)  { float* o = out + OFF_CONV_S + ((l * NB_S + b) * 2 + (t - (TS - 2))) * 512 + ch0; *(f32x4*)o = u0; *(f32x4*)(o + 4) = u1; }
                }
        } else if (pn < T_Q) {
            plain<0, SK>(acc, (bf16*)(ws + WS_CB), 512, 256 * (pn - T_CB), row0, wc, fq);
        } else if (pn < T_V) {
            const bool isk = pn >= T_K; const int ti = isk ? pn - T_K : pn - T_Q; const int head = 4 * ti + wc;
            const float* gp = (isk ? kgain : qgain) + head * 64 + 8 * fq;
            f32x4 g[2][2];
#pragma unroll
            for (int bj = 0; bj < 2; ++bj) { g[bj][0] = *(const f32x4*)(gp + 32 * bj); g[bj][1] = *(const f32x4*)(gp + 32 * bj + 4); }
            bf16* dst = (bf16*)(ws + (isk ? WS_K : WS_Q));
            const int W = win_of(ti);
#pragma unroll
            for (int ai = 0; ai < (SK ? 1 : 2); ++ai)
#pragma unroll
                for (int m = 0; m < (SK ? 2 : 4); ++m) {
                    const int row = row0 + ai * 128 + m * 16;
                    float ss = 0.f;
#pragma unroll
                    for (int bj = 0; bj < 2; ++bj)
#pragma unroll
                        for (int n = 0; n < 2; ++n) { const f32x4 x = acc[ai][bj][m][n]; ss += (x[0] * x[0] + x[1] * x[1]) + (x[2] * x[2] + x[3] * x[3]); }
                    { const int ln = fq * 16 + fr; ss += shx(ss, 16, ln); ss += shx(ss, 32, ln); }
                    const float rs = rsqrtf(ss * (1.0f / 64.0f) + EPS);
                    int kind, b, t; row_decode(row, kind, b, t);
#pragma unroll
                    for (int bj = 0; bj < 2; ++bj) {
                        const f32x4 y0 = acc[ai][bj][m][0] * rs * g[bj][0], y1 = acc[ai][bj][m][1] * rs * g[bj][1];
                        *(u32x4*)(dst + (size_t)row * 768 + head * 64 + 32 * bj + 8 * fq) = pk8(y0, y1);
                        if (isk) {
                            const int e0 = 32 * bj + 8 * fq;
                            if (kind == 0 && t >= SEQ - W) { float* o = out + offw_p(ti) + ((((l * NB_P + b) * W + (t - (SEQ - W))) * 2 + 0) * 4 + wc) * 64 + e0; *(f32x4*)o = y0; *(f32x4*)(o + 4) = y1; }
                            if (kind == 1)                 { float* o = out + offw_s(ti) + ((((l * NB_S + b) * W + (W - TS + t)) * 2 + 0) * 4 + wc) * 64 + e0; *(f32x4*)o = y0; *(f32x4*)(o + 4) = y1; }
                        }
                    }
                }
        } else if (pn < T_GQ) {
            const int ti = pn - T_V;
            plain<0, SK>(acc, (bf16*)(ws + WS_V), 768, 256 * ti, row0, wc, fq);
            const int W = win_of(ti);
#pragma unroll
            for (int ai = 0; ai < (SK ? 1 : 2); ++ai)
#pragma unroll
                for (int m = 0; m < (SK ? 2 : 4); ++m) {
                    const int row = row0 + ai * 128 + m * 16;
                    int kind, b, t; row_decode(row, kind, b, t);
#pragma unroll
                    for (int bj = 0; bj < 2; ++bj) {
                        const int hh = 2 * bj + (wc >> 1), e0 = 32 * (wc & 1) + 8 * fq;
                        if (kind == 0 && t >= SEQ - W) { float* o = out + offw_p(ti) + ((((l * NB_P + b) * W + (t - (SEQ - W))) * 2 + 1) * 4 + hh) * 64 + e0; *(f32x4*)o = acc[ai][bj][m][0]; *(f32x4*)(o + 4) = acc[ai][bj][m][1]; }
                        if (kind == 1)                 { float* o = out + offw_s(ti) + ((((l * NB_S + b) * W + (W - TS + t)) * 2 + 1) * 4 + hh) * 64 + e0; *(f32x4*)o = acc[ai][bj][m][0]; *(f32x4*)(o + 4) = acc[ai][bj][m][1]; }
                    }
                }
        } else if (pn == T_GQ) {
            plain<3, SK>(acc, (bf16*)(ws + WS_GQ), 256, 0, row0, wc, fq);
        } else if (pn == T_GK) {
            plain<0, SK>(acc, (bf16*)(ws + WS_GK), 256, 0, row0, wc, fq);
        } else if (pn < T_GR) {
            plain<0, SK>(acc, (bf16*)(ws + WS_GV), 512, 256 * (pn - T_GV), row0, wc, fq);
        } else if (pn < T_Z) {
            plain<2, SK>(acc, (bf16*)(ws + WS_GR), 512, 256 * (pn - T_GR), row0, wc, fq);
        } else if (pn == T_Z) {
#pragma unroll
            for (int bj = 0; bj < 2; ++bj) {
                const int c0 = 128 * bj + 32 * wc + 8 * fq;
                const f32x4 b0 = *(const f32x4*)(b_a + c0), b1 = *(const f32x4*)(b_a + c0 + 4);
#pragma unroll
                for (int ai = 0; ai < (SK ? 1 : 2); ++ai)
#pragma unroll
                    for (int m = 0; m < (SK ? 2 : 4); ++m) {
                        const int row = row0 + ai * 128 + m * 16;
                        f32x4 z0 = acc[ai][bj][m][0] + b0, z1 = acc[ai][bj][m][1] + b1;
#pragma unroll
                        for (int j = 0; j < 4; ++j) {
                            z0[j] = (fminf(z0[j], 0.f) - __logf(1.0f + __expf(-fabsf(z0[j])))) * (1.0f / 16.0f);
                            z1[j] = (fminf(z1[j], 0.f) - __logf(1.0f + __expf(-fabsf(z1[j])))) * (1.0f / 16.0f);
                        }
                        float* o = (float*)(ws + WS_LA) + (size_t)row * 256 + c0; *(f32x4*)o = z0; *(f32x4*)(o + 4) = z1;
                    }
            }
        } else if (pn < T_GATE) {
            const int ti = pn - T_PIN;
            plain<0, SK>(acc, (bf16*)(ws + WS_PIN), 512, 256 * ti, row0, wc, fq);
#pragma unroll
            for (int ai = 0; ai < (SK ? 1 : 2); ++ai)
#pragma unroll
                for (int m = 0; m < (SK ? 2 : 4); ++m) {
                    const int row = row0 + ai * 128 + m * 16;
                    int kind, b, t; row_decode(row, kind, b, t);
#pragma unroll
                    for (int bj = 0; bj < 2; ++bj) {
                        const int c0 = 256 * ti + 128 * bj + 32 * wc + 8 * fq;
                        if (kind == 0 && t >= SEQ - 15) { float* o = out + OFF_POOL_P + ((l * NB_P + b) * 15 + (t - (SEQ - 15))) * 512 + c0; *(f32x4*)o = acc[ai][bj][m][0]; *(f32x4*)(o + 4) = acc[ai][bj][m][1]; }
                        if (kind == 1)                  { float* o = out + OFF_POOL_S + ((l * NB_S + b) * 15 + (15 - TS + t)) * 512 + c0; *(f32x4*)o = acc[ai][bj][m][0]; *(f32x4*)(o + 4) = acc[ai][bj][m][1]; }
                    }
                }
        } else {
            _Float16* R = (_Float16*)(ws + WS_GATE);
            const int c0 = 64 * (pn - T_GATE) + 16 * wc + 4 * fq;
#pragma unroll
            for (int ai = 0; ai < (SK ? 1 : 2); ++ai)
#pragma unroll
                for (int m = 0; m < (SK ? 2 : 4); ++m) {
                    const size_t o = (size_t)(row0 + ai * 128 + m * 16) * DM + c0;
                    h16x4 r0, r1, r2, r3;
#pragma unroll
                    for (int j = 0; j < 4; ++j) {
                        const float d0 = fminf(1.0f + __expf(-acc[ai][0][m][0][j]), 16384.f), d1 = fminf(1.0f + __expf(-acc[ai][0][m][1][j]), 16384.f);
                        const float d2 = fminf(1.0f + __expf(-acc[ai][1][m][0][j]), 16384.f), d3 = fminf(1.0f + __expf(-acc[ai][1][m][1][j]), 16384.f);
                        const float i0 = __builtin_amdgcn_rcpf(d0), i1 = __builtin_amdgcn_rcpf(d1), i2 = __builtin_amdgcn_rcpf(d2), i3 = __builtin_amdgcn_rcpf(d3);
                        r0[j] = (_Float16)fminf(d1 * i0, 65504.f); r1[j] = (_Float16)fminf(d2 * i1, 65504.f); r2[j] = (_Float16)fminf(d3 * i2, 65504.f); r3[j] = (_Float16)i3;
                    }
                    EPI_ST((h16x4*)(R + o), r0); EPI_ST((h16x4*)(R + RAT_STRIDE + o), r1); EPI_ST((h16x4*)(R + 2 * RAT_STRIDE + o), r2); EPI_ST((h16x4*)(R + 3 * RAT_STRIDE + o), r3);
                }
        }
    }
};

__device__ __forceinline__ unsigned wt_lane(int wc, int fr, int g) { return (unsigned)(wc * 4096 + (g >> 1) * 1024 + ((fr * 64 + 32 * (g & 1)) ^ ((fr >> 3) << 5))); }
template <class Epi>
__device__ __forceinline__ void skinny_unit(LAS unsigned char* lds, const bf16* A, const bf16* Bt, int K, int su, const Epi E, int tid, int ld = 0) {
    if (ld == 0) ld = K;
    const int lane = tid & 63, w = __builtin_amdgcn_readfirstlane(tid >> 6), fr = lane & 15, g = lane >> 4;
    const int pn = su >> 2, wc = su & 3;
    const int nh = K >> 6, h0 = (w * nh) >> 3, h1 = ((w + 1) * nh) >> 3;
    f32x4 acc[2][2][2];
#pragma unroll
    for (int bj = 0; bj < 2; ++bj)
#pragma unroll
        for (int m = 0; m < 2; ++m)
#pragma unroll
            for (int n = 0; n < 2; ++n) acc[bj][m][n] = (f32x4){0.f, 0.f, 0.f, 0.f};
    const bf16* ap = A + (size_t)(MP + fr) * ld + 16 * g;
    const char* bp = (const char*)Bt + (size_t)pn * nh * 32768 + wt_lane(wc, fr, g);
    for (int hc = h0; hc < h1; hc += 4) {
        bf16x8 a[4][2][2], b[4][2][2][2];
#pragma unroll
        for (int q = 0; q < 4; ++q) {
            const int hq = (hc + q < h1) ? hc + q : h1 - 1;
#pragma unroll
            for (int s = 0; s < 2; ++s) {
#pragma unroll
                for (int m = 0; m < 2; ++m) a[q][m][s] = *(const bf16x8*)(ap + (size_t)(16 * m) * ld + 64 * hq + 8 * s);
#pragma unroll
                for (int bj = 0; bj < 2; ++bj)
#pragma unroll
                    for (int n = 0; n < 2; ++n) b[q][bj][n][s] = *(const bf16x8*)(bp + (size_t)hq * 32768 + bj * 16384 + n * 2048 + s * 16);
            }
        }
#pragma unroll
        for (int q = 0; q < 4; ++q) {
            const bool ok = hc + q < h1;
#pragma unroll
            for (int s = 0; s < 2; ++s)
#pragma unroll
                for (int m = 0; m < 2; ++m) {
                    bf16x8 av = a[q][m][s];
                    if (!ok) av = (bf16x8){0, 0, 0, 0, 0, 0, 0, 0};
#pragma unroll
                    for (int bj = 0; bj < 2; ++bj)
#pragma unroll
                        for (int n = 0; n < 2; ++n) acc[bj][m][n] = __builtin_amdgcn_mfma_f32_16x16x32_bf16(b[q][bj][n][s], av, acc[bj][m][n], 0, 0, 0);
                }
        }
    }
    LAS f32x4* red = (LAS f32x4*)lds;
#pragma unroll
    for (int bj = 0; bj < 2; ++bj)
#pragma unroll
        for (int m = 0; m < 2; ++m)
#pragma unroll
            for (int n = 0; n < 2; ++n) red[(w * 8 + (bj * 4 + m * 2 + n)) * 64 + lane] = acc[bj][m][n];
    __syncthreads();
    if (w == 0) {
        f32x4 full[2][2][4][2];
#pragma unroll
        for (int bj = 0; bj < 2; ++bj)
#pragma unroll
            for (int m = 0; m < 2; ++m)
#pragma unroll
                for (int n = 0; n < 2; ++n) {
                    f32x4 s = red[(bj * 4 + m * 2 + n) * 64 + lane];
#pragma unroll
                    for (int ww = 1; ww < 8; ++ww) s += red[(ww * 8 + (bj * 4 + m * 2 + n)) * 64 + lane];
                    asm volatile("" : "+v"(s) :: "memory");
                    full[0][bj][m][n] = s;
                }
        pg8::Unit u; u.pm = MP / 256; u.pn = pn; u.ri = 0;
        E.template run<true>(full, u, 0, wc, fr, g);
    }
    __syncthreads();
}

__device__ __forceinline__ void skinny_merge_unit(LAS unsigned char* lds, unsigned char* ws, const bf16* Y, const bf16* U, int su, int tid) {
    const int lane = tid & 63, w = __builtin_amdgcn_readfirstlane(tid >> 6), fr = lane & 15, g = lane >> 4;
    const int pn = su >> 2, wc = su & 3;
    f32x4 acc[2][2][2];
#pragma unroll
    for (int bj = 0; bj < 2; ++bj)
#pragma unroll
        for (int m = 0; m < 2; ++m)
#pragma unroll
            for (int n = 0; n < 2; ++n) acc[bj][m][n] = (f32x4){0.f, 0.f, 0.f, 0.f};
    if (w < 7) {
        const bf16* ap = Y + (size_t)(MP + fr) * YK + 16 * g + 256 * w;
        const char* bp = (const char*)U + (size_t)(pn * (YK / 64) + 4 * w) * 32768 + wt_lane(wc, fr, g);
        bf16x8 a[4][2][2], b[4][2][2][2];
#pragma unroll
        for (int q = 0; q < 4; ++q)
#pragma unroll
            for (int s2 = 0; s2 < 2; ++s2) {
#pragma unroll
                for (int m = 0; m < 2; ++m) a[q][m][s2] = *(const bf16x8*)(ap + (size_t)(16 * m) * YK + 64 * q + 8 * s2);
#pragma unroll
                for (int bj = 0; bj < 2; ++bj)
#pragma unroll
                    for (int n = 0; n < 2; ++n) b[q][bj][n][s2] = *(const bf16x8*)(bp + (size_t)q * 32768 + bj * 16384 + n * 2048 + s2 * 16);
            }
#pragma unroll
        for (int q = 0; q < 4; ++q)
#pragma unroll
            for (int s2 = 0; s2 < 2; ++s2)
#pragma unroll
                for (int m = 0; m < 2; ++m)
#pragma unroll
                    for (int bj = 0; bj < 2; ++bj)
#pragma unroll
                        for (int n = 0; n < 2; ++n) acc[bj][m][n] = __builtin_amdgcn_mfma_f32_16x16x32_bf16(b[q][bj][n][s2], a[q][m][s2], acc[bj][m][n], 0, 0, 0);
    }
    LAS f32x4* red = (LAS f32x4*)lds;
#pragma unroll
    for (int bj = 0; bj < 2; ++bj)
#pragma unroll
        for (int m = 0; m < 2; ++m)
#pragma unroll
            for (int n = 0; n < 2; ++n) red[(w * 8 + (bj * 4 + m * 2 + n)) * 64 + lane] = acc[bj][m][n];
    __syncthreads();
    if (w == 0) {
        bf16* MRG = (bf16*)(ws + WS_MRG);
        const int col0 = pn * 256 + wc * 32 + 8 * g;
#pragma unroll
        for (int m = 0; m < 2; ++m) {
            const int row = MP + 16 * m + fr;
#pragma unroll
            for (int bj = 0; bj < 2; ++bj) {
                const _Float16* R = (const _Float16*)(ws + WS_GATE) + (size_t)row * DM + col0 + bj * 128;
                const h16x8 r0 = *(const h16x8*)R, r1 = *(const h16x8*)(R + RAT_STRIDE), r2 = *(const h16x8*)(R + 2 * RAT_STRIDE), r3 = *(const h16x8*)(R + 3 * RAT_STRIDE);
                f32x4 o[2];
#pragma unroll
                for (int n = 0; n < 2; ++n) {
                    const int ti = bj * 4 + m * 2 + n;
                    const f32x4 pa = red[(0 * 8 + ti) * 64 + lane] + red[(1 * 8 + ti) * 64 + lane], pb = red[(2 * 8 + ti) * 64 + lane];
                    const f32x4 pc = red[(3 * 8 + ti) * 64 + lane] + red[(4 * 8 + ti) * 64 + lane], pd = red[(5 * 8 + ti) * 64 + lane] + red[(6 * 8 + ti) * 64 + lane];
#pragma unroll
                    for (int j = 0; j < 4; ++j) {
                        const float e3 = (float)r3[4 * n + j], e2 = (float)r2[4 * n + j] * e3, e1 = (float)r1[4 * n + j] * e2, e0 = (float)r0[4 * n + j] * e1;
                        o[n][j] = (e0 * pa[j] + e1 * pb[j]) + (e2 * pc[j] + e3 * pd[j]);
                    }
                }
                *(u32x4*)(MRG + (size_t)row * DM + col0 + bj * 128) = pk8(o[0], o[1]);
            }
        }
    }
    __syncthreads();
}

constexpr int IT_GU = 344 * 32, IT_D = 64 * 86, IT_IN = 448 * 32, IT_UPA = 64 * 8, IT_UPB = 64 * 4, IT_UPC = 64 * 8, IT_UPD = 64 * 8, IT_OUT = 64 * 32;
constexpr int IT_LAYER = 2 * IT_GU + 2 * IT_D + IT_IN + IT_UPA + IT_UPB + IT_UPC + IT_UPD + IT_OUT;
static_assert(IT_LAYER == 51200, "items per layer");

constexpr int PB_LAYER = 2 * 43 * 32 + 2 * 8 * 86 + 56 * 32 + 8 * 8 + 8 * 4 + 8 * 8 + 8 * 8 + 8 * 32;
static_assert(PB_LAYER == 6400, "blocks per layer");
constexpr int PB_P = 265;
constexpr int PB_PW_OFF = 69632;
struct BDesc { const float* src; const float* gain; bf16* dst; int ldw, K, kind, perm, aux0, aux1, aux2; };

__device__ __forceinline__ void pblk_decode(LAS unsigned char* lds, bf16* WB, int blk, int wave, int lane, BDesc& D) {
    const int l = blk / PB_LAYER; int r = blk % PB_LAYER;
    const int g = lane >> 3, c4 = lane & 7, bj = g >> 2, wc = g & 3;
    int wi, wi2, gi = -1, ldw, S0, k0, K, T, perm = 1, yo = 0; size_t wofs, woff;
    if (r < 2 * 1376) {
        const int f = r / 1376; r -= f * 1376; T = r % 43; const int kb = r / 43;
        wi = f ? 28 : 9; wi2 = f ? 29 : 10; wofs = (size_t)l * DM * DFF; ldw = DFF; S0 = 128 * T + 32 * wc; k0 = 64 * kb; K = DM; woff = f ? WE_GU2 : WE_GU1; gi = f ? 27 : 8;
    } else if ((r -= 2 * 1376) < 2 * 688) {
        const int f = r / 688; r -= f * 688; T = r % 8; const int kb = r / 8;
        wi = wi2 = f ? 30 : 11; wofs = (size_t)l * DFF * DM; ldw = DM; S0 = 256 * T + 32 * g; k0 = 64 * kb; K = DFF; woff = f ? WE_D2 : WE_D1;
    } else if ((r -= 2 * 688) < 1792) {
        T = r % 56; const int kb = r / 56, pn = T;
        wi = wi2 = 13; wofs = (size_t)l * DM * N_IN; ldw = N_IN; k0 = 64 * kb; K = DM; woff = WE_IN; gi = 12;
        if (pn < T_CB) S0 = (bj ? C_CH : C_CC) + 128 * pn + 32 * wc;
        else if (pn < T_Q) S0 = C_CB + 256 * (pn - T_CB) + 32 * g;
        else if (pn < T_K) S0 = C_AQ + 256 * (pn - T_Q) + 64 * wc + 32 * bj;
        else if (pn < T_V) S0 = C_AK + 256 * (pn - T_K) + 64 * wc + 32 * bj;
        else if (pn < T_GQ) S0 = C_AV + 256 * (pn - T_V) + 32 * g;
        else if (pn == T_GQ) S0 = C_GQ + 32 * g;
        else if (pn == T_GK) S0 = C_GK + 32 * g;
        else if (pn < T_GR) S0 = C_GV + 256 * (pn - T_GV) + 32 * g;
        else if (pn < T_Z) S0 = C_GR + 256 * (pn - T_GR) + 32 * g;
        else if (pn == T_Z) S0 = C_LR;
        else if (pn < T_GATE) S0 = C_PIN + 256 * (pn - T_PIN) + 32 * g;
        else { S0 = C_GATE + (2 * bj + (c4 >> 2)) * 2048 + 64 * (pn - T_GATE) + 16 * wc + 4 * (c4 & 3) - 4 * c4; perm = 0; }
    } else {
        r -= 1792; K = YK; woff = WE_UPCAT; ldw = DM; int kb;
        if (r < 64) { T = r % 8; kb = r / 8; wi = 22; wofs = (size_t)l * 512 * DM; yo = YO_A; }
        else if ((r -= 64) < 32) { T = r % 8; kb = r / 8; wi = 23; wofs = (size_t)l * 256 * DM; yo = YO_B; }
        else if ((r -= 32) < 64) { T = r % 8; kb = r / 8; wi = 24; wofs = (size_t)l * 512 * DM; yo = YO_C; }
        else if ((r -= 64) < 64) { T = r % 8; kb = r / 8; wi = 25; wofs = (size_t)l * 512 * DM; yo = YO_D; }
        else { r -= 64; T = r % 8; kb = r / 8; wi = 26; wofs = (size_t)l * DM * DM; K = DM; woff = WE_OUT; }
        wi2 = wi; S0 = 256 * T + 32 * g; k0 = 64 * kb;
    }
    const float* W0 = ldp(lds, wi); const float* W1 = ldp(lds, wi2); const float* gbase = ldp(lds, gi >= 0 ? gi : 8);
    D.src = (bj ? W1 : W0) + wofs + (size_t)(k0 + 8 * wave) * ldw + S0 + 4 * c4;
    D.gain = gi >= 0 ? gbase + (size_t)l * DM + k0 + 8 * wave : gbase;
    D.dst = WB + (size_t)l * WE_LAYER + woff + ((size_t)T * (K >> 6) + ((yo + k0) >> 6)) * 16384; D.ldw = ldw; D.K = K; D.kind = 0; D.perm = perm; D.aux0 = 0; D.aux1 = l; D.aux2 = gi >= 0;
}
__device__ __forceinline__ void pblk_load(const BDesc& D, f32x4 (&v)[8], f32x4 (&gv)[2]) {
#pragma unroll
    for (int i = 0; i < 8; ++i) v[i] = __builtin_nontemporal_load((const f32x4*)(D.src + (size_t)i * D.ldw));
    gv[0] = *(const f32x4*)D.gain; gv[1] = *(const f32x4*)(D.gain + 4);
}
template <int MODE = 0>
__device__ __forceinline__ void pblk_writeout(LAS unsigned char* lds, bf16* dst, int K, int perm, int tid) {
    LAS float* tile = (LAS float*)(lds + RING_OFF);
    const int lane = tid & 63, wave = tid >> 6;
    LDS_WAIT(); __builtin_amdgcn_s_barrier(); asm volatile("" ::: "memory");
    const int c = lane & 7;
#pragma unroll
    for (int j = 0; j < 4; ++j) {
        const int rho = (lane >> 3) + 8 * j; const int cc = perm ? pg8::perm32(rho) : rho;
        const LAS float* s = tile + (8 * c) * PB_P + 33 * wave + cc;
        u32x4 o; o.x = pk2(s[0 * PB_P], s[1 * PB_P]); o.y = pk2(s[2 * PB_P], s[3 * PB_P]); o.z = pk2(s[4 * PB_P], s[5 * PB_P]); o.w = pk2(s[6 * PB_P], s[7 * PB_P]);
        if (MODE == 0) *(u32x4*)((char*)dst + (wave >> 2) * 16384 + pg8::lds_byte(32 * (wave & 3) + rho, 8 * c)) = o; else asm volatile("" :: "v"(o));
    }
    LDS_WAIT(); __builtin_amdgcn_s_barrier(); asm volatile("" ::: "memory");
}
template <int MODE = 0>
__device__ __forceinline__ void pblk_finish(LAS unsigned char* lds, const BDesc& D, const f32x4 (&v)[8], const f32x4 (&gv)[2], int tid) {
    if (MODE == 2) { _Pragma("unroll") for (int i = 0; i < 8; ++i) asm volatile("" :: "v"(v[i])); return; }
    f32x4 g0 = gv[0], g1 = gv[1]; asm volatile("" : "+v"(g0), "+v"(g1) :: "memory");
    LAS float* tile = (LAS float*)(lds + RING_OFF);
    const int lane = tid & 63, wave = tid >> 6;
    const int g = lane >> 3, c4 = lane & 7;
#pragma unroll
    for (int i = 0; i < 8; ++i) { const float gk = D.aux2 ? (i < 4 ? g0[i & 3] : g1[i & 3]) : 1.0f; LAS float* s = tile + (8 * wave + i) * PB_P + 33 * g + 4 * c4; s[0] = v[i][0] * gk; s[1] = v[i][1] * gk; s[2] = v[i][2] * gk; s[3] = v[i][3] * gk; }
    pblk_writeout<MODE>(lds, D.dst, D.K, D.perm, tid);
}
__device__ __forceinline__ void prologue_specials(LAS unsigned char* lds, bf16* WB, int bid, int G, int tid) {
    LAS float* tile = (LAS float*)(lds + RING_OFF);
#pragma unroll 1
    for (int s = bid; s < DEPTH * 96; s += G) {
        const int l = s / 96, r = s % 96;
        bf16* wl = WB + (size_t)l * WE_LAYER;
        if (r < 32) {
            const int kb = r;
            const float* A2 = ldp(lds, 17) + (size_t)l * 16 * 256; const float* gmix = ldp(lds, 12) + (size_t)l * DM;
            const float* Wk = ldp(lds, 13) + (size_t)l * DM * N_IN + (size_t)(64 * kb) * N_IN + C_LR;
            const int c = tid & 255, half = tid >> 8;
            float w2[16];
#pragma unroll
            for (int q = 0; q < 16; ++q) w2[q] = A2[q * 256 + c];
#pragma unroll 4
            for (int i = 0; i < 32; ++i) {
                const int kk = 32 * half + i;
                const f32x4* a = (const f32x4*)(Wk + (size_t)kk * N_IN);
                float sum = 0.f;
#pragma unroll
                for (int q = 0; q < 4; ++q) { const f32x4 av = a[q]; sum += av[0] * w2[4 * q] + av[1] * w2[4 * q + 1] + av[2] * w2[4 * q + 2] + av[3] * w2[4 * q + 3]; }
                tile[kk * PB_P + 33 * (c >> 5) + (c & 31)] = sum * gmix[64 * kb + kk];
            }
            pblk_writeout(lds, wl + WE_IN + ((size_t)T_Z * (DM / 64) + kb) * 16384, DM, 1, tid);
        } else {
            const int q = r - 32, T = q % 8, kb = q / 8, gg = kb >> 1, i0 = (kb & 1) * 64;
            LAS float* pw = (LAS float*)(lds + PB_PW_OFF);
            { const f32x4* src = (const f32x4*)(ldp(lds, 20) + ((size_t)l * 4 + gg) * 128 * 128 + (size_t)i0 * 128);
              for (int e = tid; e < 64 * 32; e += NTHR) ((LAS f32x4*)pw)[e] = src[e]; }
            LDS_WAIT(); __builtin_amdgcn_s_barrier(); asm volatile("" ::: "memory");
            const int n = tid & 255, half = tid >> 8;
            const float* SC = ldp(lds, 21) + (size_t)l * 512 + gg * 128;
            const float* UD = ldp(lds, 25) + (size_t)l * 512 * DM + (size_t)(gg * 128) * DM + 256 * T + n;
            float a[32];
#pragma unroll
            for (int j = 0; j < 32; ++j) a[j] = 0.f;
#pragma unroll 2
            for (int c = 0; c < 128; ++c) {
                const float uv = UD[(size_t)c * DM] * SC[c];
#pragma unroll
                for (int j = 0; j < 32; ++j) a[j] += pw[(32 * half + j) * 128 + c] * uv;
            }
#pragma unroll
            for (int j = 0; j < 32; ++j) tile[(32 * half + j) * PB_P + 33 * (n >> 5) + (n & 31)] = a[j];
            pblk_writeout(lds, wl + WE_UPCAT + ((size_t)T * (YK / 64) + YO_D / 64 + kb) * 16384, YK, 1, tid);
        }
    }
}
constexpr int DEFER_WG0 = 96, DEFER_WGS = 160, DEFER_PER_WG = 9, DEFER_N = (DEFER_WGS * DEFER_PER_WG < 1376) ? DEFER_WGS * DEFER_PER_WG : 1376;
constexpr int TAIL_WGS = 224, TAIL_N = 568;
constexpr int DEFER_X = 224;
static_assert(DEFER_N == 1376, "the slot list jumps from the end of a gate|up matrix to a down matrix");
__device__ __forceinline__ bool pblk_deferred(int blk) {
    const int l = blk / PB_LAYER, r = blk % PB_LAYER;
    if (r < 1376) return l >= 1 && r < DEFER_N;
    if (r < 2 * 1376) return (r - 1376) < DEFER_N;
    if (r < 2 * 1376 + 688) return l >= 1 && (r - 2 * 1376) < DEFER_X;
    if (r < 2 * 1376 + 2 * 688) return (r - 2 * 1376 - 688) < DEFER_X;
    return l >= 1;
}
__device__ __forceinline__ bool pblk_special(int blk) {
    int r = blk % PB_LAYER - (2 * 1376 + 2 * 688);
    if (r < 0) return false;
    if (r < 1792) return (r % 56) == T_Z;
    r -= 1792 + 64 + 32 + 64; return r >= 0 && r < 64;
}
#define PB_BLK(i) (first + (i) + ((i) >= jump_at ? jump : 0))
#define PB_NEXT(I) { while (cand < count && ((skip_deferred && pblk_deferred(PB_BLK(cand))) || pblk_special(PB_BLK(cand)))) cand += stride; I = cand < count ? cand : -1; cand += stride; }
#define PB_LOAD(D, V, GV, I) { const int li_ = (I) >= 0 ? (I) : i0; pblk_decode(lds, WB, PB_BLK(li_), wave, lane, D); if ((I) < 0) { D.src = dummy; D.ldw = 0; } pblk_load(D, V, GV); }
#define PB_STEP(CUR, VCUR, GCUR, INEXT, NXT2, VNXT2, GNXT2, INXT2) { PB_NEXT(INXT2); \
        PB_LOAD(NXT2, VNXT2, GNXT2, INXT2) \
        pblk_finish<MODE>(lds, CUR, VCUR, GCUR, tid); \
        if (INEXT < 0) break; }
template <int MODE = 0>
__device__ __forceinline__ void prologue_blocks(LAS unsigned char* lds, bf16* WB, int first, int count, int start, int stride, int tid, bool skip_deferred, int jump_at = 0x7fffffff, int jump = 0) {
    const int lane = tid & 63, wave = __builtin_amdgcn_readfirstlane(tid >> 6);
    BDesc A, B, C; f32x4 va[8], vb[8], vc[8], ga[2], gb[2], gc[2];
    int cand = start, ia, ib, ic;
    PB_NEXT(ia); if (ia < 0) return;
    const int i0 = ia; const float* dummy = ldp(lds, 8) + 4 * lane;
    PB_LOAD(A, va, ga, ia)
    PB_NEXT(ib);
    PB_LOAD(B, vb, gb, ib)
#pragma unroll 1
    for (;;) {
        PB_STEP(A, va, ga, ib, C, vc, gc, ic)
        PB_STEP(B, vb, gb, ic, A, va, ga, ia)
        PB_STEP(C, vc, gc, ia, B, vb, gb, ib)
    }
}
#undef PB_STEP
#undef PB_LOAD
#undef PB_NEXT
#undef PB_BLK

__device__ __forceinline__ void x_init_pass(const float* xp, const float* xs, bf16* XB, unsigned long long* ss0, int gw, int NGW, int lane) {
    for (int row = gw; row < MPAD; row += NGW) {
        u32x2* o = (u32x2*)(XB + (size_t)row * DM) + lane;
        if (row < MP) {
            const int R = row & 127, C = 4 * (lane & 15);
            o = (u32x2*)((char*)XB + ((size_t)((row >> 8) * (DM / 64) + (lane >> 4)) * 2 + ((row >> 7) & 1)) * 16384 + pg8::lds_byte(R, C));
        }
        const int ostep = row < MP ? 4 * 32768 / 8 : 64;
        if (row >= MR) {
#pragma unroll
            for (int j = 0; j < 8; ++j) { u32x2 z; z.x = 0u; z.y = 0u; o[ostep * j] = z; }
            continue;
        }
        const f32x4* xr = (const f32x4*)(row < MP ? xp + (size_t)row * DM : xs + (size_t)(row - MP) * DM) + lane;
        float ss = 0.f;
#pragma unroll
        for (int j = 0; j < 8; ++j) { const f32x4 v = xr[64 * j]; u32x2 w; w.x = pk2(v[0], v[1]); w.y = pk2(v[2], v[3]); o[ostep * j] = w;
            const float a0 = bflo(w.x), a1 = bfhi(w.x), a2 = bflo(w.y), a3 = bfhi(w.y); ss += (a0 * a0 + a1 * a1) + (a2 * a2 + a3 * a3); }
        ss = wave_sum(ss, lane);
        if (lane == 0) ss0[row] = (unsigned long long)(ss * SS_FIX + 0.5f);
    }
}

constexpr int CC_N0 = DEPTH * NB_S * (128 - TS) * 128, CC_N1 = DEPTH * NB_S * (512 - TS) * 128, CC_N2 = DEPTH * NB_S * (2048 - TS) * 128, CACHE_COPY_N = CC_N0 + CC_N1 + CC_N2;
__device__ __forceinline__ void cache_copy_range(const float* c128, const float* c512, const float* c2048, float* out, int i0, int i1, int t, int nt) {
    for (int i = i0 + t; i < i1; i += nt) {
        int ii = i, gi = 0;
        if (ii >= CC_N0) { ii -= CC_N0; gi = 1; if (ii >= CC_N1) { ii -= CC_N1; gi = 2; } }
        const int W = win_of(gi), per = (W - TS) * 128, lb = ii / per, j = ii - lb * per;
        const f32x4* src = (const f32x4*)(gi == 0 ? c128 : (gi == 1 ? c512 : c2048)); f32x4* dst = (f32x4*)(out + offw_s(gi));
        __builtin_nontemporal_store(__builtin_nontemporal_load(src + (size_t)lb * W * 128 + TS * 128 + j), dst + (size_t)lb * W * 128 + j);
    }
}

__device__ __forceinline__ s16x4 ds_tr16(const LAS unsigned char* p) { return __builtin_amdgcn_ds_read_tr16_b64_v4i16((LAS s16x4*)p); }
__device__ __forceinline__ bf16x8 cat4(s16x4 a, s16x4 b) { bf16x8 r; r[0] = a[0]; r[1] = a[1]; r[2] = a[2]; r[3] = a[3]; r[4] = b[0]; r[5] = b[1]; r[6] = b[2]; r[7] = b[3]; return r; }
__device__ __forceinline__ bf16x8 pk8v(f32x4 a, f32x4 b) { const u32x4 w = pk8(a, b); return __builtin_bit_cast(bf16x8, w); }

constexpr int ATT_UNITS = NB_P * 12 * 32;
constexpr int ATT_PITCH = 144;
__device__ __forceinline__ void attn_unit(LAS unsigned char* lds, const bf16* Q, const bf16* K, const bf16* V, float* AO, float* LSE, int unit, int tid) {
    const int lane = tid & 63, w = tid >> 6, fr = lane & 15, g = lane >> 4;
    const int blk = unit & 31, bh = unit >> 5, h = bh % 12, b = bh / 12;
    const int gi = h >> 2, dl = dil_of(gi);
    const int r = blk % dl, nb = blk / dl;
    LAS unsigned char* Ks = lds; LAS unsigned char* Vs = lds + 256 * ATT_PITCH;
    for (int c = tid; c < 2048; c += NTHR) {
        const int ki = c >> 3, ch = c & 7, ksub = nb * 128 + ki - 128;
        u32x4 kv = {0u, 0u, 0u, 0u}, vv = {0u, 0u, 0u, 0u};
        if (ksub >= 0) { const size_t off = (size_t)(b * SEQ + r + dl * ksub) * 768 + h * 64 + ch * 8; kv = *(const u32x4*)(K + off); vv = *(const u32x4*)(V + off); }
        *(LAS u32x4*)(Ks + ki * ATT_PITCH + ch * 16) = kv; *(LAS u32x4*)(Vs + ki * ATT_PITCH + ch * 16) = vv;
    }
    __syncthreads();
    const int qi = 16 * w + fr;
    const int qtok = b * SEQ + r + dl * (nb * 128 + qi);
    const bf16x8 q0 = *(const bf16x8*)(Q + (size_t)qtok * 768 + h * 64 + 8 * g), q1 = *(const bf16x8*)(Q + (size_t)qtok * 768 + h * 64 + 32 + 8 * g);
    const int ks0 = w >> 1;
    f32x4 s[10];
#pragma unroll
    for (int tt = 0; tt < 10; ++tt) {
        const int T = 2 * ks0 + tt;
        const LAS unsigned char* kp = Ks + (16 * T + fr) * ATT_PITCH + 16 * g;
        const bf16x8 k0 = *(const LAS bf16x8*)kp, k1 = *(const LAS bf16x8*)(kp + 64);
        f32x4 a = {0.f, 0.f, 0.f, 0.f};
        a = __builtin_amdgcn_mfma_f32_16x16x32_bf16(k0, q0, a, 0, 0, 0);
        a = __builtin_amdgcn_mfma_f32_16x16x32_bf16(k1, q1, a, 0, 0, 0);
        s[tt] = a;
    }
    const float slope = exp2f(-8.0f * (float)(h + 1) / 12.0f) * (float)dl;
    float mx = -INFINITY;
#pragma unroll
    for (int tt = 0; tt < 10; ++tt)
#pragma unroll
        for (int j = 0; j < 4; ++j) {
            const int ki = 16 * (2 * ks0 + tt) + 4 * g + j, dist = qi - ki + 128, ksub = nb * 128 + ki - 128;
            const bool valid = (dist >= 0) && (dist <= 128) && (ksub >= 0);
            const float v = s[tt][j] * 0.125f - slope * (float)dist;
            s[tt][j] = valid ? v : -INFINITY;
            mx = fmaxf(mx, s[tt][j]);
        }
    mx = fmaxf(mx, shx(mx, 16, lane)); mx = fmaxf(mx, shx(mx, 32, lane));
    float ls = 0.f;
#pragma unroll
    for (int tt = 0; tt < 10; ++tt)
#pragma unroll
        for (int j = 0; j < 4; ++j) { const float p = __expf(s[tt][j] - mx); s[tt][j] = p; ls += p; }
    ls += shx(ls, 16, lane); ls += shx(ls, 32, lane);
    f32x4 o[4];
#pragma unroll
    for (int et = 0; et < 4; ++et) o[et] = (f32x4){0.f, 0.f, 0.f, 0.f};
    const int q4 = fr >> 2, p4 = fr & 3;
#pragma unroll
    for (int kk = 0; kk < 5; ++kk) {
        const bf16x8 pb = pk8v(s[2 * kk], s[2 * kk + 1]);
        const int rb = 32 * (ks0 + kk) + 4 * g + q4;
#pragma unroll
        for (int et = 0; et < 4; ++et) {
            const s16x4 v0 = ds_tr16(Vs + rb * ATT_PITCH + (16 * et + 4 * p4) * 2);
            const s16x4 v1 = ds_tr16(Vs + (rb + 16) * ATT_PITCH + (16 * et + 4 * p4) * 2);
            o[et] = __builtin_amdgcn_mfma_f32_16x16x32_bf16(cat4(v0, v1), pb, o[et], 0, 0, 0);
        }
    }
    const float inv = 1.0f / ls;
    float* ao = AO + (size_t)qtok * 768 + h * 64 + 4 * g;
#pragma unroll
    for (int et = 0; et < 4; ++et) *(f32x4*)(ao + 16 * et) = o[et] * inv;
    if (g == 0) LSE[(size_t)qtok * 12 + h] = mx + __logf(ls);
    __syncthreads();
}

__device__ __forceinline__ void attn_merge_pass(const float* AO, const float* LSE, bf16* YB, int gt, int NGT, int rep = 1) {
    for (int it0 = gt; it0 < rep * MR * 4 * 16; it0 += NGT) {
        const int it = it0 % (MR * 4 * 16);
        const int e4 = it & 15, slot = (it >> 4) & 3, tok = it >> 6;
        const float l0 = LSE[(size_t)tok * 12 + slot], l1 = LSE[(size_t)tok * 12 + 4 + slot], l2 = LSE[(size_t)tok * 12 + 8 + slot];
        const float m = fmaxf(l0, fmaxf(l1, l2));
        const float w0 = __expf(l0 - m), w1 = __expf(l1 - m), w2 = __expf(l2 - m), inv = 1.0f / (w0 + w1 + w2);
        const float* a = AO + (size_t)tok * 768 + slot * 64 + e4 * 4;
        const f32x4 y = (*(const f32x4*)a * w0 + *(const f32x4*)(a + 256) * w1 + *(const f32x4*)(a + 512) * w2) * inv;
        u32x2 wv; wv.x = pk2(y[0], y[1]); wv.y = pk2(y[2], y[3]);
        *(u32x2*)(YB + (size_t)tok * YK + YO_B + slot * 64 + e4 * 4) = wv;
    }
}

__device__ __forceinline__ float dot64_f32(const float (&q)[64], const float* k) {
    float s = 0.f;
#pragma unroll
    for (int c = 0; c < 16; ++c) { const f32x4 kv = ((const f32x4*)k)[c]; s += (q[4 * c] * kv[0] + q[4 * c + 1] * kv[1]) + (q[4 * c + 2] * kv[2] + q[4 * c + 3] * kv[3]); }
    return s;
}
__device__ __forceinline__ float dot64_bf(const float (&q)[64], const bf16* k) {
    float s = 0.f;
#pragma unroll
    for (int c = 0; c < 8; ++c) { const u32x4 w = ((const u32x4*)k)[c];
        s += (q[8 * c] * bflo(w.x) + q[8 * c + 1] * bfhi(w.x)) + (q[8 * c + 2] * bflo(w.y) + q[8 * c + 3] * bfhi(w.y)) + (q[8 * c + 4] * bflo(w.z) + q[8 * c + 5] * bfhi(w.z)) + (q[8 * c + 6] * bflo(w.w) + q[8 * c + 7] * bfhi(w.w)); }
    return s;
}
__device__ __forceinline__ void attn_sample_wave(const bf16* Q, const bf16* K, const bf16* V, const float* c128, const float* c512, const float* c2048, float* AO, float* LSE, int layer, int unit, int lane) {
    const int h = unit % 12, bt = unit / 12, t = bt & 3, b = bt >> 2;
    const int row = MP + b * TS + t;
    const int gi = h >> 2, slot = h & 3, dl = dil_of(gi), W = win_of(gi);
    const float* cache = (gi == 0 ? c128 : (gi == 1 ? c512 : c2048)) + (size_t)(layer * NB_S + b) * W * 512;
    float qf[64];
    { const u32x4* qp = (const u32x4*)(Q + (size_t)row * 768 + h * 64);
#pragma unroll
      for (int c = 0; c < 8; ++c) { const u32x4 w = qp[c]; qf[8 * c] = bflo(w.x) * 0.125f; qf[8 * c + 1] = bfhi(w.x) * 0.125f; qf[8 * c + 2] = bflo(w.y) * 0.125f; qf[8 * c + 3] = bfhi(w.y) * 0.125f;
          qf[8 * c + 4] = bflo(w.z) * 0.125f; qf[8 * c + 5] = bfhi(w.z) * 0.125f; qf[8 * c + 6] = bflo(w.w) * 0.125f; qf[8 * c + 7] = bfhi(w.w) * 0.125f; } }
    const float slope = exp2f(-8.0f * (float)(h + 1) / 12.0f) * (float)dl;
    float sc[3];
#pragma unroll
    for (int sj = 0; sj < 3; ++sj) {
        const int j = lane + 64 * sj;
        float d = -INFINITY;
        if (j <= 128) {
            const int idx = W + t - j * dl;
            if (idx >= W) d = dot64_bf(qf, K + (size_t)(MP + b * TS + (idx - W)) * 768 + h * 64);
            else d = dot64_f32(qf, cache + ((size_t)idx * 2 + 0) * 256 + slot * 64);
            d -= slope * (float)j;
        }
        sc[sj] = d;
    }
    const float mg = wave_max(fmaxf(sc[0], fmaxf(sc[1], sc[2])), lane);
    const float p0 = __expf(sc[0] - mg), p1 = __expf(sc[1] - mg), p2 = __expf(sc[2] - mg);
    const float lg = wave_sum(p0 + p1 + p2, lane);
    float acc = 0.f;
    const int jstart = (dl == 1) ? t + 1 : 1;
#pragma unroll 1
    for (int j = 0; j < jstart; ++j) acc += rdl(p0, j) * bf2f(V[(size_t)(MP + b * TS + (t - j * dl)) * 768 + h * 64 + lane]);
    const float* vbase = cache + 256 + slot * 64 + lane;
#pragma unroll 1
    for (int j0 = jstart; j0 <= 128; j0 += 32) {
        float vv[32];
#pragma unroll
        for (int i = 0; i < 32; ++i) { const int j = (j0 + i <= 128) ? j0 + i : 128; vv[i] = vbase[(size_t)(W + t - j * dl) * 512]; }
#pragma unroll
        for (int i = 0; i < 32; ++i) { const int j = j0 + i; const float pj = (j <= 128) ? rdl(j < 64 ? p0 : (j < 128 ? p1 : p2), j & 63) : 0.f; acc += pj * vv[i]; }
    }
    AO[(size_t)row * 768 + h * 64 + lane] = acc / lg;
    if (lane == 0) LSE[(size_t)row * 12 + h] = mg + __logf(lg);
}

__device__ __forceinline__ void conv_pool_pass(const bf16* CB, const bf16* U, const bf16* PIN, const float* conv_w, const float* st_conv, const float* st_pool, bf16* YA, bf16* YD, int layer, int gt, int NGT, int rep = 1) {
    for (int it0 = gt; it0 < rep * MPAD * 64; it0 += NGT) {
        const int it = it0 % (MPAD * 64); const int c8 = it & 63, row = it >> 6, ch = c8 * 8;
        int kind, b, t; row_decode(row, kind, b, t);
        if (kind == 2) { const u32x4 z = {0u, 0u, 0u, 0u}; *(u32x4*)(YA + (size_t)row * YK + YO_A + ch) = z; *(u32x4*)(YD + (size_t)row * YK + YO_D + ch) = z; continue; }
        float u0[8], u1[8], u2[8], cb[8];
        unpk8(*(const u32x4*)(U + (size_t)row * 512 + ch), u2);
        if (t >= 1) unpk8(*(const u32x4*)(U + (size_t)(row - 1) * 512 + ch), u1);
        else if (kind == 1) { const float* s = st_conv + ((size_t)(layer * NB_S + b) * 2 + 1) * 512 + ch; _Pragma("unroll") for (int j = 0; j < 8; ++j) u1[j] = s[j]; }
        else { _Pragma("unroll") for (int j = 0; j < 8; ++j) u1[j] = 0.f; }
        if (t >= 2) unpk8(*(const u32x4*)(U + (size_t)(row - 2) * 512 + ch), u0);
        else if (kind == 1) { const float* s = st_conv + ((size_t)(layer * NB_S + b) * 2 + t) * 512 + ch; _Pragma("unroll") for (int j = 0; j < 8; ++j) u0[j] = s[j]; }
        else { _Pragma("unroll") for (int j = 0; j < 8; ++j) u0[j] = 0.f; }
        unpk8(*(const u32x4*)(CB + (size_t)row * 512 + ch), cb);
        const float* cw = conv_w + (size_t)layer * 3 * 512 + ch;
        f32x4 ya0, ya1;
#pragma unroll
        for (int j = 0; j < 8; ++j) { const float z = cw[j] * u0[j] + cw[512 + j] * u1[j] + cw[1024 + j] * u2[j]; const float y = cb[j] * z; if (j < 4) ya0[j] = y; else ya1[j - 4] = y; }
        *(u32x4*)(YA + (size_t)row * YK + YO_A + ch) = pk8(ya0, ya1);
        const int grp = c8 >> 4, w = 2 << grp;
        float cur[8], sum[8];
        unpk8(*(const u32x4*)(PIN + (size_t)row * 512 + ch), cur);
#pragma unroll
        for (int j = 0; j < 8; ++j) sum[j] = cur[j];
        if (kind == 0) {
            u32x4 xr[15];
#pragma unroll
            for (int i = 1; i < 16; ++i) { const bool ok = (i < w) && (t - i >= 0); xr[i - 1] = *(const u32x4*)(PIN + (size_t)(ok ? row - i : row) * 512 + ch); }
#pragma unroll
            for (int i = 1; i < 16; ++i) { const bool ok = (i < w) && (t - i >= 0); float x[8]; unpk8(xr[i - 1], x); const float m = ok ? 1.f : 0.f;
#pragma unroll
                for (int j = 0; j < 8; ++j) sum[j] += m * x[j]; }
        } else {
            for (int i = 1; i < w; ++i) {
                const int tt = t - i;
                if (tt >= 0) { float x[8]; unpk8(*(const u32x4*)(PIN + (size_t)(row - i) * 512 + ch), x); _Pragma("unroll") for (int j = 0; j < 8; ++j) sum[j] += x[j]; }
                else { const float* s = st_pool + ((size_t)(layer * NB_S + b) * 15 + (15 + tt)) * 512 + ch; _Pragma("unroll") for (int j = 0; j < 8; ++j) sum[j] += s[j]; }
            }
        }
        const float cnt = (kind == 1) ? (float)w : fminf((float)w, (float)(t + 1));
        const float ic = 1.0f / cnt;
        f32x4 d0, d1;
#pragma unroll
        for (int j = 0; j < 8; ++j) { const float d = sum[j] * ic - cur[j]; if (j < 4) d0[j] = d; else d1[j - 4] = d; }
        *(u32x4*)(YD + (size_t)row * YK + YO_D + ch) = pk8(d0, d1);
    }
}

constexpr int GLA_UNITS = NB_P * 4 * 64;
constexpr int GP_K = 144, GP_V = 272;
constexpr int GLA_R0 = 0, GLA_R0_BYTES = 17408, GLA_QT = GLA_R0 + GLA_R0_BYTES, GLA_KT = GLA_QT + 64 * GP_K, GLA_VV = GLA_KT + 64 * GP_K, GLA_HALF = GLA_VV + 64 * GP_V;
static_assert(2 * GLA_HALF <= RING_BYTES, "GLA LDS");

__device__ __forceinline__ void gla_cumsum(LAS float* lb, const float* LA, int tok0, int h, int ht) {
    const int k = ht & 63, q = ht >> 6;
    float v[16]; float run = 0.f;
#pragma unroll
    for (int i = 0; i < 16; ++i) { run += LA[(size_t)(tok0 + 16 * q + i) * 256 + h * 64 + k]; v[i] = run; }
    LAS float* tot = lb + 4096;
    tot[q * 64 + k] = run;
    __syncthreads();
    float off = 0.f;
#pragma unroll
    for (int qq = 0; qq < 3; ++qq) off += (qq < q) ? tot[qq * 64 + k] : 0.f;
#pragma unroll
    for (int i = 0; i < 16; ++i) lb[(16 * q + i) * 64 + k] = v[i] + off;
    __syncthreads();
}

__device__ __forceinline__ void gla_ds_unit(LAS unsigned char* hl, const bf16* GK, const bf16* GV, const float* LA, float* DS, float* DEC, int unit, int ht) {
    const int n = unit & 63, bh = unit >> 6, h = bh & 3, b = bh >> 2;
    const int tok0 = b * SEQ + n * 64;
    const int lane = ht & 63, hw = ht >> 6, fr = lane & 15, g = lane >> 4;
    LAS float* lb = (LAS float*)(hl + GLA_R0);
    gla_cumsum(lb, LA, tok0, h, ht);
    for (int c = ht; c < 512; c += 256) {
        const int s = c >> 3, k0 = (c & 7) * 8;
        float kf[8]; unpk8(*(const u32x4*)(GK + (size_t)(tok0 + s) * 256 + h * 64 + k0), kf);
        f32x4 a0, a1;
#pragma unroll
        for (int j = 0; j < 8; ++j) { const float e = kf[j] * __expf(lb[63 * 64 + k0 + j] - lb[s * 64 + k0 + j]); if (j < 4) a0[j] = e; else a1[j - 4] = e; }
        *(LAS u32x4*)(hl + GLA_KT + s * GP_K + k0 * 2) = pk8(a0, a1);
    }
    for (int c = ht; c < 1024; c += 256) {
        const int s = c >> 4, v0 = (c & 15) * 8;
        *(LAS u32x4*)(hl + GLA_VV + s * GP_V + v0 * 2) = *(const u32x4*)(GV + (size_t)(tok0 + s) * 512 + h * 128 + v0);
    }
    if (ht < 64) DEC[(size_t)unit * 64 + ht] = __expf(lb[63 * 64 + ht]);
    __syncthreads();
    const int q4 = fr >> 2, p4 = fr & 3, kt = hw;
    float* dsb = DS + (size_t)unit * 64 * 128;
#pragma unroll
    for (int dvt = 0; dvt < 8; ++dvt) {
        f32x4 acc = {0.f, 0.f, 0.f, 0.f};
#pragma unroll
        for (int ks = 0; ks < 2; ++ks) {
            const int rb = 32 * ks + 4 * g + q4;
            const bf16x8 af = cat4(ds_tr16(hl + GLA_KT + rb * GP_K + (16 * kt + 4 * p4) * 2), ds_tr16(hl + GLA_KT + (rb + 16) * GP_K + (16 * kt + 4 * p4) * 2));
            const bf16x8 bf = cat4(ds_tr16(hl + GLA_VV + rb * GP_V + (16 * dvt + 4 * p4) * 2), ds_tr16(hl + GLA_VV + (rb + 16) * GP_V + (16 * dvt + 4 * p4) * 2));
            acc = __builtin_amdgcn_mfma_f32_16x16x32_bf16(af, bf, acc, 0, 0, 0);
        }
#pragma unroll
        for (int j = 0; j < 4; ++j) dsb[(size_t)(16 * kt + 4 * g + j) * 128 + 16 * dvt + fr] = acc[j];
    }
    __syncthreads();
}

__device__ __forceinline__ void gla_scan_pass(const float* DS, const float* DEC, bf16* SP, float* out, int layer, int gt, int rep = 1) {
    if (gt >= 8 * 64 * 128) return;
    for (int rr = 0; rr < rep; ++rr) {
    const int v = gt & 127, k = (gt >> 7) & 63, bh = gt >> 13;
    float S = 0.f;
    for (int n0 = 0; n0 < 64; n0 += 32) {
        float d[32], a[32];
#pragma unroll
        for (int i = 0; i < 32; ++i) { d[i] = DS[(((size_t)bh * 64 + n0 + i) * 64 + k) * 128 + v]; a[i] = DEC[((size_t)bh * 64 + n0 + i) * 64 + k]; }
#pragma unroll
        for (int i = 0; i < 32; ++i) { SP[(((size_t)bh * 64 + n0 + i) * 64 + k) * 128 + v] = (bf16)f2bf(S); S = a[i] * S + d[i]; }
    }
    out[OFF_GLA_P + (((size_t)layer * 8 + bh) * 64 + k) * 128 + v] = S;
    }
}

__device__ __forceinline__ void gla_out_unit(LAS unsigned char* hl, const bf16* GQ, const bf16* GK, const bf16* GV, const bf16* GR, const float* LA, const bf16* SP, const float* gnorm, bf16* YC, int unit, int ht) {
    const int n = unit & 63, bh = unit >> 6, h = bh & 3, b = bh >> 2;
    const int tok0 = b * SEQ + n * 64;
    const int lane = ht & 63, hw = ht >> 6, fr = lane & 15, g = lane >> 4;
    LAS float* lb = (LAS float*)(hl + GLA_R0);
    gla_cumsum(lb, LA, tok0, h, ht);
    for (int c = ht; c < 512; c += 256) {
        const int s = c >> 3, k0 = (c & 7) * 8;
        float qf[8], kf[8];
        unpk8(*(const u32x4*)(GQ + (size_t)(tok0 + s) * 256 + h * 64 + k0), qf);
        unpk8(*(const u32x4*)(GK + (size_t)(tok0 + s) * 256 + h * 64 + k0), kf);
        f32x4 a0, a1, c0, c1;
#pragma unroll
        for (int j = 0; j < 8; ++j) { const float bb = lb[s * 64 + k0 + j]; const float qe = qf[j] * __expf(bb), ke = kf[j] * __expf(-bb); if (j < 4) { a0[j] = qe; c0[j] = ke; } else { a1[j - 4] = qe; c1[j - 4] = ke; } }
        *(LAS u32x4*)(hl + GLA_QT + s * GP_K + k0 * 2) = pk8(a0, a1);
        *(LAS u32x4*)(hl + GLA_KT + s * GP_K + k0 * 2) = pk8(c0, c1);
    }
    for (int c = ht; c < 1024; c += 256) {
        const int s = c >> 4, v0 = (c & 15) * 8;
        *(LAS u32x4*)(hl + GLA_VV + s * GP_V + v0 * 2) = *(const u32x4*)(GV + (size_t)(tok0 + s) * 512 + h * 128 + v0);
    }
    __syncthreads();
    for (int c = ht; c < 1024; c += 256) {
        const int k = c >> 4, v0 = (c & 15) * 8;
        *(LAS u32x4*)(hl + GLA_R0 + k * GP_V + v0 * 2) = *(const u32x4*)(SP + ((size_t)unit * 64 + k) * 128 + v0);
    }
    __syncthreads();
    const int tt = hw, q4 = fr >> 2, p4 = fr & 3;
    f32x4 at[4];
    const LAS unsigned char* qrow = hl + GLA_QT + (16 * tt + fr) * GP_K;
    const bf16x8 qb0 = *(const LAS bf16x8*)(qrow + 16 * g), qb1 = *(const LAS bf16x8*)(qrow + 64 + 16 * g);
#pragma unroll
    for (int st = 0; st < 4; ++st) {
        const LAS unsigned char* krow = hl + GLA_KT + (16 * st + fr) * GP_K;
        f32x4 a = {0.f, 0.f, 0.f, 0.f};
        a = __builtin_amdgcn_mfma_f32_16x16x32_bf16(*(const LAS bf16x8*)(krow + 16 * g), qb0, a, 0, 0, 0);
        a = __builtin_amdgcn_mfma_f32_16x16x32_bf16(*(const LAS bf16x8*)(krow + 64 + 16 * g), qb1, a, 0, 0, 0);
#pragma unroll
        for (int j = 0; j < 4; ++j) { const int s = 16 * st + 4 * g + j, t = 16 * tt + fr; a[j] = (s <= t) ? a[j] : 0.f; }
        at[st] = a;
    }
    f32x4 o[8];
#pragma unroll
    for (int dvt = 0; dvt < 8; ++dvt) o[dvt] = (f32x4){0.f, 0.f, 0.f, 0.f};
#pragma unroll
    for (int ks = 0; ks < 2; ++ks) {
        const bf16x8 pb = pk8v(at[2 * ks], at[2 * ks + 1]);
        const int rb = 32 * ks + 4 * g + q4;
        const s16x4 qa = *(const LAS s16x4*)(qrow + (32 * ks + 4 * g) * 2), qc = *(const LAS s16x4*)(qrow + (32 * ks + 16 + 4 * g) * 2);
        const bf16x8 qp = cat4(qa, qc);
#pragma unroll
        for (int dvt = 0; dvt < 8; ++dvt) {
            const bf16x8 vf = cat4(ds_tr16(hl + GLA_VV + rb * GP_V + (16 * dvt + 4 * p4) * 2), ds_tr16(hl + GLA_VV + (rb + 16) * GP_V + (16 * dvt + 4 * p4) * 2));
            o[dvt] = __builtin_amdgcn_mfma_f32_16x16x32_bf16(vf, pb, o[dvt], 0, 0, 0);
            const bf16x8 sf = cat4(ds_tr16(hl + GLA_R0 + rb * GP_V + (16 * dvt + 4 * p4) * 2), ds_tr16(hl + GLA_R0 + (rb + 16) * GP_V + (16 * dvt + 4 * p4) * 2));
            o[dvt] = __builtin_amdgcn_mfma_f32_16x16x32_bf16(sf, qp, o[dvt], 0, 0, 0);
        }
    }
    float ss = 0.f;
#pragma unroll
    for (int dvt = 0; dvt < 8; ++dvt) ss += (o[dvt][0] * o[dvt][0] + o[dvt][1] * o[dvt][1]) + (o[dvt][2] * o[dvt][2] + o[dvt][3] * o[dvt][3]);
    ss += shx(ss, 16, lane); ss += shx(ss, 32, lane);
    const float rs = rsqrtf(ss * (1.0f / 128.0f) + EPS);
    const size_t orow = (size_t)(tok0 + 16 * tt + fr) * 512 + h * 128, yrow = (size_t)(tok0 + 16 * tt + fr) * YK + YO_C + h * 128;
#pragma unroll
    for (int dvt = 0; dvt < 8; ++dvt) {
        const int dv = 16 * dvt + 4 * g;
        const f32x4 gn = *(const f32x4*)(gnorm + dv);
        const u32x2 gw = *(const u32x2*)(GR + orow + dv);
        f32x4 y; y[0] = o[dvt][0] * rs * gn[0] * bflo(gw.x); y[1] = o[dvt][1] * rs * gn[1] * bfhi(gw.x); y[2] = o[dvt][2] * rs * gn[2] * bflo(gw.y); y[3] = o[dvt][3] * rs * gn[3] * bfhi(gw.y);
        u32x2 wv; wv.x = pk2(y[0], y[1]); wv.y = pk2(y[2], y[3]);
        *(u32x2*)(YC + yrow + dv) = wv;
    }
    __syncthreads();
}

__device__ __forceinline__ void gla_sample_unit(LAS float* red, const bf16* GQ, const bf16* GK, const bf16* GV, const bf16* GR, const float* LA, const float* st_gla, const float* gnorm, bf16* YC, float* out, int layer, int unit, int tid) {
    const int h = unit & 3, b = unit >> 2;
    const int dv = tid & 127, kq = tid >> 7;
    const float* s0 = st_gla + (((size_t)(layer * NB_S + b) * 4 + h) * 64 + 16 * kq) * 128 + dv;
    float S[16];
#pragma unroll
    for (int i = 0; i < 16; ++i) S[i] = s0[(size_t)i * 128];
#pragma unroll 1
    for (int t = 0; t < TS; ++t) {
        const int row = MP + b * TS + t;
        const float vv = bf2f(GV[(size_t)row * 512 + h * 128 + dv]);
        float po = 0.f;
#pragma unroll
        for (int i = 0; i < 16; ++i) {
            const int k = 16 * kq + i;
            const float a = __expf(LA[(size_t)row * 256 + h * 64 + k]);
            S[i] = a * S[i] + bf2f(GK[(size_t)row * 256 + h * 64 + k]) * vv;
            po += bf2f(GQ[(size_t)row * 256 + h * 64 + k]) * S[i];
        }
        red[kq * 128 + dv] = po;
        __syncthreads();
        float o = 0.f, sq = 0.f;
        if (kq == 0) { o = (red[dv] + red[128 + dv]) + (red[256 + dv] + red[384 + dv]); sq = o * o; }
        sq = wave_sum(sq, tid & 63);
        if (kq == 0 && (tid & 63) == 0) red[512 + (tid >> 6)] = sq;
        __syncthreads();
        if (kq == 0) {
            const float rs = rsqrtf((red[512] + red[513]) * (1.0f / 128.0f) + EPS);
            const float y = o * rs * gnorm[dv] * bf2f(GR[(size_t)row * 512 + h * 128 + dv]);
            YC[(size_t)row * YK + YO_C + h * 128 + dv] = (bf16)f2bf(y);
        }
        __syncthreads();
    }
    float* so = out + OFF_GLA_S + (((size_t)(layer * NB_S + b) * 4 + h) * 64 + 16 * kq) * 128 + dv;
#pragma unroll
    for (int i = 0; i < 16; ++i) so[(size_t)i * 128] = S[i];
}

constexpr int PH_PER_LAYER = 13, NPH = 1 + DEPTH * PH_PER_LAYER;
#define RM(bit) (1 + ((PROBE_DUP >> (bit)) & 1))
#define REP(bit) for (int rep_ = 0; rep_ < 1 + ((PROBE_DUP >> (bit)) & 1); ++rep_)
#ifndef PROBE_SP2
#define PROBE_SP2 true
#endif
#ifndef PROBE_ALIGN_GU
#define PROBE_ALIGN_GU true
#endif
#ifndef PROBE_ALIGN_RES
#define PROBE_ALIGN_RES true
#endif
#ifndef PROBE_ALIGN_WIN
#define PROBE_ALIGN_WIN true
#endif
#ifndef MK_UNROLL_LAYERS
#define MK_UNROLL_LAYERS 1
#endif
#ifndef MK_PER_PHASE
#define MK_PER_PHASE 0
#endif

struct Args { const float* in[31]; float* out; unsigned char* ws; int ph_lo, ph_hi; };
static_assert(sizeof(Args) == 31 * 8 + 8 + 8 + 8, "Args has no padding");

__device__ __forceinline__ unsigned char* launder(unsigned char* p) { unsigned long long v = (unsigned long long)p; asm volatile("" : "+s"(v)); return (unsigned char*)(GAS unsigned char*)v; }
__device__ __forceinline__ int opq_v(int x) { asm volatile("" : "+v"(x)); return x; }
__device__ __forceinline__ int opq_s(int x) { asm volatile("" : "+s"(x)); return x; }

#define IN(k) (lo <= (k) && (k) < hi)
#define SEAM(k) do { if (IN((k) + 1)) { XcdBarrier bar_; bar_.bar = (unsigned*)(WSP() + WS_CTL) + CW_BAR; bar_.x = xb_xcc_id(); bar_.st = (volatile LAS unsigned*)(lds + MISC_OFF) + 8; REP(13) xcd_barrier(bar_, tid); } } while (0)
#define TAIL_SLOT(slot) do { if (G == 256 && bid < TAIL_WGS && l < DEPTH - 1) { unsigned char* ws_ = WSP(); \
        prologue_blocks(lds, (bf16*)(ws_ + WS_W), (l + 1) * PB_LAYER + 2 * 1376 + 2 * 688 + (slot) * TAIL_N, TAIL_N, bid, TAIL_WGS, tid, false); } } while (0)
#define GW (bid * NWAVES + wave)
#define NGW (G * NWAVES)
#define GT (bid * NTHR + tid)
#define NGT (G * NTHR)
#define WSP() launder((unsigned char*)ldp(lds, PT_WS))
#define IDS() const int wave = opq_s(wave0), lane = (int)__builtin_amdgcn_mbcnt_hi(~0u, __builtin_amdgcn_mbcnt_lo(~0u, (unsigned)opq_v(0))), tid = wave * 64 + lane, G = opq_s(G0), bid = opq_s(bid0); (void)lane; (void)wave; (void)G; (void)bid
struct Ctx { LAS unsigned char* lds; int tid0, wave0, G0, bid0, lo, hi; };
#define CTX_LOCALS() LAS unsigned char* lds = c.lds; const int tid0 = c.tid0, wave0 = c.wave0, G0 = c.G0, bid0 = c.bid0, lo = c.lo, hi = c.hi; (void)lds; (void)tid0; (void)wave0; (void)G0; (void)bid0; (void)lo; (void)hi

__device__ __forceinline__ void ff_part(const Ctx c, const int l, const int f) {
    CTX_LOCALS();
    const int pb = 1 + l * PH_PER_LAYER;
    const int fb = pb + (f ? 10 : 0);
    if (IN(fb + 1)) {
        { IDS(); unsigned char* ws = WSP(); const bf16* wl = (const bf16*)(ws + WS_W) + (size_t)l * WE_LAYER;
          pg8::Gemm g{(const bf16*)(ws + WS_XN), wl + (f ? WE_GU2 : WE_GU1), MP, NGU, DM}; pg8::StaticOrder S; S.init(MP, NGU, G, bid, RM(4));
          EpiSwiGLU E{ws, 3 * l + (f ? 2 : 0)};
          pg8::gemm_phase<EpiSwiGLU, pg8::StaticOrder, PROBE_ALIGN_GU, PROBE_SP2, true>(lds + RING_OFF, g, S, E, tid); }
        { IDS(); unsigned char* ws = WSP(); const bf16* wl = (const bf16*)(ws + WS_W) + (size_t)l * WE_LAYER; EpiSwiGLU E{ws, 3 * l + (f ? 2 : 0)};
          for (int su = G - 1 - bid; su < RM(9) * (NGU / 64); su += G) skinny_unit<EpiSwiGLU>(lds + RING_OFF, (const bf16*)(ws + WS_XN), wl + (f ? WE_GU2 : WE_GU1), DM, su % (NGU / 64), E, tid); }
        { IDS(); unsigned char* ws = WSP();
          const int dfirst = (f == 0) ? l * PB_LAYER + 1376 : (l + 1) * PB_LAYER;
          if (G == 256 && bid >= DEFER_WG0 && (f == 0 || l < DEPTH - 1)) prologue_blocks(lds, (bf16*)(ws + WS_W), dfirst, DEFER_N + DEFER_X, bid - DEFER_WG0, DEFER_WGS, tid, false, DEFER_N, (f == 0) ? 688 : 1376);
          { const int slot = 2 * l + f; const int c0 = (int)((long)CACHE_COPY_N * slot / 10), c1 = (slot == 7) ? CACHE_COPY_N : (int)((long)CACHE_COPY_N * (slot + 1) / 10);
            if (G == 256) { if (bid >= DEFER_WG0) cache_copy_range(ldp(lds, 3), ldp(lds, 4), ldp(lds, 5), (float*)ldp(lds, PT_OUT), c0, c1, (bid - DEFER_WG0) * NTHR + tid, DEFER_WGS * NTHR); }
            else cache_copy_range(ldp(lds, 3), ldp(lds, 4), ldp(lds, 5), (float*)ldp(lds, PT_OUT), c0, c1, GT, NGT); } }
        IDS();
        SEAM(fb + 1);
    }
    if (IN(fb + 2)) {
        { IDS(); unsigned char* ws = WSP(); const bf16* wl = (const bf16*)(ws + WS_W) + (size_t)l * WE_LAYER;
          pg8::Gemm g{(const bf16*)(ws + WS_H), wl + (f ? WE_D2 : WE_D1), MP, DM, DFF}; pg8::StaticOrder S; S.init(MP, DM, G, bid, RM(10));
          EpiResid E{ws, lds, 0.5f, (f == 1 && l == DEPTH - 1) ? 1 : 0, (f == 0) ? 3 * l + 1 : (l < DEPTH - 1 ? 3 * l + 3 : -1)};
          pg8::gemm_phase<EpiResid, pg8::StaticOrder, PROBE_ALIGN_RES, PROBE_SP2, true>(lds + RING_OFF, g, S, E, tid); }
        { IDS(); unsigned char* ws = WSP(); const bf16* wl = (const bf16*)(ws + WS_W) + (size_t)l * WE_LAYER; EpiResid E{ws, lds, 0.5f, (f == 1 && l == DEPTH - 1) ? 1 : 0, (f == 0) ? 3 * l + 1 : (l < DEPTH - 1 ? 3 * l + 3 : -1)};
          for (int su = G - 1 - bid; su < DM / 64; su += G) skinny_unit<EpiResid>(lds + RING_OFF, (const bf16*)(ws + WS_H), wl + (f ? WE_D2 : WE_D1), DFF, su, E, tid); }
        { IDS(); TAIL_SLOT(f ? 3 : 0); }
        IDS();
        SEAM(fb + 2);
    }
}

__device__ __forceinline__ void mixer_part(const Ctx c, const int l) {
    CTX_LOCALS();
    const int pb = 1 + l * PH_PER_LAYER;
    if (IN(pb + 4)) {
        { IDS(); unsigned char* ws = WSP(); const bf16* wl = (const bf16*)(ws + WS_W) + (size_t)l * WE_LAYER;
          pg8::Gemm g{(const bf16*)(ws + WS_XN), wl + WE_IN, MP, NWIN, DM}; pg8::StaticOrder S; S.init(MP, NWIN, G, bid, RM(3));
          EpiWin E{ws, ldp(lds, 15) + (size_t)l * 768, ldp(lds, 16) + (size_t)l * 768, ldp(lds, 18) + (size_t)l * 256, (float*)ldp(lds, PT_OUT), l, 3 * l + 1};
          pg8::gemm_phase<EpiWin, pg8::StaticOrder, PROBE_ALIGN_WIN, PROBE_SP2, true>(lds + RING_OFF, g, S, E, tid); }
        { IDS(); unsigned char* ws = WSP(); const bf16* wl = (const bf16*)(ws + WS_W) + (size_t)l * WE_LAYER;
          EpiWin E{ws, ldp(lds, 15) + (size_t)l * 768, ldp(lds, 16) + (size_t)l * 768, ldp(lds, 18) + (size_t)l * 256, (float*)ldp(lds, PT_OUT), l, 3 * l + 1};
          for (int su = G - 1 - bid; su < RM(9) * (NWIN / 64); su += G) skinny_unit<EpiWin>(lds + RING_OFF, (const bf16*)(ws + WS_XN), wl + WE_IN, DM, su % (NWIN / 64), E, tid); }
        IDS();
        SEAM(pb + 4);
    }
    if (IN(pb + 5)) {
        IDS();
        { unsigned char* ws = WSP();
          for (int u = bid; u < RM(1) * ATT_UNITS; u += G) attn_unit(lds, (const bf16*)(ws + WS_Q), (const bf16*)(ws + WS_K), (const bf16*)(ws + WS_V), (float*)(ws + WS_AO), (float*)(ws + WS_LSE), u % ATT_UNITS, tid); }
        { unsigned char* ws = WSP();
          for (int u2 = bid; u2 < RM(5) * (GLA_UNITS / 2); u2 += G) gla_ds_unit(lds + (tid >> 8) * GLA_HALF, (const bf16*)(ws + WS_GK), (const bf16*)(ws + WS_GV), (const float*)(ws + WS_LA), (float*)(ws + WS_DS), (float*)(ws + WS_DEC), 2 * (u2 % (GLA_UNITS / 2)) + (tid >> 8), tid & 255); }
        { unsigned char* ws = WSP();
          conv_pool_pass((const bf16*)(ws + WS_CB), (const bf16*)(ws + WS_U), (const bf16*)(ws + WS_PIN), ldp(lds, 14), ldp(lds, 2), ldp(lds, 7), (bf16*)(ws + WS_YCAT), (bf16*)(ws + WS_YCAT), l, GT, NGT, RM(6)); }
        REP(8) { const int su = (NGW - 1 - GW);
          if (su < NB_S * TS * 12) { unsigned char* ws = WSP(); attn_sample_wave((const bf16*)(ws + WS_Q), (const bf16*)(ws + WS_K), (const bf16*)(ws + WS_V), ldp(lds, 3), ldp(lds, 4), ldp(lds, 5), (float*)(ws + WS_AO), (float*)(ws + WS_LSE), l, su, lane); } }
        REP(8) { unsigned char* ws = WSP();
          for (int u = bid - 64; u >= 0 && u < NB_S * 4; u += G) gla_sample_unit((LAS float*)lds, (const bf16*)(ws + WS_GQ), (const bf16*)(ws + WS_GK), (const bf16*)(ws + WS_GV), (const bf16*)(ws + WS_GR), (const float*)(ws + WS_LA), ldp(lds, 6), ldp(lds, 19) + (size_t)l * 128, (bf16*)(ws + WS_YCAT), (float*)ldp(lds, PT_OUT), l, u, tid); }
        SEAM(pb + 5);
    }
    if (IN(pb + 6)) {
        IDS(); unsigned char* ws = WSP();
        gla_scan_pass((const float*)(ws + WS_DS), (const float*)(ws + WS_DEC), (bf16*)(ws + WS_SP), (float*)ldp(lds, PT_OUT), l, GT, RM(7));
        attn_merge_pass((const float*)(ws + WS_AO), (const float*)(ws + WS_LSE), (bf16*)(ws + WS_YCAT), GT, NGT, RM(7));
        SEAM(pb + 6);
    }
    if (IN(pb + 7)) {
        IDS(); unsigned char* ws = WSP();
        for (int u2 = bid; u2 < RM(5) * (GLA_UNITS / 2); u2 += G) gla_out_unit(lds + (tid >> 8) * GLA_HALF, (const bf16*)(ws + WS_GQ), (const bf16*)(ws + WS_GK), (const bf16*)(ws + WS_GV), (const bf16*)(ws + WS_GR), (const float*)(ws + WS_LA), (const bf16*)(ws + WS_SP), ldp(lds, 19) + (size_t)l * 128, (bf16*)(ws + WS_YCAT), 2 * (u2 % (GLA_UNITS / 2)) + (tid >> 8), tid & 255);
        SEAM(pb + 7);
    }
    if (IN(pb + 8)) {
        REP(11) {
        { IDS(); unsigned char* ws = WSP(); const bf16* wl = (const bf16*)(ws + WS_W) + (size_t)l * WE_LAYER; pg8::StaticOrder S; S.init(MP, DM, G, bid);
          pg8::Gemm g{(const bf16*)(ws + WS_YCAT), wl + WE_UPCAT, MP, DM, YK}; EpiMergeCat E{ws};
          pg8::gemm_phase<EpiMergeCat, pg8::StaticOrder, true, PROBE_SP2>(lds + RING_OFF, g, S, E, tid); }
        { IDS(); unsigned char* ws = WSP(); const bf16* wl = (const bf16*)(ws + WS_W) + (size_t)l * WE_LAYER; const bf16* yc = (const bf16*)(ws + WS_YCAT); const bf16* uc = wl + WE_UPCAT;
          for (int su = G - 1 - bid; su < DM / 64; su += G) skinny_merge_unit(lds + RING_OFF, ws, yc, uc, su, tid); }
        { IDS(); TAIL_SLOT(1); }
        }
        IDS();
        SEAM(pb + 8);
    }
    if (IN(pb + 9)) {
        { IDS(); unsigned char* ws = WSP(); const bf16* wl = (const bf16*)(ws + WS_W) + (size_t)l * WE_LAYER;
          pg8::Gemm g{(const bf16*)(ws + WS_MRG), wl + WE_OUT, MP, DM, DM}; pg8::StaticOrder S; S.init(MP, DM, G, bid, RM(12));
          EpiResid E{ws, lds, 1.0f, 0, 3 * l + 2};
#if (PROBE_DUP >> 14) & 1
          { pg8::Gemm g0{(const bf16*)(ws + WS_MRG), wl + WE_OUT, MP, DM, 256}; EpiResid E0{ws, lds, 0.0f, 0, -1};
            pg8::gemm_phase<EpiResid, pg8::StaticOrder, PROBE_ALIGN_RES, PROBE_SP2>(lds + RING_OFF, g0, S, E0, tid); }
#endif
          pg8::gemm_phase<EpiResid, pg8::StaticOrder, PROBE_ALIGN_RES, PROBE_SP2, true>(lds + RING_OFF, g, S, E, tid); }
        { IDS(); unsigned char* ws = WSP(); const bf16* wl = (const bf16*)(ws + WS_W) + (size_t)l * WE_LAYER; EpiResid E{ws, lds, 1.0f, 0, 3 * l + 2};
          for (int su = G - 1 - bid; su < DM / 64; su += G) skinny_unit<EpiResid>(lds + RING_OFF, (const bf16*)(ws + WS_MRG), wl + WE_OUT, DM, su, E, tid); }
        { IDS(); TAIL_SLOT(2); }
        IDS();
        SEAM(pb + 9);
    }
}

__global__ void __launch_bounds__(NTHR, 2) fwd_kernel(Args args) {
    extern __shared__ __attribute__((aligned(16))) unsigned char lds_raw[];
    LAS unsigned char* lds = (LAS unsigned char*)lds_raw;
    const int tid0 = threadIdx.x; const int wave0 = __builtin_amdgcn_readfirstlane(tid0 >> 6);
    const int G0 = gridDim.x, bid0 = blockIdx.x;
    { const int tid = tid0; for (int u = tid; u < (LDS_BYTES - LDSCTL_OFF) / 4; u += NTHR) ((LAS unsigned*)(lds + LDSCTL_OFF))[u] = 0u; }
    __syncthreads();
    if (tid0 == 0) {
        LAS unsigned long long* pt = (LAS unsigned long long*)(lds + PT_OFF);
#pragma unroll
        for (int i = 0; i < 31; ++i) pt[i] = (unsigned long long)args.in[i];
        pt[PT_OUT] = (unsigned long long)args.out; pt[PT_WS] = (unsigned long long)args.ws;
    }
    __syncthreads();
    if (!MK_PER_PHASE) (void)xcd_barrier_post((unsigned*)(args.ws + WS_CTL) + CW_BAR, (volatile LAS unsigned*)(lds + MISC_OFF) + 8);
    const int lo = args.ph_lo, hi = args.ph_hi;

    if (IN(0)) {
        IDS(); unsigned char* ws = WSP(); float* out = (float*)ldp(lds, PT_OUT);
        REP(0) { prologue_blocks(lds, (bf16*)(ws + WS_W), 0, DEPTH * PB_LAYER, bid, G, tid, G == 256); prologue_specials(lds, (bf16*)(ws + WS_W), G - 1 - bid, G, tid); }
#if (PROBE_DUP >> 16) & 1
        prologue_blocks<1>(lds, (bf16*)(ws + WS_W), 0, DEPTH * PB_LAYER, bid, G, tid, G == 256);
#endif
#if (PROBE_DUP >> 17) & 1
        prologue_blocks<2>(lds, (bf16*)(ws + WS_W), 0, DEPTH * PB_LAYER, bid, G, tid, G == 256);
#endif
        x_init_pass(ldp(lds, 0), ldp(lds, 1), (bf16*)(ws + WS_XN), (unsigned long long*)(ws + WS_CTL + CTL_SS), GW, NGW, lane);
        { const f32x4* src = (const f32x4*)ldp(lds, 7); f32x4* dst = (f32x4*)(out + OFF_POOL_S); const int per = 11 * 128;
          for (int i = GT; i < DEPTH * NB_S * per; i += NGT) { const int lb = i / per, j = i - lb * per; dst[(size_t)lb * 15 * 128 + j] = src[(size_t)lb * 15 * 128 + 4 * 128 + j]; } }
        SEAM(0);
    }

    { Ctx c; c.lds = lds; c.tid0 = tid0; c.wave0 = wave0; c.G0 = G0; c.bid0 = bid0; c.lo = lo; c.hi = hi;
#if MK_UNROLL_LAYERS
      ff_part(c, 0, 0); mixer_part(c, 0); ff_part(c, 0, 1); ff_part(c, 1, 0); mixer_part(c, 1); ff_part(c, 1, 1);
      ff_part(c, 2, 0); mixer_part(c, 2); ff_part(c, 2, 1); ff_part(c, 3, 0); mixer_part(c, 3); ff_part(c, 3, 1);
#else
      _Pragma("unroll 1") for (int l = 0; l < DEPTH; ++l) {
          _Pragma("unroll 1") for (int f = 0; f < 2; ++f) { ff_part(c, l, f); if (f == 0) mixer_part(c, l); }
      }
#endif
    }
#undef IN
#undef SEAM
}

extern "C" void kernel_launch(void* const* d_in, const int* in_sizes, int n_in, void* d_out, int out_size, void* d_ws, size_t ws_size, hipStream_t stream) {
    static int grid = 0;
    if (grid == 0) {
        if (n_in != 31 || out_size != OUT_TOTAL || ws_size < WS_END) { fprintf(stderr, "kernel_launch: expected 31 inputs, %d outputs, >= %zu bytes ws; got %d, %d, %zu\n", OUT_TOTAL, (size_t)WS_END, n_in, out_size, ws_size); grid = -1; return; }
        int dev = 0, cus = 0, per_cu = 0;
        if (hipGetDevice(&dev) != hipSuccess || hipDeviceGetAttribute(&cus, hipDeviceAttributeMultiprocessorCount, dev) != hipSuccess) { grid = -1; return; }
        if (hipFuncSetAttribute((const void*)fwd_kernel, hipFuncAttributeMaxDynamicSharedMemorySize, LDS_BYTES) != hipSuccess) { fprintf(stderr, "kernel_launch: hipFuncSetAttribute failed\n"); grid = -1; return; }
        if (hipOccupancyMaxActiveBlocksPerMultiprocessor(&per_cu, (const void*)fwd_kernel, NTHR, LDS_BYTES) != hipSuccess || per_cu < 1) fprintf(stderr, "kernel_launch: occupancy query says %d\n", per_cu);
        (void)hipGetLastError();
        grid = cus;
    }
    if (grid < 0) return;
    if (hipMemsetAsync((char*)d_ws + WS_CTL, 0, CTL_ZERO_BYTES, stream) != hipSuccess) return;
    Args a; memset(&a, 0, sizeof(a));
    for (int i = 0; i < 31; ++i) a.in[i] = (const float*)d_in[i];
    a.out = (float*)d_out; a.ws = (unsigned char*)d_ws;
#if MK_PER_PHASE
    for (int ph = 0; ph < NPH; ++ph) { a.ph_lo = ph; a.ph_hi = ph + 1; hipLaunchKernelGGL(fwd_kernel, dim3(grid), dim3(NTHR), LDS_BYTES, stream, a); }
#else
    a.ph_lo = 0; a.ph_hi = NPH;
    hipLaunchKernelGGL(fwd_kernel, dim3(grid), dim3(NTHR), LDS_BYTES, stream, a);
#endif
    const hipError_t le = hipPeekAtLastError();
    if (le != hipSuccess) fprintf(stderr, "kernel_launch: launch failed: %s\n", hipGetErrorName(le));
}
```

```cpp
#include <hip/hip_runtime.h>
#include <cstdio>
#include <cstdint>
#include <cstring>
#ifndef PROBE_DUP
#define PROBE_DUP 0
#endif
namespace pg8 {
#define PG8_LAS __attribute__((address_space(3)))
typedef unsigned short bf16_t;
typedef short bf16x8 __attribute__((ext_vector_type(8)));
typedef float f32x4 __attribute__((ext_vector_type(4)));
typedef unsigned u32x4 __attribute__((ext_vector_type(4)));
constexpr int BM = 256, BK = 64, HALF = 128, HTB = HALF * BK * 2  , STAGE_BYTES = 8 * HTB, NXCD = 8, WGM = 8;

__host__ __device__ __forceinline__ int lds_byte(int r, int c) { const int st = (r >> 4) * 2 + (c >> 5), rr = r & 15, cc = c & 31, ob = rr * 64 + cc * 2; return st * 1024 + (ob ^ (((ob >> 9) & 1) << 5)); }
__host__ __device__ __forceinline__ void stage_rc(int b, int& R, int& C) { const int st = b / 1024, sb = b % 1024, swz = sb ^ (((sb >> 9) & 1) << 5); R = (st >> 1) * 16 + swz / 64; C = (st & 1) * 32 + (swz % 64) / 2; }
__host__ __device__ __forceinline__ int perm32(int rho) { const int n = rho >> 4, i = rho & 15; return 8 * (i >> 2) + 4 * n + (i & 3); }

struct Unit { int pm, pn, ri; };
struct Gemm { const bf16_t* A; const bf16_t* Bt; int M, N, K; };

struct StaticOrder {
    int nM, nN, nwg, G, c, rep;
    __host__ __device__ void init(int M, int N, int G_, int c_, int rep_ = 1) { nM = M / BM; nN = N / BM; nwg = nM * nN; G = G_; c = c_; rep = rep_; }
    __host__ __device__ bool next(int i, Unit& u) const {
        const long L = (long)i * G + c; if (L >= (long)rep * nwg) return false;
        int wgid = (int)(L % nwg);
#if (PROBE_DUP >> 15) & 1
        if (L >= nwg) wgid = 0;
#endif
        { const int q = nwg / NXCD, r = nwg % NXCD, xcd = wgid % NXCD, off = wgid / NXCD; wgid = (xcd < r ? xcd * (q + 1) : r * (q + 1) + (xcd - r) * q) + off; }
        const int nig = WGM * nN, gid = wgid / nig, fm = gid * WGM, gsz = (nM - fm) < WGM ? (nM - fm) : WGM;
        u.pm = fm + ((wgid % nig) % gsz); u.pn = (wgid % nig) / gsz; u.ri = (int)(L / nwg); return true;
    }
    __device__ __forceinline__ void a_ready(const Unit&) const {}
    __device__ __forceinline__ void done(const Unit&) const {}
};

template <class Epi, class Sched, bool ALIGN_EPI = false, bool SP2 = false, bool A_TILED = false>
__device__ __forceinline__ void gemm_phase(PG8_LAS unsigned char* lds, const Gemm g, const Sched S, const Epi E, const int tid) {
    const int wid = __builtin_amdgcn_readfirstlane(tid >> 6), lane = tid & 63, wr = wid >> 2, wc = wid & 3, fr = lane & 15, fq = lane >> 4;
    const int K = g.K, nt = K / BK;
    unsigned voffA[2], voffB[2];
#pragma unroll
    for (int i = 0; i < 2; ++i) { int R, C; stage_rc(tid * 16 + i * 8192, R, C); const int Rb = Epi::PERM ? ((R & ~31) + perm32(R & 31)) : R;
        voffA[i] = A_TILED ? (unsigned)(tid * 16 + i * 8192) : (unsigned)(R * K + C) * 2u; voffB[i] = (unsigned)(tid * 16 + i * 8192); (void)Rb; }
    const size_t kstep = A_TILED ? (size_t)32768 : (size_t)(BK * 2);
    const size_t hstep = A_TILED ? (size_t)16384 : (size_t)HALF * K * 2;
    const size_t tstep = A_TILED ? (size_t)nt * 32768 : 2 * hstep;
    const size_t kstepB = 32768, hstepB = 16384, tstepB = (size_t)nt * 32768;
    const unsigned ldsw = (unsigned)wid * 1024u;
    const int aoff = lds_byte(wr * 64 + fr, fq * 8), boff = lds_byte(wc * 32 + fr, fq * 8);
#define PG8_SA(b, h) (((b) * 2 + (h)) * HTB)
#define PG8_SB(b, h) ((4 + (b) * 2 + (h)) * HTB)
#define PG8_STAGE(bufoff, gbase, voff) do { _Pragma("unroll") for (int _i = 0; _i < 2; ++_i) \
        __builtin_amdgcn_global_load_lds((const unsigned*)((const char*)(gbase) + (voff)[_i]), (PG8_LAS unsigned*)(lds + (bufoff) + ldsw + _i * 8192), 16, 0, 0); } while (0)
#define PG8_LDA(dst, b, h) do { _Pragma("unroll") for (int m = 0; m < 4; ++m) _Pragma("unroll") for (int k = 0; k < 2; ++k) dst[m][k] = *(const PG8_LAS bf16x8*)(lds + PG8_SA(b, h) + aoff + m * 2048 + k * 1024); } while (0)
#define PG8_LDB(dst, b, h) do { _Pragma("unroll") for (int n = 0; n < 2; ++n) _Pragma("unroll") for (int k = 0; k < 2; ++k) dst[n][k] = *(const PG8_LAS bf16x8*)(lds + PG8_SB(b, h) + boff + n * 2048 + k * 1024); } while (0)
#define PG8_MMA(ai, bj, At, Bt) do { __builtin_amdgcn_s_setprio(1); _Pragma("unroll") for (int m = 0; m < 4; ++m) _Pragma("unroll") for (int n = 0; n < 2; ++n) _Pragma("unroll") for (int k = 0; k < 2; ++k) \
        acc[ai][bj][m][n] = __builtin_amdgcn_mfma_f32_16x16x32_bf16(Bt[n][k], At[m][k], acc[ai][bj][m][n], 0, 0, 0); __builtin_amdgcn_s_setprio(0); } while (0)
#define PG8_WAIT_V(n) asm volatile("s_waitcnt vmcnt(" #n ")" ::: "memory")
#define PG8_WAIT_L(n) asm volatile("s_waitcnt lgkmcnt(" #n ")" ::: "memory")
#define PG8_BAR __builtin_amdgcn_s_barrier()
#define PG8_SCHED __builtin_amdgcn_sched_barrier(0)
    Unit cur, nxt; int ui = 0;
    if (!S.next(0, cur)) return;
    f32x4 acc[2][2][4][2];
#pragma unroll
    for (int a = 0; a < 2; ++a)
#pragma unroll
        for (int b = 0; b < 2; ++b)
#pragma unroll
            for (int m = 0; m < 4; ++m)
#pragma unroll
                for (int n = 0; n < 2; ++n) acc[a][b][m][n] = (f32x4){0.f, 0.f, 0.f, 0.f};
    bf16x8 At[4][2], B0[2][2], B1[2][2];
    const char* cA = (const char*)g.A + (size_t)cur.pm * tstep; const char* cB = (const char*)g.Bt + (size_t)cur.pn * tstepB;
    S.a_ready(cur);
    if constexpr (SP2) {
        PG8_STAGE(PG8_SB(0, 0), cB, voffB); PG8_STAGE(PG8_SB(0, 1), cB + hstepB, voffB); PG8_STAGE(PG8_SA(0, 0), cA, voffA); PG8_STAGE(PG8_SA(0, 1), cA + hstep, voffA);
        if (wr == 1) PG8_BAR;
        PG8_WAIT_V(2); PG8_BAR;
        PG8_STAGE(PG8_SB(1, 0), cB + kstepB, voffB); PG8_STAGE(PG8_SA(1, 0), cA + kstep, voffA); PG8_STAGE(PG8_SB(1, 1), cB + hstepB + kstepB, voffB);
        PG8_WAIT_V(6); PG8_BAR;
    } else {
        PG8_STAGE(PG8_SB(0, 0), cB, voffB); PG8_STAGE(PG8_SA(0, 0), cA, voffA); PG8_STAGE(PG8_SB(0, 1), cB + hstepB, voffB); PG8_STAGE(PG8_SA(0, 1), cA + hstep, voffA);
        if (wr == 1) PG8_BAR;
        PG8_WAIT_V(4); PG8_BAR;
        PG8_STAGE(PG8_SB(1, 0), cB + kstepB, voffB); PG8_STAGE(PG8_SA(1, 0), cA + kstep, voffA); PG8_STAGE(PG8_SB(1, 1), cB + hstepB + kstepB, voffB);
        PG8_WAIT_V(6); PG8_BAR;
    }
    for (;;) {
        const bool has_next = S.next(ui + 1, nxt);
        const char* nA = has_next ? (const char*)g.A + (size_t)nxt.pm * tstep : cA; const char* nB = has_next ? (const char*)g.Bt + (size_t)nxt.pn * tstepB : cB;
        for (int t = 0; t < nt; t += 2) {
            const bool last = (t == nt - 2);
            const char* a1 = cA + (size_t)(t + 1) * kstep;
            const char* a2 = last ? nA : cA + (size_t)(t + 2) * kstep; const char* b2 = last ? nB : cB + (size_t)(t + 2) * kstepB;
            const char* a3 = a2 + kstep; const char* b3 = b2 + kstepB;
            if (last && has_next) S.a_ready(nxt);
            if constexpr (Epi::HAS_MID) { if (t == 8 || t == 12 || t == 20) E.mid(acc, cur, t, wr, wc, fr, fq); }
            if constexpr (SP2) {
            PG8_LDB(B0, 0, 0); PG8_LDB(B1, 0, 1); PG8_SCHED; PG8_LDA(At, 0, 0); PG8_STAGE(PG8_SA(1, 1), a1 + hstep, voffA);
            PG8_WAIT_V(8); PG8_WAIT_L(0); PG8_BAR; PG8_MMA(0, 0, At, B0); PG8_MMA(0, 1, At, B1); PG8_BAR; PG8_SCHED;
            PG8_LDA(At, 0, 1); PG8_STAGE(PG8_SB(0, 0), b2, voffB); PG8_STAGE(PG8_SB(0, 1), b2 + hstepB, voffB); PG8_STAGE(PG8_SA(0, 0), a2, voffA);
            PG8_WAIT_V(8); PG8_WAIT_L(0); PG8_BAR; PG8_MMA(1, 0, At, B0); PG8_MMA(1, 1, At, B1); PG8_BAR; PG8_SCHED;
            PG8_LDB(B0, 1, 0); PG8_LDB(B1, 1, 1); PG8_SCHED; PG8_LDA(At, 1, 0); PG8_STAGE(PG8_SA(0, 1), a2 + hstep, voffA);
            PG8_WAIT_V(8); PG8_WAIT_L(0); PG8_BAR; PG8_MMA(0, 0, At, B0); PG8_MMA(0, 1, At, B1); PG8_BAR; PG8_SCHED;
            PG8_LDA(At, 1, 1); PG8_STAGE(PG8_SB(1, 0), b3, voffB); PG8_STAGE(PG8_SB(1, 1), b3 + hstepB, voffB); PG8_STAGE(PG8_SA(1, 0), a3, voffA);
            PG8_WAIT_V(8); PG8_WAIT_L(0); PG8_BAR; PG8_MMA(1, 0, At, B0); PG8_MMA(1, 1, At, B1); PG8_BAR; PG8_SCHED;
            } else {
            PG8_LDB(B0, 0, 0); PG8_SCHED; PG8_LDA(At, 0, 0); PG8_STAGE(PG8_SA(1, 1), a1 + hstep, voffA);
            PG8_WAIT_L(8); PG8_BAR; PG8_WAIT_L(0); PG8_MMA(0, 0, At, B0); PG8_BAR; PG8_SCHED;
            PG8_LDB(B1, 0, 1); PG8_STAGE(PG8_SB(0, 0), b2, voffB);
            PG8_BAR; PG8_WAIT_L(0); PG8_MMA(0, 1, At, B1); PG8_BAR;
            PG8_LDA(At, 0, 1); PG8_STAGE(PG8_SA(0, 0), a2, voffA);
            PG8_BAR; PG8_WAIT_L(0); PG8_MMA(1, 0, At, B0); PG8_BAR; PG8_SCHED;
            PG8_STAGE(PG8_SB(0, 1), b2 + hstepB, voffB);
            PG8_WAIT_V(6); PG8_BAR; PG8_MMA(1, 1, At, B1); PG8_BAR;
            PG8_LDB(B0, 1, 0); PG8_SCHED; PG8_LDA(At, 1, 0); PG8_STAGE(PG8_SA(0, 1), a2 + hstep, voffA);
            PG8_WAIT_L(8); PG8_BAR; PG8_WAIT_L(0); PG8_MMA(0, 0, At, B0); PG8_BAR; PG8_SCHED;
            PG8_LDB(B1, 1, 1); PG8_STAGE(PG8_SB(1, 0), b3, voffB);
            PG8_BAR; PG8_WAIT_L(0); PG8_MMA(0, 1, At, B1); PG8_BAR;
            PG8_LDA(At, 1, 1); PG8_STAGE(PG8_SA(1, 0), a3, voffA);
            PG8_BAR; PG8_WAIT_L(0); PG8_MMA(1, 0, At, B0); PG8_BAR; PG8_SCHED;
            PG8_STAGE(PG8_SB(1, 1), b3 + hstepB, voffB);
            PG8_WAIT_V(6); PG8_BAR; PG8_MMA(1, 1, At, B1); PG8_BAR;
            }
        }
        if constexpr (ALIGN_EPI) { if (wr == 0) PG8_BAR; }
        if constexpr (!Epi::AFTER_DRAIN) { E(acc, cur, wr, wc, fr, fq); S.done(cur); }
        if (!has_next) break;
#pragma unroll
        for (int a = 0; a < 2; ++a)
#pragma unroll
            for (int b = 0; b < 2; ++b)
#pragma unroll
                for (int m = 0; m < 4; ++m)
#pragma unroll
                    for (int n = 0; n < 2; ++n) acc[a][b][m][n] = (f32x4){0.f, 0.f, 0.f, 0.f};
        cur = nxt; cA = nA; cB = nB; ++ui;
        if constexpr (ALIGN_EPI) { if (wr == 1) PG8_BAR; }
    }
    PG8_WAIT_V(0);
    if constexpr (!ALIGN_EPI) { if (wr == 0) PG8_BAR; }
    PG8_BAR;
    if constexpr (Epi::AFTER_DRAIN) { E.fused(acc, cur, wr, wc, fr, fq, lds, wid, lane); S.done(cur); }
#undef PG8_SA
#undef PG8_SB
#undef PG8_STAGE
#undef PG8_LDA
#undef PG8_LDB
#undef PG8_MMA
#undef PG8_WAIT_V
#undef PG8_WAIT_L
#undef PG8_BAR
#undef PG8_SCHED
}
}

constexpr int DM = 2048, DFF = 5504, DEPTH = 4;
constexpr int SEQ = 4096, NB_P = 2, MP = NB_P * SEQ;
constexpr int NB_S = 8, TS = 4, MS = NB_S * TS;
constexpr int MR = MP + MS;
constexpr int MPAD = 8448;
constexpr int PAST = 16384;
constexpr int N_IN = 14096, NWIN = 14336;
constexpr int NGU = 2 * DFF;
constexpr float EPS = 1e-6f;
constexpr int NWAVES = 8, NTHR = 512;

constexpr int C_CB = 0, C_CC = 512, C_CH = 1024, C_AQ = 1536, C_AK = 2304, C_AV = 3072, C_GQ = 3840, C_GK = 4096, C_GV = 4352, C_GR = 4864, C_LR = 5376, C_PIN = 5392, C_GATE = 5904;
constexpr int T_CONV = 0, T_CB = 4, T_Q = 6, T_K = 9, T_V = 12, T_GQ = 15, T_GK = 16, T_GV = 17, T_GR = 19, T_Z = 21, T_PIN = 22, T_GATE = 24;

constexpr int OFF_YP = 0;
constexpr int OFF_YS = OFF_YP + MP * DM;
constexpr int OFF_CONV_P = OFF_YS + MS * DM;
constexpr int OFF_CONV_S = OFF_CONV_P + DEPTH * NB_P * 2 * 512;
constexpr int OFF_W128_P = OFF_CONV_S + DEPTH * NB_S * 2 * 512;
constexpr int OFF_W128_S = OFF_W128_P + DEPTH * NB_P * 128 * 512;
constexpr int OFF_W512_P = OFF_W128_S + DEPTH * NB_S * 128 * 512;
constexpr int OFF_W512_S = OFF_W512_P + DEPTH * NB_P * 512 * 512;
constexpr int OFF_W2048_P = OFF_W512_S + DEPTH * NB_S * 512 * 512;
constexpr int OFF_W2048_S = OFF_W2048_P + DEPTH * NB_P * 2048 * 512;
constexpr int OFF_GLA_P = OFF_W2048_S + DEPTH * NB_S * 2048 * 512;
constexpr int OFF_GLA_S = OFF_GLA_P + DEPTH * NB_P * 4 * 64 * 128;
constexpr int OFF_POOL_P = OFF_GLA_S + DEPTH * NB_S * 4 * 64 * 128;
constexpr int OFF_POOL_S = OFF_POOL_P + DEPTH * NB_P * 15 * 512;
constexpr int OUT_TOTAL = OFF_POOL_S + DEPTH * NB_S * 15 * 512;
static_assert(OUT_TOTAL == 73551872, "output size");

constexpr size_t MiB = 1u << 20;
constexpr size_t WS_CTL = 0, CTL_ZERO_BYTES = 1 * MiB;
constexpr size_t SZ_ROW2K_F32 = (size_t)MPAD * DM * 4, SZ_ROW2K_BF = (size_t)MPAD * DM * 2;
constexpr size_t WS_X = WS_CTL + CTL_ZERO_BYTES;
constexpr size_t WS_XN = WS_X + SZ_ROW2K_F32;
constexpr size_t WS_H = WS_XN + SZ_ROW2K_BF;
constexpr size_t WS_CB = WS_H + (size_t)MPAD * DFF * 2;
constexpr size_t WS_U = WS_CB + (size_t)MPAD * 512 * 2;
constexpr size_t WS_Q = WS_U + (size_t)MPAD * 512 * 2;
constexpr size_t WS_K = WS_Q + (size_t)MPAD * 768 * 2;
constexpr size_t WS_V = WS_K + (size_t)MPAD * 768 * 2;
constexpr size_t WS_GQ = WS_V + (size_t)MPAD * 768 * 2;
constexpr size_t WS_GK = WS_GQ + (size_t)MPAD * 256 * 2;
constexpr size_t WS_GV = WS_GK + (size_t)MPAD * 256 * 2;
constexpr size_t WS_GR = WS_GV + (size_t)MPAD * 512 * 2;
constexpr size_t WS_LA = WS_GR + (size_t)MPAD * 512 * 2;
constexpr size_t WS_PIN = WS_LA + (size_t)MPAD * 256 * 4;
constexpr size_t WS_GATE = WS_PIN + (size_t)MPAD * 512 * 2;
constexpr int YK = 1792, YO_A = 0, YO_B = 512, YO_C = 768, YO_D = 1280;
constexpr size_t WS_YCAT = WS_GATE + (size_t)MPAD * 8192 * 2;
constexpr size_t WS_AO = WS_YCAT + (size_t)MPAD * YK * 2;
constexpr size_t WS_LSE = WS_AO + (size_t)MPAD * 768 * 4;
constexpr size_t WS_DS = WS_LSE + (size_t)MPAD * 12 * 4;
constexpr size_t WS_DEC = WS_DS + (size_t)8 * 64 * 64 * 128 * 4;
constexpr size_t WS_SP = WS_DEC + (size_t)8 * 64 * 64 * 4;
constexpr size_t WS_PM = WS_SP + (size_t)8 * 64 * 64 * 128 * 2;
constexpr size_t WS_MRG = WS_PM + (size_t)(MPAD - MP) * DM * 4;
constexpr size_t WS_W = WS_MRG + SZ_ROW2K_BF;
constexpr size_t WE_GU1 = 0;
constexpr size_t WE_D1 = WE_GU1 + (size_t)NGU * DM;
constexpr size_t WE_IN = WE_D1 + (size_t)DM * DFF;
constexpr size_t WE_UPCAT = WE_IN + (size_t)NWIN * DM;
constexpr size_t WE_OUT = WE_UPCAT + (size_t)DM * YK;
constexpr size_t WE_GU2 = WE_OUT + (size_t)DM * DM;
constexpr size_t WE_D2 = WE_GU2 + (size_t)NGU * DM;
constexpr size_t WE_LAYER = WE_D2 + (size_t)DM * DFF;
static_assert(WE_LAYER == 104857600, "layer weights");
constexpr size_t WS_END = WS_W + (size_t)DEPTH * WE_LAYER * 2;
static_assert(WS_X % 256 == 0 && WS_W % 256 == 0 && WS_LSE % 256 == 0 && WS_DS % 256 == 0, "alignment");

constexpr int CW_BAR = 4096;
constexpr size_t CTL_SS = 65536;
constexpr float SS_FIX = 16777216.0f;
static_assert(CTL_SS + 12 * (size_t)MPAD * 8 <= CTL_ZERO_BYTES, "SS fits the zeroed control region");

constexpr int RING_OFF = 0, RING_BYTES = 131072;
constexpr int LDSCTL_OFF = RING_BYTES, MISC_OFF = LDSCTL_OFF + 320;
constexpr int LDS_BYTES = 147456;

#define GAS __attribute__((address_space(1)))
#define LAS __attribute__((address_space(3)))
#define GAS __attribute__((address_space(1)))
typedef unsigned short bf16;
typedef unsigned u32x4 __attribute__((ext_vector_type(4)));
typedef unsigned u32x2 __attribute__((ext_vector_type(2)));
typedef float f32x4 __attribute__((ext_vector_type(4)));
typedef float f32x2 __attribute__((ext_vector_type(2)));
typedef short bf16x8 __attribute__((ext_vector_type(8)));
typedef short s16x4 __attribute__((ext_vector_type(4)));
#define LDS_WAIT() asm volatile("s_waitcnt lgkmcnt(0)" ::: "memory")
#define VM_WAIT() asm volatile("s_waitcnt vmcnt(0)" ::: "memory")
__device__ __forceinline__ unsigned f2bf(float f) { unsigned u = __builtin_bit_cast(unsigned, f); return (u + 0x7fffu + ((u >> 16) & 1u)) >> 16; }
__device__ __forceinline__ unsigned pk2(float lo, float hi) { return f2bf(lo) | (f2bf(hi) << 16); }
__device__ __forceinline__ float bflo(unsigned w) { return __builtin_bit_cast(float, w << 16); }
__device__ __forceinline__ float bfhi(unsigned w) { return __builtin_bit_cast(float, w & 0xffff0000u); }
__device__ __forceinline__ float bf2f(bf16 b) { return __builtin_bit_cast(float, ((unsigned)b) << 16); }
__device__ __forceinline__ u32x4 pk8(f32x4 a, f32x4 b) { u32x4 w; w.x = pk2(a[0], a[1]); w.y = pk2(a[2], a[3]); w.z = pk2(b[0], b[1]); w.w = pk2(b[2], b[3]); return w; }
__device__ __forceinline__ void unpk8(u32x4 w, float (&f)[8]) { f[0] = bflo(w.x); f[1] = bfhi(w.x); f[2] = bflo(w.y); f[3] = bfhi(w.y); f[4] = bflo(w.z); f[5] = bfhi(w.z); f[6] = bflo(w.w); f[7] = bfhi(w.w); }
__device__ __forceinline__ float sigmoidf_(float x) { return __builtin_amdgcn_rcpf(1.0f + __expf(-x)); }
__device__ __forceinline__ float siluf_(float x) { return x * sigmoidf_(x); }
__device__ __forceinline__ float shx(float v, int m, int lane) { return __builtin_bit_cast(float, __builtin_amdgcn_ds_bpermute((lane ^ m) << 2, __builtin_bit_cast(int, v))); }
__device__ __forceinline__ float rdl(float v, int j) { return __builtin_bit_cast(float, __builtin_amdgcn_readlane(__builtin_bit_cast(int, v), j)); }
__device__ __forceinline__ float wave_sum(float v, int lane) {
#pragma unroll
    for (int o = 1; o < 64; o <<= 1) v += shx(v, o, lane);
    return v;
}
__device__ __forceinline__ float wave_max(float v, int lane) {
#pragma unroll
    for (int o = 1; o < 64; o <<= 1) v = fmaxf(v, shx(v, o, lane));
    return v;
}
__device__ __forceinline__ int win_of(int gi) { return 128 << (2 * gi); }
__device__ __forceinline__ int dil_of(int gi) { return 1 << (2 * gi); }
__device__ __forceinline__ int offw_p(int gi) { return gi == 0 ? OFF_W128_P : (gi == 1 ? OFF_W512_P : OFF_W2048_P); }
__device__ __forceinline__ int offw_s(int gi) { return gi == 0 ? OFF_W128_S : (gi == 1 ? OFF_W512_S : OFF_W2048_S); }

#define XB_TMO      128
#define XB_XCNT(j)  (256  + 64 * (j))
#define XB_XSUB(j)  (1280 + 64 * (j))
#define XB_XGEN(j)  (2304 + 64 * (j))
#define XB_TOP      3328
#define XB_TOPGEN   3392
#define XCD_BAR_WORDS 3456
#define XB_SPIN_CAP (1u << 18)

__device__ __forceinline__ unsigned xb_ld(unsigned* p)              { return __hip_atomic_load(p, __ATOMIC_RELAXED, __HIP_MEMORY_SCOPE_AGENT); }
__device__ __forceinline__ unsigned xb_add(unsigned* p, unsigned v) { return __hip_atomic_fetch_add(p, v, __ATOMIC_RELAXED, __HIP_MEMORY_SCOPE_AGENT); }
__device__ __forceinline__ unsigned xb_xcc_id() { return (unsigned)__builtin_amdgcn_s_getreg((3 << 11) | 20) & 0xFu; }
#define XB_SPIN(cond, bar) do { unsigned _sp = 0; while (cond) { __builtin_amdgcn_s_sleep(1); \
    if ((++_sp & 255u) == 0u) { if (xb_ld(&(bar)[XB_TMO])) break; if (_sp > XB_SPIN_CAP) { atomicAdd(&(bar)[XB_TMO], 1u); break; } } } } while (0)

struct XcdBarrier {
    unsigned* bar; unsigned x;
    volatile LAS unsigned* st;
};
__device__ __forceinline__ XcdBarrier xcd_barrier_post(unsigned* bar, volatile LAS unsigned* st) {
    XcdBarrier b; b.bar = bar; b.x = xb_xcc_id(); b.st = st;
    if (threadIdx.x == 0) (void)xb_add(&bar[XB_XCNT(b.x)], 1u);
    return b;
}
__device__ __forceinline__ void xcd_barrier_complete(unsigned* bar, unsigned x, unsigned& nloc, unsigned& nx) {
    const unsigned G = gridDim.x * gridDim.y * gridDim.z;
    unsigned sum, cnt, mine, sp = 0u;
    for (;;) {
        sum = 0u; cnt = 0u; mine = 0u;
#pragma unroll
        for (unsigned j = 0; j < 16; ++j) { const unsigned c = xb_ld(&bar[XB_XCNT(j)]); sum += c; cnt += (c > 0u) ? 1u : 0u; mine = (j == x) ? c : mine; }
        if (sum == G) break;
        __builtin_amdgcn_s_sleep(1);
        if ((++sp & 255u) == 0u) { if (xb_ld(&bar[XB_TMO])) break; if (sp > XB_SPIN_CAP) { atomicAdd(&bar[XB_TMO], 1u); break; } }
    }
    nloc = mine > 0u ? mine : 1u; nx = cnt > 0u ? cnt : 1u;
}
__device__ __forceinline__ void xcd_barrier(const XcdBarrier& b, const int tid) {
    asm volatile("s_waitcnt vmcnt(0)" ::: "memory");
    __syncthreads();
    if (tid == 0) {
        unsigned* bar = b.bar;
        __builtin_amdgcn_s_waitcnt(0);
        unsigned nloc = b.st[0], nx = b.st[1];
        if (nloc == 0u) { xcd_barrier_complete(bar, b.x, nloc, nx); b.st[0] = nloc; b.st[1] = nx; }
        const unsigned old = xb_add(&bar[XB_XSUB(b.x)], 1u);
        const unsigned gen = old / nloc;
        if (old + 1u == (gen + 1u) * nloc) {
            __builtin_amdgcn_fence(__ATOMIC_RELEASE, "agent");
            asm volatile("s_waitcnt vmcnt(0)" ::: "memory");
            const unsigned og = xb_add(&bar[XB_TOP], 1u);
            const unsigned tg = og / nx;
            if (og + 1u == (tg + 1u) * nx) xb_add(&bar[XB_TOPGEN], 1u);
            else XB_SPIN(xb_ld(&bar[XB_TOPGEN]) == tg, bar);
            __builtin_amdgcn_fence(__ATOMIC_ACQUIRE, "agent");
            xb_add(&bar[XB_XGEN(b.x)], 1u);
            asm volatile("s_waitcnt vmcnt(0)" ::: "memory");
        } else {
            XB_SPIN(xb_ld(&bar[XB_XGEN(b.x)]) == gen, bar);
            __builtin_amdgcn_fence(__ATOMIC_ACQUIRE, "agent");
            asm volatile("s_waitcnt vmcnt(0)" ::: "memory");
        }
    }
    __syncthreads();
}

constexpr int PT_OFF = LDSCTL_OFF;
constexpr int PT_OUT = 31, PT_WS = 32;
__device__ __forceinline__ const float* ldp(LAS unsigned char* lds, int i) {
    const unsigned long long v = *(volatile LAS unsigned long long*)(lds + PT_OFF + 8 * i);
    const unsigned lo = __builtin_amdgcn_readfirstlane((unsigned)v), hi = __builtin_amdgcn_readfirstlane((unsigned)(v >> 32));
    return (const float*)(const GAS float*)(((unsigned long long)hi << 32) | lo);
}

typedef f32x4 (&AccRef)[2][2][4][2];

__device__ __forceinline__ void row_decode(int row, int& kind, int& b, int& t) {
    if (row < MP) { kind = 0; b = row >> 12; t = row & 4095; }
    else if (row < MR) { kind = 1; b = (row - MP) >> 2; t = (row - MP) & 3; }
    else { kind = 2; b = 0; t = 0; }
}


#ifndef EPI_NT
#define EPI_NT 0
#endif
#if EPI_NT
#define EPI_ST(ptr, val) __builtin_nontemporal_store((val), (ptr))
#else
#define EPI_ST(ptr, val) (*(ptr) = (val))
#endif
typedef _Float16 h16x4 __attribute__((ext_vector_type(4)));
typedef _Float16 h16x8 __attribute__((ext_vector_type(8)));
constexpr size_t RAT_STRIDE = (size_t)MPAD * DM;

template <bool SK> __device__ __forceinline__ void scale_rows_rstd(AccRef acc, const unsigned long long* ss, int row0) {
#pragma unroll
    for (int ai = 0; ai < (SK ? 1 : 2); ++ai)
#pragma unroll
        for (int m = 0; m < (SK ? 2 : 4); ++m) {
            const float r = rsqrtf((float)ss[row0 + ai * 128 + m * 16] * (1.0f / (SS_FIX * DM)) + EPS);
#pragma unroll
            for (int bj = 0; bj < 2; ++bj)
#pragma unroll
                for (int n = 0; n < 2; ++n) acc[ai][bj][m][n] *= r;
        }
}

struct EpiSwiGLU {
    static constexpr bool PERM = false, AFTER_DRAIN = false, HAS_MID = false;
    unsigned char* ws; int nid;
    __device__ __forceinline__ void operator()(AccRef acc, const pg8::Unit& u, int wr, int wc, int fr, int fq) const { run<false>(acc, u, wr, wc, fr, fq); }
    template <bool SK> __device__ __forceinline__ void run(AccRef acc, const pg8::Unit& u, int wr, int wc, int fr_, int fq_) const {
        int fr = fr_, fq = fq_; asm volatile("" : "+v"(fr), "+v"(fq));
        bf16* H = (bf16*)(ws + WS_H);
        const int row0 = u.pm * 256 + wr * 64 + fr, col0 = u.pn * 128 + wc * 32 + 8 * fq;
        scale_rows_rstd<SK>(acc, (const unsigned long long*)(ws + WS_CTL + CTL_SS) + (size_t)nid * MPAD, row0);
#pragma unroll
        for (int ai = 0; ai < (SK ? 1 : 2); ++ai)
#pragma unroll
            for (int m = 0; m < (SK ? 2 : 4); ++m) {
                bf16* p = SK ? H + (size_t)(row0 + ai * 128 + m * 16) * DFF + col0
                             : (bf16*)((char*)H + ((size_t)(u.pm * (DFF / 64) + 2 * u.pn + (wc >> 1)) * 2 + ai) * 16384 + ((4 * wr + m) * 2 + (wc & 1)) * 1024 + ((fr * 64 + 16 * fq) ^ ((fr >> 3) << 5)));
                f32x4 h0, h1;
#pragma unroll
                for (int j = 0; j < 4; ++j) { h0[j] = siluf_(acc[ai][0][m][0][j]) * acc[ai][1][m][0][j]; h1[j] = siluf_(acc[ai][0][m][1][j]) * acc[ai][1][m][1][j]; }
                EPI_ST((u32x4*)p, pk8(h0, h1));
            }
    }
};

struct EpiResid {
    static constexpr bool PERM = false, AFTER_DRAIN = false, HAS_MID = false;
    unsigned char* ws; LAS unsigned char* lds; float scale; int fin; int nid;
    __device__ __forceinline__ void operator()(AccRef acc, const pg8::Unit& u, int wr, int wc, int fr, int fq) const { run<false>(acc, u, wr, wc, fr, fq); }
    template <bool SK> __device__ __forceinline__ void run(AccRef acc, const pg8::Unit& u, int wr, int wc, int fr_, int fq_) const {
        int fr = fr_, fq = fq_; asm volatile("" : "+v"(fr), "+v"(fq));
        bf16* XB = (bf16*)(ws + WS_XN);
        unsigned long long* ssp = (unsigned long long*)(ws + WS_CTL + CTL_SS) + (size_t)(nid < 0 ? 0 : nid) * MPAD;
        float* out = fin ? (float*)ldp(lds, PT_OUT) : nullptr;
        const float scale = (u.ri == 0) ? this->scale : 0.f; const int nid = (u.ri == 0) ? this->nid : -1;
        const int row0 = u.pm * 256 + wr * 64 + fr, col0 = u.pn * 256 + wc * 32 + 8 * fq;
#pragma unroll
        for (int ai = 0; ai < (SK ? 1 : 2); ++ai)
#pragma unroll
            for (int m = 0; m < (SK ? 2 : 4); ++m) {
                const int row = row0 + ai * 128 + m * 16;
                char* xr = (char*)XB + (SK ? ((size_t)row * DM + col0) * 2
                                           : ((size_t)(u.pm * (DM / 64) + 4 * u.pn + (wc >> 1)) * 2 + ai) * 16384 + ((4 * wr + m) * 2 + (wc & 1)) * 1024 + ((fr * 64 + 16 * fq) ^ ((fr >> 3) << 5)));
                constexpr size_t BJS = SK ? 256 : 65536;
                float sq = 0.f;
#pragma unroll
                for (int bj = 0; bj < 2; ++bj) {
                    float xo[8]; unpk8(*(const u32x4*)(xr + bj * BJS), xo);
                    f32x4 v0, v1;
#pragma unroll
                    for (int j = 0; j < 4; ++j) { v0[j] = xo[j] + scale * acc[ai][bj][m][0][j]; v1[j] = xo[4 + j] + scale * acc[ai][bj][m][1][j]; }
                    if (out != nullptr && row < MR) { float* o = out + (size_t)row * DM + col0 + bj * 128; *(f32x4*)o = v0; *(f32x4*)(o + 4) = v1; }
                    const u32x4 w = pk8(v0, v1);
                    EPI_ST((u32x4*)(xr + bj * BJS), w);
                    float xn[8]; unpk8(w, xn);
#pragma unroll
                    for (int j = 0; j < 8; ++j) sq += xn[j] * xn[j];
                }
                { const int ln = fq * 16 + fr; sq += shx(sq, 16, ln); sq += shx(sq, 32, ln); }
                if (nid >= 0 && fq == 0) atomicAdd(ssp + row, (unsigned long long)(sq * SS_FIX + 0.5f));
            }
    }
};

struct EpiMergeCat {
    static constexpr bool PERM = false, AFTER_DRAIN = false, HAS_MID = true;
    unsigned char* ws;
    __device__ __forceinline__ void apply(f32x4 (&acc)[2][2][4][2], const pg8::Unit& u, int s, int wr, int wc, int fr_, int fq_) const {
        int fr = fr_, fq = fq_; asm volatile("" : "+v"(fr), "+v"(fq));
        const _Float16* R = (const _Float16*)(ws + WS_GATE) + (size_t)s * RAT_STRIDE;
        const int row0 = u.pm * 256 + wr * 64 + fr, col0 = u.pn * 256 + wc * 32 + 8 * fq;
        h16x8 r[2][4][2];
#pragma unroll
        for (int ai = 0; ai < 2; ++ai)
#pragma unroll
            for (int m = 0; m < 4; ++m)
#pragma unroll
                for (int bj = 0; bj < 2; ++bj) r[ai][m][bj] = *(const h16x8*)(R + (size_t)(row0 + ai * 128 + m * 16) * DM + col0 + bj * 128);
#pragma unroll
        for (int ai = 0; ai < 2; ++ai)
#pragma unroll
            for (int m = 0; m < 4; ++m)
#pragma unroll
                for (int bj = 0; bj < 2; ++bj)
#pragma unroll
                    for (int j = 0; j < 4; ++j) { acc[ai][bj][m][0][j] *= (float)r[ai][m][bj][j]; acc[ai][bj][m][1][j] *= (float)r[ai][m][bj][4 + j]; }
    }
    __device__ __forceinline__ void mid(f32x4 (&acc)[2][2][4][2], const pg8::Unit& u, int t, int wr, int wc, int fr, int fq) const {
        apply(acc, u, (t == 8) ? 0 : (t == 12 ? 1 : 2), wr, wc, fr, fq);
    }
    __device__ __forceinline__ void operator()(AccRef acc, const pg8::Unit& u, int wr, int wc, int fr_, int fq_) const {
        apply(acc, u, 3, wr, wc, fr_, fq_);
        int fr = fr_, fq = fq_; asm volatile("" : "+v"(fr), "+v"(fq));
        bf16* MRG = (bf16*)(ws + WS_MRG);
        const int row0 = u.pm * 256 + wr * 64 + fr, col0 = u.pn * 256 + wc * 32 + 8 * fq;
#pragma unroll
        for (int ai = 0; ai < 2; ++ai)
#pragma unroll
            for (int m = 0; m < 4; ++m)
#pragma unroll
                for (int bj = 0; bj < 2; ++bj)
                    EPI_ST((u32x4*)((char*)MRG + ((size_t)(u.pm * (DM / 64) + 4 * u.pn + 2 * bj + (wc >> 1)) * 2 + ai) * 16384 + ((4 * wr + m) * 2 + (wc & 1)) * 1024 + ((fr * 64 + 16 * fq) ^ ((fr >> 3) << 5))),
                           pk8(acc[ai][bj][m][0], acc[ai][bj][m][1]));
    }
};
template <int MODE>
struct EpiMergeS {
    static constexpr bool PERM = false, AFTER_DRAIN = false, HAS_MID = false;
    unsigned char* ws; int br;
    template <bool SK> __device__ __forceinline__ void run(AccRef acc, const pg8::Unit& u, int wr, int wc, int fr, int fq) const {
        float* P = (float*)(ws + WS_PM); bf16* MRG = (bf16*)(ws + WS_MRG);
        const int row0 = u.pm * 256 + wr * 64 + fr, col0 = u.pn * 256 + wc * 32 + 8 * fq;
#pragma unroll
        for (int m = 0; m < 2; ++m) {
            const int row = row0 + m * 16;
#pragma unroll
            for (int bj = 0; bj < 2; ++bj) {
                const int c = col0 + bj * 128;
                float g[8];
                { const _Float16* R = (const _Float16*)(ws + WS_GATE) + (size_t)row * DM + c;
                  const h16x8 r3 = *(const h16x8*)(R + 3 * RAT_STRIDE);
#pragma unroll
                  for (int j = 0; j < 8; ++j) g[j] = (float)r3[j];
#pragma unroll
                  for (int s = 2; s >= 0; --s) if (s >= br) { const h16x8 rs = *(const h16x8*)(R + (size_t)s * RAT_STRIDE);
#pragma unroll
                      for (int j = 0; j < 8; ++j) g[j] *= (float)rs[j]; } }
                f32x4 v0, v1;
#pragma unroll
                for (int j = 0; j < 4; ++j) { v0[j] = g[j] * acc[0][bj][m][0][j]; v1[j] = g[4 + j] * acc[0][bj][m][1][j]; }
                float* pp = P + (size_t)(row - MP) * DM + c;
                if (MODE != 0) { v0 += *(const f32x4*)pp; v1 += *(const f32x4*)(pp + 4); }
                if (MODE == 2) *(u32x4*)(MRG + (size_t)row * DM + c) = pk8(v0, v1);
                else { *(f32x4*)pp = v0; *(f32x4*)(pp + 4) = v1; }
            }
        }
    }
};

struct EpiWin {
    static constexpr bool PERM = false, AFTER_DRAIN = false, HAS_MID = false;
    unsigned char* ws;
    const float *qgain, *kgain, *b_a;
    float* out; int layer; int nid;

    template <int ACT, bool SK>
    __device__ __forceinline__ void plain(AccRef acc, bf16* dst, int ldc, int cbase, int row0, int wc, int fq) const {
#pragma unroll
        for (int ai = 0; ai < (SK ? 1 : 2); ++ai)
#pragma unroll
            for (int m = 0; m < (SK ? 2 : 4); ++m) {
                bf16* p = dst + (size_t)(row0 + ai * 128 + m * 16) * ldc + cbase + wc * 32 + fq * 8;
#pragma unroll
                for (int bj = 0; bj < 2; ++bj) {
                    f32x4 v0 = acc[ai][bj][m][0], v1 = acc[ai][bj][m][1];
#pragma unroll
                    for (int j = 0; j < 4; ++j) {
                        if (ACT == 1) { v0[j] = sigmoidf_(v0[j]); v1[j] = sigmoidf_(v1[j]); }
                        if (ACT == 2) { v0[j] = siluf_(v0[j]); v1[j] = siluf_(v1[j]); }
                        if (ACT == 3) { v0[j] *= 0.125f; v1[j] *= 0.125f; }
                    }
                    EPI_ST((u32x4*)(p + bj * 128), pk8(v0, v1));
                }
            }
    }

    __device__ __forceinline__ void operator()(AccRef acc, const pg8::Unit& u, int wr, int wc, int fr, int fq) const { run<false>(acc, u, wr, wc, fr, fq); }
    template <bool SK> __device__ __forceinline__ void run(AccRef acc, const pg8::Unit& u, int wr, int wc, int fr_, int fq_) const {
        int fr = fr_, fq = fq_; asm volatile("" : "+v"(fr), "+v"(fq));
        const int pn = u.pn, row0 = u.pm * 256 + wr * 64 + fr, l = layer;
        scale_rows_rstd<SK>(acc, (const unsigned long long*)(ws + WS_CTL + CTL_SS) + (size_t)nid * MPAD, row0);
        if (pn < T_CB) {
            const int ch0 = 128 * pn + 32 * wc + 8 * fq;
#pragma unroll
            for (int ai = 0; ai < (SK ? 1 : 2); ++ai)
#pragma unroll
                for (int m = 0; m < (SK ? 2 : 4); ++m) {
                    const int row = row0 + ai * 128 + m * 16;
                    const f32x4 u0 = acc[ai][0][m][0] * acc[ai][1][m][0], u1 = acc[ai][0][m][1] * acc[ai][1][m][1];
                    *(u32x4*)((bf16*)(ws + WS_U) + (size_t)row * 512 + ch0) = pk8(u0, u1);
                    int kind, b, t; row_decode(row, kind, b, t);
                    if (kind == 0 && t >= SEQ - 2) { float* o = out + OFF_CONV_P + ((l * NB_P + b) * 2 + (t - (SEQ - 2))) * 512 + ch0; *(f32x4*)o = u0; *(f32x4*)(o + 4) = u1; }
                    if (kind == 1 && t >= TS - 2)  { float* o = out + OFF_CONV_S + ((l * NB_S + b) * 2 + (t - (TS - 2))) * 512 + ch0; *(f32x4*)o = u0; *(f32x4*)(o + 4) = u1; }
                }
        } else if (pn < T_Q) {
            plain<0, SK>(acc, (bf16*)(ws + WS_CB), 512, 256 * (pn - T_CB), row0, wc, fq);
        } else if (pn < T_V) {
            const bool isk = pn >= T_K; const int ti = isk ? pn - T_K : pn - T_Q; const int head = 4 * ti + wc;
            const float* gp = (isk ? kgain : qgain) + head * 64 + 8 * fq;
            f32x4 g[2][2];
#pragma unroll
            for (int bj = 0; bj < 2; ++bj) { g[bj][0] = *(const f32x4*)(gp + 32 * bj); g[bj][1] = *(const f32x4*)(gp + 32 * bj + 4); }
            bf16* dst = (bf16*)(ws + (isk ? WS_K : WS_Q));
            const int W = win_of(ti);
#pragma unroll
            for (int ai = 0; ai < (SK ? 1 : 2); ++ai)
#pragma unroll
                for (int m = 0; m < (SK ? 2 : 4); ++m) {
                    const int row = row0 + ai * 128 + m * 16;
                    float ss = 0.f;
#pragma unroll
                    for (int bj = 0; bj < 2; ++bj)
#pragma unroll
                        for (int n = 0; n < 2; ++n) { const f32x4 x = acc[ai][bj][m][n]; ss += (x[0] * x[0] + x[1] * x[1]) + (x[2] * x[2] + x[3] * x[3]); }
                    { const int ln = fq * 16 + fr; ss += shx(ss, 16, ln); ss += shx(ss, 32, ln); }
                    const float rs = rsqrtf(ss * (1.0f / 64.0f) + EPS);
                    int kind, b, t; row_decode(row, kind, b, t);
#pragma unroll
                    for (int bj = 0; bj < 2; ++bj) {
                        const f32x4 y0 = acc[ai][bj][m][0] * rs * g[bj][0], y1 = acc[ai][bj][m][1] * rs * g[bj][1];
                        *(u32x4*)(dst + (size_t)row * 768 + head * 64 + 32 * bj + 8 * fq) = pk8(y0, y1);
                        if (isk) {
                            const int e0 = 32 * bj + 8 * fq;
                            if (kind == 0 && t >= SEQ - W) { float* o = out + offw_p(ti) + ((((l * NB_P + b) * W + (t - (SEQ - W))) * 2 + 0) * 4 + wc) * 64 + e0; *(f32x4*)o = y0; *(f32x4*)(o + 4) = y1; }
                            if (kind == 1)                 { float* o = out + offw_s(ti) + ((((l * NB_S + b) * W + (W - TS + t)) * 2 + 0) * 4 + wc) * 64 + e0; *(f32x4*)o = y0; *(f32x4*)(o + 4) = y1; }
                        }
                    }
                }
        } else if (pn < T_GQ) {
            const int ti = pn - T_V;
            plain<0, SK>(acc, (bf16*)(ws + WS_V), 768, 256 * ti, row0, wc, fq);
            const int W = win_of(ti);
#pragma unroll
            for (int ai = 0; ai < (SK ? 1 : 2); ++ai)
#pragma unroll
                for (int m = 0; m < (SK ? 2 : 4); ++m) {
                    const int row = row0 + ai * 128 + m * 16;
                    int kind, b, t; row_decode(row, kind, b, t);
#pragma unroll
                    for (int bj = 0; bj < 2; ++bj) {
                        const int hh = 2 * bj + (wc >> 1), e0 = 32 * (wc & 1) + 8 * fq;
                        if (kind == 0 && t >= SEQ - W) { float* o = out + offw_p(ti) + ((((l * NB_P + b) * W + (t - (SEQ - W))) * 2 + 1) * 4 + hh) * 64 + e0; *(f32x4*)o = acc[ai][bj][m][0]; *(f32x4*)(o + 4) = acc[ai][bj][m][1]; }
                        if (kind == 1)                 { float* o = out + offw_s(ti) + ((((l * NB_S + b) * W + (W - TS + t)) * 2 + 1) * 4 + hh) * 64 + e0; *(f32x4*)o = acc[ai][bj][m][0]; *(f32x4*)(o + 4) = acc[ai][bj][m][1]; }
                    }
                }
        } else if (pn == T_GQ) {
            plain<3, SK>(acc, (bf16*)(ws + WS_GQ), 256, 0, row0, wc, fq);
        } else if (pn == T_GK) {
            plain<0, SK>(acc, (bf16*)(ws + WS_GK), 256, 0, row0, wc, fq);
        } else if (pn < T_GR) {
            plain<0, SK>(acc, (bf16*)(ws + WS_GV), 512, 256 * (pn - T_GV), row0, wc, fq);
        } else if (pn < T_Z) {
            plain<2, SK>(acc, (bf16*)(ws + WS_GR), 512, 256 * (pn - T_GR), row0, wc, fq);
        } else if (pn == T_Z) {
#pragma unroll
            for (int bj = 0; bj < 2; ++bj) {
                const int c0 = 128 * bj + 32 * wc + 8 * fq;
                const f32x4 b0 = *(const f32x4*)(b_a + c0), b1 = *(const f32x4*)(b_a + c0 + 4);
#pragma unroll
                for (int ai = 0; ai < (SK ? 1 : 2); ++ai)
#pragma unroll
                    for (int m = 0; m < (SK ? 2 : 4); ++m) {
                        const int row = row0 + ai * 128 + m * 16;
                        f32x4 z0 = acc[ai][bj][m][0] + b0, z1 = acc[ai][bj][m][1] + b1;
#pragma unroll
                        for (int j = 0; j < 4; ++j) {
                            z0[j] = (fminf(z0[j], 0.f) - __logf(1.0f + __expf(-fabsf(z0[j])))) * (1.0f / 16.0f);
                            z1[j] = (fminf(z1[j], 0.f) - __logf(1.0f + __expf(-fabsf(z1[j])))) * (1.0f / 16.0f);
                        }
                        float* o = (float*)(ws + WS_LA) + (size_t)row * 256 + c0; *(f32x4*)o = z0; *(f32x4*)(o + 4) = z1;
                    }
            }
        } else if (pn < T_GATE) {
            const int ti = pn - T_PIN;
            plain<0, SK>(acc, (bf16*)(ws + WS_PIN), 512, 256 * ti, row0, wc, fq);
#pragma unroll
            for (int ai = 0; ai < (SK ? 1 : 2); ++ai)
#pragma unroll
                for (int m = 0; m < (SK ? 2 : 4); ++m) {
                    const int row = row0 + ai * 128 + m * 16;
                    int kind, b, t; row_decode(row, kind, b, t);
#pragma unroll
                    for (int bj = 0; bj < 2; ++bj) {
                        const int c0 = 256 * ti + 128 * bj + 32 * wc + 8 * fq;
                        if (kind == 0 && t >= SEQ - 15) { float* o = out + OFF_POOL_P + ((l * NB_P + b) * 15 + (t - (SEQ - 15))) * 512 + c0; *(f32x4*)o = acc[ai][bj][m][0]; *(f32x4*)(o + 4) = acc[ai][bj][m][1]; }
                        if (kind == 1)                  { float* o = out + OFF_POOL_S + ((l * NB_S + b) * 15 + (15 - TS + t)) * 512 + c0; *(f32x4*)o = acc[ai][bj][m][0]; *(f32x4*)(o + 4) = acc[ai][bj][m][1]; }
                    }
                }
        } else {
            _Float16* R = (_Float16*)(ws + WS_GATE);
            const int c0 = 64 * (pn - T_GATE) + 16 * wc + 4 * fq;
#pragma unroll
            for (int ai = 0; ai < (SK ? 1 : 2); ++ai)
#pragma unroll
                for (int m = 0; m < (SK ? 2 : 4); ++m) {
                    const size_t o = (size_t)(row0 + ai * 128 + m * 16) * DM + c0;
                    h16x4 r0, r1, r2, r3;
#pragma unroll
                    for (int j = 0; j < 4; ++j) {
                        const float d0 = fminf(1.0f + __expf(-acc[ai][0][m][0][j]), 16384.f), d1 = fminf(1.0f + __expf(-acc[ai][0][m][1][j]), 16384.f);
                        const float d2 = fminf(1.0f + __expf(-acc[ai][1][m][0][j]), 16384.f), d3 = fminf(1.0f + __expf(-acc[ai][1][m][1][j]), 16384.f);
                        const float i0 = __builtin_amdgcn_rcpf(d0), i1 = __builtin_amdgcn_rcpf(d1), i2 = __builtin_amdgcn_rcpf(d2), i3 = __builtin_amdgcn_rcpf(d3);
                        r0[j] = (_Float16)fminf(d1 * i0, 65504.f); r1[j] = (_Float16)fminf(d2 * i1, 65504.f); r2[j] = (_Float16)fminf(d3 * i2, 65504.f); r3[j] = (_Float16)i3;
                    }
                    EPI_ST((h16x4*)(R + o), r0); EPI_ST((h16x4*)(R + RAT_STRIDE + o), r1); EPI_ST((h16x4*)(R + 2 * RAT_STRIDE + o), r2); EPI_ST((h16x4*)(R + 3 * RAT_STRIDE + o), r3);
                }
        }
    }
};

__device__ __forceinline__ unsigned wt_lane(int wc, int fr, int g) { return (unsigned)(wc * 4096 + (g >> 1) * 1024 + ((fr * 64 + 32 * (g & 1)) ^ ((fr >> 3) << 5))); }
template <class Epi>
__device__ __forceinline__ void skinny_unit(LAS unsigned char* lds, const bf16* A, const bf16* Bt, int K, int su, const Epi E, int tid, int ld = 0) {
    if (ld == 0) ld = K;
    const int lane = tid & 63, w = __builtin_amdgcn_readfirstlane(tid >> 6), fr = lane & 15, g = lane >> 4;
    const int pn = su >> 2, wc = su & 3;
    const int nh = K >> 6, h0 = (w * nh) >> 3, h1 = ((w + 1) * nh) >> 3;
    f32x4 acc[2][2][2];
#pragma unroll
    for (int bj = 0; bj < 2; ++bj)
#pragma unroll
        for (int m = 0; m < 2; ++m)
#pragma unroll
            for (int n = 0; n < 2; ++n) acc[bj][m][n] = (f32x4){0.f, 0.f, 0.f, 0.f};
    const bf16* ap = A + (size_t)(MP + fr) * ld + 16 * g;
    const char* bp = (const char*)Bt + (size_t)pn * nh * 32768 + wt_lane(wc, fr, g);
    for (int hc = h0; hc < h1; hc += 4) {
        bf16x8 a[4][2][2], b[4][2][2][2];
#pragma unroll
        for (int q = 0; q < 4; ++q) {
            const int hq = (hc + q < h1) ? hc + q : h1 - 1;
#pragma unroll
            for (int s = 0; s < 2; ++s) {
#pragma unroll
                for (int m = 0; m < 2; ++m) a[q][m][s] = *(const bf16x8*)(ap + (size_t)(16 * m) * ld + 64 * hq + 8 * s);
#pragma unroll
                for (int bj = 0; bj < 2; ++bj)
#pragma unroll
                    for (int n = 0; n < 2; ++n) b[q][bj][n][s] = *(const bf16x8*)(bp + (size_t)hq * 32768 + bj * 16384 + n * 2048 + s * 16);
            }
        }
#pragma unroll
        for (int q = 0; q < 4; ++q) {
            const bool ok = hc + q < h1;
#pragma unroll
            for (int s = 0; s < 2; ++s)
#pragma unroll
                for (int m = 0; m < 2; ++m) {
                    bf16x8 av = a[q][m][s];
                    if (!ok) av = (bf16x8){0, 0, 0, 0, 0, 0, 0, 0};
#pragma unroll
                    for (int bj = 0; bj < 2; ++bj)
#pragma unroll
                        for (int n = 0; n < 2; ++n) acc[bj][m][n] = __builtin_amdgcn_mfma_f32_16x16x32_bf16(b[q][bj][n][s], av, acc[bj][m][n], 0, 0, 0);
                }
        }
    }
    LAS f32x4* red = (LAS f32x4*)lds;
#pragma unroll
    for (int bj = 0; bj < 2; ++bj)
#pragma unroll
        for (int m = 0; m < 2; ++m)
#pragma unroll
            for (int n = 0; n < 2; ++n) red[(w * 8 + (bj * 4 + m * 2 + n)) * 64 + lane] = acc[bj][m][n];
    __syncthreads();
    if (w == 0) {
        f32x4 full[2][2][4][2];
#pragma unroll
        for (int bj = 0; bj < 2; ++bj)
#pragma unroll
            for (int m = 0; m < 2; ++m)
#pragma unroll
                for (int n = 0; n < 2; ++n) {
                    f32x4 s = red[(bj * 4 + m * 2 + n) * 64 + lane];
#pragma unroll
                    for (int ww = 1; ww < 8; ++ww) s += red[(ww * 8 + (bj * 4 + m * 2 + n)) * 64 + lane];
                    asm volatile("" : "+v"(s) :: "memory");
                    full[0][bj][m][n] = s;
                }
        pg8::Unit u; u.pm = MP / 256; u.pn = pn; u.ri = 0;
        E.template run<true>(full, u, 0, wc, fr, g);
    }
    __syncthreads();
}

__device__ __forceinline__ void skinny_merge_unit(LAS unsigned char* lds, unsigned char* ws, const bf16* Y, const bf16* U, int su, int tid) {
    const int lane = tid & 63, w = __builtin_amdgcn_readfirstlane(tid >> 6), fr = lane & 15, g = lane >> 4;
    const int pn = su >> 2, wc = su & 3;
    f32x4 acc[2][2][2];
#pragma unroll
    for (int bj = 0; bj < 2; ++bj)
#pragma unroll
        for (int m = 0; m < 2; ++m)
#pragma unroll
            for (int n = 0; n < 2; ++n) acc[bj][m][n] = (f32x4){0.f, 0.f, 0.f, 0.f};
    if (w < 7) {
        const bf16* ap = Y + (size_t)(MP + fr) * YK + 16 * g + 256 * w;
        const char* bp = (const char*)U + (size_t)(pn * (YK / 64) + 4 * w) * 32768 + wt_lane(wc, fr, g);
        bf16x8 a[4][2][2], b[4][2][2][2];
#pragma unroll
        for (int q = 0; q < 4; ++q)
#pragma unroll
            for (int s2 = 0; s2 < 2; ++s2) {
#pragma unroll
                for (int m = 0; m < 2; ++m) a[q][m][s2] = *(const bf16x8*)(ap + (size_t)(16 * m) * YK + 64 * q + 8 * s2);
#pragma unroll
                for (int bj = 0; bj < 2; ++bj)
#pragma unroll
                    for (int n = 0; n < 2; ++n) b[q][bj][n][s2] = *(const bf16x8*)(bp + (size_t)q * 32768 + bj * 16384 + n * 2048 + s2 * 16);
            }
#pragma unroll
        for (int q = 0; q < 4; ++q)
#pragma unroll
            for (int s2 = 0; s2 < 2; ++s2)
#pragma unroll
                for (int m = 0; m < 2; ++m)
#pragma unroll
                    for (int bj = 0; bj < 2; ++bj)
#pragma unroll
                        for (int n = 0; n < 2; ++n) acc[bj][m][n] = __builtin_amdgcn_mfma_f32_16x16x32_bf16(b[q][bj][n][s2], a[q][m][s2], acc[bj][m][n], 0, 0, 0);
    }
    LAS f32x4* red = (LAS f32x4*)lds;
#pragma unroll
    for (int bj = 0; bj < 2; ++bj)
#pragma unroll
        for (int m = 0; m < 2; ++m)
#pragma unroll
            for (int n = 0; n < 2; ++n) red[(w * 8 + (bj * 4 + m * 2 + n)) * 64 + lane] = acc[bj][m][n];
    __syncthreads();
    if (w == 0) {
        bf16* MRG = (bf16*)(ws + WS_MRG);
        const int col0 = pn * 256 + wc * 32 + 8 * g;
#pragma unroll
        for (int m = 0; m < 2; ++m) {
            const int row = MP + 16 * m + fr;
#pragma unroll
            for (int bj = 0; bj < 2; ++bj) {
                const _Float16* R = (const _Float16*)(ws + WS_GATE) + (size_t)row * DM + col0 + bj * 128;
                const h16x8 r0 = *(const h16x8*)R, r1 = *(const h16x8*)(R + RAT_STRIDE), r2 = *(const h16x8*)(R + 2 * RAT_STRIDE), r3 = *(const h16x8*)(R + 3 * RAT_STRIDE);
                f32x4 o[2];
#pragma unroll
                for (int n = 0; n < 2; ++n) {
                    const int ti = bj * 4 + m * 2 + n;
                    const f32x4 pa = red[(0 * 8 + ti) * 64 + lane] + red[(1 * 8 + ti) * 64 + lane], pb = red[(2 * 8 + ti) * 64 + lane];
                    const f32x4 pc = red[(3 * 8 + ti) * 64 + lane] + red[(4 * 8 + ti) * 64 + lane], pd = red[(5 * 8 + ti) * 64 + lane] + red[(6 * 8 + ti) * 64 + lane];
#pragma unroll
                    for (int j = 0; j < 4; ++j) {
                        const float e3 = (float)r3[4 * n + j], e2 = (float)r2[4 * n + j] * e3, e1 = (float)r1[4 * n + j] * e2, e0 = (float)r0[4 * n + j] * e1;
                        o[n][j] = (e0 * pa[j] + e1 * pb[j]) + (e2 * pc[j] + e3 * pd[j]);
                    }
                }
                *(u32x4*)(MRG + (size_t)row * DM + col0 + bj * 128) = pk8(o[0], o[1]);
            }
        }
    }
    __syncthreads();
}

constexpr int IT_GU = 344 * 32, IT_D = 64 * 86, IT_IN = 448 * 32, IT_UPA = 64 * 8, IT_UPB = 64 * 4, IT_UPC = 64 * 8, IT_UPD = 64 * 8, IT_OUT = 64 * 32;
constexpr int IT_LAYER = 2 * IT_GU + 2 * IT_D + IT_IN + IT_UPA + IT_UPB + IT_UPC + IT_UPD + IT_OUT;
static_assert(IT_LAYER == 51200, "items per layer");

constexpr int PB_LAYER = 2 * 43 * 32 + 2 * 8 * 86 + 56 * 32 + 8 * 8 + 8 * 4 + 8 * 8 + 8 * 8 + 8 * 32;
static_assert(PB_LAYER == 6400, "blocks per layer");
constexpr int PB_P = 265;
constexpr int PB_PW_OFF = 69632;
struct BDesc { const float* src; const float* gain; bf16* dst; int ldw, K, kind, perm, aux0, aux1, aux2; };

__device__ __forceinline__ void pblk_decode(LAS unsigned char* lds, bf16* WB, int blk, int wave, int lane, BDesc& D) {
    const int l = blk / PB_LAYER; int r = blk % PB_LAYER;
    const int g = lane >> 3, c4 = lane & 7, bj = g >> 2, wc = g & 3;
    int wi, wi2, gi = -1, ldw, S0, k0, K, T, perm = 1, yo = 0; size_t wofs, woff;
    if (r < 2 * 1376) {
        const int f = r / 1376; r -= f * 1376; T = r % 43; const int kb = r / 43;
        wi = f ? 28 : 9; wi2 = f ? 29 : 10; wofs = (size_t)l * DM * DFF; ldw = DFF; S0 = 128 * T + 32 * wc; k0 = 64 * kb; K = DM; woff = f ? WE_GU2 : WE_GU1; gi = f ? 27 : 8;
    } else if ((r -= 2 * 1376) < 2 * 688) {
        const int f = r / 688; r -= f * 688; T = r % 8; const int kb = r / 8;
        wi = wi2 = f ? 30 : 11; wofs = (size_t)l * DFF * DM; ldw = DM; S0 = 256 * T + 32 * g; k0 = 64 * kb; K = DFF; woff = f ? WE_D2 : WE_D1;
    } else if ((r -= 2 * 688) < 1792) {
        T = r % 56; const int kb = r / 56, pn = T;
        wi = wi2 = 13; wofs = (size_t)l * DM * N_IN; ldw = N_IN; k0 = 64 * kb; K = DM; woff = WE_IN; gi = 12;
        if (pn < T_CB) S0 = (bj ? C_CH : C_CC) + 128 * pn + 32 * wc;
        else if (pn < T_Q) S0 = C_CB + 256 * (pn - T_CB) + 32 * g;
        else if (pn < T_K) S0 = C_AQ + 256 * (pn - T_Q) + 64 * wc + 32 * bj;
        else if (pn < T_V) S0 = C_AK + 256 * (pn - T_K) + 64 * wc + 32 * bj;
        else if (pn < T_GQ) S0 = C_AV + 256 * (pn - T_V) + 32 * g;
        else if (pn == T_GQ) S0 = C_GQ + 32 * g;
        else if (pn == T_GK) S0 = C_GK + 32 * g;
        else if (pn < T_GR) S0 = C_GV + 256 * (pn - T_GV) + 32 * g;
        else if (pn < T_Z) S0 = C_GR + 256 * (pn - T_GR) + 32 * g;
        else if (pn == T_Z) S0 = C_LR;
        else if (pn < T_GATE) S0 = C_PIN + 256 * (pn - T_PIN) + 32 * g;
        else { S0 = C_GATE + (2 * bj + (c4 >> 2)) * 2048 + 64 * (pn - T_GATE) + 16 * wc + 4 * (c4 & 3) - 4 * c4; perm = 0; }
    } else {
        r -= 1792; K = YK; woff = WE_UPCAT; ldw = DM; int kb;
        if (r < 64) { T = r % 8; kb = r / 8; wi = 22; wofs = (size_t)l * 512 * DM; yo = YO_A; }
        else if ((r -= 64) < 32) { T = r % 8; kb = r / 8; wi = 23; wofs = (size_t)l * 256 * DM; yo = YO_B; }
        else if ((r -= 32) < 64) { T = r % 8; kb = r / 8; wi = 24; wofs = (size_t)l * 512 * DM; yo = YO_C; }
        else if ((r -= 64) < 64) { T = r % 8; kb = r / 8; wi = 25; wofs = (size_t)l * 512 * DM; yo = YO_D; }
        else { r -= 64; T = r % 8; kb = r / 8; wi = 26; wofs = (size_t)l * DM * DM; K = DM; woff = WE_OUT; }
        wi2 = wi; S0 = 256 * T + 32 * g; k0 = 64 * kb;
    }
    const float* W0 = ldp(lds, wi); const float* W1 = ldp(lds, wi2); const float* gbase = ldp(lds, gi >= 0 ? gi : 8);
    D.src = (bj ? W1 : W0) + wofs + (size_t)(k0 + 8 * wave) * ldw + S0 + 4 * c4;
    D.gain = gi >= 0 ? gbase + (size_t)l * DM + k0 + 8 * wave : gbase;
    D.dst = WB + (size_t)l * WE_LAYER + woff + ((size_t)T * (K >> 6) + ((yo + k0) >> 6)) * 16384; D.ldw = ldw; D.K = K; D.kind = 0; D.perm = perm; D.aux0 = 0; D.aux1 = l; D.aux2 = gi >= 0;
}
__device__ __forceinline__ void pblk_load(const BDesc& D, f32x4 (&v)[8], f32x4 (&gv)[2]) {
#pragma unroll
    for (int i = 0; i < 8; ++i) v[i] = __builtin_nontemporal_load((const f32x4*)(D.src + (size_t)i * D.ldw));
    gv[0] = *(const f32x4*)D.gain; gv[1] = *(const f32x4*)(D.gain + 4);
}
template <int MODE = 0>
__device__ __forceinline__ void pblk_writeout(LAS unsigned char* lds, bf16* dst, int K, int perm, int tid) {
    LAS float* tile = (LAS float*)(lds + RING_OFF);
    const int lane = tid & 63, wave = tid >> 6;
    LDS_WAIT(); __builtin_amdgcn_s_barrier(); asm volatile("" ::: "memory");
    const int c = lane & 7;
#pragma unroll
    for (int j = 0; j < 4; ++j) {
        const int rho = (lane >> 3) + 8 * j; const int cc = perm ? pg8::perm32(rho) : rho;
        const LAS float* s = tile + (8 * c) * PB_P + 33 * wave + cc;
        u32x4 o; o.x = pk2(s[0 * PB_P], s[1 * PB_P]); o.y = pk2(s[2 * PB_P], s[3 * PB_P]); o.z = pk2(s[4 * PB_P], s[5 * PB_P]); o.w = pk2(s[6 * PB_P], s[7 * PB_P]);
        if (MODE == 0) *(u32x4*)((char*)dst + (wave >> 2) * 16384 + pg8::lds_byte(32 * (wave & 3) + rho, 8 * c)) = o; else asm volatile("" :: "v"(o));
    }
    LDS_WAIT(); __builtin_amdgcn_s_barrier(); asm volatile("" ::: "memory");
}
template <int MODE = 0>
__device__ __forceinline__ void pblk_finish(LAS unsigned char* lds, const BDesc& D, const f32x4 (&v)[8], const f32x4 (&gv)[2], int tid) {
    if (MODE == 2) { _Pragma("unroll") for (int i = 0; i < 8; ++i) asm volatile("" :: "v"(v[i])); return; }
    f32x4 g0 = gv[0], g1 = gv[1]; asm volatile("" : "+v"(g0), "+v"(g1) :: "memory");
    LAS float* tile = (LAS float*)(lds + RING_OFF);
    const int lane = tid & 63, wave = tid >> 6;
    const int g = lane >> 3, c4 = lane & 7;
#pragma unroll
    for (int i = 0; i < 8; ++i) { const float gk = D.aux2 ? (i < 4 ? g0[i & 3] : g1[i & 3]) : 1.0f; LAS float* s = tile + (8 * wave + i) * PB_P + 33 * g + 4 * c4; s[0] = v[i][0] * gk; s[1] = v[i][1] * gk; s[2] = v[i][2] * gk; s[3] = v[i][3] * gk; }
    pblk_writeout<MODE>(lds, D.dst, D.K, D.perm, tid);
}
__device__ __forceinline__ void prologue_specials(LAS unsigned char* lds, bf16* WB, int bid, int G, int tid) {
    LAS float* tile = (LAS float*)(lds + RING_OFF);
#pragma unroll 1
    for (int s = bid; s < DEPTH * 96; s += G) {
        const int l = s / 96, r = s % 96;
        bf16* wl = WB + (size_t)l * WE_LAYER;
        if (r < 32) {
            const int kb = r;
            const float* A2 = ldp(lds, 17) + (size_t)l * 16 * 256; const float* gmix = ldp(lds, 12) + (size_t)l * DM;
            const float* Wk = ldp(lds, 13) + (size_t)l * DM * N_IN + (size_t)(64 * kb) * N_IN + C_LR;
            const int c = tid & 255, half = tid >> 8;
            float w2[16];
#pragma unroll
            for (int q = 0; q < 16; ++q) w2[q] = A2[q * 256 + c];
#pragma unroll 4
            for (int i = 0; i < 32; ++i) {
                const int kk = 32 * half + i;
                const f32x4* a = (const f32x4*)(Wk + (size_t)kk * N_IN);
                float sum = 0.f;
#pragma unroll
                for (int q = 0; q < 4; ++q) { const f32x4 av = a[q]; sum += av[0] * w2[4 * q] + av[1] * w2[4 * q + 1] + av[2] * w2[4 * q + 2] + av[3] * w2[4 * q + 3]; }
                tile[kk * PB_P + 33 * (c >> 5) + (c & 31)] = sum * gmix[64 * kb + kk];
            }
            pblk_writeout(lds, wl + WE_IN + ((size_t)T_Z * (DM / 64) + kb) * 16384, DM, 1, tid);
        } else {
            const int q = r - 32, T = q % 8, kb = q / 8, gg = kb >> 1, i0 = (kb & 1) * 64;
            LAS float* pw = (LAS float*)(lds + PB_PW_OFF);
            { const f32x4* src = (const f32x4*)(ldp(lds, 20) + ((size_t)l * 4 + gg) * 128 * 128 + (size_t)i0 * 128);
              for (int e = tid; e < 64 * 32; e += NTHR) ((LAS f32x4*)pw)[e] = src[e]; }
            LDS_WAIT(); __builtin_amdgcn_s_barrier(); asm volatile("" ::: "memory");
            const int n = tid & 255, half = tid >> 8;
            const float* SC = ldp(lds, 21) + (size_t)l * 512 + gg * 128;
            const float* UD = ldp(lds, 25) + (size_t)l * 512 * DM + (size_t)(gg * 128) * DM + 256 * T + n;
            float a[32];
#pragma unroll
            for (int j = 0; j < 32; ++j) a[j] = 0.f;
#pragma unroll 2
            for (int c = 0; c < 128; c += 4) {
                const float u0 = UD[(size_t)c * DM] * SC[c], u1 = UD[(size_t)(c + 1) * DM] * SC[c + 1], u2 = UD[(size_t)(c + 2) * DM] * SC[c + 2], u3 = UD[(size_t)(c + 3) * DM] * SC[c + 3];
#pragma unroll
                for (int j = 0; j < 32; ++j) { const f32x4 p = *(const LAS f32x4*)(pw + (32 * half + j) * 128 + c); a[j] += (p[0] * u0 + p[1] * u1) + (p[2] * u2 + p[3] * u3); }
            }
#pragma unroll
            for (int j = 0; j < 32; ++j) tile[(32 * half + j) * PB_P + 33 * (n >> 5) + (n & 31)] = a[j];
            pblk_writeout(lds, wl + WE_UPCAT + ((size_t)T * (YK / 64) + YO_D / 64 + kb) * 16384, YK, 1, tid);
        }
    }
}
constexpr int DEFER_WG0 = 96, DEFER_WGS = 160, DEFER_PER_WG = 9, DEFER_N = (DEFER_WGS * DEFER_PER_WG < 1376) ? DEFER_WGS * DEFER_PER_WG : 1376;
constexpr int TAIL_WGS = 224, TAIL_N = 568;
constexpr int DEFER_X = 224;
static_assert(DEFER_N == 1376, "the slot list jumps from the end of a gate|up matrix to a down matrix");
__device__ __forceinline__ bool pblk_deferred(int blk) {
    const int l = blk / PB_LAYER, r = blk % PB_LAYER;
    if (r < 1376) return l >= 1 && r < DEFER_N;
    if (r < 2 * 1376) return (r - 1376) < DEFER_N;
    if (r < 2 * 1376 + 688) return l >= 1 && (r - 2 * 1376) < DEFER_X;
    if (r < 2 * 1376 + 2 * 688) return (r - 2 * 1376 - 688) < DEFER_X;
    return l >= 1;
}
__device__ __forceinline__ bool pblk_special(int blk) {
    int r = blk % PB_LAYER - (2 * 1376 + 2 * 688);
    if (r < 0) return false;
    if (r < 1792) return (r % 56) == T_Z;
    r -= 1792 + 64 + 32 + 64; return r >= 0 && r < 64;
}
#define PB_BLK(i) (first + (i) + ((i) >= jump_at ? jump : 0))
#define PB_NEXT(I) { while (cand < count && ((skip_deferred && pblk_deferred(PB_BLK(cand))) || pblk_special(PB_BLK(cand)))) cand += stride; I = cand < count ? cand : -1; cand += stride; }
#define PB_LOAD(D, V, GV, I) { const int li_ = (I) >= 0 ? (I) : i0; pblk_decode(lds, WB, PB_BLK(li_), wave, lane, D); if ((I) < 0) { D.src = dummy; D.ldw = 0; } pblk_load(D, V, GV); }
#define PB_STEP(CUR, VCUR, GCUR, INEXT, NXT2, VNXT2, GNXT2, INXT2) { PB_NEXT(INXT2); \
        PB_LOAD(NXT2, VNXT2, GNXT2, INXT2) \
        pblk_finish<MODE>(lds, CUR, VCUR, GCUR, tid); \
        if (INEXT < 0) break; }
template <int MODE = 0>
__device__ __forceinline__ void prologue_blocks(LAS unsigned char* lds, bf16* WB, int first, int count, int start, int stride, int tid, bool skip_deferred, int jump_at = 0x7fffffff, int jump = 0) {
    const int lane = tid & 63, wave = __builtin_amdgcn_readfirstlane(tid >> 6);
    BDesc A, B, C; f32x4 va[8], vb[8], vc[8], ga[2], gb[2], gc[2];
    int cand = start, ia, ib, ic;
    PB_NEXT(ia); if (ia < 0) return;
    const int i0 = ia; const float* dummy = ldp(lds, 8) + 4 * lane;
    PB_LOAD(A, va, ga, ia)
    PB_NEXT(ib);
    PB_LOAD(B, vb, gb, ib)
#pragma unroll 1
    for (;;) {
        PB_STEP(A, va, ga, ib, C, vc, gc, ic)
        PB_STEP(B, vb, gb, ic, A, va, ga, ia)
        PB_STEP(C, vc, gc, ia, B, vb, gb, ib)
    }
}
#undef PB_STEP
#undef PB_LOAD
#undef PB_NEXT
#undef PB_BLK

__device__ __forceinline__ void x_init_pass(const float* xp, const float* xs, bf16* XB, unsigned long long* ss0, int gw, int NGW, int lane) {
    for (int row = gw; row < MPAD; row += NGW) {
        u32x2* o = (u32x2*)(XB + (size_t)row * DM) + lane;
        if (row < MP) {
            const int R = row & 127, C = 4 * (lane & 15);
            o = (u32x2*)((char*)XB + ((size_t)((row >> 8) * (DM / 64) + (lane >> 4)) * 2 + ((row >> 7) & 1)) * 16384 + pg8::lds_byte(R, C));
        }
        const int ostep = row < MP ? 4 * 32768 / 8 : 64;
        if (row >= MR) {
#pragma unroll
            for (int j = 0; j < 8; ++j) { u32x2 z; z.x = 0u; z.y = 0u; o[ostep * j] = z; }
            continue;
        }
        const f32x4* xr = (const f32x4*)(row < MP ? xp + (size_t)row * DM : xs + (size_t)(row - MP) * DM) + lane;
        float ss = 0.f;
#pragma unroll
        for (int j = 0; j < 8; ++j) { const f32x4 v = xr[64 * j]; u32x2 w; w.x = pk2(v[0], v[1]); w.y = pk2(v[2], v[3]); o[ostep * j] = w;
            const float a0 = bflo(w.x), a1 = bfhi(w.x), a2 = bflo(w.y), a3 = bfhi(w.y); ss += (a0 * a0 + a1 * a1) + (a2 * a2 + a3 * a3); }
        ss = wave_sum(ss, lane);
        if (lane == 0) ss0[row] = (unsigned long long)(ss * SS_FIX + 0.5f);
    }
}

constexpr int CC_N0 = DEPTH * NB_S * (128 - TS) * 128, CC_N1 = DEPTH * NB_S * (512 - TS) * 128, CC_N2 = DEPTH * NB_S * (2048 - TS) * 128, CACHE_COPY_N = CC_N0 + CC_N1 + CC_N2;
__device__ __forceinline__ void cache_copy_range(const float* c128, const float* c512, const float* c2048, float* out, int i0, int i1, int t, int nt) {
    for (int i = i0 + t; i < i1; i += nt) {
        int ii = i, gi = 0;
        if (ii >= CC_N0) { ii -= CC_N0; gi = 1; if (ii >= CC_N1) { ii -= CC_N1; gi = 2; } }
        const int W = win_of(gi), per = (W - TS) * 128, lb = ii / per, j = ii - lb * per;
        const f32x4* src = (const f32x4*)(gi == 0 ? c128 : (gi == 1 ? c512 : c2048)); f32x4* dst = (f32x4*)(out + offw_s(gi));
        __builtin_nontemporal_store(__builtin_nontemporal_load(src + (size_t)lb * W * 128 + TS * 128 + j), dst + (size_t)lb * W * 128 + j);
    }
}

__device__ __forceinline__ s16x4 ds_tr16(const LAS unsigned char* p) { return __builtin_amdgcn_ds_read_tr16_b64_v4i16((LAS s16x4*)p); }
__device__ __forceinline__ bf16x8 cat4(s16x4 a, s16x4 b) { bf16x8 r; r[0] = a[0]; r[1] = a[1]; r[2] = a[2]; r[3] = a[3]; r[4] = b[0]; r[5] = b[1]; r[6] = b[2]; r[7] = b[3]; return r; }
__device__ __forceinline__ bf16x8 pk8v(f32x4 a, f32x4 b) { const u32x4 w = pk8(a, b); return __builtin_bit_cast(bf16x8, w); }

constexpr int ATT_UNITS = NB_P * 12 * 32;
constexpr int ATT_PITCH = 144;
__device__ __forceinline__ void attn_unit(LAS unsigned char* lds, const bf16* Q, const bf16* K, const bf16* V, float* AO, float* LSE, int unit, int tid) {
    const int lane = tid & 63, w = tid >> 6, fr = lane & 15, g = lane >> 4;
    const int blk = unit & 31, bh = unit >> 5, h = bh % 12, b = bh / 12;
    const int gi = h >> 2, dl = dil_of(gi);
    const int r = blk % dl, nb = blk / dl;
    LAS unsigned char* Ks = lds; LAS unsigned char* Vs = lds + 256 * ATT_PITCH;
    for (int c = tid; c < 2048; c += NTHR) {
        const int ki = c >> 3, ch = c & 7, ksub = nb * 128 + ki - 128;
        u32x4 kv = {0u, 0u, 0u, 0u}, vv = {0u, 0u, 0u, 0u};
        if (ksub >= 0) { const size_t off = (size_t)(b * SEQ + r + dl * ksub) * 768 + h * 64 + ch * 8; kv = *(const u32x4*)(K + off); vv = *(const u32x4*)(V + off); }
        *(LAS u32x4*)(Ks + ki * ATT_PITCH + ch * 16) = kv; *(LAS u32x4*)(Vs + ki * ATT_PITCH + ch * 16) = vv;
    }
    __syncthreads();
    const int qi = 16 * w + fr;
    const int qtok = b * SEQ + r + dl * (nb * 128 + qi);
    const bf16x8 q0 = *(const bf16x8*)(Q + (size_t)qtok * 768 + h * 64 + 8 * g), q1 = *(const bf16x8*)(Q + (size_t)qtok * 768 + h * 64 + 32 + 8 * g);
    const int ks0 = w >> 1;
    f32x4 s[10];
#pragma unroll
    for (int tt = 0; tt < 10; ++tt) {
        const int T = 2 * ks0 + tt;
        const LAS unsigned char* kp = Ks + (16 * T + fr) * ATT_PITCH + 16 * g;
        const bf16x8 k0 = *(const LAS bf16x8*)kp, k1 = *(const LAS bf16x8*)(kp + 64);
        f32x4 a = {0.f, 0.f, 0.f, 0.f};
        a = __builtin_amdgcn_mfma_f32_16x16x32_bf16(k0, q0, a, 0, 0, 0);
        a = __builtin_amdgcn_mfma_f32_16x16x32_bf16(k1, q1, a, 0, 0, 0);
        s[tt] = a;
    }
    const float slope = exp2f(-8.0f * (float)(h + 1) / 12.0f) * (float)dl;
    float mx = -INFINITY;
#pragma unroll
    for (int tt = 0; tt < 10; ++tt)
#pragma unroll
        for (int j = 0; j < 4; ++j) {
            const int ki = 16 * (2 * ks0 + tt) + 4 * g + j, dist = qi - ki + 128, ksub = nb * 128 + ki - 128;
            const bool valid = (dist >= 0) && (dist <= 128) && (ksub >= 0);
            const float v = s[tt][j] * 0.125f - slope * (float)dist;
            s[tt][j] = valid ? v : -INFINITY;
            mx = fmaxf(mx, s[tt][j]);
        }
    mx = fmaxf(mx, shx(mx, 16, lane)); mx = fmaxf(mx, shx(mx, 32, lane));
    float ls = 0.f;
#pragma unroll
    for (int tt = 0; tt < 10; ++tt)
#pragma unroll
        for (int j = 0; j < 4; ++j) { const float p = __expf(s[tt][j] - mx); s[tt][j] = p; ls += p; }
    ls += shx(ls, 16, lane); ls += shx(ls, 32, lane);
    f32x4 o[4];
#pragma unroll
    for (int et = 0; et < 4; ++et) o[et] = (f32x4){0.f, 0.f, 0.f, 0.f};
    const int q4 = fr >> 2, p4 = fr & 3;
#pragma unroll
    for (int kk = 0; kk < 5; ++kk) {
        const bf16x8 pb = pk8v(s[2 * kk], s[2 * kk + 1]);
        const int rb = 32 * (ks0 + kk) + 4 * g + q4;
#pragma unroll
        for (int et = 0; et < 4; ++et) {
            const s16x4 v0 = ds_tr16(Vs + rb * ATT_PITCH + (16 * et + 4 * p4) * 2);
            const s16x4 v1 = ds_tr16(Vs + (rb + 16) * ATT_PITCH + (16 * et + 4 * p4) * 2);
            o[et] = __builtin_amdgcn_mfma_f32_16x16x32_bf16(cat4(v0, v1), pb, o[et], 0, 0, 0);
        }
    }
    const float inv = 1.0f / ls;
    float* ao = AO + (size_t)qtok * 768 + h * 64 + 4 * g;
#pragma unroll
    for (int et = 0; et < 4; ++et) *(f32x4*)(ao + 16 * et) = o[et] * inv;
    if (g == 0) LSE[(size_t)qtok * 12 + h] = mx + __logf(ls);
    __syncthreads();
}

__device__ __forceinline__ void attn_merge_pass(const float* AO, const float* LSE, bf16* YB, int gt, int NGT, int rep = 1) {
    for (int it0 = gt; it0 < rep * MR * 4 * 16; it0 += NGT) {
        const int it = it0 % (MR * 4 * 16);
        const int e4 = it & 15, slot = (it >> 4) & 3, tok = it >> 6;
        const float l0 = LSE[(size_t)tok * 12 + slot], l1 = LSE[(size_t)tok * 12 + 4 + slot], l2 = LSE[(size_t)tok * 12 + 8 + slot];
        const float m = fmaxf(l0, fmaxf(l1, l2));
        const float w0 = __expf(l0 - m), w1 = __expf(l1 - m), w2 = __expf(l2 - m), inv = 1.0f / (w0 + w1 + w2);
        const float* a = AO + (size_t)tok * 768 + slot * 64 + e4 * 4;
        const f32x4 y = (*(const f32x4*)a * w0 + *(const f32x4*)(a + 256) * w1 + *(const f32x4*)(a + 512) * w2) * inv;
        u32x2 wv; wv.x = pk2(y[0], y[1]); wv.y = pk2(y[2], y[3]);
        *(u32x2*)(YB + (size_t)tok * YK + YO_B + slot * 64 + e4 * 4) = wv;
    }
}

__device__ __forceinline__ float dot64_f32(const float (&q)[64], const float* k) {
    float s = 0.f;
#pragma unroll
    for (int c = 0; c < 16; ++c) { const f32x4 kv = ((const f32x4*)k)[c]; s += (q[4 * c] * kv[0] + q[4 * c + 1] * kv[1]) + (q[4 * c + 2] * kv[2] + q[4 * c + 3] * kv[3]); }
    return s;
}
__device__ __forceinline__ float dot64_bf(const float (&q)[64], const bf16* k) {
    float s = 0.f;
#pragma unroll
    for (int c = 0; c < 8; ++c) { const u32x4 w = ((const u32x4*)k)[c];
        s += (q[8 * c] * bflo(w.x) + q[8 * c + 1] * bfhi(w.x)) + (q[8 * c + 2] * bflo(w.y) + q[8 * c + 3] * bfhi(w.y)) + (q[8 * c + 4] * bflo(w.z) + q[8 * c + 5] * bfhi(w.z)) + (q[8 * c + 6] * bflo(w.w) + q[8 * c + 7] * bfhi(w.w)); }
    return s;
}
__device__ __forceinline__ void attn_sample_wave(const bf16* Q, const bf16* K, const bf16* V, const float* c128, const float* c512, const float* c2048, float* AO, float* LSE, int layer, int unit, int lane) {
    const int h = unit % 12, bt = unit / 12, t = bt & 3, b = bt >> 2;
    const int row = MP + b * TS + t;
    const int gi = h >> 2, slot = h & 3, dl = dil_of(gi), W = win_of(gi);
    const float* cache = (gi == 0 ? c128 : (gi == 1 ? c512 : c2048)) + (size_t)(layer * NB_S + b) * W * 512;
    float qf[64];
    { const u32x4* qp = (const u32x4*)(Q + (size_t)row * 768 + h * 64);
#pragma unroll
      for (int c = 0; c < 8; ++c) { const u32x4 w = qp[c]; qf[8 * c] = bflo(w.x) * 0.125f; qf[8 * c + 1] = bfhi(w.x) * 0.125f; qf[8 * c + 2] = bflo(w.y) * 0.125f; qf[8 * c + 3] = bfhi(w.y) * 0.125f;
          qf[8 * c + 4] = bflo(w.z) * 0.125f; qf[8 * c + 5] = bfhi(w.z) * 0.125f; qf[8 * c + 6] = bflo(w.w) * 0.125f; qf[8 * c + 7] = bfhi(w.w) * 0.125f; } }
    const float slope = exp2f(-8.0f * (float)(h + 1) / 12.0f) * (float)dl;
    float sc[3];
#pragma unroll
    for (int sj = 0; sj < 3; ++sj) {
        const int j = lane + 64 * sj;
        float d = -INFINITY;
        if (j <= 128) {
            const int idx = W + t - j * dl;
            if (idx >= W) d = dot64_bf(qf, K + (size_t)(MP + b * TS + (idx - W)) * 768 + h * 64);
            else d = dot64_f32(qf, cache + ((size_t)idx * 2 + 0) * 256 + slot * 64);
            d -= slope * (float)j;
        }
        sc[sj] = d;
    }
    const float mg = wave_max(fmaxf(sc[0], fmaxf(sc[1], sc[2])), lane);
    const float p0 = __expf(sc[0] - mg), p1 = __expf(sc[1] - mg), p2 = __expf(sc[2] - mg);
    const float lg = wave_sum(p0 + p1 + p2, lane);
    float acc = 0.f;
    const int jstart = (dl == 1) ? t + 1 : 1;
#pragma unroll 1
    for (int j = 0; j < jstart; ++j) acc += rdl(p0, j) * bf2f(V[(size_t)(MP + b * TS + (t - j * dl)) * 768 + h * 64 + lane]);
    const float* vbase = cache + 256 + slot * 64 + lane;
#pragma unroll 1
    for (int j0 = jstart; j0 <= 128; j0 += 32) {
        float vv[32];
#pragma unroll
        for (int i = 0; i < 32; ++i) { const int j = (j0 + i <= 128) ? j0 + i : 128; vv[i] = vbase[(size_t)(W + t - j * dl) * 512]; }
#pragma unroll
        for (int i = 0; i < 32; ++i) { const int j = j0 + i; const float pj = (j <= 128) ? rdl(j < 64 ? p0 : (j < 128 ? p1 : p2), j & 63) : 0.f; acc += pj * vv[i]; }
    }
    AO[(size_t)row * 768 + h * 64 + lane] = acc / lg;
    if (lane == 0) LSE[(size_t)row * 12 + h] = mg + __logf(lg);
}

__device__ __forceinline__ void conv_pool_pass(const bf16* CB, const bf16* U, const bf16* PIN, const float* conv_w, const float* st_conv, const float* st_pool, bf16* YA, bf16* YD, int layer, int gt, int NGT, int rep = 1) {
    for (int it0 = gt; it0 < rep * MPAD * 64; it0 += NGT) {
        const int it = it0 % (MPAD * 64); const int c8 = it & 63, row = it >> 6, ch = c8 * 8;
        int kind, b, t; row_decode(row, kind, b, t);
        if (kind == 2) { const u32x4 z = {0u, 0u, 0u, 0u}; *(u32x4*)(YA + (size_t)row * YK + YO_A + ch) = z; *(u32x4*)(YD + (size_t)row * YK + YO_D + ch) = z; continue; }
        float u0[8], u1[8], u2[8], cb[8];
        unpk8(*(const u32x4*)(U + (size_t)row * 512 + ch), u2);
        if (t >= 1) unpk8(*(const u32x4*)(U + (size_t)(row - 1) * 512 + ch), u1);
        else if (kind == 1) { const float* s = st_conv + ((size_t)(layer * NB_S + b) * 2 + 1) * 512 + ch; _Pragma("unroll") for (int j = 0; j < 8; ++j) u1[j] = s[j]; }
        else { _Pragma("unroll") for (int j = 0; j < 8; ++j) u1[j] = 0.f; }
        if (t >= 2) unpk8(*(const u32x4*)(U + (size_t)(row - 2) * 512 + ch), u0);
        else if (kind == 1) { const float* s = st_conv + ((size_t)(layer * NB_S + b) * 2 + t) * 512 + ch; _Pragma("unroll") for (int j = 0; j < 8; ++j) u0[j] = s[j]; }
        else { _Pragma("unroll") for (int j = 0; j < 8; ++j) u0[j] = 0.f; }
        unpk8(*(const u32x4*)(CB + (size_t)row * 512 + ch), cb);
        const float* cw = conv_w + (size_t)layer * 3 * 512 + ch;
        f32x4 ya0, ya1;
#pragma unroll
        for (int j = 0; j < 8; ++j) { const float z = cw[j] * u0[j] + cw[512 + j] * u1[j] + cw[1024 + j] * u2[j]; const float y = cb[j] * z; if (j < 4) ya0[j] = y; else ya1[j - 4] = y; }
        *(u32x4*)(YA + (size_t)row * YK + YO_A + ch) = pk8(ya0, ya1);
        const int grp = c8 >> 4, w = 2 << grp;
        float cur[8], sum[8];
        unpk8(*(const u32x4*)(PIN + (size_t)row * 512 + ch), cur);
#pragma unroll
        for (int j = 0; j < 8; ++j) sum[j] = cur[j];
        if (kind == 0) {
            u32x4 xr[15];
#pragma unroll
            for (int i = 1; i < 16; ++i) { const bool ok = (i < w) && (t - i >= 0); xr[i - 1] = *(const u32x4*)(PIN + (size_t)(ok ? row - i : row) * 512 + ch); }
#pragma unroll
            for (int i = 1; i < 16; ++i) { const bool ok = (i < w) && (t - i >= 0); float x[8]; unpk8(xr[i - 1], x); const float m = ok ? 1.f : 0.f;
#pragma unroll
                for (int j = 0; j < 8; ++j) sum[j] += m * x[j]; }
        } else {
            for (int i = 1; i < w; ++i) {
                const int tt = t - i;
                if (tt >= 0) { float x[8]; unpk8(*(const u32x4*)(PIN + (size_t)(row - i) * 512 + ch), x); _Pragma("unroll") for (int j = 0; j < 8; ++j) sum[j] += x[j]; }
                else { const float* s = st_pool + ((size_t)(layer * NB_S + b) * 15 + (15 + tt)) * 512 + ch; _Pragma("unroll") for (int j = 0; j < 8; ++j) sum[j] += s[j]; }
            }
        }
        const float cnt = (kind == 1) ? (float)w : fminf((float)w, (float)(t + 1));
        const float ic = 1.0f / cnt;
        f32x4 d0, d1;
#pragma unroll
        for (int j = 0; j < 8; ++j) { const float d = sum[j] * ic - cur[j]; if (j < 4) d0[j] = d; else d1[j - 4] = d; }
        *(u32x4*)(YD + (size_t)row * YK + YO_D + ch) = pk8(d0, d1);
    }
}

constexpr int GLA_UNITS = NB_P * 4 * 64;
constexpr int GP_K = 144, GP_V = 272;
constexpr int GLA_R0 = 0, GLA_R0_BYTES = 17408, GLA_QT = GLA_R0 + GLA_R0_BYTES, GLA_KT = GLA_QT + 64 * GP_K, GLA_VV = GLA_KT + 64 * GP_K, GLA_HALF = GLA_VV + 64 * GP_V;
static_assert(2 * GLA_HALF <= RING_BYTES, "GLA LDS");

__device__ __forceinline__ void gla_cumsum(LAS float* lb, const float* LA, int tok0, int h, int ht) {
    const int k = ht & 63, q = ht >> 6;
    float v[16]; float run = 0.f;
#pragma unroll
    for (int i = 0; i < 16; ++i) { run += LA[(size_t)(tok0 + 16 * q + i) * 256 + h * 64 + k]; v[i] = run; }
    LAS float* tot = lb + 4096;
    tot[q * 64 + k] = run;
    __syncthreads();
    float off = 0.f;
#pragma unroll
    for (int qq = 0; qq < 3; ++qq) off += (qq < q) ? tot[qq * 64 + k] : 0.f;
#pragma unroll
    for (int i = 0; i < 16; ++i) lb[(16 * q + i) * 64 + k] = v[i] + off;
    __syncthreads();
}

__device__ __forceinline__ void gla_ds_unit(LAS unsigned char* hl, const bf16* GK, const bf16* GV, const float* LA, float* DS, float* DEC, int unit, int ht) {
    const int n = unit & 63, bh = unit >> 6, h = bh & 3, b = bh >> 2;
    const int tok0 = b * SEQ + n * 64;
    const int lane = ht & 63, hw = ht >> 6, fr = lane & 15, g = lane >> 4;
    LAS float* lb = (LAS float*)(hl + GLA_R0);
    gla_cumsum(lb, LA, tok0, h, ht);
    for (int c = ht; c < 512; c += 256) {
        const int s = c >> 3, k0 = (c & 7) * 8;
        float kf[8]; unpk8(*(const u32x4*)(GK + (size_t)(tok0 + s) * 256 + h * 64 + k0), kf);
        f32x4 a0, a1;
#pragma unroll
        for (int j = 0; j < 8; ++j) { const float e = kf[j] * __expf(lb[63 * 64 + k0 + j] - lb[s * 64 + k0 + j]); if (j < 4) a0[j] = e; else a1[j - 4] = e; }
        *(LAS u32x4*)(hl + GLA_KT + s * GP_K + k0 * 2) = pk8(a0, a1);
    }
    for (int c = ht; c < 1024; c += 256) {
        const int s = c >> 4, v0 = (c & 15) * 8;
        *(LAS u32x4*)(hl + GLA_VV + s * GP_V + v0 * 2) = *(const u32x4*)(GV + (size_t)(tok0 + s) * 512 + h * 128 + v0);
    }
    if (ht < 64) DEC[(size_t)unit * 64 + ht] = __expf(lb[63 * 64 + ht]);
    __syncthreads();
    const int q4 = fr >> 2, p4 = fr & 3, kt = hw;
    float* dsb = DS + (size_t)unit * 64 * 128;
#pragma unroll
    for (int dvt = 0; dvt < 8; ++dvt) {
        f32x4 acc = {0.f, 0.f, 0.f, 0.f};
#pragma unroll
        for (int ks = 0; ks < 2; ++ks) {
            const int rb = 32 * ks + 4 * g + q4;
            const bf16x8 af = cat4(ds_tr16(hl + GLA_KT + rb * GP_K + (16 * kt + 4 * p4) * 2), ds_tr16(hl + GLA_KT + (rb + 16) * GP_K + (16 * kt + 4 * p4) * 2));
            const bf16x8 bf = cat4(ds_tr16(hl + GLA_VV + rb * GP_V + (16 * dvt + 4 * p4) * 2), ds_tr16(hl + GLA_VV + (rb + 16) * GP_V + (16 * dvt + 4 * p4) * 2));
            acc = __builtin_amdgcn_mfma_f32_16x16x32_bf16(af, bf, acc, 0, 0, 0);
        }
#pragma unroll
        for (int j = 0; j < 4; ++j) dsb[(size_t)(16 * kt + 4 * g + j) * 128 + 16 * dvt + fr] = acc[j];
    }
    __syncthreads();
}

__device__ __forceinline__ void gla_scan_pass(const float* DS, const float* DEC, bf16* SP, float* out, int layer, int gt, int rep = 1) {
    if (gt >= 8 * 64 * 128) return;
    for (int rr = 0; rr < rep; ++rr) {
    const int v = gt & 127, k = (gt >> 7) & 63, bh = gt >> 13;
    float S = 0.f;
    for (int n0 = 0; n0 < 64; n0 += 32) {
        float d[32], a[32];
#pragma unroll
        for (int i = 0; i < 32; ++i) { d[i] = DS[(((size_t)bh * 64 + n0 + i) * 64 + k) * 128 + v]; a[i] = DEC[((size_t)bh * 64 + n0 + i) * 64 + k]; }
#pragma unroll
        for (int i = 0; i < 32; ++i) { SP[(((size_t)bh * 64 + n0 + i) * 64 + k) * 128 + v] = (bf16)f2bf(S); S = a[i] * S + d[i]; }
    }
    out[OFF_GLA_P + (((size_t)layer * 8 + bh) * 64 + k) * 128 + v] = S;
    }
}

__device__ __forceinline__ void gla_out_unit(LAS unsigned char* hl, const bf16* GQ, const bf16* GK, const bf16* GV, const bf16* GR, const float* LA, const bf16* SP, const float* gnorm, bf16* YC, int unit, int ht) {
    const int n = unit & 63, bh = unit >> 6, h = bh & 3, b = bh >> 2;
    const int tok0 = b * SEQ + n * 64;
    const int lane = ht & 63, hw = ht >> 6, fr = lane & 15, g = lane >> 4;
    LAS float* lb = (LAS float*)(hl + GLA_R0);
    gla_cumsum(lb, LA, tok0, h, ht);
    for (int c = ht; c < 512; c += 256) {
        const int s = c >> 3, k0 = (c & 7) * 8;
        float qf[8], kf[8];
        unpk8(*(const u32x4*)(GQ + (size_t)(tok0 + s) * 256 + h * 64 + k0), qf);
        unpk8(*(const u32x4*)(GK + (size_t)(tok0 + s) * 256 + h * 64 + k0), kf);
        f32x4 a0, a1, c0, c1;
#pragma unroll
        for (int j = 0; j < 8; ++j) { const float bb = lb[s * 64 + k0 + j]; const float qe = qf[j] * __expf(bb), ke = kf[j] * __expf(-bb); if (j < 4) { a0[j] = qe; c0[j] = ke; } else { a1[j - 4] = qe; c1[j - 4] = ke; } }
        *(LAS u32x4*)(hl + GLA_QT + s * GP_K + k0 * 2) = pk8(a0, a1);
        *(LAS u32x4*)(hl + GLA_KT + s * GP_K + k0 * 2) = pk8(c0, c1);
    }
    for (int c = ht; c < 1024; c += 256) {
        const int s = c >> 4, v0 = (c & 15) * 8;
        *(LAS u32x4*)(hl + GLA_VV + s * GP_V + v0 * 2) = *(const u32x4*)(GV + (size_t)(tok0 + s) * 512 + h * 128 + v0);
    }
    __syncthreads();
    for (int c = ht; c < 1024; c += 256) {
        const int k = c >> 4, v0 = (c & 15) * 8;
        *(LAS u32x4*)(hl + GLA_R0 + k * GP_V + v0 * 2) = *(const u32x4*)(SP + ((size_t)unit * 64 + k) * 128 + v0);
    }
    __syncthreads();
    const int tt = hw, q4 = fr >> 2, p4 = fr & 3;
    f32x4 at[4];
    const LAS unsigned char* qrow = hl + GLA_QT + (16 * tt + fr) * GP_K;
    const bf16x8 qb0 = *(const LAS bf16x8*)(qrow + 16 * g), qb1 = *(const LAS bf16x8*)(qrow + 64 + 16 * g);
#pragma unroll
    for (int st = 0; st < 4; ++st) {
        const LAS unsigned char* krow = hl + GLA_KT + (16 * st + fr) * GP_K;
        f32x4 a = {0.f, 0.f, 0.f, 0.f};
        a = __builtin_amdgcn_mfma_f32_16x16x32_bf16(*(const LAS bf16x8*)(krow + 16 * g), qb0, a, 0, 0, 0);
        a = __builtin_amdgcn_mfma_f32_16x16x32_bf16(*(const LAS bf16x8*)(krow + 64 + 16 * g), qb1, a, 0, 0, 0);
#pragma unroll
        for (int j = 0; j < 4; ++j) { const int s = 16 * st + 4 * g + j, t = 16 * tt + fr; a[j] = (s <= t) ? a[j] : 0.f; }
        at[st] = a;
    }
    f32x4 o[8];
#pragma unroll
    for (int dvt = 0; dvt < 8; ++dvt) o[dvt] = (f32x4){0.f, 0.f, 0.f, 0.f};
#pragma unroll
    for (int ks = 0; ks < 2; ++ks) {
        const bf16x8 pb = pk8v(at[2 * ks], at[2 * ks + 1]);
        const int rb = 32 * ks + 4 * g + q4;
        const s16x4 qa = *(const LAS s16x4*)(qrow + (32 * ks + 4 * g) * 2), qc = *(const LAS s16x4*)(qrow + (32 * ks + 16 + 4 * g) * 2);
        const bf16x8 qp = cat4(qa, qc);
#pragma unroll
        for (int dvt = 0; dvt < 8; ++dvt) {
            const bf16x8 vf = cat4(ds_tr16(hl + GLA_VV + rb * GP_V + (16 * dvt + 4 * p4) * 2), ds_tr16(hl + GLA_VV + (rb + 16) * GP_V + (16 * dvt + 4 * p4) * 2));
            o[dvt] = __builtin_amdgcn_mfma_f32_16x16x32_bf16(vf, pb, o[dvt], 0, 0, 0);
            const bf16x8 sf = cat4(ds_tr16(hl + GLA_R0 + rb * GP_V + (16 * dvt + 4 * p4) * 2), ds_tr16(hl + GLA_R0 + (rb + 16) * GP_V + (16 * dvt + 4 * p4) * 2));
            o[dvt] = __builtin_amdgcn_mfma_f32_16x16x32_bf16(sf, qp, o[dvt], 0, 0, 0);
        }
    }
    float ss = 0.f;
#pragma unroll
    for (int dvt = 0; dvt < 8; ++dvt) ss += (o[dvt][0] * o[dvt][0] + o[dvt][1] * o[dvt][1]) + (o[dvt][2] * o[dvt][2] + o[dvt][3] * o[dvt][3]);
    ss += shx(ss, 16, lane); ss += shx(ss, 32, lane);
    const float rs = rsqrtf(ss * (1.0f / 128.0f) + EPS);
    const size_t orow = (size_t)(tok0 + 16 * tt + fr) * 512 + h * 128, yrow = (size_t)(tok0 + 16 * tt + fr) * YK + YO_C + h * 128;
#pragma unroll
    for (int dvt = 0; dvt < 8; ++dvt) {
        const int dv = 16 * dvt + 4 * g;
        const f32x4 gn = *(const f32x4*)(gnorm + dv);
        const u32x2 gw = *(const u32x2*)(GR + orow + dv);
        f32x4 y; y[0] = o[dvt][0] * rs * gn[0] * bflo(gw.x); y[1] = o[dvt][1] * rs * gn[1] * bfhi(gw.x); y[2] = o[dvt][2] * rs * gn[2] * bflo(gw.y); y[3] = o[dvt][3] * rs * gn[3] * bfhi(gw.y);
        u32x2 wv; wv.x = pk2(y[0], y[1]); wv.y = pk2(y[2], y[3]);
        *(u32x2*)(YC + yrow + dv) = wv;
    }
    __syncthreads();
}

__device__ __forceinline__ void gla_sample_unit(LAS float* red, const bf16* GQ, const bf16* GK, const bf16* GV, const bf16* GR, const float* LA, const float* st_gla, const float* gnorm, bf16* YC, float* out, int layer, int unit, int tid) {
    const int h = unit & 3, b = unit >> 2;
    const int dv = tid & 127, kq = tid >> 7;
    const float* s0 = st_gla + (((size_t)(layer * NB_S + b) * 4 + h) * 64 + 16 * kq) * 128 + dv;
    float S[16];
#pragma unroll
    for (int i = 0; i < 16; ++i) S[i] = s0[(size_t)i * 128];
#pragma unroll 1
    for (int t = 0; t < TS; ++t) {
        const int row = MP + b * TS + t;
        const float vv = bf2f(GV[(size_t)row * 512 + h * 128 + dv]);
        float po = 0.f;
#pragma unroll
        for (int i = 0; i < 16; ++i) {
            const int k = 16 * kq + i;
            const float a = __expf(LA[(size_t)row * 256 + h * 64 + k]);
            S[i] = a * S[i] + bf2f(GK[(size_t)row * 256 + h * 64 + k]) * vv;
            po += bf2f(GQ[(size_t)row * 256 + h * 64 + k]) * S[i];
        }
        red[kq * 128 + dv] = po;
        __syncthreads();
        float o = 0.f, sq = 0.f;
        if (kq == 0) { o = (red[dv] + red[128 + dv]) + (red[256 + dv] + red[384 + dv]); sq = o * o; }
        sq = wave_sum(sq, tid & 63);
        if (kq == 0 && (tid & 63) == 0) red[512 + (tid >> 6)] = sq;
        __syncthreads();
        if (kq == 0) {
            const float rs = rsqrtf((red[512] + red[513]) * (1.0f / 128.0f) + EPS);
            const float y = o * rs * gnorm[dv] * bf2f(GR[(size_t)row * 512 + h * 128 + dv]);
            YC[(size_t)row * YK + YO_C + h * 128 + dv] = (bf16)f2bf(y);
        }
        __syncthreads();
    }
    float* so = out + OFF_GLA_S + (((size_t)(layer * NB_S + b) * 4 + h) * 64 + 16 * kq) * 128 + dv;
#pragma unroll
    for (int i = 0; i < 16; ++i) so[(size_t)i * 128] = S[i];
}

constexpr int PH_PER_LAYER = 13, NPH = 1 + DEPTH * PH_PER_LAYER;
#define RM(bit) (1 + ((PROBE_DUP >> (bit)) & 1))
#define REP(bit) for (int rep_ = 0; rep_ < 1 + ((PROBE_DUP >> (bit)) & 1); ++rep_)
#ifndef PROBE_SP2
#define PROBE_SP2 true
#endif
#ifndef PROBE_ALIGN_GU
#define PROBE_ALIGN_GU true
#endif
#ifndef PROBE_ALIGN_RES
#define PROBE_ALIGN_RES true
#endif
#ifndef PROBE_ALIGN_WIN
#define PROBE_ALIGN_WIN true
#endif
#ifndef MK_UNROLL_LAYERS
#define MK_UNROLL_LAYERS 1
#endif
#ifndef MK_PER_PHASE
#define MK_PER_PHASE 0
#endif

struct Args { const float* in[31]; float* out; unsigned char* ws; int ph_lo, ph_hi; };
static_assert(sizeof(Args) == 31 * 8 + 8 + 8 + 8, "Args has no padding");

__device__ __forceinline__ unsigned char* launder(unsigned char* p) { unsigned long long v = (unsigned long long)p; asm volatile("" : "+s"(v)); return (unsigned char*)(GAS unsigned char*)v; }
__device__ __forceinline__ int opq_v(int x) { asm volatile("" : "+v"(x)); return x; }
__device__ __forceinline__ int opq_s(int x) { asm volatile("" : "+s"(x)); return x; }

#define IN(k) (lo <= (k) && (k) < hi)
#define SEAM(k) do { if (IN((k) + 1)) { XcdBarrier bar_; bar_.bar = (unsigned*)(WSP() + WS_CTL) + CW_BAR; bar_.x = xb_xcc_id(); bar_.st = (volatile LAS unsigned*)(lds + MISC_OFF) + 8; REP(13) xcd_barrier(bar_, tid); } } while (0)
#define TAIL_SLOT(slot) do { if (G == 256 && bid < TAIL_WGS && l < DEPTH - 1) { unsigned char* ws_ = WSP(); \
        prologue_blocks(lds, (bf16*)(ws_ + WS_W), (l + 1) * PB_LAYER + 2 * 1376 + 2 * 688 + (slot) * TAIL_N, TAIL_N, bid, TAIL_WGS, tid, false); } } while (0)
#define GW (bid * NWAVES + wave)
#define NGW (G * NWAVES)
#define GT (bid * NTHR + tid)
#define NGT (G * NTHR)
#define WSP() launder((unsigned char*)ldp(lds, PT_WS))
#define IDS() const int wave = opq_s(wave0), lane = (int)__builtin_amdgcn_mbcnt_hi(~0u, __builtin_amdgcn_mbcnt_lo(~0u, (unsigned)opq_v(0))), tid = wave * 64 + lane, G = opq_s(G0), bid = opq_s(bid0); (void)lane; (void)wave; (void)G; (void)bid
struct Ctx { LAS unsigned char* lds; int tid0, wave0, G0, bid0, lo, hi; };
#define CTX_LOCALS() LAS unsigned char* lds = c.lds; const int tid0 = c.tid0, wave0 = c.wave0, G0 = c.G0, bid0 = c.bid0, lo = c.lo, hi = c.hi; (void)lds; (void)tid0; (void)wave0; (void)G0; (void)bid0; (void)lo; (void)hi

__device__ __forceinline__ void ff_part(const Ctx c, const int l, const int f) {
    CTX_LOCALS();
    const int pb = 1 + l * PH_PER_LAYER;
    const int fb = pb + (f ? 10 : 0);
    if (IN(fb + 1)) {
        { IDS(); unsigned char* ws = WSP(); const bf16* wl = (const bf16*)(ws + WS_W) + (size_t)l * WE_LAYER;
          pg8::Gemm g{(const bf16*)(ws + WS_XN), wl + (f ? WE_GU2 : WE_GU1), MP, NGU, DM}; pg8::StaticOrder S; S.init(MP, NGU, G, bid, RM(4));
          EpiSwiGLU E{ws, 3 * l + (f ? 2 : 0)};
          pg8::gemm_phase<EpiSwiGLU, pg8::StaticOrder, PROBE_ALIGN_GU, PROBE_SP2, true>(lds + RING_OFF, g, S, E, tid); }
        { IDS(); unsigned char* ws = WSP(); const bf16* wl = (const bf16*)(ws + WS_W) + (size_t)l * WE_LAYER; EpiSwiGLU E{ws, 3 * l + (f ? 2 : 0)};
          for (int su = G - 1 - bid; su < RM(9) * (NGU / 64); su += G) skinny_unit<EpiSwiGLU>(lds + RING_OFF, (const bf16*)(ws + WS_XN), wl + (f ? WE_GU2 : WE_GU1), DM, su % (NGU / 64), E, tid); }
        { IDS(); unsigned char* ws = WSP();
          const int dfirst = (f == 0) ? l * PB_LAYER + 1376 : (l + 1) * PB_LAYER;
          if (G == 256 && bid >= DEFER_WG0 && (f == 0 || l < DEPTH - 1)) prologue_blocks(lds, (bf16*)(ws + WS_W), dfirst, DEFER_N + DEFER_X, bid - DEFER_WG0, DEFER_WGS, tid, false, DEFER_N, (f == 0) ? 688 : 1376);
          { const int slot = 2 * l + f; const int c0 = (int)((long)CACHE_COPY_N * slot / 10), c1 = (slot == 7) ? CACHE_COPY_N : (int)((long)CACHE_COPY_N * (slot + 1) / 10);
            if (G == 256) { if (bid >= DEFER_WG0) cache_copy_range(ldp(lds, 3), ldp(lds, 4), ldp(lds, 5), (float*)ldp(lds, PT_OUT), c0, c1, (bid - DEFER_WG0) * NTHR + tid, DEFER_WGS * NTHR); }
            else cache_copy_range(ldp(lds, 3), ldp(lds, 4), ldp(lds, 5), (float*)ldp(lds, PT_OUT), c0, c1, GT, NGT); } }
        IDS();
        SEAM(fb + 1);
    }
    if (IN(fb + 2)) {
        { IDS(); unsigned char* ws = WSP(); const bf16* wl = (const bf16*)(ws + WS_W) + (size_t)l * WE_LAYER;
          pg8::Gemm g{(const bf16*)(ws + WS_H), wl + (f ? WE_D2 : WE_D1), MP, DM, DFF}; pg8::StaticOrder S; S.init(MP, DM, G, bid, RM(10));
          EpiResid E{ws, lds, 0.5f, (f == 1 && l == DEPTH - 1) ? 1 : 0, (f == 0) ? 3 * l + 1 : (l < DEPTH - 1 ? 3 * l + 3 : -1)};
          pg8::gemm_phase<EpiResid, pg8::StaticOrder, PROBE_ALIGN_RES, PROBE_SP2, true>(lds + RING_OFF, g, S, E, tid); }
        { IDS(); unsigned char* ws = WSP(); const bf16* wl = (const bf16*)(ws + WS_W) + (size_t)l * WE_LAYER; EpiResid E{ws, lds, 0.5f, (f == 1 && l == DEPTH - 1) ? 1 : 0, (f == 0) ? 3 * l + 1 : (l < DEPTH - 1 ? 3 * l + 3 : -1)};
          for (int su = G - 1 - bid; su < DM / 64; su += G) skinny_unit<EpiResid>(lds + RING_OFF, (const bf16*)(ws + WS_H), wl + (f ? WE_D2 : WE_D1), DFF, su, E, tid); }
        { IDS(); TAIL_SLOT(f ? 3 : 0); }
        IDS();
        SEAM(fb + 2);
    }
}

__device__ __forceinline__ void mixer_part(const Ctx c, const int l) {
    CTX_LOCALS();
    const int pb = 1 + l * PH_PER_LAYER;
    if (IN(pb + 4)) {
        { IDS(); unsigned char* ws = WSP(); const bf16* wl = (const bf16*)(ws + WS_W) + (size_t)l * WE_LAYER;
          pg8::Gemm g{(const bf16*)(ws + WS_XN), wl + WE_IN, MP, NWIN, DM}; pg8::StaticOrder S; S.init(MP, NWIN, G, bid, RM(3));
          EpiWin E{ws, ldp(lds, 15) + (size_t)l * 768, ldp(lds, 16) + (size_t)l * 768, ldp(lds, 18) + (size_t)l * 256, (float*)ldp(lds, PT_OUT), l, 3 * l + 1};
          pg8::gemm_phase<EpiWin, pg8::StaticOrder, PROBE_ALIGN_WIN, PROBE_SP2, true>(lds + RING_OFF, g, S, E, tid); }
        { IDS(); unsigned char* ws = WSP(); const bf16* wl = (const bf16*)(ws + WS_W) + (size_t)l * WE_LAYER;
          EpiWin E{ws, ldp(lds, 15) + (size_t)l * 768, ldp(lds, 16) + (size_t)l * 768, ldp(lds, 18) + (size_t)l * 256, (float*)ldp(lds, PT_OUT), l, 3 * l + 1};
          for (int su = G - 1 - bid; su < RM(9) * (NWIN / 64); su += G) skinny_unit<EpiWin>(lds + RING_OFF, (const bf16*)(ws + WS_XN), wl + WE_IN, DM, su % (NWIN / 64), E, tid); }
        IDS();
        SEAM(pb + 4);
    }
    if (IN(pb + 5)) {
        IDS();
        { unsigned char* ws = WSP();
          for (int u = bid; u < RM(1) * ATT_UNITS; u += G) attn_unit(lds, (const bf16*)(ws + WS_Q), (const bf16*)(ws + WS_K), (const bf16*)(ws + WS_V), (float*)(ws + WS_AO), (float*)(ws + WS_LSE), u % ATT_UNITS, tid); }
        { unsigned char* ws = WSP();
          for (int u2 = bid; u2 < RM(5) * (GLA_UNITS / 2); u2 += G) gla_ds_unit(lds + (tid >> 8) * GLA_HALF, (const bf16*)(ws + WS_GK), (const bf16*)(ws + WS_GV), (const float*)(ws + WS_LA), (float*)(ws + WS_DS), (float*)(ws + WS_DEC), 2 * (u2 % (GLA_UNITS / 2)) + (tid >> 8), tid & 255); }
        { unsigned char* ws = WSP();
          conv_pool_pass((const bf16*)(ws + WS_CB), (const bf16*)(ws + WS_U), (const bf16*)(ws + WS_PIN), ldp(lds, 14), ldp(lds, 2), ldp(lds, 7), (bf16*)(ws + WS_YCAT), (bf16*)(ws + WS_YCAT), l, GT, NGT, RM(6)); }
        REP(8) { const int su = (NGW - 1 - GW);
          if (su < NB_S * TS * 12) { unsigned char* ws = WSP(); attn_sample_wave((const bf16*)(ws + WS_Q), (const bf16*)(ws + WS_K), (const bf16*)(ws + WS_V), ldp(lds, 3), ldp(lds, 4), ldp(lds, 5), (float*)(ws + WS_AO), (float*)(ws + WS_LSE), l, su, lane); } }
        REP(8) { unsigned char* ws = WSP();
          for (int u = bid - 64; u >= 0 && u < NB_S * 4; u += G) gla_sample_unit((LAS float*)lds, (const bf16*)(ws + WS_GQ), (const bf16*)(ws + WS_GK), (const bf16*)(ws + WS_GV), (const bf16*)(ws + WS_GR), (const float*)(ws + WS_LA), ldp(lds, 6), ldp(lds, 19) + (size_t)l * 128, (bf16*)(ws + WS_YCAT), (float*)ldp(lds, PT_OUT), l, u, tid); }
        SEAM(pb + 5);
    }
    if (IN(pb + 6)) {
        IDS(); unsigned char* ws = WSP();
        gla_scan_pass((const float*)(ws + WS_DS), (const float*)(ws + WS_DEC), (bf16*)(ws + WS_SP), (float*)ldp(lds, PT_OUT), l, GT, RM(7));
        attn_merge_pass((const float*)(ws + WS_AO), (const float*)(ws + WS_LSE), (bf16*)(ws + WS_YCAT), GT, NGT, RM(7));
        SEAM(pb + 6);
    }
    if (IN(pb + 7)) {
        IDS(); unsigned char* ws = WSP();
        for (int u2 = bid; u2 < RM(5) * (GLA_UNITS / 2); u2 += G) gla_out_unit(lds + (tid >> 8) * GLA_HALF, (const bf16*)(ws + WS_GQ), (const bf16*)(ws + WS_GK), (const bf16*)(ws + WS_GV), (const bf16*)(ws + WS_GR), (const float*)(ws + WS_LA), (const bf16*)(ws + WS_SP), ldp(lds, 19) + (size_t)l * 128, (bf16*)(ws + WS_YCAT), 2 * (u2 % (GLA_UNITS / 2)) + (tid >> 8), tid & 255);
        SEAM(pb + 7);
    }
    if (IN(pb + 8)) {
        REP(11) {
        { IDS(); unsigned char* ws = WSP(); const bf16* wl = (const bf16*)(ws + WS_W) + (size_t)l * WE_LAYER; pg8::StaticOrder S; S.init(MP, DM, G, bid);
          pg8::Gemm g{(const bf16*)(ws + WS_YCAT), wl + WE_UPCAT, MP, DM, YK}; EpiMergeCat E{ws};
          pg8::gemm_phase<EpiMergeCat, pg8::StaticOrder, true, PROBE_SP2>(lds + RING_OFF, g, S, E, tid); }
        { IDS(); unsigned char* ws = WSP(); const bf16* wl = (const bf16*)(ws + WS_W) + (size_t)l * WE_LAYER; const bf16* yc = (const bf16*)(ws + WS_YCAT); const bf16* uc = wl + WE_UPCAT;
          for (int su = G - 1 - bid; su < DM / 64; su += G) skinny_merge_unit(lds + RING_OFF, ws, yc, uc, su, tid); }
        { IDS(); TAIL_SLOT(1); }
        }
        IDS();
        SEAM(pb + 8);
    }
    if (IN(pb + 9)) {
        { IDS(); unsigned char* ws = WSP(); const bf16* wl = (const bf16*)(ws + WS_W) + (size_t)l * WE_LAYER;
          pg8::Gemm g{(const bf16*)(ws + WS_MRG), wl + WE_OUT, MP, DM, DM}; pg8::StaticOrder S; S.init(MP, DM, G, bid, RM(12));
          EpiResid E{ws, lds, 1.0f, 0, 3 * l + 2};
#if (PROBE_DUP >> 14) & 1
          { pg8::Gemm g0{(const bf16*)(ws + WS_MRG), wl + WE_OUT, MP, DM, 256}; EpiResid E0{ws, lds, 0.0f, 0, -1};
            pg8::gemm_phase<EpiResid, pg8::StaticOrder, PROBE_ALIGN_RES, PROBE_SP2>(lds + RING_OFF, g0, S, E0, tid); }
#endif
          pg8::gemm_phase<EpiResid, pg8::StaticOrder, PROBE_ALIGN_RES, PROBE_SP2, true>(lds + RING_OFF, g, S, E, tid); }
        { IDS(); unsigned char* ws = WSP(); const bf16* wl = (const bf16*)(ws + WS_W) + (size_t)l * WE_LAYER; EpiResid E{ws, lds, 1.0f, 0, 3 * l + 2};
          for (int su = G - 1 - bid; su < DM / 64; su += G) skinny_unit<EpiResid>(lds + RING_OFF, (const bf16*)(ws + WS_MRG), wl + WE_OUT, DM, su, E, tid); }
        { IDS(); TAIL_SLOT(2); }
        IDS();
        SEAM(pb + 9);
    }
}

__global__ void __launch_bounds__(NTHR, 2) fwd_kernel(Args args) {
    extern __shared__ __attribute__((aligned(16))) unsigned char lds_raw[];
    LAS unsigned char* lds = (LAS unsigned char*)lds_raw;
    const int tid0 = threadIdx.x; const int wave0 = __builtin_amdgcn_readfirstlane(tid0 >> 6);
    const int G0 = gridDim.x, bid0 = blockIdx.x;
    { const int tid = tid0; for (int u = tid; u < (LDS_BYTES - LDSCTL_OFF) / 4; u += NTHR) ((LAS unsigned*)(lds + LDSCTL_OFF))[u] = 0u; }
    __syncthreads();
    if (tid0 == 0) {
        LAS unsigned long long* pt = (LAS unsigned long long*)(lds + PT_OFF);
#pragma unroll
        for (int i = 0; i < 31; ++i) pt[i] = (unsigned long long)args.in[i];
        pt[PT_OUT] = (unsigned long long)args.out; pt[PT_WS] = (unsigned long long)args.ws;
    }
    __syncthreads();
    if (!MK_PER_PHASE) (void)xcd_barrier_post((unsigned*)(args.ws + WS_CTL) + CW_BAR, (volatile LAS unsigned*)(lds + MISC_OFF) + 8);
    const int lo = args.ph_lo, hi = args.ph_hi;

    if (IN(0)) {
        IDS(); unsigned char* ws = WSP(); float* out = (float*)ldp(lds, PT_OUT);
        REP(0) { prologue_blocks(lds, (bf16*)(ws + WS_W), 0, DEPTH * PB_LAYER, bid, G, tid, G == 256); prologue_specials(lds, (bf16*)(ws + WS_W), G - 1 - bid, G, tid); }
#if (PROBE_DUP >> 18) & 1
        prologue_specials(lds, (bf16*)(ws + WS_W), G - 1 - bid, G, tid);
#endif
#if (PROBE_DUP >> 16) & 1
        prologue_blocks<1>(lds, (bf16*)(ws + WS_W), 0, DEPTH * PB_LAYER, bid, G, tid, G == 256);
#endif
#if (PROBE_DUP >> 17) & 1
        prologue_blocks<2>(lds, (bf16*)(ws + WS_W), 0, DEPTH * PB_LAYER, bid, G, tid, G == 256);
#endif
        x_init_pass(ldp(lds, 0), ldp(lds, 1), (bf16*)(ws + WS_XN), (unsigned long long*)(ws + WS_CTL + CTL_SS), GW, NGW, lane);
        { const f32x4* src = (const f32x4*)ldp(lds, 7); f32x4* dst = (f32x4*)(out + OFF_POOL_S); const int per = 11 * 128;
          for (int i = GT; i < DEPTH * NB_S * per; i += NGT) { const int lb = i / per, j = i - lb * per; dst[(size_t)lb * 15 * 128 + j] = src[(size_t)lb * 15 * 128 + 4 * 128 + j]; } }
        SEAM(0);
    }

    { Ctx c; c.lds = lds; c.tid0 = tid0; c.wave0 = wave0; c.G0 = G0; c.bid0 = bid0; c.lo = lo; c.hi = hi;
#if MK_UNROLL_LAYERS
      ff_part(c, 0, 0); mixer_part(c, 0); ff_part(c, 0, 1); ff_part(c, 1, 0); mixer_part(c, 1); ff_part(c, 1, 1);
      ff_part(c, 2, 0); mixer_part(c, 2); ff_part(c, 2, 1); ff_part(c, 3, 0); mixer_part(c, 3); ff_part(c, 3, 1);
#else
      _Pragma("unroll 1") for (int l = 0; l < DEPTH; ++l) {
          _Pragma("unroll 1") for (int f = 0; f < 2; ++f) { ff_part(c, l, f); if (f == 0) mixer_part(c, l); }
      }
#endif
    }
#undef IN
#undef SEAM
}

extern "C" void kernel_launch(void* const* d_in, const int* in_sizes, int n_in, void* d_out, int out_size, void* d_ws, size_t ws_size, hipStream_t stream) {
    static int grid = 0;
    if (grid == 0) {
        if (n_in != 31 || out_size != OUT_TOTAL || ws_size < WS_END) { fprintf(stderr, "kernel_launch: expected 31 inputs, %d outputs, >= %zu bytes ws; got %d, %d, %zu\n", OUT_TOTAL, (size_t)WS_END, n_in, out_size, ws_size); grid = -1; return; }
        int dev = 0, cus = 0, per_cu = 0;
        if (hipGetDevice(&dev) != hipSuccess || hipDeviceGetAttribute(&cus, hipDeviceAttributeMultiprocessorCount, dev) != hipSuccess) { grid = -1; return; }
        if (hipFuncSetAttribute((const void*)fwd_kernel, hipFuncAttributeMaxDynamicSharedMemorySize, LDS_BYTES) != hipSuccess) { fprintf(stderr, "kernel_launch: hipFuncSetAttribute failed\n"); grid = -1; return; }
        if (hipOccupancyMaxActiveBlocksPerMultiprocessor(&per_cu, (const void*)fwd_kernel, NTHR, LDS_BYTES) != hipSuccess || per_cu < 1) fprintf(stderr, "kernel_launch: occupancy query says %d\n", per_cu);
        (void)hipGetLastError();
        grid = cus;
    }
    if (grid < 0) return;
    if (hipMemsetAsync((char*)d_ws + WS_CTL, 0, CTL_ZERO_BYTES, stream) != hipSuccess) return;
    Args a; memset(&a, 0, sizeof(a));
    for (int i = 0; i < 31; ++i) a.in[i] = (const float*)d_in[i];
    a.out = (float*)d_out; a.ws = (unsigned char*)d_ws;
#if MK_PER_PHASE
    for (int ph = 0; ph < NPH; ++ph) { a.ph_lo = ph; a.ph_hi = ph + 1; hipLaunchKernelGGL(fwd_kernel, dim3(grid), dim3(NTHR), LDS_BYTES, stream, a); }
#else
    a.ph_lo = 0; a.ph_hi = NPH;
    hipLaunchKernelGGL(fwd_kernel, dim3(grid), dim3(NTHR), LDS_BYTES, stream, a);
#endif
    const hipError_t le = hipPeekAtLastError();
    if (le != hipSuccess) fprintf(stderr, "kernel_launch: launch failed: %s\n", hipGetErrorName(le));
}
```

```cpp
#include <hip/hip_runtime.h>
#include <cstdio>
#include <cstdint>
#include <cstring>
#ifndef PROBE_DUP
#define PROBE_DUP 0
#endif
namespace pg8 {
#define PG8_LAS __attribute__((address_space(3)))
typedef unsigned short bf16_t;
typedef short bf16x8 __attribute__((ext_vector_type(8)));
typedef float f32x4 __attribute__((ext_vector_type(4)));
typedef unsigned u32x4 __attribute__((ext_vector_type(4)));
constexpr int BM = 256, BK = 64, HALF = 128, HTB = HALF * BK * 2  , STAGE_BYTES = 8 * HTB, NXCD = 8, WGM = 4;

__host__ __device__ __forceinline__ int lds_byte(int r, int c) { const int st = (r >> 4) * 2 + (c >> 5), rr = r & 15, cc = c & 31, ob = rr * 64 + cc * 2; return st * 1024 + (ob ^ (((ob >> 9) & 1) << 5)); }
__host__ __device__ __forceinline__ void stage_rc(int b, int& R, int& C) { const int st = b / 1024, sb = b % 1024, swz = sb ^ (((sb >> 9) & 1) << 5); R = (st >> 1) * 16 + swz / 64; C = (st & 1) * 32 + (swz % 64) / 2; }
__host__ __device__ __forceinline__ int perm32(int rho) { const int n = rho >> 4, i = rho & 15; return 8 * (i >> 2) + 4 * n + (i & 3); }

struct Unit { int pm, pn, ri; };
struct Gemm { const bf16_t* A; const bf16_t* Bt; int M, N, K; };

struct StaticOrder {
    int nM, nN, nwg, G, c, rep;
    __host__ __device__ void init(int M, int N, int G_, int c_, int rep_ = 1) { nM = M / BM; nN = N / BM; nwg = nM * nN; G = G_; c = c_; rep = rep_; }
    __host__ __device__ bool next(int i, Unit& u) const {
        const long L = (long)i * G + c; if (L >= (long)rep * nwg) return false;
        int wgid = (int)(L % nwg);
#if (PROBE_DUP >> 15) & 1
        if (L >= nwg) wgid = 0;
#endif
        { const int q = nwg / NXCD, r = nwg % NXCD, xcd = wgid % NXCD, off = wgid / NXCD; wgid = (xcd < r ? xcd * (q + 1) : r * (q + 1) + (xcd - r) * q) + off; }
        const int nig = WGM * nN, gid = wgid / nig, fm = gid * WGM, gsz = (nM - fm) < WGM ? (nM - fm) : WGM;
        u.pm = fm + ((wgid % nig) % gsz); u.pn = (wgid % nig) / gsz; u.ri = (int)(L / nwg); return true;
    }
    __device__ __forceinline__ void a_ready(const Unit&) const {}
    __device__ __forceinline__ void done(const Unit&) const {}
};

template <class Epi, class Sched, bool ALIGN_EPI = false, bool SP2 = false, bool A_TILED = false>
__device__ __forceinline__ void gemm_phase(PG8_LAS unsigned char* lds, const Gemm g, const Sched S, const Epi E, const int tid) {
    const int wid = __builtin_amdgcn_readfirstlane(tid >> 6), lane = tid & 63, wr = wid >> 2, wc = wid & 3, fr = lane & 15, fq = lane >> 4;
    const int K = g.K, nt = K / BK;
    unsigned voffA[2], voffB[2];
#pragma unroll
    for (int i = 0; i < 2; ++i) { int R, C; stage_rc(tid * 16 + i * 8192, R, C); const int Rb = Epi::PERM ? ((R & ~31) + perm32(R & 31)) : R;
        voffA[i] = A_TILED ? (unsigned)(tid * 16 + i * 8192) : (unsigned)(R * K + C) * 2u; voffB[i] = (unsigned)(tid * 16 + i * 8192); (void)Rb; }
    const size_t kstep = A_TILED ? (size_t)32768 : (size_t)(BK * 2);
    const size_t hstep = A_TILED ? (size_t)16384 : (size_t)HALF * K * 2;
    const size_t tstep = A_TILED ? (size_t)nt * 32768 : 2 * hstep;
    const size_t kstepB = 32768, hstepB = 16384, tstepB = (size_t)nt * 32768;
    const unsigned ldsw = (unsigned)wid * 1024u;
    const int aoff = lds_byte(wr * 64 + fr, fq * 8), boff = lds_byte(wc * 32 + fr, fq * 8);
#define PG8_SA(b, h) (((b) * 2 + (h)) * HTB)
#define PG8_SB(b, h) ((4 + (b) * 2 + (h)) * HTB)
#define PG8_STAGE(bufoff, gbase, voff) do { _Pragma("unroll") for (int _i = 0; _i < 2; ++_i) \
        __builtin_amdgcn_global_load_lds((const unsigned*)((const char*)(gbase) + (voff)[_i]), (PG8_LAS unsigned*)(lds + (bufoff) + ldsw + _i * 8192), 16, 0, 0); } while (0)
#define PG8_LDA(dst, b, h) do { _Pragma("unroll") for (int m = 0; m < 4; ++m) _Pragma("unroll") for (int k = 0; k < 2; ++k) dst[m][k] = *(const PG8_LAS bf16x8*)(lds + PG8_SA(b, h) + aoff + m * 2048 + k * 1024); } while (0)
#define PG8_LDB(dst, b, h) do { _Pragma("unroll") for (int n = 0; n < 2; ++n) _Pragma("unroll") for (int k = 0; k < 2; ++k) dst[n][k] = *(const PG8_LAS bf16x8*)(lds + PG8_SB(b, h) + boff + n * 2048 + k * 1024); } while (0)
#define PG8_MMA(ai, bj, At, Bt) do { __builtin_amdgcn_s_setprio(1); _Pragma("unroll") for (int m = 0; m < 4; ++m) _Pragma("unroll") for (int n = 0; n < 2; ++n) _Pragma("unroll") for (int k = 0; k < 2; ++k) \
        acc[ai][bj][m][n] = __builtin_amdgcn_mfma_f32_16x16x32_bf16(Bt[n][k], At[m][k], acc[ai][bj][m][n], 0, 0, 0); __builtin_amdgcn_s_setprio(0); } while (0)
#define PG8_WAIT_V(n) asm volatile("s_waitcnt vmcnt(" #n ")" ::: "memory")
#define PG8_WAIT_L(n) asm volatile("s_waitcnt lgkmcnt(" #n ")" ::: "memory")
#define PG8_BAR __builtin_amdgcn_s_barrier()
#define PG8_SCHED __builtin_amdgcn_sched_barrier(0)
    Unit cur, nxt; int ui = 0;
    if (!S.next(0, cur)) return;
    f32x4 acc[2][2][4][2];
#pragma unroll
    for (int a = 0; a < 2; ++a)
#pragma unroll
        for (int b = 0; b < 2; ++b)
#pragma unroll
            for (int m = 0; m < 4; ++m)
#pragma unroll
                for (int n = 0; n < 2; ++n) acc[a][b][m][n] = (f32x4){0.f, 0.f, 0.f, 0.f};
    bf16x8 At[4][2], B0[2][2], B1[2][2];
    const char* cA = (const char*)g.A + (size_t)cur.pm * tstep; const char* cB = (const char*)g.Bt + (size_t)cur.pn * tstepB;
    S.a_ready(cur);
    if constexpr (SP2) {
        PG8_STAGE(PG8_SB(0, 0), cB, voffB); PG8_STAGE(PG8_SB(0, 1), cB + hstepB, voffB); PG8_STAGE(PG8_SA(0, 0), cA, voffA); PG8_STAGE(PG8_SA(0, 1), cA + hstep, voffA);
        if (wr == 1) PG8_BAR;
        PG8_WAIT_V(2); PG8_BAR;
        PG8_STAGE(PG8_SB(1, 0), cB + kstepB, voffB); PG8_STAGE(PG8_SA(1, 0), cA + kstep, voffA); PG8_STAGE(PG8_SB(1, 1), cB + hstepB + kstepB, voffB);
        PG8_WAIT_V(6); PG8_BAR;
    } else {
        PG8_STAGE(PG8_SB(0, 0), cB, voffB); PG8_STAGE(PG8_SA(0, 0), cA, voffA); PG8_STAGE(PG8_SB(0, 1), cB + hstepB, voffB); PG8_STAGE(PG8_SA(0, 1), cA + hstep, voffA);
        if (wr == 1) PG8_BAR;
        PG8_WAIT_V(4); PG8_BAR;
        PG8_STAGE(PG8_SB(1, 0), cB + kstepB, voffB); PG8_STAGE(PG8_SA(1, 0), cA + kstep, voffA); PG8_STAGE(PG8_SB(1, 1), cB + hstepB + kstepB, voffB);
        PG8_WAIT_V(6); PG8_BAR;
    }
    for (;;) {
        const bool has_next = S.next(ui + 1, nxt);
        const char* nA = has_next ? (const char*)g.A + (size_t)nxt.pm * tstep : cA; const char* nB = has_next ? (const char*)g.Bt + (size_t)nxt.pn * tstepB : cB;
        for (int t = 0; t < nt; t += 2) {
            const bool last = (t == nt - 2);
            const char* a1 = cA + (size_t)(t + 1) * kstep;
            const char* a2 = last ? nA : cA + (size_t)(t + 2) * kstep; const char* b2 = last ? nB : cB + (size_t)(t + 2) * kstepB;
            const char* a3 = a2 + kstep; const char* b3 = b2 + kstepB;
            if (last && has_next) S.a_ready(nxt);
            if constexpr (Epi::HAS_MID) { if (t == 8 || t == 12 || t == 20) E.mid(acc, cur, t, wr, wc, fr, fq); }
            if constexpr (SP2) {
            PG8_LDB(B0, 0, 0); PG8_LDB(B1, 0, 1); PG8_SCHED; PG8_LDA(At, 0, 0); PG8_STAGE(PG8_SA(1, 1), a1 + hstep, voffA);
            PG8_WAIT_V(8); PG8_WAIT_L(0); PG8_BAR; PG8_MMA(0, 0, At, B0); PG8_MMA(0, 1, At, B1); PG8_BAR; PG8_SCHED;
            PG8_LDA(At, 0, 1); PG8_STAGE(PG8_SB(0, 0), b2, voffB); PG8_STAGE(PG8_SB(0, 1), b2 + hstepB, voffB); PG8_STAGE(PG8_SA(0, 0), a2, voffA);
            PG8_WAIT_V(8); PG8_WAIT_L(0); PG8_BAR; PG8_MMA(1, 0, At, B0); PG8_MMA(1, 1, At, B1); PG8_BAR; PG8_SCHED;
            PG8_LDB(B0, 1, 0); PG8_LDB(B1, 1, 1); PG8_SCHED; PG8_LDA(At, 1, 0); PG8_STAGE(PG8_SA(0, 1), a2 + hstep, voffA);
            PG8_WAIT_V(8); PG8_WAIT_L(0); PG8_BAR; PG8_MMA(0, 0, At, B0); PG8_MMA(0, 1, At, B1); PG8_BAR; PG8_SCHED;
            PG8_LDA(At, 1, 1); PG8_STAGE(PG8_SB(1, 0), b3, voffB); PG8_STAGE(PG8_SB(1, 1), b3 + hstepB, voffB); PG8_STAGE(PG8_SA(1, 0), a3, voffA);
            PG8_WAIT_V(8); PG8_WAIT_L(0); PG8_BAR; PG8_MMA(1, 0, At, B0); PG8_MMA(1, 1, At, B1); PG8_BAR; PG8_SCHED;
            } else {
            PG8_LDB(B0, 0, 0); PG8_SCHED; PG8_LDA(At, 0, 0); PG8_STAGE(PG8_SA(1, 1), a1 + hstep, voffA);
            PG8_WAIT_L(8); PG8_BAR; PG8_WAIT_L(0); PG8_MMA(0, 0, At, B0); PG8_BAR; PG8_SCHED;
            PG8_LDB(B1, 0, 1); PG8_STAGE(PG8_SB(0, 0), b2, voffB);
            PG8_BAR; PG8_WAIT_L(0); PG8_MMA(0, 1, At, B1); PG8_BAR;
            PG8_LDA(At, 0, 1); PG8_STAGE(PG8_SA(0, 0), a2, voffA);
            PG8_BAR; PG8_WAIT_L(0); PG8_MMA(1, 0, At, B0); PG8_BAR; PG8_SCHED;
            PG8_STAGE(PG8_SB(0, 1), b2 + hstepB, voffB);
            PG8_WAIT_V(6); PG8_BAR; PG8_MMA(1, 1, At, B1); PG8_BAR;
            PG8_LDB(B0, 1, 0); PG8_SCHED; PG8_LDA(At, 1, 0); PG8_STAGE(PG8_SA(0, 1), a2 + hstep, voffA);
            PG8_WAIT_L(8); PG8_BAR; PG8_WAIT_L(0); PG8_MMA(0, 0, At, B0); PG8_BAR; PG8_SCHED;
            PG8_LDB(B1, 1, 1); PG8_STAGE(PG8_SB(1, 0), b3, voffB);
            PG8_BAR; PG8_WAIT_L(0); PG8_MMA(0, 1, At, B1); PG8_BAR;
            PG8_LDA(At, 1, 1); PG8_STAGE(PG8_SA(1, 0), a3, voffA);
            PG8_BAR; PG8_WAIT_L(0); PG8_MMA(1, 0, At, B0); PG8_BAR; PG8_SCHED;
            PG8_STAGE(PG8_SB(1, 1), b3 + hstepB, voffB);
            PG8_WAIT_V(6); PG8_BAR; PG8_MMA(1, 1, At, B1); PG8_BAR;
            }
        }
        if constexpr (ALIGN_EPI) { if (wr == 0) PG8_BAR; }
        if constexpr (!Epi::AFTER_DRAIN) { E(acc, cur, wr, wc, fr, fq); S.done(cur); }
        if (!has_next) break;
#pragma unroll
        for (int a = 0; a < 2; ++a)
#pragma unroll
            for (int b = 0; b < 2; ++b)
#pragma unroll
                for (int m = 0; m < 4; ++m)
#pragma unroll
                    for (int n = 0; n < 2; ++n) acc[a][b][m][n] = (f32x4){0.f, 0.f, 0.f, 0.f};
        cur = nxt; cA = nA; cB = nB; ++ui;
        if constexpr (ALIGN_EPI) { if (wr == 1) PG8_BAR; }
    }
    PG8_WAIT_V(0);
    if constexpr (!ALIGN_EPI) { if (wr == 0) PG8_BAR; }
    PG8_BAR;
    if constexpr (Epi::AFTER_DRAIN) { E.fused(acc, cur, wr, wc, fr, fq, lds, wid, lane); S.done(cur); }
#undef PG8_SA
#undef PG8_SB
#undef PG8_STAGE
#undef PG8_LDA
#undef PG8_LDB
#undef PG8_MMA
#undef PG8_WAIT_V
#undef PG8_WAIT_L
#undef PG8_BAR
#undef PG8_SCHED
}
}

constexpr int DM = 2048, DFF = 5504, DEPTH = 4;
constexpr int SEQ = 4096, NB_P = 2, MP = NB_P * SEQ;
constexpr int NB_S = 8, TS = 4, MS = NB_S * TS;
constexpr int MR = MP + MS;
constexpr int MPAD = 8448;
constexpr int PAST = 16384;
constexpr int N_IN = 14096, NWIN = 14336;
constexpr int NGU = 2 * DFF;
constexpr float EPS = 1e-6f;
constexpr int NWAVES = 8, NTHR = 512;

constexpr int C_CB = 0, C_CC = 512, C_CH = 1024, C_AQ = 1536, C_AK = 2304, C_AV = 3072, C_GQ = 3840, C_GK = 4096, C_GV = 4352, C_GR = 4864, C_LR = 5376, C_PIN = 5392, C_GATE = 5904;
constexpr int T_CONV = 0, T_CB = 4, T_Q = 6, T_K = 9, T_V = 12, T_GQ = 15, T_GK = 16, T_GV = 17, T_GR = 19, T_Z = 21, T_PIN = 22, T_GATE = 24;

constexpr int OFF_YP = 0;
constexpr int OFF_YS = OFF_YP + MP * DM;
constexpr int OFF_CONV_P = OFF_YS + MS * DM;
constexpr int OFF_CONV_S = OFF_CONV_P + DEPTH * NB_P * 2 * 512;
constexpr int OFF_W128_P = OFF_CONV_S + DEPTH * NB_S * 2 * 512;
constexpr int OFF_W128_S = OFF_W128_P + DEPTH * NB_P * 128 * 512;
constexpr int OFF_W512_P = OFF_W128_S + DEPTH * NB_S * 128 * 512;
constexpr int OFF_W512_S = OFF_W512_P + DEPTH * NB_P * 512 * 512;
constexpr int OFF_W2048_P = OFF_W512_S + DEPTH * NB_S * 512 * 512;
constexpr int OFF_W2048_S = OFF_W2048_P + DEPTH * NB_P * 2048 * 512;
constexpr int OFF_GLA_P = OFF_W2048_S + DEPTH * NB_S * 2048 * 512;
constexpr int OFF_GLA_S = OFF_GLA_P + DEPTH * NB_P * 4 * 64 * 128;
constexpr int OFF_POOL_P = OFF_GLA_S + DEPTH * NB_S * 4 * 64 * 128;
constexpr int OFF_POOL_S = OFF_POOL_P + DEPTH * NB_P * 15 * 512;
constexpr int OUT_TOTAL = OFF_POOL_S + DEPTH * NB_S * 15 * 512;
static_assert(OUT_TOTAL == 73551872, "output size");

constexpr size_t MiB = 1u << 20;
constexpr size_t WS_CTL = 0, CTL_ZERO_BYTES = 1 * MiB;
constexpr size_t SZ_ROW2K_F32 = (size_t)MPAD * DM * 4, SZ_ROW2K_BF = (size_t)MPAD * DM * 2;
constexpr size_t WS_X = WS_CTL + CTL_ZERO_BYTES;
constexpr size_t WS_XN = WS_X + SZ_ROW2K_F32;
constexpr size_t WS_H = WS_XN + SZ_ROW2K_BF;
constexpr size_t WS_CB = WS_H + (size_t)MPAD * DFF * 2;
constexpr size_t WS_U = WS_CB + (size_t)MPAD * 512 * 2;
constexpr size_t WS_Q = WS_U + (size_t)MPAD * 512 * 2;
constexpr size_t WS_K = WS_Q + (size_t)MPAD * 768 * 2;
constexpr size_t WS_V = WS_K + (size_t)MPAD * 768 * 2;
constexpr size_t WS_GQ = WS_V + (size_t)MPAD * 768 * 2;
constexpr size_t WS_GK = WS_GQ + (size_t)MPAD * 256 * 2;
constexpr size_t WS_GV = WS_GK + (size_t)MPAD * 256 * 2;
constexpr size_t WS_GR = WS_GV + (size_t)MPAD * 512 * 2;
constexpr size_t WS_LA = WS_GR + (size_t)MPAD * 512 * 2;
constexpr size_t WS_PIN = WS_LA + (size_t)MPAD * 256 * 4;
constexpr size_t WS_GATE = WS_PIN + (size_t)MPAD * 512 * 2;
constexpr int YK = 1792, YO_A = 0, YO_B = 512, YO_C = 768, YO_D = 1280;
constexpr size_t WS_YCAT = WS_GATE + (size_t)MPAD * 8192 * 2;
constexpr size_t WS_AO = WS_YCAT + (size_t)MPAD * YK * 2;
constexpr size_t WS_LSE = WS_AO + (size_t)MPAD * 768 * 4;
constexpr size_t WS_DS = WS_LSE + (size_t)MPAD * 12 * 4;
constexpr size_t WS_DEC = WS_DS + (size_t)8 * 64 * 64 * 128 * 4;
constexpr size_t WS_SP = WS_DEC + (size_t)8 * 64 * 64 * 4;
constexpr size_t WS_PM = WS_SP + (size_t)8 * 64 * 64 * 128 * 2;
constexpr size_t WS_MRG = WS_PM + (size_t)(MPAD - MP) * DM * 4;
constexpr size_t WS_W = WS_MRG + SZ_ROW2K_BF;
constexpr size_t WE_GU1 = 0;
constexpr size_t WE_D1 = WE_GU1 + (size_t)NGU * DM;
constexpr size_t WE_IN = WE_D1 + (size_t)DM * DFF;
constexpr size_t WE_UPCAT = WE_IN + (size_t)NWIN * DM;
constexpr size_t WE_OUT = WE_UPCAT + (size_t)DM * YK;
constexpr size_t WE_GU2 = WE_OUT + (size_t)DM * DM;
constexpr size_t WE_D2 = WE_GU2 + (size_t)NGU * DM;
constexpr size_t WE_LAYER = WE_D2 + (size_t)DM * DFF;
static_assert(WE_LAYER == 104857600, "layer weights");
constexpr size_t WS_END = WS_W + (size_t)DEPTH * WE_LAYER * 2;
static_assert(WS_X % 256 == 0 && WS_W % 256 == 0 && WS_LSE % 256 == 0 && WS_DS % 256 == 0, "alignment");

constexpr int CW_BAR = 4096;
constexpr size_t CTL_SS = 65536;
constexpr float SS_FIX = 16777216.0f;
static_assert(CTL_SS + 12 * (size_t)MPAD * 8 <= CTL_ZERO_BYTES, "SS fits the zeroed control region");

constexpr int RING_OFF = 0, RING_BYTES = 131072;
constexpr int LDSCTL_OFF = RING_BYTES, MISC_OFF = LDSCTL_OFF + 320;
constexpr int LDS_BYTES = 147456;

#define GAS __attribute__((address_space(1)))
#define LAS __attribute__((address_space(3)))
#define GAS __attribute__((address_space(1)))
typedef unsigned short bf16;
typedef unsigned u32x4 __attribute__((ext_vector_type(4)));
typedef unsigned u32x2 __attribute__((ext_vector_type(2)));
typedef float f32x4 __attribute__((ext_vector_type(4)));
typedef float f32x2 __attribute__((ext_vector_type(2)));
typedef short bf16x8 __attribute__((ext_vector_type(8)));
typedef short s16x4 __attribute__((ext_vector_type(4)));
#define LDS_WAIT() asm volatile("s_waitcnt lgkmcnt(0)" ::: "memory")
#define VM_WAIT() asm volatile("s_waitcnt vmcnt(0)" ::: "memory")
__device__ __forceinline__ unsigned f2bf(float f) { unsigned u = __builtin_bit_cast(unsigned, f); return (u + 0x7fffu + ((u >> 16) & 1u)) >> 16; }
__device__ __forceinline__ unsigned pk2(float lo, float hi) { return f2bf(lo) | (f2bf(hi) << 16); }
__device__ __forceinline__ float bflo(unsigned w) { return __builtin_bit_cast(float, w << 16); }
__device__ __forceinline__ float bfhi(unsigned w) { return __builtin_bit_cast(float, w & 0xffff0000u); }
__device__ __forceinline__ float bf2f(bf16 b) { return __builtin_bit_cast(float, ((unsigned)b) << 16); }
__device__ __forceinline__ u32x4 pk8(f32x4 a, f32x4 b) { u32x4 w; w.x = pk2(a[0], a[1]); w.y = pk2(a[2], a[3]); w.z = pk2(b[0], b[1]); w.w = pk2(b[2], b[3]); return w; }
__device__ __forceinline__ void unpk8(u32x4 w, float (&f)[8]) { f[0] = bflo(w.x); f[1] = bfhi(w.x); f[2] = bflo(w.y); f[3] = bfhi(w.y); f[4] = bflo(w.z); f[5] = bfhi(w.z); f[6] = bflo(w.w); f[7] = bfhi(w.w); }
__device__ __forceinline__ float sigmoidf_(float x) { return __builtin_amdgcn_rcpf(1.0f + __expf(-x)); }
__device__ __forceinline__ float siluf_(float x) { return x * sigmoidf_(x); }
__device__ __forceinline__ float shx(float v, int m, int lane) { return __builtin_bit_cast(float, __builtin_amdgcn_ds_bpermute((lane ^ m) << 2, __builtin_bit_cast(int, v))); }
__device__ __forceinline__ float rdl(float v, int j) { return __builtin_bit_cast(float, __builtin_amdgcn_readlane(__builtin_bit_cast(int, v), j)); }
__device__ __forceinline__ float wave_sum(float v, int lane) {
#pragma unroll
    for (int o = 1; o < 64; o <<= 1) v += shx(v, o, lane);
    return v;
}
__device__ __forceinline__ float wave_max(float v, int lane) {
#pragma unroll
    for (int o = 1; o < 64; o <<= 1) v = fmaxf(v, shx(v, o, lane));
    return v;
}
__device__ __forceinline__ int win_of(int gi) { return 128 << (2 * gi); }
__device__ __forceinline__ int dil_of(int gi) { return 1 << (2 * gi); }
__device__ __forceinline__ int offw_p(int gi) { return gi == 0 ? OFF_W128_P : (gi == 1 ? OFF_W512_P : OFF_W2048_P); }
__device__ __forceinline__ int offw_s(int gi) { return gi == 0 ? OFF_W128_S : (gi == 1 ? OFF_W512_S : OFF_W2048_S); }

#define XB_TMO      128
#define XB_XCNT(j)  (256  + 64 * (j))
#define XB_XSUB(j)  (1280 + 64 * (j))
#define XB_XGEN(j)  (2304 + 64 * (j))
#define XB_TOP      3328
#define XB_TOPGEN   3392
#define XCD_BAR_WORDS 3456
#define XB_SPIN_CAP (1u << 18)

__device__ __forceinline__ unsigned xb_ld(unsigned* p)              { return __hip_atomic_load(p, __ATOMIC_RELAXED, __HIP_MEMORY_SCOPE_AGENT); }
__device__ __forceinline__ unsigned xb_add(unsigned* p, unsigned v) { return __hip_atomic_fetch_add(p, v, __ATOMIC_RELAXED, __HIP_MEMORY_SCOPE_AGENT); }
__device__ __forceinline__ unsigned xb_xcc_id() { return (unsigned)__builtin_amdgcn_s_getreg((3 << 11) | 20) & 0xFu; }
#define XB_SPIN(cond, bar) do { unsigned _sp = 0; while (cond) { __builtin_amdgcn_s_sleep(1); \
    if ((++_sp & 255u) == 0u) { if (xb_ld(&(bar)[XB_TMO])) break; if (_sp > XB_SPIN_CAP) { atomicAdd(&(bar)[XB_TMO], 1u); break; } } } } while (0)

struct XcdBarrier {
    unsigned* bar; unsigned x;
    volatile LAS unsigned* st;
};
__device__ __forceinline__ XcdBarrier xcd_barrier_post(unsigned* bar, volatile LAS unsigned* st) {
    XcdBarrier b; b.bar = bar; b.x = xb_xcc_id(); b.st = st;
    if (threadIdx.x == 0) (void)xb_add(&bar[XB_XCNT(b.x)], 1u);
    return b;
}
__device__ __forceinline__ void xcd_barrier_complete(unsigned* bar, unsigned x, unsigned& nloc, unsigned& nx) {
    const unsigned G = gridDim.x * gridDim.y * gridDim.z;
    unsigned sum, cnt, mine, sp = 0u;
    for (;;) {
        sum = 0u; cnt = 0u; mine = 0u;
#pragma unroll
        for (unsigned j = 0; j < 16; ++j) { const unsigned c = xb_ld(&bar[XB_XCNT(j)]); sum += c; cnt += (c > 0u) ? 1u : 0u; mine = (j == x) ? c : mine; }
        if (sum == G) break;
        __builtin_amdgcn_s_sleep(1);
        if ((++sp & 255u) == 0u) { if (xb_ld(&bar[XB_TMO])) break; if (sp > XB_SPIN_CAP) { atomicAdd(&bar[XB_TMO], 1u); break; } }
    }
    nloc = mine > 0u ? mine : 1u; nx = cnt > 0u ? cnt : 1u;
}
__device__ __forceinline__ void xcd_barrier(const XcdBarrier& b, const int tid) {
    asm volatile("s_waitcnt vmcnt(0)" ::: "memory");
    __syncthreads();
    if (tid == 0) {
        unsigned* bar = b.bar;
        __builtin_amdgcn_s_waitcnt(0);
        unsigned nloc = b.st[0], nx = b.st[1];
        if (nloc == 0u) { xcd_barrier_complete(bar, b.x, nloc, nx); b.st[0] = nloc; b.st[1] = nx; }
        const unsigned old = xb_add(&bar[XB_XSUB(b.x)], 1u);
        const unsigned gen = old / nloc;
        if (old + 1u == (gen + 1u) * nloc) {
            __builtin_amdgcn_fence(__ATOMIC_RELEASE, "agent");
            asm volatile("s_waitcnt vmcnt(0)" ::: "memory");
            const unsigned og = xb_add(&bar[XB_TOP], 1u);
            const unsigned tg = og / nx;
            if (og + 1u == (tg + 1u) * nx) xb_add(&bar[XB_TOPGEN], 1u);
            else XB_SPIN(xb_ld(&bar[XB_TOPGEN]) == tg, bar);
            __builtin_amdgcn_fence(__ATOMIC_ACQUIRE, "agent");
            xb_add(&bar[XB_XGEN(b.x)], 1u);
            asm volatile("s_waitcnt vmcnt(0)" ::: "memory");
        } else {
            XB_SPIN(xb_ld(&bar[XB_XGEN(b.x)]) == gen, bar);
            __builtin_amdgcn_fence(__ATOMIC_ACQUIRE, "agent");
            asm volatile("s_waitcnt vmcnt(0)" ::: "memory");
        }
    }
    __syncthreads();
}

constexpr int PT_OFF = LDSCTL_OFF;
constexpr int PT_OUT = 31, PT_WS = 32;
__device__ __forceinline__ const float* ldp(LAS unsigned char* lds, int i) {
    const unsigned long long v = *(volatile LAS unsigned long long*)(lds + PT_OFF + 8 * i);
    const unsigned lo = __builtin_amdgcn_readfirstlane((unsigned)v), hi = __builtin_amdgcn_readfirstlane((unsigned)(v >> 32));
    return (const float*)(const GAS float*)(((unsigned long long)hi << 32) | lo);
}

typedef f32x4 (&AccRef)[2][2][4][2];

__device__ __forceinline__ void row_decode(int row, int& kind, int& b, int& t) {
    if (row < MP) { kind = 0; b = row >> 12; t = row & 4095; }
    else if (row < MR) { kind = 1; b = (row - MP) >> 2; t = (row - MP) & 3; }
    else { kind = 2; b = 0; t = 0; }
}


#ifndef EPI_NT
#define EPI_NT 0
#endif
#if EPI_NT
#define EPI_ST(ptr, val) __builtin_nontemporal_store((val), (ptr))
#else
#define EPI_ST(ptr, val) (*(ptr) = (val))
#endif
typedef _Float16 h16x4 __attribute__((ext_vector_type(4)));
typedef _Float16 h16x8 __attribute__((ext_vector_type(8)));
constexpr size_t RAT_STRIDE = (size_t)MPAD * DM;

template <bool SK> __device__ __forceinline__ void scale_rows_rstd(AccRef acc, const unsigned long long* ss, int row0) {
#pragma unroll
    for (int ai = 0; ai < (SK ? 1 : 2); ++ai)
#pragma unroll
        for (int m = 0; m < (SK ? 2 : 4); ++m) {
            const float r = rsqrtf((float)ss[row0 + ai * 128 + m * 16] * (1.0f / (SS_FIX * DM)) + EPS);
#pragma unroll
            for (int bj = 0; bj < 2; ++bj)
#pragma unroll
                for (int n = 0; n < 2; ++n) acc[ai][bj][m][n] *= r;
        }
}

struct EpiSwiGLU {
    static constexpr bool PERM = false, AFTER_DRAIN = false, HAS_MID = false;
    unsigned char* ws; int nid;
    __device__ __forceinline__ void operator()(AccRef acc, const pg8::Unit& u, int wr, int wc, int fr, int fq) const { run<false>(acc, u, wr, wc, fr, fq); }
    template <bool SK> __device__ __forceinline__ void run(AccRef acc, const pg8::Unit& u, int wr, int wc, int fr_, int fq_) const {
        int fr = fr_, fq = fq_; asm volatile("" : "+v"(fr), "+v"(fq));
        bf16* H = (bf16*)(ws + WS_H);
        const int row0 = u.pm * 256 + wr * 64 + fr, col0 = u.pn * 128 + wc * 32 + 8 * fq;
        scale_rows_rstd<SK>(acc, (const unsigned long long*)(ws + WS_CTL + CTL_SS) + (size_t)nid * MPAD, row0);
#pragma unroll
        for (int ai = 0; ai < (SK ? 1 : 2); ++ai)
#pragma unroll
            for (int m = 0; m < (SK ? 2 : 4); ++m) {
                bf16* p = SK ? H + (size_t)(row0 + ai * 128 + m * 16) * DFF + col0
                             : (bf16*)((char*)H + ((size_t)(u.pm * (DFF / 64) + 2 * u.pn + (wc >> 1)) * 2 + ai) * 16384 + ((4 * wr + m) * 2 + (wc & 1)) * 1024 + ((fr * 64 + 16 * fq) ^ ((fr >> 3) << 5)));
                f32x4 h0, h1;
#pragma unroll
                for (int j = 0; j < 4; ++j) { h0[j] = siluf_(acc[ai][0][m][0][j]) * acc[ai][1][m][0][j]; h1[j] = siluf_(acc[ai][0][m][1][j]) * acc[ai][1][m][1][j]; }
                EPI_ST((u32x4*)p, pk8(h0, h1));
            }
    }
};

struct EpiResid {
    static constexpr bool PERM = false, AFTER_DRAIN = false, HAS_MID = false;
    unsigned char* ws; LAS unsigned char* lds; float scale; int fin; int nid;
    __device__ __forceinline__ void operator()(AccRef acc, const pg8::Unit& u, int wr, int wc, int fr, int fq) const { run<false>(acc, u, wr, wc, fr, fq); }
    template <bool SK> __device__ __forceinline__ void run(AccRef acc, const pg8::Unit& u, int wr, int wc, int fr_, int fq_) const {
        int fr = fr_, fq = fq_; asm volatile("" : "+v"(fr), "+v"(fq));
        bf16* XB = (bf16*)(ws + WS_XN);
        unsigned long long* ssp = (unsigned long long*)(ws + WS_CTL + CTL_SS) + (size_t)(nid < 0 ? 0 : nid) * MPAD;
        float* out = fin ? (float*)ldp(lds, PT_OUT) : nullptr;
        const float scale = (u.ri == 0) ? this->scale : 0.f; const int nid = (u.ri == 0) ? this->nid : -1;
        const int row0 = u.pm * 256 + wr * 64 + fr, col0 = u.pn * 256 + wc * 32 + 8 * fq;
#pragma unroll
        for (int ai = 0; ai < (SK ? 1 : 2); ++ai)
#pragma unroll
            for (int m = 0; m < (SK ? 2 : 4); ++m) {
                const int row = row0 + ai * 128 + m * 16;
                char* xr = (char*)XB + (SK ? ((size_t)row * DM + col0) * 2
                                           : ((size_t)(u.pm * (DM / 64) + 4 * u.pn + (wc >> 1)) * 2 + ai) * 16384 + ((4 * wr + m) * 2 + (wc & 1)) * 1024 + ((fr * 64 + 16 * fq) ^ ((fr >> 3) << 5)));
                constexpr size_t BJS = SK ? 256 : 65536;
                float sq = 0.f;
#pragma unroll
                for (int bj = 0; bj < 2; ++bj) {
                    float xo[8]; unpk8(*(const u32x4*)(xr + bj * BJS), xo);
                    f32x4 v0, v1;
#pragma unroll
                    for (int j = 0; j < 4; ++j) { v0[j] = xo[j] + scale * acc[ai][bj][m][0][j]; v1[j] = xo[4 + j] + scale * acc[ai][bj][m][1][j]; }
                    if (out != nullptr && row < MR) { float* o = out + (size_t)row * DM + col0 + bj * 128; *(f32x4*)o = v0; *(f32x4*)(o + 4) = v1; }
                    const u32x4 w = pk8(v0, v1);
                    EPI_ST((u32x4*)(xr + bj * BJS), w);
                    float xn[8]; unpk8(w, xn);
#pragma unroll
                    for (int j = 0; j < 8; ++j) sq += xn[j] * xn[j];
                }
                { const int ln = fq * 16 + fr; sq += shx(sq, 16, ln); sq += shx(sq, 32, ln); }
                if (nid >= 0 && fq == 0) atomicAdd(ssp + row, (unsigned long long)(sq * SS_FIX + 0.5f));
            }
    }
};

struct EpiMergeCat {
    static constexpr bool PERM = false, AFTER_DRAIN = false, HAS_MID = true;
    unsigned char* ws;
    __device__ __forceinline__ void apply(f32x4 (&acc)[2][2][4][2], const pg8::Unit& u, int s, int wr, int wc, int fr_, int fq_) const {
        int fr = fr_, fq = fq_; asm volatile("" : "+v"(fr), "+v"(fq));
        const _Float16* R = (const _Float16*)(ws + WS_GATE) + (size_t)s * RAT_STRIDE;
        const int row0 = u.pm * 256 + wr * 64 + fr, col0 = u.pn * 256 + wc * 32 + 8 * fq;
        h16x8 r[2][4][2];
#pragma unroll
        for (int ai = 0; ai < 2; ++ai)
#pragma unroll
            for (int m = 0; m < 4; ++m)
#pragma unroll
                for (int bj = 0; bj < 2; ++bj) r[ai][m][bj] = *(const h16x8*)(R + (size_t)(row0 + ai * 128 + m * 16) * DM + col0 + bj * 128);
#pragma unroll
        for (int ai = 0; ai < 2; ++ai)
#pragma unroll
            for (int m = 0; m < 4; ++m)
#pragma unroll
                for (int bj = 0; bj < 2; ++bj)
#pragma unroll
                    for (int j = 0; j < 4; ++j) { acc[ai][bj][m][0][j] *= (float)r[ai][m][bj][j]; acc[ai][bj][m][1][j] *= (float)r[ai][m][bj][4 + j]; }
    }
    __device__ __forceinline__ void mid(f32x4 (&acc)[2][2][4][2], const pg8::Unit& u, int t, int wr, int wc, int fr, int fq) const {
        apply(acc, u, (t == 8) ? 0 : (t == 12 ? 1 : 2), wr, wc, fr, fq);
    }
    __device__ __forceinline__ void operator()(AccRef acc, const pg8::Unit& u, int wr, int wc, int fr_, int fq_) const {
        apply(acc, u, 3, wr, wc, fr_, fq_);
        int fr = fr_, fq = fq_; asm volatile("" : "+v"(fr), "+v"(fq));
        bf16* MRG = (bf16*)(ws + WS_MRG);
        const int row0 = u.pm * 256 + wr * 64 + fr, col0 = u.pn * 256 + wc * 32 + 8 * fq;
#pragma unroll
        for (int ai = 0; ai < 2; ++ai)
#pragma unroll
            for (int m = 0; m < 4; ++m)
#pragma unroll
                for (int bj = 0; bj < 2; ++bj)
                    EPI_ST((u32x4*)((char*)MRG + ((size_t)(u.pm * (DM / 64) + 4 * u.pn + 2 * bj + (wc >> 1)) * 2 + ai) * 16384 + ((4 * wr + m) * 2 + (wc & 1)) * 1024 + ((fr * 64 + 16 * fq) ^ ((fr >> 3) << 5))),
                           pk8(acc[ai][bj][m][0], acc[ai][bj][m][1]));
    }
};
template <int MODE>
struct EpiMergeS {
    static constexpr bool PERM = false, AFTER_DRAIN = false, HAS_MID = false;
    unsigned char* ws; int br;
    template <bool SK> __device__ __forceinline__ void run(AccRef acc, const pg8::Unit& u, int wr, int wc, int fr, int fq) const {
        float* P = (float*)(ws + WS_PM); bf16* MRG = (bf16*)(ws + WS_MRG);
        const int row0 = u.pm * 256 + wr * 64 + fr, col0 = u.pn * 256 + wc * 32 + 8 * fq;
#pragma unroll
        for (int m = 0; m < 2; ++m) {
            const int row = row0 + m * 16;
#pragma unroll
            for (int bj = 0; bj < 2; ++bj) {
                const int c = col0 + bj * 128;
                float g[8];
                { const _Float16* R = (const _Float16*)(ws + WS_GATE) + (size_t)row * DM + c;
                  const h16x8 r3 = *(const h16x8*)(R + 3 * RAT_STRIDE);
#pragma unroll
                  for (int j = 0; j < 8; ++j) g[j] = (float)r3[j];
#pragma unroll
                  for (int s = 2; s >= 0; --s) if (s >= br) { const h16x8 rs = *(const h16x8*)(R + (size_t)s * RAT_STRIDE);
#pragma unroll
                      for (int j = 0; j < 8; ++j) g[j] *= (float)rs[j]; } }
                f32x4 v0, v1;
#pragma unroll
                for (int j = 0; j < 4; ++j) { v0[j] = g[j] * acc[0][bj][m][0][j]; v1[j] = g[4 + j] * acc[0][bj][m][1][j]; }
                float* pp = P + (size_t)(row - MP) * DM + c;
                if (MODE != 0) { v0 += *(const f32x4*)pp; v1 += *(const f32x4*)(pp + 4); }
                if (MODE == 2) *(u32x4*)(MRG + (size_t)row * DM + c) = pk8(v0, v1);
                else { *(f32x4*)pp = v0; *(f32x4*)(pp + 4) = v1; }
            }
        }
    }
};

struct EpiWin {
    static constexpr bool PERM = false, AFTER_DRAIN = false, HAS_MID = false;
    unsigned char* ws;
    const float *qgain, *kgain, *b_a;
    float* out; int layer; int nid;

    template <int ACT, bool SK>
    __device__ __forceinline__ void plain(AccRef acc, bf16* dst, int ldc, int cbase, int row0, int wc, int fq) const {
#pragma unroll
        for (int ai = 0; ai < (SK ? 1 : 2); ++ai)
#pragma unroll
            for (int m = 0; m < (SK ? 2 : 4); ++m) {
                bf16* p = dst + (size_t)(row0 + ai * 128 + m * 16) * ldc + cbase + wc * 32 + fq * 8;
#pragma unroll
                for (int bj = 0; bj < 2; ++bj) {
                    f32x4 v0 = acc[ai][bj][m][0], v1 = acc[ai][bj][m][1];
#pragma unroll
                    for (int j = 0; j < 4; ++j) {
                        if (ACT == 1) { v0[j] = sigmoidf_(v0[j]); v1[j] = sigmoidf_(v1[j]); }
                        if (ACT == 2) { v0[j] = siluf_(v0[j]); v1[j] = siluf_(v1[j]); }
                        if (ACT == 3) { v0[j] *= 0.125f; v1[j] *= 0.125f; }
                    }
                    EPI_ST((u32x4*)(p + bj * 128), pk8(v0, v1));
                }
            }
    }

    __device__ __forceinline__ void operator()(AccRef acc, const pg8::Unit& u, int wr, int wc, int fr, int fq) const { run<false>(acc, u, wr, wc, fr, fq); }
    template <bool SK> __device__ __forceinline__ void run(AccRef acc, const pg8::Unit& u, int wr, int wc, int fr_, int fq_) const {
        int fr = fr_, fq = fq_; asm volatile("" : "+v"(fr), "+v"(fq));
        const int pn = u.pn, row0 = u.pm * 256 + wr * 64 + fr, l = layer;
        scale_rows_rstd<SK>(acc, (const unsigned long long*)(ws + WS_CTL + CTL_SS) + (size_t)nid * MPAD, row0);
        if (pn < T_CB) {
            const int ch0 = 128 * pn + 32 * wc + 8 * fq;
#pragma unroll
            for (int ai = 0; ai < (SK ? 1 : 2); ++ai)
#pragma unroll
                for (int m = 0; m < (SK ? 2 : 4); ++m) {
                    const int row = row0 + ai * 128 + m * 16;
                    const f32x4 u0 = acc[ai][0][m][0] * acc[ai][1][m][0], u1 = acc[ai][0][m][1] * acc[ai][1][m][1];
                    *(u32x4*)((bf16*)(ws + WS_U) + (size_t)row * 512 + ch0) = pk8(u0, u1);
                    int kind, b, t; row_decode(row, kind, b, t);
                    if (kind == 0 && t >= SEQ - 2) { float* o = out + OFF_CONV_P + ((l * NB_P + b) * 2 + (t - (SEQ - 2))) * 512 + ch0; *(f32x4*)o = u0; *(f32x4*)(o + 4) = u1; }
                    if (kind == 1 && t >= TS - 2)  { float* o = out + OFF_CONV_S + ((l * NB_S + b) * 2 + (t - (TS - 2))) * 512 + ch0; *(f32x4*)o = u0; *(f32x4*)(o + 4) = u1; }
                }
        } else if (pn < T_Q) {
            plain<0, SK>(acc, (bf16*)(ws + WS_CB), 512, 256 * (pn - T_CB), row0, wc, fq);
        } else if (pn < T_V) {
            const bool isk = pn >= T_K; const int ti = isk ? pn - T_K : pn - T_Q; const int head = 4 * ti + wc;
            const float* gp = (isk ? kgain : qgain) + head * 64 + 8 * fq;
            f32x4 g[2][2];
#pragma unroll
            for (int bj = 0; bj < 2; ++bj) { g[bj][0] = *(const f32x4*)(gp + 32 * bj); g[bj][1] = *(const f32x4*)(gp + 32 * bj + 4); }
            bf16* dst = (bf16*)(ws + (isk ? WS_K : WS_Q));
            const int W = win_of(ti);
#pragma unroll
            for (int ai = 0; ai < (SK ? 1 : 2); ++ai)
#pragma unroll
                for (int m = 0; m < (SK ? 2 : 4); ++m) {
                    const int row = row0 + ai * 128 + m * 16;
                    float ss = 0.f;
#pragma unroll
                    for (int bj = 0; bj < 2; ++bj)
#pragma unroll
                        for (int n = 0; n < 2; ++n) { const f32x4 x = acc[ai][bj][m][n]; ss += (x[0] * x[0] + x[1] * x[1]) + (x[2] * x[2] + x[3] * x[3]); }
                    { const int ln = fq * 16 + fr; ss += shx(ss, 16, ln); ss += shx(ss, 32, ln); }
                    const float rs = rsqrtf(ss * (1.0f / 64.0f) + EPS);
                    int kind, b, t; row_decode(row, kind, b, t);
#pragma unroll
                    for (int bj = 0; bj < 2; ++bj) {
                        const f32x4 y0 = acc[ai][bj][m][0] * rs * g[bj][0], y1 = acc[ai][bj][m][1] * rs * g[bj][1];
                        *(u32x4*)(dst + (size_t)row * 768 + head * 64 + 32 * bj + 8 * fq) = pk8(y0, y1);
                        if (isk) {
                            const int e0 = 32 * bj + 8 * fq;
                            if (kind == 0 && t >= SEQ - W) { float* o = out + offw_p(ti) + ((((l * NB_P + b) * W + (t - (SEQ - W))) * 2 + 0) * 4 + wc) * 64 + e0; *(f32x4*)o = y0; *(f32x4*)(o + 4) = y1; }
                            if (kind == 1)                 { float* o = out + offw_s(ti) + ((((l * NB_S + b) * W + (W - TS + t)) * 2 + 0) * 4 + wc) * 64 + e0; *(f32x4*)o = y0; *(f32x4*)(o + 4) = y1; }
                        }
                    }
                }
        } else if (pn < T_GQ) {
            const int ti = pn - T_V;
            plain<0, SK>(acc, (bf16*)(ws + WS_V), 768, 256 * ti, row0, wc, fq);
            const int W = win_of(ti);
#pragma unroll
            for (int ai = 0; ai < (SK ? 1 : 2); ++ai)
#pragma unroll
                for (int m = 0; m < (SK ? 2 : 4); ++m) {
                    const int row = row0 + ai * 128 + m * 16;
                    int kind, b, t; row_decode(row, kind, b, t);
#pragma unroll
                    for (int bj = 0; bj < 2; ++bj) {
                        const int hh = 2 * bj + (wc >> 1), e0 = 32 * (wc & 1) + 8 * fq;
                        if (kind == 0 && t >= SEQ - W) { float* o = out + offw_p(ti) + ((((l * NB_P + b) * W + (t - (SEQ - W))) * 2 + 1) * 4 + hh) * 64 + e0; *(f32x4*)o = acc[ai][bj][m][0]; *(f32x4*)(o + 4) = acc[ai][bj][m][1]; }
                        if (kind == 1)                 { float* o = out + offw_s(ti) + ((((l * NB_S + b) * W + (W - TS + t)) * 2 + 1) * 4 + hh) * 64 + e0; *(f32x4*)o = acc[ai][bj][m][0]; *(f32x4*)(o + 4) = acc[ai][bj][m][1]; }
                    }
                }
        } else if (pn == T_GQ) {
            plain<3, SK>(acc, (bf16*)(ws + WS_GQ), 256, 0, row0, wc, fq);
        } else if (pn == T_GK) {
            plain<0, SK>(acc, (bf16*)(ws + WS_GK), 256, 0, row0, wc, fq);
        } else if (pn < T_GR) {
            plain<0, SK>(acc, (bf16*)(ws + WS_GV), 512, 256 * (pn - T_GV), row0, wc, fq);
        } else if (pn < T_Z) {
            plain<2, SK>(acc, (bf16*)(ws + WS_GR), 512, 256 * (pn - T_GR), row0, wc, fq);
        } else if (pn == T_Z) {
#pragma unroll
            for (int bj = 0; bj < 2; ++bj) {
                const int c0 = 128 * bj + 32 * wc + 8 * fq;
                const f32x4 b0 = *(const f32x4*)(b_a + c0), b1 = *(const f32x4*)(b_a + c0 + 4);
#pragma unroll
                for (int ai = 0; ai < (SK ? 1 : 2); ++ai)
#pragma unroll
                    for (int m = 0; m < (SK ? 2 : 4); ++m) {
                        const int row = row0 + ai * 128 + m * 16;
                        f32x4 z0 = acc[ai][bj][m][0] + b0, z1 = acc[ai][bj][m][1] + b1;
#pragma unroll
                        for (int j = 0; j < 4; ++j) {
                            z0[j] = (fminf(z0[j], 0.f) - __logf(1.0f + __expf(-fabsf(z0[j])))) * (1.0f / 16.0f);
                            z1[j] = (fminf(z1[j], 0.f) - __logf(1.0f + __expf(-fabsf(z1[j])))) * (1.0f / 16.0f);
                        }
                        float* o = (float*)(ws + WS_LA) + (size_t)row * 256 + c0; *(f32x4*)o = z0; *(f32x4*)(o + 4) = z1;
                    }
            }
        } else if (pn < T_GATE) {
            const int ti = pn - T_PIN;
            plain<0, SK>(acc, (bf16*)(ws + WS_PIN), 512, 256 * ti, row0, wc, fq);
#pragma unroll
            for (int ai = 0; ai < (SK ? 1 : 2); ++ai)
#pragma unroll
                for (int m = 0; m < (SK ? 2 : 4); ++m) {
                    const int row = row0 + ai * 128 + m * 16;
                    int kind, b, t; row_decode(row, kind, b, t);
#pragma unroll
                    for (int bj = 0; bj < 2; ++bj) {
                        const int c0 = 256 * ti + 128 * bj + 32 * wc + 8 * fq;
                        if (kind == 0 && t >= SEQ - 15) { float* o = out + OFF_POOL_P + ((l * NB_P + b) * 15 + (t - (SEQ - 15))) * 512 + c0; *(f32x4*)o = acc[ai][bj][m][0]; *(f32x4*)(o + 4) = acc[ai][bj][m][1]; }
                        if (kind == 1)                  { float* o = out + OFF_POOL_S + ((l * NB_S + b) * 15 + (15 - TS + t)) * 512 + c0; *(f32x4*)o = acc[ai][bj][m][0]; *(f32x4*)(o + 4) = acc[ai][bj][m][1]; }
                    }
                }
        } else {
            _Float16* R = (_Float16*)(ws + WS_GATE);
            const int c0 = 64 * (pn - T_GATE) + 16 * wc + 4 * fq;
#pragma unroll
            for (int ai = 0; ai < (SK ? 1 : 2); ++ai)
#pragma unroll
                for (int m = 0; m < (SK ? 2 : 4); ++m) {
                    const size_t o = (size_t)(row0 + ai * 128 + m * 16) * DM + c0;
                    h16x4 r0, r1, r2, r3;
#pragma unroll
                    for (int j = 0; j < 4; ++j) {
                        const float d0 = fminf(1.0f + __expf(-acc[ai][0][m][0][j]), 16384.f), d1 = fminf(1.0f + __expf(-acc[ai][0][m][1][j]), 16384.f);
                        const float d2 = fminf(1.0f + __expf(-acc[ai][1][m][0][j]), 16384.f), d3 = fminf(1.0f + __expf(-acc[ai][1][m][1][j]), 16384.f);
                        const float i0 = __builtin_amdgcn_rcpf(d0), i1 = __builtin_amdgcn_rcpf(d1), i2 = __builtin_amdgcn_rcpf(d2), i3 = __builtin_amdgcn_rcpf(d3);
                        r0[j] = (_Float16)fminf(d1 * i0, 65504.f); r1[j] = (_Float16)fminf(d2 * i1, 65504.f); r2[j] = (_Float16)fminf(d3 * i2, 65504.f); r3[j] = (_Float16)i3;
                    }
                    EPI_ST((h16x4*)(R + o), r0); EPI_ST((h16x4*)(R + RAT_STRIDE + o), r1); EPI_ST((h16x4*)(R + 2 * RAT_STRIDE + o), r2); EPI_ST((h16x4*)(R + 3 * RAT_STRIDE + o), r3);
                }
        }
    }
};

__device__ __forceinline__ unsigned wt_lane(int wc, int fr, int g) { return (unsigned)(wc * 4096 + (g >> 1) * 1024 + ((fr * 64 + 32 * (g & 1)) ^ ((fr >> 3) << 5))); }
template <class Epi>
__device__ __forceinline__ void skinny_unit(LAS unsigned char* lds, const bf16* A, const bf16* Bt, int K, int su, const Epi E, int tid, int ld = 0) {
    if (ld == 0) ld = K;
    const int lane = tid & 63, w = __builtin_amdgcn_readfirstlane(tid >> 6), fr = lane & 15, g = lane >> 4;
    const int pn = su >> 2, wc = su & 3;
    const int nh = K >> 6, h0 = (w * nh) >> 3, h1 = ((w + 1) * nh) >> 3;
    f32x4 acc[2][2][2];
#pragma unroll
    for (int bj = 0; bj < 2; ++bj)
#pragma unroll
        for (int m = 0; m < 2; ++m)
#pragma unroll
            for (int n = 0; n < 2; ++n) acc[bj][m][n] = (f32x4){0.f, 0.f, 0.f, 0.f};
    const bf16* ap = A + (size_t)(MP + fr) * ld + 16 * g;
    const char* bp = (const char*)Bt + (size_t)pn * nh * 32768 + wt_lane(wc, fr, g);
    for (int hc = h0; hc < h1; hc += 4) {
        bf16x8 a[4][2][2], b[4][2][2][2];
#pragma unroll
        for (int q = 0; q < 4; ++q) {
            const int hq = (hc + q < h1) ? hc + q : h1 - 1;
#pragma unroll
            for (int s = 0; s < 2; ++s) {
#pragma unroll
                for (int m = 0; m < 2; ++m) a[q][m][s] = *(const bf16x8*)(ap + (size_t)(16 * m) * ld + 64 * hq + 8 * s);
#pragma unroll
                for (int bj = 0; bj < 2; ++bj)
#pragma unroll
                    for (int n = 0; n < 2; ++n) b[q][bj][n][s] = *(const bf16x8*)(bp + (size_t)hq * 32768 + bj * 16384 + n * 2048 + s * 16);
            }
        }
#pragma unroll
        for (int q = 0; q < 4; ++q) {
            const bool ok = hc + q < h1;
#pragma unroll
            for (int s = 0; s < 2; ++s)
#pragma unroll
                for (int m = 0; m < 2; ++m) {
                    bf16x8 av = a[q][m][s];
                    if (!ok) av = (bf16x8){0, 0, 0, 0, 0, 0, 0, 0};
#pragma unroll
                    for (int bj = 0; bj < 2; ++bj)
#pragma unroll
                        for (int n = 0; n < 2; ++n) acc[bj][m][n] = __builtin_amdgcn_mfma_f32_16x16x32_bf16(b[q][bj][n][s], av, acc[bj][m][n], 0, 0, 0);
                }
        }
    }
    LAS f32x4* red = (LAS f32x4*)lds;
#pragma unroll
    for (int bj = 0; bj < 2; ++bj)
#pragma unroll
        for (int m = 0; m < 2; ++m)
#pragma unroll
            for (int n = 0; n < 2; ++n) red[(w * 8 + (bj * 4 + m * 2 + n)) * 64 + lane] = acc[bj][m][n];
    __syncthreads();
    if (w == 0) {
        f32x4 full[2][2][4][2];
#pragma unroll
        for (int bj = 0; bj < 2; ++bj)
#pragma unroll
            for (int m = 0; m < 2; ++m)
#pragma unroll
                for (int n = 0; n < 2; ++n) {
                    f32x4 s = red[(bj * 4 + m * 2 + n) * 64 + lane];
#pragma unroll
                    for (int ww = 1; ww < 8; ++ww) s += red[(ww * 8 + (bj * 4 + m * 2 + n)) * 64 + lane];
                    asm volatile("" : "+v"(s) :: "memory");
                    full[0][bj][m][n] = s;
                }
        pg8::Unit u; u.pm = MP / 256; u.pn = pn; u.ri = 0;
        E.template run<true>(full, u, 0, wc, fr, g);
    }
    __syncthreads();
}

__device__ __forceinline__ void skinny_merge_unit(LAS unsigned char* lds, unsigned char* ws, const bf16* Y, const bf16* U, int su, int tid) {
    const int lane = tid & 63, w = __builtin_amdgcn_readfirstlane(tid >> 6), fr = lane & 15, g = lane >> 4;
    const int pn = su >> 2, wc = su & 3;
    f32x4 acc[2][2][2];
#pragma unroll
    for (int bj = 0; bj < 2; ++bj)
#pragma unroll
        for (int m = 0; m < 2; ++m)
#pragma unroll
            for (int n = 0; n < 2; ++n) acc[bj][m][n] = (f32x4){0.f, 0.f, 0.f, 0.f};
    if (w < 7) {
        const bf16* ap = Y + (size_t)(MP + fr) * YK + 16 * g + 256 * w;
        const char* bp = (const char*)U + (size_t)(pn * (YK / 64) + 4 * w) * 32768 + wt_lane(wc, fr, g);
        bf16x8 a[4][2][2], b[4][2][2][2];
#pragma unroll
        for (int q = 0; q < 4; ++q)
#pragma unroll
            for (int s2 = 0; s2 < 2; ++s2) {
#pragma unroll
                for (int m = 0; m < 2; ++m) a[q][m][s2] = *(const bf16x8*)(ap + (size_t)(16 * m) * YK + 64 * q + 8 * s2);
#pragma unroll
                for (int bj = 0; bj < 2; ++bj)
#pragma unroll
                    for (int n = 0; n < 2; ++n) b[q][bj][n][s2] = *(const bf16x8*)(bp + (size_t)q * 32768 + bj * 16384 + n * 2048 + s2 * 16);
            }
#pragma unroll
        for (int q = 0; q < 4; ++q)
#pragma unroll
            for (int s2 = 0; s2 < 2; ++s2)
#pragma unroll
                for (int m = 0; m < 2; ++m)
#pragma unroll
                    for (int bj = 0; bj < 2; ++bj)
#pragma unroll
                        for (int n = 0; n < 2; ++n) acc[bj][m][n] = __builtin_amdgcn_mfma_f32_16x16x32_bf16(b[q][bj][n][s2], a[q][m][s2], acc[bj][m][n], 0, 0, 0);
    }
    LAS f32x4* red = (LAS f32x4*)lds;
#pragma unroll
    for (int bj = 0; bj < 2; ++bj)
#pragma unroll
        for (int m = 0; m < 2; ++m)
#pragma unroll
            for (int n = 0; n < 2; ++n) red[(w * 8 + (bj * 4 + m * 2 + n)) * 64 + lane] = acc[bj][m][n];
    __syncthreads();
    if (w == 0) {
        bf16* MRG = (bf16*)(ws + WS_MRG);
        const int col0 = pn * 256 + wc * 32 + 8 * g;
#pragma unroll
        for (int m = 0; m < 2; ++m) {
            const int row = MP + 16 * m + fr;
#pragma unroll
            for (int bj = 0; bj < 2; ++bj) {
                const _Float16* R = (const _Float16*)(ws + WS_GATE) + (size_t)row * DM + col0 + bj * 128;
                const h16x8 r0 = *(const h16x8*)R, r1 = *(const h16x8*)(R + RAT_STRIDE), r2 = *(const h16x8*)(R + 2 * RAT_STRIDE), r3 = *(const h16x8*)(R + 3 * RAT_STRIDE);
                f32x4 o[2];
#pragma unroll
                for (int n = 0; n < 2; ++n) {
                    const int ti = bj * 4 + m * 2 + n;
                    const f32x4 pa = red[(0 * 8 + ti) * 64 + lane] + red[(1 * 8 + ti) * 64 + lane], pb = red[(2 * 8 + ti) * 64 + lane];
                    const f32x4 pc = red[(3 * 8 + ti) * 64 + lane] + red[(4 * 8 + ti) * 64 + lane], pd = red[(5 * 8 + ti) * 64 + lane] + red[(6 * 8 + ti) * 64 + lane];
#pragma unroll
                    for (int j = 0; j < 4; ++j) {
                        const float e3 = (float)r3[4 * n + j], e2 = (float)r2[4 * n + j] * e3, e1 = (float)r1[4 * n + j] * e2, e0 = (float)r0[4 * n + j] * e1;
                        o[n][j] = (e0 * pa[j] + e1 * pb[j]) + (e2 * pc[j] + e3 * pd[j]);
                    }
                }
                *(u32x4*)(MRG + (size_t)row * DM + col0 + bj * 128) = pk8(o[0], o[1]);
            }
        }
    }
    __syncthreads();
}

constexpr int IT_GU = 344 * 32, IT_D = 64 * 86, IT_IN = 448 * 32, IT_UPA = 64 * 8, IT_UPB = 64 * 4, IT_UPC = 64 * 8, IT_UPD = 64 * 8, IT_OUT = 64 * 32;
constexpr int IT_LAYER = 2 * IT_GU + 2 * IT_D + IT_IN + IT_UPA + IT_UPB + IT_UPC + IT_UPD + IT_OUT;
static_assert(IT_LAYER == 51200, "items per layer");

constexpr int PB_LAYER = 2 * 43 * 32 + 2 * 8 * 86 + 56 * 32 + 8 * 8 + 8 * 4 + 8 * 8 + 8 * 8 + 8 * 32;
static_assert(PB_LAYER == 6400, "blocks per layer");
constexpr int PB_P = 265;
constexpr int PB_PW_OFF = 69632;
struct BDesc { const float* src; const float* gain; bf16* dst; int ldw, K, kind, perm, aux0, aux1, aux2; };

__device__ __forceinline__ void pblk_decode(LAS unsigned char* lds, bf16* WB, int blk, int wave, int lane, BDesc& D) {
    const int l = blk / PB_LAYER; int r = blk % PB_LAYER;
    const int g = lane >> 3, c4 = lane & 7, bj = g >> 2, wc = g & 3;
    int wi, wi2, gi = -1, ldw, S0, k0, K, T, perm = 1, yo = 0; size_t wofs, woff;
    if (r < 2 * 1376) {
        const int f = r / 1376; r -= f * 1376; T = r % 43; const int kb = r / 43;
        wi = f ? 28 : 9; wi2 = f ? 29 : 10; wofs = (size_t)l * DM * DFF; ldw = DFF; S0 = 128 * T + 32 * wc; k0 = 64 * kb; K = DM; woff = f ? WE_GU2 : WE_GU1; gi = f ? 27 : 8;
    } else if ((r -= 2 * 1376) < 2 * 688) {
        const int f = r / 688; r -= f * 688; T = r % 8; const int kb = r / 8;
        wi = wi2 = f ? 30 : 11; wofs = (size_t)l * DFF * DM; ldw = DM; S0 = 256 * T + 32 * g; k0 = 64 * kb; K = DFF; woff = f ? WE_D2 : WE_D1;
    } else if ((r -= 2 * 688) < 1792) {
        T = r % 56; const int kb = r / 56, pn = T;
        wi = wi2 = 13; wofs = (size_t)l * DM * N_IN; ldw = N_IN; k0 = 64 * kb; K = DM; woff = WE_IN; gi = 12;
        if (pn < T_CB) S0 = (bj ? C_CH : C_CC) + 128 * pn + 32 * wc;
        else if (pn < T_Q) S0 = C_CB + 256 * (pn - T_CB) + 32 * g;
        else if (pn < T_K) S0 = C_AQ + 256 * (pn - T_Q) + 64 * wc + 32 * bj;
        else if (pn < T_V) S0 = C_AK + 256 * (pn - T_K) + 64 * wc + 32 * bj;
        else if (pn < T_GQ) S0 = C_AV + 256 * (pn - T_V) + 32 * g;
        else if (pn == T_GQ) S0 = C_GQ + 32 * g;
        else if (pn == T_GK) S0 = C_GK + 32 * g;
        else if (pn < T_GR) S0 = C_GV + 256 * (pn - T_GV) + 32 * g;
        else if (pn < T_Z) S0 = C_GR + 256 * (pn - T_GR) + 32 * g;
        else if (pn == T_Z) S0 = C_LR;
        else if (pn < T_GATE) S0 = C_PIN + 256 * (pn - T_PIN) + 32 * g;
        else { S0 = C_GATE + (2 * bj + (c4 >> 2)) * 2048 + 64 * (pn - T_GATE) + 16 * wc + 4 * (c4 & 3) - 4 * c4; perm = 0; }
    } else {
        r -= 1792; K = YK; woff = WE_UPCAT; ldw = DM; int kb;
        if (r < 64) { T = r % 8; kb = r / 8; wi = 22; wofs = (size_t)l * 512 * DM; yo = YO_A; }
        else if ((r -= 64) < 32) { T = r % 8; kb = r / 8; wi = 23; wofs = (size_t)l * 256 * DM; yo = YO_B; }
        else if ((r -= 32) < 64) { T = r % 8; kb = r / 8; wi = 24; wofs = (size_t)l * 512 * DM; yo = YO_C; }
        else if ((r -= 64) < 64) { T = r % 8; kb = r / 8; wi = 25; wofs = (size_t)l * 512 * DM; yo = YO_D; }
        else { r -= 64; T = r % 8; kb = r / 8; wi = 26; wofs = (size_t)l * DM * DM; K = DM; woff = WE_OUT; }
        wi2 = wi; S0 = 256 * T + 32 * g; k0 = 64 * kb;
    }
    const float* W0 = ldp(lds, wi); const float* W1 = ldp(lds, wi2); const float* gbase = ldp(lds, gi >= 0 ? gi : 8);
    D.src = (bj ? W1 : W0) + wofs + (size_t)(k0 + 8 * wave) * ldw + S0 + 4 * c4;
    D.gain = gi >= 0 ? gbase + (size_t)l * DM + k0 + 8 * wave : gbase;
    D.dst = WB + (size_t)l * WE_LAYER + woff + ((size_t)T * (K >> 6) + ((yo + k0) >> 6)) * 16384; D.ldw = ldw; D.K = K; D.kind = 0; D.perm = perm; D.aux0 = 0; D.aux1 = l; D.aux2 = gi >= 0;
}
__device__ __forceinline__ void pblk_load(const BDesc& D, f32x4 (&v)[8], f32x4 (&gv)[2]) {
#pragma unroll
    for (int i = 0; i < 8; ++i) v[i] = __builtin_nontemporal_load((const f32x4*)(D.src + (size_t)i * D.ldw));
    gv[0] = *(const f32x4*)D.gain; gv[1] = *(const f32x4*)(D.gain + 4);
}
template <int MODE = 0>
__device__ __forceinline__ void pblk_writeout(LAS unsigned char* lds, bf16* dst, int K, int perm, int tid) {
    LAS float* tile = (LAS float*)(lds + RING_OFF);
    const int lane = tid & 63, wave = tid >> 6;
    LDS_WAIT(); __builtin_amdgcn_s_barrier(); asm volatile("" ::: "memory");
    const int c = lane & 7;
#pragma unroll
    for (int j = 0; j < 4; ++j) {
        const int rho = (lane >> 3) + 8 * j; const int cc = perm ? pg8::perm32(rho) : rho;
        const LAS float* s = tile + (8 * c) * PB_P + 33 * wave + cc;
        u32x4 o; o.x = pk2(s[0 * PB_P], s[1 * PB_P]); o.y = pk2(s[2 * PB_P], s[3 * PB_P]); o.z = pk2(s[4 * PB_P], s[5 * PB_P]); o.w = pk2(s[6 * PB_P], s[7 * PB_P]);
        if (MODE == 0) *(u32x4*)((char*)dst + (wave >> 2) * 16384 + pg8::lds_byte(32 * (wave & 3) + rho, 8 * c)) = o; else asm volatile("" :: "v"(o));
    }
    LDS_WAIT(); __builtin_amdgcn_s_barrier(); asm volatile("" ::: "memory");
}
template <int MODE = 0>
__device__ __forceinline__ void pblk_finish(LAS unsigned char* lds, const BDesc& D, const f32x4 (&v)[8], const f32x4 (&gv)[2], int tid) {
    if (MODE == 2) { _Pragma("unroll") for (int i = 0; i < 8; ++i) asm volatile("" :: "v"(v[i])); return; }
    f32x4 g0 = gv[0], g1 = gv[1]; asm volatile("" : "+v"(g0), "+v"(g1) :: "memory");
    LAS float* tile = (LAS float*)(lds + RING_OFF);
    const int lane = tid & 63, wave = tid >> 6;
    const int g = lane >> 3, c4 = lane & 7;
#pragma unroll
    for (int i = 0; i < 8; ++i) { const float gk = D.aux2 ? (i < 4 ? g0[i & 3] : g1[i & 3]) : 1.0f; LAS float* s = tile + (8 * wave + i) * PB_P + 33 * g + 4 * c4; s[0] = v[i][0] * gk; s[1] = v[i][1] * gk; s[2] = v[i][2] * gk; s[3] = v[i][3] * gk; }
    pblk_writeout<MODE>(lds, D.dst, D.K, D.perm, tid);
}
__device__ __forceinline__ void prologue_specials(LAS unsigned char* lds, bf16* WB, int bid, int G, int tid) {
    LAS float* tile = (LAS float*)(lds + RING_OFF);
#pragma unroll 1
    for (int s = bid; s < DEPTH * 96; s += G) {
        const int l = s / 96, r = s % 96;
        bf16* wl = WB + (size_t)l * WE_LAYER;
        if (r < 32) {
            const int kb = r;
            const float* A2 = ldp(lds, 17) + (size_t)l * 16 * 256; const float* gmix = ldp(lds, 12) + (size_t)l * DM;
            const float* Wk = ldp(lds, 13) + (size_t)l * DM * N_IN + (size_t)(64 * kb) * N_IN + C_LR;
            const int c = tid & 255, half = tid >> 8;
            float w2[16];
#pragma unroll
            for (int q = 0; q < 16; ++q) w2[q] = A2[q * 256 + c];
#pragma unroll 4
            for (int i = 0; i < 32; ++i) {
                const int kk = 32 * half + i;
                const f32x4* a = (const f32x4*)(Wk + (size_t)kk * N_IN);
                float sum = 0.f;
#pragma unroll
                for (int q = 0; q < 4; ++q) { const f32x4 av = a[q]; sum += av[0] * w2[4 * q] + av[1] * w2[4 * q + 1] + av[2] * w2[4 * q + 2] + av[3] * w2[4 * q + 3]; }
                tile[kk * PB_P + 33 * (c >> 5) + (c & 31)] = sum * gmix[64 * kb + kk];
            }
            pblk_writeout(lds, wl + WE_IN + ((size_t)T_Z * (DM / 64) + kb) * 16384, DM, 1, tid);
        } else {
            const int q = r - 32, T = q % 8, kb = q / 8, gg = kb >> 1, i0 = (kb & 1) * 64;
            LAS float* pw = (LAS float*)(lds + PB_PW_OFF);
            { const f32x4* src = (const f32x4*)(ldp(lds, 20) + ((size_t)l * 4 + gg) * 128 * 128 + (size_t)i0 * 128);
              for (int e = tid; e < 64 * 32; e += NTHR) ((LAS f32x4*)pw)[e] = src[e]; }
            LDS_WAIT(); __builtin_amdgcn_s_barrier(); asm volatile("" ::: "memory");
            const int n = tid & 255, half = tid >> 8;
            const float* SC = ldp(lds, 21) + (size_t)l * 512 + gg * 128;
            const float* UD = ldp(lds, 25) + (size_t)l * 512 * DM + (size_t)(gg * 128) * DM + 256 * T + n;
            float a[32];
#pragma unroll
            for (int j = 0; j < 32; ++j) a[j] = 0.f;
#pragma unroll 2
            for (int c = 0; c < 128; c += 4) {
                const float u0 = UD[(size_t)c * DM] * SC[c], u1 = UD[(size_t)(c + 1) * DM] * SC[c + 1], u2 = UD[(size_t)(c + 2) * DM] * SC[c + 2], u3 = UD[(size_t)(c + 3) * DM] * SC[c + 3];
#pragma unroll
                for (int j = 0; j < 32; ++j) { const f32x4 p = *(const LAS f32x4*)(pw + (32 * half + j) * 128 + c); a[j] += (p[0] * u0 + p[1] * u1) + (p[2] * u2 + p[3] * u3); }
            }
#pragma unroll
            for (int j = 0; j < 32; ++j) tile[(32 * half + j) * PB_P + 33 * (n >> 5) + (n & 31)] = a[j];
            pblk_writeout(lds, wl + WE_UPCAT + ((size_t)T * (YK / 64) + YO_D / 64 + kb) * 16384, YK, 1, tid);
        }
    }
}
constexpr int DEFER_WG0 = 96, DEFER_WGS = 160, DEFER_PER_WG = 9, DEFER_N = (DEFER_WGS * DEFER_PER_WG < 1376) ? DEFER_WGS * DEFER_PER_WG : 1376;
constexpr int TAIL_WGS = 224, TAIL_N = 568;
constexpr int DEFER_X = 224;
static_assert(DEFER_N == 1376, "the slot list jumps from the end of a gate|up matrix to a down matrix");
__device__ __forceinline__ bool pblk_deferred(int blk) {
    const int l = blk / PB_LAYER, r = blk % PB_LAYER;
    if (r < 1376) return l >= 1 && r < DEFER_N;
    if (r < 2 * 1376) return (r - 1376) < DEFER_N;
    if (r < 2 * 1376 + 688) return l >= 1 && (r - 2 * 1376) < DEFER_X;
    if (r < 2 * 1376 + 2 * 688) return (r - 2 * 1376 - 688) < DEFER_X;
    return l >= 1;
}
__device__ __forceinline__ bool pblk_special(int blk) {
    int r = blk % PB_LAYER - (2 * 1376 + 2 * 688);
    if (r < 0) return false;
    if (r < 1792) return (r % 56) == T_Z;
    r -= 1792 + 64 + 32 + 64; return r >= 0 && r < 64;
}
#define PB_BLK(i) (first + (i) + ((i) >= jump_at ? jump : 0))
#define PB_NEXT(I) { while (cand < count && ((skip_deferred && pblk_deferred(PB_BLK(cand))) || pblk_special(PB_BLK(cand)))) cand += stride; I = cand < count ? cand : -1; cand += stride; }
#define PB_LOAD(D, V, GV, I) { const int li_ = (I) >= 0 ? (I) : i0; pblk_decode(lds, WB, PB_BLK(li_), wave, lane, D); if ((I) < 0) { D.src = dummy; D.ldw = 0; } pblk_load(D, V, GV); }
#define PB_STEP(CUR, VCUR, GCUR, INEXT, NXT2, VNXT2, GNXT2, INXT2) { PB_NEXT(INXT2); \
        PB_LOAD(NXT2, VNXT2, GNXT2, INXT2) \
        pblk_finish<MODE>(lds, CUR, VCUR, GCUR, tid); \
        if (INEXT < 0) break; }
template <int MODE = 0>
__device__ __forceinline__ void prologue_blocks(LAS unsigned char* lds, bf16* WB, int first, int count, int start, int stride, int tid, bool skip_deferred, int jump_at = 0x7fffffff, int jump = 0) {
    const int lane = tid & 63, wave = __builtin_amdgcn_readfirstlane(tid >> 6);
    BDesc A, B, C; f32x4 va[8], vb[8], vc[8], ga[2], gb[2], gc[2];
    int cand = start, ia, ib, ic;
    PB_NEXT(ia); if (ia < 0) return;
    const int i0 = ia; const float* dummy = ldp(lds, 8) + 4 * lane;
    PB_LOAD(A, va, ga, ia)
    PB_NEXT(ib);
    PB_LOAD(B, vb, gb, ib)
#pragma unroll 1
    for (;;) {
        PB_STEP(A, va, ga, ib, C, vc, gc, ic)
        PB_STEP(B, vb, gb, ic, A, va, ga, ia)
        PB_STEP(C, vc, gc, ia, B, vb, gb, ib)
    }
}
#undef PB_STEP
#undef PB_LOAD
#undef PB_NEXT
#undef PB_BLK

__device__ __forceinline__ void x_init_pass(const float* xp, const float* xs, bf16* XB, unsigned long long* ss0, int gw, int NGW, int lane) {
    for (int row = gw; row < MPAD; row += NGW) {
        u32x2* o = (u32x2*)(XB + (size_t)row * DM) + lane;
        if (row < MP) {
            const int R = row & 127, C = 4 * (lane & 15);
            o = (u32x2*)((char*)XB + ((size_t)((row >> 8) * (DM / 64) + (lane >> 4)) * 2 + ((row >> 7) & 1)) * 16384 + pg8::lds_byte(R, C));
        }
        const int ostep = row < MP ? 4 * 32768 / 8 : 64;
        if (row >= MR) {
#pragma unroll
            for (int j = 0; j < 8; ++j) { u32x2 z; z.x = 0u; z.y = 0u; o[ostep * j] = z; }
            continue;
        }
        const f32x4* xr = (const f32x4*)(row < MP ? xp + (size_t)row * DM : xs + (size_t)(row - MP) * DM) + lane;
        float ss = 0.f;
#pragma unroll
        for (int j = 0; j < 8; ++j) { const f32x4 v = xr[64 * j]; u32x2 w; w.x = pk2(v[0], v[1]); w.y = pk2(v[2], v[3]); o[ostep * j] = w;
            const float a0 = bflo(w.x), a1 = bfhi(w.x), a2 = bflo(w.y), a3 = bfhi(w.y); ss += (a0 * a0 + a1 * a1) + (a2 * a2 + a3 * a3); }
        ss = wave_sum(ss, lane);
        if (lane == 0) ss0[row] = (unsigned long long)(ss * SS_FIX + 0.5f);
    }
}

constexpr int CC_N0 = DEPTH * NB_S * (128 - TS) * 128, CC_N1 = DEPTH * NB_S * (512 - TS) * 128, CC_N2 = DEPTH * NB_S * (2048 - TS) * 128, CACHE_COPY_N = CC_N0 + CC_N1 + CC_N2;
__device__ __forceinline__ void cache_copy_range(const float* c128, const float* c512, const float* c2048, float* out, int i0, int i1, int t, int nt) {
    for (int i = i0 + t; i < i1; i += nt) {
        int ii = i, gi = 0;
        if (ii >= CC_N0) { ii -= CC_N0; gi = 1; if (ii >= CC_N1) { ii -= CC_N1; gi = 2; } }
        const int W = win_of(gi), per = (W - TS) * 128, lb = ii / per, j = ii - lb * per;
        const f32x4* src = (const f32x4*)(gi == 0 ? c128 : (gi == 1 ? c512 : c2048)); f32x4* dst = (f32x4*)(out + offw_s(gi));
        __builtin_nontemporal_store(__builtin_nontemporal_load(src + (size_t)lb * W * 128 + TS * 128 + j), dst + (size_t)lb * W * 128 + j);
    }
}

__device__ __forceinline__ s16x4 ds_tr16(const LAS unsigned char* p) { return __builtin_amdgcn_ds_read_tr16_b64_v4i16((LAS s16x4*)p); }
__device__ __forceinline__ bf16x8 cat4(s16x4 a, s16x4 b) { bf16x8 r; r[0] = a[0]; r[1] = a[1]; r[2] = a[2]; r[3] = a[3]; r[4] = b[0]; r[5] = b[1]; r[6] = b[2]; r[7] = b[3]; return r; }
__device__ __forceinline__ bf16x8 pk8v(f32x4 a, f32x4 b) { const u32x4 w = pk8(a, b); return __builtin_bit_cast(bf16x8, w); }

constexpr int ATT_UNITS = NB_P * 12 * 32;
constexpr int ATT_PITCH = 144;
__device__ __forceinline__ void attn_unit(LAS unsigned char* lds, const bf16* Q, const bf16* K, const bf16* V, float* AO, float* LSE, int unit, int tid) {
    const int lane = tid & 63, w = tid >> 6, fr = lane & 15, g = lane >> 4;
    const int blk = unit & 31, bh = unit >> 5, h = bh % 12, b = bh / 12;
    const int gi = h >> 2, dl = dil_of(gi);
    const int r = blk % dl, nb = blk / dl;
    LAS unsigned char* Ks = lds; LAS unsigned char* Vs = lds + 256 * ATT_PITCH;
    for (int c = tid; c < 2048; c += NTHR) {
        const int ki = c >> 3, ch = c & 7, ksub = nb * 128 + ki - 128;
        u32x4 kv = {0u, 0u, 0u, 0u}, vv = {0u, 0u, 0u, 0u};
        if (ksub >= 0) { const size_t off = (size_t)(b * SEQ + r + dl * ksub) * 768 + h * 64 + ch * 8; kv = *(const u32x4*)(K + off); vv = *(const u32x4*)(V + off); }
        *(LAS u32x4*)(Ks + ki * ATT_PITCH + ch * 16) = kv; *(LAS u32x4*)(Vs + ki * ATT_PITCH + ch * 16) = vv;
    }
    __syncthreads();
    const int qi = 16 * w + fr;
    const int qtok = b * SEQ + r + dl * (nb * 128 + qi);
    const bf16x8 q0 = *(const bf16x8*)(Q + (size_t)qtok * 768 + h * 64 + 8 * g), q1 = *(const bf16x8*)(Q + (size_t)qtok * 768 + h * 64 + 32 + 8 * g);
    const int ks0 = w >> 1;
    f32x4 s[10];
#pragma unroll
    for (int tt = 0; tt < 10; ++tt) {
        const int T = 2 * ks0 + tt;
        const LAS unsigned char* kp = Ks + (16 * T + fr) * ATT_PITCH + 16 * g;
        const bf16x8 k0 = *(const LAS bf16x8*)kp, k1 = *(const LAS bf16x8*)(kp + 64);
        f32x4 a = {0.f, 0.f, 0.f, 0.f};
        a = __builtin_amdgcn_mfma_f32_16x16x32_bf16(k0, q0, a, 0, 0, 0);
        a = __builtin_amdgcn_mfma_f32_16x16x32_bf16(k1, q1, a, 0, 0, 0);
        s[tt] = a;
    }
    const float slope = exp2f(-8.0f * (float)(h + 1) / 12.0f) * (float)dl;
    float mx = -INFINITY;
#pragma unroll
    for (int tt = 0; tt < 10; ++tt)
#pragma unroll
        for (int j = 0; j < 4; ++j) {
            const int ki = 16 * (2 * ks0 + tt) + 4 * g + j, dist = qi - ki + 128, ksub = nb * 128 + ki - 128;
            const bool valid = (dist >= 0) && (dist <= 128) && (ksub >= 0);
            const float v = s[tt][j] * 0.125f - slope * (float)dist;
            s[tt][j] = valid ? v : -INFINITY;
            mx = fmaxf(mx, s[tt][j]);
        }
    mx = fmaxf(mx, shx(mx, 16, lane)); mx = fmaxf(mx, shx(mx, 32, lane));
    float ls = 0.f;
#pragma unroll
    for (int tt = 0; tt < 10; ++tt)
#pragma unroll
        for (int j = 0; j < 4; ++j) { const float p = __expf(s[tt][j] - mx); s[tt][j] = p; ls += p; }
    ls += shx(ls, 16, lane); ls += shx(ls, 32, lane);
    f32x4 o[4];
#pragma unroll
    for (int et = 0; et < 4; ++et) o[et] = (f32x4){0.f, 0.f, 0.f, 0.f};
    const int q4 = fr >> 2, p4 = fr & 3;
#pragma unroll
    for (int kk = 0; kk < 5; ++kk) {
        const bf16x8 pb = pk8v(s[2 * kk], s[2 * kk + 1]);
        const int rb = 32 * (ks0 + kk) + 4 * g + q4;
#pragma unroll
        for (int et = 0; et < 4; ++et) {
            const s16x4 v0 = ds_tr16(Vs + rb * ATT_PITCH + (16 * et + 4 * p4) * 2);
            const s16x4 v1 = ds_tr16(Vs + (rb + 16) * ATT_PITCH + (16 * et + 4 * p4) * 2);
            o[et] = __builtin_amdgcn_mfma_f32_16x16x32_bf16(cat4(v0, v1), pb, o[et], 0, 0, 0);
        }
    }
    const float inv = 1.0f / ls;
    float* ao = AO + (size_t)qtok * 768 + h * 64 + 4 * g;
#pragma unroll
    for (int et = 0; et < 4; ++et) *(f32x4*)(ao + 16 * et) = o[et] * inv;
    if (g == 0) LSE[(size_t)qtok * 12 + h] = mx + __logf(ls);
    __syncthreads();
}

__device__ __forceinline__ void attn_merge_pass(const float* AO, const float* LSE, bf16* YB, int gt, int NGT, int rep = 1) {
    for (int it0 = gt; it0 < rep * MR * 4 * 16; it0 += NGT) {
        const int it = it0 % (MR * 4 * 16);
        const int e4 = it & 15, slot = (it >> 4) & 3, tok = it >> 6;
        const float l0 = LSE[(size_t)tok * 12 + slot], l1 = LSE[(size_t)tok * 12 + 4 + slot], l2 = LSE[(size_t)tok * 12 + 8 + slot];
        const float m = fmaxf(l0, fmaxf(l1, l2));
        const float w0 = __expf(l0 - m), w1 = __expf(l1 - m), w2 = __expf(l2 - m), inv = 1.0f / (w0 + w1 + w2);
        const float* a = AO + (size_t)tok * 768 + slot * 64 + e4 * 4;
        const f32x4 y = (*(const f32x4*)a * w0 + *(const f32x4*)(a + 256) * w1 + *(const f32x4*)(a + 512) * w2) * inv;
        u32x2 wv; wv.x = pk2(y[0], y[1]); wv.y = pk2(y[2], y[3]);
        *(u32x2*)(YB + (size_t)tok * YK + YO_B + slot * 64 + e4 * 4) = wv;
    }
}

__device__ __forceinline__ float dot64_f32(const float (&q)[64], const float* k) {
    float s = 0.f;
#pragma unroll
    for (int c = 0; c < 16; ++c) { const f32x4 kv = ((const f32x4*)k)[c]; s += (q[4 * c] * kv[0] + q[4 * c + 1] * kv[1]) + (q[4 * c + 2] * kv[2] + q[4 * c + 3] * kv[3]); }
    return s;
}
__device__ __forceinline__ float dot64_bf(const float (&q)[64], const bf16* k) {
    float s = 0.f;
#pragma unroll
    for (int c = 0; c < 8; ++c) { const u32x4 w = ((const u32x4*)k)[c];
        s += (q[8 * c] * bflo(w.x) + q[8 * c + 1] * bfhi(w.x)) + (q[8 * c + 2] * bflo(w.y) + q[8 * c + 3] * bfhi(w.y)) + (q[8 * c + 4] * bflo(w.z) + q[8 * c + 5] * bfhi(w.z)) + (q[8 * c + 6] * bflo(w.w) + q[8 * c + 7] * bfhi(w.w)); }
    return s;
}
__device__ __forceinline__ void attn_sample_wave(const bf16* Q, const bf16* K, const bf16* V, const float* c128, const float* c512, const float* c2048, float* AO, float* LSE, int layer, int unit, int lane) {
    const int h = unit % 12, bt = unit / 12, t = bt & 3, b = bt >> 2;
    const int row = MP + b * TS + t;
    const int gi = h >> 2, slot = h & 3, dl = dil_of(gi), W = win_of(gi);
    const float* cache = (gi == 0 ? c128 : (gi == 1 ? c512 : c2048)) + (size_t)(layer * NB_S + b) * W * 512;
    float qf[64];
    { const u32x4* qp = (const u32x4*)(Q + (size_t)row * 768 + h * 64);
#pragma unroll
      for (int c = 0; c < 8; ++c) { const u32x4 w = qp[c]; qf[8 * c] = bflo(w.x) * 0.125f; qf[8 * c + 1] = bfhi(w.x) * 0.125f; qf[8 * c + 2] = bflo(w.y) * 0.125f; qf[8 * c + 3] = bfhi(w.y) * 0.125f;
          qf[8 * c + 4] = bflo(w.z) * 0.125f; qf[8 * c + 5] = bfhi(w.z) * 0.125f; qf[8 * c + 6] = bflo(w.w) * 0.125f; qf[8 * c + 7] = bfhi(w.w) * 0.125f; } }
    const float slope = exp2f(-8.0f * (float)(h + 1) / 12.0f) * (float)dl;
    float sc[3];
#pragma unroll
    for (int sj = 0; sj < 3; ++sj) {
        const int j = lane + 64 * sj;
        float d = -INFINITY;
        if (j <= 128) {
            const int idx = W + t - j * dl;
            if (idx >= W) d = dot64_bf(qf, K + (size_t)(MP + b * TS + (idx - W)) * 768 + h * 64);
            else d = dot64_f32(qf, cache + ((size_t)idx * 2 + 0) * 256 + slot * 64);
            d -= slope * (float)j;
        }
        sc[sj] = d;
    }
    const float mg = wave_max(fmaxf(sc[0], fmaxf(sc[1], sc[2])), lane);
    const float p0 = __expf(sc[0] - mg), p1 = __expf(sc[1] - mg), p2 = __expf(sc[2] - mg);
    const float lg = wave_sum(p0 + p1 + p2, lane);
    float acc = 0.f;
    const int jstart = (dl == 1) ? t + 1 : 1;
#pragma unroll 1
    for (int j = 0; j < jstart; ++j) acc += rdl(p0, j) * bf2f(V[(size_t)(MP + b * TS + (t - j * dl)) * 768 + h * 64 + lane]);
    const float* vbase = cache + 256 + slot * 64 + lane;
#pragma unroll 1
    for (int j0 = jstart; j0 <= 128; j0 += 32) {
        float vv[32];
#pragma unroll
        for (int i = 0; i < 32; ++i) { const int j = (j0 + i <= 128) ? j0 + i : 128; vv[i] = vbase[(size_t)(W + t - j * dl) * 512]; }
#pragma unroll
        for (int i = 0; i < 32; ++i) { const int j = j0 + i; const float pj = (j <= 128) ? rdl(j < 64 ? p0 : (j < 128 ? p1 : p2), j & 63) : 0.f; acc += pj * vv[i]; }
    }
    AO[(size_t)row * 768 + h * 64 + lane] = acc / lg;
    if (lane == 0) LSE[(size_t)row * 12 + h] = mg + __logf(lg);
}

__device__ __forceinline__ void conv_pool_pass(const bf16* CB, const bf16* U, const bf16* PIN, const float* conv_w, const float* st_conv, const float* st_pool, bf16* YA, bf16* YD, int layer, int gt, int NGT, int rep = 1) {
    for (int it0 = gt; it0 < rep * MPAD * 64; it0 += NGT) {
        const int it = it0 % (MPAD * 64); const int c8 = it & 63, row = it >> 6, ch = c8 * 8;
        int kind, b, t; row_decode(row, kind, b, t);
        if (kind == 2) { const u32x4 z = {0u, 0u, 0u, 0u}; *(u32x4*)(YA + (size_t)row * YK + YO_A + ch) = z; *(u32x4*)(YD + (size_t)row * YK + YO_D + ch) = z; continue; }
        float u0[8], u1[8], u2[8], cb[8];
        unpk8(*(const u32x4*)(U + (size_t)row * 512 + ch), u2);
        if (t >= 1) unpk8(*(const u32x4*)(U + (size_t)(row - 1) * 512 + ch), u1);
        else if (kind == 1) { const float* s = st_conv + ((size_t)(layer * NB_S + b) * 2 + 1) * 512 + ch; _Pragma("unroll") for (int j = 0; j < 8; ++j) u1[j] = s[j]; }
        else { _Pragma("unroll") for (int j = 0; j < 8; ++j) u1[j] = 0.f; }
        if (t >= 2) unpk8(*(const u32x4*)(U + (size_t)(row - 2) * 512 + ch), u0);
        else if (kind == 1) { const float* s = st_conv + ((size_t)(layer * NB_S + b) * 2 + t) * 512 + ch; _Pragma("unroll") for (int j = 0; j < 8; ++j) u0[j] = s[j]; }
        else { _Pragma("unroll") for (int j = 0; j < 8; ++j) u0[j] = 0.f; }
        unpk8(*(const u32x4*)(CB + (size_t)row * 512 + ch), cb);
        const float* cw = conv_w + (size_t)layer * 3 * 512 + ch;
        f32x4 ya0, ya1;
#pragma unroll
        for (int j = 0; j < 8; ++j) { const float z = cw[j] * u0[j] + cw[512 + j] * u1[j] + cw[1024 + j] * u2[j]; const float y = cb[j] * z; if (j < 4) ya0[j] = y; else ya1[j - 4] = y; }
        *(u32x4*)(YA + (size_t)row * YK + YO_A + ch) = pk8(ya0, ya1);
        const int grp = c8 >> 4, w = 2 << grp;
        float cur[8], sum[8];
        unpk8(*(const u32x4*)(PIN + (size_t)row * 512 + ch), cur);
#pragma unroll
        for (int j = 0; j < 8; ++j) sum[j] = cur[j];
        if (kind == 0) {
            u32x4 xr[15];
#pragma unroll
            for (int i = 1; i < 16; ++i) { const bool ok = (i < w) && (t - i >= 0); xr[i - 1] = *(const u32x4*)(PIN + (size_t)(ok ? row - i : row) * 512 + ch); }
#pragma unroll
            for (int i = 1; i < 16; ++i) { const bool ok = (i < w) && (t - i >= 0); float x[8]; unpk8(xr[i - 1], x); const float m = ok ? 1.f : 0.f;
#pragma unroll
                for (int j = 0; j < 8; ++j) sum[j] += m * x[j]; }
        } else {
            for (int i = 1; i < w; ++i) {
                const int tt = t - i;
                if (tt >= 0) { float x[8]; unpk8(*(const u32x4*)(PIN + (size_t)(row - i) * 512 + ch), x); _Pragma("unroll") for (int j = 0; j < 8; ++j) sum[j] += x[j]; }
                else { const float* s = st_pool + ((size_t)(layer * NB_S + b) * 15 + (15 + tt)) * 512 + ch; _Pragma("unroll") for (int j = 0; j < 8; ++j) sum[j] += s[j]; }
            }
        }
        const float cnt = (kind == 1) ? (float)w : fminf((float)w, (float)(t + 1));
        const float ic = 1.0f / cnt;
        f32x4 d0, d1;
#pragma unroll
        for (int j = 0; j < 8; ++j) { const float d = sum[j] * ic - cur[j]; if (j < 4) d0[j] = d; else d1[j - 4] = d; }
        *(u32x4*)(YD + (size_t)row * YK + YO_D + ch) = pk8(d0, d1);
    }
}

constexpr int GLA_UNITS = NB_P * 4 * 64;
constexpr int GP_K = 144, GP_V = 272;
constexpr int GLA_R0 = 0, GLA_R0_BYTES = 17408, GLA_QT = GLA_R0 + GLA_R0_BYTES, GLA_KT = GLA_QT + 64 * GP_K, GLA_VV = GLA_KT + 64 * GP_K, GLA_HALF = GLA_VV + 64 * GP_V;
static_assert(2 * GLA_HALF <= RING_BYTES, "GLA LDS");

__device__ __forceinline__ void gla_cumsum(LAS float* lb, const float* LA, int tok0, int h, int ht) {
    const int k = ht & 63, q = ht >> 6;
    float v[16]; float run = 0.f;
#pragma unroll
    for (int i = 0; i < 16; ++i) { run += LA[(size_t)(tok0 + 16 * q + i) * 256 + h * 64 + k]; v[i] = run; }
    LAS float* tot = lb + 4096;
    tot[q * 64 + k] = run;
    __syncthreads();
    float off = 0.f;
#pragma unroll
    for (int qq = 0; qq < 3; ++qq) off += (qq < q) ? tot[qq * 64 + k] : 0.f;
#pragma unroll
    for (int i = 0; i < 16; ++i) lb[(16 * q + i) * 64 + k] = v[i] + off;
    __syncthreads();
}

__device__ __forceinline__ void gla_ds_unit(LAS unsigned char* hl, const bf16* GK, const bf16* GV, const float* LA, float* DS, float* DEC, int unit, int ht) {
    const int n = unit & 63, bh = unit >> 6, h = bh & 3, b = bh >> 2;
    const int tok0 = b * SEQ + n * 64;
    const int lane = ht & 63, hw = ht >> 6, fr = lane & 15, g = lane >> 4;
    LAS float* lb = (LAS float*)(hl + GLA_R0);
    gla_cumsum(lb, LA, tok0, h, ht);
    for (int c = ht; c < 512; c += 256) {
        const int s = c >> 3, k0 = (c & 7) * 8;
        float kf[8]; unpk8(*(const u32x4*)(GK + (size_t)(tok0 + s) * 256 + h * 64 + k0), kf);
        f32x4 a0, a1;
#pragma unroll
        for (int j = 0; j < 8; ++j) { const float e = kf[j] * __expf(lb[63 * 64 + k0 + j] - lb[s * 64 + k0 + j]); if (j < 4) a0[j] = e; else a1[j - 4] = e; }
        *(LAS u32x4*)(hl + GLA_KT + s * GP_K + k0 * 2) = pk8(a0, a1);
    }
    for (int c = ht; c < 1024; c += 256) {
        const int s = c >> 4, v0 = (c & 15) * 8;
        *(LAS u32x4*)(hl + GLA_VV + s * GP_V + v0 * 2) = *(const u32x4*)(GV + (size_t)(tok0 + s) * 512 + h * 128 + v0);
    }
    if (ht < 64) DEC[(size_t)unit * 64 + ht] = __expf(lb[63 * 64 + ht]);
    __syncthreads();
    const int q4 = fr >> 2, p4 = fr & 3, kt = hw;
    float* dsb = DS + (size_t)unit * 64 * 128;
#pragma unroll
    for (int dvt = 0; dvt < 8; ++dvt) {
        f32x4 acc = {0.f, 0.f, 0.f, 0.f};
#pragma unroll
        for (int ks = 0; ks < 2; ++ks) {
            const int rb = 32 * ks + 4 * g + q4;
            const bf16x8 af = cat4(ds_tr16(hl + GLA_KT + rb * GP_K + (16 * kt + 4 * p4) * 2), ds_tr16(hl + GLA_KT + (rb + 16) * GP_K + (16 * kt + 4 * p4) * 2));
            const bf16x8 bf = cat4(ds_tr16(hl + GLA_VV + rb * GP_V + (16 * dvt + 4 * p4) * 2), ds_tr16(hl + GLA_VV + (rb + 16) * GP_V + (16 * dvt + 4 * p4) * 2));
            acc = __builtin_amdgcn_mfma_f32_16x16x32_bf16(af, bf, acc, 0, 0, 0);
        }
#pragma unroll
        for (int j = 0; j < 4; ++j) dsb[(size_t)(16 * kt + 4 * g + j) * 128 + 16 * dvt + fr] = acc[j];
    }
    __syncthreads();
}

__device__ __forceinline__ void gla_scan_pass(const float* DS, const float* DEC, bf16* SP, float* out, int layer, int gt, int rep = 1) {
    if (gt >= 8 * 64 * 128) return;
    for (int rr = 0; rr < rep; ++rr) {
    const int v = gt & 127, k = (gt >> 7) & 63, bh = gt >> 13;
    float S = 0.f;
    for (int n0 = 0; n0 < 64; n0 += 32) {
        float d[32], a[32];
#pragma unroll
        for (int i = 0; i < 32; ++i) { d[i] = DS[(((size_t)bh * 64 + n0 + i) * 64 + k) * 128 + v]; a[i] = DEC[((size_t)bh * 64 + n0 + i) * 64 + k]; }
#pragma unroll
        for (int i = 0; i < 32; ++i) { SP[(((size_t)bh * 64 + n0 + i) * 64 + k) * 128 + v] = (bf16)f2bf(S); S = a[i] * S + d[i]; }
    }
    out[OFF_GLA_P + (((size_t)layer * 8 + bh) * 64 + k) * 128 + v] = S;
    }
}

__device__ __forceinline__ void gla_out_unit(LAS unsigned char* hl, const bf16* GQ, const bf16* GK, const bf16* GV, const bf16* GR, const float* LA, const bf16* SP, const float* gnorm, bf16* YC, int unit, int ht) {
    const int n = unit & 63, bh = unit >> 6, h = bh & 3, b = bh >> 2;
    const int tok0 = b * SEQ + n * 64;
    const int lane = ht & 63, hw = ht >> 6, fr = lane & 15, g = lane >> 4;
    LAS float* lb = (LAS float*)(hl + GLA_R0);
    gla_cumsum(lb, LA, tok0, h, ht);
    for (int c = ht; c < 512; c += 256) {
        const int s = c >> 3, k0 = (c & 7) * 8;
        float qf[8], kf[8];
        unpk8(*(const u32x4*)(GQ + (size_t)(tok0 + s) * 256 + h * 64 + k0), qf);
        unpk8(*(const u32x4*)(GK + (size_t)(tok0 + s) * 256 + h * 64 + k0), kf);
        f32x4 a0, a1, c0, c1;
#pragma unroll
        for (int j = 0; j < 8; ++j) { const float bb = lb[s * 64 + k0 + j]; const float qe = qf[j] * __expf(bb), ke = kf[j] * __expf(-bb); if (j < 4) { a0[j] = qe; c0[j] = ke; } else { a1[j - 4] = qe; c1[j - 4] = ke; } }
        *(LAS u32x4*)(hl + GLA_QT + s * GP_K + k0 * 2) = pk8(a0, a1);
        *(LAS u32x4*)(hl + GLA_KT + s * GP_K + k0 * 2) = pk8(c0, c1);
    }
    for (int c = ht; c < 1024; c += 256) {
        const int s = c >> 4, v0 = (c & 15) * 8;
        *(LAS u32x4*)(hl + GLA_VV + s * GP_V + v0 * 2) = *(const u32x4*)(GV + (size_t)(tok0 + s) * 512 + h * 128 + v0);
    }
    __syncthreads();
    for (int c = ht; c < 1024; c += 256) {
        const int k = c >> 4, v0 = (c & 15) * 8;
        *(LAS u32x4*)(hl + GLA_R0 + k * GP_V + v0 * 2) = *(const u32x4*)(SP + ((size_t)unit * 64 + k) * 128 + v0);
    }
    __syncthreads();
    const int tt = hw, q4 = fr >> 2, p4 = fr & 3;
    f32x4 at[4];
    const LAS unsigned char* qrow = hl + GLA_QT + (16 * tt + fr) * GP_K;
    const bf16x8 qb0 = *(const LAS bf16x8*)(qrow + 16 * g), qb1 = *(const LAS bf16x8*)(qrow + 64 + 16 * g);
#pragma unroll
    for (int st = 0; st < 4; ++st) {
        const LAS unsigned char* krow = hl + GLA_KT + (16 * st + fr) * GP_K;
        f32x4 a = {0.f, 0.f, 0.f, 0.f};
        a = __builtin_amdgcn_mfma_f32_16x16x32_bf16(*(const LAS bf16x8*)(krow + 16 * g), qb0, a, 0, 0, 0);
        a = __builtin_amdgcn_mfma_f32_16x16x32_bf16(*(const LAS bf16x8*)(krow + 64 + 16 * g), qb1, a, 0, 0, 0);
#pragma unroll
        for (int j = 0; j < 4; ++j) { const int s = 16 * st + 4 * g + j, t = 16 * tt + fr; a[j] = (s <= t) ? a[j] : 0.f; }
        at[st] = a;
    }
    f32x4 o[8];
#pragma unroll
    for (int dvt = 0; dvt < 8; ++dvt) o[dvt] = (f32x4){0.f, 0.f, 0.f, 0.f};
#pragma unroll
    for (int ks = 0; ks < 2; ++ks) {
        const bf16x8 pb = pk8v(at[2 * ks], at[2 * ks + 1]);
        const int rb = 32 * ks + 4 * g + q4;
        const s16x4 qa = *(const LAS s16x4*)(qrow + (32 * ks + 4 * g) * 2), qc = *(const LAS s16x4*)(qrow + (32 * ks + 16 + 4 * g) * 2);
        const bf16x8 qp = cat4(qa, qc);
#pragma unroll
        for (int dvt = 0; dvt < 8; ++dvt) {
            const bf16x8 vf = cat4(ds_tr16(hl + GLA_VV + rb * GP_V + (16 * dvt + 4 * p4) * 2), ds_tr16(hl + GLA_VV + (rb + 16) * GP_V + (16 * dvt + 4 * p4) * 2));
            o[dvt] = __builtin_amdgcn_mfma_f32_16x16x32_bf16(vf, pb, o[dvt], 0, 0, 0);
            const bf16x8 sf = cat4(ds_tr16(hl + GLA_R0 + rb * GP_V + (16 * dvt + 4 * p4) * 2), ds_tr16(hl + GLA_R0 + (rb + 16) * GP_V + (16 * dvt + 4 * p4) * 2));
            o[dvt] = __builtin_amdgcn_mfma_f32_16x16x32_bf16(sf, qp, o[dvt], 0, 0, 0);
        }
    }
    float ss = 0.f;
#pragma unroll
    for (int dvt = 0; dvt < 8; ++dvt) ss += (o[dvt][0] * o[dvt][0] + o[dvt][1] * o[dvt][1]) + (o[dvt][2] * o[dvt][2] + o[dvt][3] * o[dvt][3]);
    ss += shx(ss, 16, lane); ss += shx(ss, 32, lane);
    const float rs = rsqrtf(ss * (1.0f / 128.0f) + EPS);
    const size_t orow = (size_t)(tok0 + 16 * tt + fr) * 512 + h * 128, yrow = (size_t)(tok0 + 16 * tt + fr) * YK + YO_C + h * 128;
#pragma unroll
    for (int dvt = 0; dvt < 8; ++dvt) {
        const int dv = 16 * dvt + 4 * g;
        const f32x4 gn = *(const f32x4*)(gnorm + dv);
        const u32x2 gw = *(const u32x2*)(GR + orow + dv);
        f32x4 y; y[0] = o[dvt][0] * rs * gn[0] * bflo(gw.x); y[1] = o[dvt][1] * rs * gn[1] * bfhi(gw.x); y[2] = o[dvt][2] * rs * gn[2] * bflo(gw.y); y[3] = o[dvt][3] * rs * gn[3] * bfhi(gw.y);
        u32x2 wv; wv.x = pk2(y[0], y[1]); wv.y = pk2(y[2], y[3]);
        *(u32x2*)(YC + yrow + dv) = wv;
    }
    __syncthreads();
}

__device__ __forceinline__ void gla_sample_unit(LAS float* red, const bf16* GQ, const bf16* GK, const bf16* GV, const bf16* GR, const float* LA, const float* st_gla, const float* gnorm, bf16* YC, float* out, int layer, int unit, int tid) {
    const int h = unit & 3, b = unit >> 2;
    const int dv = tid & 127, kq = tid >> 7;
    const float* s0 = st_gla + (((size_t)(layer * NB_S + b) * 4 + h) * 64 + 16 * kq) * 128 + dv;
    float S[16];
#pragma unroll
    for (int i = 0; i < 16; ++i) S[i] = s0[(size_t)i * 128];
#pragma unroll 1
    for (int t = 0; t < TS; ++t) {
        const int row = MP + b * TS + t;
        const float vv = bf2f(GV[(size_t)row * 512 + h * 128 + dv]);
        float po = 0.f;
#pragma unroll
        for (int i = 0; i < 16; ++i) {
            const int k = 16 * kq + i;
            const float a = __expf(LA[(size_t)row * 256 + h * 64 + k]);
            S[i] = a * S[i] + bf2f(GK[(size_t)row * 256 + h * 64 + k]) * vv;
            po += bf2f(GQ[(size_t)row * 256 + h * 64 + k]) * S[i];
        }
        red[kq * 128 + dv] = po;
        __syncthreads();
        float o = 0.f, sq = 0.f;
        if (kq == 0) { o = (red[dv] + red[128 + dv]) + (red[256 + dv] + red[384 + dv]); sq = o * o; }
        sq = wave_sum(sq, tid & 63);
        if (kq == 0 && (tid & 63) == 0) red[512 + (tid >> 6)] = sq;
        __syncthreads();
        if (kq == 0) {
            const float rs = rsqrtf((red[512] + red[513]) * (1.0f / 128.0f) + EPS);
            const float y = o * rs * gnorm[dv] * bf2f(GR[(size_t)row * 512 + h * 128 + dv]);
            YC[(size_t)row * YK + YO_C + h * 128 + dv] = (bf16)f2bf(y);
        }
        __syncthreads();
    }
    float* so = out + OFF_GLA_S + (((size_t)(layer * NB_S + b) * 4 + h) * 64 + 16 * kq) * 128 + dv;
#pragma unroll
    for (int i = 0; i < 16; ++i) so[(size_t)i * 128] = S[i];
}

constexpr int PH_PER_LAYER = 13, NPH = 1 + DEPTH * PH_PER_LAYER;
#define RM(bit) (1 + ((PROBE_DUP >> (bit)) & 1))
#define REP(bit) for (int rep_ = 0; rep_ < 1 + ((PROBE_DUP >> (bit)) & 1); ++rep_)
#ifndef PROBE_SP2
#define PROBE_SP2 true
#endif
#ifndef PROBE_ALIGN_GU
#define PROBE_ALIGN_GU true
#endif
#ifndef PROBE_ALIGN_RES
#define PROBE_ALIGN_RES true
#endif
#ifndef PROBE_ALIGN_WIN
#define PROBE_ALIGN_WIN true
#endif
#ifndef MK_UNROLL_LAYERS
#define MK_UNROLL_LAYERS 1
#endif
#ifndef MK_PER_PHASE
#define MK_PER_PHASE 0
#endif

struct Args { const float* in[31]; float* out; unsigned char* ws; int ph_lo, ph_hi; };
static_assert(sizeof(Args) == 31 * 8 + 8 + 8 + 8, "Args has no padding");

__device__ __forceinline__ unsigned char* launder(unsigned char* p) { unsigned long long v = (unsigned long long)p; asm volatile("" : "+s"(v)); return (unsigned char*)(GAS unsigned char*)v; }
__device__ __forceinline__ int opq_v(int x) { asm volatile("" : "+v"(x)); return x; }
__device__ __forceinline__ int opq_s(int x) { asm volatile("" : "+s"(x)); return x; }

#define IN(k) (lo <= (k) && (k) < hi)
#define SEAM(k) do { if (IN((k) + 1)) { XcdBarrier bar_; bar_.bar = (unsigned*)(WSP() + WS_CTL) + CW_BAR; bar_.x = xb_xcc_id(); bar_.st = (volatile LAS unsigned*)(lds + MISC_OFF) + 8; REP(13) xcd_barrier(bar_, tid); } } while (0)
#define TAIL_SLOT(slot) do { if (G == 256 && bid < TAIL_WGS && l < DEPTH - 1) { unsigned char* ws_ = WSP(); \
        prologue_blocks(lds, (bf16*)(ws_ + WS_W), (l + 1) * PB_LAYER + 2 * 1376 + 2 * 688 + (slot) * TAIL_N, TAIL_N, bid, TAIL_WGS, tid, false); } } while (0)
#define GW (bid * NWAVES + wave)
#define NGW (G * NWAVES)
#define GT (bid * NTHR + tid)
#define NGT (G * NTHR)
#define WSP() launder((unsigned char*)ldp(lds, PT_WS))
#define IDS() const int wave = opq_s(wave0), lane = (int)__builtin_amdgcn_mbcnt_hi(~0u, __builtin_amdgcn_mbcnt_lo(~0u, (unsigned)opq_v(0))), tid = wave * 64 + lane, G = opq_s(G0), bid = opq_s(bid0); (void)lane; (void)wave; (void)G; (void)bid
struct Ctx { LAS unsigned char* lds; int tid0, wave0, G0, bid0, lo, hi; };
#define CTX_LOCALS() LAS unsigned char* lds = c.lds; const int tid0 = c.tid0, wave0 = c.wave0, G0 = c.G0, bid0 = c.bid0, lo = c.lo, hi = c.hi; (void)lds; (void)tid0; (void)wave0; (void)G0; (void)bid0; (void)lo; (void)hi

__device__ __forceinline__ void ff_part(const Ctx c, const int l, const int f) {
    CTX_LOCALS();
    const int pb = 1 + l * PH_PER_LAYER;
    const int fb = pb + (f ? 10 : 0);
    if (IN(fb + 1)) {
        { IDS(); unsigned char* ws = WSP(); const bf16* wl = (const bf16*)(ws + WS_W) + (size_t)l * WE_LAYER;
          pg8::Gemm g{(const bf16*)(ws + WS_XN), wl + (f ? WE_GU2 : WE_GU1), MP, NGU, DM}; pg8::StaticOrder S; S.init(MP, NGU, G, bid, RM(4));
          EpiSwiGLU E{ws, 3 * l + (f ? 2 : 0)};
          pg8::gemm_phase<EpiSwiGLU, pg8::StaticOrder, PROBE_ALIGN_GU, PROBE_SP2, true>(lds + RING_OFF, g, S, E, tid); }
        { IDS(); unsigned char* ws = WSP(); const bf16* wl = (const bf16*)(ws + WS_W) + (size_t)l * WE_LAYER; EpiSwiGLU E{ws, 3 * l + (f ? 2 : 0)};
          for (int su = G - 1 - bid; su < RM(9) * (NGU / 64); su += G) skinny_unit<EpiSwiGLU>(lds + RING_OFF, (const bf16*)(ws + WS_XN), wl + (f ? WE_GU2 : WE_GU1), DM, su % (NGU / 64), E, tid); }
        { IDS(); unsigned char* ws = WSP();
          const int dfirst = (f == 0) ? l * PB_LAYER + 1376 : (l + 1) * PB_LAYER;
          if (G == 256 && bid >= DEFER_WG0 && (f == 0 || l < DEPTH - 1)) prologue_blocks(lds, (bf16*)(ws + WS_W), dfirst, DEFER_N + DEFER_X, bid - DEFER_WG0, DEFER_WGS, tid, false, DEFER_N, (f == 0) ? 688 : 1376);
          { const int slot = 2 * l + f; const int c0 = (int)((long)CACHE_COPY_N * slot / 10), c1 = (slot == 7) ? CACHE_COPY_N : (int)((long)CACHE_COPY_N * (slot + 1) / 10);
            if (G == 256) { if (bid >= DEFER_WG0) cache_copy_range(ldp(lds, 3), ldp(lds, 4), ldp(lds, 5), (float*)ldp(lds, PT_OUT), c0, c1, (bid - DEFER_WG0) * NTHR + tid, DEFER_WGS * NTHR); }
            else cache_copy_range(ldp(lds, 3), ldp(lds, 4), ldp(lds, 5), (float*)ldp(lds, PT_OUT), c0, c1, GT, NGT); } }
        IDS();
        SEAM(fb + 1);
    }
    if (IN(fb + 2)) {
        { IDS(); unsigned char* ws = WSP(); const bf16* wl = (const bf16*)(ws + WS_W) + (size_t)l * WE_LAYER;
          pg8::Gemm g{(const bf16*)(ws + WS_H), wl + (f ? WE_D2 : WE_D1), MP, DM, DFF}; pg8::StaticOrder S; S.init(MP, DM, G, bid, RM(10));
          EpiResid E{ws, lds, 0.5f, (f == 1 && l == DEPTH - 1) ? 1 : 0, (f == 0) ? 3 * l + 1 : (l < DEPTH - 1 ? 3 * l + 3 : -1)};
          pg8::gemm_phase<EpiResid, pg8::StaticOrder, PROBE_ALIGN_RES, PROBE_SP2, true>(lds + RING_OFF, g, S, E, tid); }
        { IDS(); unsigned char* ws = WSP(); const bf16* wl = (const bf16*)(ws + WS_W) + (size_t)l * WE_LAYER; EpiResid E{ws, lds, 0.5f, (f == 1 && l == DEPTH - 1) ? 1 : 0, (f == 0) ? 3 * l + 1 : (l < DEPTH - 1 ? 3 * l + 3 : -1)};
          for (int su = G - 1 - bid; su < DM / 64; su += G) skinny_unit<EpiResid>(lds + RING_OFF, (const bf16*)(ws + WS_H), wl + (f ? WE_D2 : WE_D1), DFF, su, E, tid); }
        { IDS(); TAIL_SLOT(f ? 3 : 0); }
        IDS();
        SEAM(fb + 2);
    }
}

__device__ __forceinline__ void mixer_part(const Ctx c, const int l) {
    CTX_LOCALS();
    const int pb = 1 + l * PH_PER_LAYER;
    if (IN(pb + 4)) {
        { IDS(); unsigned char* ws = WSP(); const bf16* wl = (const bf16*)(ws + WS_W) + (size_t)l * WE_LAYER;
          pg8::Gemm g{(const bf16*)(ws + WS_XN), wl + WE_IN, MP, NWIN, DM}; pg8::StaticOrder S; S.init(MP, NWIN, G, bid, RM(3));
          EpiWin E{ws, ldp(lds, 15) + (size_t)l * 768, ldp(lds, 16) + (size_t)l * 768, ldp(lds, 18) + (size_t)l * 256, (float*)ldp(lds, PT_OUT), l, 3 * l + 1};
          pg8::gemm_phase<EpiWin, pg8::StaticOrder, PROBE_ALIGN_WIN, PROBE_SP2, true>(lds + RING_OFF, g, S, E, tid); }
        { IDS(); unsigned char* ws = WSP(); const bf16* wl = (const bf16*)(ws + WS_W) + (size_t)l * WE_LAYER;
          EpiWin E{ws, ldp(lds, 15) + (size_t)l * 768, ldp(lds, 16) + (size_t)l * 768, ldp(lds, 18) + (size_t)l * 256, (float*)ldp(lds, PT_OUT), l, 3 * l + 1};
          for (int su = G - 1 - bid; su < RM(9) * (NWIN / 64); su += G) skinny_unit<EpiWin>(lds + RING_OFF, (const bf16*)(ws + WS_XN), wl + WE_IN, DM, su % (NWIN / 64), E, tid); }
        IDS();
        SEAM(pb + 4);
    }
    if (IN(pb + 5)) {
        IDS();
        { unsigned char* ws = WSP();
          for (int u = bid; u < RM(1) * ATT_UNITS; u += G) attn_unit(lds, (const bf16*)(ws + WS_Q), (const bf16*)(ws + WS_K), (const bf16*)(ws + WS_V), (float*)(ws + WS_AO), (float*)(ws + WS_LSE), u % ATT_UNITS, tid); }
        { unsigned char* ws = WSP();
          for (int u2 = bid; u2 < RM(5) * (GLA_UNITS / 2); u2 += G) gla_ds_unit(lds + (tid >> 8) * GLA_HALF, (const bf16*)(ws + WS_GK), (const bf16*)(ws + WS_GV), (const float*)(ws + WS_LA), (float*)(ws + WS_DS), (float*)(ws + WS_DEC), 2 * (u2 % (GLA_UNITS / 2)) + (tid >> 8), tid & 255); }
        { unsigned char* ws = WSP();
          conv_pool_pass((const bf16*)(ws + WS_CB), (const bf16*)(ws + WS_U), (const bf16*)(ws + WS_PIN), ldp(lds, 14), ldp(lds, 2), ldp(lds, 7), (bf16*)(ws + WS_YCAT), (bf16*)(ws + WS_YCAT), l, GT, NGT, RM(6)); }
        REP(8) { const int su = (NGW - 1 - GW);
          if (su < NB_S * TS * 12) { unsigned char* ws = WSP(); attn_sample_wave((const bf16*)(ws + WS_Q), (const bf16*)(ws + WS_K), (const bf16*)(ws + WS_V), ldp(lds, 3), ldp(lds, 4), ldp(lds, 5), (float*)(ws + WS_AO), (float*)(ws + WS_LSE), l, su, lane); } }
        REP(8) { unsigned char* ws = WSP();
          for (int u = bid - 64; u >= 0 && u < NB_S * 4; u += G) gla_sample_unit((LAS float*)lds, (const bf16*)(ws + WS_GQ), (const bf16*)(ws + WS_GK), (const bf16*)(ws + WS_GV), (const bf16*)(ws + WS_GR), (const float*)(ws + WS_LA), ldp(lds, 6), ldp(lds, 19) + (size_t)l * 128, (bf16*)(ws + WS_YCAT), (float*)ldp(lds, PT_OUT), l, u, tid); }
        SEAM(pb + 5);
    }
    if (IN(pb + 6)) {
        IDS(); unsigned char* ws = WSP();
        gla_scan_pass((const float*)(ws + WS_DS), (const float*)(ws + WS_DEC), (bf16*)(ws + WS_SP), (float*)ldp(lds, PT_OUT), l, GT, RM(7));
        attn_merge_pass((const float*)(ws + WS_AO), (const float*)(ws + WS_LSE), (bf16*)(ws + WS_YCAT), GT, NGT, RM(7));
        SEAM(pb + 6);
    }
    if (IN(pb + 7)) {
        IDS(); unsigned char* ws = WSP();
        for (int u2 = bid; u2 < RM(5) * (GLA_UNITS / 2); u2 += G) gla_out_unit(lds + (tid >> 8) * GLA_HALF, (const bf16*)(ws + WS_GQ), (const bf16*)(ws + WS_GK), (const bf16*)(ws + WS_GV), (const bf16*)(ws + WS_GR), (const float*)(ws + WS_LA), (const bf16*)(ws + WS_SP), ldp(lds, 19) + (size_t)l * 128, (bf16*)(ws + WS_YCAT), 2 * (u2 % (GLA_UNITS / 2)) + (tid >> 8), tid & 255);
        SEAM(pb + 7);
    }
    if (IN(pb + 8)) {
        REP(11) {
        { IDS(); unsigned char* ws = WSP(); const bf16* wl = (const bf16*)(ws + WS_W) + (size_t)l * WE_LAYER; pg8::StaticOrder S; S.init(MP, DM, G, bid);
          pg8::Gemm g{(const bf16*)(ws + WS_YCAT), wl + WE_UPCAT, MP, DM, YK}; EpiMergeCat E{ws};
          pg8::gemm_phase<EpiMergeCat, pg8::StaticOrder, true, PROBE_SP2>(lds + RING_OFF, g, S, E, tid); }
        { IDS(); unsigned char* ws = WSP(); const bf16* wl = (const bf16*)(ws + WS_W) + (size_t)l * WE_LAYER; const bf16* yc = (const bf16*)(ws + WS_YCAT); const bf16* uc = wl + WE_UPCAT;
          for (int su = G - 1 - bid; su < DM / 64; su += G) skinny_merge_unit(lds + RING_OFF, ws, yc, uc, su, tid); }
        { IDS(); TAIL_SLOT(1); }
        }
        IDS();
        SEAM(pb + 8);
    }
    if (IN(pb + 9)) {
        { IDS(); unsigned char* ws = WSP(); const bf16* wl = (const bf16*)(ws + WS_W) + (size_t)l * WE_LAYER;
          pg8::Gemm g{(const bf16*)(ws + WS_MRG), wl + WE_OUT, MP, DM, DM}; pg8::StaticOrder S; S.init(MP, DM, G, bid, RM(12));
          EpiResid E{ws, lds, 1.0f, 0, 3 * l + 2};
#if (PROBE_DUP >> 14) & 1
          { pg8::Gemm g0{(const bf16*)(ws + WS_MRG), wl + WE_OUT, MP, DM, 256}; EpiResid E0{ws, lds, 0.0f, 0, -1};
            pg8::gemm_phase<EpiResid, pg8::StaticOrder, PROBE_ALIGN_RES, PROBE_SP2>(lds + RING_OFF, g0, S, E0, tid); }
#endif
          pg8::gemm_phase<EpiResid, pg8::StaticOrder, PROBE_ALIGN_RES, PROBE_SP2, true>(lds + RING_OFF, g, S, E, tid); }
        { IDS(); unsigned char* ws = WSP(); const bf16* wl = (const bf16*)(ws + WS_W) + (size_t)l * WE_LAYER; EpiResid E{ws, lds, 1.0f, 0, 3 * l + 2};
          for (int su = G - 1 - bid; su < DM / 64; su += G) skinny_unit<EpiResid>(lds + RING_OFF, (const bf16*)(ws + WS_MRG), wl + WE_OUT, DM, su, E, tid); }
        { IDS(); TAIL_SLOT(2); }
        IDS();
        SEAM(pb + 9);
    }
}

__global__ void __launch_bounds__(NTHR, 2) fwd_kernel(Args args) {
    extern __shared__ __attribute__((aligned(16))) unsigned char lds_raw[];
    LAS unsigned char* lds = (LAS unsigned char*)lds_raw;
    const int tid0 = threadIdx.x; const int wave0 = __builtin_amdgcn_readfirstlane(tid0 >> 6);
    const int G0 = gridDim.x, bid0 = blockIdx.x;
    { const int tid = tid0; for (int u = tid; u < (LDS_BYTES - LDSCTL_OFF) / 4; u += NTHR) ((LAS unsigned*)(lds + LDSCTL_OFF))[u] = 0u; }
    __syncthreads();
    if (tid0 == 0) {
        LAS unsigned long long* pt = (LAS unsigned long long*)(lds + PT_OFF);
#pragma unroll
        for (int i = 0; i < 31; ++i) pt[i] = (unsigned long long)args.in[i];
        pt[PT_OUT] = (unsigned long long)args.out; pt[PT_WS] = (unsigned long long)args.ws;
    }
    __syncthreads();
    if (!MK_PER_PHASE) (void)xcd_barrier_post((unsigned*)(args.ws + WS_CTL) + CW_BAR, (volatile LAS unsigned*)(lds + MISC_OFF) + 8);
    const int lo = args.ph_lo, hi = args.ph_hi;

    if (IN(0)) {
        IDS(); unsigned char* ws = WSP(); float* out = (float*)ldp(lds, PT_OUT);
        REP(0) { prologue_blocks(lds, (bf16*)(ws + WS_W), 0, DEPTH * PB_LAYER, bid, G, tid, G == 256); prologue_specials(lds, (bf16*)(ws + WS_W), G - 1 - bid, G, tid); }
#if (PROBE_DUP >> 18) & 1
        prologue_specials(lds, (bf16*)(ws + WS_W), G - 1 - bid, G, tid);
#endif
#if (PROBE_DUP >> 16) & 1
        prologue_blocks<1>(lds, (bf16*)(ws + WS_W), 0, DEPTH * PB_LAYER, bid, G, tid, G == 256);
#endif
#if (PROBE_DUP >> 17) & 1
        prologue_blocks<2>(lds, (bf16*)(ws + WS_W), 0, DEPTH * PB_LAYER, bid, G, tid, G == 256);
#endif
        x_init_pass(ldp(lds, 0), ldp(lds, 1), (bf16*)(ws + WS_XN), (unsigned long long*)(ws + WS_CTL + CTL_SS), GW, NGW, lane);
        { const f32x4* src = (const f32x4*)ldp(lds, 7); f32x4* dst = (f32x4*)(out + OFF_POOL_S); const int per = 11 * 128;
          for (int i = GT; i < DEPTH * NB_S * per; i += NGT) { const int lb = i / per, j = i - lb * per; dst[(size_t)lb * 15 * 128 + j] = src[(size_t)lb * 15 * 128 + 4 * 128 + j]; } }
        SEAM(0);
    }

    { Ctx c; c.lds = lds; c.tid0 = tid0; c.wave0 = wave0; c.G0 = G0; c.bid0 = bid0; c.lo = lo; c.hi = hi;
#if MK_UNROLL_LAYERS
      ff_part(c, 0, 0); mixer_part(c, 0); ff_part(c, 0, 1); ff_part(c, 1, 0); mixer_part(c, 1); ff_part(c, 1, 1);
      ff_part(c, 2, 0); mixer_part(c, 2); ff_part(c, 2, 1); ff_part(c, 3, 0); mixer_part(c, 3); ff_part(c, 3, 1);
#else
      _Pragma("unroll 1") for (int l = 0; l < DEPTH; ++l) {
          _Pragma("unroll 1") for (int f = 0; f < 2; ++f) { ff_part(c, l, f); if (f == 0) mixer_part(c, l); }
      }
#endif
    }
#undef IN
#undef SEAM
}

extern "C" void kernel_launch(void* const* d_in, const int* in_sizes, int n_in, void* d_out, int out_size, void* d_ws, size_t ws_size, hipStream_t stream) {
    static int grid = 0;
    if (grid == 0) {
        if (n_in != 31 || out_size != OUT_TOTAL || ws_size < WS_END) { fprintf(stderr, "kernel_launch: expected 31 inputs, %d outputs, >= %zu bytes ws; got %d, %d, %zu\n", OUT_TOTAL, (size_t)WS_END, n_in, out_size, ws_size); grid = -1; return; }
        int dev = 0, cus = 0, per_cu = 0;
        if (hipGetDevice(&dev) != hipSuccess || hipDeviceGetAttribute(&cus, hipDeviceAttributeMultiprocessorCount, dev) != hipSuccess) { grid = -1; return; }
        if (hipFuncSetAttribute((const void*)fwd_kernel, hipFuncAttributeMaxDynamicSharedMemorySize, LDS_BYTES) != hipSuccess) { fprintf(stderr, "kernel_launch: hipFuncSetAttribute failed\n"); grid = -1; return; }
        if (hipOccupancyMaxActiveBlocksPerMultiprocessor(&per_cu, (const void*)fwd_kernel, NTHR, LDS_BYTES) != hipSuccess || per_cu < 1) fprintf(stderr, "kernel_launch: occupancy query says %d\n", per_cu);
        (void)hipGetLastError();
        grid = cus;
    }
    if (grid < 0) return;
    if (hipMemsetAsync((char*)d_ws + WS_CTL, 0, CTL_ZERO_BYTES, stream) != hipSuccess) return;
    Args a; memset(&a, 0, sizeof(a));
    for (int i = 0; i < 31; ++i) a.in[i] = (const float*)d_in[i];
    a.out = (float*)d_out; a.ws = (unsigned char*)d_ws;
#if MK_PER_PHASE
    for (int ph = 0; ph < NPH; ++ph) { a.ph_lo = ph; a.ph_hi = ph + 1; hipLaunchKernelGGL(fwd_kernel, dim3(grid), dim3(NTHR), LDS_BYTES, stream, a); }
#else
    a.ph_lo = 0; a.ph_hi = NPH;
    hipLaunchKernelGGL(fwd_kernel, dim3(grid), dim3(NTHR), LDS_BYTES, stream, a);
#endif
    const hipError_t le = hipPeekAtLastError();
    if (le != hipSuccess) fprintf(stderr, "kernel_launch: launch failed: %s\n", hipGetErrorName(le));
}
```
